# Optimizing an MI355X kernel written in HIP

```python
import math
import jax, jax.numpy as jnp
from jax import lax
import numpy as np


D_MODEL = 2048
BATCH = 4
SEQ = 4096
DEPTH = 4

GRID_W = 64
CTX_LEN = 256
BRANCH_WIDTH = D_MODEL // 2
N_BRANCH = 3
A_DH = 64
A_DV = 2 * A_DH
A_HEADS = BRANCH_WIDTH // A_DV
A_QK_WIDTH = A_HEADS * 2 * A_DH
A_SCALE = A_DH ** -0.5
A_Q_BLOCK = 128
ROPE_THETA = 10000.0
ROPE_PAIRS = A_DH // 4
LAMBDA_STD = 0.1
B_CHUNK = 128
B_GROUPS = 8
B_GDIM = BRANCH_WIDTH // B_GROUPS
C_WINDOWS = (2, 4, 8, 16)
C_GROUPS = len(C_WINDOWS)
C_GDIM = BRANCH_WIDTH // C_GROUPS
FFN_HIDDEN = ((8 * D_MODEL + 3 * 256 - 1) // (3 * 256)) * 256
ALPHA = (2 * DEPTH) ** 0.25
BETA = (8 * DEPTH) ** -0.25
LN_EPS = 1e-6
Q_OFF = 0
K_OFF = Q_OFF + A_QK_WIDTH
V_OFF = K_OFF + A_QK_WIDTH
V_END = V_OFF + BRANCH_WIDTH
BU_OFF = V_END
C_OFF = BU_OFF + 2 * BRANCH_WIDTH
G_OFF = C_OFF + BRANCH_WIDTH
IN_WIDTH = G_OFF + N_BRANCH * D_MODEL

kernel_name = 'hybrid_diffattn_gmlp_pool_dit_block'

f32 = jnp.float32


def norm_only(x):
    xf = x.astype(f32)
    mu = jnp.mean(xf, -1, keepdims=True)
    var = jnp.mean(jnp.square(xf - mu), -1, keepdims=True)
    return ((xf - mu) * lax.rsqrt(var + LN_EPS)).astype(x.dtype)


def layer_norm(x, g, b):
    xf = x.astype(f32)
    mu = jnp.mean(xf, -1, keepdims=True)
    var = jnp.mean(jnp.square(xf - mu), -1, keepdims=True)
    return ((xf - mu) * lax.rsqrt(var + LN_EPS) * g + b).astype(x.dtype)


def rms_norm(x, g):
    xf = x.astype(f32)
    return (xf * lax.rsqrt(jnp.mean(jnp.square(xf), -1, keepdims=True) + LN_EPS) * g).astype(x.dtype)


def adaln(cond, w, b, n_chunks):
    width = n_chunks * D_MODEL
    return jax.nn.silu(cond) @ w[:, :width] + b[:width]


def axial_rope_tables(row, col):
    inv = ROPE_THETA ** (-jnp.arange(ROPE_PAIRS, dtype=f32) / ROPE_PAIRS)
    ang = jnp.stack([row.astype(f32)[:, None] * inv, col.astype(f32)[:, None] * inv], axis=1)
    return jnp.cos(ang), jnp.sin(ang)


def apply_rope(x, cos, sin):
    xr = x.reshape(x.shape[:-1] + (2, 2, ROPE_PAIRS)).astype(f32)
    x1, x2 = xr[..., 0, :], xr[..., 1, :]
    cb, sb = cos[:, None, None], sin[:, None, None]
    out = jnp.stack([x1 * cb - x2 * sb, x1 * sb + x2 * cb], axis=-2)
    return out.reshape(x.shape).astype(x.dtype)


def heads_qk(z):
    return z.reshape(z.shape[0], z.shape[1], A_HEADS, 2, A_DH)


def heads_v(z):
    return z.reshape(z.shape[0], z.shape[1], A_HEADS, A_DV)


def diff_attention(q, k, v, lam):
    s = jnp.einsum('bqhmd,bkhmd->bhmqk', q, k).astype(f32) * A_SCALE
    p = jax.nn.softmax(s, axis=-1)
    a = (p[:, :, 0] - lam * p[:, :, 1]).astype(v.dtype)
    return jnp.einsum('bhqk,bkhd->bqhd', a, v)


def latent_diff_attention(q, k, v, lam):
    bsz, n, h, m, d = q.shape
    nblk = n // A_Q_BLOCK
    qb = jnp.moveaxis(q.reshape(bsz, nblk, A_Q_BLOCK, h, m, d), 1, 0)
    ob = lax.map(lambda blk: diff_attention(blk, k, v, lam), qb)
    return jnp.moveaxis(ob, 0, 1).reshape(bsz, n, h, v.shape[-1])


def diff_post(o, g, lam_init):
    o = rms_norm(o, g) * (1.0 - lam_init)
    return o.reshape(o.shape[0], o.shape[1], BRANCH_WIDTH)


def gmlp_branch(z_uv, ln_g, ln_b, w_s, b_s):
    z = jax.nn.gelu(z_uv, approximate=False)
    u, v = z[..., :BRANCH_WIDTH], z[..., BRANCH_WIDTH:]
    v = layer_norm(v, ln_g, ln_b)
    bsz, n, _ = v.shape
    v = v.reshape(bsz, n // B_CHUNK, B_CHUNK, B_GROUPS, B_GDIM)
    s = jnp.einsum('gij,bnjgc->bnigc', w_s, v) + b_s.T[:, :, None]
    return u * s.reshape(bsz, n, BRANCH_WIDTH)


def pool_branch(z, w_pool, scale):
    bsz, n, _ = z.shape
    zf = z.reshape(bsz, n, C_GROUPS, C_GDIM).astype(f32)
    cs = jnp.concatenate([jnp.zeros_like(zf[:, :1]), jnp.cumsum(zf, axis=1)], axis=1)
    t = jnp.arange(n)
    pooled = []
    for g, w in enumerate(C_WINDOWS):
        lo = jnp.clip(t - w // 2, 0, n)
        hi = jnp.clip(t - w // 2 + w, 0, n)
        cs_g = cs[:, :, g]
        pooled.append((cs_g[:, hi] - cs_g[:, lo]) / (hi - lo).astype(f32)[None, :, None])
    d = (jnp.stack(pooled, axis=2) - zf).astype(z.dtype)
    y = jnp.einsum('blgc,gcd->blgd', d, w_pool)
    return y.reshape(bsz, n, BRANCH_WIDTH) * scale


def merge_branches(z_gate, y_a, y_b, y_c, w_branch, w_out):
    bsz, n, _ = z_gate.shape
    ys = jnp.stack([y_a, y_b, y_c], axis=2)
    proj = jnp.einsum('blnw,nwd->blnd', ys, w_branch)
    gates = jax.nn.sigmoid(z_gate.reshape(bsz, n, N_BRANCH, D_MODEL))
    return jnp.sum(gates * proj, axis=2) @ w_out


def swiglu(h, w_gu, w_down):
    z = h @ w_gu
    return (jax.nn.silu(z[..., :FFN_HIDDEN]) * z[..., FFN_HIDDEN:]) @ w_down


def setup_inputs(seed: int = 0) -> dict:
    key = jax.random.key(seed)
    ks = jax.random.split(key, 24)

    def nrm(k, shape, scale):
        return jax.random.normal(k, shape, f32) * scale

    return {
        'x': nrm(ks[0], (BATCH, SEQ, D_MODEL), 1.0),
        'c': nrm(ks[1], (BATCH, D_MODEL), 1.0),
        'ctx': nrm(ks[2], (BATCH, CTX_LEN, D_MODEL), 1.0),
        'c_ctx': nrm(ks[3], (D_MODEL,), 1.0),
        'w_ada': nrm(ks[4], (DEPTH, D_MODEL, 6 * D_MODEL), 0.5 * D_MODEL ** -0.5),
        'b_ada': nrm(ks[5], (DEPTH, 6 * D_MODEL), 0.02),
        'w_in': nrm(ks[6], (DEPTH, D_MODEL, IN_WIDTH), D_MODEL ** -0.5),
        'lam_qk': nrm(ks[7], (DEPTH, 4, A_DH), LAMBDA_STD),
        'subln_g': 1.0 + nrm(ks[8], (DEPTH, A_DV), 0.1),
        'gmlp_ln_g': 1.0 + nrm(ks[9], (DEPTH, BRANCH_WIDTH), 0.1),
        'gmlp_ln_b': nrm(ks[10], (DEPTH, BRANCH_WIDTH), 0.02),
        'w_spatial': nrm(ks[11], (DEPTH, B_GROUPS, B_CHUNK, B_CHUNK), B_CHUNK ** -0.5),
        'b_spatial': 1.0 + nrm(ks[12], (DEPTH, B_GROUPS, B_CHUNK), 0.1),
        'w_pool': nrm(ks[13], (DEPTH, C_GROUPS, C_GDIM, C_GDIM), C_GDIM ** -0.5),
        'pool_scale': 1.0 + nrm(ks[14], (DEPTH, BRANCH_WIDTH), 0.1),
        'w_branch': nrm(ks[15], (DEPTH, N_BRANCH, BRANCH_WIDTH, D_MODEL), BRANCH_WIDTH ** -0.5),
        'w_out': nrm(ks[16], (DEPTH, D_MODEL, D_MODEL), BETA * D_MODEL ** -0.5),
        'ln1_g': 1.0 + nrm(ks[17], (DEPTH, D_MODEL), 0.1),
        'ln1_b': nrm(ks[18], (DEPTH, D_MODEL), 0.02),
        'w_gu': nrm(ks[19], (DEPTH, D_MODEL, 2 * FFN_HIDDEN), D_MODEL ** -0.5),
        'w_down': nrm(ks[20], (DEPTH, FFN_HIDDEN, D_MODEL), BETA * FFN_HIDDEN ** -0.5),
        'ln2_g': 1.0 + nrm(ks[21], (DEPTH, D_MODEL), 0.1),
        'ln2_b': nrm(ks[22], (DEPTH, D_MODEL), 0.02),
    }


def reference(x, c, ctx, c_ctx, w_ada, b_ada, w_in, lam_qk, subln_g, gmlp_ln_g, gmlp_ln_b,
              w_spatial, b_spatial, w_pool, pool_scale, w_branch, w_out, ln1_g, ln1_b,
              w_gu, w_down, ln2_g, ln2_b):
    n_lat = x.shape[1]
    rows = n_lat // GRID_W
    row = jnp.repeat(jnp.arange(rows), GRID_W)
    col = jnp.tile(jnp.arange(GRID_W), rows)
    cos, sin = axial_rope_tables(row, col)

    x = norm_only(x)
    ctx = norm_only(ctx)

    for l in range(DEPTH):
        last = l == DEPTH - 1
        lam_init = 0.8 - 0.6 * math.exp(-0.3 * l)
        lq = lam_qk[l].astype(f32)
        lam = jnp.exp(jnp.sum(lq[0] * lq[1])) - jnp.exp(jnp.sum(lq[2] * lq[3])) + lam_init

        sh_m, sc_m, g_m, sh_f, sc_f, g_f = jnp.split(adaln(c, w_ada[l], b_ada[l], 6)[:, None, :], 6, axis=-1)
        n_ctx_mod = 2 if last else 6
        mods_c = jnp.split(adaln(c_ctx, w_ada[l], b_ada[l], n_ctx_mod), n_ctx_mod, axis=-1)

        h = x * (1.0 + sc_m) + sh_m
        hc = ctx * (1.0 + mods_c[1]) + mods_c[0]
        z = h @ w_in[l]
        if last:
            zc_kv = hc @ w_in[l][:, K_OFF:V_END]
        else:
            zc = hc @ w_in[l]
            zc_kv = zc[..., K_OFF:V_END]
        k_c = heads_qk(zc_kv[..., :A_QK_WIDTH])
        v_c = heads_v(zc_kv[..., A_QK_WIDTH:])

        q = apply_rope(heads_qk(z[..., Q_OFF:K_OFF]), cos, sin)
        k = apply_rope(heads_qk(z[..., K_OFF:V_OFF]), cos, sin)
        v = heads_v(z[..., V_OFF:V_END])
        k_all = jnp.concatenate([k_c, k], axis=1)
        v_all = jnp.concatenate([v_c, v], axis=1)
        y_a = diff_post(latent_diff_attention(q, k_all, v_all, lam), subln_g[l], lam_init)
        y_b = gmlp_branch(z[..., BU_OFF:C_OFF], gmlp_ln_g[l], gmlp_ln_b[l], w_spatial[l], b_spatial[l])
        y_c = pool_branch(z[..., C_OFF:G_OFF], w_pool[l], pool_scale[l])
        out = merge_branches(z[..., G_OFF:], y_a, y_b, y_c, w_branch[l], w_out[l])
        x = layer_norm(ALPHA * x + g_m * out, ln1_g[l], ln1_b[l])

        hf = x * (1.0 + sc_f) + sh_f
        x = layer_norm(ALPHA * x + g_f * swiglu(hf, w_gu[l], w_down[l]), ln2_g[l], ln2_b[l])

        if not last:
            _, _, g_mc, sh_fc, sc_fc, g_fc = mods_c
            q_c = heads_qk(zc[..., Q_OFF:K_OFF])
            y_ac = diff_post(diff_attention(q_c, k_c, v_c, lam), subln_g[l], lam_init)
            y_bc = gmlp_branch(zc[..., BU_OFF:C_OFF], gmlp_ln_g[l], gmlp_ln_b[l], w_spatial[l], b_spatial[l])
            y_cc = pool_branch(zc[..., C_OFF:G_OFF], w_pool[l], pool_scale[l])
            out_c = merge_branches(zc[..., G_OFF:], y_ac, y_bc, y_cc, w_branch[l], w_out[l])
            ctx = layer_norm(ALPHA * ctx + g_mc * out_c, ln1_g[l], ln1_b[l])
            hfc = ctx * (1.0 + sc_fc) + sh_fc
            ctx = layer_norm(ALPHA * ctx + g_fc * swiglu(hfc, w_gu[l], w_down[l]), ln2_g[l], ln2_b[l])

    return x
```

```cpp
#include <hip/hip_runtime.h>
#include <cstdio>
#include <cstdint>
#include <cmath>
namespace pg8 {
#define PG8_LAS __attribute__((address_space(3)))
typedef unsigned short bf16_t;
typedef short bf16x8 __attribute__((ext_vector_type(8)));
typedef float f32x4 __attribute__((ext_vector_type(4)));
typedef unsigned u32x4 __attribute__((ext_vector_type(4)));
constexpr int BM = 256, BK = 64, HALF = 128, HTB = HALF * BK * 2  , STAGE_BYTES = 8 * HTB, NXCD = 8, WGM = 8;

__host__ __device__ __forceinline__ int lds_byte(int r, int c) { const int st = (r >> 4) * 2 + (c >> 5), rr = r & 15, cc = c & 31, ob = rr * 64 + cc * 2; return st * 1024 + (ob ^ (((ob >> 9) & 1) << 5)); }
__host__ __device__ __forceinline__ void stage_rc(int b, int& R, int& C) { const int st = b / 1024, sb = b % 1024, swz = sb ^ (((sb >> 9) & 1) << 5); R = (st >> 1) * 16 + swz / 64; C = (st & 1) * 32 + (swz % 64) / 2; }
__host__ __device__ __forceinline__ int perm32(int rho) { const int n = rho >> 4, i = rho & 15; return 8 * (i >> 2) + 4 * n + (i & 3); }

struct Unit { int pm, pn; };
struct Gemm { const bf16_t* A; const bf16_t* Bt; int M, N, K; };

struct StaticOrder {
    int nM, nN, nwg, G, c;
    __host__ __device__ void init(int M, int N, int G_, int c_) { nM = M / BM; nN = N / BM; nwg = nM * nN; G = G_; c = c_; }
    __host__ __device__ bool next(int i, Unit& u) const {
        const long L = (long)i * G + c; if (L >= nwg) return false;
        int wgid = (int)L; { const int q = nwg / NXCD, r = nwg % NXCD, xcd = wgid % NXCD, off = wgid / NXCD; wgid = (xcd < r ? xcd * (q + 1) : r * (q + 1) + (xcd - r) * q) + off; }
        const int nig = WGM * nN, gid = wgid / nig, fm = gid * WGM, gsz = (nM - fm) < WGM ? (nM - fm) : WGM;
        u.pm = fm + ((wgid % nig) % gsz); u.pn = (wgid % nig) / gsz; return true;
    }
    __device__ __forceinline__ void a_ready(const Unit&) const {}
    __device__ __forceinline__ void done(const Unit&) const {}
};

__device__ __forceinline__ unsigned cvt_pk_bf16(float lo, float hi) { unsigned r; asm volatile("v_cvt_pk_bf16_f32 %0, %1, %2" : "=v"(r) : "v"(lo), "v"(hi)); return r; }
typedef float f32x2 __attribute__((ext_vector_type(2)));
__device__ __forceinline__ f32x2 gelu_pk(f32x2 v) {
    const f32x2 av = __builtin_elementwise_abs(v), d = av * 0.2316418882f + 1.0f;
    f32x2 t; t.x = __builtin_amdgcn_rcpf(d.x); t.y = __builtin_amdgcn_rcpf(d.y);
    f32x2 q = t * 0.5307027145f + (-0.7265760135f); q = q * t + 0.7107068705f; q = q * t + (-0.142248368f); q = q * t + 0.127414796f; q = q * t;
    const f32x2 s = (v * v) * (-0.72134752044f);
    f32x2 e; e.x = __builtin_amdgcn_exp2f(s.x); e.y = __builtin_amdgcn_exp2f(s.y);
    const f32x2 m = v * (q * e), r = v - m;
    f32x2 o; o.x = v.x < 0.f ? m.x : r.x; o.y = v.y < 0.f ? m.y : r.y; return o;
}

typedef unsigned u32x2 __attribute__((ext_vector_type(2)));
__device__ __forceinline__ float bf_lo(unsigned w) { return __uint_as_float(w << 16); }
__device__ __forceinline__ float bf_hi(unsigned w) { return __uint_as_float(w & 0xffff0000u); }
__device__ __forceinline__ void store8_bf16(bf16_t* p, const f32x4 v0, const f32x4 v1) {
    u32x4 w; w.x = cvt_pk_bf16(v0[0], v0[1]); w.y = cvt_pk_bf16(v0[2], v0[3]); w.z = cvt_pk_bf16(v1[0], v1[1]); w.w = cvt_pk_bf16(v1[2], v1[3]); *(u32x4*)p = w;
}
__device__ __forceinline__ float sigmoid_f(float x) { return __builtin_amdgcn_rcpf(1.0f + __builtin_amdgcn_exp2f(x * -1.4426950408889634f)); }

struct EpiInProj {
    static constexpr bool PERM = true, AFTER_DRAIN = false; static constexpr int KSEG = 0;
    bf16_t* Z; const float* rope; float qscale; int ldc; int nlat;
    __device__ __forceinline__ void kseg(f32x4 (&)[2][2][4][2], const Unit&, int, int, int, int, int) const {}
    __device__ __forceinline__ void operator()(const f32x4 (&acc)[2][2][4][2], const Unit& u, int wr, int wc, int fr, int fq) const {
        const int pn = u.pn; const int row0 = u.pm * BM + wr * 64 + fr; const int col0 = pn * BM + wc * 32 + 8 * fq;
        if (pn < 8) {
            const float sc = pn < 4 ? qscale : 1.0f;
#pragma unroll
            for (int ai = 0; ai < 2; ++ai)
#pragma unroll
                for (int m = 0; m < 4; ++m) {
                    const int row = row0 + ai * HALF + m * 16; const int t = row & 4095; const int pos = (wc & 1) ? (t & 63) : (t >> 6);
                    f32x4 cs0 = *(const f32x4*)(rope + (pos * 16 + 4 * fq) * 2), cs1 = *(const f32x4*)(rope + (pos * 16 + 4 * fq) * 2 + 4);
                    if (row >= nlat) { cs0 = (f32x4){1.f, 0.f, 1.f, 0.f}; cs1 = cs0; }
                    bf16_t* rowp = Z + (size_t)row * ldc + col0;
#pragma unroll
                    for (int bj = 0; bj < 2; ++bj) {
                        const f32x4 a = acc[ai][bj][m][0], b = acc[ai][bj][m][1];
                        f32x4 o0, o1;
                        o0[0] = (a[0] * cs0[0] - a[1] * cs0[1]) * sc; o0[1] = (a[0] * cs0[1] + a[1] * cs0[0]) * sc;
                        o0[2] = (a[2] * cs0[2] - a[3] * cs0[3]) * sc; o0[3] = (a[2] * cs0[3] + a[3] * cs0[2]) * sc;
                        o1[0] = (b[0] * cs1[0] - b[1] * cs1[1]) * sc; o1[1] = (b[0] * cs1[1] + b[1] * cs1[0]) * sc;
                        o1[2] = (b[2] * cs1[2] - b[3] * cs1[3]) * sc; o1[3] = (b[2] * cs1[3] + b[3] * cs1[2]) * sc;
                        store8_bf16(rowp + bj * HALF, o0, o1);
                    }
                }
        } else if (pn < 12 || (pn >= 20 && pn < 24)) {
#pragma unroll
            for (int ai = 0; ai < 2; ++ai)
#pragma unroll
                for (int m = 0; m < 4; ++m) { bf16_t* rowp = Z + (size_t)(row0 + ai * HALF + m * 16) * ldc + col0;
#pragma unroll
                    for (int bj = 0; bj < 2; ++bj) store8_bf16(rowp + bj * HALF, acc[ai][bj][m][0], acc[ai][bj][m][1]); }
        } else if (pn < 20) {
#pragma unroll
            for (int ai = 0; ai < 2; ++ai)
#pragma unroll
                for (int m = 0; m < 4; ++m) { bf16_t* rowp = Z + (size_t)(row0 + ai * HALF + m * 16) * ldc + col0;
#pragma unroll
                    for (int bj = 0; bj < 2; ++bj) { const f32x4 v0 = acc[ai][bj][m][0], v1 = acc[ai][bj][m][1];
                        const f32x2 a = gelu_pk((f32x2){v0[0], v0[1]}), b = gelu_pk((f32x2){v0[2], v0[3]}), c = gelu_pk((f32x2){v1[0], v1[1]}), d = gelu_pk((f32x2){v1[2], v1[3]});
                        store8_bf16(rowp + bj * HALF, (f32x4){a.x, a.y, b.x, b.y}, (f32x4){c.x, c.y, d.x, d.y}); } }
        } else {
#pragma unroll
            for (int ai = 0; ai < 2; ++ai)
#pragma unroll
                for (int m = 0; m < 4; ++m) { bf16_t* rowp = Z + (size_t)(row0 + ai * HALF + m * 16) * ldc + col0;
#pragma unroll
                    for (int bj = 0; bj < 2; ++bj) { const f32x4 v0 = acc[ai][bj][m][0], v1 = acc[ai][bj][m][1]; f32x4 o0, o1;
#pragma unroll
                        for (int i = 0; i < 4; ++i) { o0[i] = __builtin_fmaxf(sigmoid_f(v0[i]), 1e-12f); o1[i] = __builtin_fmaxf(sigmoid_f(v1[i]), 1e-12f); }
                        store8_bf16(rowp + bj * HALF, o0, o1); } }
        }
    }
};

struct EpiGate {
    static constexpr bool PERM = true, AFTER_DRAIN = false; static constexpr int KSEG = 16;
    const bf16_t* G; int ldg; bf16_t* O; int ldo;
    __device__ __forceinline__ void kseg(f32x4 (&acc)[2][2][4][2], const Unit& u, int seg, int wr, int wc, int fr, int fq) const {
        const int row0 = u.pm * BM + wr * 64 + fr; const int col0 = u.pn * BM + wc * 32 + 8 * fq;
#pragma unroll
        for (int ai = 0; ai < 2; ++ai)
#pragma unroll
            for (int m = 0; m < 4; ++m) { const bf16_t* gp = G + (size_t)(row0 + ai * HALF + m * 16) * ldg + (seg - 1) * 2048 + col0;
#pragma unroll
                for (int bj = 0; bj < 2; ++bj) { const u32x4 ga = *(const u32x4*)(gp + bj * HALF), gb = *(const u32x4*)(gp + 2048 + bj * HALF);
                    f32x4 r0, r1;
                    r0[0] = bf_lo(ga.x) * __builtin_amdgcn_rcpf(bf_lo(gb.x)); r0[1] = bf_hi(ga.x) * __builtin_amdgcn_rcpf(bf_hi(gb.x));
                    r0[2] = bf_lo(ga.y) * __builtin_amdgcn_rcpf(bf_lo(gb.y)); r0[3] = bf_hi(ga.y) * __builtin_amdgcn_rcpf(bf_hi(gb.y));
                    r1[0] = bf_lo(ga.z) * __builtin_amdgcn_rcpf(bf_lo(gb.z)); r1[1] = bf_hi(ga.z) * __builtin_amdgcn_rcpf(bf_hi(gb.z));
                    r1[2] = bf_lo(ga.w) * __builtin_amdgcn_rcpf(bf_lo(gb.w)); r1[3] = bf_hi(ga.w) * __builtin_amdgcn_rcpf(bf_hi(gb.w));
                    acc[ai][bj][m][0] *= r0; acc[ai][bj][m][1] *= r1; }
                asm volatile("" ::: "memory"); }
    }
    __device__ __forceinline__ void operator()(const f32x4 (&acc)[2][2][4][2], const Unit& u, int wr, int wc, int fr, int fq) const {
        const int row0 = u.pm * BM + wr * 64 + fr; const int col0 = u.pn * BM + wc * 32 + 8 * fq;
#pragma unroll
        for (int ai = 0; ai < 2; ++ai)
#pragma unroll
            for (int m = 0; m < 4; ++m) { const size_t row = (size_t)(row0 + ai * HALF + m * 16); const bf16_t* gp = G + row * ldg + 2 * 2048 + col0; bf16_t* op = O + row * ldo + col0;
#pragma unroll
                for (int bj = 0; bj < 2; ++bj) { const u32x4 g = *(const u32x4*)(gp + bj * HALF);
                    const f32x4 g0 = (f32x4){bf_lo(g.x), bf_hi(g.x), bf_lo(g.y), bf_hi(g.y)}, g1 = (f32x4){bf_lo(g.z), bf_hi(g.z), bf_lo(g.w), bf_hi(g.w)};
                    store8_bf16(op + bj * HALF, acc[ai][bj][m][0] * g0, acc[ai][bj][m][1] * g1); }
                asm volatile("" ::: "memory"); }
    }
};

struct EpiResid {
    static constexpr bool PERM = false, AFTER_DRAIN = false; static constexpr int KSEG = 0;
    float* X; int ldc; const float* gv; int gstride; float alpha;
    __device__ __forceinline__ void kseg(f32x4 (&)[2][2][4][2], const Unit&, int, int, int, int, int) const {}
    __device__ __forceinline__ void operator()(const f32x4 (&acc)[2][2][4][2], const Unit& u, int wr, int wc, int fr, int fq) const {
        const int row0 = u.pm * BM + wr * 64 + fr, col0 = u.pn * BM + wc * 32 + 4 * fq; const int grp = u.pm < 64 ? (u.pm >> 4) : 4;
        f32x4 g[2][2];
#pragma unroll
        for (int bj = 0; bj < 2; ++bj)
#pragma unroll
            for (int n = 0; n < 2; ++n) g[bj][n] = *(const f32x4*)(gv + (size_t)grp * gstride + col0 + bj * HALF + n * 16);
#pragma unroll
        for (int ai = 0; ai < 2; ++ai)
#pragma unroll
            for (int m = 0; m < 4; ++m) { float* rowp = X + (size_t)(row0 + ai * HALF + m * 16) * ldc + col0;
#pragma unroll
                for (int bj = 0; bj < 2; ++bj)
#pragma unroll
                    for (int n = 0; n < 2; ++n) { const f32x4 xv = *(const f32x4*)(rowp + bj * HALF + n * 16); *(f32x4*)(rowp + bj * HALF + n * 16) = xv * alpha + g[bj][n] * acc[ai][bj][m][n]; }
                if (m & 1) asm volatile("" ::: "memory"); }
    }
};

struct EpiSwiglu {
    static constexpr bool PERM = true, AFTER_DRAIN = false; static constexpr int KSEG = 0;
    bf16_t* H; int ldc;
    __device__ __forceinline__ void kseg(f32x4 (&)[2][2][4][2], const Unit&, int, int, int, int, int) const {}
    __device__ __forceinline__ void operator()(const f32x4 (&acc)[2][2][4][2], const Unit& u, int wr, int wc, int fr, int fq) const {
        const int row0 = u.pm * BM + wr * 64 + fr, col0 = u.pn * HALF + wc * 32 + 8 * fq;
#pragma unroll
        for (int ai = 0; ai < 2; ++ai)
#pragma unroll
            for (int m = 0; m < 4; ++m) { bf16_t* rowp = H + (size_t)(row0 + ai * HALF + m * 16) * ldc + col0; f32x4 o[2];
#pragma unroll
                for (int n = 0; n < 2; ++n) { const f32x4 gt = acc[ai][0][m][n], up = acc[ai][1][m][n];
#pragma unroll
                    for (int i = 0; i < 4; ++i) o[n][i] = gt[i] * sigmoid_f(gt[i]) * up[i]; }
                store8_bf16(rowp, o[0], o[1]); }
    }
};
template <class Epi, class Sched, bool ALIGN_EPI = false, bool SP2 = false>
__device__ __forceinline__ void gemm_phase(PG8_LAS unsigned char* lds, const Gemm g, const Sched& S, const Epi& E) {
    int tid_ = threadIdx.x; asm volatile("" : "+v"(tid_));
    const int tid = tid_, wid = __builtin_amdgcn_readfirstlane(tid >> 6), lane = tid & 63, wr = wid >> 2, wc = wid & 3, fr = lane & 15, fq = lane >> 4;
    const int K = g.K, nt = K / BK;
    unsigned voffA[2], voffB[2];
#pragma unroll
    for (int i = 0; i < 2; ++i) { int R, C; stage_rc(tid * 16 + i * 8192, R, C); const int Rb = Epi::PERM ? ((R & ~31) + perm32(R & 31)) : R;
        voffA[i] = (unsigned)(R * K + C) * 2u; voffB[i] = (unsigned)(Rb * K + C) * 2u; }
    const size_t kstep = (size_t)(BK * 2);
    const size_t hstep = (size_t)HALF * K * 2;
    const size_t tstep = 2 * hstep;
    const unsigned ldsw = (unsigned)wid * 1024u;
    const int aoff = lds_byte(wr * 64 + fr, fq * 8), boff = lds_byte(wc * 32 + fr, fq * 8);
#define PG8_SA(b, h) (((b) * 2 + (h)) * HTB)
#define PG8_SB(b, h) ((4 + (b) * 2 + (h)) * HTB)
#define PG8_STAGE(bufoff, gbase, voff) do { _Pragma("unroll") for (int _i = 0; _i < 2; ++_i) \
        __builtin_amdgcn_global_load_lds((const unsigned*)((const char*)(gbase) + (voff)[_i]), (PG8_LAS unsigned*)(lds + (bufoff) + ldsw + _i * 8192), 16, 0, 0); } while (0)
#define PG8_LDA(dst, b, h) do { _Pragma("unroll") for (int m = 0; m < 4; ++m) _Pragma("unroll") for (int k = 0; k < 2; ++k) dst[m][k] = *(const PG8_LAS bf16x8*)(lds + PG8_SA(b, h) + aoff + m * 2048 + k * 1024); } while (0)
#define PG8_LDB(dst, b, h) do { _Pragma("unroll") for (int n = 0; n < 2; ++n) _Pragma("unroll") for (int k = 0; k < 2; ++k) dst[n][k] = *(const PG8_LAS bf16x8*)(lds + PG8_SB(b, h) + boff + n * 2048 + k * 1024); } while (0)
#define PG8_MMA(ai, bj, At, Bt) do { __builtin_amdgcn_s_setprio(1); _Pragma("unroll") for (int m = 0; m < 4; ++m) _Pragma("unroll") for (int n = 0; n < 2; ++n) _Pragma("unroll") for (int k = 0; k < 2; ++k) \
        acc[ai][bj][m][n] = __builtin_amdgcn_mfma_f32_16x16x32_bf16(Bt[n][k], At[m][k], acc[ai][bj][m][n], 0, 0, 0); __builtin_amdgcn_s_setprio(0); } while (0)
#define PG8_WAIT_V(n) asm volatile("s_waitcnt vmcnt(" #n ")" ::: "memory")
#define PG8_WAIT_L(n) asm volatile("s_waitcnt lgkmcnt(" #n ")" ::: "memory")
#define PG8_BAR __builtin_amdgcn_s_barrier()
#define PG8_SCHED __builtin_amdgcn_sched_barrier(0)
    Unit cur, nxt; int ui = 0;
    if (!S.next(0, cur)) return;
    f32x4 acc[2][2][4][2];
#pragma unroll
    for (int a = 0; a < 2; ++a)
#pragma unroll
        for (int b = 0; b < 2; ++b)
#pragma unroll
            for (int m = 0; m < 4; ++m)
#pragma unroll
                for (int n = 0; n < 2; ++n) acc[a][b][m][n] = (f32x4){0.f, 0.f, 0.f, 0.f};
    bf16x8 At[4][2], B0[2][2], B1[2][2];
    const char* cA = (const char*)g.A + (size_t)cur.pm * tstep; const char* cB = (const char*)g.Bt + (size_t)cur.pn * tstep;
    S.a_ready(cur);
    if constexpr (SP2) {
        PG8_STAGE(PG8_SB(0, 0), cB, voffB); PG8_STAGE(PG8_SB(0, 1), cB + hstep, voffB); PG8_STAGE(PG8_SA(0, 0), cA, voffA); PG8_STAGE(PG8_SA(0, 1), cA + hstep, voffA);
        if (wr == 1) PG8_BAR;
        PG8_WAIT_V(2); PG8_BAR;
        PG8_STAGE(PG8_SB(1, 0), cB + kstep, voffB); PG8_STAGE(PG8_SA(1, 0), cA + kstep, voffA); PG8_STAGE(PG8_SB(1, 1), cB + hstep + kstep, voffB);
        PG8_WAIT_V(6); PG8_BAR;
    } else {
        PG8_STAGE(PG8_SB(0, 0), cB, voffB); PG8_STAGE(PG8_SA(0, 0), cA, voffA); PG8_STAGE(PG8_SB(0, 1), cB + hstep, voffB); PG8_STAGE(PG8_SA(0, 1), cA + hstep, voffA);
        if (wr == 1) PG8_BAR;
        PG8_WAIT_V(4); PG8_BAR;
        PG8_STAGE(PG8_SB(1, 0), cB + kstep, voffB); PG8_STAGE(PG8_SA(1, 0), cA + kstep, voffA); PG8_STAGE(PG8_SB(1, 1), cB + hstep + kstep, voffB);
        PG8_WAIT_V(6); PG8_BAR;
    }
    for (;;) {
        const bool has_next = S.next(ui + 1, nxt);
        const char* nA = has_next ? (const char*)g.A + (size_t)nxt.pm * tstep : cA; const char* nB = has_next ? (const char*)g.Bt + (size_t)nxt.pn * tstep : cB;
        for (int t = 0; t < nt; t += 2) {
            const bool last = (t == nt - 2);
            if constexpr (Epi::KSEG > 0) { if (t > 0 && (t % Epi::KSEG) == 0) E.kseg(acc, cur, t / Epi::KSEG, wr, wc, fr, fq); }
            const char* a1 = cA + (size_t)(t + 1) * kstep;
            const char* a2 = last ? nA : cA + (size_t)(t + 2) * kstep; const char* b2 = last ? nB : cB + (size_t)(t + 2) * kstep;
            const char* a3 = a2 + kstep; const char* b3 = b2 + kstep;
            if (last && has_next) S.a_ready(nxt);
            if constexpr (SP2) {
            PG8_LDB(B0, 0, 0); PG8_LDB(B1, 0, 1); PG8_SCHED; PG8_LDA(At, 0, 0); PG8_STAGE(PG8_SA(1, 1), a1 + hstep, voffA);
            PG8_WAIT_V(8); PG8_WAIT_L(0); PG8_BAR; PG8_MMA(0, 0, At, B0); PG8_MMA(0, 1, At, B1); PG8_BAR; PG8_SCHED;
            PG8_LDA(At, 0, 1); PG8_STAGE(PG8_SB(0, 0), b2, voffB); PG8_STAGE(PG8_SB(0, 1), b2 + hstep, voffB); PG8_STAGE(PG8_SA(0, 0), a2, voffA);
            PG8_WAIT_V(8); PG8_WAIT_L(0); PG8_BAR; PG8_MMA(1, 0, At, B0); PG8_MMA(1, 1, At, B1); PG8_BAR; PG8_SCHED;
            PG8_LDB(B0, 1, 0); PG8_LDB(B1, 1, 1); PG8_SCHED; PG8_LDA(At, 1, 0); PG8_STAGE(PG8_SA(0, 1), a2 + hstep, voffA);
            PG8_WAIT_V(8); PG8_WAIT_L(0); PG8_BAR; PG8_MMA(0, 0, At, B0); PG8_MMA(0, 1, At, B1); PG8_BAR; PG8_SCHED;
            PG8_LDA(At, 1, 1); PG8_STAGE(PG8_SB(1, 0), b3, voffB); PG8_STAGE(PG8_SB(1, 1), b3 + hstep, voffB); PG8_STAGE(PG8_SA(1, 0), a3, voffA);
            PG8_WAIT_V(8); PG8_WAIT_L(0); PG8_BAR; PG8_MMA(1, 0, At, B0); PG8_MMA(1, 1, At, B1); PG8_BAR; PG8_SCHED;
            } else {
            PG8_LDB(B0, 0, 0); PG8_SCHED; PG8_LDA(At, 0, 0); PG8_STAGE(PG8_SA(1, 1), a1 + hstep, voffA);
            PG8_WAIT_L(8); PG8_BAR; PG8_WAIT_L(0); PG8_MMA(0, 0, At, B0); PG8_BAR; PG8_SCHED;
            PG8_LDB(B1, 0, 1); PG8_STAGE(PG8_SB(0, 0), b2, voffB);
            PG8_BAR; PG8_WAIT_L(0); PG8_MMA(0, 1, At, B1); PG8_BAR;
            PG8_LDA(At, 0, 1); PG8_STAGE(PG8_SA(0, 0), a2, voffA);
            PG8_BAR; PG8_WAIT_L(0); PG8_MMA(1, 0, At, B0); PG8_BAR; PG8_SCHED;
            PG8_STAGE(PG8_SB(0, 1), b2 + hstep, voffB);
            PG8_WAIT_V(6); PG8_BAR; PG8_MMA(1, 1, At, B1); PG8_BAR;
            PG8_LDB(B0, 1, 0); PG8_SCHED; PG8_LDA(At, 1, 0); PG8_STAGE(PG8_SA(0, 1), a2 + hstep, voffA);
            PG8_WAIT_L(8); PG8_BAR; PG8_WAIT_L(0); PG8_MMA(0, 0, At, B0); PG8_BAR; PG8_SCHED;
            PG8_LDB(B1, 1, 1); PG8_STAGE(PG8_SB(1, 0), b3, voffB);
            PG8_BAR; PG8_WAIT_L(0); PG8_MMA(0, 1, At, B1); PG8_BAR;
            PG8_LDA(At, 1, 1); PG8_STAGE(PG8_SA(1, 0), a3, voffA);
            PG8_BAR; PG8_WAIT_L(0); PG8_MMA(1, 0, At, B0); PG8_BAR; PG8_SCHED;
            PG8_STAGE(PG8_SB(1, 1), b3 + hstep, voffB);
            PG8_WAIT_V(6); PG8_BAR; PG8_MMA(1, 1, At, B1); PG8_BAR;
            }
        }
        if constexpr (ALIGN_EPI) { if (wr == 0) PG8_BAR; }
        if constexpr (!Epi::AFTER_DRAIN) { E(acc, cur, wr, wc, fr, fq); S.done(cur); }
        if (!has_next) break;
#pragma unroll
        for (int a = 0; a < 2; ++a)
#pragma unroll
            for (int b = 0; b < 2; ++b)
#pragma unroll
                for (int m = 0; m < 4; ++m)
#pragma unroll
                    for (int n = 0; n < 2; ++n) acc[a][b][m][n] = (f32x4){0.f, 0.f, 0.f, 0.f};
        cur = nxt; cA = nA; cB = nB; ++ui;
        if constexpr (ALIGN_EPI) { if (wr == 1) PG8_BAR; }
    }
    PG8_WAIT_V(0);
    if constexpr (!ALIGN_EPI) { if (wr == 0) PG8_BAR; }
    PG8_BAR;
    if constexpr (Epi::AFTER_DRAIN) { E.fused(acc, cur, wr, wc, fr, fq, lds, wid, lane); S.done(cur); }
#undef PG8_SA
#undef PG8_SB
#undef PG8_STAGE
#undef PG8_LDA
#undef PG8_LDB
#undef PG8_MMA
#undef PG8_WAIT_V
#undef PG8_WAIT_L
#undef PG8_BAR
#undef PG8_SCHED
}
}

constexpr int NWAVES = 8;
constexpr int D = 2048, NBATCH = 4, SEQ = 4096, DEPTH = 4, CTXL = 256;
constexpr int MLAT = NBATCH * SEQ, MCTX = NBATCH * CTXL, MTOT = MLAT + MCTX;
constexpr int INW = 12288, BW = 1024, FFH = 5632, NHEAD = 8;
constexpr int Q_OFF = 0, K_OFF = 1024, V_OFF = 2048, BU_OFF = 3072, C_OFF = 5120, G_OFF = 6144;
constexpr int YW = 3 * BW;
constexpr float LN_EPS = 1e-6f;
constexpr float ALPHA = 1.681792830507429f;
constexpr float QSCALE = 0.125f * 1.4426950408889634f;

constexpr size_t MiB = 1u << 20;
constexpr size_t WS_CTL = 0, CTL_ZERO_BYTES = 1 * MiB;
constexpr size_t WS_ROPE = 1 * MiB;
constexpr size_t WS_MODS = 2 * MiB;
constexpr size_t WS_MODP = 4 * MiB;
constexpr size_t WS_WSP = 20 * MiB;
constexpr size_t WS_WPOOL = 21 * MiB;
constexpr size_t WS_WIN = 24 * MiB;
constexpr size_t WS_WBR = 216 * MiB;
constexpr size_t WS_WOUT = 264 * MiB;
constexpr size_t WS_WGU = 296 * MiB;
constexpr size_t WS_WDN = 472 * MiB;
constexpr size_t WS_X = 560 * MiB;
constexpr size_t WS_HA = 696 * MiB;
constexpr size_t WS_Y = 764 * MiB;
constexpr size_t WS_MG = 866 * MiB;
constexpr size_t WS_Z = 934 * MiB;
constexpr size_t WS_END = 1342 * MiB;
static_assert(WS_MODP + 16ull * 4 * 5 * 12288 * 4 <= WS_WSP && WS_WIN + 4ull * 12288 * 2048 * 2 <= WS_WBR && WS_WBR + 4ull * 2048 * 3072 * 2 <= WS_WOUT && WS_WOUT + 4ull * 2048 * 2048 * 2 <= WS_WGU, "ws map 1");
static_assert(WS_WGU + 4ull * 11264 * 2048 * 2 <= WS_WDN && WS_WDN + 4ull * 2048 * 5632 * 2 <= WS_X && WS_X + (size_t)MTOT * D * 4 <= WS_HA && WS_HA + (size_t)MTOT * D * 2 <= WS_Y, "ws map 2");
static_assert(WS_Y + (size_t)MTOT * YW * 2 <= WS_MG && WS_MG + (size_t)MTOT * D * 2 <= WS_Z && WS_Z + (size_t)MTOT * INW * 2 <= WS_END, "ws map 3");
constexpr int CW_BAR = 4096;

constexpr int RING_OFF = 0, RING_BYTES = 131072;
constexpr int LDSCTL_OFF = RING_BYTES, MISC_OFF = LDSCTL_OFF + 320;
constexpr int LDS_BYTES = 147456;

#define GAS __attribute__((address_space(1)))
#define LAS __attribute__((address_space(3)))
typedef unsigned short bf16;
typedef unsigned v4u __attribute__((ext_vector_type(4)));
typedef unsigned v2u __attribute__((ext_vector_type(2)));
typedef float f32x4 __attribute__((ext_vector_type(4)));
typedef float f32x16 __attribute__((ext_vector_type(16)));
typedef short bf16x8 __attribute__((ext_vector_type(8)));
typedef short s16x4 __attribute__((ext_vector_type(4)));
typedef GAS unsigned gu32;
#define RLX_AGENT __ATOMIC_RELAXED, __HIP_MEMORY_SCOPE_AGENT
#define LDS_WAIT() asm volatile("s_waitcnt lgkmcnt(0)" ::: "memory")
#define VM_WAIT() asm volatile("s_waitcnt vmcnt(0)" ::: "memory")
__device__ __forceinline__ unsigned f2bf(float f) { unsigned u = __builtin_bit_cast(unsigned, f); return (u + 0x7fffu + ((u >> 16) & 1u)) >> 16; }
__device__ __forceinline__ unsigned pk2(float lo, float hi) { return f2bf(lo) | (f2bf(hi) << 16); }
__device__ __forceinline__ unsigned cvtpk(float lo, float hi) { unsigned r; asm volatile("v_cvt_pk_bf16_f32 %0, %1, %2" : "=v"(r) : "v"(lo), "v"(hi)); return r; }
__device__ __forceinline__ float bflo(unsigned w) { return __uint_as_float(w << 16); }
__device__ __forceinline__ float bfhi(unsigned w) { return __uint_as_float(w & 0xffff0000u); }

#define XB_TMO      128
#define XB_XCNT(j)  (256  + 64 * (j))
#define XB_XSUB(j)  (1280 + 64 * (j))
#define XB_XGEN(j)  (2304 + 64 * (j))
#define XB_TOP      3328
#define XB_TOPGEN   3392
#define XCD_BAR_WORDS 3456
#define XB_SPIN_CAP (1u << 18)

__device__ __forceinline__ unsigned xb_ld(unsigned* p)              { return __hip_atomic_load(p, __ATOMIC_RELAXED, __HIP_MEMORY_SCOPE_AGENT); }
__device__ __forceinline__ unsigned xb_add(unsigned* p, unsigned v) { return __hip_atomic_fetch_add(p, v, __ATOMIC_RELAXED, __HIP_MEMORY_SCOPE_AGENT); }
__device__ __forceinline__ unsigned xb_xcc_id() { return (unsigned)__builtin_amdgcn_s_getreg((3 << 11) | 20) & 0xFu; }
#define XB_SPIN(cond, bar) do { unsigned _sp = 0; while (cond) { __builtin_amdgcn_s_sleep(1); \
    if ((++_sp & 255u) == 0u) { if (xb_ld(&(bar)[XB_TMO])) break; if (_sp > XB_SPIN_CAP) { atomicAdd(&(bar)[XB_TMO], 1u); break; } } } } while (0)

struct XcdBarrier {
    unsigned* bar; unsigned x;
    volatile LAS unsigned* st;
};

__device__ __forceinline__ XcdBarrier xcd_barrier_post(unsigned* bar, volatile LAS unsigned* st) {
    XcdBarrier b; b.bar = bar; b.x = xb_xcc_id(); b.st = st;
    if (threadIdx.x == 0) (void)xb_add(&bar[XB_XCNT(b.x)], 1u);
    return b;
}
__device__ __forceinline__ void xcd_barrier_complete(unsigned* bar, unsigned x, unsigned& nloc, unsigned& nx) {
    const unsigned G = gridDim.x * gridDim.y * gridDim.z;
    unsigned sum, cnt, mine, sp = 0u;
    for (;;) {
        sum = 0u; cnt = 0u; mine = 0u;
#pragma unroll
        for (unsigned j = 0; j < 16; ++j) { const unsigned c = xb_ld(&bar[XB_XCNT(j)]); sum += c; cnt += (c > 0u) ? 1u : 0u; mine = (j == x) ? c : mine; }
        if (sum == G) break;
        __builtin_amdgcn_s_sleep(1);
        if ((++sp & 255u) == 0u) { if (xb_ld(&bar[XB_TMO])) break; if (sp > XB_SPIN_CAP) { atomicAdd(&bar[XB_TMO], 1u); break; } }
    }
    nloc = mine > 0u ? mine : 1u; nx = cnt > 0u ? cnt : 1u;
}

__device__ __forceinline__ void xcd_barrier(const XcdBarrier& b) {
    asm volatile("s_waitcnt vmcnt(0)" ::: "memory");
    __syncthreads();
    if (threadIdx.x == 0) {
        unsigned* bar = b.bar;
        __builtin_amdgcn_s_waitcnt(0);
        unsigned nloc = b.st[0], nx = b.st[1];
        if (nloc == 0u) { xcd_barrier_complete(bar, b.x, nloc, nx); b.st[0] = nloc; b.st[1] = nx; }
        const unsigned old = xb_add(&bar[XB_XSUB(b.x)], 1u);
        const unsigned gen = old / nloc;
        if (old + 1u == (gen + 1u) * nloc) {
            __builtin_amdgcn_fence(__ATOMIC_RELEASE, "agent");
            asm volatile("s_waitcnt vmcnt(0)" ::: "memory");
            const unsigned og = xb_add(&bar[XB_TOP], 1u);
            const unsigned tg = og / nx;
            if (og + 1u == (tg + 1u) * nx) xb_add(&bar[XB_TOPGEN], 1u);
            else XB_SPIN(xb_ld(&bar[XB_TOPGEN]) == tg, bar);
            __builtin_amdgcn_fence(__ATOMIC_ACQUIRE, "agent");
            xb_add(&bar[XB_XGEN(b.x)], 1u);
            asm volatile("s_waitcnt vmcnt(0)" ::: "memory");
        } else {
            XB_SPIN(xb_ld(&bar[XB_XGEN(b.x)]) == gen, bar);
            __builtin_amdgcn_fence(__ATOMIC_ACQUIRE, "agent");
            asm volatile("s_waitcnt vmcnt(0)" ::: "memory");
        }
    }
    __syncthreads();
}


struct Frame {
    LAS unsigned char* lds;
    volatile LAS unsigned* MISC;
    gu32* ctl;
    int tid, lane, wave, vcu, G;
    const float *x, *c, *ctx, *cctx, *w_ada, *b_ada, *w_in, *lam_qk, *subln_g, *gln_g, *gln_b, *w_sp, *b_sp, *w_pool, *pool_scale, *w_branch, *w_out, *ln1_g, *ln1_b, *w_gu, *w_down, *ln2_g, *ln2_b;
    float* out;
    float *rope, *mods, *modp, *X;
    bf16 *Wsp, *Wpool, *Win, *Wbr, *Wout, *Wgu, *Wdn, *HA, *Y, *MG, *Z;
};

__device__ __forceinline__ float wave_sum(float v) {
#pragma unroll
    for (int o = 1; o < 64; o <<= 1) v += __shfl_xor(v, o);
    return v;
}

__device__ __forceinline__ void cvt_item(const float* W, int N, int k0, int ncol0, bool perm, bf16* WT, size_t drow0, int ldk, int dk0, LAS float* scr, int lane) {
#pragma unroll 8
    for (int i = 0; i < 32; ++i) { const int kk = 2 * i + (lane >> 5); scr[kk * 33 + (lane & 31)] = W[(size_t)(k0 + kk) * N + ncol0 + (lane & 31)]; }
    LDS_WAIT(); asm volatile("" ::: "memory");
    const int c = lane & 7;
#pragma unroll
    for (int j = 0; j < 4; ++j) { const int n = (lane >> 3) + 8 * j; const int ns = perm ? ((n & 1) * 16 + (n >> 1)) : n; const LAS float* s = scr + (8 * c) * 33 + ns;
        v4u o; o.x = pk2(s[0 * 33], s[1 * 33]); o.y = pk2(s[2 * 33], s[3 * 33]); o.z = pk2(s[4 * 33], s[5 * 33]); o.w = pk2(s[6 * 33], s[7 * 33]);
        *(GAS v4u*)(WT + (drow0 + n) * (size_t)ldk + dk0 + k0 + 8 * c) = o; }
    LDS_WAIT(); asm volatile("" ::: "memory");
}
constexpr int CV_IN = 32 * 384, CV_GU = 32 * 352, CV_DN = 88 * 64, CV_BR = 3 * 16 * 64, CV_OUT = 32 * 64, CV_POOL = 4 * 4 * 8, CV_LAYER = CV_IN + CV_GU + CV_DN + CV_BR + CV_OUT + CV_POOL;
__device__ __forceinline__ void cvt_dispatch(Frame& F, int it, LAS float* scr) {
    const int l = it / CV_LAYER; int r = it - l * CV_LAYER;
    if (r < CV_IN) { const int kb = r / 384, nb = r - kb * 384;
        cvt_item(F.w_in + (size_t)l * D * INW, INW, 64 * kb, 32 * nb, nb < 64, F.Win + (size_t)l * INW * D, (size_t)32 * nb, D, 0, scr, F.lane); return; }
    r -= CV_IN;
    if (r < CV_GU) { const int kb = r / 352, nb = r - kb * 352; const int tpn = nb >> 3, half = (nb >> 2) & 1, jj0 = (nb & 3) * 32;
        cvt_item(F.w_gu + (size_t)l * D * 2 * FFH, 2 * FFH, 64 * kb, half * FFH + 128 * tpn + jj0, false, F.Wgu + (size_t)l * 2 * FFH * D, (size_t)32 * nb, D, 0, scr, F.lane); return; }
    r -= CV_GU;
    if (r < CV_DN) { const int kb = r >> 6, nb = r & 63;
        cvt_item(F.w_down + (size_t)l * FFH * D, D, 64 * kb, 32 * nb, false, F.Wdn + (size_t)l * D * FFH, (size_t)32 * nb, FFH, 0, scr, F.lane); return; }
    r -= CV_DN;
    if (r < CV_BR) { const int n = r >> 10, rr = r & 1023, kb = rr >> 6, nb = rr & 63;
        cvt_item(F.w_branch + ((size_t)l * 3 + n) * BW * D, D, 64 * kb, 32 * nb, false, F.Wbr + (size_t)l * D * YW, (size_t)32 * nb, YW, BW * n, scr, F.lane); return; }
    r -= CV_BR;
    if (r < CV_OUT) { const int kb = r >> 6, nb = r & 63;
        cvt_item(F.w_out + (size_t)l * D * D, D, 64 * kb, 32 * nb, false, F.Wout + (size_t)l * D * D, (size_t)32 * nb, D, 0, scr, F.lane); return; }
    r -= CV_OUT;
    { const int g = r >> 5, rr = r & 31, kb = rr >> 3, nb = rr & 7;
        cvt_item(F.w_pool + ((size_t)l * 4 + g) * 65536, 256, 64 * kb, 32 * nb, false, F.Wpool + ((size_t)l * 4 + g) * 65536, (size_t)32 * nb, 256, 0, scr, F.lane); }
}

__device__ __forceinline__ double rope_inv(int p) {
    const double t[16] = {1.0, 0.5623413251903491, 0.31622776601683794, 0.1778279410038923, 0.1, 0.05623413251903491, 0.03162277660168379, 0.01778279410038923,
                          0.01, 0.005623413251903491, 0.003162277660168379, 0.001778279410038923, 0.001, 0.0005623413251903491, 0.00031622776601683794, 0.0001778279410038923};
    double r = t[0];
#pragma unroll
    for (int i = 1; i < 16; ++i) r = (p == i) ? t[i] : r;
    return r;
}
__device__ __forceinline__ void phase_a1(Frame& F) {
    const int gw = F.vcu * NWAVES + F.wave, NGW = F.G * NWAVES;
    LAS float* scs = (LAS float*)(F.lds);
    for (int i = F.tid; i < 5 * D; i += NWAVES * 64) { const int g = i >> 11, k = i & 2047; const float v = g < 4 ? F.c[g * D + k] : F.cctx[k]; scs[i] = v / (1.0f + __expf(-v)); }
    __syncthreads();
    for (int it = gw; it < 4 * 16 * 48; it += NGW) {
        const int l = it / 768, rem = it - l * 768, ks = rem / 48, cgw = rem - ks * 48; const int col = cgw * 256 + F.lane * 4;
        const float* wp = F.w_ada + ((size_t)l * D + ks * 128) * INW + col;
        f32x4 a0 = {0.f, 0.f, 0.f, 0.f}, a1 = a0, a2 = a0, a3 = a0, a4 = a0;
#pragma unroll 8
        for (int k = 0; k < 128; ++k) { const f32x4 w = *(const GAS f32x4*)(wp + (size_t)k * INW); const int kk = ks * 128 + k;
            a0 += w * scs[kk]; a1 += w * scs[D + kk]; a2 += w * scs[2 * D + kk]; a3 += w * scs[3 * D + kk]; a4 += w * scs[4 * D + kk]; }
        float* pp = F.modp + (((size_t)ks * 4 + l) * 5) * INW + col;
        *(f32x4*)(pp) = a0; *(f32x4*)(pp + INW) = a1; *(f32x4*)(pp + 2 * INW) = a2; *(f32x4*)(pp + 3 * INW) = a3; *(f32x4*)(pp + 4 * INW) = a4;
    }
    __syncthreads();
    LAS float* scr = (LAS float*)(F.lds + F.wave * 16384);
    for (int it = gw; it < DEPTH * CV_LAYER; it += NGW) cvt_dispatch(F, it, scr);
    for (int it = gw; it < (DEPTH * 8 * 128 * 128) / 512; it += NGW) { const size_t e = (size_t)it * 512 + F.lane * 8;
        const f32x4 a = *(const f32x4*)(F.w_sp + e), b = *(const f32x4*)(F.w_sp + e + 4);
        v4u o; o.x = pk2(a[0], a[1]); o.y = pk2(a[2], a[3]); o.z = pk2(b[0], b[1]); o.w = pk2(b[2], b[3]); *(v4u*)(F.Wsp + e) = o; }
    if (gw == 0) {
        for (int e = F.lane; e < 1024; e += 64) { const int pos = e >> 4, pr = e & 15;
            const double ang = (double)pos * rope_inv(pr); const double twopi = 6.283185307179586476925286766559;
            const double kq = __builtin_rint(ang / twopi); const double rr = ang - kq * twopi; const double r2 = rr * rr;
            double sn = 1.0, cs = 1.0;
#pragma unroll
            for (int n = 14; n >= 1; --n) { sn = 1.0 - sn * r2 / (double)((2 * n) * (2 * n + 1)); cs = 1.0 - cs * r2 / (double)((2 * n - 1) * (2 * n)); }
            sn *= rr;
            F.rope[2 * e] = (float)cs; F.rope[2 * e + 1] = (float)sn; }
    }
}
__device__ __forceinline__ void phase_a2(Frame& F) {
    const int gt = F.vcu * NWAVES * 64 + F.tid, NGT = F.G * NWAVES * 64;
    for (int i = gt; i < DEPTH * 5 * (INW / 4); i += NGT) { const int l = i / (5 * (INW / 4)), rem = i - l * (5 * (INW / 4)), g = rem / (INW / 4), j = (rem - g * (INW / 4)) * 4;
        f32x4 s = *(const f32x4*)(F.b_ada + (size_t)l * INW + j);
#pragma unroll
        for (int ks = 0; ks < 16; ++ks) s += *(const f32x4*)(F.modp + (((size_t)ks * 4 + l) * 5 + g) * INW + j);
        *(f32x4*)(F.mods + ((size_t)l * 5 + g) * INW + j) = s; }
}
__device__ __forceinline__ void ln_row(const float* src, const float* gam, const float* bet, float* xo, bf16* ho, const float* sc, const float* sh, int lane) {
    f32x4 v[8]; float s = 0.f;
#pragma unroll
    for (int j = 0; j < 8; ++j) { v[j] = *(const GAS f32x4*)(src + 4 * lane + 256 * j); s += (v[j][0] + v[j][1]) + (v[j][2] + v[j][3]); }
    const float mean = wave_sum(s) * (1.f / D); float s2 = 0.f;
#pragma unroll
    for (int j = 0; j < 8; ++j) { v[j] = v[j] - mean; s2 += (v[j][0] * v[j][0] + v[j][1] * v[j][1]) + (v[j][2] * v[j][2] + v[j][3] * v[j][3]); }
    const float rstd = 1.0f / sqrtf(wave_sum(s2) * (1.f / D) + LN_EPS);
#pragma unroll
    for (int j = 0; j < 8; ++j) { const int col = 4 * lane + 256 * j; f32x4 xn = v[j] * rstd;
        if (gam) xn = xn * *(const f32x4*)(gam + col) + *(const f32x4*)(bet + col);
        if (xo) *(GAS f32x4*)(xo + col) = xn;
        if (ho) { const f32x4 hv = xn * (1.0f + *(const f32x4*)(sc + col)) + *(const f32x4*)(sh + col); v2u o; o.x = pk2(hv[0], hv[1]); o.y = pk2(hv[2], hv[3]); *(GAS v2u*)(ho + col) = o; } }
}
__device__ __forceinline__ int row_group(int row) { return row < MLAT ? (row >> 12) : 4; }
__device__ __forceinline__ void phase_a3(Frame& F) {
    const int gw = F.vcu * NWAVES + F.wave, NGW = F.G * NWAVES;
    for (int row = gw; row < MTOT; row += NGW) { const float* src = row < MLAT ? F.x + (size_t)row * D : F.ctx + (size_t)(row - MLAT) * D; const float* md = F.mods + (size_t)row_group(row) * INW;
        ln_row(src, nullptr, nullptr, F.X + (size_t)row * D, F.HA + (size_t)row * D, md + D, md, F.lane); }
}
__device__ __forceinline__ void phase_ln(Frame& F, const float* gam, const float* bet, int nrows, bool to_out, bool want_h, int lm, int moff) {
    const int gw = F.vcu * NWAVES + F.wave, NGW = F.G * NWAVES;
    for (int row = gw; row < nrows; row += NGW) { const float* md = F.mods + ((size_t)lm * 5 + row_group(row)) * INW + moff;
        ln_row(F.X + (size_t)row * D, gam, bet, to_out ? F.out + (size_t)row * D : F.X + (size_t)row * D, want_h ? F.HA + (size_t)row * D : nullptr, md + D, md, F.lane); }
}

constexpr int AT_KB = 0, AT_VB = 32768, AT_TILE = 16384, AT_QB = 65536;
__device__ __forceinline__ s16x4 vtr(const LAS unsigned char* p) { typedef short v4i16_t __attribute__((ext_vector_type(4))); return __builtin_bit_cast(s16x4, __builtin_amdgcn_ds_read_tr16_b64_v4i16((LAS v4i16_t*)p)); }
__device__ __forceinline__ float max3f(float a, float b, float c) { float r; asm("v_max3_f32 %0, %1, %2, %3" : "=v"(r) : "v"(a), "v"(b), "v"(c)); return r; }
__device__ __forceinline__ void glds16(const void* gsrc, unsigned lds_dst) { unsigned keep;
    asm volatile("s_mov_b32 %0, m0\n\ts_mov_b32 m0, %2\n\ts_nop 0\n\tglobal_load_lds_dwordx4 %1, off\n\ts_mov_b32 m0, %0" : "=&s"(keep) : "v"(gsrc), "s"(lds_dst) : "memory"); }
__device__ __forceinline__ void attn_unit(Frame& F, int b, int h, int qb, bool ctxq, float lam, float oscale, const float* subg) {
    int lane_ = F.lane; asm volatile("" : "+v"(lane_));
    const int lane = lane_, wid = F.wave, r32 = lane & 31, hi = lane >> 5;
    const bf16* Z = F.Z;
    const int qrow = (ctxq ? MLAT + b * CTXL : b * SEQ + qb * 256) + wid * 32 + r32;
    __syncthreads();
    LAS unsigned char* qlds = F.lds + AT_QB + wid * 8192 + lane * 16;
#pragma unroll
    for (int m = 0; m < 2; ++m)
#pragma unroll
        for (int d0 = 0; d0 < 4; ++d0) *(LAS bf16x8*)(qlds + (m * 4 + d0) * 1024) = *(const GAS bf16x8*)(Z + (size_t)qrow * INW + Q_OFF + h * 128 + m * 64 + d0 * 16 + hi * 8);
    const int NT = ctxq ? 4 : 68;
    const int ctxrow0 = MLAT + b * CTXL, latrow0 = b * SEQ - 256;
    const unsigned lds0 = (unsigned)(size_t)F.lds;
    const int prow = 8 * wid + (lane >> 4), ppos = lane & 15;
    const unsigned koff0 = (unsigned)(prow * INW + K_OFF + h * 128 + ((ppos ^ (prow & 15)) * 8)), koff1 = (unsigned)((prow + 4) * INW + K_OFF + h * 128 + ((ppos ^ ((prow + 4) & 15)) * 8));
    const unsigned voff0 = (unsigned)(prow * INW + V_OFF + h * 128 + ((ppos ^ (4 * (prow & 3))) * 8)), voff1 = voff0 + 4 * INW;
    const unsigned kdst = (unsigned)__builtin_amdgcn_readfirstlane((int)(lds0 + AT_KB + wid * 2048)), vdst = (unsigned)__builtin_amdgcn_readfirstlane((int)(lds0 + AT_VB + wid * 2048));
#define AT_DMA(t, bufo) do { const bf16* tb_ = Z + (size_t)((((t) < 4) ? ctxrow0 : latrow0) + 64 * (t)) * INW; \
        glds16(tb_ + koff0, kdst + (bufo)); glds16(tb_ + koff1, kdst + (bufo) + 1024); glds16(tb_ + voff0, vdst + (bufo)); glds16(tb_ + voff1, vdst + (bufo) + 1024); } while (0)
    f32x16 o[2][4];
#pragma unroll
    for (int m = 0; m < 2; ++m)
#pragma unroll
        for (int db = 0; db < 4; ++db)
#pragma unroll
            for (int r = 0; r < 16; ++r) o[m][db][r] = 0.f;
    float mref[2] = {0.f, 0.f}, lsum[2] = {0.f, 0.f};
    const unsigned kaddr0 = AT_KB + r32 * 256 + ((hi ^ (r32 & 15)) << 4);
    const int a4 = (lane & 15) >> 2, cc = 2 * ((lane >> 4) & 1) + ((lane & 3) >> 1);
    const unsigned vaddr0 = AT_VB + (4 * hi + a4) * 256 + ((4 * a4 + cc) << 4) + 8 * (lane & 1);
    AT_DMA(0, 0);
    for (int t = 0; t < NT; ++t) {
        const unsigned bo = (t & 1) ? AT_TILE : 0;
        if (t + 1 < NT) { AT_DMA(t + 1, bo ^ AT_TILE); asm volatile("s_waitcnt vmcnt(4)\n\ts_barrier" ::: "memory"); }
        else { asm volatile("s_waitcnt vmcnt(0)\n\ts_barrier" ::: "memory"); }
        bf16x8 pk[2][2][2];
        unsigned kb_ = kaddr0 + bo, vb_ = vaddr0 + bo; asm volatile("" : "+v"(kb_), "+v"(vb_));
#pragma unroll
        for (int m = 0; m < 2; ++m) {
            f32x16 p0, p1;
#pragma unroll
            for (int r = 0; r < 16; ++r) { p0[r] = -mref[m]; p1[r] = -mref[m]; }
#pragma unroll
            for (int d0 = 0; d0 < 4; ++d0) {
                const unsigned ka = kb_ ^ (unsigned)((8 * m + 2 * d0) << 4);
                const bf16x8 qv = *(const LAS bf16x8*)(qlds + (m * 4 + d0) * 1024);
                const bf16x8 kf0 = *(const LAS bf16x8*)(F.lds + ka), kf1 = *(const LAS bf16x8*)(F.lds + ka + 32 * 256);
                p0 = __builtin_amdgcn_mfma_f32_32x32x16_bf16(kf0, qv, p0, 0, 0, 0);
                p1 = __builtin_amdgcn_mfma_f32_32x32x16_bf16(kf1, qv, p1, 0, 0, 0);
            }
            float tmax = max3f(p0[0], p1[0], p0[1]);
#pragma unroll
            for (int r = 1; r < 15; ++r) tmax = max3f(tmax, p1[r], p0[r + 1]);
            tmax = max3f(tmax, p1[15], __shfl_xor(max3f(tmax, p1[15], p1[15]), 32));
            if (t == 0) {
                mref[m] = tmax;
#pragma unroll
                for (int r = 0; r < 16; ++r) { p0[r] -= tmax; p1[r] -= tmax; }
            } else if (__any(tmax > 8.0f)) {
                const float dl = __builtin_fmaxf(tmax, 0.f); mref[m] += dl; const float al = __builtin_amdgcn_exp2f(-dl); lsum[m] *= al;
#pragma unroll
                for (int r = 0; r < 16; ++r) { p0[r] -= dl; p1[r] -= dl; }
#pragma unroll
                for (int db = 0; db < 4; ++db)
#pragma unroll
                    for (int r = 0; r < 16; ++r) o[m][db][r] *= al;
            }
            float ls = 0.f;
#pragma unroll
            for (int r = 0; r < 16; ++r) { p0[r] = __builtin_amdgcn_exp2f(p0[r]); p1[r] = __builtin_amdgcn_exp2f(p1[r]); ls += p0[r] + p1[r]; }
            lsum[m] += ls;
#pragma unroll
            for (int s = 0; s < 2; ++s) {
                v4u w0, w1;
                w0.x = cvtpk(p0[8 * s + 0], p0[8 * s + 1]); w0.y = cvtpk(p0[8 * s + 2], p0[8 * s + 3]); w0.z = cvtpk(p0[8 * s + 4], p0[8 * s + 5]); w0.w = cvtpk(p0[8 * s + 6], p0[8 * s + 7]);
                w1.x = cvtpk(p1[8 * s + 0], p1[8 * s + 1]); w1.y = cvtpk(p1[8 * s + 2], p1[8 * s + 3]); w1.z = cvtpk(p1[8 * s + 4], p1[8 * s + 5]); w1.w = cvtpk(p1[8 * s + 6], p1[8 * s + 7]);
                pk[m][0][s] = __builtin_bit_cast(bf16x8, w0); pk[m][1][s] = __builtin_bit_cast(bf16x8, w1);
            }
            __builtin_amdgcn_sched_barrier(0);
        }
#pragma unroll
        for (int db = 0; db < 4; ++db) {
            const unsigned va = vb_ ^ (unsigned)(db << 6);
#pragma unroll
            for (int kh = 0; kh < 2; ++kh)
#pragma unroll
                for (int s = 0; s < 2; ++s) {
                    const s16x4 lo = vtr(F.lds + va + (32 * kh + 16 * s) * 256), hh = vtr(F.lds + va + (32 * kh + 16 * s + 8) * 256);
                    const bf16x8 vf = (bf16x8){lo[0], lo[1], lo[2], lo[3], hh[0], hh[1], hh[2], hh[3]};
                    o[0][db] = __builtin_amdgcn_mfma_f32_32x32x16_bf16(vf, pk[0][kh][s], o[0][db], 0, 0, 0);
                    o[1][db] = __builtin_amdgcn_mfma_f32_32x32x16_bf16(vf, pk[1][kh][s], o[1][db], 0, 0, 0);
                }
        }
        asm volatile("s_waitcnt lgkmcnt(0)\n\ts_barrier" ::: "memory");
    }
#undef AT_DMA
    const float l0 = lsum[0] + __shfl_xor(lsum[0], 32), l1 = lsum[1] + __shfl_xor(lsum[1], 32);
    const float i0 = 1.0f / l0, i1 = lam / l1; float ss = 0.f;
#pragma unroll
    for (int db = 0; db < 4; ++db)
#pragma unroll
        for (int r = 0; r < 16; ++r) { const float v = o[0][db][r] * i0 - o[1][db][r] * i1; o[0][db][r] = v; ss += v * v; }
    ss += __shfl_xor(ss, 32);
    const float rs = oscale / sqrtf(ss * (1.0f / 128.0f) + LN_EPS);
    bf16* yp = F.Y + (size_t)qrow * YW + h * 128 + 4 * hi;
#pragma unroll
    for (int db = 0; db < 4; ++db)
#pragma unroll
        for (int g4 = 0; g4 < 4; ++g4) { const int d = 32 * db + 8 * g4; const f32x4 gv = *(const f32x4*)(subg + d + 4 * hi);
            v2u w; w.x = cvtpk(o[0][db][4 * g4 + 0] * rs * gv[0], o[0][db][4 * g4 + 1] * rs * gv[1]); w.y = cvtpk(o[0][db][4 * g4 + 2] * rs * gv[2], o[0][db][4 * g4 + 3] * rs * gv[3]);
            *(GAS v2u*)(yp + d) = w; }
}

constexpr int GM_ST = 0, GM_VT = 1024, GM_VP = 272;
__device__ __forceinline__ void gmlp_unit(Frame& F, int row0, int l) {
    int tid_ = F.tid; asm volatile("" : "+v"(tid_)); const int tid = tid_, lane = tid & 63, wid = F.wave;
    typedef float f32x2v __attribute__((ext_vector_type(2)));
    LAS f32x2v* st = (LAS f32x2v*)(F.lds + GM_ST); LAS unsigned char* vt = F.lds + GM_VT;
    const bf16* Z = F.Z;
    __syncthreads();
    for (int i = 0; i < 16; ++i) { const int tok = wid * 16 + i; const bf16* vp = Z + (size_t)(row0 + tok) * INW + BU_OFF + BW + lane * 16;
        const v4u a = *(const GAS v4u*)(vp), b2 = *(const GAS v4u*)(vp + 8);
        float x[16] = {bflo(a.x), bfhi(a.x), bflo(a.y), bfhi(a.y), bflo(a.z), bfhi(a.z), bflo(a.w), bfhi(a.w), bflo(b2.x), bfhi(b2.x), bflo(b2.y), bfhi(b2.y), bflo(b2.z), bfhi(b2.z), bflo(b2.w), bfhi(b2.w)};
        float s = 0.f;
#pragma unroll
        for (int e = 0; e < 16; ++e) s += x[e];
        const float mean = wave_sum(s) * (1.0f / 1024.0f); float q = 0.f;
#pragma unroll
        for (int e = 0; e < 16; ++e) { const float dd = x[e] - mean; q += dd * dd; }
        const float rstd = 1.0f / sqrtf(wave_sum(q) * (1.0f / 1024.0f) + LN_EPS);
        if (lane == 0) st[tok] = (f32x2v){mean, rstd}; }
    __syncthreads();
    const float* lng = F.gln_g + (size_t)l * BW; const float* lnb = F.gln_b + (size_t)l * BW;
    for (int g = 0; g < 8; ++g) {
        { const int j = tid & 127, cc = tid >> 7; const f32x2v sj = st[j]; const bf16* vp = Z + (size_t)(row0 + j) * INW + BU_OFF + BW + g * 128 + cc * 32;
#pragma unroll
          for (int q4 = 0; q4 < 4; ++q4) { const v4u a = *(const GAS v4u*)(vp + q4 * 8); const int c0 = cc * 32 + q4 * 8;
              const f32x4 g0 = *(const f32x4*)(lng + g * 128 + c0), g1 = *(const f32x4*)(lng + g * 128 + c0 + 4), b0 = *(const f32x4*)(lnb + g * 128 + c0), b1 = *(const f32x4*)(lnb + g * 128 + c0 + 4);
              const float xv[8] = {bflo(a.x), bfhi(a.x), bflo(a.y), bfhi(a.y), bflo(a.z), bfhi(a.z), bflo(a.w), bfhi(a.w)};
#pragma unroll
              for (int e = 0; e < 8; ++e) { const float gg = e < 4 ? g0[e & 3] : g1[e & 3], bb = e < 4 ? b0[e & 3] : b1[e & 3]; const float y = (xv[e] - sj.x) * sj.y * gg + bb;
                  *(LAS bf16*)(vt + (c0 + e) * GM_VP + j * 2) = (bf16)f2bf(y); } } }
        __syncthreads();
        { const int fr = lane & 15, fq = lane >> 4;
          bf16x8 af[4];
#pragma unroll
          for (int ks = 0; ks < 4; ++ks) af[ks] = *(const LAS bf16x8*)(vt + (wid * 16 + fr) * GM_VP + (ks * 32 + fq * 8) * 2);
          const bf16* wg = F.Wsp + ((size_t)l * 8 + g) * 16384;
          const float* bs = F.b_sp + ((size_t)l * 8 + g) * 128;
#pragma unroll 2
          for (int it = 0; it < 8; ++it) { f32x4 acc = {0.f, 0.f, 0.f, 0.f};
#pragma unroll
              for (int ks = 0; ks < 4; ++ks) { const bf16x8 bfr = *(const GAS bf16x8*)(wg + (size_t)(it * 16 + fr) * 128 + ks * 32 + fq * 8); acc = __builtin_amdgcn_mfma_f32_16x16x32_bf16(af[ks], bfr, acc, 0, 0, 0); }
              const int tok = it * 16 + fr; const int ch = g * 128 + wid * 16 + 4 * fq; const float bias = bs[tok];
              const v2u uu = *(const GAS v2u*)(Z + (size_t)(row0 + tok) * INW + BU_OFF + ch);
              v2u w; w.x = cvtpk(bflo(uu.x) * (acc[0] + bias), bfhi(uu.x) * (acc[1] + bias)); w.y = cvtpk(bflo(uu.y) * (acc[2] + bias), bfhi(uu.y) * (acc[3] + bias));
              *(GAS v2u*)(F.Y + (size_t)(row0 + tok) * YW + BW + ch) = w; } }
        __syncthreads();
    }
}

constexpr int PL_DP = 528;
__device__ __forceinline__ void pool_unit(Frame& F, int row0, int g, int l) {
    int tid_ = F.tid; asm volatile("" : "+v"(tid_)); const int tid = tid_, lane = tid & 63, wid = F.wave;
    LAS unsigned char* dt = F.lds;
    const bf16* Z = F.Z;
    const int seqlen = row0 < MLAT ? SEQ : CTXL; const int s0 = row0 < MLAT ? (row0 & ~(SEQ - 1)) : MLAT + ((row0 - MLAT) & ~(CTXL - 1));
    const int w = 2 << g, hw = w >> 1;
    __syncthreads();
    { const int ch = tid & 31, tg = tid >> 5;
      const bf16* zc = Z + C_OFF + g * 256 + ch * 8;
      for (int i = 0; i < 8; ++i) { const int tl = tg * 8 + i; const int p = row0 - s0 + tl; const int lo = p - hw < 0 ? 0 : p - hw; const int hi = p - hw + w > seqlen ? seqlen : p - hw + w;
          float sum[8] = {0.f, 0.f, 0.f, 0.f, 0.f, 0.f, 0.f, 0.f};
          for (int q = lo; q < hi; ++q) { const v4u a = *(const GAS v4u*)(zc + (size_t)(s0 + q) * INW);
              sum[0] += bflo(a.x); sum[1] += bfhi(a.x); sum[2] += bflo(a.y); sum[3] += bfhi(a.y); sum[4] += bflo(a.z); sum[5] += bfhi(a.z); sum[6] += bflo(a.w); sum[7] += bfhi(a.w); }
          const v4u zz = *(const GAS v4u*)(zc + (size_t)(s0 + p) * INW); const float inv = 1.0f / (float)(hi - lo);
          v4u o; o.x = pk2(sum[0] * inv - bflo(zz.x), sum[1] * inv - bfhi(zz.x)); o.y = pk2(sum[2] * inv - bflo(zz.y), sum[3] * inv - bfhi(zz.y));
          o.z = pk2(sum[4] * inv - bflo(zz.z), sum[5] * inv - bfhi(zz.z)); o.w = pk2(sum[6] * inv - bflo(zz.w), sum[7] * inv - bfhi(zz.w));
          *(LAS v4u*)(dt + tl * PL_DP + ch * 16) = o; } }
    __syncthreads();
    { const int fr = lane & 15, fq = lane >> 4;
      f32x4 acc[2][8];
#pragma unroll
      for (int a = 0; a < 2; ++a)
#pragma unroll
          for (int tt = 0; tt < 8; ++tt) acc[a][tt] = (f32x4){0.f, 0.f, 0.f, 0.f};
      const bf16* wp = F.Wpool + ((size_t)l * 4 + g) * 65536 + (size_t)(wid * 32 + fr) * 256 + fq * 8;
#pragma unroll 2
      for (int ks = 0; ks < 8; ++ks) { const bf16x8 a0 = *(const GAS bf16x8*)(wp + ks * 32), a1 = *(const GAS bf16x8*)(wp + 16 * 256 + ks * 32);
#pragma unroll
          for (int tt = 0; tt < 8; ++tt) { const bf16x8 bfr = *(const LAS bf16x8*)(dt + (tt * 16 + fr) * PL_DP + (ks * 32 + fq * 8) * 2);
              acc[0][tt] = __builtin_amdgcn_mfma_f32_16x16x32_bf16(a0, bfr, acc[0][tt], 0, 0, 0); acc[1][tt] = __builtin_amdgcn_mfma_f32_16x16x32_bf16(a1, bfr, acc[1][tt], 0, 0, 0); } }
      const float* ps = F.pool_scale + (size_t)l * BW + g * 256;
#pragma unroll
      for (int a = 0; a < 2; ++a) { const int dd = wid * 32 + a * 16 + 4 * fq; const f32x4 sc = *(const f32x4*)(ps + dd);
#pragma unroll
          for (int tt = 0; tt < 8; ++tt) { const f32x4 v = acc[a][tt] * sc; v2u wv; wv.x = cvtpk(v[0], v[1]); wv.y = cvtpk(v[2], v[3]);
              *(GAS v2u*)(F.Y + (size_t)(row0 + tt * 16 + fr) * YW + 2 * BW + g * 256 + dd) = wv; } } }
}

#ifndef MIXM
#define MIXM 7
#endif
__device__ __forceinline__ void phase_mixers(Frame& F, int l, float lam_init) {
    const bool last = (l == DEPTH - 1);
    float d01 = 0.f, d23 = 0.f; const float* lq = F.lam_qk + (size_t)l * 256;
    for (int i = 0; i < 64; ++i) { d01 += lq[i] * lq[64 + i]; d23 += lq[128 + i] * lq[192 + i]; }
    const float lam = __expf(d01) - __expf(d23) + lam_init; const float oscale = 1.0f - lam_init;
    const float* subg = F.subln_g + (size_t)l * 128;
#pragma nounroll
    for (int i = 0; i < 3; ++i) { const int uid = F.vcu + F.G * i;
        if (!(MIXM & 1)) continue;
        if (uid < 512) attn_unit(F, uid >> 7, (uid >> 4) & 7, uid & 15, false, lam, oscale, subg);
        else if (!last && uid < 544) attn_unit(F, (uid - 512) >> 3, (uid - 512) & 7, 0, true, lam, oscale, subg); }
    const int nchunk = last ? MLAT / 128 : MTOT / 128;
    if (MIXM & 2) for (int cidx = F.G - 1 - F.vcu; cidx < nchunk; cidx += F.G) gmlp_unit(F, cidx * 128, l);
    if (MIXM & 4) for (int u = F.vcu; u < nchunk * 4; u += F.G) pool_unit(F, (u >> 2) * 128, u & 3, l);
    __syncthreads();
}

constexpr int NPHASE = 3 + 8 * DEPTH;
struct Args { const float* in[23]; float* out; unsigned char* ws; int ph_lo, ph_hi; float lam_init[4]; };
__global__ void __launch_bounds__(NWAVES * 64, 2) fwd(Args args) {
    extern __shared__ __attribute__((aligned(16))) unsigned char lds[];
    Frame F;
    F.lds = (LAS unsigned char*)lds;
    F.MISC = (volatile LAS unsigned*)(F.lds + MISC_OFF);
    F.tid = threadIdx.x; F.lane = F.tid & 63; F.wave = __builtin_amdgcn_readfirstlane(F.tid >> 6);
    F.G = gridDim.x; { const int bx = blockIdx.x; F.vcu = (F.G % 8 == 0) ? (bx % 8) * (F.G / 8) + bx / 8 : bx; }
    unsigned char* ws = args.ws;
    F.ctl = (gu32*)(ws + WS_CTL);
    F.x = args.in[0]; F.c = args.in[1]; F.ctx = args.in[2]; F.cctx = args.in[3]; F.w_ada = args.in[4]; F.b_ada = args.in[5]; F.w_in = args.in[6]; F.lam_qk = args.in[7]; F.subln_g = args.in[8];
    F.gln_g = args.in[9]; F.gln_b = args.in[10]; F.w_sp = args.in[11]; F.b_sp = args.in[12]; F.w_pool = args.in[13]; F.pool_scale = args.in[14]; F.w_branch = args.in[15]; F.w_out = args.in[16];
    F.ln1_g = args.in[17]; F.ln1_b = args.in[18]; F.w_gu = args.in[19]; F.w_down = args.in[20]; F.ln2_g = args.in[21]; F.ln2_b = args.in[22]; F.out = args.out;
    F.rope = (float*)(ws + WS_ROPE); F.mods = (float*)(ws + WS_MODS); F.modp = (float*)(ws + WS_MODP); F.X = (float*)(ws + WS_X);
    F.Wsp = (bf16*)(ws + WS_WSP); F.Wpool = (bf16*)(ws + WS_WPOOL); F.Win = (bf16*)(ws + WS_WIN); F.Wbr = (bf16*)(ws + WS_WBR); F.Wout = (bf16*)(ws + WS_WOUT); F.Wgu = (bf16*)(ws + WS_WGU); F.Wdn = (bf16*)(ws + WS_WDN);
    F.HA = (bf16*)(ws + WS_HA); F.Y = (bf16*)(ws + WS_Y); F.MG = (bf16*)(ws + WS_MG); F.Z = (bf16*)(ws + WS_Z);
    for (int u = F.tid; u < (LDS_BYTES - LDSCTL_OFF) / 4; u += NWAVES * 64) ((LAS unsigned*)(F.lds + LDSCTL_OFF))[u] = 0u;
    __syncthreads();
    const int lo = args.ph_lo, hi = args.ph_hi;
    const bool use_bar = (hi - lo) > 1;
    XcdBarrier bar; bar.bar = (unsigned*)(F.ctl + CW_BAR); bar.x = 0; bar.st = nullptr;
    if (use_bar) bar = xcd_barrier_post((unsigned*)(F.ctl + CW_BAR), F.MISC + 8);
#ifndef PHM
#define PHM 0xFFFF
#endif
#define IN(k) (lo <= (k) && (k) < hi)
#define KIND(b) ((PHM >> (b)) & 1)
#define SEAM(k) do { if (IN(k) && IN((k) + 1)) xcd_barrier(bar); } while (0)

    if (KIND(0) && IN(0)) { phase_a1(F); } SEAM(0);
    if (KIND(1) && IN(1)) { phase_a2(F); } SEAM(1);
    if (KIND(2) && IN(2)) { phase_a3(F); } SEAM(2);

#pragma nounroll
    for (int l = 0; l < DEPTH; ++l) {
        const int pb = 3 + 8 * l; const bool last = (l == DEPTH - 1);
        { int t_ = threadIdx.x; asm volatile("" : "+v"(t_)); F.tid = t_; F.lane = t_ & 63; F.wave = __builtin_amdgcn_readfirstlane(t_ >> 6); }
        const int Mrows = last ? MLAT : MTOT;
        const float* mods_l = F.mods + (size_t)l * 5 * INW;
        if (KIND(3) && IN(pb + 0)) {
            pg8::Gemm g{F.HA, F.Win + (size_t)l * INW * D, MTOT, INW, D}; pg8::StaticOrder S; S.init(MTOT, INW, F.G, (int)blockIdx.x);
            pg8::EpiInProj E{F.Z, F.rope, QSCALE, INW, MLAT};
            pg8::gemm_phase<pg8::EpiInProj, pg8::StaticOrder, true, true>(F.lds + RING_OFF, g, S, E);
        }
        SEAM(pb + 0);
        if (KIND(4) && IN(pb + 1)) { phase_mixers(F, l, args.lam_init[l]); }
        SEAM(pb + 1);
        if (KIND(5) && IN(pb + 2)) {
            pg8::Gemm g{F.Y, F.Wbr + (size_t)l * D * YW, Mrows, D, YW}; pg8::StaticOrder S; S.init(Mrows, D, F.G, (int)blockIdx.x);
            pg8::EpiGate E{F.Z + G_OFF, INW, F.MG, D};
            pg8::gemm_phase<pg8::EpiGate, pg8::StaticOrder, true, true>(F.lds + RING_OFF, g, S, E);
        }
        SEAM(pb + 2);
        if (KIND(6) && IN(pb + 3)) {
            pg8::Gemm g{F.MG, F.Wout + (size_t)l * D * D, Mrows, D, D}; pg8::StaticOrder S; S.init(Mrows, D, F.G, (int)blockIdx.x);
            pg8::EpiResid E{F.X, D, mods_l + 2 * D, INW, ALPHA};
            pg8::gemm_phase<pg8::EpiResid, pg8::StaticOrder, true, true>(F.lds + RING_OFF, g, S, E);
        }
        SEAM(pb + 3);
        if (KIND(7) && IN(pb + 4)) { phase_ln(F, F.ln1_g + (size_t)l * D, F.ln1_b + (size_t)l * D, Mrows, false, true, l, 3 * D); }
        SEAM(pb + 4);
        if (KIND(8) && IN(pb + 5)) {
            pg8::Gemm g{F.HA, F.Wgu + (size_t)l * 2 * FFH * D, Mrows, 2 * FFH, D}; pg8::StaticOrder S; S.init(Mrows, 2 * FFH, F.G, (int)blockIdx.x);
            pg8::EpiSwiglu E{F.Z, FFH};
            pg8::gemm_phase<pg8::EpiSwiglu, pg8::StaticOrder, true, true>(F.lds + RING_OFF, g, S, E);
        }
        SEAM(pb + 5);
        if (KIND(9) && IN(pb + 6)) {
            pg8::Gemm g{F.Z, F.Wdn + (size_t)l * D * FFH, Mrows, D, FFH}; pg8::StaticOrder S; S.init(Mrows, D, F.G, (int)blockIdx.x);
            pg8::EpiResid E{F.X, D, mods_l + 5 * D, INW, ALPHA};
            pg8::gemm_phase<pg8::EpiResid, pg8::StaticOrder, true, true>(F.lds + RING_OFF, g, S, E);
        }
        SEAM(pb + 6);
        if (KIND(7) && IN(pb + 7)) { phase_ln(F, F.ln2_g + (size_t)l * D, F.ln2_b + (size_t)l * D, Mrows, last, !last, last ? l : l + 1, 0); }
        if (!last) SEAM(pb + 7);
    }
#undef IN
#undef SEAM
}

#ifndef MK_ONE_LAUNCH
#define MK_ONE_LAUNCH 0
#endif
extern "C" void kernel_launch(void* const* d_in, const int* in_sizes, int n_in, void* d_out, int out_size, void* d_ws, size_t ws_size, hipStream_t stream) {
    static int grid = 0;
    if (grid == 0) {
        if (n_in != 23 || in_sizes[0] != MLAT * D || out_size != MLAT * D || ws_size < WS_END) {
            fprintf(stderr, "kernel_launch: unexpected shapes / workspace (n_in %d, in0 %d, out %d, ws %zu, need %zu); nothing launched\n", n_in, n_in > 0 ? in_sizes[0] : -1, out_size, ws_size, (size_t)WS_END); grid = -1; return; }
        int dev = 0, cus = 0, per_cu = 0;
        if (hipGetDevice(&dev) != hipSuccess || hipDeviceGetAttribute(&cus, hipDeviceAttributeMultiprocessorCount, dev) != hipSuccess) { grid = -1; return; }
        if (hipFuncSetAttribute((const void*)fwd, hipFuncAttributeMaxDynamicSharedMemorySize, LDS_BYTES) != hipSuccess) { fprintf(stderr, "kernel_launch: hipFuncSetAttribute failed\n"); grid = -1; return; }
        if (hipOccupancyMaxActiveBlocksPerMultiprocessor(&per_cu, (const void*)fwd, NWAVES * 64, LDS_BYTES) != hipSuccess || per_cu < 1) fprintf(stderr, "kernel_launch: occupancy query reports %d\n", per_cu);
        (void)hipGetLastError();
        grid = cus;
    }
    if (grid < 0) return;
    if (hipMemsetAsync((char*)d_ws + WS_CTL, 0, CTL_ZERO_BYTES, stream) != hipSuccess) return;
    Args a{};
    for (int i = 0; i < 23; ++i) a.in[i] = (const float*)d_in[i];
    a.out = (float*)d_out; a.ws = (unsigned char*)d_ws;
    for (int l = 0; l < DEPTH; ++l) a.lam_init[l] = (float)(0.8 - 0.6 * exp(-0.3 * (double)l));
#if MK_ONE_LAUNCH
    a.ph_lo = 0; a.ph_hi = NPHASE;
    hipLaunchKernelGGL(fwd, dim3(grid), dim3(NWAVES * 64), LDS_BYTES, stream, a);
#else
    for (int p = 0; p < NPHASE; ++p) { a.ph_lo = p; a.ph_hi = p + 1; hipLaunchKernelGGL(fwd, dim3(grid), dim3(NWAVES * 64), LDS_BYTES, stream, a); }
#endif
}
```

```cpp
#include <hip/hip_runtime.h>
#include <cstdio>
#include <cstdint>
#include <cmath>
namespace pg8 {
#define PG8_LAS __attribute__((address_space(3)))
typedef unsigned short bf16_t;
typedef short bf16x8 __attribute__((ext_vector_type(8)));
typedef float f32x4 __attribute__((ext_vector_type(4)));
typedef unsigned u32x4 __attribute__((ext_vector_type(4)));
constexpr int BM = 256, BK = 64, HALF = 128, HTB = HALF * BK * 2  , STAGE_BYTES = 8 * HTB, NXCD = 8, WGM = 8;

__host__ __device__ __forceinline__ int lds_byte(int r, int c) { const int st = (r >> 4) * 2 + (c >> 5), rr = r & 15, cc = c & 31, ob = rr * 64 + cc * 2; return st * 1024 + (ob ^ (((ob >> 9) & 1) << 5)); }
__host__ __device__ __forceinline__ void stage_rc(int b, int& R, int& C) { const int st = b / 1024, sb = b % 1024, swz = sb ^ (((sb >> 9) & 1) << 5); R = (st >> 1) * 16 + swz / 64; C = (st & 1) * 32 + (swz % 64) / 2; }
__host__ __device__ __forceinline__ int perm32(int rho) { const int n = rho >> 4, i = rho & 15; return 8 * (i >> 2) + 4 * n + (i & 3); }

struct Unit { int pm, pn; };
struct Gemm { const bf16_t* A; const bf16_t* Bt; int M, N, K; };

struct StaticOrder {
    int nM, nN, nwg, G, c;
    __host__ __device__ void init(int M, int N, int G_, int c_) { nM = M / BM; nN = N / BM; nwg = nM * nN; G = G_; c = c_; }
    __host__ __device__ bool next(int i, Unit& u) const {
        const long L = (long)i * G + c; if (L >= nwg) return false;
        int wgid = (int)L; { const int q = nwg / NXCD, r = nwg % NXCD, xcd = wgid % NXCD, off = wgid / NXCD; wgid = (xcd < r ? xcd * (q + 1) : r * (q + 1) + (xcd - r) * q) + off; }
        const int nig = WGM * nN, gid = wgid / nig, fm = gid * WGM, gsz = (nM - fm) < WGM ? (nM - fm) : WGM;
        u.pm = fm + ((wgid % nig) % gsz); u.pn = (wgid % nig) / gsz; return true;
    }
    __device__ __forceinline__ void a_ready(const Unit&) const {}
    __device__ __forceinline__ void done(const Unit&) const {}
};

__device__ __forceinline__ unsigned cvt_pk_bf16(float lo, float hi) { unsigned r; asm volatile("v_cvt_pk_bf16_f32 %0, %1, %2" : "=v"(r) : "v"(lo), "v"(hi)); return r; }
typedef float f32x2 __attribute__((ext_vector_type(2)));
__device__ __forceinline__ f32x2 gelu_pk(f32x2 v) {
    const f32x2 av = __builtin_elementwise_abs(v), d = av * 0.2316418882f + 1.0f;
    f32x2 t; t.x = __builtin_amdgcn_rcpf(d.x); t.y = __builtin_amdgcn_rcpf(d.y);
    f32x2 q = t * 0.5307027145f + (-0.7265760135f); q = q * t + 0.7107068705f; q = q * t + (-0.142248368f); q = q * t + 0.127414796f; q = q * t;
    const f32x2 s = (v * v) * (-0.72134752044f);
    f32x2 e; e.x = __builtin_amdgcn_exp2f(s.x); e.y = __builtin_amdgcn_exp2f(s.y);
    const f32x2 m = v * (q * e), r = v - m;
    f32x2 o; o.x = v.x < 0.f ? m.x : r.x; o.y = v.y < 0.f ? m.y : r.y; return o;
}

typedef unsigned u32x2 __attribute__((ext_vector_type(2)));
__device__ __forceinline__ float bf_lo(unsigned w) { return __uint_as_float(w << 16); }
__device__ __forceinline__ float bf_hi(unsigned w) { return __uint_as_float(w & 0xffff0000u); }
__device__ __forceinline__ void store8_bf16(bf16_t* p, const f32x4 v0, const f32x4 v1) {
    u32x4 w; w.x = cvt_pk_bf16(v0[0], v0[1]); w.y = cvt_pk_bf16(v0[2], v0[3]); w.z = cvt_pk_bf16(v1[0], v1[1]); w.w = cvt_pk_bf16(v1[2], v1[3]); *(u32x4*)p = w;
}
__device__ __forceinline__ float sigmoid_f(float x) { return __builtin_amdgcn_rcpf(1.0f + __builtin_amdgcn_exp2f(x * -1.4426950408889634f)); }

struct EpiInProj {
    static constexpr bool PERM = true, AFTER_DRAIN = false; static constexpr int KSEG = 0;
    bf16_t* Z; const float* rope; float qscale; int ldc; int nlat;
    __device__ __forceinline__ void kseg(f32x4 (&)[2][2][4][2], const Unit&, int, int, int, int, int) const {}
    __device__ __forceinline__ void operator()(const f32x4 (&acc)[2][2][4][2], const Unit& u, int wr, int wc, int fr, int fq) const {
        const int pn = u.pn; const int row0 = u.pm * BM + wr * 64 + fr; const int col0 = pn * BM + wc * 32 + 8 * fq;
        if (pn < 8) {
            const float sc = pn < 4 ? qscale : 1.0f;
#pragma unroll
            for (int ai = 0; ai < 2; ++ai)
#pragma unroll
                for (int m = 0; m < 4; ++m) {
                    const int row = row0 + ai * HALF + m * 16; const int t = row & 4095; const int pos = (wc & 1) ? (t & 63) : (t >> 6);
                    f32x4 cs0 = *(const f32x4*)(rope + (pos * 16 + 4 * fq) * 2), cs1 = *(const f32x4*)(rope + (pos * 16 + 4 * fq) * 2 + 4);
                    if (row >= nlat) { cs0 = (f32x4){1.f, 0.f, 1.f, 0.f}; cs1 = cs0; }
                    bf16_t* rowp = Z + (size_t)row * ldc + col0;
#pragma unroll
                    for (int bj = 0; bj < 2; ++bj) {
                        const f32x4 a = acc[ai][bj][m][0], b = acc[ai][bj][m][1];
                        f32x4 o0, o1;
                        o0[0] = (a[0] * cs0[0] - a[1] * cs0[1]) * sc; o0[1] = (a[0] * cs0[1] + a[1] * cs0[0]) * sc;
                        o0[2] = (a[2] * cs0[2] - a[3] * cs0[3]) * sc; o0[3] = (a[2] * cs0[3] + a[3] * cs0[2]) * sc;
                        o1[0] = (b[0] * cs1[0] - b[1] * cs1[1]) * sc; o1[1] = (b[0] * cs1[1] + b[1] * cs1[0]) * sc;
                        o1[2] = (b[2] * cs1[2] - b[3] * cs1[3]) * sc; o1[3] = (b[2] * cs1[3] + b[3] * cs1[2]) * sc;
                        store8_bf16(rowp + bj * HALF, o0, o1);
                    }
                }
        } else if (pn < 12 || (pn >= 20 && pn < 24)) {
#pragma unroll
            for (int ai = 0; ai < 2; ++ai)
#pragma unroll
                for (int m = 0; m < 4; ++m) { bf16_t* rowp = Z + (size_t)(row0 + ai * HALF + m * 16) * ldc + col0;
#pragma unroll
                    for (int bj = 0; bj < 2; ++bj) store8_bf16(rowp + bj * HALF, acc[ai][bj][m][0], acc[ai][bj][m][1]); }
        } else if (pn < 20) {
#pragma unroll
            for (int ai = 0; ai < 2; ++ai)
#pragma unroll
                for (int m = 0; m < 4; ++m) { bf16_t* rowp = Z + (size_t)(row0 + ai * HALF + m * 16) * ldc + col0;
#pragma unroll
                    for (int bj = 0; bj < 2; ++bj) { const f32x4 v0 = acc[ai][bj][m][0], v1 = acc[ai][bj][m][1];
                        const f32x2 a = gelu_pk((f32x2){v0[0], v0[1]}), b = gelu_pk((f32x2){v0[2], v0[3]}), c = gelu_pk((f32x2){v1[0], v1[1]}), d = gelu_pk((f32x2){v1[2], v1[3]});
                        store8_bf16(rowp + bj * HALF, (f32x4){a.x, a.y, b.x, b.y}, (f32x4){c.x, c.y, d.x, d.y}); } }
        } else {
#pragma unroll
            for (int ai = 0; ai < 2; ++ai)
#pragma unroll
                for (int m = 0; m < 4; ++m) { bf16_t* rowp = Z + (size_t)(row0 + ai * HALF + m * 16) * ldc + col0;
#pragma unroll
                    for (int bj = 0; bj < 2; ++bj) { const f32x4 v0 = acc[ai][bj][m][0], v1 = acc[ai][bj][m][1]; f32x4 o0, o1;
#pragma unroll
                        for (int i = 0; i < 4; ++i) { o0[i] = __builtin_fmaxf(sigmoid_f(v0[i]), 1e-12f); o1[i] = __builtin_fmaxf(sigmoid_f(v1[i]), 1e-12f); }
                        store8_bf16(rowp + bj * HALF, o0, o1); } }
        }
    }
};

struct EpiGate {
    static constexpr bool PERM = true, AFTER_DRAIN = false; static constexpr int KSEG = 16;
    const bf16_t* G; int ldg; bf16_t* O; int ldo;
    __device__ __forceinline__ void kseg(f32x4 (&acc)[2][2][4][2], const Unit& u, int seg, int wr, int wc, int fr, int fq) const {
        const int row0 = u.pm * BM + wr * 64 + fr; const int col0 = u.pn * BM + wc * 32 + 8 * fq;
#pragma unroll
        for (int ai = 0; ai < 2; ++ai)
#pragma unroll
            for (int m = 0; m < 4; ++m) { const bf16_t* gp = G + (size_t)(row0 + ai * HALF + m * 16) * ldg + (seg - 1) * 2048 + col0;
#pragma unroll
                for (int bj = 0; bj < 2; ++bj) { const u32x4 ga = *(const u32x4*)(gp + bj * HALF), gb = *(const u32x4*)(gp + 2048 + bj * HALF);
                    f32x4 r0, r1;
                    r0[0] = bf_lo(ga.x) * __builtin_amdgcn_rcpf(bf_lo(gb.x)); r0[1] = bf_hi(ga.x) * __builtin_amdgcn_rcpf(bf_hi(gb.x));
                    r0[2] = bf_lo(ga.y) * __builtin_amdgcn_rcpf(bf_lo(gb.y)); r0[3] = bf_hi(ga.y) * __builtin_amdgcn_rcpf(bf_hi(gb.y));
                    r1[0] = bf_lo(ga.z) * __builtin_amdgcn_rcpf(bf_lo(gb.z)); r1[1] = bf_hi(ga.z) * __builtin_amdgcn_rcpf(bf_hi(gb.z));
                    r1[2] = bf_lo(ga.w) * __builtin_amdgcn_rcpf(bf_lo(gb.w)); r1[3] = bf_hi(ga.w) * __builtin_amdgcn_rcpf(bf_hi(gb.w));
                    acc[ai][bj][m][0] *= r0; acc[ai][bj][m][1] *= r1; }
                asm volatile("" ::: "memory"); }
    }
    __device__ __forceinline__ void operator()(const f32x4 (&acc)[2][2][4][2], const Unit& u, int wr, int wc, int fr, int fq) const {
        const int row0 = u.pm * BM + wr * 64 + fr; const int col0 = u.pn * BM + wc * 32 + 8 * fq;
#pragma unroll
        for (int ai = 0; ai < 2; ++ai)
#pragma unroll
            for (int m = 0; m < 4; ++m) { const size_t row = (size_t)(row0 + ai * HALF + m * 16); const bf16_t* gp = G + row * ldg + 2 * 2048 + col0; bf16_t* op = O + row * ldo + col0;
#pragma unroll
                for (int bj = 0; bj < 2; ++bj) { const u32x4 g = *(const u32x4*)(gp + bj * HALF);
                    const f32x4 g0 = (f32x4){bf_lo(g.x), bf_hi(g.x), bf_lo(g.y), bf_hi(g.y)}, g1 = (f32x4){bf_lo(g.z), bf_hi(g.z), bf_lo(g.w), bf_hi(g.w)};
                    store8_bf16(op + bj * HALF, acc[ai][bj][m][0] * g0, acc[ai][bj][m][1] * g1); }
                asm volatile("" ::: "memory"); }
    }
};

struct EpiResid {
    static constexpr bool PERM = false, AFTER_DRAIN = false; static constexpr int KSEG = 0;
    float* X; int ldc; const float* gv; int gstride; float alpha;
    __device__ __forceinline__ void kseg(f32x4 (&)[2][2][4][2], const Unit&, int, int, int, int, int) const {}
    __device__ __forceinline__ void operator()(const f32x4 (&acc)[2][2][4][2], const Unit& u, int wr, int wc, int fr, int fq) const {
        const int row0 = u.pm * BM + wr * 64 + fr, col0 = u.pn * BM + wc * 32 + 4 * fq; const int grp = u.pm < 64 ? (u.pm >> 4) : 4;
        f32x4 g[2][2];
#pragma unroll
        for (int bj = 0; bj < 2; ++bj)
#pragma unroll
            for (int n = 0; n < 2; ++n) g[bj][n] = *(const f32x4*)(gv + (size_t)grp * gstride + col0 + bj * HALF + n * 16);
#pragma unroll
        for (int ai = 0; ai < 2; ++ai)
#pragma unroll
            for (int m = 0; m < 4; ++m) { float* rowp = X + (size_t)(row0 + ai * HALF + m * 16) * ldc + col0;
#pragma unroll
                for (int bj = 0; bj < 2; ++bj)
#pragma unroll
                    for (int n = 0; n < 2; ++n) { const f32x4 xv = *(const f32x4*)(rowp + bj * HALF + n * 16); *(f32x4*)(rowp + bj * HALF + n * 16) = xv * alpha + g[bj][n] * acc[ai][bj][m][n]; }
                if (m & 1) asm volatile("" ::: "memory"); }
    }
};

struct EpiSwiglu {
    static constexpr bool PERM = true, AFTER_DRAIN = false; static constexpr int KSEG = 0;
    bf16_t* H; int ldc;
    __device__ __forceinline__ void kseg(f32x4 (&)[2][2][4][2], const Unit&, int, int, int, int, int) const {}
    __device__ __forceinline__ void operator()(const f32x4 (&acc)[2][2][4][2], const Unit& u, int wr, int wc, int fr, int fq) const {
        const int row0 = u.pm * BM + wr * 64 + fr, col0 = u.pn * HALF + wc * 32 + 8 * fq;
#pragma unroll
        for (int ai = 0; ai < 2; ++ai)
#pragma unroll
            for (int m = 0; m < 4; ++m) { bf16_t* rowp = H + (size_t)(row0 + ai * HALF + m * 16) * ldc + col0; f32x4 o[2];
#pragma unroll
                for (int n = 0; n < 2; ++n) { const f32x4 gt = acc[ai][0][m][n], up = acc[ai][1][m][n];
#pragma unroll
                    for (int i = 0; i < 4; ++i) o[n][i] = gt[i] * sigmoid_f(gt[i]) * up[i]; }
                store8_bf16(rowp, o[0], o[1]); }
    }
};
template <class Epi, class Sched, bool ALIGN_EPI = false, bool SP2 = false>
__device__ __forceinline__ void gemm_phase(PG8_LAS unsigned char* lds, const Gemm g, const Sched& S, const Epi& E) {
    int tid_ = threadIdx.x; asm volatile("" : "+v"(tid_));
    const int tid = tid_, wid = __builtin_amdgcn_readfirstlane(tid >> 6), lane = tid & 63, wr = wid >> 2, wc = wid & 3, fr = lane & 15, fq = lane >> 4;
    const int K = g.K, nt = K / BK;
    unsigned voffA[2], voffB[2];
#pragma unroll
    for (int i = 0; i < 2; ++i) { int R, C; stage_rc(tid * 16 + i * 8192, R, C); const int Rb = Epi::PERM ? ((R & ~31) + perm32(R & 31)) : R;
        voffA[i] = (unsigned)(R * K + C) * 2u; voffB[i] = (unsigned)(Rb * K + C) * 2u; }
    const size_t kstep = (size_t)(BK * 2);
    const size_t hstep = (size_t)HALF * K * 2;
    const size_t tstep = 2 * hstep;
    const unsigned ldsw = (unsigned)wid * 1024u;
    const int aoff = lds_byte(wr * 64 + fr, fq * 8), boff = lds_byte(wc * 32 + fr, fq * 8);
#define PG8_SA(b, h) (((b) * 2 + (h)) * HTB)
#define PG8_SB(b, h) ((4 + (b) * 2 + (h)) * HTB)
#define PG8_STAGE(bufoff, gbase, voff) do { _Pragma("unroll") for (int _i = 0; _i < 2; ++_i) \
        __builtin_amdgcn_global_load_lds((const unsigned*)((const char*)(gbase) + (voff)[_i]), (PG8_LAS unsigned*)(lds + (bufoff) + ldsw + _i * 8192), 16, 0, 0); } while (0)
#define PG8_LDA(dst, b, h) do { _Pragma("unroll") for (int m = 0; m < 4; ++m) _Pragma("unroll") for (int k = 0; k < 2; ++k) dst[m][k] = *(const PG8_LAS bf16x8*)(lds + PG8_SA(b, h) + aoff + m * 2048 + k * 1024); } while (0)
#define PG8_LDB(dst, b, h) do { _Pragma("unroll") for (int n = 0; n < 2; ++n) _Pragma("unroll") for (int k = 0; k < 2; ++k) dst[n][k] = *(const PG8_LAS bf16x8*)(lds + PG8_SB(b, h) + boff + n * 2048 + k * 1024); } while (0)
#define PG8_MMA(ai, bj, At, Bt) do { __builtin_amdgcn_s_setprio(1); _Pragma("unroll") for (int m = 0; m < 4; ++m) _Pragma("unroll") for (int n = 0; n < 2; ++n) _Pragma("unroll") for (int k = 0; k < 2; ++k) \
        acc[ai][bj][m][n] = __builtin_amdgcn_mfma_f32_16x16x32_bf16(Bt[n][k], At[m][k], acc[ai][bj][m][n], 0, 0, 0); __builtin_amdgcn_s_setprio(0); } while (0)
#define PG8_WAIT_V(n) asm volatile("s_waitcnt vmcnt(" #n ")" ::: "memory")
#define PG8_WAIT_L(n) asm volatile("s_waitcnt lgkmcnt(" #n ")" ::: "memory")
#define PG8_BAR __builtin_amdgcn_s_barrier()
#define PG8_SCHED __builtin_amdgcn_sched_barrier(0)
    Unit cur, nxt; int ui = 0;
    if (!S.next(0, cur)) return;
    f32x4 acc[2][2][4][2];
#pragma unroll
    for (int a = 0; a < 2; ++a)
#pragma unroll
        for (int b = 0; b < 2; ++b)
#pragma unroll
            for (int m = 0; m < 4; ++m)
#pragma unroll
                for (int n = 0; n < 2; ++n) acc[a][b][m][n] = (f32x4){0.f, 0.f, 0.f, 0.f};
    bf16x8 At[4][2], B0[2][2], B1[2][2];
    const char* cA = (const char*)g.A + (size_t)cur.pm * tstep; const char* cB = (const char*)g.Bt + (size_t)cur.pn * tstep;
    S.a_ready(cur);
    if constexpr (SP2) {
        PG8_STAGE(PG8_SB(0, 0), cB, voffB); PG8_STAGE(PG8_SB(0, 1), cB + hstep, voffB); PG8_STAGE(PG8_SA(0, 0), cA, voffA); PG8_STAGE(PG8_SA(0, 1), cA + hstep, voffA);
        if (wr == 1) PG8_BAR;
        PG8_WAIT_V(2); PG8_BAR;
        PG8_STAGE(PG8_SB(1, 0), cB + kstep, voffB); PG8_STAGE(PG8_SA(1, 0), cA + kstep, voffA); PG8_STAGE(PG8_SB(1, 1), cB + hstep + kstep, voffB);
        PG8_WAIT_V(6); PG8_BAR;
    } else {
        PG8_STAGE(PG8_SB(0, 0), cB, voffB); PG8_STAGE(PG8_SA(0, 0), cA, voffA); PG8_STAGE(PG8_SB(0, 1), cB + hstep, voffB); PG8_STAGE(PG8_SA(0, 1), cA + hstep, voffA);
        if (wr == 1) PG8_BAR;
        PG8_WAIT_V(4); PG8_BAR;
        PG8_STAGE(PG8_SB(1, 0), cB + kstep, voffB); PG8_STAGE(PG8_SA(1, 0), cA + kstep, voffA); PG8_STAGE(PG8_SB(1, 1), cB + hstep + kstep, voffB);
        PG8_WAIT_V(6); PG8_BAR;
    }
    for (;;) {
        const bool has_next = S.next(ui + 1, nxt);
        const char* nA = has_next ? (const char*)g.A + (size_t)nxt.pm * tstep : cA; const char* nB = has_next ? (const char*)g.Bt + (size_t)nxt.pn * tstep : cB;
        for (int t = 0; t < nt; t += 2) {
            const bool last = (t == nt - 2);
            if constexpr (Epi::KSEG > 0) { if (t > 0 && (t % Epi::KSEG) == 0) E.kseg(acc, cur, t / Epi::KSEG, wr, wc, fr, fq); }
            const char* a1 = cA + (size_t)(t + 1) * kstep;
            const char* a2 = last ? nA : cA + (size_t)(t + 2) * kstep; const char* b2 = last ? nB : cB + (size_t)(t + 2) * kstep;
            const char* a3 = a2 + kstep; const char* b3 = b2 + kstep;
            if (last && has_next) S.a_ready(nxt);
            if constexpr (SP2) {
            PG8_LDB(B0, 0, 0); PG8_LDB(B1, 0, 1); PG8_SCHED; PG8_LDA(At, 0, 0); PG8_STAGE(PG8_SA(1, 1), a1 + hstep, voffA);
            PG8_WAIT_V(8); PG8_WAIT_L(0); PG8_BAR; PG8_MMA(0, 0, At, B0); PG8_MMA(0, 1, At, B1); PG8_BAR; PG8_SCHED;
            PG8_LDA(At, 0, 1); PG8_STAGE(PG8_SB(0, 0), b2, voffB); PG8_STAGE(PG8_SB(0, 1), b2 + hstep, voffB); PG8_STAGE(PG8_SA(0, 0), a2, voffA);
            PG8_WAIT_V(8); PG8_WAIT_L(0); PG8_BAR; PG8_MMA(1, 0, At, B0); PG8_MMA(1, 1, At, B1); PG8_BAR; PG8_SCHED;
            PG8_LDB(B0, 1, 0); PG8_LDB(B1, 1, 1); PG8_SCHED; PG8_LDA(At, 1, 0); PG8_STAGE(PG8_SA(0, 1), a2 + hstep, voffA);
            PG8_WAIT_V(8); PG8_WAIT_L(0); PG8_BAR; PG8_MMA(0, 0, At, B0); PG8_MMA(0, 1, At, B1); PG8_BAR; PG8_SCHED;
            PG8_LDA(At, 1, 1); PG8_STAGE(PG8_SB(1, 0), b3, voffB); PG8_STAGE(PG8_SB(1, 1), b3 + hstep, voffB); PG8_STAGE(PG8_SA(1, 0), a3, voffA);
            PG8_WAIT_V(8); PG8_WAIT_L(0); PG8_BAR; PG8_MMA(1, 0, At, B0); PG8_MMA(1, 1, At, B1); PG8_BAR; PG8_SCHED;
            } else {
            PG8_LDB(B0, 0, 0); PG8_SCHED; PG8_LDA(At, 0, 0); PG8_STAGE(PG8_SA(1, 1), a1 + hstep, voffA);
            PG8_WAIT_L(8); PG8_BAR; PG8_WAIT_L(0); PG8_MMA(0, 0, At, B0); PG8_BAR; PG8_SCHED;
            PG8_LDB(B1, 0, 1); PG8_STAGE(PG8_SB(0, 0), b2, voffB);
            PG8_BAR; PG8_WAIT_L(0); PG8_MMA(0, 1, At, B1); PG8_BAR;
            PG8_LDA(At, 0, 1); PG8_STAGE(PG8_SA(0, 0), a2, voffA);
            PG8_BAR; PG8_WAIT_L(0); PG8_MMA(1, 0, At, B0); PG8_BAR; PG8_SCHED;
            PG8_STAGE(PG8_SB(0, 1), b2 + hstep, voffB);
            PG8_WAIT_V(6); PG8_BAR; PG8_MMA(1, 1, At, B1); PG8_BAR;
            PG8_LDB(B0, 1, 0); PG8_SCHED; PG8_LDA(At, 1, 0); PG8_STAGE(PG8_SA(0, 1), a2 + hstep, voffA);
            PG8_WAIT_L(8); PG8_BAR; PG8_WAIT_L(0); PG8_MMA(0, 0, At, B0); PG8_BAR; PG8_SCHED;
            PG8_LDB(B1, 1, 1); PG8_STAGE(PG8_SB(1, 0), b3, voffB);
            PG8_BAR; PG8_WAIT_L(0); PG8_MMA(0, 1, At, B1); PG8_BAR;
            PG8_LDA(At, 1, 1); PG8_STAGE(PG8_SA(1, 0), a3, voffA);
            PG8_BAR; PG8_WAIT_L(0); PG8_MMA(1, 0, At, B0); PG8_BAR; PG8_SCHED;
            PG8_STAGE(PG8_SB(1, 1), b3 + hstep, voffB);
            PG8_WAIT_V(6); PG8_BAR; PG8_MMA(1, 1, At, B1); PG8_BAR;
            }
        }
        if constexpr (ALIGN_EPI) { if (wr == 0) PG8_BAR; }
        if constexpr (!Epi::AFTER_DRAIN) { E(acc, cur, wr, wc, fr, fq); S.done(cur); }
        if (!has_next) break;
#pragma unroll
        for (int a = 0; a < 2; ++a)
#pragma unroll
            for (int b = 0; b < 2; ++b)
#pragma unroll
                for (int m = 0; m < 4; ++m)
#pragma unroll
                    for (int n = 0; n < 2; ++n) acc[a][b][m][n] = (f32x4){0.f, 0.f, 0.f, 0.f};
        cur = nxt; cA = nA; cB = nB; ++ui;
        if constexpr (ALIGN_EPI) { if (wr == 1) PG8_BAR; }
    }
    PG8_WAIT_V(0);
    if constexpr (!ALIGN_EPI) { if (wr == 0) PG8_BAR; }
    PG8_BAR;
    if constexpr (Epi::AFTER_DRAIN) { E.fused(acc, cur, wr, wc, fr, fq, lds, wid, lane); S.done(cur); }
#undef PG8_SA
#undef PG8_SB
#undef PG8_STAGE
#undef PG8_LDA
#undef PG8_LDB
#undef PG8_MMA
#undef PG8_WAIT_V
#undef PG8_WAIT_L
#undef PG8_BAR
#undef PG8_SCHED
}
}

constexpr int NWAVES = 8;
constexpr int D = 2048, NBATCH = 4, SEQ = 4096, DEPTH = 4, CTXL = 256;
constexpr int MLAT = NBATCH * SEQ, MCTX = NBATCH * CTXL, MTOT = MLAT + MCTX;
constexpr int INW = 12288, BW = 1024, FFH = 5632, NHEAD = 8;
constexpr int Q_OFF = 0, K_OFF = 1024, V_OFF = 2048, BU_OFF = 3072, C_OFF = 5120, G_OFF = 6144;
constexpr int YW = 3 * BW;
constexpr float LN_EPS = 1e-6f;
constexpr float ALPHA = 1.681792830507429f;
constexpr float QSCALE = 0.125f * 1.4426950408889634f;

constexpr size_t MiB = 1u << 20;
constexpr size_t WS_CTL = 0, CTL_ZERO_BYTES = 1 * MiB;
constexpr size_t WS_ROPE = 1 * MiB;
constexpr size_t WS_MODS = 2 * MiB;
constexpr size_t WS_MODP = 4 * MiB;
constexpr size_t WS_WSP = 20 * MiB;
constexpr size_t WS_WPOOL = 21 * MiB;
constexpr size_t WS_WIN = 24 * MiB;
constexpr size_t WS_WBR = 216 * MiB;
constexpr size_t WS_WOUT = 264 * MiB;
constexpr size_t WS_WGU = 296 * MiB;
constexpr size_t WS_WDN = 472 * MiB;
constexpr size_t WS_X = 560 * MiB;
constexpr size_t WS_HA = 696 * MiB;
constexpr size_t WS_Y = 764 * MiB;
constexpr size_t WS_MG = 866 * MiB;
constexpr size_t WS_Z = 934 * MiB;
constexpr size_t WS_END = 1342 * MiB;
static_assert(WS_MODP + 16ull * 4 * 5 * 12288 * 4 <= WS_WSP && WS_WIN + 4ull * 12288 * 2048 * 2 <= WS_WBR && WS_WBR + 4ull * 2048 * 3072 * 2 <= WS_WOUT && WS_WOUT + 4ull * 2048 * 2048 * 2 <= WS_WGU, "ws map 1");
static_assert(WS_WGU + 4ull * 11264 * 2048 * 2 <= WS_WDN && WS_WDN + 4ull * 2048 * 5632 * 2 <= WS_X && WS_X + (size_t)MTOT * D * 4 <= WS_HA && WS_HA + (size_t)MTOT * D * 2 <= WS_Y, "ws map 2");
static_assert(WS_Y + (size_t)MTOT * YW * 2 <= WS_MG && WS_MG + (size_t)MTOT * D * 2 <= WS_Z && WS_Z + (size_t)MTOT * INW * 2 <= WS_END, "ws map 3");
constexpr int CW_BAR = 4096;

constexpr int RING_OFF = 0, RING_BYTES = 131072;
constexpr int LDSCTL_OFF = RING_BYTES, MISC_OFF = LDSCTL_OFF + 320;
constexpr int LDS_BYTES = 147456;

#define GAS __attribute__((address_space(1)))
#define LAS __attribute__((address_space(3)))
typedef unsigned short bf16;
typedef unsigned v4u __attribute__((ext_vector_type(4)));
typedef unsigned v2u __attribute__((ext_vector_type(2)));
typedef float f32x4 __attribute__((ext_vector_type(4)));
typedef float f32x16 __attribute__((ext_vector_type(16)));
typedef short bf16x8 __attribute__((ext_vector_type(8)));
typedef short s16x4 __attribute__((ext_vector_type(4)));
typedef GAS unsigned gu32;
#define RLX_AGENT __ATOMIC_RELAXED, __HIP_MEMORY_SCOPE_AGENT
#define LDS_WAIT() asm volatile("s_waitcnt lgkmcnt(0)" ::: "memory")
#define VM_WAIT() asm volatile("s_waitcnt vmcnt(0)" ::: "memory")
__device__ __forceinline__ unsigned f2bf(float f) { unsigned u = __builtin_bit_cast(unsigned, f); return (u + 0x7fffu + ((u >> 16) & 1u)) >> 16; }
__device__ __forceinline__ unsigned pk2(float lo, float hi) { return f2bf(lo) | (f2bf(hi) << 16); }
__device__ __forceinline__ unsigned cvtpk(float lo, float hi) { unsigned r; asm volatile("v_cvt_pk_bf16_f32 %0, %1, %2" : "=v"(r) : "v"(lo), "v"(hi)); return r; }
__device__ __forceinline__ float bflo(unsigned w) { return __uint_as_float(w << 16); }
__device__ __forceinline__ float bfhi(unsigned w) { return __uint_as_float(w & 0xffff0000u); }

#define XB_TMO      128
#define XB_XCNT(j)  (256  + 64 * (j))
#define XB_XSUB(j)  (1280 + 64 * (j))
#define XB_XGEN(j)  (2304 + 64 * (j))
#define XB_TOP      3328
#define XB_TOPGEN   3392
#define XCD_BAR_WORDS 3456
#define XB_SPIN_CAP (1u << 18)

__device__ __forceinline__ unsigned xb_ld(unsigned* p)              { return __hip_atomic_load(p, __ATOMIC_RELAXED, __HIP_MEMORY_SCOPE_AGENT); }
__device__ __forceinline__ unsigned xb_add(unsigned* p, unsigned v) { return __hip_atomic_fetch_add(p, v, __ATOMIC_RELAXED, __HIP_MEMORY_SCOPE_AGENT); }
__device__ __forceinline__ unsigned xb_xcc_id() { return (unsigned)__builtin_amdgcn_s_getreg((3 << 11) | 20) & 0xFu; }
#define XB_SPIN(cond, bar) do { unsigned _sp = 0; while (cond) { __builtin_amdgcn_s_sleep(1); \
    if ((++_sp & 255u) == 0u) { if (xb_ld(&(bar)[XB_TMO])) break; if (_sp > XB_SPIN_CAP) { atomicAdd(&(bar)[XB_TMO], 1u); break; } } } } while (0)

struct XcdBarrier {
    unsigned* bar; unsigned x;
    volatile LAS unsigned* st;
};

__device__ __forceinline__ XcdBarrier xcd_barrier_post(unsigned* bar, volatile LAS unsigned* st) {
    XcdBarrier b; b.bar = bar; b.x = xb_xcc_id(); b.st = st;
    if (threadIdx.x == 0) (void)xb_add(&bar[XB_XCNT(b.x)], 1u);
    return b;
}
__device__ __forceinline__ void xcd_barrier_complete(unsigned* bar, unsigned x, unsigned& nloc, unsigned& nx) {
    const unsigned G = gridDim.x * gridDim.y * gridDim.z;
    unsigned sum, cnt, mine, sp = 0u;
    for (;;) {
        sum = 0u; cnt = 0u; mine = 0u;
#pragma unroll
        for (unsigned j = 0; j < 16; ++j) { const unsigned c = xb_ld(&bar[XB_XCNT(j)]); sum += c; cnt += (c > 0u) ? 1u : 0u; mine = (j == x) ? c : mine; }
        if (sum == G) break;
        __builtin_amdgcn_s_sleep(1);
        if ((++sp & 255u) == 0u) { if (xb_ld(&bar[XB_TMO])) break; if (sp > XB_SPIN_CAP) { atomicAdd(&bar[XB_TMO], 1u); break; } }
    }
    nloc = mine > 0u ? mine : 1u; nx = cnt > 0u ? cnt : 1u;
}

__device__ __forceinline__ void xcd_barrier(const XcdBarrier& b) {
    asm volatile("s_waitcnt vmcnt(0)" ::: "memory");
    __syncthreads();
    if (threadIdx.x == 0) {
        unsigned* bar = b.bar;
        __builtin_amdgcn_s_waitcnt(0);
        unsigned nloc = b.st[0], nx = b.st[1];
        if (nloc == 0u) { xcd_barrier_complete(bar, b.x, nloc, nx); b.st[0] = nloc; b.st[1] = nx; }
        const unsigned old = xb_add(&bar[XB_XSUB(b.x)], 1u);
        const unsigned gen = old / nloc;
        if (old + 1u == (gen + 1u) * nloc) {
            __builtin_amdgcn_fence(__ATOMIC_RELEASE, "agent");
            asm volatile("s_waitcnt vmcnt(0)" ::: "memory");
            const unsigned og = xb_add(&bar[XB_TOP], 1u);
            const unsigned tg = og / nx;
            if (og + 1u == (tg + 1u) * nx) xb_add(&bar[XB_TOPGEN], 1u);
            else XB_SPIN(xb_ld(&bar[XB_TOPGEN]) == tg, bar);
            __builtin_amdgcn_fence(__ATOMIC_ACQUIRE, "agent");
            xb_add(&bar[XB_XGEN(b.x)], 1u);
            asm volatile("s_waitcnt vmcnt(0)" ::: "memory");
        } else {
            XB_SPIN(xb_ld(&bar[XB_XGEN(b.x)]) == gen, bar);
            __builtin_amdgcn_fence(__ATOMIC_ACQUIRE, "agent");
            asm volatile("s_waitcnt vmcnt(0)" ::: "memory");
        }
    }
    __syncthreads();
}


struct Frame {
    LAS unsigned char* lds;
    volatile LAS unsigned* MISC;
    gu32* ctl;
    int tid, lane, wave, vcu, G;
    const float *x, *c, *ctx, *cctx, *w_ada, *b_ada, *w_in, *lam_qk, *subln_g, *gln_g, *gln_b, *w_sp, *b_sp, *w_pool, *pool_scale, *w_branch, *w_out, *ln1_g, *ln1_b, *w_gu, *w_down, *ln2_g, *ln2_b;
    float* out;
    float *rope, *mods, *modp, *X;
    bf16 *Wsp, *Wpool, *Win, *Wbr, *Wout, *Wgu, *Wdn, *HA, *Y, *MG, *Z;
};

__device__ __forceinline__ float wave_sum(float v) {
#pragma unroll
    for (int o = 1; o < 64; o <<= 1) v += __shfl_xor(v, o);
    return v;
}

__device__ __forceinline__ void cvt_item(const float* W, int N, int k0, int ncol0, bool perm, bf16* WT, size_t drow0, int ldk, int dk0, LAS float* scr, int lane) {
#pragma unroll 8
    for (int i = 0; i < 32; ++i) { const int kk = 2 * i + (lane >> 5); scr[kk * 33 + (lane & 31)] = W[(size_t)(k0 + kk) * N + ncol0 + (lane & 31)]; }
    LDS_WAIT(); asm volatile("" ::: "memory");
    const int c = lane & 7;
#pragma unroll
    for (int j = 0; j < 4; ++j) { const int n = (lane >> 3) + 8 * j; const int ns = perm ? ((n & 1) * 16 + (n >> 1)) : n; const LAS float* s = scr + (8 * c) * 33 + ns;
        v4u o; o.x = pk2(s[0 * 33], s[1 * 33]); o.y = pk2(s[2 * 33], s[3 * 33]); o.z = pk2(s[4 * 33], s[5 * 33]); o.w = pk2(s[6 * 33], s[7 * 33]);
        *(GAS v4u*)(WT + (drow0 + n) * (size_t)ldk + dk0 + k0 + 8 * c) = o; }
    LDS_WAIT(); asm volatile("" ::: "memory");
}
constexpr int CV_IN = 32 * 384, CV_GU = 32 * 352, CV_DN = 88 * 64, CV_BR = 3 * 16 * 64, CV_OUT = 32 * 64, CV_POOL = 4 * 4 * 8, CV_LAYER = CV_IN + CV_GU + CV_DN + CV_BR + CV_OUT + CV_POOL;
__device__ __forceinline__ void cvt_dispatch(Frame& F, int it, LAS float* scr) {
    const int l = it / CV_LAYER; int r = it - l * CV_LAYER;
    if (r < CV_IN) { const int kb = r / 384, nb = r - kb * 384;
        cvt_item(F.w_in + (size_t)l * D * INW, INW, 64 * kb, 32 * nb, nb < 64, F.Win + (size_t)l * INW * D, (size_t)32 * nb, D, 0, scr, F.lane); return; }
    r -= CV_IN;
    if (r < CV_GU) { const int kb = r / 352, nb = r - kb * 352; const int tpn = nb >> 3, half = (nb >> 2) & 1, jj0 = (nb & 3) * 32;
        cvt_item(F.w_gu + (size_t)l * D * 2 * FFH, 2 * FFH, 64 * kb, half * FFH + 128 * tpn + jj0, false, F.Wgu + (size_t)l * 2 * FFH * D, (size_t)32 * nb, D, 0, scr, F.lane); return; }
    r -= CV_GU;
    if (r < CV_DN) { const int kb = r >> 6, nb = r & 63;
        cvt_item(F.w_down + (size_t)l * FFH * D, D, 64 * kb, 32 * nb, false, F.Wdn + (size_t)l * D * FFH, (size_t)32 * nb, FFH, 0, scr, F.lane); return; }
    r -= CV_DN;
    if (r < CV_BR) { const int n = r >> 10, rr = r & 1023, kb = rr >> 6, nb = rr & 63;
        cvt_item(F.w_branch + ((size_t)l * 3 + n) * BW * D, D, 64 * kb, 32 * nb, false, F.Wbr + (size_t)l * D * YW, (size_t)32 * nb, YW, BW * n, scr, F.lane); return; }
    r -= CV_BR;
    if (r < CV_OUT) { const int kb = r >> 6, nb = r & 63;
        cvt_item(F.w_out + (size_t)l * D * D, D, 64 * kb, 32 * nb, false, F.Wout + (size_t)l * D * D, (size_t)32 * nb, D, 0, scr, F.lane); return; }
    r -= CV_OUT;
    { const int g = r >> 5, rr = r & 31, kb = rr >> 3, nb = rr & 7;
        cvt_item(F.w_pool + ((size_t)l * 4 + g) * 65536, 256, 64 * kb, 32 * nb, false, F.Wpool + ((size_t)l * 4 + g) * 65536, (size_t)32 * nb, 256, 0, scr, F.lane); }
}

__device__ __forceinline__ double rope_inv(int p) {
    const double t[16] = {1.0, 0.5623413251903491, 0.31622776601683794, 0.1778279410038923, 0.1, 0.05623413251903491, 0.03162277660168379, 0.01778279410038923,
                          0.01, 0.005623413251903491, 0.003162277660168379, 0.001778279410038923, 0.001, 0.0005623413251903491, 0.00031622776601683794, 0.0001778279410038923};
    double r = t[0];
#pragma unroll
    for (int i = 1; i < 16; ++i) r = (p == i) ? t[i] : r;
    return r;
}
__device__ __forceinline__ void phase_a1(Frame& F) {
    const int gw = F.vcu * NWAVES + F.wave, NGW = F.G * NWAVES;
    LAS float* scs = (LAS float*)(F.lds);
    for (int i = F.tid; i < 5 * D; i += NWAVES * 64) { const int g = i >> 11, k = i & 2047; const float v = g < 4 ? F.c[g * D + k] : F.cctx[k]; scs[i] = v / (1.0f + __expf(-v)); }
    __syncthreads();
    for (int it = gw; it < 4 * 16 * 48; it += NGW) {
        const int l = it / 768, rem = it - l * 768, ks = rem / 48, cgw = rem - ks * 48; const int col = cgw * 256 + F.lane * 4;
        const float* wp = F.w_ada + ((size_t)l * D + ks * 128) * INW + col;
        f32x4 a0 = {0.f, 0.f, 0.f, 0.f}, a1 = a0, a2 = a0, a3 = a0, a4 = a0;
#pragma unroll 8
        for (int k = 0; k < 128; ++k) { const f32x4 w = *(const GAS f32x4*)(wp + (size_t)k * INW); const int kk = ks * 128 + k;
            a0 += w * scs[kk]; a1 += w * scs[D + kk]; a2 += w * scs[2 * D + kk]; a3 += w * scs[3 * D + kk]; a4 += w * scs[4 * D + kk]; }
        float* pp = F.modp + (((size_t)ks * 4 + l) * 5) * INW + col;
        *(f32x4*)(pp) = a0; *(f32x4*)(pp + INW) = a1; *(f32x4*)(pp + 2 * INW) = a2; *(f32x4*)(pp + 3 * INW) = a3; *(f32x4*)(pp + 4 * INW) = a4;
    }
    __syncthreads();
    LAS float* scr = (LAS float*)(F.lds + F.wave * 16384);
    for (int it = gw; it < DEPTH * CV_LAYER; it += NGW) cvt_dispatch(F, it, scr);
    for (int it = gw; it < (DEPTH * 8 * 128 * 128) / 512; it += NGW) { const size_t e = (size_t)it * 512 + F.lane * 8;
        const f32x4 a = *(const f32x4*)(F.w_sp + e), b = *(const f32x4*)(F.w_sp + e + 4);
        v4u o; o.x = pk2(a[0], a[1]); o.y = pk2(a[2], a[3]); o.z = pk2(b[0], b[1]); o.w = pk2(b[2], b[3]); *(v4u*)(F.Wsp + e) = o; }
    if (gw == 0) {
        for (int e = F.lane; e < 1024; e += 64) { const int pos = e >> 4, pr = e & 15;
            const double ang = (double)pos * rope_inv(pr); const double twopi = 6.283185307179586476925286766559;
            const double kq = __builtin_rint(ang / twopi); const double rr = ang - kq * twopi; const double r2 = rr * rr;
            double sn = 1.0, cs = 1.0;
#pragma unroll
            for (int n = 14; n >= 1; --n) { sn = 1.0 - sn * r2 / (double)((2 * n) * (2 * n + 1)); cs = 1.0 - cs * r2 / (double)((2 * n - 1) * (2 * n)); }
            sn *= rr;
            F.rope[2 * e] = (float)cs; F.rope[2 * e + 1] = (float)sn; }
    }
}
__device__ __forceinline__ void phase_a2(Frame& F) {
    const int gt = F.vcu * NWAVES * 64 + F.tid, NGT = F.G * NWAVES * 64;
    for (int i = gt; i < DEPTH * 5 * (INW / 4); i += NGT) { const int l = i / (5 * (INW / 4)), rem = i - l * (5 * (INW / 4)), g = rem / (INW / 4), j = (rem - g * (INW / 4)) * 4;
        f32x4 s = *(const f32x4*)(F.b_ada + (size_t)l * INW + j);
#pragma unroll
        for (int ks = 0; ks < 16; ++ks) s += *(const f32x4*)(F.modp + (((size_t)ks * 4 + l) * 5 + g) * INW + j);
        *(f32x4*)(F.mods + ((size_t)l * 5 + g) * INW + j) = s; }
}
__device__ __forceinline__ void ln_row(const float* src, const float* gam, const float* bet, float* xo, bf16* ho, const float* sc, const float* sh, int lane) {
    f32x4 v[8]; float s = 0.f;
#pragma unroll
    for (int j = 0; j < 8; ++j) { v[j] = *(const GAS f32x4*)(src + 4 * lane + 256 * j); s += (v[j][0] + v[j][1]) + (v[j][2] + v[j][3]); }
    const float mean = wave_sum(s) * (1.f / D); float s2 = 0.f;
#pragma unroll
    for (int j = 0; j < 8; ++j) { v[j] = v[j] - mean; s2 += (v[j][0] * v[j][0] + v[j][1] * v[j][1]) + (v[j][2] * v[j][2] + v[j][3] * v[j][3]); }
    const float rstd = 1.0f / sqrtf(wave_sum(s2) * (1.f / D) + LN_EPS);
#pragma unroll
    for (int j = 0; j < 8; ++j) { const int col = 4 * lane + 256 * j; f32x4 xn = v[j] * rstd;
        if (gam) xn = xn * *(const f32x4*)(gam + col) + *(const f32x4*)(bet + col);
        if (xo) *(GAS f32x4*)(xo + col) = xn;
        if (ho) { const f32x4 hv = xn * (1.0f + *(const f32x4*)(sc + col)) + *(const f32x4*)(sh + col); v2u o; o.x = pk2(hv[0], hv[1]); o.y = pk2(hv[2], hv[3]); *(GAS v2u*)(ho + col) = o; } }
}
__device__ __forceinline__ int row_group(int row) { return row < MLAT ? (row >> 12) : 4; }
__device__ __forceinline__ void phase_a3(Frame& F) {
    const int gw = F.vcu * NWAVES + F.wave, NGW = F.G * NWAVES;
    for (int row = gw; row < MTOT; row += NGW) { const float* src = row < MLAT ? F.x + (size_t)row * D : F.ctx + (size_t)(row - MLAT) * D; const float* md = F.mods + (size_t)row_group(row) * INW;
        ln_row(src, nullptr, nullptr, F.X + (size_t)row * D, F.HA + (size_t)row * D, md + D, md, F.lane); }
}
__device__ __forceinline__ void phase_ln(Frame& F, const float* gam, const float* bet, int nrows, bool to_out, bool want_h, int lm, int moff) {
    const int gw = F.vcu * NWAVES + F.wave, NGW = F.G * NWAVES;
    for (int row = gw; row < nrows; row += NGW) { const float* md = F.mods + ((size_t)lm * 5 + row_group(row)) * INW + moff;
        ln_row(F.X + (size_t)row * D, gam, bet, to_out ? F.out + (size_t)row * D : F.X + (size_t)row * D, want_h ? F.HA + (size_t)row * D : nullptr, md + D, md, F.lane); }
}

constexpr int AT_KB = 0, AT_VB = 32768, AT_TILE = 16384, AT_QB = 65536;
__device__ __forceinline__ s16x4 vtr(const LAS unsigned char* p) { typedef short v4i16_t __attribute__((ext_vector_type(4))); return __builtin_bit_cast(s16x4, __builtin_amdgcn_ds_read_tr16_b64_v4i16((LAS v4i16_t*)p)); }
__device__ __forceinline__ float max3f(float a, float b, float c) { float r; asm("v_max3_f32 %0, %1, %2, %3" : "=v"(r) : "v"(a), "v"(b), "v"(c)); return r; }
__device__ __forceinline__ void glds16(const void* gsrc, unsigned lds_dst) { unsigned keep;
    asm volatile("s_mov_b32 %0, m0\n\ts_mov_b32 m0, %2\n\ts_nop 0\n\tglobal_load_lds_dwordx4 %1, off\n\ts_mov_b32 m0, %0" : "=&s"(keep) : "v"(gsrc), "s"(lds_dst) : "memory"); }
__device__ __forceinline__ void attn_unit(Frame& F, int b, int h, int qb, bool ctxq, float lam, float oscale, const float* subg) {
    int lane_ = F.lane; asm volatile("" : "+v"(lane_));
    const int lane = lane_, wid = F.wave, r32 = lane & 31, hi = lane >> 5;
    const bf16* Z = F.Z;
    const int qrow = (ctxq ? MLAT + b * CTXL : b * SEQ + qb * 256) + wid * 32 + r32;
    __syncthreads();
    LAS unsigned char* qlds = F.lds + AT_QB + wid * 8192 + lane * 16;
#pragma unroll
    for (int m = 0; m < 2; ++m)
#pragma unroll
        for (int d0 = 0; d0 < 4; ++d0) *(LAS bf16x8*)(qlds + (m * 4 + d0) * 1024) = *(const GAS bf16x8*)(Z + (size_t)qrow * INW + Q_OFF + h * 128 + m * 64 + d0 * 16 + hi * 8);
    const int NT = ctxq ? 4 : 68;
    const int ctxrow0 = MLAT + b * CTXL, latrow0 = b * SEQ - 256;
    const unsigned lds0 = (unsigned)(size_t)F.lds;
    const int prow = 8 * wid + (lane >> 4), ppos = lane & 15;
    const unsigned koff0 = (unsigned)(prow * INW + K_OFF + h * 128 + ((ppos ^ (prow & 15)) * 8)), koff1 = (unsigned)((prow + 4) * INW + K_OFF + h * 128 + ((ppos ^ ((prow + 4) & 15)) * 8));
    const unsigned voff0 = (unsigned)(prow * INW + V_OFF + h * 128 + ((ppos ^ (4 * (prow & 3))) * 8)), voff1 = voff0 + 4 * INW;
    const unsigned kdst = (unsigned)__builtin_amdgcn_readfirstlane((int)(lds0 + AT_KB + wid * 2048)), vdst = (unsigned)__builtin_amdgcn_readfirstlane((int)(lds0 + AT_VB + wid * 2048));
#define AT_DMA(t, bufo) do { const bf16* tb_ = Z + (size_t)((((t) < 4) ? ctxrow0 : latrow0) + 64 * (t)) * INW; \
        glds16(tb_ + koff0, kdst + (bufo)); glds16(tb_ + koff1, kdst + (bufo) + 1024); glds16(tb_ + voff0, vdst + (bufo)); glds16(tb_ + voff1, vdst + (bufo) + 1024); } while (0)
    f32x16 o[2][4];
#pragma unroll
    for (int m = 0; m < 2; ++m)
#pragma unroll
        for (int db = 0; db < 4; ++db)
#pragma unroll
            for (int r = 0; r < 16; ++r) o[m][db][r] = 0.f;
    float mref[2] = {0.f, 0.f}, lsum[2] = {0.f, 0.f};
    const unsigned kaddr0 = AT_KB + r32 * 256 + ((hi ^ (r32 & 15)) << 4);
    const int a4 = (lane & 15) >> 2, cc = 2 * ((lane >> 4) & 1) + ((lane & 3) >> 1);
    const unsigned vaddr0 = AT_VB + (4 * hi + a4) * 256 + ((4 * a4 + cc) << 4) + 8 * (lane & 1);
    AT_DMA(0, 0);
    for (int t = 0; t < NT; ++t) {
        const unsigned bo = (t & 1) ? AT_TILE : 0;
        if (t + 1 < NT) { AT_DMA(t + 1, bo ^ AT_TILE); asm volatile("s_waitcnt vmcnt(4)\n\ts_barrier" ::: "memory"); }
        else { asm volatile("s_waitcnt vmcnt(0)\n\ts_barrier" ::: "memory"); }
        bf16x8 pk[2][2][2];
        unsigned kb_ = kaddr0 + bo, vb_ = vaddr0 + bo; asm volatile("" : "+v"(kb_), "+v"(vb_));
#pragma unroll
        for (int m = 0; m < 2; ++m) {
            f32x16 p0, p1;
#pragma unroll
            for (int r = 0; r < 16; ++r) { p0[r] = -mref[m]; p1[r] = -mref[m]; }
#pragma unroll
            for (int d0 = 0; d0 < 4; ++d0) {
                const unsigned ka = kb_ ^ (unsigned)((8 * m + 2 * d0) << 4);
                const bf16x8 qv = *(const LAS bf16x8*)(qlds + (m * 4 + d0) * 1024);
                const bf16x8 kf0 = *(const LAS bf16x8*)(F.lds + ka), kf1 = *(const LAS bf16x8*)(F.lds + ka + 32 * 256);
                p0 = __builtin_amdgcn_mfma_f32_32x32x16_bf16(kf0, qv, p0, 0, 0, 0);
                p1 = __builtin_amdgcn_mfma_f32_32x32x16_bf16(kf1, qv, p1, 0, 0, 0);
            }
            float tmax = max3f(p0[0], p1[0], p0[1]);
#pragma unroll
            for (int r = 1; r < 15; ++r) tmax = max3f(tmax, p1[r], p0[r + 1]);
            tmax = max3f(tmax, p1[15], __shfl_xor(max3f(tmax, p1[15], p1[15]), 32));
            if (t == 0) {
                mref[m] = tmax;
#pragma unroll
                for (int r = 0; r < 16; ++r) { p0[r] -= tmax; p1[r] -= tmax; }
            } else if (__any(tmax > 8.0f)) {
                const float dl = __builtin_fmaxf(tmax, 0.f); mref[m] += dl; const float al = __builtin_amdgcn_exp2f(-dl); lsum[m] *= al;
#pragma unroll
                for (int r = 0; r < 16; ++r) { p0[r] -= dl; p1[r] -= dl; }
#pragma unroll
                for (int db = 0; db < 4; ++db)
#pragma unroll
                    for (int r = 0; r < 16; ++r) o[m][db][r] *= al;
            }
            float ls = 0.f;
#pragma unroll
            for (int r = 0; r < 16; ++r) { p0[r] = __builtin_amdgcn_exp2f(p0[r]); p1[r] = __builtin_amdgcn_exp2f(p1[r]); ls += p0[r] + p1[r]; }
            lsum[m] += ls;
#pragma unroll
            for (int s = 0; s < 2; ++s) {
                v4u w0, w1;
                w0.x = cvtpk(p0[8 * s + 0], p0[8 * s + 1]); w0.y = cvtpk(p0[8 * s + 2], p0[8 * s + 3]); w0.z = cvtpk(p0[8 * s + 4], p0[8 * s + 5]); w0.w = cvtpk(p0[8 * s + 6], p0[8 * s + 7]);
                w1.x = cvtpk(p1[8 * s + 0], p1[8 * s + 1]); w1.y = cvtpk(p1[8 * s + 2], p1[8 * s + 3]); w1.z = cvtpk(p1[8 * s + 4], p1[8 * s + 5]); w1.w = cvtpk(p1[8 * s + 6], p1[8 * s + 7]);
                pk[m][0][s] = __builtin_bit_cast(bf16x8, w0); pk[m][1][s] = __builtin_bit_cast(bf16x8, w1);
            }
            __builtin_amdgcn_sched_barrier(0);
        }
#pragma unroll
        for (int db = 0; db < 4; ++db) {
            const unsigned va = vb_ ^ (unsigned)(db << 6);
#pragma unroll
            for (int kh = 0; kh < 2; ++kh)
#pragma unroll
                for (int s = 0; s < 2; ++s) {
                    const s16x4 lo = vtr(F.lds + va + (32 * kh + 16 * s) * 256), hh = vtr(F.lds + va + (32 * kh + 16 * s + 8) * 256);
                    const bf16x8 vf = (bf16x8){lo[0], lo[1], lo[2], lo[3], hh[0], hh[1], hh[2], hh[3]};
                    o[0][db] = __builtin_amdgcn_mfma_f32_32x32x16_bf16(vf, pk[0][kh][s], o[0][db], 0, 0, 0);
                    o[1][db] = __builtin_amdgcn_mfma_f32_32x32x16_bf16(vf, pk[1][kh][s], o[1][db], 0, 0, 0);
                }
        }
        asm volatile("s_waitcnt lgkmcnt(0)\n\ts_barrier" ::: "memory");
    }
#undef AT_DMA
    const float l0 = lsum[0] + __shfl_xor(lsum[0], 32), l1 = lsum[1] + __shfl_xor(lsum[1], 32);
    const float i0 = 1.0f / l0, i1 = lam / l1; float ss = 0.f;
#pragma unroll
    for (int db = 0; db < 4; ++db)
#pragma unroll
        for (int r = 0; r < 16; ++r) { const float v = o[0][db][r] * i0 - o[1][db][r] * i1; o[0][db][r] = v; ss += v * v; }
    ss += __shfl_xor(ss, 32);
    const float rs = oscale / sqrtf(ss * (1.0f / 128.0f) + LN_EPS);
    bf16* yp = F.Y + (size_t)qrow * YW + h * 128 + 4 * hi;
#pragma unroll
    for (int db = 0; db < 4; ++db)
#pragma unroll
        for (int g4 = 0; g4 < 4; ++g4) { const int d = 32 * db + 8 * g4; const f32x4 gv = *(const f32x4*)(subg + d + 4 * hi);
            v2u w; w.x = cvtpk(o[0][db][4 * g4 + 0] * rs * gv[0], o[0][db][4 * g4 + 1] * rs * gv[1]); w.y = cvtpk(o[0][db][4 * g4 + 2] * rs * gv[2], o[0][db][4 * g4 + 3] * rs * gv[3]);
            *(GAS v2u*)(yp + d) = w; }
}

constexpr int GM_ST = 0, GM_VT = 1024, GM_VP = 272;
__device__ __forceinline__ void gmlp_unit(Frame& F, int row0, int l) {
    int tid_ = F.tid; asm volatile("" : "+v"(tid_)); const int tid = tid_, lane = tid & 63, wid = F.wave;
    typedef float f32x2v __attribute__((ext_vector_type(2)));
    LAS f32x2v* st = (LAS f32x2v*)(F.lds + GM_ST); LAS unsigned char* vt = F.lds + GM_VT;
    const bf16* Z = F.Z;
    __syncthreads();
    for (int i = 0; i < 16; ++i) { const int tok = wid * 16 + i; const bf16* vp = Z + (size_t)(row0 + tok) * INW + BU_OFF + BW + lane * 16;
        const v4u a = *(const GAS v4u*)(vp), b2 = *(const GAS v4u*)(vp + 8);
        float x[16] = {bflo(a.x), bfhi(a.x), bflo(a.y), bfhi(a.y), bflo(a.z), bfhi(a.z), bflo(a.w), bfhi(a.w), bflo(b2.x), bfhi(b2.x), bflo(b2.y), bfhi(b2.y), bflo(b2.z), bfhi(b2.z), bflo(b2.w), bfhi(b2.w)};
        float s = 0.f;
#pragma unroll
        for (int e = 0; e < 16; ++e) s += x[e];
        const float mean = wave_sum(s) * (1.0f / 1024.0f); float q = 0.f;
#pragma unroll
        for (int e = 0; e < 16; ++e) { const float dd = x[e] - mean; q += dd * dd; }
        const float rstd = 1.0f / sqrtf(wave_sum(q) * (1.0f / 1024.0f) + LN_EPS);
        if (lane == 0) st[tok] = (f32x2v){mean, rstd}; }
    __syncthreads();
    const float* lng = F.gln_g + (size_t)l * BW; const float* lnb = F.gln_b + (size_t)l * BW;
    for (int g = 0; g < 8; ++g) {
        { const int j = tid & 127, cc = tid >> 7; const f32x2v sj = st[j]; const bf16* vp = Z + (size_t)(row0 + j) * INW + BU_OFF + BW + g * 128 + cc * 32;
#pragma unroll
          for (int q4 = 0; q4 < 4; ++q4) { const v4u a = *(const GAS v4u*)(vp + q4 * 8); const int c0 = cc * 32 + q4 * 8;
              const f32x4 g0 = *(const f32x4*)(lng + g * 128 + c0), g1 = *(const f32x4*)(lng + g * 128 + c0 + 4), b0 = *(const f32x4*)(lnb + g * 128 + c0), b1 = *(const f32x4*)(lnb + g * 128 + c0 + 4);
              const float xv[8] = {bflo(a.x), bfhi(a.x), bflo(a.y), bfhi(a.y), bflo(a.z), bfhi(a.z), bflo(a.w), bfhi(a.w)};
#pragma unroll
              for (int e = 0; e < 8; ++e) { const float gg = e < 4 ? g0[e & 3] : g1[e & 3], bb = e < 4 ? b0[e & 3] : b1[e & 3]; const float y = (xv[e] - sj.x) * sj.y * gg + bb;
                  *(LAS bf16*)(vt + (c0 + e) * GM_VP + j * 2) = (bf16)f2bf(y); } } }
        __syncthreads();
        { const int fr = lane & 15, fq = lane >> 4;
          bf16x8 af[4];
#pragma unroll
          for (int ks = 0; ks < 4; ++ks) af[ks] = *(const LAS bf16x8*)(vt + (wid * 16 + fr) * GM_VP + (ks * 32 + fq * 8) * 2);
          const bf16* wg = F.Wsp + ((size_t)l * 8 + g) * 16384;
          const float* bs = F.b_sp + ((size_t)l * 8 + g) * 128;
#pragma unroll 2
          for (int it = 0; it < 8; ++it) { f32x4 acc = {0.f, 0.f, 0.f, 0.f};
#pragma unroll
              for (int ks = 0; ks < 4; ++ks) { const bf16x8 bfr = *(const GAS bf16x8*)(wg + (size_t)(it * 16 + fr) * 128 + ks * 32 + fq * 8); acc = __builtin_amdgcn_mfma_f32_16x16x32_bf16(af[ks], bfr, acc, 0, 0, 0); }
              const int tok = it * 16 + fr; const int ch = g * 128 + wid * 16 + 4 * fq; const float bias = bs[tok];
              const v2u uu = *(const GAS v2u*)(Z + (size_t)(row0 + tok) * INW + BU_OFF + ch);
              v2u w; w.x = cvtpk(bflo(uu.x) * (acc[0] + bias), bfhi(uu.x) * (acc[1] + bias)); w.y = cvtpk(bflo(uu.y) * (acc[2] + bias), bfhi(uu.y) * (acc[3] + bias));
              *(GAS v2u*)(F.Y + (size_t)(row0 + tok) * YW + BW + ch) = w; } }
        __syncthreads();
    }
}

constexpr int PL_DP = 528;
__device__ __forceinline__ void pool_unit(Frame& F, int row0, int g, int l) {
    int tid_ = F.tid; asm volatile("" : "+v"(tid_)); const int tid = tid_, lane = tid & 63, wid = F.wave;
    LAS unsigned char* dt = F.lds;
    const bf16* Z = F.Z;
    const int seqlen = row0 < MLAT ? SEQ : CTXL; const int s0 = row0 < MLAT ? (row0 & ~(SEQ - 1)) : MLAT + ((row0 - MLAT) & ~(CTXL - 1));
    const int w = 2 << g, hw = w >> 1;
    __syncthreads();
    { const int ch = tid & 31, tg = tid >> 5;
      const bf16* zc = Z + C_OFF + g * 256 + ch * 8;
      for (int i = 0; i < 8; ++i) { const int tl = tg * 8 + i; const int p = row0 - s0 + tl; const int lo = p - hw < 0 ? 0 : p - hw; const int hi = p - hw + w > seqlen ? seqlen : p - hw + w;
          float sum[8] = {0.f, 0.f, 0.f, 0.f, 0.f, 0.f, 0.f, 0.f};
          for (int q = lo; q < hi; ++q) { const v4u a = *(const GAS v4u*)(zc + (size_t)(s0 + q) * INW);
              sum[0] += bflo(a.x); sum[1] += bfhi(a.x); sum[2] += bflo(a.y); sum[3] += bfhi(a.y); sum[4] += bflo(a.z); sum[5] += bfhi(a.z); sum[6] += bflo(a.w); sum[7] += bfhi(a.w); }
          const v4u zz = *(const GAS v4u*)(zc + (size_t)(s0 + p) * INW); const float inv = 1.0f / (float)(hi - lo);
          v4u o; o.x = pk2(sum[0] * inv - bflo(zz.x), sum[1] * inv - bfhi(zz.x)); o.y = pk2(sum[2] * inv - bflo(zz.y), sum[3] * inv - bfhi(zz.y));
          o.z = pk2(sum[4] * inv - bflo(zz.z), sum[5] * inv - bfhi(zz.z)); o.w = pk2(sum[6] * inv - bflo(zz.w), sum[7] * inv - bfhi(zz.w));
          *(LAS v4u*)(dt + tl * PL_DP + ch * 16) = o; } }
    __syncthreads();
    { const int fr = lane & 15, fq = lane >> 4;
      f32x4 acc[2][8];
#pragma unroll
      for (int a = 0; a < 2; ++a)
#pragma unroll
          for (int tt = 0; tt < 8; ++tt) acc[a][tt] = (f32x4){0.f, 0.f, 0.f, 0.f};
      const bf16* wp = F.Wpool + ((size_t)l * 4 + g) * 65536 + (size_t)(wid * 32 + fr) * 256 + fq * 8;
#pragma unroll 2
      for (int ks = 0; ks < 8; ++ks) { const bf16x8 a0 = *(const GAS bf16x8*)(wp + ks * 32), a1 = *(const GAS bf16x8*)(wp + 16 * 256 + ks * 32);
#pragma unroll
          for (int tt = 0; tt < 8; ++tt) { const bf16x8 bfr = *(const LAS bf16x8*)(dt + (tt * 16 + fr) * PL_DP + (ks * 32 + fq * 8) * 2);
              acc[0][tt] = __builtin_amdgcn_mfma_f32_16x16x32_bf16(a0, bfr, acc[0][tt], 0, 0, 0); acc[1][tt] = __builtin_amdgcn_mfma_f32_16x16x32_bf16(a1, bfr, acc[1][tt], 0, 0, 0); } }
      const float* ps = F.pool_scale + (size_t)l * BW + g * 256;
#pragma unroll
      for (int a = 0; a < 2; ++a) { const int dd = wid * 32 + a * 16 + 4 * fq; const f32x4 sc = *(const f32x4*)(ps + dd);
#pragma unroll
          for (int tt = 0; tt < 8; ++tt) { const f32x4 v = acc[a][tt] * sc; v2u wv; wv.x = cvtpk(v[0], v[1]); wv.y = cvtpk(v[2], v[3]);
              *(GAS v2u*)(F.Y + (size_t)(row0 + tt * 16 + fr) * YW + 2 * BW + g * 256 + dd) = wv; } } }
}

#ifndef MIXM
#define MIXM 7
#endif
__device__ __forceinline__ void phase_mixers(Frame& F, int l, float lam_init) {
    const bool last = (l == DEPTH - 1);
    float d01 = 0.f, d23 = 0.f; const float* lq = F.lam_qk + (size_t)l * 256;
    for (int i = 0; i < 64; ++i) { d01 += lq[i] * lq[64 + i]; d23 += lq[128 + i] * lq[192 + i]; }
    const float lam = __expf(d01) - __expf(d23) + lam_init; const float oscale = 1.0f - lam_init;
    const float* subg = F.subln_g + (size_t)l * 128;
#pragma nounroll
    for (int i = 0; i < 3; ++i) { const int uid = F.vcu + F.G * i;
        if (!(MIXM & 1)) continue;
        if (uid < 512) attn_unit(F, uid >> 7, (uid >> 4) & 7, uid & 15, false, lam, oscale, subg);
        else if (!last && uid < 544) attn_unit(F, (uid - 512) >> 3, (uid - 512) & 7, 0, true, lam, oscale, subg); }
    const int nchunk = last ? MLAT / 128 : MTOT / 128;
    if (MIXM & 2) for (int cidx = F.G - 1 - F.vcu; cidx < nchunk; cidx += F.G) gmlp_unit(F, cidx * 128, l);
    if (MIXM & 4) for (int u = F.vcu; u < nchunk * 4; u += F.G) pool_unit(F, (u >> 2) * 128, u & 3, l);
    __syncthreads();
}

constexpr int NPHASE = 3 + 8 * DEPTH;
struct Args { const float* in[23]; float* out; unsigned char* ws; int ph_lo, ph_hi; float lam_init[4]; };
__global__ void __launch_bounds__(NWAVES * 64, 2) fwd(Args args) {
    extern __shared__ __attribute__((aligned(16))) unsigned char lds[];
    Frame F;
    F.lds = (LAS unsigned char*)lds;
    F.MISC = (volatile LAS unsigned*)(F.lds + MISC_OFF);
    F.tid = threadIdx.x; F.lane = F.tid & 63; F.wave = __builtin_amdgcn_readfirstlane(F.tid >> 6);
    F.G = gridDim.x; { const int bx = blockIdx.x; F.vcu = (F.G % 8 == 0) ? (bx % 8) * (F.G / 8) + bx / 8 : bx; }
    unsigned char* ws = args.ws;
    F.ctl = (gu32*)(ws + WS_CTL);
    F.x = args.in[0]; F.c = args.in[1]; F.ctx = args.in[2]; F.cctx = args.in[3]; F.w_ada = args.in[4]; F.b_ada = args.in[5]; F.w_in = args.in[6]; F.lam_qk = args.in[7]; F.subln_g = args.in[8];
    F.gln_g = args.in[9]; F.gln_b = args.in[10]; F.w_sp = args.in[11]; F.b_sp = args.in[12]; F.w_pool = args.in[13]; F.pool_scale = args.in[14]; F.w_branch = args.in[15]; F.w_out = args.in[16];
    F.ln1_g = args.in[17]; F.ln1_b = args.in[18]; F.w_gu = args.in[19]; F.w_down = args.in[20]; F.ln2_g = args.in[21]; F.ln2_b = args.in[22]; F.out = args.out;
    F.rope = (float*)(ws + WS_ROPE); F.mods = (float*)(ws + WS_MODS); F.modp = (float*)(ws + WS_MODP); F.X = (float*)(ws + WS_X);
    F.Wsp = (bf16*)(ws + WS_WSP); F.Wpool = (bf16*)(ws + WS_WPOOL); F.Win = (bf16*)(ws + WS_WIN); F.Wbr = (bf16*)(ws + WS_WBR); F.Wout = (bf16*)(ws + WS_WOUT); F.Wgu = (bf16*)(ws + WS_WGU); F.Wdn = (bf16*)(ws + WS_WDN);
    F.HA = (bf16*)(ws + WS_HA); F.Y = (bf16*)(ws + WS_Y); F.MG = (bf16*)(ws + WS_MG); F.Z = (bf16*)(ws + WS_Z);
    for (int u = F.tid; u < (LDS_BYTES - LDSCTL_OFF) / 4; u += NWAVES * 64) ((LAS unsigned*)(F.lds + LDSCTL_OFF))[u] = 0u;
    __syncthreads();
    const int lo = args.ph_lo, hi = args.ph_hi;
    const bool use_bar = (hi - lo) > 1;
    XcdBarrier bar; bar.bar = (unsigned*)(F.ctl + CW_BAR); bar.x = 0; bar.st = nullptr;
    if (use_bar) bar = xcd_barrier_post((unsigned*)(F.ctl + CW_BAR), F.MISC + 8);
#ifndef PHM
#define PHM 0xFFFF
#endif
#define IN(k) (lo <= (k) && (k) < hi)
#define KIND(b) ((PHM >> (b)) & 1)
#define SEAM(k) do { if (IN(k) && IN((k) + 1)) xcd_barrier(bar); } while (0)

    if (KIND(0) && IN(0)) { phase_a1(F); } SEAM(0);
    if (KIND(1) && IN(1)) { phase_a2(F); } SEAM(1);
    if (KIND(2) && IN(2)) { phase_a3(F); } SEAM(2);

#pragma nounroll
    for (int l = 0; l < DEPTH; ++l) {
        const int pb = 3 + 8 * l; const bool last = (l == DEPTH - 1);
        { int t_ = threadIdx.x; asm volatile("" : "+v"(t_)); F.tid = t_; F.lane = t_ & 63; F.wave = __builtin_amdgcn_readfirstlane(t_ >> 6); }
        const int Mrows = last ? MLAT : MTOT;
        const float* mods_l = F.mods + (size_t)l * 5 * INW;
        if (KIND(3) && IN(pb + 0)) {
            pg8::Gemm g{F.HA, F.Win + (size_t)l * INW * D, MTOT, INW, D}; pg8::StaticOrder S; S.init(MTOT, INW, F.G, (int)blockIdx.x);
            pg8::EpiInProj E{F.Z, F.rope, QSCALE, INW, MLAT};
            pg8::gemm_phase<pg8::EpiInProj, pg8::StaticOrder, true, true>(F.lds + RING_OFF, g, S, E);
        }
        SEAM(pb + 0);
        if (KIND(4) && IN(pb + 1)) { phase_mixers(F, l, args.lam_init[l]); }
        SEAM(pb + 1);
        if (KIND(5) && IN(pb + 2)) {
            pg8::Gemm g{F.Y, F.Wbr + (size_t)l * D * YW, Mrows, D, YW}; pg8::StaticOrder S; S.init(Mrows, D, F.G, (int)blockIdx.x);
            pg8::EpiGate E{F.Z + G_OFF, INW, F.MG, D};
            pg8::gemm_phase<pg8::EpiGate, pg8::StaticOrder, true, true>(F.lds + RING_OFF, g, S, E);
        }
        SEAM(pb + 2);
        if (KIND(6) && IN(pb + 3)) {
            pg8::Gemm g{F.MG, F.Wout + (size_t)l * D * D, Mrows, D, D}; pg8::StaticOrder S; S.init(Mrows, D, F.G, (int)blockIdx.x);
            pg8::EpiResid E{F.X, D, mods_l + 2 * D, INW, ALPHA};
            pg8::gemm_phase<pg8::EpiResid, pg8::StaticOrder, true, true>(F.lds + RING_OFF, g, S, E);
        }
        SEAM(pb + 3);
        if (KIND(7) && IN(pb + 4)) { phase_ln(F, F.ln1_g + (size_t)l * D, F.ln1_b + (size_t)l * D, Mrows, false, true, l, 3 * D); }
        SEAM(pb + 4);
        if (KIND(8) && IN(pb + 5)) {
            pg8::Gemm g{F.HA, F.Wgu + (size_t)l * 2 * FFH * D, Mrows, 2 * FFH, D}; pg8::StaticOrder S; S.init(Mrows, 2 * FFH, F.G, (int)blockIdx.x);
            pg8::EpiSwiglu E{F.Z, FFH};
            pg8::gemm_phase<pg8::EpiSwiglu, pg8::StaticOrder, true, true>(F.lds + RING_OFF, g, S, E);
        }
        SEAM(pb + 5);
        if (KIND(9) && IN(pb + 6)) {
            pg8::Gemm g{F.Z, F.Wdn + (size_t)l * D * FFH, Mrows, D, FFH}; pg8::StaticOrder S; S.init(Mrows, D, F.G, (int)blockIdx.x);
            pg8::EpiResid E{F.X, D, mods_l + 5 * D, INW, ALPHA};
            pg8::gemm_phase<pg8::EpiResid, pg8::StaticOrder, true, true>(F.lds + RING_OFF, g, S, E);
        }
        SEAM(pb + 6);
        if (KIND(7) && IN(pb + 7)) { phase_ln(F, F.ln2_g + (size_t)l * D, F.ln2_b + (size_t)l * D, Mrows, last, !last, last ? l : l + 1, 0); }
        if (!last) SEAM(pb + 7);
    }
#undef IN
#undef SEAM
}

#ifndef MK_ONE_LAUNCH
#define MK_ONE_LAUNCH 1
#endif
extern "C" void kernel_launch(void* const* d_in, const int* in_sizes, int n_in, void* d_out, int out_size, void* d_ws, size_t ws_size, hipStream_t stream) {
    static int grid = 0;
    if (grid == 0) {
        if (n_in != 23 || in_sizes[0] != MLAT * D || out_size != MLAT * D || ws_size < WS_END) {
            fprintf(stderr, "kernel_launch: unexpected shapes / workspace (n_in %d, in0 %d, out %d, ws %zu, need %zu); nothing launched\n", n_in, n_in > 0 ? in_sizes[0] : -1, out_size, ws_size, (size_t)WS_END); grid = -1; return; }
        int dev = 0, cus = 0, per_cu = 0;
        if (hipGetDevice(&dev) != hipSuccess || hipDeviceGetAttribute(&cus, hipDeviceAttributeMultiprocessorCount, dev) != hipSuccess) { grid = -1; return; }
        if (hipFuncSetAttribute((const void*)fwd, hipFuncAttributeMaxDynamicSharedMemorySize, LDS_BYTES) != hipSuccess) { fprintf(stderr, "kernel_launch: hipFuncSetAttribute failed\n"); grid = -1; return; }
        if (hipOccupancyMaxActiveBlocksPerMultiprocessor(&per_cu, (const void*)fwd, NWAVES * 64, LDS_BYTES) != hipSuccess || per_cu < 1) fprintf(stderr, "kernel_launch: occupancy query reports %d\n", per_cu);
        (void)hipGetLastError();
        grid = cus;
    }
    if (grid < 0) return;
    if (hipMemsetAsync((char*)d_ws + WS_CTL, 0, CTL_ZERO_BYTES, stream) != hipSuccess) return;
    Args a{};
    for (int i = 0; i < 23; ++i) a.in[i] = (const float*)d_in[i];
    a.out = (float*)d_out; a.ws = (unsigned char*)d_ws;
    for (int l = 0; l < DEPTH; ++l) a.lam_init[l] = (float)(0.8 - 0.6 * exp(-0.3 * (double)l));
#if MK_ONE_LAUNCH
    a.ph_lo = 0; a.ph_hi = NPHASE;
    hipLaunchKernelGGL(fwd, dim3(grid), dim3(NWAVES * 64), LDS_BYTES, stream, a);
#else
    for (int p = 0; p < NPHASE; ++p) { a.ph_lo = p; a.ph_hi = p + 1; hipLaunchKernelGGL(fwd, dim3(grid), dim3(NWAVES * 64), LDS_BYTES, stream, a); }
#endif
}
```

```cpp
#include <hip/hip_runtime.h>
#include <cstdio>
#include <cstdint>
#include <cmath>
namespace pg8 {
#define PG8_LAS __attribute__((address_space(3)))
typedef unsigned short bf16_t;
typedef short bf16x8 __attribute__((ext_vector_type(8)));
typedef float f32x4 __attribute__((ext_vector_type(4)));
typedef unsigned u32x4 __attribute__((ext_vector_type(4)));
constexpr int BM = 256, BK = 64, HALF = 128, HTB = HALF * BK * 2  , STAGE_BYTES = 8 * HTB, NXCD = 8, WGM = 8;

__host__ __device__ __forceinline__ int lds_byte(int r, int c) { const int st = (r >> 4) * 2 + (c >> 5), rr = r & 15, cc = c & 31, ob = rr * 64 + cc * 2; return st * 1024 + (ob ^ (((ob >> 9) & 1) << 5)); }
__host__ __device__ __forceinline__ void stage_rc(int b, int& R, int& C) { const int st = b / 1024, sb = b % 1024, swz = sb ^ (((sb >> 9) & 1) << 5); R = (st >> 1) * 16 + swz / 64; C = (st & 1) * 32 + (swz % 64) / 2; }
__host__ __device__ __forceinline__ int perm32(int rho) { const int n = rho >> 4, i = rho & 15; return 8 * (i >> 2) + 4 * n + (i & 3); }

struct Unit { int pm, pn, ka; };
struct Gemm { const bf16_t* A; const bf16_t* Bt; int M, N, K, lda, ldb; };

struct StaticOrder {
    int nM, nN, nwg, G, c;
    __host__ __device__ void init(int M, int N, int G_, int c_) { nM = M / BM; nN = N / BM; nwg = nM * nN; G = G_; c = c_; }
    __host__ __device__ bool next(int i, Unit& u) const {
        const long L = (long)i * G + c; if (L >= nwg) return false;
        int wgid = (int)L; { const int q = nwg / NXCD, r = nwg % NXCD, xcd = wgid % NXCD, off = wgid / NXCD; wgid = (xcd < r ? xcd * (q + 1) : r * (q + 1) + (xcd - r) * q) + off; }
        const int nig = WGM * nN, gid = wgid / nig, fm = gid * WGM, gsz = (nM - fm) < WGM ? (nM - fm) : WGM;
        u.pm = fm + ((wgid % nig) % gsz); u.pn = (wgid % nig) / gsz; u.ka = 0; return true;
    }
    __device__ __forceinline__ void a_ready(const Unit&) const {}
    __device__ __forceinline__ void done(const Unit&) const {}
};

struct SplitOrder {
    int nsplit, klen, G, c, pm0, ntile;
    __host__ __device__ void init(int pm0_, int ntile_, int nsplit_, int klen_, int G_, int c_) { pm0 = pm0_; ntile = ntile_; nsplit = nsplit_; klen = klen_; G = G_; c = c_; }
    __host__ __device__ bool next(int i, Unit& u) const { const int L = i * G + c; if (L >= ntile * nsplit) return false; const int tt = L / nsplit; u.pm = pm0 + (tt & 3); u.pn = tt >> 2; u.ka = (L - tt * nsplit) * klen; return true; }
    __device__ __forceinline__ void a_ready(const Unit&) const {}
    __device__ __forceinline__ void done(const Unit&) const {}
};
__device__ __forceinline__ unsigned cvt_pk_bf16(float lo, float hi) { unsigned r; asm volatile("v_cvt_pk_bf16_f32 %0, %1, %2" : "=v"(r) : "v"(lo), "v"(hi)); return r; }
typedef float f32x2 __attribute__((ext_vector_type(2)));
__device__ __forceinline__ f32x2 gelu_pk(f32x2 v) {
    const f32x2 av = __builtin_elementwise_abs(v), d = av * 0.2316418882f + 1.0f;
    f32x2 t; t.x = __builtin_amdgcn_rcpf(d.x); t.y = __builtin_amdgcn_rcpf(d.y);
    f32x2 q = t * 0.5307027145f + (-0.7265760135f); q = q * t + 0.7107068705f; q = q * t + (-0.142248368f); q = q * t + 0.127414796f; q = q * t;
    const f32x2 s = (v * v) * (-0.72134752044f);
    f32x2 e; e.x = __builtin_amdgcn_exp2f(s.x); e.y = __builtin_amdgcn_exp2f(s.y);
    const f32x2 m = v * (q * e), r = v - m;
    f32x2 o; o.x = v.x < 0.f ? m.x : r.x; o.y = v.y < 0.f ? m.y : r.y; return o;
}

typedef unsigned u32x2 __attribute__((ext_vector_type(2)));
__device__ __forceinline__ float bf_lo(unsigned w) { return __uint_as_float(w << 16); }
__device__ __forceinline__ float bf_hi(unsigned w) { return __uint_as_float(w & 0xffff0000u); }
__device__ __forceinline__ void store8_bf16(bf16_t* p, const f32x4 v0, const f32x4 v1) {
    u32x4 w; w.x = cvt_pk_bf16(v0[0], v0[1]); w.y = cvt_pk_bf16(v0[2], v0[3]); w.z = cvt_pk_bf16(v1[0], v1[1]); w.w = cvt_pk_bf16(v1[2], v1[3]); *(u32x4*)p = w;
}
__device__ __forceinline__ float sigmoid_f(float x) { return __builtin_amdgcn_rcpf(1.0f + __builtin_amdgcn_exp2f(x * -1.4426950408889634f)); }

struct EpiInProj {
    static constexpr bool PERM = true, AFTER_DRAIN = false; static constexpr int KSEG = 0;
    bf16_t* Z; const float* rope; float qscale; int ldc; int nlat; bf16_t* Kb; bf16_t* Vb;
    __device__ __forceinline__ void kseg(f32x4 (&)[2][2][4][2], const Unit&, int, int, int, int, int) const {}
    __device__ __forceinline__ void operator()(const f32x4 (&acc)[2][2][4][2], const Unit& u, int wr, int wc, int fr, int fq) const {
        const int pn = u.pn; const int row0 = u.pm * BM + wr * 64 + fr; const int col0 = pn * BM + wc * 32 + 8 * fq;
        if (pn < 8) {
            const float sc = pn < 4 ? qscale : 1.0f;
#pragma unroll
            for (int ai = 0; ai < 2; ++ai)
#pragma unroll
                for (int m = 0; m < 4; ++m) {
                    const int row = row0 + ai * HALF + m * 16; const int t = row & 4095; const int pos = (wc & 1) ? (t & 63) : (t >> 6);
                    f32x4 cs0 = *(const f32x4*)(rope + (pos * 16 + 4 * fq) * 2), cs1 = *(const f32x4*)(rope + (pos * 16 + 4 * fq) * 2 + 4);
                    if (row >= nlat) { cs0 = (f32x4){1.f, 0.f, 1.f, 0.f}; cs1 = cs0; }
                    bf16_t* rowp = Z + (size_t)row * ldc + col0;
                    if (pn >= 4) { const int bb = row < nlat ? (row >> 12) : ((row - nlat) >> 8), key = row < nlat ? 256 + (row & 4095) : ((row - nlat) & 255);
                        rowp = Kb + ((size_t)(bb * 8 + 2 * (pn - 4)) * 4352 + key) * 128 + wc * 32 + 8 * fq; }
#pragma unroll
                    for (int bj = 0; bj < 2; ++bj) {
                        const f32x4 a = acc[ai][bj][m][0], b = acc[ai][bj][m][1];
                        f32x4 o0, o1;
                        o0[0] = (a[0] * cs0[0] - a[1] * cs0[1]) * sc; o0[1] = (a[0] * cs0[1] + a[1] * cs0[0]) * sc;
                        o0[2] = (a[2] * cs0[2] - a[3] * cs0[3]) * sc; o0[3] = (a[2] * cs0[3] + a[3] * cs0[2]) * sc;
                        o1[0] = (b[0] * cs1[0] - b[1] * cs1[1]) * sc; o1[1] = (b[0] * cs1[1] + b[1] * cs1[0]) * sc;
                        o1[2] = (b[2] * cs1[2] - b[3] * cs1[3]) * sc; o1[3] = (b[2] * cs1[3] + b[3] * cs1[2]) * sc;
                        store8_bf16(rowp + (pn >= 4 ? (size_t)bj * 4352 * 128 : (size_t)bj * HALF), o0, o1);
                    }
                }
        } else if (pn < 12) {
#pragma unroll
            for (int ai = 0; ai < 2; ++ai)
#pragma unroll
                for (int m = 0; m < 4; ++m) { const int row = row0 + ai * HALF + m * 16; const int bb = row < nlat ? (row >> 12) : ((row - nlat) >> 8), key = row < nlat ? 256 + (row & 4095) : ((row - nlat) & 255);
                    bf16_t* rowp = Vb + ((size_t)(bb * 8 + 2 * (pn - 8)) * 4352 + key) * 128 + wc * 32 + 8 * fq;
#pragma unroll
                    for (int bj = 0; bj < 2; ++bj) store8_bf16(rowp + (size_t)bj * 4352 * 128, acc[ai][bj][m][0], acc[ai][bj][m][1]); }
        } else if (pn >= 20 && pn < 24) {
#pragma unroll
            for (int ai = 0; ai < 2; ++ai)
#pragma unroll
                for (int m = 0; m < 4; ++m) { bf16_t* rowp = Z + (size_t)(row0 + ai * HALF + m * 16) * ldc + col0;
#pragma unroll
                    for (int bj = 0; bj < 2; ++bj) store8_bf16(rowp + bj * HALF, acc[ai][bj][m][0], acc[ai][bj][m][1]); }
        } else if (pn < 20) {
#pragma unroll
            for (int ai = 0; ai < 2; ++ai)
#pragma unroll
                for (int m = 0; m < 4; ++m) { bf16_t* rowp = Z + (size_t)(row0 + ai * HALF + m * 16) * ldc + col0;
#pragma unroll
                    for (int bj = 0; bj < 2; ++bj) { const f32x4 v0 = acc[ai][bj][m][0], v1 = acc[ai][bj][m][1];
                        const f32x2 a = gelu_pk((f32x2){v0[0], v0[1]}), b = gelu_pk((f32x2){v0[2], v0[3]}), c = gelu_pk((f32x2){v1[0], v1[1]}), d = gelu_pk((f32x2){v1[2], v1[3]});
                        store8_bf16(rowp + bj * HALF, (f32x4){a.x, a.y, b.x, b.y}, (f32x4){c.x, c.y, d.x, d.y}); } }
        } else {
#pragma unroll
            for (int ai = 0; ai < 2; ++ai)
#pragma unroll
                for (int m = 0; m < 4; ++m) { bf16_t* rowp = Z + (size_t)(row0 + ai * HALF + m * 16) * ldc + col0;
#pragma unroll
                    for (int bj = 0; bj < 2; ++bj) { const f32x4 v0 = acc[ai][bj][m][0], v1 = acc[ai][bj][m][1]; f32x4 o0, o1;
#pragma unroll
                        for (int i = 0; i < 4; ++i) { o0[i] = __builtin_fmaxf(sigmoid_f(v0[i]), 1e-12f); o1[i] = __builtin_fmaxf(sigmoid_f(v1[i]), 1e-12f); }
                        store8_bf16(rowp + bj * HALF, o0, o1); } }
        }
    }
};

struct EpiGate {
    static constexpr bool PERM = true, AFTER_DRAIN = false; static constexpr int KSEG = 16;
    const bf16_t* G; int ldg; bf16_t* O; int ldo;
    __device__ __forceinline__ void kseg(f32x4 (&acc)[2][2][4][2], const Unit& u, int seg, int wr, int wc, int fr, int fq) const {
        const int row0 = u.pm * BM + wr * 64 + fr; const int col0 = u.pn * BM + wc * 32 + 8 * fq;
#pragma unroll
        for (int ai = 0; ai < 2; ++ai)
#pragma unroll
            for (int m = 0; m < 4; ++m) { const bf16_t* gp = G + (size_t)(row0 + ai * HALF + m * 16) * ldg + (seg - 1) * 2048 + col0;
#pragma unroll
                for (int bj = 0; bj < 2; ++bj) { const u32x4 ga = *(const u32x4*)(gp + bj * HALF), gb = *(const u32x4*)(gp + 2048 + bj * HALF);
                    f32x4 r0, r1;
                    r0[0] = bf_lo(ga.x) * __builtin_amdgcn_rcpf(bf_lo(gb.x)); r0[1] = bf_hi(ga.x) * __builtin_amdgcn_rcpf(bf_hi(gb.x));
                    r0[2] = bf_lo(ga.y) * __builtin_amdgcn_rcpf(bf_lo(gb.y)); r0[3] = bf_hi(ga.y) * __builtin_amdgcn_rcpf(bf_hi(gb.y));
                    r1[0] = bf_lo(ga.z) * __builtin_amdgcn_rcpf(bf_lo(gb.z)); r1[1] = bf_hi(ga.z) * __builtin_amdgcn_rcpf(bf_hi(gb.z));
                    r1[2] = bf_lo(ga.w) * __builtin_amdgcn_rcpf(bf_lo(gb.w)); r1[3] = bf_hi(ga.w) * __builtin_amdgcn_rcpf(bf_hi(gb.w));
                    acc[ai][bj][m][0] *= r0; acc[ai][bj][m][1] *= r1; }
                asm volatile("" ::: "memory"); }
    }
    __device__ __forceinline__ void operator()(const f32x4 (&acc)[2][2][4][2], const Unit& u, int wr, int wc, int fr, int fq) const {
        const int row0 = u.pm * BM + wr * 64 + fr; const int col0 = u.pn * BM + wc * 32 + 8 * fq;
#pragma unroll
        for (int ai = 0; ai < 2; ++ai)
#pragma unroll
            for (int m = 0; m < 4; ++m) { const size_t row = (size_t)(row0 + ai * HALF + m * 16); const bf16_t* gp = G + row * ldg + 2 * 2048 + col0; bf16_t* op = O + row * ldo + col0;
#pragma unroll
                for (int bj = 0; bj < 2; ++bj) { const u32x4 g = *(const u32x4*)(gp + bj * HALF);
                    const f32x4 g0 = (f32x4){bf_lo(g.x), bf_hi(g.x), bf_lo(g.y), bf_hi(g.y)}, g1 = (f32x4){bf_lo(g.z), bf_hi(g.z), bf_lo(g.w), bf_hi(g.w)};
                    store8_bf16(op + bj * HALF, acc[ai][bj][m][0] * g0, acc[ai][bj][m][1] * g1); }
                asm volatile("" ::: "memory"); }
    }
};

template <bool SLAB> struct EpiResidT {
    static constexpr bool PERM = !SLAB, AFTER_DRAIN = false; static constexpr int KSEG = 0;
    const float* gv; int gstride; void* Tw; int ldc; int klen, nlat;
    __device__ __forceinline__ void kseg(f32x4 (&)[2][2][4][2], const Unit&, int, int, int, int, int) const {}
    __device__ __forceinline__ void operator()(const f32x4 (&acc)[2][2][4][2], const Unit& u, int wr, int wc, int fr, int fq) const {
        const int row0 = u.pm * BM + wr * 64 + fr; const int grp = u.pm < 64 ? (u.pm >> 4) : 4;
        if constexpr (SLAB) {
            const int col0 = u.pn * BM + wc * 32 + 4 * fq;
            f32x4 g[2][2];
#pragma unroll
            for (int bj = 0; bj < 2; ++bj)
#pragma unroll
                for (int n = 0; n < 2; ++n) g[bj][n] = *(const f32x4*)(gv + (size_t)grp * gstride + col0 + bj * HALF + n * 16);
#pragma unroll
            for (int ai = 0; ai < 2; ++ai)
#pragma unroll
                for (int m = 0; m < 4; ++m) { float* pp = (float*)Tw + ((size_t)(u.ka / klen) * 1024 + (size_t)(row0 + ai * HALF + m * 16 - nlat)) * ldc + col0;
#pragma unroll
                    for (int bj = 0; bj < 2; ++bj)
#pragma unroll
                        for (int n = 0; n < 2; ++n) *(f32x4*)(pp + bj * HALF + n * 16) = g[bj][n] * acc[ai][bj][m][n]; }
        } else {
            const int col0 = u.pn * BM + wc * 32 + 8 * fq;
            f32x4 g[2][2];
#pragma unroll
            for (int bj = 0; bj < 2; ++bj)
#pragma unroll
                for (int n = 0; n < 2; ++n) g[bj][n] = *(const f32x4*)(gv + (size_t)grp * gstride + col0 + bj * HALF + n * 4);
#pragma unroll
            for (int ai = 0; ai < 2; ++ai)
#pragma unroll
                for (int m = 0; m < 4; ++m) { bf16_t* tp = (bf16_t*)Tw + (size_t)(row0 + ai * HALF + m * 16) * ldc + col0;
#pragma unroll
                    for (int bj = 0; bj < 2; ++bj) store8_bf16(tp + bj * HALF, g[bj][0] * acc[ai][bj][m][0], g[bj][1] * acc[ai][bj][m][1]); }
        }
    }
};

struct EpiSwiglu {
    static constexpr bool PERM = true, AFTER_DRAIN = false; static constexpr int KSEG = 0;
    bf16_t* H; int ldc;
    __device__ __forceinline__ void kseg(f32x4 (&)[2][2][4][2], const Unit&, int, int, int, int, int) const {}
    __device__ __forceinline__ void operator()(const f32x4 (&acc)[2][2][4][2], const Unit& u, int wr, int wc, int fr, int fq) const {
        const int row0 = u.pm * BM + wr * 64 + fr, col0 = u.pn * HALF + wc * 32 + 8 * fq;
#pragma unroll
        for (int ai = 0; ai < 2; ++ai)
#pragma unroll
            for (int m = 0; m < 4; ++m) { bf16_t* rowp = H + (size_t)(row0 + ai * HALF + m * 16) * ldc + col0; f32x4 o[2];
#pragma unroll
                for (int n = 0; n < 2; ++n) { const f32x4 gt = acc[ai][0][m][n], up = acc[ai][1][m][n];
#pragma unroll
                    for (int i = 0; i < 4; ++i) o[n][i] = gt[i] * sigmoid_f(gt[i]) * up[i]; }
                store8_bf16(rowp, o[0], o[1]); }
    }
};
template <class Epi, class Sched, bool ALIGN_EPI = false, bool SP2 = false>
__device__ __forceinline__ void gemm_phase(PG8_LAS unsigned char* lds, const Gemm g, const Sched& S, const Epi& E) {
    int tid_ = threadIdx.x; asm volatile("" : "+v"(tid_));
    const int tid = tid_, wid = __builtin_amdgcn_readfirstlane(tid >> 6), lane = tid & 63, wr = wid >> 2, wc = wid & 3, fr = lane & 15, fq = lane >> 4;
    const int K = g.K, nt = K / BK;
    unsigned voffA[2], voffB[2];
#pragma unroll
    for (int i = 0; i < 2; ++i) { int R, C; stage_rc(tid * 16 + i * 8192, R, C); const int Rb = Epi::PERM ? ((R & ~31) + perm32(R & 31)) : R;
        voffA[i] = (unsigned)(R * g.lda + C) * 2u; voffB[i] = (unsigned)(Rb * g.ldb + C) * 2u; }
    const size_t kstep = (size_t)(BK * 2);
    const size_t hstepA = (size_t)HALF * g.lda * 2, hstepB = (size_t)HALF * g.ldb * 2;
    const size_t tstepA = 2 * hstepA, tstepB = 2 * hstepB;
    const unsigned ldsw = (unsigned)wid * 1024u;
    const int aoff = lds_byte(wr * 64 + fr, fq * 8), boff = lds_byte(wc * 32 + fr, fq * 8);
#define PG8_SA(b, h) (((b) * 2 + (h)) * HTB)
#define PG8_SB(b, h) ((4 + (b) * 2 + (h)) * HTB)
#define PG8_STAGE(bufoff, gbase, voff) do { _Pragma("unroll") for (int _i = 0; _i < 2; ++_i) \
        __builtin_amdgcn_global_load_lds((const unsigned*)((const char*)(gbase) + (voff)[_i]), (PG8_LAS unsigned*)(lds + (bufoff) + ldsw + _i * 8192), 16, 0, 0); } while (0)
#define PG8_LDA(dst, b, h) do { _Pragma("unroll") for (int m = 0; m < 4; ++m) _Pragma("unroll") for (int k = 0; k < 2; ++k) dst[m][k] = *(const PG8_LAS bf16x8*)(lds + PG8_SA(b, h) + aoff + m * 2048 + k * 1024); } while (0)
#define PG8_LDB(dst, b, h) do { _Pragma("unroll") for (int n = 0; n < 2; ++n) _Pragma("unroll") for (int k = 0; k < 2; ++k) dst[n][k] = *(const PG8_LAS bf16x8*)(lds + PG8_SB(b, h) + boff + n * 2048 + k * 1024); } while (0)
#define PG8_MMA(ai, bj, At, Bt) do { __builtin_amdgcn_s_setprio(1); _Pragma("unroll") for (int m = 0; m < 4; ++m) _Pragma("unroll") for (int n = 0; n < 2; ++n) _Pragma("unroll") for (int k = 0; k < 2; ++k) \
        acc[ai][bj][m][n] = __builtin_amdgcn_mfma_f32_16x16x32_bf16(Bt[n][k], At[m][k], acc[ai][bj][m][n], 0, 0, 0); __builtin_amdgcn_s_setprio(0); } while (0)
#define PG8_WAIT_V(n) asm volatile("s_waitcnt vmcnt(" #n ")" ::: "memory")
#define PG8_WAIT_L(n) asm volatile("s_waitcnt lgkmcnt(" #n ")" ::: "memory")
#define PG8_BAR __builtin_amdgcn_s_barrier()
#define PG8_SCHED __builtin_amdgcn_sched_barrier(0)
    Unit cur, nxt; int ui = 0;
    if (!S.next(0, cur)) return;
    f32x4 acc[2][2][4][2];
#pragma unroll
    for (int a = 0; a < 2; ++a)
#pragma unroll
        for (int b = 0; b < 2; ++b)
#pragma unroll
            for (int m = 0; m < 4; ++m)
#pragma unroll
                for (int n = 0; n < 2; ++n) acc[a][b][m][n] = (f32x4){0.f, 0.f, 0.f, 0.f};
    bf16x8 At[4][2], B0[2][2], B1[2][2];
    const char* cA = (const char*)g.A + (size_t)cur.pm * tstepA + (size_t)cur.ka * 2; const char* cB = (const char*)g.Bt + (size_t)cur.pn * tstepB + (size_t)cur.ka * 2;
    S.a_ready(cur);
    if constexpr (SP2) {
        PG8_STAGE(PG8_SB(0, 0), cB, voffB); PG8_STAGE(PG8_SB(0, 1), cB + hstepB, voffB); PG8_STAGE(PG8_SA(0, 0), cA, voffA); PG8_STAGE(PG8_SA(0, 1), cA + hstepA, voffA);
        if (wr == 1) PG8_BAR;
        PG8_WAIT_V(2); PG8_BAR;
        PG8_STAGE(PG8_SB(1, 0), cB + kstep, voffB); PG8_STAGE(PG8_SA(1, 0), cA + kstep, voffA); PG8_STAGE(PG8_SB(1, 1), cB + hstepB + kstep, voffB);
        PG8_WAIT_V(6); PG8_BAR;
    } else {
        PG8_STAGE(PG8_SB(0, 0), cB, voffB); PG8_STAGE(PG8_SA(0, 0), cA, voffA); PG8_STAGE(PG8_SB(0, 1), cB + hstepB, voffB); PG8_STAGE(PG8_SA(0, 1), cA + hstepA, voffA);
        if (wr == 1) PG8_BAR;
        PG8_WAIT_V(4); PG8_BAR;
        PG8_STAGE(PG8_SB(1, 0), cB + kstep, voffB); PG8_STAGE(PG8_SA(1, 0), cA + kstep, voffA); PG8_STAGE(PG8_SB(1, 1), cB + hstepB + kstep, voffB);
        PG8_WAIT_V(6); PG8_BAR;
    }
    for (;;) {
        const bool has_next = S.next(ui + 1, nxt);
        const char* nA = has_next ? (const char*)g.A + (size_t)nxt.pm * tstepA + (size_t)nxt.ka * 2 : cA; const char* nB = has_next ? (const char*)g.Bt + (size_t)nxt.pn * tstepB + (size_t)nxt.ka * 2 : cB;
        for (int t = 0; t < nt; t += 2) {
            const bool last = (t == nt - 2);
            if constexpr (Epi::KSEG > 0) { if (t > 0 && (t % Epi::KSEG) == 0) E.kseg(acc, cur, t / Epi::KSEG, wr, wc, fr, fq); }
            const char* a1 = cA + (size_t)(t + 1) * kstep;
            const char* a2 = last ? nA : cA + (size_t)(t + 2) * kstep; const char* b2 = last ? nB : cB + (size_t)(t + 2) * kstep;
            const char* a3 = a2 + kstep; const char* b3 = b2 + kstep;
            if (last && has_next) S.a_ready(nxt);
            if constexpr (SP2) {
            PG8_LDB(B0, 0, 0); PG8_LDB(B1, 0, 1); PG8_SCHED; PG8_LDA(At, 0, 0); PG8_STAGE(PG8_SA(1, 1), a1 + hstepA, voffA);
            PG8_WAIT_V(8); PG8_WAIT_L(0); PG8_BAR; PG8_MMA(0, 0, At, B0); PG8_MMA(0, 1, At, B1); PG8_BAR; PG8_SCHED;
            PG8_LDA(At, 0, 1); PG8_STAGE(PG8_SB(0, 0), b2, voffB); PG8_STAGE(PG8_SB(0, 1), b2 + hstepB, voffB); PG8_STAGE(PG8_SA(0, 0), a2, voffA);
            PG8_WAIT_V(8); PG8_WAIT_L(0); PG8_BAR; PG8_MMA(1, 0, At, B0); PG8_MMA(1, 1, At, B1); PG8_BAR; PG8_SCHED;
            PG8_LDB(B0, 1, 0); PG8_LDB(B1, 1, 1); PG8_SCHED; PG8_LDA(At, 1, 0); PG8_STAGE(PG8_SA(0, 1), a2 + hstepA, voffA);
            PG8_WAIT_V(8); PG8_WAIT_L(0); PG8_BAR; PG8_MMA(0, 0, At, B0); PG8_MMA(0, 1, At, B1); PG8_BAR; PG8_SCHED;
            PG8_LDA(At, 1, 1); PG8_STAGE(PG8_SB(1, 0), b3, voffB); PG8_STAGE(PG8_SB(1, 1), b3 + hstepB, voffB); PG8_STAGE(PG8_SA(1, 0), a3, voffA);
            PG8_WAIT_V(8); PG8_WAIT_L(0); PG8_BAR; PG8_MMA(1, 0, At, B0); PG8_MMA(1, 1, At, B1); PG8_BAR; PG8_SCHED;
            } else {
            PG8_LDB(B0, 0, 0); PG8_SCHED; PG8_LDA(At, 0, 0); PG8_STAGE(PG8_SA(1, 1), a1 + hstepA, voffA);
            PG8_WAIT_L(8); PG8_BAR; PG8_WAIT_L(0); PG8_MMA(0, 0, At, B0); PG8_BAR; PG8_SCHED;
            PG8_LDB(B1, 0, 1); PG8_STAGE(PG8_SB(0, 0), b2, voffB);
            PG8_BAR; PG8_WAIT_L(0); PG8_MMA(0, 1, At, B1); PG8_BAR;
            PG8_LDA(At, 0, 1); PG8_STAGE(PG8_SA(0, 0), a2, voffA);
            PG8_BAR; PG8_WAIT_L(0); PG8_MMA(1, 0, At, B0); PG8_BAR; PG8_SCHED;
            PG8_STAGE(PG8_SB(0, 1), b2 + hstepB, voffB);
            PG8_WAIT_V(6); PG8_BAR; PG8_MMA(1, 1, At, B1); PG8_BAR;
            PG8_LDB(B0, 1, 0); PG8_SCHED; PG8_LDA(At, 1, 0); PG8_STAGE(PG8_SA(0, 1), a2 + hstepA, voffA);
            PG8_WAIT_L(8); PG8_BAR; PG8_WAIT_L(0); PG8_MMA(0, 0, At, B0); PG8_BAR; PG8_SCHED;
            PG8_LDB(B1, 1, 1); PG8_STAGE(PG8_SB(1, 0), b3, voffB);
            PG8_BAR; PG8_WAIT_L(0); PG8_MMA(0, 1, At, B1); PG8_BAR;
            PG8_LDA(At, 1, 1); PG8_STAGE(PG8_SA(1, 0), a3, voffA);
            PG8_BAR; PG8_WAIT_L(0); PG8_MMA(1, 0, At, B0); PG8_BAR; PG8_SCHED;
            PG8_STAGE(PG8_SB(1, 1), b3 + hstepB, voffB);
            PG8_WAIT_V(6); PG8_BAR; PG8_MMA(1, 1, At, B1); PG8_BAR;
            }
        }
        if constexpr (ALIGN_EPI) { if (wr == 0) PG8_BAR; }
        if constexpr (!Epi::AFTER_DRAIN) { E(acc, cur, wr, wc, fr, fq); S.done(cur); }
        if (!has_next) break;
#pragma unroll
        for (int a = 0; a < 2; ++a)
#pragma unroll
            for (int b = 0; b < 2; ++b)
#pragma unroll
                for (int m = 0; m < 4; ++m)
#pragma unroll
                    for (int n = 0; n < 2; ++n) acc[a][b][m][n] = (f32x4){0.f, 0.f, 0.f, 0.f};
        cur = nxt; cA = nA; cB = nB; ++ui;
        if constexpr (ALIGN_EPI) { if (wr == 1) PG8_BAR; }
    }
    PG8_WAIT_V(0);
    if constexpr (!ALIGN_EPI) { if (wr == 0) PG8_BAR; }
    PG8_BAR;
    if constexpr (Epi::AFTER_DRAIN) { E.fused(acc, cur, wr, wc, fr, fq, lds, wid, lane); S.done(cur); }
#undef PG8_SA
#undef PG8_SB
#undef PG8_STAGE
#undef PG8_LDA
#undef PG8_LDB
#undef PG8_MMA
#undef PG8_WAIT_V
#undef PG8_WAIT_L
#undef PG8_BAR
#undef PG8_SCHED
}
}

constexpr int NWAVES = 8;
constexpr int D = 2048, NBATCH = 4, SEQ = 4096, DEPTH = 4, CTXL = 256;
constexpr int MLAT = NBATCH * SEQ, MCTX = NBATCH * CTXL, MTOT = MLAT + MCTX;
constexpr int INW = 12288, BW = 1024, FFH = 5632, NHEAD = 8;
constexpr int Q_OFF = 0, K_OFF = 1024, V_OFF = 2048, BU_OFF = 3072, C_OFF = 5120, G_OFF = 6144;
constexpr int YW = 3 * BW;
constexpr float LN_EPS = 1e-6f;
constexpr float ALPHA = 1.681792830507429f;
constexpr float QSCALE = 0.125f * 1.4426950408889634f;

constexpr size_t MiB = 1u << 20;
constexpr size_t WS_CTL = 0, CTL_ZERO_BYTES = 1 * MiB;
constexpr size_t WS_ROPE = 1 * MiB;
constexpr size_t WS_MODS = 2 * MiB;
constexpr size_t WS_MODP = 4 * MiB;
constexpr size_t WS_WSP = 20 * MiB;
constexpr size_t WS_WPOOL = 21 * MiB;
constexpr size_t WS_WIN = 24 * MiB;
constexpr size_t WS_WBR = 216 * MiB;
constexpr size_t WS_WOUT = 264 * MiB;
constexpr size_t WS_WGU = 296 * MiB;
constexpr size_t WS_WDN = 472 * MiB;
constexpr size_t WS_X = 560 * MiB;
constexpr size_t WS_HA = 696 * MiB;
constexpr size_t WS_Y = 764 * MiB;
constexpr size_t WS_MG = 866 * MiB;
constexpr size_t WS_Z = 934 * MiB;
constexpr size_t WS_KB = 1342 * MiB, WS_VB = 1378 * MiB;
constexpr size_t WS_END = 1414 * MiB;
static_assert(WS_MODP + 16ull * 4 * 5 * 12288 * 4 <= WS_WSP && WS_WIN + 4ull * 12288 * 2048 * 2 <= WS_WBR && WS_WBR + 4ull * 2048 * 3072 * 2 <= WS_WOUT && WS_WOUT + 4ull * 2048 * 2048 * 2 <= WS_WGU, "ws map 1");
static_assert(WS_WGU + 4ull * 11264 * 2048 * 2 <= WS_WDN && WS_WDN + 4ull * 2048 * 5632 * 2 <= WS_X && WS_X + (size_t)MTOT * D * 4 <= WS_HA && WS_HA + (size_t)MTOT * D * 2 <= WS_Y, "ws map 2");
static_assert(WS_Y + (size_t)MTOT * YW * 2 <= WS_MG && WS_MG + (size_t)MTOT * D * 2 <= WS_Z && WS_Z + (size_t)MTOT * INW * 2 <= WS_KB && WS_KB + 32ull * 4352 * 256 <= WS_VB && WS_VB + 32ull * 4352 * 256 <= WS_END, "ws map 3");
constexpr int CW_BAR = 4096;

constexpr int RING_OFF = 0, RING_BYTES = 131072;
constexpr int LDSCTL_OFF = RING_BYTES, MISC_OFF = LDSCTL_OFF + 320;
constexpr int LDS_BYTES = 147456;

#define GAS __attribute__((address_space(1)))
#define LAS __attribute__((address_space(3)))
typedef unsigned short bf16;
typedef unsigned v4u __attribute__((ext_vector_type(4)));
typedef unsigned v2u __attribute__((ext_vector_type(2)));
typedef float f32x4 __attribute__((ext_vector_type(4)));
typedef float f32x16 __attribute__((ext_vector_type(16)));
typedef short bf16x8 __attribute__((ext_vector_type(8)));
typedef short s16x4 __attribute__((ext_vector_type(4)));
typedef GAS unsigned gu32;
#define RLX_AGENT __ATOMIC_RELAXED, __HIP_MEMORY_SCOPE_AGENT
#define LDS_WAIT() asm volatile("s_waitcnt lgkmcnt(0)" ::: "memory")
#define VM_WAIT() asm volatile("s_waitcnt vmcnt(0)" ::: "memory")
__device__ __forceinline__ unsigned f2bf(float f) { unsigned u = __builtin_bit_cast(unsigned, f); return (u + 0x7fffu + ((u >> 16) & 1u)) >> 16; }
__device__ __forceinline__ unsigned pk2(float lo, float hi) { return f2bf(lo) | (f2bf(hi) << 16); }
__device__ __forceinline__ unsigned cvtpk(float lo, float hi) { unsigned r; asm volatile("v_cvt_pk_bf16_f32 %0, %1, %2" : "=v"(r) : "v"(lo), "v"(hi)); return r; }
__device__ __forceinline__ float bflo(unsigned w) { return __uint_as_float(w << 16); }
__device__ __forceinline__ float bfhi(unsigned w) { return __uint_as_float(w & 0xffff0000u); }

#define XB_TMO      128
#define XB_XCNT(j)  (256  + 64 * (j))
#define XB_XSUB(j)  (1280 + 64 * (j))
#define XB_XGEN(j)  (2304 + 64 * (j))
#define XB_TOP      3328
#define XB_TOPGEN   3392
#define XCD_BAR_WORDS 3456
#define XB_SPIN_CAP (1u << 18)

__device__ __forceinline__ unsigned xb_ld(unsigned* p)              { return __hip_atomic_load(p, __ATOMIC_RELAXED, __HIP_MEMORY_SCOPE_AGENT); }
__device__ __forceinline__ unsigned xb_add(unsigned* p, unsigned v) { return __hip_atomic_fetch_add(p, v, __ATOMIC_RELAXED, __HIP_MEMORY_SCOPE_AGENT); }
__device__ __forceinline__ unsigned xb_xcc_id() { return (unsigned)__builtin_amdgcn_s_getreg((3 << 11) | 20) & 0xFu; }
#define XB_SPIN(cond, bar) do { unsigned _sp = 0; while (cond) { __builtin_amdgcn_s_sleep(1); \
    if ((++_sp & 255u) == 0u) { if (xb_ld(&(bar)[XB_TMO])) break; if (_sp > XB_SPIN_CAP) { atomicAdd(&(bar)[XB_TMO], 1u); break; } } } } while (0)

struct XcdBarrier {
    unsigned* bar; unsigned x;
    volatile LAS unsigned* st;
};

__device__ __forceinline__ XcdBarrier xcd_barrier_post(unsigned* bar, volatile LAS unsigned* st) {
    XcdBarrier b; b.bar = bar; b.x = xb_xcc_id(); b.st = st;
    if (threadIdx.x == 0) (void)xb_add(&bar[XB_XCNT(b.x)], 1u);
    return b;
}
__device__ __forceinline__ void xcd_barrier_complete(unsigned* bar, unsigned x, unsigned& nloc, unsigned& nx) {
    const unsigned G = gridDim.x * gridDim.y * gridDim.z;
    unsigned sum, cnt, mine, sp = 0u;
    for (;;) {
        sum = 0u; cnt = 0u; mine = 0u;
#pragma unroll
        for (unsigned j = 0; j < 16; ++j) { const unsigned c = xb_ld(&bar[XB_XCNT(j)]); sum += c; cnt += (c > 0u) ? 1u : 0u; mine = (j == x) ? c : mine; }
        if (sum == G) break;
        __builtin_amdgcn_s_sleep(1);
        if ((++sp & 255u) == 0u) { if (xb_ld(&bar[XB_TMO])) break; if (sp > XB_SPIN_CAP) { atomicAdd(&bar[XB_TMO], 1u); break; } }
    }
    nloc = mine > 0u ? mine : 1u; nx = cnt > 0u ? cnt : 1u;
}

__device__ __forceinline__ void xcd_barrier(const XcdBarrier& b) {
    asm volatile("s_waitcnt vmcnt(0)" ::: "memory");
    __syncthreads();
    if (threadIdx.x == 0) {
        unsigned* bar = b.bar;
        __builtin_amdgcn_s_waitcnt(0);
        unsigned nloc = b.st[0], nx = b.st[1];
        if (nloc == 0u) { xcd_barrier_complete(bar, b.x, nloc, nx); b.st[0] = nloc; b.st[1] = nx; }
        const unsigned old = xb_add(&bar[XB_XSUB(b.x)], 1u);
        const unsigned gen = old / nloc;
        if (old + 1u == (gen + 1u) * nloc) {
            __builtin_amdgcn_fence(__ATOMIC_RELEASE, "agent");
            asm volatile("s_waitcnt vmcnt(0)" ::: "memory");
            const unsigned og = xb_add(&bar[XB_TOP], 1u);
            const unsigned tg = og / nx;
            if (og + 1u == (tg + 1u) * nx) xb_add(&bar[XB_TOPGEN], 1u);
            else XB_SPIN(xb_ld(&bar[XB_TOPGEN]) == tg, bar);
            __builtin_amdgcn_fence(__ATOMIC_ACQUIRE, "agent");
            xb_add(&bar[XB_XGEN(b.x)], 1u);
            asm volatile("s_waitcnt vmcnt(0)" ::: "memory");
        } else {
            XB_SPIN(xb_ld(&bar[XB_XGEN(b.x)]) == gen, bar);
            __builtin_amdgcn_fence(__ATOMIC_ACQUIRE, "agent");
            asm volatile("s_waitcnt vmcnt(0)" ::: "memory");
        }
    }
    __syncthreads();
}


struct Frame {
    LAS unsigned char* lds;
    volatile LAS unsigned* MISC;
    gu32* ctl;
    int vcu, G, bx;
    __device__ __forceinline__ int ltid() const { int t = threadIdx.x; asm volatile("" : "+v"(t)); return t; }
    const float *x, *c, *ctx, *cctx, *w_ada, *b_ada, *w_in, *lam_qk, *subln_g, *gln_g, *gln_b, *w_sp, *b_sp, *w_pool, *pool_scale, *w_branch, *w_out, *ln1_g, *ln1_b, *w_gu, *w_down, *ln2_g, *ln2_b;
    float* out;
    float *rope, *mods, *modp, *X;
    bf16 *Wsp, *Wpool, *Win, *Wbr, *Wout, *Wgu, *Wdn, *HA, *Y, *MG, *Z, *KB, *VB;
};

typedef __attribute__((address_space(4))) const unsigned char* kptr_t;
__device__ __forceinline__ void frame_ptrs(Frame& F) {
    kptr_t kp = (kptr_t)__builtin_amdgcn_kernarg_segment_ptr(); asm volatile("" : "+s"(kp));
#define KIN(i) (*(const float* const __attribute__((address_space(4)))*)(kp + 8 * (i)))
    F.x = KIN(0); F.c = KIN(1); F.ctx = KIN(2); F.cctx = KIN(3); F.w_ada = KIN(4); F.b_ada = KIN(5); F.w_in = KIN(6); F.lam_qk = KIN(7); F.subln_g = KIN(8);
    F.gln_g = KIN(9); F.gln_b = KIN(10); F.w_sp = KIN(11); F.b_sp = KIN(12); F.w_pool = KIN(13); F.pool_scale = KIN(14); F.w_branch = KIN(15); F.w_out = KIN(16);
    F.ln1_g = KIN(17); F.ln1_b = KIN(18); F.w_gu = KIN(19); F.w_down = KIN(20); F.ln2_g = KIN(21); F.ln2_b = KIN(22);
#undef KIN
    F.out = *(float* const __attribute__((address_space(4)))*)(kp + 184);
    unsigned char* ws = *(unsigned char* const __attribute__((address_space(4)))*)(kp + 192);
    F.rope = (float*)(ws + WS_ROPE); F.mods = (float*)(ws + WS_MODS); F.modp = (float*)(ws + WS_MODP); F.X = (float*)(ws + WS_X);
    F.Wsp = (bf16*)(ws + WS_WSP); F.Wpool = (bf16*)(ws + WS_WPOOL); F.Win = (bf16*)(ws + WS_WIN); F.Wbr = (bf16*)(ws + WS_WBR); F.Wout = (bf16*)(ws + WS_WOUT); F.Wgu = (bf16*)(ws + WS_WGU); F.Wdn = (bf16*)(ws + WS_WDN);
    F.HA = (bf16*)(ws + WS_HA); F.Y = (bf16*)(ws + WS_Y); F.MG = (bf16*)(ws + WS_MG); F.Z = (bf16*)(ws + WS_Z); F.KB = (bf16*)(ws + WS_KB); F.VB = (bf16*)(ws + WS_VB);
}
__device__ __forceinline__ float wave_sum(float v) {
#pragma unroll
    for (int o = 1; o < 64; o <<= 1) v += __shfl_xor(v, o);
    return v;
}

__device__ __forceinline__ void cvt_item(const float* W, int N, int k0, int ncol0, bool perm, bf16* WT, size_t drow0, int ldk, int dk0, LAS float* scr, int lane) {
#pragma unroll 8
    for (int i = 0; i < 32; ++i) { const int kk = 2 * i + (lane >> 5); scr[kk * 33 + (lane & 31)] = W[(size_t)(k0 + kk) * N + ncol0 + (lane & 31)]; }
    LDS_WAIT(); asm volatile("" ::: "memory");
    const int c = lane & 7;
#pragma unroll
    for (int j = 0; j < 4; ++j) { const int n = (lane >> 3) + 8 * j; const int ns = perm ? ((n & 1) * 16 + (n >> 1)) : n; const LAS float* s = scr + (8 * c) * 33 + ns;
        v4u o; o.x = pk2(s[0 * 33], s[1 * 33]); o.y = pk2(s[2 * 33], s[3 * 33]); o.z = pk2(s[4 * 33], s[5 * 33]); o.w = pk2(s[6 * 33], s[7 * 33]);
        *(GAS v4u*)(WT + (drow0 + n) * (size_t)ldk + dk0 + k0 + 8 * c) = o; }
    LDS_WAIT(); asm volatile("" ::: "memory");
}
constexpr int CV_IN = 32 * 384, CV_GU = 32 * 352, CV_DN = 88 * 64, CV_BR = 3 * 16 * 64, CV_OUT = 32 * 64, CV_POOL = 4 * 4 * 8, CV_LAYER = CV_IN + CV_GU + CV_DN + CV_BR + CV_OUT + CV_POOL;
__device__ __forceinline__ void cvt_dispatch(Frame& F, int it, LAS float* scr) {
    const int l = it / CV_LAYER; int r = it - l * CV_LAYER;
    if (r < CV_IN) { const int kb = r / 384, nb = r - kb * 384;
        cvt_item(F.w_in + (size_t)l * D * INW, INW, 64 * kb, 32 * nb, nb < 64, F.Win + (size_t)l * INW * D, (size_t)32 * nb, D, 0, scr, (F.ltid() & 63)); return; }
    r -= CV_IN;
    if (r < CV_GU) { const int kb = r / 352, nb = r - kb * 352; const int tpn = nb >> 3, half = (nb >> 2) & 1, jj0 = (nb & 3) * 32;
        cvt_item(F.w_gu + (size_t)l * D * 2 * FFH, 2 * FFH, 64 * kb, half * FFH + 128 * tpn + jj0, false, F.Wgu + (size_t)l * 2 * FFH * D, (size_t)32 * nb, D, 0, scr, (F.ltid() & 63)); return; }
    r -= CV_GU;
    if (r < CV_DN) { const int kb = r >> 6, nb = r & 63;
        cvt_item(F.w_down + (size_t)l * FFH * D, D, 64 * kb, 32 * nb, false, F.Wdn + (size_t)l * D * FFH, (size_t)32 * nb, FFH, 0, scr, (F.ltid() & 63)); return; }
    r -= CV_DN;
    if (r < CV_BR) { const int n = r >> 10, rr = r & 1023, kb = rr >> 6, nb = rr & 63;
        cvt_item(F.w_branch + ((size_t)l * 3 + n) * BW * D, D, 64 * kb, 32 * nb, false, F.Wbr + (size_t)l * D * YW, (size_t)32 * nb, YW, BW * n, scr, (F.ltid() & 63)); return; }
    r -= CV_BR;
    if (r < CV_OUT) { const int kb = r >> 6, nb = r & 63;
        cvt_item(F.w_out + (size_t)l * D * D, D, 64 * kb, 32 * nb, false, F.Wout + (size_t)l * D * D, (size_t)32 * nb, D, 0, scr, (F.ltid() & 63)); return; }
    r -= CV_OUT;
    { const int g = r >> 5, rr = r & 31, kb = rr >> 3, nb = rr & 7;
        cvt_item(F.w_pool + ((size_t)l * 4 + g) * 65536, 256, 64 * kb, 32 * nb, false, F.Wpool + ((size_t)l * 4 + g) * 65536, (size_t)32 * nb, 256, 0, scr, (F.ltid() & 63)); }
}

__device__ __forceinline__ double rope_inv(int p) {
    const double t[16] = {1.0, 0.5623413251903491, 0.31622776601683794, 0.1778279410038923, 0.1, 0.05623413251903491, 0.03162277660168379, 0.01778279410038923,
                          0.01, 0.005623413251903491, 0.003162277660168379, 0.001778279410038923, 0.001, 0.0005623413251903491, 0.00031622776601683794, 0.0001778279410038923};
    double r = t[0];
#pragma unroll
    for (int i = 1; i < 16; ++i) r = (p == i) ? t[i] : r;
    return r;
}
#ifndef TAILWORK
#define TAILWORK 0
#endif
__device__ __forceinline__ void ada_partial_layer(Frame& F, int l, int gw, int NGW) {
    LAS float* scs = (LAS float*)(F.lds);
    __syncthreads();
    for (int i = F.ltid(); i < 5 * D; i += NWAVES * 64) { const int g = i >> 11, k = i & 2047; const float v = g < 4 ? F.c[g * D + k] : F.cctx[k]; scs[i] = v / (1.0f + __expf(-v)); }
    __syncthreads();
    for (int it = gw; it < 16 * 48; it += NGW) {
        const int ks = it / 48, cgw = it - ks * 48; const int col = cgw * 256 + (F.ltid() & 63) * 4;
        const float* wp = F.w_ada + ((size_t)l * D + ks * 128) * INW + col;
        f32x4 a0 = {0.f, 0.f, 0.f, 0.f}, a1 = a0, a2 = a0, a3 = a0, a4 = a0;
#pragma unroll 8
        for (int k = 0; k < 128; ++k) { const f32x4 w = *(const GAS f32x4*)(wp + (size_t)k * INW); const int kk = ks * 128 + k;
            a0 += w * scs[kk]; a1 += w * scs[D + kk]; a2 += w * scs[2 * D + kk]; a3 += w * scs[3 * D + kk]; a4 += w * scs[4 * D + kk]; }
        float* pp = F.modp + (((size_t)ks * 4 + l) * 5) * INW + col;
        *(f32x4*)(pp) = a0; *(f32x4*)(pp + INW) = a1; *(f32x4*)(pp + 2 * INW) = a2; *(f32x4*)(pp + 3 * INW) = a3; *(f32x4*)(pp + 4 * INW) = a4;
    }
    __syncthreads();
}
__device__ __forceinline__ void cvt_layer(Frame& F, int l, int gw, int NGW) {
    LAS float* scr = (LAS float*)(F.lds + __builtin_amdgcn_readfirstlane(F.ltid() >> 6) * 16384);
    for (int it = gw; it < CV_LAYER; it += NGW) cvt_dispatch(F, l * CV_LAYER + it, scr);
}
__device__ __forceinline__ void mods_reduce_layer(Frame& F, int l) {
    const int gt = F.vcu * NWAVES * 64 + F.ltid(), NGT = F.G * NWAVES * 64;
    for (int i = gt; i < 5 * (INW / 4); i += NGT) { const int g = i / (INW / 4), j = (i - g * (INW / 4)) * 4;
        f32x4 sm = *(const f32x4*)(F.b_ada + (size_t)l * INW + j);
#pragma unroll
        for (int ks = 0; ks < 16; ++ks) sm += *(const f32x4*)(F.modp + (((size_t)ks * 4 + l) * 5 + g) * INW + j);
        *(f32x4*)(F.mods + ((size_t)l * 5 + g) * INW + j) = sm; }
}
__device__ __forceinline__ void phase_a1(Frame& F) {
    const int gw = F.vcu * NWAVES + __builtin_amdgcn_readfirstlane(F.ltid() >> 6), NGW = F.G * NWAVES;
#pragma nounroll
    for (int l = 0; l < (TAILWORK ? 1 : DEPTH); ++l) ada_partial_layer(F, l, gw, NGW);
#pragma nounroll
    for (int l = 0; l < (TAILWORK ? 1 : DEPTH); ++l) cvt_layer(F, l, gw, NGW);
    for (int it = gw; it < (DEPTH * 8 * 128 * 128) / 512; it += NGW) { const size_t e = (size_t)it * 512 + (F.ltid() & 63) * 8;
        const f32x4 a = *(const f32x4*)(F.w_sp + e), b = *(const f32x4*)(F.w_sp + e + 4);
        v4u o; o.x = pk2(a[0], a[1]); o.y = pk2(a[2], a[3]); o.z = pk2(b[0], b[1]); o.w = pk2(b[2], b[3]); *(v4u*)(F.Wsp + e) = o; }
    if (gw == 0) {
        for (int e = (F.ltid() & 63); e < 1024; e += 64) { const int pos = e >> 4, pr = e & 15;
            const double ang = (double)pos * rope_inv(pr); const double twopi = 6.283185307179586476925286766559;
            const double kq = __builtin_rint(ang / twopi); const double rr = ang - kq * twopi; const double r2 = rr * rr;
            double sn = 1.0, cs = 1.0;
#pragma unroll
            for (int n = 14; n >= 1; --n) { sn = 1.0 - sn * r2 / (double)((2 * n) * (2 * n + 1)); cs = 1.0 - cs * r2 / (double)((2 * n - 1) * (2 * n)); }
            sn *= rr;
            F.rope[2 * e] = (float)cs; F.rope[2 * e + 1] = (float)sn; }
    }
}
__device__ __forceinline__ void phase_a2(Frame& F) {
#pragma nounroll
    for (int l = 0; l < (TAILWORK ? 1 : DEPTH); ++l) mods_reduce_layer(F, l); }
__device__ __forceinline__ void ln_row(const float* src, const bf16* tadd, const float* part, int npart, const float* gam, const float* bet, float* xo, float xs, bf16* ho, const float* sc, const float* sh, int lane) {
    f32x4 v[8]; float s = 0.f;
#pragma unroll
    for (int j = 0; j < 8; ++j) v[j] = *(const GAS f32x4*)(src + 4 * lane + 256 * j);
    if (tadd) {
#pragma unroll
        for (int j = 0; j < 8; ++j) { const v2u t2 = *(const GAS v2u*)(tadd + 4 * lane + 256 * j); v[j] += (f32x4){bflo(t2.x), bfhi(t2.x), bflo(t2.y), bfhi(t2.y)}; } }
    for (int p = 0; p < npart; ++p) {
#pragma unroll
        for (int j = 0; j < 8; ++j) v[j] += *(const GAS f32x4*)(part + (size_t)p * 1024 * D + 4 * lane + 256 * j); }
#pragma unroll
    for (int j = 0; j < 8; ++j) s += (v[j][0] + v[j][1]) + (v[j][2] + v[j][3]);
    const float mean = wave_sum(s) * (1.f / D); float s2 = 0.f;
#pragma unroll
    for (int j = 0; j < 8; ++j) { v[j] = v[j] - mean; s2 += (v[j][0] * v[j][0] + v[j][1] * v[j][1]) + (v[j][2] * v[j][2] + v[j][3] * v[j][3]); }
    const float rstd = 1.0f / sqrtf(wave_sum(s2) * (1.f / D) + LN_EPS);
#pragma unroll
    for (int j = 0; j < 8; ++j) { const int col = 4 * lane + 256 * j; f32x4 xn = v[j] * rstd;
        if (gam) xn = xn * *(const f32x4*)(gam + col) + *(const f32x4*)(bet + col);
        if (xo) *(GAS f32x4*)(xo + col) = xn * xs;
        if (ho) { const f32x4 hv = xn * (1.0f + *(const f32x4*)(sc + col)) + *(const f32x4*)(sh + col); v2u o; o.x = pk2(hv[0], hv[1]); o.y = pk2(hv[2], hv[3]); *(GAS v2u*)(ho + col) = o; } }
}
__device__ __forceinline__ int row_group(int row) { return row < MLAT ? (row >> 12) : 4; }
__device__ __forceinline__ void phase_a3(Frame& F) {
    const int gw = F.vcu * NWAVES + __builtin_amdgcn_readfirstlane(F.ltid() >> 6), NGW = F.G * NWAVES;
    for (int row = gw; row < MTOT; row += NGW) { const float* src = row < MLAT ? F.x + (size_t)row * D : F.ctx + (size_t)(row - MLAT) * D; const float* md = F.mods + (size_t)row_group(row) * INW;
        ln_row(src, nullptr, nullptr, 0, nullptr, nullptr, F.X + (size_t)row * D, ALPHA, F.HA + (size_t)row * D, md + D, md, (F.ltid() & 63)); }
}
__device__ __forceinline__ void phase_ln(Frame& F, const float* gam, const float* bet, int nrows, bool to_out, bool want_h, int lm, int moff, int nsplit) {
    const int gw = F.vcu * NWAVES + __builtin_amdgcn_readfirstlane(F.ltid() >> 6), NGW = F.G * NWAVES;
    for (int row = gw; row < nrows; row += NGW) { const float* md = F.mods + ((size_t)lm * 5 + row_group(row)) * INW + moff;
        ln_row(F.X + (size_t)row * D, row < MLAT ? F.Y + (size_t)row * D : nullptr, (const float*)(F.Z + (size_t)100 * MiB) + (size_t)(row - MLAT) * D, row >= MLAT ? nsplit : 0, gam, bet, to_out ? F.out + (size_t)row * D : F.X + (size_t)row * D, to_out ? 1.0f : ALPHA, want_h ? F.HA + (size_t)row * D : nullptr, md + D, md, (F.ltid() & 63)); }
}

constexpr int AT_KB = 0, AT_VB = 32768, AT_TILE = 16384, AT_XB = 65536;
__device__ __forceinline__ s16x4 vtr(const LAS unsigned char* p) { typedef short v4i16_t __attribute__((ext_vector_type(4))); return __builtin_bit_cast(s16x4, __builtin_amdgcn_ds_read_tr16_b64_v4i16((LAS v4i16_t*)p)); }
__device__ __forceinline__ float max3f(float a, float b, float c) { float r; asm("v_max3_f32 %0, %1, %2, %3" : "=v"(r) : "v"(a), "v"(b), "v"(c)); return r; }
__device__ __forceinline__ void glds16(const void* gsrc, unsigned lds_dst) { unsigned keep;
    asm volatile("s_mov_b32 %0, m0\n\ts_mov_b32 m0, %2\n\ts_nop 0\n\tglobal_load_lds_dwordx4 %1, off\n\ts_mov_b32 m0, %0" : "=&s"(keep) : "v"(gsrc), "s"(lds_dst) : "memory"); }
#define AT_WAITV(n) asm volatile("s_waitcnt vmcnt(" #n ")" ::: "memory")
#define AT_BAR() asm volatile("s_waitcnt lgkmcnt(0)\n\ts_barrier" ::: "memory")
__device__ __forceinline__ void attn_unit(Frame& F, int b, int h, int qb, bool ctxq, float lam, float oscale, const float* subg) {
    int lane_ = (F.ltid() & 63); asm volatile("" : "+v"(lane_));
    const int lane = lane_, wid = __builtin_amdgcn_readfirstlane(F.ltid() >> 6), r32 = lane & 31, hi = lane >> 5, m = wid >> 2, qg = wid & 3; const bool lead = wid < 4;
    const bf16* Z = F.Z;
    const int qrow = (ctxq ? MLAT + b * CTXL : b * SEQ) + qb * 128 + qg * 32 + r32;
    bf16x8 qf[4];
#pragma unroll
    for (int d0 = 0; d0 < 4; ++d0) qf[d0] = *(const GAS bf16x8*)(Z + (size_t)qrow * INW + Q_OFF + h * 128 + m * 64 + d0 * 16 + hi * 8);
    const int NT = ctxq ? 4 : 68;
    const bf16* Kbh = F.KB + (size_t)(b * 8 + h) * 4352 * 128; const bf16* Vbh = F.VB + (size_t)(b * 8 + h) * 4352 * 128;
    const unsigned lds0 = (unsigned)(size_t)F.lds;
    const int prow = 8 * wid + (lane >> 4), ppos = lane & 15;
    const unsigned koff0 = (unsigned)(prow * 128 + ((ppos ^ (prow & 15)) * 8)), koff1 = (unsigned)((prow + 4) * 128 + ((ppos ^ ((prow + 4) & 15)) * 8));
    const unsigned voff0 = (unsigned)(prow * 128 + ((ppos ^ (4 * (prow & 3))) * 8)), voff1 = voff0 + 4 * 128;
    const unsigned kdst = (unsigned)__builtin_amdgcn_readfirstlane((int)(lds0 + AT_KB + wid * 2048)), vdst = (unsigned)__builtin_amdgcn_readfirstlane((int)(lds0 + AT_VB + wid * 2048));
#define AT_DMAK(t, bufo) do { const bf16* tb_ = Kbh + (size_t)(t) * 8192; glds16(tb_ + koff0, kdst + (bufo)); glds16(tb_ + koff1, kdst + (bufo) + 1024); } while (0)
#define AT_DMAV(t, bufo) do { const bf16* tb_ = Vbh + (size_t)(t) * 8192; glds16(tb_ + voff0, vdst + (bufo)); glds16(tb_ + voff1, vdst + (bufo) + 1024); } while (0)
    f32x16 o[4];
#pragma unroll
    for (int db = 0; db < 4; ++db)
#pragma unroll
        for (int r = 0; r < 16; ++r) o[db][r] = 0.f;
    float mref = 0.f, lsum = 0.f;
    f32x16 negm;
#pragma unroll
    for (int r = 0; r < 16; ++r) negm[r] = 0.f;
    const unsigned kaddr0 = AT_KB + r32 * 256 + (((8 * m + hi) ^ (r32 & 15)) << 4);
    const int a4 = (lane & 15) >> 2, cc = 2 * ((lane >> 4) & 1) + ((lane & 3) >> 1);
    const unsigned vaddr0 = AT_VB + (4 * hi + a4) * 256 + ((4 * a4 + cc) << 4) + 8 * (lane & 1);
    __syncthreads();
    AT_DMAK(0, 0); AT_DMAV(0, 0);
    AT_WAITV(2); AT_BAR();
    if (!lead) { if (NT > 1) { AT_DMAK(1, AT_TILE); AT_WAITV(2); } else AT_WAITV(0); AT_BAR(); }
    for (int t = 0; t < NT; ++t) {
        const unsigned bo = (t & 1) ? AT_TILE : 0; const bool more = (t + 1 < NT);
        if (more) { if (lead) AT_DMAK(t + 1, bo ^ AT_TILE); else AT_DMAV(t + 1, bo ^ AT_TILE); }
        unsigned kb_ = kaddr0 + bo, vb_ = vaddr0 + bo; asm volatile("" : "+v"(kb_), "+v"(vb_));
        f32x16 p0, p1;
        { bf16x8 kf[4][2];
#pragma unroll
          for (int d0 = 0; d0 < 4; ++d0) { const unsigned ka = kb_ ^ (unsigned)((2 * d0) << 4); kf[d0][0] = *(const LAS bf16x8*)(F.lds + ka); kf[d0][1] = *(const LAS bf16x8*)(F.lds + ka + 32 * 256); }
          __builtin_amdgcn_sched_barrier(0);
          p0 = __builtin_amdgcn_mfma_f32_32x32x16_bf16(kf[0][0], qf[0], negm, 0, 0, 0);
#pragma unroll
          for (int d0 = 1; d0 < 4; ++d0) p0 = __builtin_amdgcn_mfma_f32_32x32x16_bf16(kf[d0][0], qf[d0], p0, 0, 0, 0);
          p1 = __builtin_amdgcn_mfma_f32_32x32x16_bf16(kf[0][1], qf[0], negm, 0, 0, 0);
#pragma unroll
          for (int d0 = 1; d0 < 4; ++d0) p1 = __builtin_amdgcn_mfma_f32_32x32x16_bf16(kf[d0][1], qf[d0], p1, 0, 0, 0); }
#define AT_SOFTMAX(P, OTHER, PK, FIRST) do { \
        float tmax = max3f(P[0], P[1], P[2]); \
        _Pragma("unroll") for (int r = 3; r < 15; r += 2) tmax = max3f(tmax, P[r], P[r + 1]); \
        tmax = __builtin_fmaxf(tmax, P[15]); { auto rr_ = __builtin_amdgcn_permlane32_swap(__float_as_uint(tmax), __float_as_uint(tmax), false, false); tmax = __builtin_fmaxf(__uint_as_float(rr_[0]), __uint_as_float(rr_[1])); } \
        if (FIRST) { mref = tmax; \
            _Pragma("unroll") for (int r = 0; r < 16; ++r) { P[r] -= tmax; OTHER[r] -= tmax; negm[r] = -mref; } \
        } else if (__any(tmax > 8.0f)) { \
            const float dl = __builtin_fmaxf(tmax, 0.f); mref += dl; const float al = __builtin_amdgcn_exp2f(-dl); lsum *= al; \
            _Pragma("unroll") for (int r = 0; r < 16; ++r) { P[r] -= dl; OTHER[r] -= dl; negm[r] = -mref; } \
            _Pragma("unroll") for (int db = 0; db < 4; ++db) _Pragma("unroll") for (int r = 0; r < 16; ++r) o[db][r] *= al; \
        } \
        float ls0_ = 0.f, ls1_ = 0.f, ls2_ = 0.f, ls3_ = 0.f; \
        _Pragma("unroll") for (int r = 0; r < 16; r += 4) { P[r] = __builtin_amdgcn_exp2f(P[r]); P[r + 1] = __builtin_amdgcn_exp2f(P[r + 1]); P[r + 2] = __builtin_amdgcn_exp2f(P[r + 2]); P[r + 3] = __builtin_amdgcn_exp2f(P[r + 3]); \
            ls0_ += P[r]; ls1_ += P[r + 1]; ls2_ += P[r + 2]; ls3_ += P[r + 3]; } \
        lsum += (ls0_ + ls1_) + (ls2_ + ls3_); \
        _Pragma("unroll") for (int s_ = 0; s_ < 2; ++s_) { v4u w_; \
            w_.x = cvtpk(P[8 * s_ + 0], P[8 * s_ + 1]); w_.y = cvtpk(P[8 * s_ + 2], P[8 * s_ + 3]); w_.z = cvtpk(P[8 * s_ + 4], P[8 * s_ + 5]); w_.w = cvtpk(P[8 * s_ + 6], P[8 * s_ + 7]); \
            PK[s_] = __builtin_bit_cast(bf16x8, w_); } } while (0)
        bf16x8 pka[2], pkb[2];
        f32x16 dummy_;
        AT_SOFTMAX(p0, p1, pka, t == 0);
        if (more) AT_WAITV(2); else AT_WAITV(0);
        AT_BAR();
        if (lead) { if (more) AT_DMAV(t + 1, bo ^ AT_TILE); } else { if (t + 2 < NT) AT_DMAK(t + 2, bo); }
        { s16x4 va_[4][2][2], vc_[4][2][2];
#define AT_VLOAD(dst, kh_) do { _Pragma("unroll") for (int d_ = 0; d_ < 4; ++d_) { const unsigned va = vb_ ^ (unsigned)(d_ << 6); \
            _Pragma("unroll") for (int s_ = 0; s_ < 2; ++s_) { dst[d_][s_][0] = vtr(F.lds + va + (32 * (kh_) + 16 * s_) * 256); dst[d_][s_][1] = vtr(F.lds + va + (32 * (kh_) + 16 * s_ + 8) * 256); } } } while (0)
#define AT_VMMA(src, PK) do { _Pragma("unroll") for (int s_ = 0; s_ < 2; ++s_) _Pragma("unroll") for (int d_ = 0; d_ < 4; ++d_) { \
            const bf16x8 vf = (bf16x8){src[d_][s_][0][0], src[d_][s_][0][1], src[d_][s_][0][2], src[d_][s_][0][3], src[d_][s_][1][0], src[d_][s_][1][1], src[d_][s_][1][2], src[d_][s_][1][3]}; \
            o[d_] = __builtin_amdgcn_mfma_f32_32x32x16_bf16(vf, PK[s_], o[d_], 0, 0, 0); } } while (0)
          AT_VLOAD(va_, 0); __builtin_amdgcn_sched_barrier(0);
          AT_VLOAD(vc_, 1); __builtin_amdgcn_sched_barrier(0);
          AT_VMMA(va_, pka);
          AT_SOFTMAX(p1, dummy_, pkb, false);
          AT_VMMA(vc_, pkb);
          __builtin_amdgcn_sched_barrier(0);
#undef AT_VLOAD
#undef AT_VMMA
        }
#undef AT_SOFTMAX
        if (lead) { if (more) AT_WAITV(2); } else { if (t + 2 < NT) AT_WAITV(2); else AT_WAITV(0); }
        AT_BAR();
    }
    if (lead) AT_BAR();
    const float lt = lsum + __shfl_xor(lsum, 32);
    LAS float* xs = (LAS float*)(F.lds + AT_XB) + qg * 4096 + lane;
    if (!lead) { const float sc1 = lam / lt;
#pragma unroll
        for (int db = 0; db < 4; ++db)
#pragma unroll
            for (int r = 0; r < 16; ++r) xs[(db * 16 + r) * 64] = o[db][r] * sc1; }
    __syncthreads();
    if (lead) {
        const float i0 = 1.0f / lt; float ss = 0.f;
#pragma unroll
        for (int db = 0; db < 4; ++db)
#pragma unroll
            for (int r = 0; r < 16; ++r) { const float v = o[db][r] * i0 - xs[(db * 16 + r) * 64]; o[db][r] = v; ss += v * v; }
        ss += __shfl_xor(ss, 32);
        const float rs = oscale / sqrtf(ss * (1.0f / 128.0f) + LN_EPS);
        bf16* yp = F.Y + (size_t)qrow * YW + h * 128 + 4 * hi;
#pragma unroll
        for (int db = 0; db < 4; ++db)
#pragma unroll
            for (int g4 = 0; g4 < 4; ++g4) { const int d = 32 * db + 8 * g4; const f32x4 gv = *(const f32x4*)(subg + d + 4 * hi);
                v2u w; w.x = cvtpk(o[db][4 * g4 + 0] * rs * gv[0], o[db][4 * g4 + 1] * rs * gv[1]); w.y = cvtpk(o[db][4 * g4 + 2] * rs * gv[2], o[db][4 * g4 + 3] * rs * gv[3]);
                *(GAS v2u*)(yp + d) = w; }
    }
#undef AT_DMAK
#undef AT_DMAV
}

constexpr int GM_ST = 0, GM_VT = 1024, GM_VP = 272;
__device__ __forceinline__ void gmlp_unit(Frame& F, int row0, int l) {
    int tid_ = F.ltid(); asm volatile("" : "+v"(tid_)); const int tid = tid_, lane = tid & 63, wid = __builtin_amdgcn_readfirstlane(F.ltid() >> 6);
    typedef float f32x2v __attribute__((ext_vector_type(2)));
    LAS f32x2v* st = (LAS f32x2v*)(F.lds + GM_ST); LAS unsigned char* vt = F.lds + GM_VT;
    const bf16* Z = F.Z;
    __syncthreads();
#pragma unroll
    for (int hb = 0; hb < 2; ++hb) {
        v4u va[8], vb[8];
#pragma unroll
        for (int i = 0; i < 8; ++i) { const bf16* vp = Z + (size_t)(row0 + wid * 16 + hb * 8 + i) * INW + BU_OFF + BW + lane * 16; va[i] = *(const GAS v4u*)(vp); vb[i] = *(const GAS v4u*)(vp + 8); }
#pragma unroll
        for (int i = 0; i < 8; ++i) { const v4u a = va[i], b2 = vb[i];
            const float x[16] = {bflo(a.x), bfhi(a.x), bflo(a.y), bfhi(a.y), bflo(a.z), bfhi(a.z), bflo(a.w), bfhi(a.w), bflo(b2.x), bfhi(b2.x), bflo(b2.y), bfhi(b2.y), bflo(b2.z), bfhi(b2.z), bflo(b2.w), bfhi(b2.w)};
            float s = 0.f;
#pragma unroll
            for (int e = 0; e < 16; ++e) s += x[e];
            const float mean = wave_sum(s) * (1.0f / 1024.0f); float q = 0.f;
#pragma unroll
            for (int e = 0; e < 16; ++e) { const float dd = x[e] - mean; q += dd * dd; }
            const float rstd = 1.0f / sqrtf(wave_sum(q) * (1.0f / 1024.0f) + LN_EPS);
            if (lane == 0) st[wid * 16 + hb * 8 + i] = (f32x2v){mean, rstd}; }
    }
    const float* lng = F.gln_g + (size_t)l * BW; const float* lnb = F.gln_b + (size_t)l * BW;
    const int j = tid & 127, cc = tid >> 7;
    const int fr = lane & 15, fq = lane >> 4, tok = wid * 16 + fr;
    const bf16* vsrc = Z + (size_t)(row0 + j) * INW + BU_OFF + BW + cc * 32;
    v4u vr[4];
#pragma unroll
    for (int q4 = 0; q4 < 4; ++q4) vr[q4] = *(const GAS v4u*)(vsrc + q4 * 8);
    __syncthreads();
    const f32x2v sj = st[j];
#pragma unroll 1
    for (int g = 0; g < 8; ++g) {
        bf16x8 wf[4]; v2u uu[8];
        const bf16* wg = F.Wsp + ((size_t)l * 8 + g) * 16384 + (size_t)tok * 128 + fq * 8;
#pragma unroll
        for (int ks = 0; ks < 4; ++ks) wf[ks] = *(const GAS bf16x8*)(wg + ks * 32);
        const bf16* up = Z + (size_t)(row0 + tok) * INW + BU_OFF + g * 128 + 4 * fq;
#pragma unroll
        for (int ct = 0; ct < 8; ++ct) uu[ct] = *(const GAS v2u*)(up + ct * 16);
        const float bias = F.b_sp[((size_t)l * 8 + g) * 128 + tok];
#pragma unroll
        for (int q4 = 0; q4 < 4; ++q4) { const v4u a = vr[q4]; const int c0 = cc * 32 + q4 * 8;
            const f32x4 g0 = *(const f32x4*)(lng + g * 128 + c0), g1 = *(const f32x4*)(lng + g * 128 + c0 + 4), b0 = *(const f32x4*)(lnb + g * 128 + c0), b1 = *(const f32x4*)(lnb + g * 128 + c0 + 4);
            const float xv[8] = {bflo(a.x), bfhi(a.x), bflo(a.y), bfhi(a.y), bflo(a.z), bfhi(a.z), bflo(a.w), bfhi(a.w)};
#pragma unroll
            for (int e = 0; e < 8; ++e) { const float gg = e < 4 ? g0[e & 3] : g1[e & 3], bb = e < 4 ? b0[e & 3] : b1[e & 3]; const float y = (xv[e] - sj.x) * sj.y * gg + bb;
                *(LAS bf16*)(vt + (c0 + e) * GM_VP + j * 2) = (bf16)f2bf(y); } }
        if (g < 7) {
#pragma unroll
            for (int q4 = 0; q4 < 4; ++q4) vr[q4] = *(const GAS v4u*)(vsrc + (g + 1) * 128 + q4 * 8);
        }
        __syncthreads();
#pragma unroll
        for (int ct = 0; ct < 8; ++ct) { f32x4 acc = {0.f, 0.f, 0.f, 0.f};
#pragma unroll
            for (int ks = 0; ks < 4; ++ks) { const bf16x8 af = *(const LAS bf16x8*)(vt + (ct * 16 + fr) * GM_VP + (ks * 32 + fq * 8) * 2); acc = __builtin_amdgcn_mfma_f32_16x16x32_bf16(af, wf[ks], acc, 0, 0, 0); }
            const v2u u2 = uu[ct];
            v2u w; w.x = cvtpk(bflo(u2.x) * (acc[0] + bias), bfhi(u2.x) * (acc[1] + bias)); w.y = cvtpk(bflo(u2.y) * (acc[2] + bias), bfhi(u2.y) * (acc[3] + bias));
            *(GAS v2u*)(F.Y + (size_t)(row0 + tok) * YW + BW + g * 128 + ct * 16 + 4 * fq) = w; }
        __syncthreads();
    }
}

constexpr int PL_DP = 528;
template <int GI> __device__ __forceinline__ void pool_unit(Frame& F, int row0, int l) {
    int tid_ = F.ltid(); asm volatile("" : "+v"(tid_)); const int tid = tid_, lane = tid & 63, wid = __builtin_amdgcn_readfirstlane(F.ltid() >> 6);
    LAS unsigned char* dt = F.lds;
    const bf16* Z = F.Z;
    constexpr int W = 2 << GI, HW = W / 2, NR = 8 + W - 1;
    const int seqlen = row0 < MLAT ? SEQ : CTXL; const int s0 = row0 < MLAT ? (row0 & ~(SEQ - 1)) : MLAT + ((row0 - MLAT) & ~(CTXL - 1));
    const int fr = lane & 15, fq = lane >> 4;
    bf16x8 wa[8][2];
    { const bf16* wp = F.Wpool + ((size_t)l * 4 + GI) * 65536 + (size_t)(wid * 32 + fr) * 256 + fq * 8;
#pragma unroll
      for (int ks = 0; ks < 8; ++ks) { wa[ks][0] = *(const GAS bf16x8*)(wp + ks * 32); wa[ks][1] = *(const GAS bf16x8*)(wp + 16 * 256 + ks * 32); } }
    __syncthreads();
    { const int ch = tid & 31, tg = tid >> 5;
      const bf16* zc = Z + C_OFF + GI * 256 + ch * 8; const int p0 = row0 - s0 + tg * 8;
      v4u rw[NR];
#pragma unroll
      for (int k = 0; k < NR; ++k) { const int q = p0 - HW + k; const bool ok = (q >= 0) && (q < seqlen); const int qq = ok ? q : p0; const v4u a = *(const GAS v4u*)(zc + (size_t)(s0 + qq) * INW); rw[k] = ok ? a : (v4u){0u, 0u, 0u, 0u}; }
      float sum[8] = {0.f, 0.f, 0.f, 0.f, 0.f, 0.f, 0.f, 0.f};
#pragma unroll
      for (int k = 0; k < W; ++k) { const v4u a = rw[k]; sum[0] += bflo(a.x); sum[1] += bfhi(a.x); sum[2] += bflo(a.y); sum[3] += bfhi(a.y); sum[4] += bflo(a.z); sum[5] += bfhi(a.z); sum[6] += bflo(a.w); sum[7] += bfhi(a.w); }
#pragma unroll
      for (int i = 0; i < 8; ++i) { const int p = p0 + i; const int lo = p - HW < 0 ? 0 : p - HW; const int hi = p - HW + W > seqlen ? seqlen : p - HW + W; const float inv = 1.0f / (float)(hi - lo);
          const v4u zz = rw[i + HW];
          v4u o; o.x = pk2(sum[0] * inv - bflo(zz.x), sum[1] * inv - bfhi(zz.x)); o.y = pk2(sum[2] * inv - bflo(zz.y), sum[3] * inv - bfhi(zz.y));
          o.z = pk2(sum[4] * inv - bflo(zz.z), sum[5] * inv - bfhi(zz.z)); o.w = pk2(sum[6] * inv - bflo(zz.w), sum[7] * inv - bfhi(zz.w));
          *(LAS v4u*)(dt + (tg * 8 + i) * PL_DP + ch * 16) = o;
          if (i < 7) { const v4u a = rw[i + W], b = rw[i];
              sum[0] += bflo(a.x) - bflo(b.x); sum[1] += bfhi(a.x) - bfhi(b.x); sum[2] += bflo(a.y) - bflo(b.y); sum[3] += bfhi(a.y) - bfhi(b.y);
              sum[4] += bflo(a.z) - bflo(b.z); sum[5] += bfhi(a.z) - bfhi(b.z); sum[6] += bflo(a.w) - bflo(b.w); sum[7] += bfhi(a.w) - bfhi(b.w); } } }
    __syncthreads();
    { f32x4 acc[2][8];
#pragma unroll
      for (int a = 0; a < 2; ++a)
#pragma unroll
          for (int tt = 0; tt < 8; ++tt) acc[a][tt] = (f32x4){0.f, 0.f, 0.f, 0.f};
#pragma unroll
      for (int ks = 0; ks < 8; ++ks) {
#pragma unroll
          for (int tt = 0; tt < 8; ++tt) { const bf16x8 bfr = *(const LAS bf16x8*)(dt + (tt * 16 + fr) * PL_DP + (ks * 32 + fq * 8) * 2);
              acc[0][tt] = __builtin_amdgcn_mfma_f32_16x16x32_bf16(wa[ks][0], bfr, acc[0][tt], 0, 0, 0); acc[1][tt] = __builtin_amdgcn_mfma_f32_16x16x32_bf16(wa[ks][1], bfr, acc[1][tt], 0, 0, 0); } }
      const float* ps = F.pool_scale + (size_t)l * BW + GI * 256;
#pragma unroll
      for (int a = 0; a < 2; ++a) { const int dd = wid * 32 + a * 16 + 4 * fq; const f32x4 sc = *(const f32x4*)(ps + dd);
#pragma unroll
          for (int tt = 0; tt < 8; ++tt) { const f32x4 v = acc[a][tt] * sc; v2u wv; wv.x = cvtpk(v[0], v[1]); wv.y = cvtpk(v[2], v[3]);
              *(GAS v2u*)(F.Y + (size_t)(row0 + tt * 16 + fr) * YW + 2 * BW + GI * 256 + dd) = wv; } } }
}
__device__ __forceinline__ void pool_dispatch(Frame& F, int row0, int g, int l) {
    if (g == 0) pool_unit<0>(F, row0, l); else if (g == 1) pool_unit<1>(F, row0, l); else if (g == 2) pool_unit<2>(F, row0, l); else pool_unit<3>(F, row0, l);
}

#ifndef MIXM
#define MIXM 7
#endif
__device__ __forceinline__ void phase_mixers(Frame& F, int l, float lam_init) {
    const bool last = (l == DEPTH - 1);
    float d01 = 0.f, d23 = 0.f; const float* lq = F.lam_qk + (size_t)l * 256;
    for (int i = 0; i < 64; ++i) { d01 += lq[i] * lq[64 + i]; d23 += lq[128 + i] * lq[192 + i]; }
    const float lam = __expf(d01) - __expf(d23) + lam_init; const float oscale = 1.0f - lam_init;
    const float* subg = F.subln_g + (size_t)l * 128;
#ifndef REP_ATT
#define REP_ATT 1
#endif
#ifndef REP_GP
#define REP_GP 1
#endif
#pragma nounroll
    for (int i = 0; i < 5 * REP_ATT; ++i) { const int uid = F.vcu + F.G * (i % 5);
        if (!(MIXM & 1)) continue;
        if (uid < 1024) attn_unit(F, uid >> 8, (uid >> 5) & 7, uid & 31, false, lam, oscale, subg);
        else if (!last && uid < 1088) attn_unit(F, (uid - 1024) >> 4, ((uid - 1024) >> 1) & 7, uid & 1, true, lam, oscale, subg); }
    const int nchunk = last ? MLAT / 128 : MTOT / 128;
#pragma nounroll
    for (int rgp = 0; rgp < REP_GP; ++rgp) {
    if (MIXM & 2) for (int cidx = F.G - 1 - F.vcu; cidx < nchunk; cidx += F.G) gmlp_unit(F, cidx * 128, l);
    if (MIXM & 4) for (int u = F.vcu; u < nchunk * 4; u += F.G) pool_dispatch(F, (u >> 2) * 128, u & 3, l);
    }
    __syncthreads();
}

#ifndef MK_ONE_LAUNCH
#define MK_ONE_LAUNCH 1
#endif
constexpr int NPHASE = 3 + 8 * DEPTH;
struct Args { const float* in[23]; float* out; unsigned char* ws; int ph_lo, ph_hi; float lam_init[4]; };
__global__ void __launch_bounds__(NWAVES * 64, 2) fwd(Args args) {
    extern __shared__ __attribute__((aligned(16))) unsigned char lds[];
    Frame F;
    F.lds = (LAS unsigned char*)lds;
    F.MISC = (volatile LAS unsigned*)(F.lds + MISC_OFF);
    F.G = gridDim.x; { const int bx = blockIdx.x; F.bx = bx; F.vcu = (F.G % 8 == 0) ? (bx % 8) * (F.G / 8) + bx / 8 : bx; }
    unsigned char* ws = args.ws;
    F.ctl = (gu32*)(ws + WS_CTL);
    frame_ptrs(F);
    for (int u = F.ltid(); u < (LDS_BYTES - LDSCTL_OFF) / 4; u += NWAVES * 64) ((LAS unsigned*)(F.lds + LDSCTL_OFF))[u] = 0u;
    __syncthreads();
#if MK_ONE_LAUNCH
    constexpr int lo = 0, hi = NPHASE; constexpr bool use_bar = true;
#else
    const int lo = args.ph_lo, hi = args.ph_hi;
    const bool use_bar = (hi - lo) > 1;
#endif
    XcdBarrier bar; bar.bar = (unsigned*)(F.ctl + CW_BAR); bar.x = 0; bar.st = nullptr;
    if (use_bar) bar = xcd_barrier_post((unsigned*)(F.ctl + CW_BAR), F.MISC + 8);
#ifndef PHM
#define PHM 0xFFFF
#endif
#define IN(k) (lo <= (k) && (k) < hi)
#define KIND(b) ((PHM >> (b)) & 1)
#ifndef REP_MASK
#define REP_MASK 0
#endif
#define NREP(b) (((REP_MASK >> (b)) & 1) ? 2 : 1)
#define BARRIER() do { XcdBarrier b_ = bar; asm volatile("" : "+s"(b_.x)); xcd_barrier(b_); } while (0)
#define SEAM(k) do { if (IN(k) && IN((k) + 1)) BARRIER(); } while (0)

    if (KIND(0) && IN(0)) { for (int rep = 0; rep < NREP(0); ++rep) { frame_ptrs(F); phase_a1(F); if (rep + 1 < NREP(0)) BARRIER(); } } SEAM(0);
    if (KIND(1) && IN(1)) { frame_ptrs(F); phase_a2(F); } SEAM(1);
    if (KIND(2) && IN(2)) { frame_ptrs(F); phase_a3(F); } SEAM(2);

#pragma nounroll
    for (int l = 0; l < DEPTH; ++l) {
        const int pb = 3 + 8 * l; const bool last = (l == DEPTH - 1);
        { int g_ = F.G, v_ = F.vcu, b_ = F.bx; asm volatile("" : "+s"(g_), "+s"(v_), "+s"(b_)); F.G = g_; F.vcu = v_; F.bx = b_; }
        const int Mrows = last ? MLAT : MTOT;
        if (KIND(3) && IN(pb + 0)) for (int rep = 0; rep < NREP(3); ++rep) { if (rep) BARRIER(); frame_ptrs(F);
            pg8::Gemm g{F.HA, F.Win + (size_t)l * INW * D, MTOT, INW, D, D, D}; pg8::StaticOrder S; S.init(MTOT, INW, F.G, F.bx);
            pg8::EpiInProj E{F.Z, F.rope, QSCALE, INW, MLAT, F.KB, F.VB};
            pg8::gemm_phase<pg8::EpiInProj, pg8::StaticOrder, true, true>(F.lds + RING_OFF, g, S, E);
        }
        SEAM(pb + 0);
        if (KIND(4) && IN(pb + 1)) for (int rep = 0; rep < NREP(4); ++rep) { if (rep) BARRIER(); frame_ptrs(F); phase_mixers(F, l, args.lam_init[l]); }
        SEAM(pb + 1);
        if (KIND(5) && IN(pb + 2)) for (int rep = 0; rep < NREP(5); ++rep) { if (rep) BARRIER(); frame_ptrs(F);
            pg8::Gemm g{F.Y, F.Wbr + (size_t)l * D * YW, Mrows, D, YW, YW, YW}; pg8::StaticOrder S; S.init(Mrows, D, F.G, F.bx);
            pg8::EpiGate E{F.Z + G_OFF, INW, F.MG, D};
            pg8::gemm_phase<pg8::EpiGate, pg8::StaticOrder, true, true>(F.lds + RING_OFF, g, S, E);
        }
        SEAM(pb + 2);
        if (KIND(6) && IN(pb + 3)) for (int rep = 0; rep < NREP(6); ++rep) { if (rep) BARRIER(); frame_ptrs(F);
            void* tw = rep ? (void*)(F.Z + (size_t)134 * MiB) : (void*)F.Y;
            { pg8::Gemm g{F.MG, F.Wout + (size_t)l * D * D, MLAT, D, D, D, D}; pg8::StaticOrder S; S.init(MLAT, D, F.G, F.bx);
              pg8::EpiResidT<false> E{F.mods + (size_t)l * 5 * INW + 2 * D, INW, tw, D, 1, MLAT};
              pg8::gemm_phase<pg8::EpiResidT<false>, pg8::StaticOrder, true, true>(F.lds + RING_OFF, g, S, E); }
            if (!last) { pg8::Gemm g{F.MG, F.Wout + (size_t)l * D * D, MTOT, D, 256, D, D}; pg8::SplitOrder S; S.init(MLAT / 256, 32, 8, 256, F.G, F.bx);
              pg8::EpiResidT<true> E{F.mods + (size_t)l * 5 * INW + 2 * D, INW, rep ? (void*)(F.Z + (size_t)170 * MiB) : (void*)(F.Z + (size_t)100 * MiB), D, 256, MLAT};
              pg8::gemm_phase<pg8::EpiResidT<true>, pg8::SplitOrder, true, true>(F.lds + RING_OFF, g, S, E); }
            if (TAILWORK && !last && F.bx >= 32 && rep == 0) ada_partial_layer(F, l + 1, (F.bx - 32) * NWAVES + __builtin_amdgcn_readfirstlane(F.ltid() >> 6), (F.G - 32) * NWAVES);
        }
        SEAM(pb + 3);
        if (KIND(7) && IN(pb + 4)) { frame_ptrs(F); phase_ln(F, F.ln1_g + (size_t)l * D, F.ln1_b + (size_t)l * D, Mrows, false, true, l, 3 * D, last ? 0 : 8); if (TAILWORK && !last) mods_reduce_layer(F, l + 1); }
        SEAM(pb + 4);
        if (KIND(8) && IN(pb + 5)) for (int rep = 0; rep < NREP(8); ++rep) { if (rep) BARRIER(); frame_ptrs(F);
            pg8::Gemm g{F.HA, F.Wgu + (size_t)l * 2 * FFH * D, Mrows, 2 * FFH, D, D, D}; pg8::StaticOrder S; S.init(Mrows, 2 * FFH, F.G, F.bx);
            pg8::EpiSwiglu E{F.Z, FFH};
            pg8::gemm_phase<pg8::EpiSwiglu, pg8::StaticOrder, true, true>(F.lds + RING_OFF, g, S, E);
        }
        SEAM(pb + 5);
        if (KIND(9) && IN(pb + 6)) for (int rep = 0; rep < NREP(9); ++rep) { if (rep) BARRIER(); frame_ptrs(F);
            void* tw = rep ? (void*)(F.Z + (size_t)134 * MiB) : (void*)F.Y;
            { pg8::Gemm g{F.Z, F.Wdn + (size_t)l * D * FFH, MLAT, D, FFH, FFH, FFH}; pg8::StaticOrder S; S.init(MLAT, D, F.G, F.bx);
              pg8::EpiResidT<false> E{F.mods + (size_t)l * 5 * INW + 5 * D, INW, tw, D, 1, MLAT};
              pg8::gemm_phase<pg8::EpiResidT<false>, pg8::StaticOrder, true, true>(F.lds + RING_OFF, g, S, E); }
            if (!last) { pg8::Gemm g{F.Z, F.Wdn + (size_t)l * D * FFH, MTOT, D, FFH / 4, FFH, FFH}; pg8::SplitOrder S; S.init(MLAT / 256, 32, 4, FFH / 4, F.G, F.bx);
              pg8::EpiResidT<true> E{F.mods + (size_t)l * 5 * INW + 5 * D, INW, rep ? (void*)(F.Z + (size_t)170 * MiB) : (void*)(F.Z + (size_t)100 * MiB), D, FFH / 4, MLAT};
              pg8::gemm_phase<pg8::EpiResidT<true>, pg8::SplitOrder, true, true>(F.lds + RING_OFF, g, S, E); }
            if (TAILWORK && !last && F.bx >= 32 && rep == 0) { __syncthreads(); cvt_layer(F, l + 1, (F.bx - 32) * NWAVES + __builtin_amdgcn_readfirstlane(F.ltid() >> 6), (F.G - 32) * NWAVES); }
        }
        SEAM(pb + 6);
        if (KIND(7) && IN(pb + 7)) { frame_ptrs(F); phase_ln(F, F.ln2_g + (size_t)l * D, F.ln2_b + (size_t)l * D, Mrows, last, !last, last ? l : l + 1, 0, last ? 0 : 4); }
        if (!last) SEAM(pb + 7);
    }
#undef IN
#undef SEAM
}

extern "C" void kernel_launch(void* const* d_in, const int* in_sizes, int n_in, void* d_out, int out_size, void* d_ws, size_t ws_size, hipStream_t stream) {
    static int grid = 0;
    if (grid == 0) {
        if (n_in != 23 || in_sizes[0] != MLAT * D || out_size != MLAT * D || ws_size < WS_END) {
            fprintf(stderr, "kernel_launch: unexpected shapes / workspace (n_in %d, in0 %d, out %d, ws %zu, need %zu); nothing launched\n", n_in, n_in > 0 ? in_sizes[0] : -1, out_size, ws_size, (size_t)WS_END); grid = -1; return; }
        int dev = 0, cus = 0, per_cu = 0;
        if (hipGetDevice(&dev) != hipSuccess || hipDeviceGetAttribute(&cus, hipDeviceAttributeMultiprocessorCount, dev) != hipSuccess) { grid = -1; return; }
        if (hipFuncSetAttribute((const void*)fwd, hipFuncAttributeMaxDynamicSharedMemorySize, LDS_BYTES) != hipSuccess) { fprintf(stderr, "kernel_launch: hipFuncSetAttribute failed\n"); grid = -1; return; }
        if (hipOccupancyMaxActiveBlocksPerMultiprocessor(&per_cu, (const void*)fwd, NWAVES * 64, LDS_BYTES) != hipSuccess || per_cu < 1) fprintf(stderr, "kernel_launch: occupancy query reports %d\n", per_cu);
        (void)hipGetLastError();
        grid = cus;
    }
    if (grid < 0) return;
    if (hipMemsetAsync((char*)d_ws + WS_CTL, 0, CTL_ZERO_BYTES, stream) != hipSuccess) return;
    Args a{};
    for (int i = 0; i < 23; ++i) a.in[i] = (const float*)d_in[i];
    a.out = (float*)d_out; a.ws = (unsigned char*)d_ws;
    for (int l = 0; l < DEPTH; ++l) a.lam_init[l] = (float)(0.8 - 0.6 * exp(-0.3 * (double)l));
#if MK_ONE_LAUNCH
    a.ph_lo = 0; a.ph_hi = NPHASE;
    hipLaunchKernelGGL(fwd, dim3(grid), dim3(NWAVES * 64), LDS_BYTES, stream, a);
#else
    for (int p = 0; p < NPHASE; ++p) { a.ph_lo = p; a.ph_hi = p + 1; hipLaunchKernelGGL(fwd, dim3(grid), dim3(NWAVES * 64), LDS_BYTES, stream, a); }
#endif
}
```

```cpp
#include <hip/hip_runtime.h>
#include <cstdio>
#include <cstdint>
#include <cmath>
namespace pg8 {
#define PG8_LAS __attribute__((address_space(3)))
typedef unsigned short bf16_t;
typedef short bf16x8 __attribute__((ext_vector_type(8)));
typedef float f32x4 __attribute__((ext_vector_type(4)));
typedef unsigned u32x4 __attribute__((ext_vector_type(4)));
constexpr int BM = 256, BK = 64, HALF = 128, HTB = HALF * BK * 2  , STAGE_BYTES = 8 * HTB, NXCD = 8, WGM = 8;

__host__ __device__ __forceinline__ int lds_byte(int r, int c) { const int st = (r >> 4) * 2 + (c >> 5), rr = r & 15, cc = c & 31, ob = rr * 64 + cc * 2; return st * 1024 + (ob ^ (((ob >> 9) & 1) << 5)); }
__host__ __device__ __forceinline__ void stage_rc(int b, int& R, int& C) { const int st = b / 1024, sb = b % 1024, swz = sb ^ (((sb >> 9) & 1) << 5); R = (st >> 1) * 16 + swz / 64; C = (st & 1) * 32 + (swz % 64) / 2; }
__host__ __device__ __forceinline__ int perm32(int rho) { const int n = rho >> 4, i = rho & 15; return 8 * (i >> 2) + 4 * n + (i & 3); }

struct Unit { int pm, pn, ka; };
struct Gemm { const bf16_t* A; const bf16_t* Bt; int M, N, K, lda, ldb; };

struct StaticOrder {
    int nM, nN, nwg, G, c;
    __host__ __device__ void init(int M, int N, int G_, int c_) { nM = M / BM; nN = N / BM; nwg = nM * nN; G = G_; c = c_; }
    __host__ __device__ bool next(int i, Unit& u) const {
        const long L = (long)i * G + c; if (L >= nwg) return false;
        int wgid = (int)L; { const int q = nwg / NXCD, r = nwg % NXCD, xcd = wgid % NXCD, off = wgid / NXCD; wgid = (xcd < r ? xcd * (q + 1) : r * (q + 1) + (xcd - r) * q) + off; }
        const int nig = WGM * nN, gid = wgid / nig, fm = gid * WGM, gsz = (nM - fm) < WGM ? (nM - fm) : WGM;
        u.pm = fm + ((wgid % nig) % gsz); u.pn = (wgid % nig) / gsz; u.ka = 0; return true;
    }
    __device__ __forceinline__ void a_ready(const Unit&) const {}
    __device__ __forceinline__ void done(const Unit&) const {}
};

struct SplitOrder {
    int nsplit, klen, G, c, pm0, ntile;
    __host__ __device__ void init(int pm0_, int ntile_, int nsplit_, int klen_, int G_, int c_) { pm0 = pm0_; ntile = ntile_; nsplit = nsplit_; klen = klen_; G = G_; c = c_; }
    __host__ __device__ bool next(int i, Unit& u) const { const int L = i * G + c; if (L >= ntile * nsplit) return false; const int tt = L / nsplit; u.pm = pm0 + (tt & 3); u.pn = tt >> 2; u.ka = (L - tt * nsplit) * klen; return true; }
    __device__ __forceinline__ void a_ready(const Unit&) const {}
    __device__ __forceinline__ void done(const Unit&) const {}
};
__device__ __forceinline__ unsigned cvt_pk_bf16(float lo, float hi) { unsigned r; asm volatile("v_cvt_pk_bf16_f32 %0, %1, %2" : "=v"(r) : "v"(lo), "v"(hi)); return r; }
typedef float f32x2 __attribute__((ext_vector_type(2)));
__device__ __forceinline__ f32x2 gelu_pk(f32x2 v) {
    const f32x2 av = __builtin_elementwise_abs(v), d = av * 0.2316418882f + 1.0f;
    f32x2 t; t.x = __builtin_amdgcn_rcpf(d.x); t.y = __builtin_amdgcn_rcpf(d.y);
    f32x2 q = t * 0.5307027145f + (-0.7265760135f); q = q * t + 0.7107068705f; q = q * t + (-0.142248368f); q = q * t + 0.127414796f; q = q * t;
    const f32x2 s = (v * v) * (-0.72134752044f);
    f32x2 e; e.x = __builtin_amdgcn_exp2f(s.x); e.y = __builtin_amdgcn_exp2f(s.y);
    const f32x2 m = v * (q * e), r = v - m;
    f32x2 o; o.x = v.x < 0.f ? m.x : r.x; o.y = v.y < 0.f ? m.y : r.y; return o;
}

typedef unsigned u32x2 __attribute__((ext_vector_type(2)));
__device__ __forceinline__ float bf_lo(unsigned w) { return __uint_as_float(w << 16); }
__device__ __forceinline__ float bf_hi(unsigned w) { return __uint_as_float(w & 0xffff0000u); }
__device__ __forceinline__ void store8_bf16(bf16_t* p, const f32x4 v0, const f32x4 v1) {
    u32x4 w; w.x = cvt_pk_bf16(v0[0], v0[1]); w.y = cvt_pk_bf16(v0[2], v0[3]); w.z = cvt_pk_bf16(v1[0], v1[1]); w.w = cvt_pk_bf16(v1[2], v1[3]); *(u32x4*)p = w;
}
__device__ __forceinline__ float sigmoid_f(float x) { return __builtin_amdgcn_rcpf(1.0f + __builtin_amdgcn_exp2f(x * -1.4426950408889634f)); }

struct EpiInProj {
    static constexpr bool PERM = true, AFTER_DRAIN = false; static constexpr int KSEG = 0;
    bf16_t* Z; const float* rope; float qscale; int ldc; int nlat; bf16_t* Kb; bf16_t* Vb;
    __device__ __forceinline__ void kseg(f32x4 (&)[2][2][4][2], const Unit&, int, int, int, int, int) const {}
    __device__ __forceinline__ void operator()(const f32x4 (&acc)[2][2][4][2], const Unit& u, int wr, int wc, int fr, int fq) const {
        const int pn = u.pn; const int row0 = u.pm * BM + wr * 64 + fr; const int col0 = pn * BM + wc * 32 + 8 * fq;
        if (pn < 8) {
            const float sc = pn < 4 ? qscale : 1.0f;
#pragma unroll
            for (int ai = 0; ai < 2; ++ai)
#pragma unroll
                for (int m = 0; m < 4; ++m) {
                    const int row = row0 + ai * HALF + m * 16; const int t = row & 4095; const int pos = (wc & 1) ? (t & 63) : (t >> 6);
                    f32x4 cs0 = *(const f32x4*)(rope + (pos * 16 + 4 * fq) * 2), cs1 = *(const f32x4*)(rope + (pos * 16 + 4 * fq) * 2 + 4);
                    if (row >= nlat) { cs0 = (f32x4){1.f, 0.f, 1.f, 0.f}; cs1 = cs0; }
                    bf16_t* rowp = Z + (size_t)row * ldc + col0;
                    if (pn >= 4) { const int bb = row < nlat ? (row >> 12) : ((row - nlat) >> 8), key = row < nlat ? 256 + (row & 4095) : ((row - nlat) & 255);
                        rowp = Kb + ((size_t)(bb * 8 + 2 * (pn - 4)) * 4352 + key) * 128 + wc * 32 + 8 * fq; }
#pragma unroll
                    for (int bj = 0; bj < 2; ++bj) {
                        const f32x4 a = acc[ai][bj][m][0], b = acc[ai][bj][m][1];
                        f32x4 o0, o1;
                        o0[0] = (a[0] * cs0[0] - a[1] * cs0[1]) * sc; o0[1] = (a[0] * cs0[1] + a[1] * cs0[0]) * sc;
                        o0[2] = (a[2] * cs0[2] - a[3] * cs0[3]) * sc; o0[3] = (a[2] * cs0[3] + a[3] * cs0[2]) * sc;
                        o1[0] = (b[0] * cs1[0] - b[1] * cs1[1]) * sc; o1[1] = (b[0] * cs1[1] + b[1] * cs1[0]) * sc;
                        o1[2] = (b[2] * cs1[2] - b[3] * cs1[3]) * sc; o1[3] = (b[2] * cs1[3] + b[3] * cs1[2]) * sc;
                        store8_bf16(rowp + (pn >= 4 ? (size_t)bj * 4352 * 128 : (size_t)bj * HALF), o0, o1);
                    }
                }
        } else if (pn < 12) {
#pragma unroll
            for (int ai = 0; ai < 2; ++ai)
#pragma unroll
                for (int m = 0; m < 4; ++m) { const int row = row0 + ai * HALF + m * 16; const int bb = row < nlat ? (row >> 12) : ((row - nlat) >> 8), key = row < nlat ? 256 + (row & 4095) : ((row - nlat) & 255);
                    bf16_t* rowp = Vb + ((size_t)(bb * 8 + 2 * (pn - 8)) * 4352 + key) * 128 + wc * 32 + 8 * fq;
#pragma unroll
                    for (int bj = 0; bj < 2; ++bj) store8_bf16(rowp + (size_t)bj * 4352 * 128, acc[ai][bj][m][0], acc[ai][bj][m][1]); }
        } else if (pn >= 20 && pn < 24) {
#pragma unroll
            for (int ai = 0; ai < 2; ++ai)
#pragma unroll
                for (int m = 0; m < 4; ++m) { bf16_t* rowp = Z + (size_t)(row0 + ai * HALF + m * 16) * ldc + col0;
#pragma unroll
                    for (int bj = 0; bj < 2; ++bj) store8_bf16(rowp + bj * HALF, acc[ai][bj][m][0], acc[ai][bj][m][1]); }
        } else if (pn < 20) {
#pragma unroll
            for (int ai = 0; ai < 2; ++ai)
#pragma unroll
                for (int m = 0; m < 4; ++m) { bf16_t* rowp = Z + (size_t)(row0 + ai * HALF + m * 16) * ldc + col0;
#pragma unroll
                    for (int bj = 0; bj < 2; ++bj) { const f32x4 v0 = acc[ai][bj][m][0], v1 = acc[ai][bj][m][1];
                        const f32x2 a = gelu_pk((f32x2){v0[0], v0[1]}), b = gelu_pk((f32x2){v0[2], v0[3]}), c = gelu_pk((f32x2){v1[0], v1[1]}), d = gelu_pk((f32x2){v1[2], v1[3]});
                        store8_bf16(rowp + bj * HALF, (f32x4){a.x, a.y, b.x, b.y}, (f32x4){c.x, c.y, d.x, d.y}); } }
        } else {
#pragma unroll
            for (int ai = 0; ai < 2; ++ai)
#pragma unroll
                for (int m = 0; m < 4; ++m) { bf16_t* rowp = Z + (size_t)(row0 + ai * HALF + m * 16) * ldc + col0;
#pragma unroll
                    for (int bj = 0; bj < 2; ++bj) { const f32x4 v0 = acc[ai][bj][m][0], v1 = acc[ai][bj][m][1]; f32x4 o0, o1;
#pragma unroll
                        for (int i = 0; i < 4; ++i) { o0[i] = __builtin_fmaxf(sigmoid_f(v0[i]), 1e-12f); o1[i] = __builtin_fmaxf(sigmoid_f(v1[i]), 1e-12f); }
                        store8_bf16(rowp + bj * HALF, o0, o1); } }
        }
    }
};

struct EpiGate {
    static constexpr bool PERM = true, AFTER_DRAIN = false; static constexpr int KSEG = 16;
    const bf16_t* G; int ldg; bf16_t* O; int ldo;
    __device__ __forceinline__ void kseg(f32x4 (&acc)[2][2][4][2], const Unit& u, int seg, int wr, int wc, int fr, int fq) const {
        const int row0 = u.pm * BM + wr * 64 + fr; const int col0 = u.pn * BM + wc * 32 + 8 * fq;
#pragma unroll
        for (int ai = 0; ai < 2; ++ai) {
            u32x4 ga[4][2], gb[4][2];
#pragma unroll
            for (int m = 0; m < 4; ++m) { const bf16_t* gp = G + (size_t)(row0 + ai * HALF + m * 16) * ldg + (seg - 1) * 2048 + col0;
#pragma unroll
                for (int bj = 0; bj < 2; ++bj) { ga[m][bj] = *(const u32x4*)(gp + bj * HALF); gb[m][bj] = *(const u32x4*)(gp + 2048 + bj * HALF); } }
#pragma unroll
            for (int m = 0; m < 4; ++m)
#pragma unroll
                for (int bj = 0; bj < 2; ++bj) { const u32x4 a = ga[m][bj], b = gb[m][bj];
                    f32x4 r0, r1;
                    r0[0] = bf_lo(a.x) * __builtin_amdgcn_rcpf(bf_lo(b.x)); r0[1] = bf_hi(a.x) * __builtin_amdgcn_rcpf(bf_hi(b.x));
                    r0[2] = bf_lo(a.y) * __builtin_amdgcn_rcpf(bf_lo(b.y)); r0[3] = bf_hi(a.y) * __builtin_amdgcn_rcpf(bf_hi(b.y));
                    r1[0] = bf_lo(a.z) * __builtin_amdgcn_rcpf(bf_lo(b.z)); r1[1] = bf_hi(a.z) * __builtin_amdgcn_rcpf(bf_hi(b.z));
                    r1[2] = bf_lo(a.w) * __builtin_amdgcn_rcpf(bf_lo(b.w)); r1[3] = bf_hi(a.w) * __builtin_amdgcn_rcpf(bf_hi(b.w));
                    acc[ai][bj][m][0] *= r0; acc[ai][bj][m][1] *= r1; }
            asm volatile("" ::: "memory"); }
    }
    __device__ __forceinline__ void operator()(const f32x4 (&acc)[2][2][4][2], const Unit& u, int wr, int wc, int fr, int fq) const {
        const int row0 = u.pm * BM + wr * 64 + fr; const int col0 = u.pn * BM + wc * 32 + 8 * fq;
        u32x4 gg[2][4][2];
#pragma unroll
        for (int ai = 0; ai < 2; ++ai)
#pragma unroll
            for (int m = 0; m < 4; ++m) { const bf16_t* gp = G + (size_t)(row0 + ai * HALF + m * 16) * ldg + 2 * 2048 + col0;
#pragma unroll
                for (int bj = 0; bj < 2; ++bj) gg[ai][m][bj] = *(const u32x4*)(gp + bj * HALF); }
#pragma unroll
        for (int ai = 0; ai < 2; ++ai)
#pragma unroll
            for (int m = 0; m < 4; ++m) { bf16_t* op = O + (size_t)(row0 + ai * HALF + m * 16) * ldo + col0;
#pragma unroll
                for (int bj = 0; bj < 2; ++bj) { const u32x4 g = gg[ai][m][bj];
                    const f32x4 g0 = (f32x4){bf_lo(g.x), bf_hi(g.x), bf_lo(g.y), bf_hi(g.y)}, g1 = (f32x4){bf_lo(g.z), bf_hi(g.z), bf_lo(g.w), bf_hi(g.w)};
                    store8_bf16(op + bj * HALF, acc[ai][bj][m][0] * g0, acc[ai][bj][m][1] * g1); } }
    }
};

template <bool SLAB> struct EpiResidT {
    static constexpr bool PERM = !SLAB, AFTER_DRAIN = false; static constexpr int KSEG = 0;
    const float* gv; int gstride; void* Tw; int ldc; int klen, nlat;
    __device__ __forceinline__ void kseg(f32x4 (&)[2][2][4][2], const Unit&, int, int, int, int, int) const {}
    __device__ __forceinline__ void operator()(const f32x4 (&acc)[2][2][4][2], const Unit& u, int wr, int wc, int fr, int fq) const {
        const int row0 = u.pm * BM + wr * 64 + fr; const int grp = u.pm < 64 ? (u.pm >> 4) : 4;
        if constexpr (SLAB) {
            const int col0 = u.pn * BM + wc * 32 + 4 * fq;
            f32x4 g[2][2];
#pragma unroll
            for (int bj = 0; bj < 2; ++bj)
#pragma unroll
                for (int n = 0; n < 2; ++n) g[bj][n] = *(const f32x4*)(gv + (size_t)grp * gstride + col0 + bj * HALF + n * 16);
#pragma unroll
            for (int ai = 0; ai < 2; ++ai)
#pragma unroll
                for (int m = 0; m < 4; ++m) { float* pp = (float*)Tw + ((size_t)(u.ka / klen) * 1024 + (size_t)(row0 + ai * HALF + m * 16 - nlat)) * ldc + col0;
#pragma unroll
                    for (int bj = 0; bj < 2; ++bj)
#pragma unroll
                        for (int n = 0; n < 2; ++n) *(f32x4*)(pp + bj * HALF + n * 16) = g[bj][n] * acc[ai][bj][m][n]; }
        } else {
            const int col0 = u.pn * BM + wc * 32 + 8 * fq;
            f32x4 g[2][2];
#pragma unroll
            for (int bj = 0; bj < 2; ++bj)
#pragma unroll
                for (int n = 0; n < 2; ++n) g[bj][n] = *(const f32x4*)(gv + (size_t)grp * gstride + col0 + bj * HALF + n * 4);
#pragma unroll
            for (int ai = 0; ai < 2; ++ai)
#pragma unroll
                for (int m = 0; m < 4; ++m) { bf16_t* tp = (bf16_t*)Tw + (size_t)(row0 + ai * HALF + m * 16) * ldc + col0;
#pragma unroll
                    for (int bj = 0; bj < 2; ++bj) store8_bf16(tp + bj * HALF, g[bj][0] * acc[ai][bj][m][0], g[bj][1] * acc[ai][bj][m][1]); }
        }
    }
};

struct EpiSwiglu {
    static constexpr bool PERM = true, AFTER_DRAIN = false; static constexpr int KSEG = 0;
    bf16_t* H; int ldc;
    __device__ __forceinline__ void kseg(f32x4 (&)[2][2][4][2], const Unit&, int, int, int, int, int) const {}
    __device__ __forceinline__ void operator()(const f32x4 (&acc)[2][2][4][2], const Unit& u, int wr, int wc, int fr, int fq) const {
        const int row0 = u.pm * BM + wr * 64 + fr, col0 = u.pn * HALF + wc * 32 + 8 * fq;
#pragma unroll
        for (int ai = 0; ai < 2; ++ai)
#pragma unroll
            for (int m = 0; m < 4; ++m) { bf16_t* rowp = H + (size_t)(row0 + ai * HALF + m * 16) * ldc + col0; f32x4 o[2];
#pragma unroll
                for (int n = 0; n < 2; ++n) { const f32x4 gt = acc[ai][0][m][n], up = acc[ai][1][m][n];
#pragma unroll
                    for (int i = 0; i < 4; ++i) o[n][i] = gt[i] * sigmoid_f(gt[i]) * up[i]; }
                store8_bf16(rowp, o[0], o[1]); }
    }
};
template <class Epi, class Sched, bool ALIGN_EPI = false, bool SP2 = false>
__device__ __forceinline__ void gemm_phase(PG8_LAS unsigned char* lds, const Gemm g, const Sched& S, const Epi& E) {
    int tid_ = threadIdx.x; asm volatile("" : "+v"(tid_));
    const int tid = tid_, wid = __builtin_amdgcn_readfirstlane(tid >> 6), lane = tid & 63, wr = wid >> 2, wc = wid & 3, fr = lane & 15, fq = lane >> 4;
    const int K = g.K, nt = K / BK;
    unsigned voffA[2], voffB[2];
#pragma unroll
    for (int i = 0; i < 2; ++i) { int R, C; stage_rc(tid * 16 + i * 8192, R, C); const int Rb = Epi::PERM ? ((R & ~31) + perm32(R & 31)) : R;
        voffA[i] = (unsigned)(R * g.lda + C) * 2u; voffB[i] = (unsigned)(Rb * g.ldb + C) * 2u; }
    const size_t kstep = (size_t)(BK * 2);
    const size_t hstepA = (size_t)HALF * g.lda * 2, hstepB = (size_t)HALF * g.ldb * 2;
    const size_t tstepA = 2 * hstepA, tstepB = 2 * hstepB;
    const unsigned ldsw = (unsigned)wid * 1024u;
    const int aoff = lds_byte(wr * 64 + fr, fq * 8), boff = lds_byte(wc * 32 + fr, fq * 8);
#define PG8_SA(b, h) (((b) * 2 + (h)) * HTB)
#define PG8_SB(b, h) ((4 + (b) * 2 + (h)) * HTB)
#define PG8_STAGE(bufoff, gbase, voff) do { _Pragma("unroll") for (int _i = 0; _i < 2; ++_i) \
        __builtin_amdgcn_global_load_lds((const unsigned*)((const char*)(gbase) + (voff)[_i]), (PG8_LAS unsigned*)(lds + (bufoff) + ldsw + _i * 8192), 16, 0, 0); } while (0)
#define PG8_LDA(dst, b, h) do { _Pragma("unroll") for (int m = 0; m < 4; ++m) _Pragma("unroll") for (int k = 0; k < 2; ++k) dst[m][k] = *(const PG8_LAS bf16x8*)(lds + PG8_SA(b, h) + aoff + m * 2048 + k * 1024); } while (0)
#define PG8_LDB(dst, b, h) do { _Pragma("unroll") for (int n = 0; n < 2; ++n) _Pragma("unroll") for (int k = 0; k < 2; ++k) dst[n][k] = *(const PG8_LAS bf16x8*)(lds + PG8_SB(b, h) + boff + n * 2048 + k * 1024); } while (0)
#define PG8_MMA(ai, bj, At, Bt) do { __builtin_amdgcn_s_setprio(1); _Pragma("unroll") for (int m = 0; m < 4; ++m) _Pragma("unroll") for (int n = 0; n < 2; ++n) _Pragma("unroll") for (int k = 0; k < 2; ++k) \
        acc[ai][bj][m][n] = __builtin_amdgcn_mfma_f32_16x16x32_bf16(Bt[n][k], At[m][k], acc[ai][bj][m][n], 0, 0, 0); __builtin_amdgcn_s_setprio(0); } while (0)
#define PG8_WAIT_V(n) asm volatile("s_waitcnt vmcnt(" #n ")" ::: "memory")
#define PG8_WAIT_L(n) asm volatile("s_waitcnt lgkmcnt(" #n ")" ::: "memory")
#define PG8_BAR __builtin_amdgcn_s_barrier()
#define PG8_SCHED __builtin_amdgcn_sched_barrier(0)
    Unit cur, nxt; int ui = 0;
    if (!S.next(0, cur)) return;
    f32x4 acc[2][2][4][2];
#pragma unroll
    for (int a = 0; a < 2; ++a)
#pragma unroll
        for (int b = 0; b < 2; ++b)
#pragma unroll
            for (int m = 0; m < 4; ++m)
#pragma unroll
                for (int n = 0; n < 2; ++n) acc[a][b][m][n] = (f32x4){0.f, 0.f, 0.f, 0.f};
    bf16x8 At[4][2], B0[2][2], B1[2][2];
    const char* cA = (const char*)g.A + (size_t)cur.pm * tstepA + (size_t)cur.ka * 2; const char* cB = (const char*)g.Bt + (size_t)cur.pn * tstepB + (size_t)cur.ka * 2;
    S.a_ready(cur);
    if constexpr (SP2) {
        PG8_STAGE(PG8_SB(0, 0), cB, voffB); PG8_STAGE(PG8_SB(0, 1), cB + hstepB, voffB); PG8_STAGE(PG8_SA(0, 0), cA, voffA); PG8_STAGE(PG8_SA(0, 1), cA + hstepA, voffA);
        if (wr == 1) PG8_BAR;
        PG8_WAIT_V(2); PG8_BAR;
        PG8_STAGE(PG8_SB(1, 0), cB + kstep, voffB); PG8_STAGE(PG8_SA(1, 0), cA + kstep, voffA); PG8_STAGE(PG8_SB(1, 1), cB + hstepB + kstep, voffB);
        PG8_WAIT_V(6); PG8_BAR;
    } else {
        PG8_STAGE(PG8_SB(0, 0), cB, voffB); PG8_STAGE(PG8_SA(0, 0), cA, voffA); PG8_STAGE(PG8_SB(0, 1), cB + hstepB, voffB); PG8_STAGE(PG8_SA(0, 1), cA + hstepA, voffA);
        if (wr == 1) PG8_BAR;
        PG8_WAIT_V(4); PG8_BAR;
        PG8_STAGE(PG8_SB(1, 0), cB + kstep, voffB); PG8_STAGE(PG8_SA(1, 0), cA + kstep, voffA); PG8_STAGE(PG8_SB(1, 1), cB + hstepB + kstep, voffB);
        PG8_WAIT_V(6); PG8_BAR;
    }
    for (;;) {
        const bool has_next = S.next(ui + 1, nxt);
        const char* nA = has_next ? (const char*)g.A + (size_t)nxt.pm * tstepA + (size_t)nxt.ka * 2 : cA; const char* nB = has_next ? (const char*)g.Bt + (size_t)nxt.pn * tstepB + (size_t)nxt.ka * 2 : cB;
        for (int t = 0; t < nt; t += 2) {
            const bool last = (t == nt - 2);
            if constexpr (Epi::KSEG > 0) { if (t > 0 && (t % Epi::KSEG) == 0) E.kseg(acc, cur, t / Epi::KSEG, wr, wc, fr, fq); }
            const char* a1 = cA + (size_t)(t + 1) * kstep;
            const char* a2 = last ? nA : cA + (size_t)(t + 2) * kstep; const char* b2 = last ? nB : cB + (size_t)(t + 2) * kstep;
            const char* a3 = a2 + kstep; const char* b3 = b2 + kstep;
            if (last && has_next) S.a_ready(nxt);
            if constexpr (SP2) {
            PG8_LDB(B0, 0, 0); PG8_LDB(B1, 0, 1); PG8_SCHED; PG8_LDA(At, 0, 0); PG8_STAGE(PG8_SA(1, 1), a1 + hstepA, voffA);
            PG8_WAIT_V(8); PG8_WAIT_L(0); PG8_BAR; PG8_MMA(0, 0, At, B0); PG8_MMA(0, 1, At, B1); PG8_BAR; PG8_SCHED;
            PG8_LDA(At, 0, 1); PG8_STAGE(PG8_SB(0, 0), b2, voffB); PG8_STAGE(PG8_SB(0, 1), b2 + hstepB, voffB); PG8_STAGE(PG8_SA(0, 0), a2, voffA);
            PG8_WAIT_V(8); PG8_WAIT_L(0); PG8_BAR; PG8_MMA(1, 0, At, B0); PG8_MMA(1, 1, At, B1); PG8_BAR; PG8_SCHED;
            PG8_LDB(B0, 1, 0); PG8_LDB(B1, 1, 1); PG8_SCHED; PG8_LDA(At, 1, 0); PG8_STAGE(PG8_SA(0, 1), a2 + hstepA, voffA);
            PG8_WAIT_V(8); PG8_WAIT_L(0); PG8_BAR; PG8_MMA(0, 0, At, B0); PG8_MMA(0, 1, At, B1); PG8_BAR; PG8_SCHED;
            PG8_LDA(At, 1, 1); PG8_STAGE(PG8_SB(1, 0), b3, voffB); PG8_STAGE(PG8_SB(1, 1), b3 + hstepB, voffB); PG8_STAGE(PG8_SA(1, 0), a3, voffA);
            PG8_WAIT_V(8); PG8_WAIT_L(0); PG8_BAR; PG8_MMA(1, 0, At, B0); PG8_MMA(1, 1, At, B1); PG8_BAR; PG8_SCHED;
            } else {
            PG8_LDB(B0, 0, 0); PG8_SCHED; PG8_LDA(At, 0, 0); PG8_STAGE(PG8_SA(1, 1), a1 + hstepA, voffA);
            PG8_WAIT_L(8); PG8_BAR; PG8_WAIT_L(0); PG8_MMA(0, 0, At, B0); PG8_BAR; PG8_SCHED;
            PG8_LDB(B1, 0, 1); PG8_STAGE(PG8_SB(0, 0), b2, voffB);
            PG8_BAR; PG8_WAIT_L(0); PG8_MMA(0, 1, At, B1); PG8_BAR;
            PG8_LDA(At, 0, 1); PG8_STAGE(PG8_SA(0, 0), a2, voffA);
            PG8_BAR; PG8_WAIT_L(0); PG8_MMA(1, 0, At, B0); PG8_BAR; PG8_SCHED;
            PG8_STAGE(PG8_SB(0, 1), b2 + hstepB, voffB);
            PG8_WAIT_V(6); PG8_BAR; PG8_MMA(1, 1, At, B1); PG8_BAR;
            PG8_LDB(B0, 1, 0); PG8_SCHED; PG8_LDA(At, 1, 0); PG8_STAGE(PG8_SA(0, 1), a2 + hstepA, voffA);
            PG8_WAIT_L(8); PG8_BAR; PG8_WAIT_L(0); PG8_MMA(0, 0, At, B0); PG8_BAR; PG8_SCHED;
            PG8_LDB(B1, 1, 1); PG8_STAGE(PG8_SB(1, 0), b3, voffB);
            PG8_BAR; PG8_WAIT_L(0); PG8_MMA(0, 1, At, B1); PG8_BAR;
            PG8_LDA(At, 1, 1); PG8_STAGE(PG8_SA(1, 0), a3, voffA);
            PG8_BAR; PG8_WAIT_L(0); PG8_MMA(1, 0, At, B0); PG8_BAR; PG8_SCHED;
            PG8_STAGE(PG8_SB(1, 1), b3 + hstepB, voffB);
            PG8_WAIT_V(6); PG8_BAR; PG8_MMA(1, 1, At, B1); PG8_BAR;
            }
        }
        if constexpr (ALIGN_EPI) { if (wr == 0) PG8_BAR; }
        if constexpr (!Epi::AFTER_DRAIN) { E(acc, cur, wr, wc, fr, fq); S.done(cur); }
        if (!has_next) break;
#pragma unroll
        for (int a = 0; a < 2; ++a)
#pragma unroll
            for (int b = 0; b < 2; ++b)
#pragma unroll
                for (int m = 0; m < 4; ++m)
#pragma unroll
                    for (int n = 0; n < 2; ++n) acc[a][b][m][n] = (f32x4){0.f, 0.f, 0.f, 0.f};
        cur = nxt; cA = nA; cB = nB; ++ui;
        if constexpr (ALIGN_EPI) { if (wr == 1) PG8_BAR; }
    }
    PG8_WAIT_V(0);
    if constexpr (!ALIGN_EPI) { if (wr == 0) PG8_BAR; }
    PG8_BAR;
    if constexpr (Epi::AFTER_DRAIN) { E.fused(acc, cur, wr, wc, fr, fq, lds, wid, lane); S.done(cur); }
#undef PG8_SA
#undef PG8_SB
#undef PG8_STAGE
#undef PG8_LDA
#undef PG8_LDB
#undef PG8_MMA
#undef PG8_WAIT_V
#undef PG8_WAIT_L
#undef PG8_BAR
#undef PG8_SCHED
}
}

constexpr int NWAVES = 8;
constexpr int D = 2048, NBATCH = 4, SEQ = 4096, DEPTH = 4, CTXL = 256;
constexpr int MLAT = NBATCH * SEQ, MCTX = NBATCH * CTXL, MTOT = MLAT + MCTX;
constexpr int INW = 12288, BW = 1024, FFH = 5632, NHEAD = 8;
constexpr int Q_OFF = 0, K_OFF = 1024, V_OFF = 2048, BU_OFF = 3072, C_OFF = 5120, G_OFF = 6144;
constexpr int YW = 3 * BW;
constexpr float LN_EPS = 1e-6f;
constexpr float ALPHA = 1.681792830507429f;
constexpr float QSCALE = 0.125f * 1.4426950408889634f;

constexpr size_t MiB = 1u << 20;
constexpr size_t WS_CTL = 0, CTL_ZERO_BYTES = 1 * MiB;
constexpr size_t WS_ROPE = 1 * MiB;
constexpr size_t WS_MODS = 2 * MiB;
constexpr size_t WS_MODP = 4 * MiB;
constexpr size_t WS_WSP = 20 * MiB;
constexpr size_t WS_WPOOL = 21 * MiB;
constexpr size_t WS_WIN = 24 * MiB;
constexpr size_t WS_WBR = 216 * MiB;
constexpr size_t WS_WOUT = 264 * MiB;
constexpr size_t WS_WGU = 296 * MiB;
constexpr size_t WS_WDN = 472 * MiB;
constexpr size_t WS_X = 560 * MiB;
constexpr size_t WS_HA = 696 * MiB;
constexpr size_t WS_Y = 764 * MiB;
constexpr size_t WS_MG = 866 * MiB;
constexpr size_t WS_Z = 934 * MiB;
constexpr size_t WS_KB = 1342 * MiB, WS_VB = 1378 * MiB;
constexpr size_t WS_END = 1414 * MiB;
static_assert(WS_MODP + 16ull * 4 * 5 * 12288 * 4 <= WS_WSP && WS_WIN + 4ull * 12288 * 2048 * 2 <= WS_WBR && WS_WBR + 4ull * 2048 * 3072 * 2 <= WS_WOUT && WS_WOUT + 4ull * 2048 * 2048 * 2 <= WS_WGU, "ws map 1");
static_assert(WS_WGU + 4ull * 11264 * 2048 * 2 <= WS_WDN && WS_WDN + 4ull * 2048 * 5632 * 2 <= WS_X && WS_X + (size_t)MTOT * D * 4 <= WS_HA && WS_HA + (size_t)MTOT * D * 2 <= WS_Y, "ws map 2");
static_assert(WS_Y + (size_t)MTOT * YW * 2 <= WS_MG && WS_MG + (size_t)MTOT * D * 2 <= WS_Z && WS_Z + (size_t)MTOT * INW * 2 <= WS_KB && WS_KB + 32ull * 4352 * 256 <= WS_VB && WS_VB + 32ull * 4352 * 256 <= WS_END, "ws map 3");
constexpr int CW_BAR = 4096;

constexpr int RING_OFF = 0, RING_BYTES = 131072;
constexpr int LDSCTL_OFF = RING_BYTES, MISC_OFF = LDSCTL_OFF + 320;
constexpr int LDS_BYTES = 147456;

#define GAS __attribute__((address_space(1)))
#define LAS __attribute__((address_space(3)))
typedef unsigned short bf16;
typedef unsigned v4u __attribute__((ext_vector_type(4)));
typedef unsigned v2u __attribute__((ext_vector_type(2)));
typedef float f32x4 __attribute__((ext_vector_type(4)));
typedef float f32x16 __attribute__((ext_vector_type(16)));
typedef short bf16x8 __attribute__((ext_vector_type(8)));
typedef short s16x4 __attribute__((ext_vector_type(4)));
typedef GAS unsigned gu32;
#define RLX_AGENT __ATOMIC_RELAXED, __HIP_MEMORY_SCOPE_AGENT
#define LDS_WAIT() asm volatile("s_waitcnt lgkmcnt(0)" ::: "memory")
#define VM_WAIT() asm volatile("s_waitcnt vmcnt(0)" ::: "memory")
__device__ __forceinline__ unsigned f2bf(float f) { unsigned u = __builtin_bit_cast(unsigned, f); return (u + 0x7fffu + ((u >> 16) & 1u)) >> 16; }
__device__ __forceinline__ unsigned pk2(float lo, float hi) { return f2bf(lo) | (f2bf(hi) << 16); }
__device__ __forceinline__ unsigned cvtpk(float lo, float hi) { unsigned r; asm volatile("v_cvt_pk_bf16_f32 %0, %1, %2" : "=v"(r) : "v"(lo), "v"(hi)); return r; }
__device__ __forceinline__ float bflo(unsigned w) { return __uint_as_float(w << 16); }
__device__ __forceinline__ float bfhi(unsigned w) { return __uint_as_float(w & 0xffff0000u); }

#define XB_TMO      128
#define XB_XCNT(j)  (256  + 64 * (j))
#define XB_XSUB(j)  (1280 + 64 * (j))
#define XB_XGEN(j)  (2304 + 64 * (j))
#define XB_TOP      3328
#define XB_TOPGEN   3392
#define XCD_BAR_WORDS 3456
#define XB_SPIN_CAP (1u << 18)

__device__ __forceinline__ unsigned xb_ld(unsigned* p)              { return __hip_atomic_load(p, __ATOMIC_RELAXED, __HIP_MEMORY_SCOPE_AGENT); }
__device__ __forceinline__ unsigned xb_add(unsigned* p, unsigned v) { return __hip_atomic_fetch_add(p, v, __ATOMIC_RELAXED, __HIP_MEMORY_SCOPE_AGENT); }
__device__ __forceinline__ unsigned xb_xcc_id() { return (unsigned)__builtin_amdgcn_s_getreg((3 << 11) | 20) & 0xFu; }
#define XB_SPIN(cond, bar) do { unsigned _sp = 0; while (cond) { __builtin_amdgcn_s_sleep(1); \
    if ((++_sp & 255u) == 0u) { if (xb_ld(&(bar)[XB_TMO])) break; if (_sp > XB_SPIN_CAP) { atomicAdd(&(bar)[XB_TMO], 1u); break; } } } } while (0)

struct XcdBarrier {
    unsigned* bar; unsigned x;
    volatile LAS unsigned* st;
};

__device__ __forceinline__ XcdBarrier xcd_barrier_post(unsigned* bar, volatile LAS unsigned* st) {
    XcdBarrier b; b.bar = bar; b.x = xb_xcc_id(); b.st = st;
    if (threadIdx.x == 0) (void)xb_add(&bar[XB_XCNT(b.x)], 1u);
    return b;
}
__device__ __forceinline__ void xcd_barrier_complete(unsigned* bar, unsigned x, unsigned& nloc, unsigned& nx) {
    const unsigned G = gridDim.x * gridDim.y * gridDim.z;
    unsigned sum, cnt, mine, sp = 0u;
    for (;;) {
        sum = 0u; cnt = 0u; mine = 0u;
#pragma unroll
        for (unsigned j = 0; j < 16; ++j) { const unsigned c = xb_ld(&bar[XB_XCNT(j)]); sum += c; cnt += (c > 0u) ? 1u : 0u; mine = (j == x) ? c : mine; }
        if (sum == G) break;
        __builtin_amdgcn_s_sleep(1);
        if ((++sp & 255u) == 0u) { if (xb_ld(&bar[XB_TMO])) break; if (sp > XB_SPIN_CAP) { atomicAdd(&bar[XB_TMO], 1u); break; } }
    }
    nloc = mine > 0u ? mine : 1u; nx = cnt > 0u ? cnt : 1u;
}

__device__ __forceinline__ void xcd_barrier(const XcdBarrier& b) {
    asm volatile("s_waitcnt vmcnt(0)" ::: "memory");
    __syncthreads();
    if (threadIdx.x == 0) {
        unsigned* bar = b.bar;
        __builtin_amdgcn_s_waitcnt(0);
        unsigned nloc = b.st[0], nx = b.st[1];
        if (nloc == 0u) { xcd_barrier_complete(bar, b.x, nloc, nx); b.st[0] = nloc; b.st[1] = nx; }
        const unsigned old = xb_add(&bar[XB_XSUB(b.x)], 1u);
        const unsigned gen = old / nloc;
        if (old + 1u == (gen + 1u) * nloc) {
            __builtin_amdgcn_fence(__ATOMIC_RELEASE, "agent");
            asm volatile("s_waitcnt vmcnt(0)" ::: "memory");
            const unsigned og = xb_add(&bar[XB_TOP], 1u);
            const unsigned tg = og / nx;
            if (og + 1u == (tg + 1u) * nx) xb_add(&bar[XB_TOPGEN], 1u);
            else XB_SPIN(xb_ld(&bar[XB_TOPGEN]) == tg, bar);
            __builtin_amdgcn_fence(__ATOMIC_ACQUIRE, "agent");
            xb_add(&bar[XB_XGEN(b.x)], 1u);
            asm volatile("s_waitcnt vmcnt(0)" ::: "memory");
        } else {
            XB_SPIN(xb_ld(&bar[XB_XGEN(b.x)]) == gen, bar);
            __builtin_amdgcn_fence(__ATOMIC_ACQUIRE, "agent");
            asm volatile("s_waitcnt vmcnt(0)" ::: "memory");
        }
    }
    __syncthreads();
}


struct Frame {
    LAS unsigned char* lds;
    volatile LAS unsigned* MISC;
    gu32* ctl;
    int vcu, G, bx;
    __device__ __forceinline__ int ltid() const { int t = threadIdx.x; asm volatile("" : "+v"(t)); return t; }
    const float *x, *c, *ctx, *cctx, *w_ada, *b_ada, *w_in, *lam_qk, *subln_g, *gln_g, *gln_b, *w_sp, *b_sp, *w_pool, *pool_scale, *w_branch, *w_out, *ln1_g, *ln1_b, *w_gu, *w_down, *ln2_g, *ln2_b;
    float* out;
    float *rope, *mods, *modp, *X;
    bf16 *Wsp, *Wpool, *Win, *Wbr, *Wout, *Wgu, *Wdn, *HA, *Y, *MG, *Z, *KB, *VB;
};

typedef __attribute__((address_space(4))) const unsigned char* kptr_t;
__device__ __forceinline__ void frame_ptrs(Frame& F) {
    kptr_t kp = (kptr_t)__builtin_amdgcn_kernarg_segment_ptr(); asm volatile("" : "+s"(kp));
#define KIN(i) (*(const float* const __attribute__((address_space(4)))*)(kp + 8 * (i)))
    F.x = KIN(0); F.c = KIN(1); F.ctx = KIN(2); F.cctx = KIN(3); F.w_ada = KIN(4); F.b_ada = KIN(5); F.w_in = KIN(6); F.lam_qk = KIN(7); F.subln_g = KIN(8);
    F.gln_g = KIN(9); F.gln_b = KIN(10); F.w_sp = KIN(11); F.b_sp = KIN(12); F.w_pool = KIN(13); F.pool_scale = KIN(14); F.w_branch = KIN(15); F.w_out = KIN(16);
    F.ln1_g = KIN(17); F.ln1_b = KIN(18); F.w_gu = KIN(19); F.w_down = KIN(20); F.ln2_g = KIN(21); F.ln2_b = KIN(22);
#undef KIN
    F.out = *(float* const __attribute__((address_space(4)))*)(kp + 184);
    unsigned char* ws = *(unsigned char* const __attribute__((address_space(4)))*)(kp + 192);
    F.rope = (float*)(ws + WS_ROPE); F.mods = (float*)(ws + WS_MODS); F.modp = (float*)(ws + WS_MODP); F.X = (float*)(ws + WS_X);
    F.Wsp = (bf16*)(ws + WS_WSP); F.Wpool = (bf16*)(ws + WS_WPOOL); F.Win = (bf16*)(ws + WS_WIN); F.Wbr = (bf16*)(ws + WS_WBR); F.Wout = (bf16*)(ws + WS_WOUT); F.Wgu = (bf16*)(ws + WS_WGU); F.Wdn = (bf16*)(ws + WS_WDN);
    F.HA = (bf16*)(ws + WS_HA); F.Y = (bf16*)(ws + WS_Y); F.MG = (bf16*)(ws + WS_MG); F.Z = (bf16*)(ws + WS_Z); F.KB = (bf16*)(ws + WS_KB); F.VB = (bf16*)(ws + WS_VB);
}
__device__ __forceinline__ float wave_sum(float v) {
#pragma unroll
    for (int o = 1; o < 64; o <<= 1) v += __shfl_xor(v, o);
    return v;
}

__device__ __forceinline__ void cvt_item(const float* W, int N, int k0, int ncol0, bool perm, bf16* WT, size_t drow0, int ldk, int dk0, LAS float* scr, int lane) {
#pragma unroll 8
    for (int i = 0; i < 32; ++i) { const int kk = 2 * i + (lane >> 5); scr[kk * 33 + (lane & 31)] = W[(size_t)(k0 + kk) * N + ncol0 + (lane & 31)]; }
    LDS_WAIT(); asm volatile("" ::: "memory");
    const int c = lane & 7;
#pragma unroll
    for (int j = 0; j < 4; ++j) { const int n = (lane >> 3) + 8 * j; const int ns = perm ? ((n & 1) * 16 + (n >> 1)) : n; const LAS float* s = scr + (8 * c) * 33 + ns;
        v4u o; o.x = pk2(s[0 * 33], s[1 * 33]); o.y = pk2(s[2 * 33], s[3 * 33]); o.z = pk2(s[4 * 33], s[5 * 33]); o.w = pk2(s[6 * 33], s[7 * 33]);
        *(GAS v4u*)(WT + (drow0 + n) * (size_t)ldk + dk0 + k0 + 8 * c) = o; }
    LDS_WAIT(); asm volatile("" ::: "memory");
}
constexpr int CV_IN = 32 * 384, CV_GU = 32 * 352, CV_DN = 88 * 64, CV_BR = 3 * 16 * 64, CV_OUT = 32 * 64, CV_POOL = 4 * 4 * 8, CV_LAYER = CV_IN + CV_GU + CV_DN + CV_BR + CV_OUT + CV_POOL;
__device__ __forceinline__ void cvt_dispatch(Frame& F, int it, LAS float* scr) {
    const int l = it / CV_LAYER; int r = it - l * CV_LAYER;
    if (r < CV_IN) { const int kb = r / 384, nb = r - kb * 384;
        cvt_item(F.w_in + (size_t)l * D * INW, INW, 64 * kb, 32 * nb, nb < 64, F.Win + (size_t)l * INW * D, (size_t)32 * nb, D, 0, scr, (F.ltid() & 63)); return; }
    r -= CV_IN;
    if (r < CV_GU) { const int kb = r / 352, nb = r - kb * 352; const int tpn = nb >> 3, half = (nb >> 2) & 1, jj0 = (nb & 3) * 32;
        cvt_item(F.w_gu + (size_t)l * D * 2 * FFH, 2 * FFH, 64 * kb, half * FFH + 128 * tpn + jj0, false, F.Wgu + (size_t)l * 2 * FFH * D, (size_t)32 * nb, D, 0, scr, (F.ltid() & 63)); return; }
    r -= CV_GU;
    if (r < CV_DN) { const int kb = r >> 6, nb = r & 63;
        cvt_item(F.w_down + (size_t)l * FFH * D, D, 64 * kb, 32 * nb, false, F.Wdn + (size_t)l * D * FFH, (size_t)32 * nb, FFH, 0, scr, (F.ltid() & 63)); return; }
    r -= CV_DN;
    if (r < CV_BR) { const int n = r >> 10, rr = r & 1023, kb = rr >> 6, nb = rr & 63;
        cvt_item(F.w_branch + ((size_t)l * 3 + n) * BW * D, D, 64 * kb, 32 * nb, false, F.Wbr + (size_t)l * D * YW, (size_t)32 * nb, YW, BW * n, scr, (F.ltid() & 63)); return; }
    r -= CV_BR;
    if (r < CV_OUT) { const int kb = r >> 6, nb = r & 63;
        cvt_item(F.w_out + (size_t)l * D * D, D, 64 * kb, 32 * nb, false, F.Wout + (size_t)l * D * D, (size_t)32 * nb, D, 0, scr, (F.ltid() & 63)); return; }
    r -= CV_OUT;
    { const int g = r >> 5, rr = r & 31, kb = rr >> 3, nb = rr & 7;
        cvt_item(F.w_pool + ((size_t)l * 4 + g) * 65536, 256, 64 * kb, 32 * nb, false, F.Wpool + ((size_t)l * 4 + g) * 65536, (size_t)32 * nb, 256, 0, scr, (F.ltid() & 63)); }
}

__device__ __forceinline__ double rope_inv(int p) {
    const double t[16] = {1.0, 0.5623413251903491, 0.31622776601683794, 0.1778279410038923, 0.1, 0.05623413251903491, 0.03162277660168379, 0.01778279410038923,
                          0.01, 0.005623413251903491, 0.003162277660168379, 0.001778279410038923, 0.001, 0.0005623413251903491, 0.00031622776601683794, 0.0001778279410038923};
    double r = t[0];
#pragma unroll
    for (int i = 1; i < 16; ++i) r = (p == i) ? t[i] : r;
    return r;
}
#ifndef TAILWORK
#define TAILWORK 0
#endif
__device__ __forceinline__ void ada_partial_layer(Frame& F, int l, int gw, int NGW) {
    LAS float* scs = (LAS float*)(F.lds);
    __syncthreads();
    for (int i = F.ltid(); i < 5 * D; i += NWAVES * 64) { const int g = i >> 11, k = i & 2047; const float v = g < 4 ? F.c[g * D + k] : F.cctx[k]; scs[i] = v / (1.0f + __expf(-v)); }
    __syncthreads();
    for (int it = gw; it < 16 * 48; it += NGW) {
        const int ks = it / 48, cgw = it - ks * 48; const int col = cgw * 256 + (F.ltid() & 63) * 4;
        const float* wp = F.w_ada + ((size_t)l * D + ks * 128) * INW + col;
        f32x4 a0 = {0.f, 0.f, 0.f, 0.f}, a1 = a0, a2 = a0, a3 = a0, a4 = a0;
#pragma unroll 8
        for (int k = 0; k < 128; ++k) { const f32x4 w = *(const GAS f32x4*)(wp + (size_t)k * INW); const int kk = ks * 128 + k;
            a0 += w * scs[kk]; a1 += w * scs[D + kk]; a2 += w * scs[2 * D + kk]; a3 += w * scs[3 * D + kk]; a4 += w * scs[4 * D + kk]; }
        float* pp = F.modp + (((size_t)ks * 4 + l) * 5) * INW + col;
        *(f32x4*)(pp) = a0; *(f32x4*)(pp + INW) = a1; *(f32x4*)(pp + 2 * INW) = a2; *(f32x4*)(pp + 3 * INW) = a3; *(f32x4*)(pp + 4 * INW) = a4;
    }
    __syncthreads();
}
__device__ __forceinline__ void cvt_layer(Frame& F, int l, int gw, int NGW) {
    LAS float* scr = (LAS float*)(F.lds + __builtin_amdgcn_readfirstlane(F.ltid() >> 6) * 16384);
    for (int it = gw; it < CV_LAYER; it += NGW) cvt_dispatch(F, l * CV_LAYER + it, scr);
}
__device__ __forceinline__ void mods_reduce_layer(Frame& F, int l) {
    const int gt = F.vcu * NWAVES * 64 + F.ltid(), NGT = F.G * NWAVES * 64;
    for (int i = gt; i < 5 * (INW / 4); i += NGT) { const int g = i / (INW / 4), j = (i - g * (INW / 4)) * 4;
        f32x4 sm = *(const f32x4*)(F.b_ada + (size_t)l * INW + j);
#pragma unroll
        for (int ks = 0; ks < 16; ++ks) sm += *(const f32x4*)(F.modp + (((size_t)ks * 4 + l) * 5 + g) * INW + j);
        *(f32x4*)(F.mods + ((size_t)l * 5 + g) * INW + j) = sm; }
}
__device__ __forceinline__ void phase_a1(Frame& F) {
    const int gw = F.vcu * NWAVES + __builtin_amdgcn_readfirstlane(F.ltid() >> 6), NGW = F.G * NWAVES;
#pragma nounroll
    for (int l = 0; l < (TAILWORK ? 1 : DEPTH); ++l) ada_partial_layer(F, l, gw, NGW);
#pragma nounroll
    for (int l = 0; l < (TAILWORK ? 1 : DEPTH); ++l) cvt_layer(F, l, gw, NGW);
    for (int it = gw; it < (DEPTH * 8 * 128 * 128) / 512; it += NGW) { const size_t e = (size_t)it * 512 + (F.ltid() & 63) * 8;
        const f32x4 a = *(const f32x4*)(F.w_sp + e), b = *(const f32x4*)(F.w_sp + e + 4);
        v4u o; o.x = pk2(a[0], a[1]); o.y = pk2(a[2], a[3]); o.z = pk2(b[0], b[1]); o.w = pk2(b[2], b[3]); *(v4u*)(F.Wsp + e) = o; }
    if (gw == 0) {
        for (int e = (F.ltid() & 63); e < 1024; e += 64) { const int pos = e >> 4, pr = e & 15;
            const double ang = (double)pos * rope_inv(pr); const double twopi = 6.283185307179586476925286766559;
            const double kq = __builtin_rint(ang / twopi); const double rr = ang - kq * twopi; const double r2 = rr * rr;
            double sn = 1.0, cs = 1.0;
#pragma unroll
            for (int n = 14; n >= 1; --n) { sn = 1.0 - sn * r2 / (double)((2 * n) * (2 * n + 1)); cs = 1.0 - cs * r2 / (double)((2 * n - 1) * (2 * n)); }
            sn *= rr;
            F.rope[2 * e] = (float)cs; F.rope[2 * e + 1] = (float)sn; }
    }
}
__device__ __forceinline__ void phase_a2(Frame& F) {
#pragma nounroll
    for (int l = 0; l < (TAILWORK ? 1 : DEPTH); ++l) mods_reduce_layer(F, l); }
__device__ __forceinline__ void ln_row(const float* src, const bf16* tadd, const float* part, int npart, const float* gam, const float* bet, float* xo, float xs, bf16* ho, const float* sc, const float* sh, int lane) {
    f32x4 v[8]; float s = 0.f;
#pragma unroll
    for (int j = 0; j < 8; ++j) v[j] = *(const GAS f32x4*)(src + 4 * lane + 256 * j);
    if (tadd) {
#pragma unroll
        for (int j = 0; j < 8; ++j) { const v2u t2 = *(const GAS v2u*)(tadd + 4 * lane + 256 * j); v[j] += (f32x4){bflo(t2.x), bfhi(t2.x), bflo(t2.y), bfhi(t2.y)}; } }
    for (int p = 0; p < npart; ++p) {
#pragma unroll
        for (int j = 0; j < 8; ++j) v[j] += *(const GAS f32x4*)(part + (size_t)p * 1024 * D + 4 * lane + 256 * j); }
#pragma unroll
    for (int j = 0; j < 8; ++j) s += (v[j][0] + v[j][1]) + (v[j][2] + v[j][3]);
    const float mean = wave_sum(s) * (1.f / D); float s2 = 0.f;
#pragma unroll
    for (int j = 0; j < 8; ++j) { v[j] = v[j] - mean; s2 += (v[j][0] * v[j][0] + v[j][1] * v[j][1]) + (v[j][2] * v[j][2] + v[j][3] * v[j][3]); }
    const float rstd = 1.0f / sqrtf(wave_sum(s2) * (1.f / D) + LN_EPS);
#pragma unroll
    for (int j = 0; j < 8; ++j) { const int col = 4 * lane + 256 * j; f32x4 xn = v[j] * rstd;
        if (gam) xn = xn * *(const f32x4*)(gam + col) + *(const f32x4*)(bet + col);
        if (xo) *(GAS f32x4*)(xo + col) = xn * xs;
        if (ho) { const f32x4 hv = xn * (1.0f + *(const f32x4*)(sc + col)) + *(const f32x4*)(sh + col); v2u o; o.x = pk2(hv[0], hv[1]); o.y = pk2(hv[2], hv[3]); *(GAS v2u*)(ho + col) = o; } }
}
__device__ __forceinline__ int row_group(int row) { return row < MLAT ? (row >> 12) : 4; }
__device__ __forceinline__ void phase_a3(Frame& F) {
    const int gw = F.vcu * NWAVES + __builtin_amdgcn_readfirstlane(F.ltid() >> 6), NGW = F.G * NWAVES;
    for (int row = gw; row < MTOT; row += NGW) { const float* src = row < MLAT ? F.x + (size_t)row * D : F.ctx + (size_t)(row - MLAT) * D; const float* md = F.mods + (size_t)row_group(row) * INW;
        ln_row(src, nullptr, nullptr, 0, nullptr, nullptr, F.X + (size_t)row * D, ALPHA, F.HA + (size_t)row * D, md + D, md, (F.ltid() & 63)); }
}
__device__ __forceinline__ void phase_ln(Frame& F, const float* gam, const float* bet, int nrows, bool to_out, bool want_h, int lm, int moff, int nsplit) {
    const int gw = F.vcu * NWAVES + __builtin_amdgcn_readfirstlane(F.ltid() >> 6), NGW = F.G * NWAVES;
    for (int row = gw; row < nrows; row += NGW) { const float* md = F.mods + ((size_t)lm * 5 + row_group(row)) * INW + moff;
        ln_row(F.X + (size_t)row * D, row < MLAT ? F.Y + (size_t)row * D : nullptr, (const float*)(F.Z + (size_t)100 * MiB) + (size_t)(row - MLAT) * D, row >= MLAT ? nsplit : 0, gam, bet, to_out ? F.out + (size_t)row * D : F.X + (size_t)row * D, to_out ? 1.0f : ALPHA, want_h ? F.HA + (size_t)row * D : nullptr, md + D, md, (F.ltid() & 63)); }
}

constexpr int AT_KB = 0, AT_VB = 32768, AT_TILE = 16384, AT_XB = 65536;
__device__ __forceinline__ s16x4 vtr(const LAS unsigned char* p) { typedef short v4i16_t __attribute__((ext_vector_type(4))); return __builtin_bit_cast(s16x4, __builtin_amdgcn_ds_read_tr16_b64_v4i16((LAS v4i16_t*)p)); }
__device__ __forceinline__ float max3f(float a, float b, float c) { float r; asm("v_max3_f32 %0, %1, %2, %3" : "=v"(r) : "v"(a), "v"(b), "v"(c)); return r; }
__device__ __forceinline__ void glds16(const void* gsrc, unsigned lds_dst) { unsigned keep;
    asm volatile("s_mov_b32 %0, m0\n\ts_mov_b32 m0, %2\n\ts_nop 0\n\tglobal_load_lds_dwordx4 %1, off\n\ts_mov_b32 m0, %0" : "=&s"(keep) : "v"(gsrc), "s"(lds_dst) : "memory"); }
#define AT_WAITV(n) asm volatile("s_waitcnt vmcnt(" #n ")" ::: "memory")
#define AT_BAR() asm volatile("s_waitcnt lgkmcnt(0)\n\ts_barrier" ::: "memory")
__device__ __forceinline__ void attn_unit(Frame& F, int b, int h, int qb, bool ctxq, float lam, float oscale, const float* subg) {
    int lane_ = (F.ltid() & 63); asm volatile("" : "+v"(lane_));
    const int lane = lane_, wid = __builtin_amdgcn_readfirstlane(F.ltid() >> 6), r32 = lane & 31, hi = lane >> 5, m = wid >> 2, qg = wid & 3; const bool lead = wid < 4;
    const bf16* Z = F.Z;
    const int qrow = (ctxq ? MLAT + b * CTXL : b * SEQ) + qb * 128 + qg * 32 + r32;
    bf16x8 qf[4];
#pragma unroll
    for (int d0 = 0; d0 < 4; ++d0) qf[d0] = *(const GAS bf16x8*)(Z + (size_t)qrow * INW + Q_OFF + h * 128 + m * 64 + d0 * 16 + hi * 8);
    const int NT = ctxq ? 4 : 68;
    const bf16* Kbh = F.KB + (size_t)(b * 8 + h) * 4352 * 128; const bf16* Vbh = F.VB + (size_t)(b * 8 + h) * 4352 * 128;
    const unsigned lds0 = (unsigned)(size_t)F.lds;
    const int prow = 8 * wid + (lane >> 4), ppos = lane & 15;
    const unsigned koff0 = (unsigned)(prow * 128 + ((ppos ^ (prow & 15)) * 8)), koff1 = (unsigned)((prow + 4) * 128 + ((ppos ^ ((prow + 4) & 15)) * 8));
    const unsigned voff0 = (unsigned)(prow * 128 + ((ppos ^ (4 * (prow & 3))) * 8)), voff1 = voff0 + 4 * 128;
    const unsigned kdst = (unsigned)__builtin_amdgcn_readfirstlane((int)(lds0 + AT_KB + wid * 2048)), vdst = (unsigned)__builtin_amdgcn_readfirstlane((int)(lds0 + AT_VB + wid * 2048));
#define AT_DMAK(t, bufo) do { const bf16* tb_ = Kbh + (size_t)(t) * 8192; glds16(tb_ + koff0, kdst + (bufo)); glds16(tb_ + koff1, kdst + (bufo) + 1024); } while (0)
#define AT_DMAV(t, bufo) do { const bf16* tb_ = Vbh + (size_t)(t) * 8192; glds16(tb_ + voff0, vdst + (bufo)); glds16(tb_ + voff1, vdst + (bufo) + 1024); } while (0)
    f32x16 o[4];
#pragma unroll
    for (int db = 0; db < 4; ++db)
#pragma unroll
        for (int r = 0; r < 16; ++r) o[db][r] = 0.f;
    float mref = 0.f, lsum = 0.f;
    f32x16 negm;
#pragma unroll
    for (int r = 0; r < 16; ++r) negm[r] = 0.f;
    const unsigned kaddr0 = AT_KB + r32 * 256 + (((8 * m + hi) ^ (r32 & 15)) << 4);
    const int a4 = (lane & 15) >> 2, cc = 2 * ((lane >> 4) & 1) + ((lane & 3) >> 1);
    const unsigned vaddr0 = AT_VB + (4 * hi + a4) * 256 + ((4 * a4 + cc) << 4) + 8 * (lane & 1);
    __syncthreads();
    AT_DMAK(0, 0); AT_DMAV(0, 0);
    AT_WAITV(2); AT_BAR();
    if (!lead) { if (NT > 1) { AT_DMAK(1, AT_TILE); AT_WAITV(2); } else AT_WAITV(0); AT_BAR(); }
    for (int t = 0; t < NT; ++t) {
        const unsigned bo = (t & 1) ? AT_TILE : 0; const bool more = (t + 1 < NT);
        if (more) { if (lead) AT_DMAK(t + 1, bo ^ AT_TILE); else AT_DMAV(t + 1, bo ^ AT_TILE); }
        unsigned kb_ = kaddr0 + bo, vb_ = vaddr0 + bo; asm volatile("" : "+v"(kb_), "+v"(vb_));
        f32x16 p0, p1;
        { bf16x8 kf[4][2];
#pragma unroll
          for (int d0 = 0; d0 < 4; ++d0) { const unsigned ka = kb_ ^ (unsigned)((2 * d0) << 4); kf[d0][0] = *(const LAS bf16x8*)(F.lds + ka); kf[d0][1] = *(const LAS bf16x8*)(F.lds + ka + 32 * 256); }
          __builtin_amdgcn_sched_barrier(0);
          p0 = __builtin_amdgcn_mfma_f32_32x32x16_bf16(kf[0][0], qf[0], negm, 0, 0, 0);
#pragma unroll
          for (int d0 = 1; d0 < 4; ++d0) p0 = __builtin_amdgcn_mfma_f32_32x32x16_bf16(kf[d0][0], qf[d0], p0, 0, 0, 0);
          p1 = __builtin_amdgcn_mfma_f32_32x32x16_bf16(kf[0][1], qf[0], negm, 0, 0, 0);
#pragma unroll
          for (int d0 = 1; d0 < 4; ++d0) p1 = __builtin_amdgcn_mfma_f32_32x32x16_bf16(kf[d0][1], qf[d0], p1, 0, 0, 0); }
#define AT_SOFTMAX(P, OTHER, PK, FIRST) do { \
        float tmax = max3f(P[0], P[1], P[2]); \
        _Pragma("unroll") for (int r = 3; r < 15; r += 2) tmax = max3f(tmax, P[r], P[r + 1]); \
        tmax = __builtin_fmaxf(tmax, P[15]); { auto rr_ = __builtin_amdgcn_permlane32_swap(__float_as_uint(tmax), __float_as_uint(tmax), false, false); tmax = __builtin_fmaxf(__uint_as_float(rr_[0]), __uint_as_float(rr_[1])); } \
        if (FIRST) { mref = tmax; \
            _Pragma("unroll") for (int r = 0; r < 16; ++r) { P[r] -= tmax; OTHER[r] -= tmax; negm[r] = -mref; } \
        } else if (__any(tmax > 8.0f)) { \
            const float dl = __builtin_fmaxf(tmax, 0.f); mref += dl; const float al = __builtin_amdgcn_exp2f(-dl); lsum *= al; \
            _Pragma("unroll") for (int r = 0; r < 16; ++r) { P[r] -= dl; OTHER[r] -= dl; negm[r] = -mref; } \
            _Pragma("unroll") for (int db = 0; db < 4; ++db) _Pragma("unroll") for (int r = 0; r < 16; ++r) o[db][r] *= al; \
        } \
        float ls0_ = 0.f, ls1_ = 0.f, ls2_ = 0.f, ls3_ = 0.f; \
        _Pragma("unroll") for (int r = 0; r < 16; r += 4) { P[r] = __builtin_amdgcn_exp2f(P[r]); P[r + 1] = __builtin_amdgcn_exp2f(P[r + 1]); P[r + 2] = __builtin_amdgcn_exp2f(P[r + 2]); P[r + 3] = __builtin_amdgcn_exp2f(P[r + 3]); \
            ls0_ += P[r]; ls1_ += P[r + 1]; ls2_ += P[r + 2]; ls3_ += P[r + 3]; } \
        lsum += (ls0_ + ls1_) + (ls2_ + ls3_); \
        _Pragma("unroll") for (int s_ = 0; s_ < 2; ++s_) { v4u w_; \
            w_.x = cvtpk(P[8 * s_ + 0], P[8 * s_ + 1]); w_.y = cvtpk(P[8 * s_ + 2], P[8 * s_ + 3]); w_.z = cvtpk(P[8 * s_ + 4], P[8 * s_ + 5]); w_.w = cvtpk(P[8 * s_ + 6], P[8 * s_ + 7]); \
            PK[s_] = __builtin_bit_cast(bf16x8, w_); } } while (0)
        bf16x8 pka[2], pkb[2];
        f32x16 dummy_;
        AT_SOFTMAX(p0, p1, pka, t == 0);
        if (more) AT_WAITV(2); else AT_WAITV(0);
        AT_BAR();
        if (lead) { if (more) AT_DMAV(t + 1, bo ^ AT_TILE); } else { if (t + 2 < NT) AT_DMAK(t + 2, bo); }
        { s16x4 va_[4][2][2], vc_[4][2][2];
#define AT_VLOAD(dst, kh_) do { _Pragma("unroll") for (int d_ = 0; d_ < 4; ++d_) { const unsigned va = vb_ ^ (unsigned)(d_ << 6); \
            _Pragma("unroll") for (int s_ = 0; s_ < 2; ++s_) { dst[d_][s_][0] = vtr(F.lds + va + (32 * (kh_) + 16 * s_) * 256); dst[d_][s_][1] = vtr(F.lds + va + (32 * (kh_) + 16 * s_ + 8) * 256); } } } while (0)
#define AT_VMMA(src, PK) do { _Pragma("unroll") for (int s_ = 0; s_ < 2; ++s_) _Pragma("unroll") for (int d_ = 0; d_ < 4; ++d_) { \
            const bf16x8 vf = (bf16x8){src[d_][s_][0][0], src[d_][s_][0][1], src[d_][s_][0][2], src[d_][s_][0][3], src[d_][s_][1][0], src[d_][s_][1][1], src[d_][s_][1][2], src[d_][s_][1][3]}; \
            o[d_] = __builtin_amdgcn_mfma_f32_32x32x16_bf16(vf, PK[s_], o[d_], 0, 0, 0); } } while (0)
          AT_VLOAD(va_, 0); __builtin_amdgcn_sched_barrier(0);
          AT_VLOAD(vc_, 1); __builtin_amdgcn_sched_barrier(0);
          AT_VMMA(va_, pka);
          AT_SOFTMAX(p1, dummy_, pkb, false);
          AT_VMMA(vc_, pkb);
          __builtin_amdgcn_sched_barrier(0);
#undef AT_VLOAD
#undef AT_VMMA
        }
#undef AT_SOFTMAX
        if (lead) { if (more) AT_WAITV(2); } else { if (t + 2 < NT) AT_WAITV(2); else AT_WAITV(0); }
        AT_BAR();
    }
    if (lead) AT_BAR();
    const float lt = lsum + __shfl_xor(lsum, 32);
    LAS float* xs = (LAS float*)(F.lds + AT_XB) + qg * 4096 + lane;
    if (!lead) { const float sc1 = lam / lt;
#pragma unroll
        for (int db = 0; db < 4; ++db)
#pragma unroll
            for (int r = 0; r < 16; ++r) xs[(db * 16 + r) * 64] = o[db][r] * sc1; }
    __syncthreads();
    if (lead) {
        const float i0 = 1.0f / lt; float ss = 0.f;
#pragma unroll
        for (int db = 0; db < 4; ++db)
#pragma unroll
            for (int r = 0; r < 16; ++r) { const float v = o[db][r] * i0 - xs[(db * 16 + r) * 64]; o[db][r] = v; ss += v * v; }
        ss += __shfl_xor(ss, 32);
        const float rs = oscale / sqrtf(ss * (1.0f / 128.0f) + LN_EPS);
        bf16* yp = F.Y + (size_t)qrow * YW + h * 128 + 4 * hi;
#pragma unroll
        for (int db = 0; db < 4; ++db)
#pragma unroll
            for (int g4 = 0; g4 < 4; ++g4) { const int d = 32 * db + 8 * g4; const f32x4 gv = *(const f32x4*)(subg + d + 4 * hi);
                v2u w; w.x = cvtpk(o[db][4 * g4 + 0] * rs * gv[0], o[db][4 * g4 + 1] * rs * gv[1]); w.y = cvtpk(o[db][4 * g4 + 2] * rs * gv[2], o[db][4 * g4 + 3] * rs * gv[3]);
                *(GAS v2u*)(yp + d) = w; }
    }
#undef AT_DMAK
#undef AT_DMAV
}

constexpr int GM_ST = 0, GM_VT = 1024, GM_VP = 272;
__device__ __forceinline__ void gmlp_unit(Frame& F, int row0, int l) {
    int tid_ = F.ltid(); asm volatile("" : "+v"(tid_)); const int tid = tid_, lane = tid & 63, wid = __builtin_amdgcn_readfirstlane(F.ltid() >> 6);
    typedef float f32x2v __attribute__((ext_vector_type(2)));
    LAS f32x2v* st = (LAS f32x2v*)(F.lds + GM_ST); LAS unsigned char* vt = F.lds + GM_VT;
    const bf16* Z = F.Z;
    __syncthreads();
#pragma unroll
    for (int hb = 0; hb < 2; ++hb) {
        v4u va[8], vb[8];
#pragma unroll
        for (int i = 0; i < 8; ++i) { const bf16* vp = Z + (size_t)(row0 + wid * 16 + hb * 8 + i) * INW + BU_OFF + BW + lane * 16; va[i] = *(const GAS v4u*)(vp); vb[i] = *(const GAS v4u*)(vp + 8); }
#pragma unroll
        for (int i = 0; i < 8; ++i) { const v4u a = va[i], b2 = vb[i];
            const float x[16] = {bflo(a.x), bfhi(a.x), bflo(a.y), bfhi(a.y), bflo(a.z), bfhi(a.z), bflo(a.w), bfhi(a.w), bflo(b2.x), bfhi(b2.x), bflo(b2.y), bfhi(b2.y), bflo(b2.z), bfhi(b2.z), bflo(b2.w), bfhi(b2.w)};
            float s = 0.f;
#pragma unroll
            for (int e = 0; e < 16; ++e) s += x[e];
            const float mean = wave_sum(s) * (1.0f / 1024.0f); float q = 0.f;
#pragma unroll
            for (int e = 0; e < 16; ++e) { const float dd = x[e] - mean; q += dd * dd; }
            const float rstd = 1.0f / sqrtf(wave_sum(q) * (1.0f / 1024.0f) + LN_EPS);
            if (lane == 0) st[wid * 16 + hb * 8 + i] = (f32x2v){mean, rstd}; }
    }
    const float* lng = F.gln_g + (size_t)l * BW; const float* lnb = F.gln_b + (size_t)l * BW;
    const int j = tid & 127, cc = tid >> 7;
    const int fr = lane & 15, fq = lane >> 4, tok = wid * 16 + fr;
    const bf16* vsrc = Z + (size_t)(row0 + j) * INW + BU_OFF + BW + cc * 32;
    v4u vr[4];
#pragma unroll
    for (int q4 = 0; q4 < 4; ++q4) vr[q4] = *(const GAS v4u*)(vsrc + q4 * 8);
    __syncthreads();
    const f32x2v sj = st[j];
#pragma unroll 1
    for (int g = 0; g < 8; ++g) {
        bf16x8 wf[4]; v2u uu[8];
        const bf16* wg = F.Wsp + ((size_t)l * 8 + g) * 16384 + (size_t)tok * 128 + fq * 8;
#pragma unroll
        for (int ks = 0; ks < 4; ++ks) wf[ks] = *(const GAS bf16x8*)(wg + ks * 32);
        const bf16* up = Z + (size_t)(row0 + tok) * INW + BU_OFF + g * 128 + 4 * fq;
#pragma unroll
        for (int ct = 0; ct < 8; ++ct) uu[ct] = *(const GAS v2u*)(up + ct * 16);
        const float bias = F.b_sp[((size_t)l * 8 + g) * 128 + tok];
#pragma unroll
        for (int q4 = 0; q4 < 4; ++q4) { const v4u a = vr[q4]; const int c0 = cc * 32 + q4 * 8;
            const f32x4 g0 = *(const f32x4*)(lng + g * 128 + c0), g1 = *(const f32x4*)(lng + g * 128 + c0 + 4), b0 = *(const f32x4*)(lnb + g * 128 + c0), b1 = *(const f32x4*)(lnb + g * 128 + c0 + 4);
            const float xv[8] = {bflo(a.x), bfhi(a.x), bflo(a.y), bfhi(a.y), bflo(a.z), bfhi(a.z), bflo(a.w), bfhi(a.w)};
#pragma unroll
            for (int e = 0; e < 8; ++e) { const float gg = e < 4 ? g0[e & 3] : g1[e & 3], bb = e < 4 ? b0[e & 3] : b1[e & 3]; const float y = (xv[e] - sj.x) * sj.y * gg + bb;
                *(LAS bf16*)(vt + (c0 + e) * GM_VP + j * 2) = (bf16)f2bf(y); } }
        if (g < 7) {
#pragma unroll
            for (int q4 = 0; q4 < 4; ++q4) vr[q4] = *(const GAS v4u*)(vsrc + (g + 1) * 128 + q4 * 8);
        }
        __syncthreads();
#pragma unroll
        for (int ct = 0; ct < 8; ++ct) { f32x4 acc = {0.f, 0.f, 0.f, 0.f};
#pragma unroll
            for (int ks = 0; ks < 4; ++ks) { const bf16x8 af = *(const LAS bf16x8*)(vt + (ct * 16 + fr) * GM_VP + (ks * 32 + fq * 8) * 2); acc = __builtin_amdgcn_mfma_f32_16x16x32_bf16(af, wf[ks], acc, 0, 0, 0); }
            const v2u u2 = uu[ct];
            v2u w; w.x = cvtpk(bflo(u2.x) * (acc[0] + bias), bfhi(u2.x) * (acc[1] + bias)); w.y = cvtpk(bflo(u2.y) * (acc[2] + bias), bfhi(u2.y) * (acc[3] + bias));
            *(GAS v2u*)(F.Y + (size_t)(row0 + tok) * YW + BW + g * 128 + ct * 16 + 4 * fq) = w; }
        __syncthreads();
    }
}

constexpr int PL_DP = 528;
template <int GI> __device__ __forceinline__ void pool_unit(Frame& F, int row0, int l) {
    int tid_ = F.ltid(); asm volatile("" : "+v"(tid_)); const int tid = tid_, lane = tid & 63, wid = __builtin_amdgcn_readfirstlane(F.ltid() >> 6);
    LAS unsigned char* dt = F.lds;
    const bf16* Z = F.Z;
    constexpr int W = 2 << GI, HW = W / 2, NR = 8 + W - 1;
    const int seqlen = row0 < MLAT ? SEQ : CTXL; const int s0 = row0 < MLAT ? (row0 & ~(SEQ - 1)) : MLAT + ((row0 - MLAT) & ~(CTXL - 1));
    const int fr = lane & 15, fq = lane >> 4;
    bf16x8 wa[8][2];
    { const bf16* wp = F.Wpool + ((size_t)l * 4 + GI) * 65536 + (size_t)(wid * 32 + fr) * 256 + fq * 8;
#pragma unroll
      for (int ks = 0; ks < 8; ++ks) { wa[ks][0] = *(const GAS bf16x8*)(wp + ks * 32); wa[ks][1] = *(const GAS bf16x8*)(wp + 16 * 256 + ks * 32); } }
    __syncthreads();
    { const int ch = tid & 31, tg = tid >> 5;
      const bf16* zc = Z + C_OFF + GI * 256 + ch * 8; const int p0 = row0 - s0 + tg * 8;
      v4u rw[NR];
#pragma unroll
      for (int k = 0; k < NR; ++k) { const int q = p0 - HW + k; const bool ok = (q >= 0) && (q < seqlen); const int qq = ok ? q : p0; const v4u a = *(const GAS v4u*)(zc + (size_t)(s0 + qq) * INW); rw[k] = ok ? a : (v4u){0u, 0u, 0u, 0u}; }
      float sum[8] = {0.f, 0.f, 0.f, 0.f, 0.f, 0.f, 0.f, 0.f};
#pragma unroll
      for (int k = 0; k < W; ++k) { const v4u a = rw[k]; sum[0] += bflo(a.x); sum[1] += bfhi(a.x); sum[2] += bflo(a.y); sum[3] += bfhi(a.y); sum[4] += bflo(a.z); sum[5] += bfhi(a.z); sum[6] += bflo(a.w); sum[7] += bfhi(a.w); }
#pragma unroll
      for (int i = 0; i < 8; ++i) { const int p = p0 + i; const int lo = p - HW < 0 ? 0 : p - HW; const int hi = p - HW + W > seqlen ? seqlen : p - HW + W; const float inv = 1.0f / (float)(hi - lo);
          const v4u zz = rw[i + HW];
          v4u o; o.x = pk2(sum[0] * inv - bflo(zz.x), sum[1] * inv - bfhi(zz.x)); o.y = pk2(sum[2] * inv - bflo(zz.y), sum[3] * inv - bfhi(zz.y));
          o.z = pk2(sum[4] * inv - bflo(zz.z), sum[5] * inv - bfhi(zz.z)); o.w = pk2(sum[6] * inv - bflo(zz.w), sum[7] * inv - bfhi(zz.w));
          *(LAS v4u*)(dt + (tg * 8 + i) * PL_DP + ch * 16) = o;
          if (i < 7) { const v4u a = rw[i + W], b = rw[i];
              sum[0] += bflo(a.x) - bflo(b.x); sum[1] += bfhi(a.x) - bfhi(b.x); sum[2] += bflo(a.y) - bflo(b.y); sum[3] += bfhi(a.y) - bfhi(b.y);
              sum[4] += bflo(a.z) - bflo(b.z); sum[5] += bfhi(a.z) - bfhi(b.z); sum[6] += bflo(a.w) - bflo(b.w); sum[7] += bfhi(a.w) - bfhi(b.w); } } }
    __syncthreads();
    { f32x4 acc[2][8];
#pragma unroll
      for (int a = 0; a < 2; ++a)
#pragma unroll
          for (int tt = 0; tt < 8; ++tt) acc[a][tt] = (f32x4){0.f, 0.f, 0.f, 0.f};
#pragma unroll
      for (int ks = 0; ks < 8; ++ks) {
#pragma unroll
          for (int tt = 0; tt < 8; ++tt) { const bf16x8 bfr = *(const LAS bf16x8*)(dt + (tt * 16 + fr) * PL_DP + (ks * 32 + fq * 8) * 2);
              acc[0][tt] = __builtin_amdgcn_mfma_f32_16x16x32_bf16(wa[ks][0], bfr, acc[0][tt], 0, 0, 0); acc[1][tt] = __builtin_amdgcn_mfma_f32_16x16x32_bf16(wa[ks][1], bfr, acc[1][tt], 0, 0, 0); } }
      const float* ps = F.pool_scale + (size_t)l * BW + GI * 256;
#pragma unroll
      for (int a = 0; a < 2; ++a) { const int dd = wid * 32 + a * 16 + 4 * fq; const f32x4 sc = *(const f32x4*)(ps + dd);
#pragma unroll
          for (int tt = 0; tt < 8; ++tt) { const f32x4 v = acc[a][tt] * sc; v2u wv; wv.x = cvtpk(v[0], v[1]); wv.y = cvtpk(v[2], v[3]);
              *(GAS v2u*)(F.Y + (size_t)(row0 + tt * 16 + fr) * YW + 2 * BW + GI * 256 + dd) = wv; } } }
}
__device__ __forceinline__ void pool_dispatch(Frame& F, int row0, int g, int l) {
    if (g == 0) pool_unit<0>(F, row0, l); else if (g == 1) pool_unit<1>(F, row0, l); else if (g == 2) pool_unit<2>(F, row0, l); else pool_unit<3>(F, row0, l);
}

#ifndef MIXM
#define MIXM 7
#endif
__device__ __forceinline__ void phase_mixers(Frame& F, int l, float lam_init) {
    const bool last = (l == DEPTH - 1);
    float d01 = 0.f, d23 = 0.f; const float* lq = F.lam_qk + (size_t)l * 256;
    for (int i = 0; i < 64; ++i) { d01 += lq[i] * lq[64 + i]; d23 += lq[128 + i] * lq[192 + i]; }
    const float lam = __expf(d01) - __expf(d23) + lam_init; const float oscale = 1.0f - lam_init;
    const float* subg = F.subln_g + (size_t)l * 128;
#ifndef REP_ATT
#define REP_ATT 1
#endif
#ifndef REP_GP
#define REP_GP 1
#endif
#pragma nounroll
    for (int i = 0; i < 5 * REP_ATT; ++i) { const int uid = F.vcu + F.G * (i % 5);
        if (!(MIXM & 1)) continue;
        if (uid < 1024) attn_unit(F, uid >> 8, (uid >> 5) & 7, uid & 31, false, lam, oscale, subg);
        else if (!last && uid < 1088) attn_unit(F, (uid - 1024) >> 4, ((uid - 1024) >> 1) & 7, uid & 1, true, lam, oscale, subg); }
    const int nchunk = last ? MLAT / 128 : MTOT / 128;
#pragma nounroll
    for (int rgp = 0; rgp < REP_GP; ++rgp) {
    if (MIXM & 2) for (int cidx = F.G - 1 - F.vcu; cidx < nchunk; cidx += F.G) gmlp_unit(F, cidx * 128, l);
    if (MIXM & 4) { const int nfree = F.G - nchunk, npool = nchunk * 4;
        if (nfree > 0 && F.G == 256) {
            if (F.vcu < nfree) { for (int k = 0; k < 4; ++k) { const int u = F.vcu * 4 + k; if (u < npool) pool_dispatch(F, (u >> 2) * 128, u & 3, l); } }
            else { for (int u = nfree * 4 + (F.vcu - nfree); u < npool; u += nchunk) pool_dispatch(F, (u >> 2) * 128, u & 3, l); }
        } else { for (int u = F.vcu; u < npool; u += F.G) pool_dispatch(F, (u >> 2) * 128, u & 3, l); } }
    }
    __syncthreads();
}

#ifndef MK_ONE_LAUNCH
#define MK_ONE_LAUNCH 1
#endif
constexpr int NPHASE = 3 + 8 * DEPTH;
struct Args { const float* in[23]; float* out; unsigned char* ws; int ph_lo, ph_hi; float lam_init[4]; };
__global__ void __launch_bounds__(NWAVES * 64, 2) fwd(Args args) {
    extern __shared__ __attribute__((aligned(16))) unsigned char lds[];
    Frame F;
    F.lds = (LAS unsigned char*)lds;
    F.MISC = (volatile LAS unsigned*)(F.lds + MISC_OFF);
    F.G = gridDim.x; { const int bx = blockIdx.x; F.bx = bx; F.vcu = (F.G % 8 == 0) ? (bx % 8) * (F.G / 8) + bx / 8 : bx; }
    unsigned char* ws = args.ws;
    F.ctl = (gu32*)(ws + WS_CTL);
    frame_ptrs(F);
    for (int u = F.ltid(); u < (LDS_BYTES - LDSCTL_OFF) / 4; u += NWAVES * 64) ((LAS unsigned*)(F.lds + LDSCTL_OFF))[u] = 0u;
    __syncthreads();
#if MK_ONE_LAUNCH
    constexpr int lo = 0, hi = NPHASE; constexpr bool use_bar = true;
#else
    const int lo = args.ph_lo, hi = args.ph_hi;
    const bool use_bar = (hi - lo) > 1;
#endif
    XcdBarrier bar; bar.bar = (unsigned*)(F.ctl + CW_BAR); bar.x = 0; bar.st = nullptr;
    if (use_bar) bar = xcd_barrier_post((unsigned*)(F.ctl + CW_BAR), F.MISC + 8);
#ifndef PHM
#define PHM 0xFFFF
#endif
#define IN(k) (lo <= (k) && (k) < hi)
#define KIND(b) ((PHM >> (b)) & 1)
#ifndef REP_MASK
#define REP_MASK 0
#endif
#define NREP(b) (((REP_MASK >> (b)) & 1) ? 2 : 1)
#define BARRIER() do { XcdBarrier b_ = bar; asm volatile("" : "+s"(b_.x)); xcd_barrier(b_); } while (0)
#define SEAM(k) do { if (IN(k) && IN((k) + 1)) BARRIER(); } while (0)

    if (KIND(0) && IN(0)) { for (int rep = 0; rep < NREP(0); ++rep) { frame_ptrs(F); phase_a1(F); if (rep + 1 < NREP(0)) BARRIER(); } } SEAM(0);
    if (KIND(1) && IN(1)) { frame_ptrs(F); phase_a2(F); } SEAM(1);
    if (KIND(2) && IN(2)) { frame_ptrs(F); phase_a3(F); } SEAM(2);

#pragma nounroll
    for (int l = 0; l < DEPTH; ++l) {
        const int pb = 3 + 8 * l; const bool last = (l == DEPTH - 1);
        { int g_ = F.G, v_ = F.vcu, b_ = F.bx; asm volatile("" : "+s"(g_), "+s"(v_), "+s"(b_)); F.G = g_; F.vcu = v_; F.bx = b_; }
        const int Mrows = last ? MLAT : MTOT;
        if (KIND(3) && IN(pb + 0)) for (int rep = 0; rep < NREP(3); ++rep) { if (rep) BARRIER(); frame_ptrs(F);
            pg8::Gemm g{F.HA, F.Win + (size_t)l * INW * D, MTOT, INW, D, D, D}; pg8::StaticOrder S; S.init(MTOT, INW, F.G, F.bx);
            pg8::EpiInProj E{F.Z, F.rope, QSCALE, INW, MLAT, F.KB, F.VB};
            pg8::gemm_phase<pg8::EpiInProj, pg8::StaticOrder, true, true>(F.lds + RING_OFF, g, S, E);
        }
        SEAM(pb + 0);
        if (KIND(4) && IN(pb + 1)) for (int rep = 0; rep < NREP(4); ++rep) { if (rep) BARRIER(); frame_ptrs(F); phase_mixers(F, l, args.lam_init[l]); }
        SEAM(pb + 1);
        if (KIND(5) && IN(pb + 2)) for (int rep = 0; rep < NREP(5); ++rep) { if (rep) BARRIER(); frame_ptrs(F);
            pg8::Gemm g{F.Y, F.Wbr + (size_t)l * D * YW, Mrows, D, YW, YW, YW}; pg8::StaticOrder S; S.init(Mrows, D, F.G, F.bx);
            pg8::EpiGate E{F.Z + G_OFF, INW, F.MG, D};
            pg8::gemm_phase<pg8::EpiGate, pg8::StaticOrder, true, true>(F.lds + RING_OFF, g, S, E);
        }
        SEAM(pb + 2);
        if (KIND(6) && IN(pb + 3)) for (int rep = 0; rep < NREP(6); ++rep) { if (rep) BARRIER(); frame_ptrs(F);
            void* tw = rep ? (void*)(F.Z + (size_t)134 * MiB) : (void*)F.Y;
            { pg8::Gemm g{F.MG, F.Wout + (size_t)l * D * D, MLAT, D, D, D, D}; pg8::StaticOrder S; S.init(MLAT, D, F.G, F.bx);
              pg8::EpiResidT<false> E{F.mods + (size_t)l * 5 * INW + 2 * D, INW, tw, D, 1, MLAT};
              pg8::gemm_phase<pg8::EpiResidT<false>, pg8::StaticOrder, true, true>(F.lds + RING_OFF, g, S, E); }
            if (!last) { pg8::Gemm g{F.MG, F.Wout + (size_t)l * D * D, MTOT, D, 256, D, D}; pg8::SplitOrder S; S.init(MLAT / 256, 32, 8, 256, F.G, F.bx);
              pg8::EpiResidT<true> E{F.mods + (size_t)l * 5 * INW + 2 * D, INW, rep ? (void*)(F.Z + (size_t)170 * MiB) : (void*)(F.Z + (size_t)100 * MiB), D, 256, MLAT};
              pg8::gemm_phase<pg8::EpiResidT<true>, pg8::SplitOrder, true, true>(F.lds + RING_OFF, g, S, E); }
            if (TAILWORK && !last && F.bx >= 32 && rep == 0) ada_partial_layer(F, l + 1, (F.bx - 32) * NWAVES + __builtin_amdgcn_readfirstlane(F.ltid() >> 6), (F.G - 32) * NWAVES);
        }
        SEAM(pb + 3);
        if (KIND(7) && IN(pb + 4)) { frame_ptrs(F); phase_ln(F, F.ln1_g + (size_t)l * D, F.ln1_b + (size_t)l * D, Mrows, false, true, l, 3 * D, last ? 0 : 8); if (TAILWORK && !last) mods_reduce_layer(F, l + 1); }
        SEAM(pb + 4);
        if (KIND(8) && IN(pb + 5)) for (int rep = 0; rep < NREP(8); ++rep) { if (rep) BARRIER(); frame_ptrs(F);
            pg8::Gemm g{F.HA, F.Wgu + (size_t)l * 2 * FFH * D, Mrows, 2 * FFH, D, D, D}; pg8::StaticOrder S; S.init(Mrows, 2 * FFH, F.G, F.bx);
            pg8::EpiSwiglu E{F.Z, FFH};
            pg8::gemm_phase<pg8::EpiSwiglu, pg8::StaticOrder, true, true>(F.lds + RING_OFF, g, S, E);
        }
        SEAM(pb + 5);
        if (KIND(9) && IN(pb + 6)) for (int rep = 0; rep < NREP(9); ++rep) { if (rep) BARRIER(); frame_ptrs(F);
            void* tw = rep ? (void*)(F.Z + (size_t)134 * MiB) : (void*)F.Y;
            { pg8::Gemm g{F.Z, F.Wdn + (size_t)l * D * FFH, MLAT, D, FFH, FFH, FFH}; pg8::StaticOrder S; S.init(MLAT, D, F.G, F.bx);
              pg8::EpiResidT<false> E{F.mods + (size_t)l * 5 * INW + 5 * D, INW, tw, D, 1, MLAT};
              pg8::gemm_phase<pg8::EpiResidT<false>, pg8::StaticOrder, true, true>(F.lds + RING_OFF, g, S, E); }
            if (!last) { pg8::Gemm g{F.Z, F.Wdn + (size_t)l * D * FFH, MTOT, D, FFH / 4, FFH, FFH}; pg8::SplitOrder S; S.init(MLAT / 256, 32, 4, FFH / 4, F.G, F.bx);
              pg8::EpiResidT<true> E{F.mods + (size_t)l * 5 * INW + 5 * D, INW, rep ? (void*)(F.Z + (size_t)170 * MiB) : (void*)(F.Z + (size_t)100 * MiB), D, FFH / 4, MLAT};
              pg8::gemm_phase<pg8::EpiResidT<true>, pg8::SplitOrder, true, true>(F.lds + RING_OFF, g, S, E); }
            if (TAILWORK && !last && F.bx >= 32 && rep == 0) { __syncthreads(); cvt_layer(F, l + 1, (F.bx - 32) * NWAVES + __builtin_amdgcn_readfirstlane(F.ltid() >> 6), (F.G - 32) * NWAVES); }
        }
        SEAM(pb + 6);
        if (KIND(7) && IN(pb + 7)) { frame_ptrs(F); phase_ln(F, F.ln2_g + (size_t)l * D, F.ln2_b + (size_t)l * D, Mrows, last, !last, last ? l : l + 1, 0, last ? 0 : 4); }
        if (!last) SEAM(pb + 7);
    }
#undef IN
#undef SEAM
}

extern "C" void kernel_launch(void* const* d_in, const int* in_sizes, int n_in, void* d_out, int out_size, void* d_ws, size_t ws_size, hipStream_t stream) {
    static int grid = 0;
    if (grid == 0) {
        if (n_in != 23 || in_sizes[0] != MLAT * D || out_size != MLAT * D || ws_size < WS_END) {
            fprintf(stderr, "kernel_launch: unexpected shapes / workspace (n_in %d, in0 %d, out %d, ws %zu, need %zu); nothing launched\n", n_in, n_in > 0 ? in_sizes[0] : -1, out_size, ws_size, (size_t)WS_END); grid = -1; return; }
        int dev = 0, cus = 0, per_cu = 0;
        if (hipGetDevice(&dev) != hipSuccess || hipDeviceGetAttribute(&cus, hipDeviceAttributeMultiprocessorCount, dev) != hipSuccess) { grid = -1; return; }
        if (hipFuncSetAttribute((const void*)fwd, hipFuncAttributeMaxDynamicSharedMemorySize, LDS_BYTES) != hipSuccess) { fprintf(stderr, "kernel_launch: hipFuncSetAttribute failed\n"); grid = -1; return; }
        if (hipOccupancyMaxActiveBlocksPerMultiprocessor(&per_cu, (const void*)fwd, NWAVES * 64, LDS_BYTES) != hipSuccess || per_cu < 1) fprintf(stderr, "kernel_launch: occupancy query reports %d\n", per_cu);
        (void)hipGetLastError();
        grid = cus;
    }
    if (grid < 0) return;
    if (hipMemsetAsync((char*)d_ws + WS_CTL, 0, CTL_ZERO_BYTES, stream) != hipSuccess) return;
    Args a{};
    for (int i = 0; i < 23; ++i) a.in[i] = (const float*)d_in[i];
    a.out = (float*)d_out; a.ws = (unsigned char*)d_ws;
    for (int l = 0; l < DEPTH; ++l) a.lam_init[l] = (float)(0.8 - 0.6 * exp(-0.3 * (double)l));
#if MK_ONE_LAUNCH
    a.ph_lo = 0; a.ph_hi = NPHASE;
    hipLaunchKernelGGL(fwd, dim3(grid), dim3(NWAVES * 64), LDS_BYTES, stream, a);
#else
    for (int p = 0; p < NPHASE; ++p) { a.ph_lo = p; a.ph_hi = p + 1; hipLaunchKernelGGL(fwd, dim3(grid), dim3(NWAVES * 64), LDS_BYTES, stream, a); }
#endif
}
```

```cpp
#include <hip/hip_runtime.h>
#include <cstdio>
#include <cstdint>
#include <cmath>
namespace pg8 {
#define PG8_LAS __attribute__((address_space(3)))
typedef unsigned short bf16_t;
typedef short bf16x8 __attribute__((ext_vector_type(8)));
typedef float f32x4 __attribute__((ext_vector_type(4)));
typedef unsigned u32x4 __attribute__((ext_vector_type(4)));
constexpr int BM = 256, BK = 64, HALF = 128, HTB = HALF * BK * 2  , STAGE_BYTES = 8 * HTB, NXCD = 8, WGM = 8;

__host__ __device__ __forceinline__ int lds_byte(int r, int c) { const int st = (r >> 4) * 2 + (c >> 5), rr = r & 15, cc = c & 31, ob = rr * 64 + cc * 2; return st * 1024 + (ob ^ (((ob >> 9) & 1) << 5)); }
__host__ __device__ __forceinline__ void stage_rc(int b, int& R, int& C) { const int st = b / 1024, sb = b % 1024, swz = sb ^ (((sb >> 9) & 1) << 5); R = (st >> 1) * 16 + swz / 64; C = (st & 1) * 32 + (swz % 64) / 2; }
__host__ __device__ __forceinline__ int perm32(int rho) { const int n = rho >> 4, i = rho & 15; return 8 * (i >> 2) + 4 * n + (i & 3); }

struct Unit { int pm, pn, ka; };
struct Gemm { const bf16_t* A; const bf16_t* Bt; int M, N, K, lda, ldb; };

struct StaticOrder {
    int nM, nN, nwg, G, c;
    __host__ __device__ void init(int M, int N, int G_, int c_) { nM = M / BM; nN = N / BM; nwg = nM * nN; G = G_; c = c_; }
    __host__ __device__ bool next(int i, Unit& u) const {
        const long L = (long)i * G + c; if (L >= nwg) return false;
        int wgid = (int)L; { const int q = nwg / NXCD, r = nwg % NXCD, xcd = wgid % NXCD, off = wgid / NXCD; wgid = (xcd < r ? xcd * (q + 1) : r * (q + 1) + (xcd - r) * q) + off; }
        const int nig = WGM * nN, gid = wgid / nig, fm = gid * WGM, gsz = (nM - fm) < WGM ? (nM - fm) : WGM;
        u.pm = fm + ((wgid % nig) % gsz); u.pn = (wgid % nig) / gsz; u.ka = 0; return true;
    }
    __device__ __forceinline__ void a_ready(const Unit&) const {}
    __device__ __forceinline__ void done(const Unit&) const {}
};

struct SplitOrder {
    int nsplit, klen, G, c, pm0, ntile;
    __host__ __device__ void init(int pm0_, int ntile_, int nsplit_, int klen_, int G_, int c_) { pm0 = pm0_; ntile = ntile_; nsplit = nsplit_; klen = klen_; G = G_; c = c_; }
    __host__ __device__ bool next(int i, Unit& u) const { const int L = i * G + c; if (L >= ntile * nsplit) return false; const int tt = L / nsplit; u.pm = pm0 + (tt & 3); u.pn = tt >> 2; u.ka = (L - tt * nsplit) * klen; return true; }
    __device__ __forceinline__ void a_ready(const Unit&) const {}
    __device__ __forceinline__ void done(const Unit&) const {}
};
__device__ __forceinline__ unsigned cvt_pk_bf16(float lo, float hi) { unsigned r; asm volatile("v_cvt_pk_bf16_f32 %0, %1, %2" : "=v"(r) : "v"(lo), "v"(hi)); return r; }
typedef float f32x2 __attribute__((ext_vector_type(2)));
__device__ __forceinline__ f32x2 gelu_pk(f32x2 v) {
    const f32x2 av = __builtin_elementwise_abs(v), d = av * 0.2316418882f + 1.0f;
    f32x2 t; t.x = __builtin_amdgcn_rcpf(d.x); t.y = __builtin_amdgcn_rcpf(d.y);
    f32x2 q = t * 0.5307027145f + (-0.7265760135f); q = q * t + 0.7107068705f; q = q * t + (-0.142248368f); q = q * t + 0.127414796f; q = q * t;
    const f32x2 s = (v * v) * (-0.72134752044f);
    f32x2 e; e.x = __builtin_amdgcn_exp2f(s.x); e.y = __builtin_amdgcn_exp2f(s.y);
    const f32x2 m = v * (q * e), r = v - m;
    f32x2 o; o.x = v.x < 0.f ? m.x : r.x; o.y = v.y < 0.f ? m.y : r.y; return o;
}

typedef unsigned u32x2 __attribute__((ext_vector_type(2)));
__device__ __forceinline__ float bf_lo(unsigned w) { return __uint_as_float(w << 16); }
__device__ __forceinline__ float bf_hi(unsigned w) { return __uint_as_float(w & 0xffff0000u); }
__device__ __forceinline__ void store8_bf16(bf16_t* p, const f32x4 v0, const f32x4 v1) {
    u32x4 w; w.x = cvt_pk_bf16(v0[0], v0[1]); w.y = cvt_pk_bf16(v0[2], v0[3]); w.z = cvt_pk_bf16(v1[0], v1[1]); w.w = cvt_pk_bf16(v1[2], v1[3]); *(u32x4*)p = w;
}
__device__ __forceinline__ float sigmoid_f(float x) { return __builtin_amdgcn_rcpf(1.0f + __builtin_amdgcn_exp2f(x * -1.4426950408889634f)); }

struct EpiInProj {
    static constexpr bool PERM = true, AFTER_DRAIN = false; static constexpr int KSEG = 0;
    bf16_t* Z; const float* rope; float qscale; int ldc; int nlat; bf16_t* Kb; bf16_t* Vb; int dry;
    __device__ __forceinline__ void kseg(f32x4 (&)[2][2][4][2], const Unit&, int, int, int, int, int) const {}
    __device__ __forceinline__ void operator()(const f32x4 (&acc)[2][2][4][2], const Unit& u, int wr, int wc, int fr, int fq) const {
        const int pn = u.pn; const int row0 = u.pm * BM + wr * 64 + fr; const int col0 = pn * BM + wc * 32 + 8 * fq;
        if (dry) { float s_ = 0.f;
#pragma unroll
            for (int a_ = 0; a_ < 2; ++a_)
#pragma unroll
                for (int b_ = 0; b_ < 2; ++b_)
#pragma unroll
                    for (int m_ = 0; m_ < 4; ++m_)
#pragma unroll
                        for (int n_ = 0; n_ < 2; ++n_) s_ += acc[a_][b_][m_][n_][0];
            if (s_ != s_) Z[0] = 0; return; }
        if (pn < 8) {
            const float sc = pn < 4 ? qscale : 1.0f;
#pragma unroll
            for (int ai = 0; ai < 2; ++ai)
#pragma unroll
                for (int m = 0; m < 4; ++m) {
                    const int row = row0 + ai * HALF + m * 16; const int t = row & 4095; const int pos = (wc & 1) ? (t & 63) : (t >> 6);
                    f32x4 cs0 = *(const f32x4*)(rope + (pos * 16 + 4 * fq) * 2), cs1 = *(const f32x4*)(rope + (pos * 16 + 4 * fq) * 2 + 4);
                    if (row >= nlat) { cs0 = (f32x4){1.f, 0.f, 1.f, 0.f}; cs1 = cs0; }
                    bf16_t* rowp = Z + (size_t)row * ldc + col0;
                    if (pn >= 4) { const int bb = row < nlat ? (row >> 12) : ((row - nlat) >> 8), key = row < nlat ? 256 + (row & 4095) : ((row - nlat) & 255);
                        rowp = Kb + ((size_t)(bb * 8 + 2 * (pn - 4)) * 4352 + key) * 128 + wc * 32 + 8 * fq; }
#pragma unroll
                    for (int bj = 0; bj < 2; ++bj) {
                        const f32x4 a = acc[ai][bj][m][0], b = acc[ai][bj][m][1];
                        f32x4 o0, o1;
                        o0[0] = (a[0] * cs0[0] - a[1] * cs0[1]) * sc; o0[1] = (a[0] * cs0[1] + a[1] * cs0[0]) * sc;
                        o0[2] = (a[2] * cs0[2] - a[3] * cs0[3]) * sc; o0[3] = (a[2] * cs0[3] + a[3] * cs0[2]) * sc;
                        o1[0] = (b[0] * cs1[0] - b[1] * cs1[1]) * sc; o1[1] = (b[0] * cs1[1] + b[1] * cs1[0]) * sc;
                        o1[2] = (b[2] * cs1[2] - b[3] * cs1[3]) * sc; o1[3] = (b[2] * cs1[3] + b[3] * cs1[2]) * sc;
                        store8_bf16(rowp + (pn >= 4 ? (size_t)bj * 4352 * 128 : (size_t)bj * HALF), o0, o1);
                    }
                }
        } else if (pn < 12) {
#pragma unroll
            for (int ai = 0; ai < 2; ++ai)
#pragma unroll
                for (int m = 0; m < 4; ++m) { const int row = row0 + ai * HALF + m * 16; const int bb = row < nlat ? (row >> 12) : ((row - nlat) >> 8), key = row < nlat ? 256 + (row & 4095) : ((row - nlat) & 255);
                    bf16_t* rowp = Vb + ((size_t)(bb * 8 + 2 * (pn - 8)) * 4352 + key) * 128 + wc * 32 + 8 * fq;
#pragma unroll
                    for (int bj = 0; bj < 2; ++bj) store8_bf16(rowp + (size_t)bj * 4352 * 128, acc[ai][bj][m][0], acc[ai][bj][m][1]); }
        } else if (pn >= 20 && pn < 24) {
#pragma unroll
            for (int ai = 0; ai < 2; ++ai)
#pragma unroll
                for (int m = 0; m < 4; ++m) { bf16_t* rowp = Z + (size_t)(row0 + ai * HALF + m * 16) * ldc + col0;
#pragma unroll
                    for (int bj = 0; bj < 2; ++bj) store8_bf16(rowp + bj * HALF, acc[ai][bj][m][0], acc[ai][bj][m][1]); }
        } else if (pn < 20) {
#pragma unroll
            for (int ai = 0; ai < 2; ++ai)
#pragma unroll
                for (int m = 0; m < 4; ++m) { bf16_t* rowp = Z + (size_t)(row0 + ai * HALF + m * 16) * ldc + col0;
#pragma unroll
                    for (int bj = 0; bj < 2; ++bj) { const f32x4 v0 = acc[ai][bj][m][0], v1 = acc[ai][bj][m][1];
                        const f32x2 a = gelu_pk((f32x2){v0[0], v0[1]}), b = gelu_pk((f32x2){v0[2], v0[3]}), c = gelu_pk((f32x2){v1[0], v1[1]}), d = gelu_pk((f32x2){v1[2], v1[3]});
                        store8_bf16(rowp + bj * HALF, (f32x4){a.x, a.y, b.x, b.y}, (f32x4){c.x, c.y, d.x, d.y}); } }
        } else {
#pragma unroll
            for (int ai = 0; ai < 2; ++ai)
#pragma unroll
                for (int m = 0; m < 4; ++m) { bf16_t* rowp = Z + (size_t)(row0 + ai * HALF + m * 16) * ldc + col0;
#pragma unroll
                    for (int bj = 0; bj < 2; ++bj) { const f32x4 v0 = acc[ai][bj][m][0], v1 = acc[ai][bj][m][1]; f32x4 o0, o1;
#pragma unroll
                        for (int i = 0; i < 4; ++i) { o0[i] = __builtin_fmaxf(sigmoid_f(v0[i]), 1e-12f); o1[i] = __builtin_fmaxf(sigmoid_f(v1[i]), 1e-12f); }
                        store8_bf16(rowp + bj * HALF, o0, o1); } }
        }
    }
};

struct EpiGate {
    static constexpr bool PERM = true, AFTER_DRAIN = false; static constexpr int KSEG = 16;
    const bf16_t* G; int ldg; bf16_t* O; int ldo;
    __device__ __forceinline__ void kseg(f32x4 (&acc)[2][2][4][2], const Unit& u, int seg, int wr, int wc, int fr, int fq) const {
        const int row0 = u.pm * BM + wr * 64 + fr; const int col0 = u.pn * BM + wc * 32 + 8 * fq;
#pragma unroll
        for (int ai = 0; ai < 2; ++ai) {
            u32x4 ga[4][2], gb[4][2];
#pragma unroll
            for (int m = 0; m < 4; ++m) { const bf16_t* gp = G + (size_t)(row0 + ai * HALF + m * 16) * ldg + (seg - 1) * 2048 + col0;
#pragma unroll
                for (int bj = 0; bj < 2; ++bj) { ga[m][bj] = *(const u32x4*)(gp + bj * HALF); gb[m][bj] = *(const u32x4*)(gp + 2048 + bj * HALF); } }
#pragma unroll
            for (int m = 0; m < 4; ++m)
#pragma unroll
                for (int bj = 0; bj < 2; ++bj) { const u32x4 a = ga[m][bj], b = gb[m][bj];
                    f32x4 r0, r1;
                    r0[0] = bf_lo(a.x) * __builtin_amdgcn_rcpf(bf_lo(b.x)); r0[1] = bf_hi(a.x) * __builtin_amdgcn_rcpf(bf_hi(b.x));
                    r0[2] = bf_lo(a.y) * __builtin_amdgcn_rcpf(bf_lo(b.y)); r0[3] = bf_hi(a.y) * __builtin_amdgcn_rcpf(bf_hi(b.y));
                    r1[0] = bf_lo(a.z) * __builtin_amdgcn_rcpf(bf_lo(b.z)); r1[1] = bf_hi(a.z) * __builtin_amdgcn_rcpf(bf_hi(b.z));
                    r1[2] = bf_lo(a.w) * __builtin_amdgcn_rcpf(bf_lo(b.w)); r1[3] = bf_hi(a.w) * __builtin_amdgcn_rcpf(bf_hi(b.w));
                    acc[ai][bj][m][0] *= r0; acc[ai][bj][m][1] *= r1; }
            asm volatile("" ::: "memory"); }
    }
    __device__ __forceinline__ void operator()(const f32x4 (&acc)[2][2][4][2], const Unit& u, int wr, int wc, int fr, int fq) const {
        const int row0 = u.pm * BM + wr * 64 + fr; const int col0 = u.pn * BM + wc * 32 + 8 * fq;
        u32x4 gg[2][4][2];
#pragma unroll
        for (int ai = 0; ai < 2; ++ai)
#pragma unroll
            for (int m = 0; m < 4; ++m) { const bf16_t* gp = G + (size_t)(row0 + ai * HALF + m * 16) * ldg + 2 * 2048 + col0;
#pragma unroll
                for (int bj = 0; bj < 2; ++bj) gg[ai][m][bj] = *(const u32x4*)(gp + bj * HALF); }
#pragma unroll
        for (int ai = 0; ai < 2; ++ai)
#pragma unroll
            for (int m = 0; m < 4; ++m) { bf16_t* op = O + (size_t)(row0 + ai * HALF + m * 16) * ldo + col0;
#pragma unroll
                for (int bj = 0; bj < 2; ++bj) { const u32x4 g = gg[ai][m][bj];
                    const f32x4 g0 = (f32x4){bf_lo(g.x), bf_hi(g.x), bf_lo(g.y), bf_hi(g.y)}, g1 = (f32x4){bf_lo(g.z), bf_hi(g.z), bf_lo(g.w), bf_hi(g.w)};
                    store8_bf16(op + bj * HALF, acc[ai][bj][m][0] * g0, acc[ai][bj][m][1] * g1); } }
    }
};

template <bool SLAB> struct EpiResidT {
    static constexpr bool PERM = !SLAB, AFTER_DRAIN = false; static constexpr int KSEG = 0;
    const float* gv; int gstride; void* Tw; int ldc; int klen, nlat;
    __device__ __forceinline__ void kseg(f32x4 (&)[2][2][4][2], const Unit&, int, int, int, int, int) const {}
    __device__ __forceinline__ void operator()(const f32x4 (&acc)[2][2][4][2], const Unit& u, int wr, int wc, int fr, int fq) const {
        const int row0 = u.pm * BM + wr * 64 + fr; const int grp = u.pm < 64 ? (u.pm >> 4) : 4;
        if constexpr (SLAB) {
            const int col0 = u.pn * BM + wc * 32 + 4 * fq;
            f32x4 g[2][2];
#pragma unroll
            for (int bj = 0; bj < 2; ++bj)
#pragma unroll
                for (int n = 0; n < 2; ++n) g[bj][n] = *(const f32x4*)(gv + (size_t)grp * gstride + col0 + bj * HALF + n * 16);
#pragma unroll
            for (int ai = 0; ai < 2; ++ai)
#pragma unroll
                for (int m = 0; m < 4; ++m) { float* pp = (float*)Tw + ((size_t)(u.ka / klen) * 1024 + (size_t)(row0 + ai * HALF + m * 16 - nlat)) * ldc + col0;
#pragma unroll
                    for (int bj = 0; bj < 2; ++bj)
#pragma unroll
                        for (int n = 0; n < 2; ++n) *(f32x4*)(pp + bj * HALF + n * 16) = g[bj][n] * acc[ai][bj][m][n]; }
        } else {
            const int col0 = u.pn * BM + wc * 32 + 8 * fq;
            f32x4 g[2][2];
#pragma unroll
            for (int bj = 0; bj < 2; ++bj)
#pragma unroll
                for (int n = 0; n < 2; ++n) g[bj][n] = *(const f32x4*)(gv + (size_t)grp * gstride + col0 + bj * HALF + n * 4);
#pragma unroll
            for (int ai = 0; ai < 2; ++ai)
#pragma unroll
                for (int m = 0; m < 4; ++m) { bf16_t* tp = (bf16_t*)Tw + (size_t)(row0 + ai * HALF + m * 16) * ldc + col0;
#pragma unroll
                    for (int bj = 0; bj < 2; ++bj) store8_bf16(tp + bj * HALF, g[bj][0] * acc[ai][bj][m][0], g[bj][1] * acc[ai][bj][m][1]); }
        }
    }
};

struct EpiSwiglu {
    static constexpr bool PERM = true, AFTER_DRAIN = false; static constexpr int KSEG = 0;
    bf16_t* H; int ldc;
    __device__ __forceinline__ void kseg(f32x4 (&)[2][2][4][2], const Unit&, int, int, int, int, int) const {}
    __device__ __forceinline__ void operator()(const f32x4 (&acc)[2][2][4][2], const Unit& u, int wr, int wc, int fr, int fq) const {
        const int row0 = u.pm * BM + wr * 64 + fr, col0 = u.pn * HALF + wc * 32 + 8 * fq;
#pragma unroll
        for (int ai = 0; ai < 2; ++ai)
#pragma unroll
            for (int m = 0; m < 4; ++m) { bf16_t* rowp = H + (size_t)(row0 + ai * HALF + m * 16) * ldc + col0; f32x4 o[2];
#pragma unroll
                for (int n = 0; n < 2; ++n) { const f32x4 gt = acc[ai][0][m][n], up = acc[ai][1][m][n];
#pragma unroll
                    for (int i = 0; i < 4; ++i) o[n][i] = gt[i] * sigmoid_f(gt[i]) * up[i]; }
                store8_bf16(rowp, o[0], o[1]); }
    }
};
template <class Epi, class Sched, bool ALIGN_EPI = false, bool SP2 = false>
__device__ __forceinline__ void gemm_phase(PG8_LAS unsigned char* lds, const Gemm g, const Sched& S, const Epi& E) {
    int tid_ = threadIdx.x; asm volatile("" : "+v"(tid_));
    const int tid = tid_, wid = __builtin_amdgcn_readfirstlane(tid >> 6), lane = tid & 63, wr = wid >> 2, wc = wid & 3, fr = lane & 15, fq = lane >> 4;
    const int K = g.K, nt = K / BK;
    unsigned voffA[2], voffB[2];
#pragma unroll
    for (int i = 0; i < 2; ++i) { int R, C; stage_rc(tid * 16 + i * 8192, R, C); const int Rb = Epi::PERM ? ((R & ~31) + perm32(R & 31)) : R;
        voffA[i] = (unsigned)(R * g.lda + C) * 2u; voffB[i] = (unsigned)(Rb * g.ldb + C) * 2u; }
    const size_t kstep = (size_t)(BK * 2);
    const size_t hstepA = (size_t)HALF * g.lda * 2, hstepB = (size_t)HALF * g.ldb * 2;
    const size_t tstepA = 2 * hstepA, tstepB = 2 * hstepB;
    const unsigned ldsw = (unsigned)wid * 1024u;
    const int aoff = lds_byte(wr * 64 + fr, fq * 8), boff = lds_byte(wc * 32 + fr, fq * 8);
#define PG8_SA(b, h) (((b) * 2 + (h)) * HTB)
#define PG8_SB(b, h) ((4 + (b) * 2 + (h)) * HTB)
#define PG8_STAGE(bufoff, gbase, voff) do { _Pragma("unroll") for (int _i = 0; _i < 2; ++_i) \
        __builtin_amdgcn_global_load_lds((const unsigned*)((const char*)(gbase) + (voff)[_i]), (PG8_LAS unsigned*)(lds + (bufoff) + ldsw + _i * 8192), 16, 0, 0); } while (0)
#define PG8_LDA(dst, b, h) do { _Pragma("unroll") for (int m = 0; m < 4; ++m) _Pragma("unroll") for (int k = 0; k < 2; ++k) dst[m][k] = *(const PG8_LAS bf16x8*)(lds + PG8_SA(b, h) + aoff + m * 2048 + k * 1024); } while (0)
#define PG8_LDB(dst, b, h) do { _Pragma("unroll") for (int n = 0; n < 2; ++n) _Pragma("unroll") for (int k = 0; k < 2; ++k) dst[n][k] = *(const PG8_LAS bf16x8*)(lds + PG8_SB(b, h) + boff + n * 2048 + k * 1024); } while (0)
#define PG8_MMA(ai, bj, At, Bt) do { __builtin_amdgcn_s_setprio(1); _Pragma("unroll") for (int m = 0; m < 4; ++m) _Pragma("unroll") for (int n = 0; n < 2; ++n) _Pragma("unroll") for (int k = 0; k < 2; ++k) \
        acc[ai][bj][m][n] = __builtin_amdgcn_mfma_f32_16x16x32_bf16(Bt[n][k], At[m][k], acc[ai][bj][m][n], 0, 0, 0); __builtin_amdgcn_s_setprio(0); } while (0)
#define PG8_WAIT_V(n) asm volatile("s_waitcnt vmcnt(" #n ")" ::: "memory")
#define PG8_WAIT_L(n) asm volatile("s_waitcnt lgkmcnt(" #n ")" ::: "memory")
#define PG8_BAR __builtin_amdgcn_s_barrier()
#define PG8_SCHED __builtin_amdgcn_sched_barrier(0)
    Unit cur, nxt; int ui = 0;
    if (!S.next(0, cur)) return;
    f32x4 acc[2][2][4][2];
#pragma unroll
    for (int a = 0; a < 2; ++a)
#pragma unroll
        for (int b = 0; b < 2; ++b)
#pragma unroll
            for (int m = 0; m < 4; ++m)
#pragma unroll
                for (int n = 0; n < 2; ++n) acc[a][b][m][n] = (f32x4){0.f, 0.f, 0.f, 0.f};
    bf16x8 At[4][2], B0[2][2], B1[2][2];
    const char* cA = (const char*)g.A + (size_t)cur.pm * tstepA + (size_t)cur.ka * 2; const char* cB = (const char*)g.Bt + (size_t)cur.pn * tstepB + (size_t)cur.ka * 2;
    S.a_ready(cur);
    if constexpr (SP2) {
        PG8_STAGE(PG8_SB(0, 0), cB, voffB); PG8_STAGE(PG8_SB(0, 1), cB + hstepB, voffB); PG8_STAGE(PG8_SA(0, 0), cA, voffA); PG8_STAGE(PG8_SA(0, 1), cA + hstepA, voffA);
        if (wr == 1) PG8_BAR;
        PG8_WAIT_V(2); PG8_BAR;
        PG8_STAGE(PG8_SB(1, 0), cB + kstep, voffB); PG8_STAGE(PG8_SA(1, 0), cA + kstep, voffA); PG8_STAGE(PG8_SB(1, 1), cB + hstepB + kstep, voffB);
        PG8_WAIT_V(6); PG8_BAR;
    } else {
        PG8_STAGE(PG8_SB(0, 0), cB, voffB); PG8_STAGE(PG8_SA(0, 0), cA, voffA); PG8_STAGE(PG8_SB(0, 1), cB + hstepB, voffB); PG8_STAGE(PG8_SA(0, 1), cA + hstepA, voffA);
        if (wr == 1) PG8_BAR;
        PG8_WAIT_V(4); PG8_BAR;
        PG8_STAGE(PG8_SB(1, 0), cB + kstep, voffB); PG8_STAGE(PG8_SA(1, 0), cA + kstep, voffA); PG8_STAGE(PG8_SB(1, 1), cB + hstepB + kstep, voffB);
        PG8_WAIT_V(6); PG8_BAR;
    }
    for (;;) {
        const bool has_next = S.next(ui + 1, nxt);
        const char* nA = has_next ? (const char*)g.A + (size_t)nxt.pm * tstepA + (size_t)nxt.ka * 2 : cA; const char* nB = has_next ? (const char*)g.Bt + (size_t)nxt.pn * tstepB + (size_t)nxt.ka * 2 : cB;
        for (int t = 0; t < nt; t += 2) {
            const bool last = (t == nt - 2);
            if constexpr (Epi::KSEG > 0) { if (t > 0 && (t % Epi::KSEG) == 0) E.kseg(acc, cur, t / Epi::KSEG, wr, wc, fr, fq); }
            const char* a1 = cA + (size_t)(t + 1) * kstep;
            const char* a2 = last ? nA : cA + (size_t)(t + 2) * kstep; const char* b2 = last ? nB : cB + (size_t)(t + 2) * kstep;
            const char* a3 = a2 + kstep; const char* b3 = b2 + kstep;
            if (last && has_next) S.a_ready(nxt);
            if constexpr (SP2) {
            PG8_LDB(B0, 0, 0); PG8_LDB(B1, 0, 1); PG8_SCHED; PG8_LDA(At, 0, 0); PG8_STAGE(PG8_SA(1, 1), a1 + hstepA, voffA);
            PG8_WAIT_V(8); PG8_WAIT_L(0); PG8_BAR; PG8_MMA(0, 0, At, B0); PG8_MMA(0, 1, At, B1); PG8_BAR; PG8_SCHED;
            PG8_LDA(At, 0, 1); PG8_STAGE(PG8_SB(0, 0), b2, voffB); PG8_STAGE(PG8_SB(0, 1), b2 + hstepB, voffB); PG8_STAGE(PG8_SA(0, 0), a2, voffA);
            PG8_WAIT_V(8); PG8_WAIT_L(0); PG8_BAR; PG8_MMA(1, 0, At, B0); PG8_MMA(1, 1, At, B1); PG8_BAR; PG8_SCHED;
            PG8_LDB(B0, 1, 0); PG8_LDB(B1, 1, 1); PG8_SCHED; PG8_LDA(At, 1, 0); PG8_STAGE(PG8_SA(0, 1), a2 + hstepA, voffA);
            PG8_WAIT_V(8); PG8_WAIT_L(0); PG8_BAR; PG8_MMA(0, 0, At, B0); PG8_MMA(0, 1, At, B1); PG8_BAR; PG8_SCHED;
            PG8_LDA(At, 1, 1); PG8_STAGE(PG8_SB(1, 0), b3, voffB); PG8_STAGE(PG8_SB(1, 1), b3 + hstepB, voffB); PG8_STAGE(PG8_SA(1, 0), a3, voffA);
            PG8_WAIT_V(8); PG8_WAIT_L(0); PG8_BAR; PG8_MMA(1, 0, At, B0); PG8_MMA(1, 1, At, B1); PG8_BAR; PG8_SCHED;
            } else {
            PG8_LDB(B0, 0, 0); PG8_SCHED; PG8_LDA(At, 0, 0); PG8_STAGE(PG8_SA(1, 1), a1 + hstepA, voffA);
            PG8_WAIT_L(8); PG8_BAR; PG8_WAIT_L(0); PG8_MMA(0, 0, At, B0); PG8_BAR; PG8_SCHED;
            PG8_LDB(B1, 0, 1); PG8_STAGE(PG8_SB(0, 0), b2, voffB);
            PG8_BAR; PG8_WAIT_L(0); PG8_MMA(0, 1, At, B1); PG8_BAR;
            PG8_LDA(At, 0, 1); PG8_STAGE(PG8_SA(0, 0), a2, voffA);
            PG8_BAR; PG8_WAIT_L(0); PG8_MMA(1, 0, At, B0); PG8_BAR; PG8_SCHED;
            PG8_STAGE(PG8_SB(0, 1), b2 + hstepB, voffB);
            PG8_WAIT_V(6); PG8_BAR; PG8_MMA(1, 1, At, B1); PG8_BAR;
            PG8_LDB(B0, 1, 0); PG8_SCHED; PG8_LDA(At, 1, 0); PG8_STAGE(PG8_SA(0, 1), a2 + hstepA, voffA);
            PG8_WAIT_L(8); PG8_BAR; PG8_WAIT_L(0); PG8_MMA(0, 0, At, B0); PG8_BAR; PG8_SCHED;
            PG8_LDB(B1, 1, 1); PG8_STAGE(PG8_SB(1, 0), b3, voffB);
            PG8_BAR; PG8_WAIT_L(0); PG8_MMA(0, 1, At, B1); PG8_BAR;
            PG8_LDA(At, 1, 1); PG8_STAGE(PG8_SA(1, 0), a3, voffA);
            PG8_BAR; PG8_WAIT_L(0); PG8_MMA(1, 0, At, B0); PG8_BAR; PG8_SCHED;
            PG8_STAGE(PG8_SB(1, 1), b3 + hstepB, voffB);
            PG8_WAIT_V(6); PG8_BAR; PG8_MMA(1, 1, At, B1); PG8_BAR;
            }
        }
        if constexpr (ALIGN_EPI) { if (wr == 0) PG8_BAR; }
        if constexpr (!Epi::AFTER_DRAIN) { E(acc, cur, wr, wc, fr, fq); S.done(cur); }
        if (!has_next) break;
#pragma unroll
        for (int a = 0; a < 2; ++a)
#pragma unroll
            for (int b = 0; b < 2; ++b)
#pragma unroll
                for (int m = 0; m < 4; ++m)
#pragma unroll
                    for (int n = 0; n < 2; ++n) acc[a][b][m][n] = (f32x4){0.f, 0.f, 0.f, 0.f};
        cur = nxt; cA = nA; cB = nB; ++ui;
        if constexpr (ALIGN_EPI) { if (wr == 1) PG8_BAR; }
    }
    PG8_WAIT_V(0);
    if constexpr (!ALIGN_EPI) { if (wr == 0) PG8_BAR; }
    PG8_BAR;
    if constexpr (Epi::AFTER_DRAIN) { E.fused(acc, cur, wr, wc, fr, fq, lds, wid, lane); S.done(cur); }
#undef PG8_SA
#undef PG8_SB
#undef PG8_STAGE
#undef PG8_LDA
#undef PG8_LDB
#undef PG8_MMA
#undef PG8_WAIT_V
#undef PG8_WAIT_L
#undef PG8_BAR
#undef PG8_SCHED
}
}

constexpr int NWAVES = 8;
constexpr int D = 2048, NBATCH = 4, SEQ = 4096, DEPTH = 4, CTXL = 256;
constexpr int MLAT = NBATCH * SEQ, MCTX = NBATCH * CTXL, MTOT = MLAT + MCTX;
constexpr int INW = 12288, BW = 1024, FFH = 5632, NHEAD = 8;
constexpr int Q_OFF = 0, K_OFF = 1024, V_OFF = 2048, BU_OFF = 3072, C_OFF = 5120, G_OFF = 6144;
constexpr int YW = 3 * BW;
constexpr float LN_EPS = 1e-6f;
constexpr float ALPHA = 1.681792830507429f;
constexpr float QSCALE = 0.125f * 1.4426950408889634f;

constexpr size_t MiB = 1u << 20;
constexpr size_t WS_CTL = 0, CTL_ZERO_BYTES = 1 * MiB;
constexpr size_t WS_ROPE = 1 * MiB;
constexpr size_t WS_MODS = 2 * MiB;
constexpr size_t WS_MODP = 4 * MiB;
constexpr size_t WS_WSP = 20 * MiB;
constexpr size_t WS_WPOOL = 21 * MiB;
constexpr size_t WS_WIN = 24 * MiB;
constexpr size_t WS_WBR = 216 * MiB;
constexpr size_t WS_WOUT = 264 * MiB;
constexpr size_t WS_WGU = 296 * MiB;
constexpr size_t WS_WDN = 472 * MiB;
constexpr size_t WS_X = 560 * MiB;
constexpr size_t WS_HA = 696 * MiB;
constexpr size_t WS_Y = 764 * MiB;
constexpr size_t WS_MG = 866 * MiB;
constexpr size_t WS_Z = 934 * MiB;
constexpr size_t WS_KB = 1342 * MiB, WS_VB = 1378 * MiB;
constexpr size_t WS_END = 1414 * MiB;
static_assert(WS_MODP + 16ull * 4 * 5 * 12288 * 4 <= WS_WSP && WS_WIN + 4ull * 12288 * 2048 * 2 <= WS_WBR && WS_WBR + 4ull * 2048 * 3072 * 2 <= WS_WOUT && WS_WOUT + 4ull * 2048 * 2048 * 2 <= WS_WGU, "ws map 1");
static_assert(WS_WGU + 4ull * 11264 * 2048 * 2 <= WS_WDN && WS_WDN + 4ull * 2048 * 5632 * 2 <= WS_X && WS_X + (size_t)MTOT * D * 4 <= WS_HA && WS_HA + (size_t)MTOT * D * 2 <= WS_Y, "ws map 2");
static_assert(WS_Y + (size_t)MTOT * YW * 2 <= WS_MG && WS_MG + (size_t)MTOT * D * 2 <= WS_Z && WS_Z + (size_t)MTOT * INW * 2 <= WS_KB && WS_KB + 32ull * 4352 * 256 <= WS_VB && WS_VB + 32ull * 4352 * 256 <= WS_END, "ws map 3");
constexpr int CW_BAR = 4096;

constexpr int RING_OFF = 0, RING_BYTES = 131072;
constexpr int LDSCTL_OFF = RING_BYTES, MISC_OFF = LDSCTL_OFF + 320;
constexpr int LDS_BYTES = 147456;

#define GAS __attribute__((address_space(1)))
#define LAS __attribute__((address_space(3)))
typedef unsigned short bf16;
typedef unsigned v4u __attribute__((ext_vector_type(4)));
typedef unsigned v2u __attribute__((ext_vector_type(2)));
typedef float f32x4 __attribute__((ext_vector_type(4)));
typedef float f32x16 __attribute__((ext_vector_type(16)));
typedef short bf16x8 __attribute__((ext_vector_type(8)));
typedef short s16x4 __attribute__((ext_vector_type(4)));
typedef GAS unsigned gu32;
#define RLX_AGENT __ATOMIC_RELAXED, __HIP_MEMORY_SCOPE_AGENT
#define LDS_WAIT() asm volatile("s_waitcnt lgkmcnt(0)" ::: "memory")
#define VM_WAIT() asm volatile("s_waitcnt vmcnt(0)" ::: "memory")
__device__ __forceinline__ unsigned f2bf(float f) { unsigned u = __builtin_bit_cast(unsigned, f); return (u + 0x7fffu + ((u >> 16) & 1u)) >> 16; }
__device__ __forceinline__ unsigned pk2(float lo, float hi) { return f2bf(lo) | (f2bf(hi) << 16); }
__device__ __forceinline__ unsigned cvtpk(float lo, float hi) { unsigned r; asm volatile("v_cvt_pk_bf16_f32 %0, %1, %2" : "=v"(r) : "v"(lo), "v"(hi)); return r; }
__device__ __forceinline__ float bflo(unsigned w) { return __uint_as_float(w << 16); }
__device__ __forceinline__ float bfhi(unsigned w) { return __uint_as_float(w & 0xffff0000u); }

#define XB_TMO      128
#define XB_XCNT(j)  (256  + 64 * (j))
#define XB_XSUB(j)  (1280 + 64 * (j))
#define XB_XGEN(j)  (2304 + 64 * (j))
#define XB_TOP      3328
#define XB_TOPGEN   3392
#define XCD_BAR_WORDS 3456
#define XB_SPIN_CAP (1u << 18)

__device__ __forceinline__ unsigned xb_ld(unsigned* p)              { return __hip_atomic_load(p, __ATOMIC_RELAXED, __HIP_MEMORY_SCOPE_AGENT); }
__device__ __forceinline__ unsigned xb_add(unsigned* p, unsigned v) { return __hip_atomic_fetch_add(p, v, __ATOMIC_RELAXED, __HIP_MEMORY_SCOPE_AGENT); }
__device__ __forceinline__ unsigned xb_xcc_id() { return (unsigned)__builtin_amdgcn_s_getreg((3 << 11) | 20) & 0xFu; }
#define XB_SPIN(cond, bar) do { unsigned _sp = 0; while (cond) { __builtin_amdgcn_s_sleep(1); \
    if ((++_sp & 255u) == 0u) { if (xb_ld(&(bar)[XB_TMO])) break; if (_sp > XB_SPIN_CAP) { atomicAdd(&(bar)[XB_TMO], 1u); break; } } } } while (0)

struct XcdBarrier {
    unsigned* bar; unsigned x;
    volatile LAS unsigned* st;
};

__device__ __forceinline__ XcdBarrier xcd_barrier_post(unsigned* bar, volatile LAS unsigned* st) {
    XcdBarrier b; b.bar = bar; b.x = xb_xcc_id(); b.st = st;
    if (threadIdx.x == 0) (void)xb_add(&bar[XB_XCNT(b.x)], 1u);
    return b;
}
__device__ __forceinline__ void xcd_barrier_complete(unsigned* bar, unsigned x, unsigned& nloc, unsigned& nx) {
    const unsigned G = gridDim.x * gridDim.y * gridDim.z;
    unsigned sum, cnt, mine, sp = 0u;
    for (;;) {
        sum = 0u; cnt = 0u; mine = 0u;
#pragma unroll
        for (unsigned j = 0; j < 16; ++j) { const unsigned c = xb_ld(&bar[XB_XCNT(j)]); sum += c; cnt += (c > 0u) ? 1u : 0u; mine = (j == x) ? c : mine; }
        if (sum == G) break;
        __builtin_amdgcn_s_sleep(1);
        if ((++sp & 255u) == 0u) { if (xb_ld(&bar[XB_TMO])) break; if (sp > XB_SPIN_CAP) { atomicAdd(&bar[XB_TMO], 1u); break; } }
    }
    nloc = mine > 0u ? mine : 1u; nx = cnt > 0u ? cnt : 1u;
}

__device__ __forceinline__ void xcd_barrier(const XcdBarrier& b) {
    asm volatile("s_waitcnt vmcnt(0)" ::: "memory");
    __syncthreads();
    if (threadIdx.x == 0) {
        unsigned* bar = b.bar;
        __builtin_amdgcn_s_waitcnt(0);
        unsigned nloc = b.st[0], nx = b.st[1];
        if (nloc == 0u) { xcd_barrier_complete(bar, b.x, nloc, nx); b.st[0] = nloc; b.st[1] = nx; }
        const unsigned old = xb_add(&bar[XB_XSUB(b.x)], 1u);
        const unsigned gen = old / nloc;
        if (old + 1u == (gen + 1u) * nloc) {
            __builtin_amdgcn_fence(__ATOMIC_RELEASE, "agent");
            asm volatile("s_waitcnt vmcnt(0)" ::: "memory");
            const unsigned og = xb_add(&bar[XB_TOP], 1u);
            const unsigned tg = og / nx;
            if (og + 1u == (tg + 1u) * nx) xb_add(&bar[XB_TOPGEN], 1u);
            else XB_SPIN(xb_ld(&bar[XB_TOPGEN]) == tg, bar);
            __builtin_amdgcn_fence(__ATOMIC_ACQUIRE, "agent");
            xb_add(&bar[XB_XGEN(b.x)], 1u);
            asm volatile("s_waitcnt vmcnt(0)" ::: "memory");
        } else {
            XB_SPIN(xb_ld(&bar[XB_XGEN(b.x)]) == gen, bar);
            __builtin_amdgcn_fence(__ATOMIC_ACQUIRE, "agent");
            asm volatile("s_waitcnt vmcnt(0)" ::: "memory");
        }
    }
    __syncthreads();
}


struct Frame {
    LAS unsigned char* lds;
    volatile LAS unsigned* MISC;
    gu32* ctl;
    int vcu, G, bx;
    __device__ __forceinline__ int ltid() const { int t = threadIdx.x; asm volatile("" : "+v"(t)); return t; }
    const float *x, *c, *ctx, *cctx, *w_ada, *b_ada, *w_in, *lam_qk, *subln_g, *gln_g, *gln_b, *w_sp, *b_sp, *w_pool, *pool_scale, *w_branch, *w_out, *ln1_g, *ln1_b, *w_gu, *w_down, *ln2_g, *ln2_b;
    float* out;
    float *rope, *mods, *modp, *X;
    bf16 *Wsp, *Wpool, *Win, *Wbr, *Wout, *Wgu, *Wdn, *HA, *Y, *MG, *Z, *KB, *VB;
};

typedef __attribute__((address_space(4))) const unsigned char* kptr_t;
__device__ __forceinline__ void frame_ptrs(Frame& F) {
    kptr_t kp = (kptr_t)__builtin_amdgcn_kernarg_segment_ptr(); asm volatile("" : "+s"(kp));
#define KIN(i) (*(const float* const __attribute__((address_space(4)))*)(kp + 8 * (i)))
    F.x = KIN(0); F.c = KIN(1); F.ctx = KIN(2); F.cctx = KIN(3); F.w_ada = KIN(4); F.b_ada = KIN(5); F.w_in = KIN(6); F.lam_qk = KIN(7); F.subln_g = KIN(8);
    F.gln_g = KIN(9); F.gln_b = KIN(10); F.w_sp = KIN(11); F.b_sp = KIN(12); F.w_pool = KIN(13); F.pool_scale = KIN(14); F.w_branch = KIN(15); F.w_out = KIN(16);
    F.ln1_g = KIN(17); F.ln1_b = KIN(18); F.w_gu = KIN(19); F.w_down = KIN(20); F.ln2_g = KIN(21); F.ln2_b = KIN(22);
#undef KIN
    F.out = *(float* const __attribute__((address_space(4)))*)(kp + 184);
    unsigned char* ws = *(unsigned char* const __attribute__((address_space(4)))*)(kp + 192);
    F.rope = (float*)(ws + WS_ROPE); F.mods = (float*)(ws + WS_MODS); F.modp = (float*)(ws + WS_MODP); F.X = (float*)(ws + WS_X);
    F.Wsp = (bf16*)(ws + WS_WSP); F.Wpool = (bf16*)(ws + WS_WPOOL); F.Win = (bf16*)(ws + WS_WIN); F.Wbr = (bf16*)(ws + WS_WBR); F.Wout = (bf16*)(ws + WS_WOUT); F.Wgu = (bf16*)(ws + WS_WGU); F.Wdn = (bf16*)(ws + WS_WDN);
    F.HA = (bf16*)(ws + WS_HA); F.Y = (bf16*)(ws + WS_Y); F.MG = (bf16*)(ws + WS_MG); F.Z = (bf16*)(ws + WS_Z); F.KB = (bf16*)(ws + WS_KB); F.VB = (bf16*)(ws + WS_VB);
}
__device__ __forceinline__ float wave_sum(float v) {
#pragma unroll
    for (int o = 1; o < 64; o <<= 1) v += __shfl_xor(v, o);
    return v;
}

__device__ __forceinline__ void cvt_item(const float* W, int N, int k0, int ncol0, bool perm, bf16* WT, size_t drow0, int ldk, int dk0, LAS float* scr, int lane) {
#pragma unroll 8
    for (int i = 0; i < 32; ++i) { const int kk = 2 * i + (lane >> 5); scr[kk * 33 + (lane & 31)] = W[(size_t)(k0 + kk) * N + ncol0 + (lane & 31)]; }
    LDS_WAIT(); asm volatile("" ::: "memory");
    const int c = lane & 7;
#pragma unroll
    for (int j = 0; j < 4; ++j) { const int n = (lane >> 3) + 8 * j; const int ns = perm ? ((n & 1) * 16 + (n >> 1)) : n; const LAS float* s = scr + (8 * c) * 33 + ns;
        v4u o; o.x = pk2(s[0 * 33], s[1 * 33]); o.y = pk2(s[2 * 33], s[3 * 33]); o.z = pk2(s[4 * 33], s[5 * 33]); o.w = pk2(s[6 * 33], s[7 * 33]);
        *(GAS v4u*)(WT + (drow0 + n) * (size_t)ldk + dk0 + k0 + 8 * c) = o; }
    LDS_WAIT(); asm volatile("" ::: "memory");
}
constexpr int CV_IN = 32 * 384, CV_GU = 32 * 352, CV_DN = 88 * 64, CV_BR = 3 * 16 * 64, CV_OUT = 32 * 64, CV_POOL = 4 * 4 * 8, CV_LAYER = CV_IN + CV_GU + CV_DN + CV_BR + CV_OUT + CV_POOL;
__device__ __forceinline__ void cvt_dispatch(Frame& F, int it, LAS float* scr) {
    const int l = it / CV_LAYER; int r = it - l * CV_LAYER;
    if (r < CV_IN) { const int kb = r / 384, nb = r - kb * 384;
        cvt_item(F.w_in + (size_t)l * D * INW, INW, 64 * kb, 32 * nb, nb < 64, F.Win + (size_t)l * INW * D, (size_t)32 * nb, D, 0, scr, (F.ltid() & 63)); return; }
    r -= CV_IN;
    if (r < CV_GU) { const int kb = r / 352, nb = r - kb * 352; const int tpn = nb >> 3, half = (nb >> 2) & 1, jj0 = (nb & 3) * 32;
        cvt_item(F.w_gu + (size_t)l * D * 2 * FFH, 2 * FFH, 64 * kb, half * FFH + 128 * tpn + jj0, false, F.Wgu + (size_t)l * 2 * FFH * D, (size_t)32 * nb, D, 0, scr, (F.ltid() & 63)); return; }
    r -= CV_GU;
    if (r < CV_DN) { const int kb = r >> 6, nb = r & 63;
        cvt_item(F.w_down + (size_t)l * FFH * D, D, 64 * kb, 32 * nb, false, F.Wdn + (size_t)l * D * FFH, (size_t)32 * nb, FFH, 0, scr, (F.ltid() & 63)); return; }
    r -= CV_DN;
    if (r < CV_BR) { const int n = r >> 10, rr = r & 1023, kb = rr >> 6, nb = rr & 63;
        cvt_item(F.w_branch + ((size_t)l * 3 + n) * BW * D, D, 64 * kb, 32 * nb, false, F.Wbr + (size_t)l * D * YW, (size_t)32 * nb, YW, BW * n, scr, (F.ltid() & 63)); return; }
    r -= CV_BR;
    if (r < CV_OUT) { const int kb = r >> 6, nb = r & 63;
        cvt_item(F.w_out + (size_t)l * D * D, D, 64 * kb, 32 * nb, false, F.Wout + (size_t)l * D * D, (size_t)32 * nb, D, 0, scr, (F.ltid() & 63)); return; }
    r -= CV_OUT;
    { const int g = r >> 5, rr = r & 31, kb = rr >> 3, nb = rr & 7;
        cvt_item(F.w_pool + ((size_t)l * 4 + g) * 65536, 256, 64 * kb, 32 * nb, false, F.Wpool + ((size_t)l * 4 + g) * 65536, (size_t)32 * nb, 256, 0, scr, (F.ltid() & 63)); }
}

__device__ __forceinline__ double rope_inv(int p) {
    const double t[16] = {1.0, 0.5623413251903491, 0.31622776601683794, 0.1778279410038923, 0.1, 0.05623413251903491, 0.03162277660168379, 0.01778279410038923,
                          0.01, 0.005623413251903491, 0.003162277660168379, 0.001778279410038923, 0.001, 0.0005623413251903491, 0.00031622776601683794, 0.0001778279410038923};
    double r = t[0];
#pragma unroll
    for (int i = 1; i < 16; ++i) r = (p == i) ? t[i] : r;
    return r;
}
#ifndef TAILWORK
#define TAILWORK 0
#endif
__device__ __forceinline__ void ada_partial_layer(Frame& F, int l, int gw, int NGW) {
    LAS float* scs = (LAS float*)(F.lds);
    __syncthreads();
    for (int i = F.ltid(); i < 5 * D; i += NWAVES * 64) { const int g = i >> 11, k = i & 2047; const float v = g < 4 ? F.c[g * D + k] : F.cctx[k]; scs[i] = v / (1.0f + __expf(-v)); }
    __syncthreads();
    for (int it = gw; it < 16 * 48; it += NGW) {
        const int ks = it / 48, cgw = it - ks * 48; const int col = cgw * 256 + (F.ltid() & 63) * 4;
        const float* wp = F.w_ada + ((size_t)l * D + ks * 128) * INW + col;
        f32x4 a0 = {0.f, 0.f, 0.f, 0.f}, a1 = a0, a2 = a0, a3 = a0, a4 = a0;
#pragma unroll 8
        for (int k = 0; k < 128; ++k) { const f32x4 w = *(const GAS f32x4*)(wp + (size_t)k * INW); const int kk = ks * 128 + k;
            a0 += w * scs[kk]; a1 += w * scs[D + kk]; a2 += w * scs[2 * D + kk]; a3 += w * scs[3 * D + kk]; a4 += w * scs[4 * D + kk]; }
        float* pp = F.modp + (((size_t)ks * 4 + l) * 5) * INW + col;
        *(f32x4*)(pp) = a0; *(f32x4*)(pp + INW) = a1; *(f32x4*)(pp + 2 * INW) = a2; *(f32x4*)(pp + 3 * INW) = a3; *(f32x4*)(pp + 4 * INW) = a4;
    }
    __syncthreads();
}
__device__ __forceinline__ void cvt_layer(Frame& F, int l, int gw, int NGW) {
    LAS float* scr = (LAS float*)(F.lds + __builtin_amdgcn_readfirstlane(F.ltid() >> 6) * 16384);
    for (int it = gw; it < CV_LAYER; it += NGW) cvt_dispatch(F, l * CV_LAYER + it, scr);
}
__device__ __forceinline__ void mods_reduce_layer(Frame& F, int l) {
    const int gt = F.vcu * NWAVES * 64 + F.ltid(), NGT = F.G * NWAVES * 64;
    for (int i = gt; i < 5 * (INW / 4); i += NGT) { const int g = i / (INW / 4), j = (i - g * (INW / 4)) * 4;
        f32x4 sm = *(const f32x4*)(F.b_ada + (size_t)l * INW + j);
#pragma unroll
        for (int ks = 0; ks < 16; ++ks) sm += *(const f32x4*)(F.modp + (((size_t)ks * 4 + l) * 5 + g) * INW + j);
        *(f32x4*)(F.mods + ((size_t)l * 5 + g) * INW + j) = sm; }
}
__device__ __forceinline__ void phase_a1(Frame& F) {
    const int gw = F.vcu * NWAVES + __builtin_amdgcn_readfirstlane(F.ltid() >> 6), NGW = F.G * NWAVES;
#pragma nounroll
    for (int l = 0; l < (TAILWORK ? 1 : DEPTH); ++l) ada_partial_layer(F, l, gw, NGW);
#pragma nounroll
    for (int l = 0; l < (TAILWORK ? 1 : DEPTH); ++l) cvt_layer(F, l, gw, NGW);
    for (int it = gw; it < (DEPTH * 8 * 128 * 128) / 512; it += NGW) { const size_t e = (size_t)it * 512 + (F.ltid() & 63) * 8;
        const f32x4 a = *(const f32x4*)(F.w_sp + e), b = *(const f32x4*)(F.w_sp + e + 4);
        v4u o; o.x = pk2(a[0], a[1]); o.y = pk2(a[2], a[3]); o.z = pk2(b[0], b[1]); o.w = pk2(b[2], b[3]); *(v4u*)(F.Wsp + e) = o; }
    if (gw == 0) {
        for (int e = (F.ltid() & 63); e < 1024; e += 64) { const int pos = e >> 4, pr = e & 15;
            const double ang = (double)pos * rope_inv(pr); const double twopi = 6.283185307179586476925286766559;
            const double kq = __builtin_rint(ang / twopi); const double rr = ang - kq * twopi; const double r2 = rr * rr;
            double sn = 1.0, cs = 1.0;
#pragma unroll
            for (int n = 14; n >= 1; --n) { sn = 1.0 - sn * r2 / (double)((2 * n) * (2 * n + 1)); cs = 1.0 - cs * r2 / (double)((2 * n - 1) * (2 * n)); }
            sn *= rr;
            F.rope[2 * e] = (float)cs; F.rope[2 * e + 1] = (float)sn; }
    }
}
__device__ __forceinline__ void phase_a2(Frame& F) {
#pragma nounroll
    for (int l = 0; l < (TAILWORK ? 1 : DEPTH); ++l) mods_reduce_layer(F, l); }
__device__ __forceinline__ void ln_row(const float* src, const bf16* tadd, const float* part, int npart, const float* gam, const float* bet, float* xo, float xs, bf16* ho, const float* sc, const float* sh, int lane) {
    f32x4 v[8]; float s = 0.f;
#pragma unroll
    for (int j = 0; j < 8; ++j) v[j] = *(const GAS f32x4*)(src + 4 * lane + 256 * j);
    if (tadd) {
#pragma unroll
        for (int j = 0; j < 8; ++j) { const v2u t2 = *(const GAS v2u*)(tadd + 4 * lane + 256 * j); v[j] += (f32x4){bflo(t2.x), bfhi(t2.x), bflo(t2.y), bfhi(t2.y)}; } }
    for (int p = 0; p < npart; ++p) {
#pragma unroll
        for (int j = 0; j < 8; ++j) v[j] += *(const GAS f32x4*)(part + (size_t)p * 1024 * D + 4 * lane + 256 * j); }
#pragma unroll
    for (int j = 0; j < 8; ++j) s += (v[j][0] + v[j][1]) + (v[j][2] + v[j][3]);
    const float mean = wave_sum(s) * (1.f / D); float s2 = 0.f;
#pragma unroll
    for (int j = 0; j < 8; ++j) { v[j] = v[j] - mean; s2 += (v[j][0] * v[j][0] + v[j][1] * v[j][1]) + (v[j][2] * v[j][2] + v[j][3] * v[j][3]); }
    const float rstd = 1.0f / sqrtf(wave_sum(s2) * (1.f / D) + LN_EPS);
#pragma unroll
    for (int j = 0; j < 8; ++j) { const int col = 4 * lane + 256 * j; f32x4 xn = v[j] * rstd;
        if (gam) xn = xn * *(const f32x4*)(gam + col) + *(const f32x4*)(bet + col);
        if (xo) *(GAS f32x4*)(xo + col) = xn * xs;
        if (ho) { const f32x4 hv = xn * (1.0f + *(const f32x4*)(sc + col)) + *(const f32x4*)(sh + col); v2u o; o.x = pk2(hv[0], hv[1]); o.y = pk2(hv[2], hv[3]); *(GAS v2u*)(ho + col) = o; } }
}
__device__ __forceinline__ int row_group(int row) { return row < MLAT ? (row >> 12) : 4; }
__device__ __forceinline__ void phase_a3(Frame& F) {
    const int gw = F.vcu * NWAVES + __builtin_amdgcn_readfirstlane(F.ltid() >> 6), NGW = F.G * NWAVES;
    for (int row = gw; row < MTOT; row += NGW) { const float* src = row < MLAT ? F.x + (size_t)row * D : F.ctx + (size_t)(row - MLAT) * D; const float* md = F.mods + (size_t)row_group(row) * INW;
        ln_row(src, nullptr, nullptr, 0, nullptr, nullptr, F.X + (size_t)row * D, ALPHA, F.HA + (size_t)row * D, md + D, md, (F.ltid() & 63)); }
}
__device__ __forceinline__ void ln_finish(f32x4 (&v)[8], const float* gam, const float* bet, float* xo, float xs, bf16* ho, const float* sc, const float* sh, int lane) {
    float s = 0.f;
#pragma unroll
    for (int j = 0; j < 8; ++j) s += (v[j][0] + v[j][1]) + (v[j][2] + v[j][3]);
    const float mean = wave_sum(s) * (1.f / D); float s2 = 0.f;
#pragma unroll
    for (int j = 0; j < 8; ++j) { v[j] = v[j] - mean; s2 += (v[j][0] * v[j][0] + v[j][1] * v[j][1]) + (v[j][2] * v[j][2] + v[j][3] * v[j][3]); }
    const float rstd = 1.0f / sqrtf(wave_sum(s2) * (1.f / D) + LN_EPS);
#pragma unroll
    for (int j = 0; j < 8; ++j) { const int col = 4 * lane + 256 * j; f32x4 xn = v[j] * rstd;
        xn = xn * *(const f32x4*)(gam + col) + *(const f32x4*)(bet + col);
        if (xo) *(GAS f32x4*)(xo + col) = xn * xs;
        if (ho) { const f32x4 hv = xn * (1.0f + *(const f32x4*)(sc + col)) + *(const f32x4*)(sh + col); v2u o; o.x = pk2(hv[0], hv[1]); o.y = pk2(hv[2], hv[3]); *(GAS v2u*)(ho + col) = o; } }
}
__device__ __forceinline__ void phase_ln(Frame& F, const float* gam, const float* bet, int nrows, bool to_out, bool want_h, int lm, int moff, int nsplit, bool dry = false) {
    const int gw = F.vcu * NWAVES + __builtin_amdgcn_readfirstlane(F.ltid() >> 6), NGW = F.G * NWAVES; const int lane = F.ltid() & 63;
    f32x4 xa[8]; v2u ta[8];
    int row = gw;
    if (row < MLAT) {
#pragma unroll
        for (int j = 0; j < 8; ++j) { xa[j] = *(const GAS f32x4*)(F.X + (size_t)row * D + 4 * lane + 256 * j); ta[j] = *(const GAS v2u*)(F.Y + (size_t)row * D + 4 * lane + 256 * j); } }
    for (; row < MLAT; row += NGW) {
        f32x4 v[8];
#pragma unroll
        for (int j = 0; j < 8; ++j) v[j] = xa[j] + (f32x4){bflo(ta[j].x), bfhi(ta[j].x), bflo(ta[j].y), bfhi(ta[j].y)};
        const int nx = row + NGW;
        if (nx < MLAT) {
#pragma unroll
            for (int j = 0; j < 8; ++j) { xa[j] = *(const GAS f32x4*)(F.X + (size_t)nx * D + 4 * lane + 256 * j); ta[j] = *(const GAS v2u*)(F.Y + (size_t)nx * D + 4 * lane + 256 * j); } }
        const float* md = F.mods + ((size_t)lm * 5 + (row >> 12)) * INW + moff;
        ln_finish(v, gam, bet, dry ? (float*)(F.Z + (size_t)134 * MiB) + (size_t)row * D : (to_out ? F.out + (size_t)row * D : F.X + (size_t)row * D), to_out ? 1.0f : ALPHA, want_h ? (dry ? F.MG : F.HA) + (size_t)row * D : nullptr, md + D, md, lane);
    }
    for (; row < nrows; row += NGW) { const float* md = F.mods + ((size_t)lm * 5 + 4) * INW + moff;
        ln_row(F.X + (size_t)row * D, nullptr, (const float*)(F.Z + (size_t)100 * MiB) + (size_t)(row - MLAT) * D, nsplit, gam, bet, dry ? (float*)(F.Z + (size_t)134 * MiB) + (size_t)row * D : (to_out ? F.out + (size_t)row * D : F.X + (size_t)row * D), to_out ? 1.0f : ALPHA, want_h ? (dry ? F.MG : F.HA) + (size_t)row * D : nullptr, md + D, md, lane); }
}

constexpr int AT_KB = 0, AT_VB = 32768, AT_TILE = 16384, AT_XB = 65536;
__device__ __forceinline__ s16x4 vtr(const LAS unsigned char* p) { typedef short v4i16_t __attribute__((ext_vector_type(4))); return __builtin_bit_cast(s16x4, __builtin_amdgcn_ds_read_tr16_b64_v4i16((LAS v4i16_t*)p)); }
__device__ __forceinline__ float max3f(float a, float b, float c) { float r; asm("v_max3_f32 %0, %1, %2, %3" : "=v"(r) : "v"(a), "v"(b), "v"(c)); return r; }
__device__ __forceinline__ void glds16(const void* gsrc, unsigned lds_dst) { unsigned keep;
    asm volatile("s_mov_b32 %0, m0\n\ts_mov_b32 m0, %2\n\ts_nop 0\n\tglobal_load_lds_dwordx4 %1, off\n\ts_mov_b32 m0, %0" : "=&s"(keep) : "v"(gsrc), "s"(lds_dst) : "memory"); }
#define AT_WAITV(n) asm volatile("s_waitcnt vmcnt(" #n ")" ::: "memory")
#define AT_BAR() asm volatile("s_waitcnt lgkmcnt(0)\n\ts_barrier" ::: "memory")
__device__ __forceinline__ void attn_unit(Frame& F, int b, int h, int qb, bool ctxq, float lam, float oscale, const float* subg) {
    int lane_ = (F.ltid() & 63); asm volatile("" : "+v"(lane_));
    const int lane = lane_, wid = __builtin_amdgcn_readfirstlane(F.ltid() >> 6), r32 = lane & 31, hi = lane >> 5, m = wid >> 2, qg = wid & 3; const bool lead = wid < 4;
    const bf16* Z = F.Z;
    const int qrow = (ctxq ? MLAT + b * CTXL : b * SEQ) + qb * 128 + qg * 32 + r32;
    bf16x8 qf[4];
#pragma unroll
    for (int d0 = 0; d0 < 4; ++d0) qf[d0] = *(const GAS bf16x8*)(Z + (size_t)qrow * INW + Q_OFF + h * 128 + m * 64 + d0 * 16 + hi * 8);
    const int NT = ctxq ? 4 : 68;
    const bf16* Kbh = F.KB + (size_t)(b * 8 + h) * 4352 * 128; const bf16* Vbh = F.VB + (size_t)(b * 8 + h) * 4352 * 128;
    const unsigned lds0 = (unsigned)(size_t)F.lds;
    const int prow = 8 * wid + (lane >> 4), ppos = lane & 15;
    const unsigned koff0 = (unsigned)(prow * 128 + ((ppos ^ (prow & 15)) * 8)), koff1 = (unsigned)((prow + 4) * 128 + ((ppos ^ ((prow + 4) & 15)) * 8));
    const unsigned voff0 = (unsigned)(prow * 128 + ((ppos ^ (4 * (prow & 3))) * 8)), voff1 = voff0 + 4 * 128;
    const unsigned kdst = (unsigned)__builtin_amdgcn_readfirstlane((int)(lds0 + AT_KB + wid * 2048)), vdst = (unsigned)__builtin_amdgcn_readfirstlane((int)(lds0 + AT_VB + wid * 2048));
#define AT_DMAK(t, bufo) do { const bf16* tb_ = Kbh + (size_t)(t) * 8192; glds16(tb_ + koff0, kdst + (bufo)); glds16(tb_ + koff1, kdst + (bufo) + 1024); } while (0)
#define AT_DMAV(t, bufo) do { const bf16* tb_ = Vbh + (size_t)(t) * 8192; glds16(tb_ + voff0, vdst + (bufo)); glds16(tb_ + voff1, vdst + (bufo) + 1024); } while (0)
    f32x16 o[4];
#pragma unroll
    for (int db = 0; db < 4; ++db)
#pragma unroll
        for (int r = 0; r < 16; ++r) o[db][r] = 0.f;
    float mref = 0.f, lsum = 0.f;
    f32x16 negm;
#pragma unroll
    for (int r = 0; r < 16; ++r) negm[r] = 0.f;
    const unsigned kaddr0 = AT_KB + r32 * 256 + (((8 * m + hi) ^ (r32 & 15)) << 4);
    const int a4 = (lane & 15) >> 2, cc = 2 * ((lane >> 4) & 1) + ((lane & 3) >> 1);
    const unsigned vaddr0 = AT_VB + (4 * hi + a4) * 256 + ((4 * a4 + cc) << 4) + 8 * (lane & 1);
    __syncthreads();
    AT_DMAK(0, 0); AT_DMAV(0, 0);
    AT_WAITV(2); AT_BAR();
    if (!lead) { if (NT > 1) { AT_DMAK(1, AT_TILE); AT_WAITV(2); } else AT_WAITV(0); AT_BAR(); }
    for (int t = 0; t < NT; ++t) {
        const unsigned bo = (t & 1) ? AT_TILE : 0; const bool more = (t + 1 < NT);
        if (more) { if (lead) AT_DMAK(t + 1, bo ^ AT_TILE); else AT_DMAV(t + 1, bo ^ AT_TILE); }
        unsigned kb_ = kaddr0 + bo, vb_ = vaddr0 + bo; asm volatile("" : "+v"(kb_), "+v"(vb_));
        f32x16 p0, p1;
        { bf16x8 kf[4][2];
#pragma unroll
          for (int d0 = 0; d0 < 4; ++d0) { const unsigned ka = kb_ ^ (unsigned)((2 * d0) << 4); kf[d0][0] = *(const LAS bf16x8*)(F.lds + ka); kf[d0][1] = *(const LAS bf16x8*)(F.lds + ka + 32 * 256); }
          __builtin_amdgcn_sched_barrier(0);
          p0 = __builtin_amdgcn_mfma_f32_32x32x16_bf16(kf[0][0], qf[0], negm, 0, 0, 0);
#pragma unroll
          for (int d0 = 1; d0 < 4; ++d0) p0 = __builtin_amdgcn_mfma_f32_32x32x16_bf16(kf[d0][0], qf[d0], p0, 0, 0, 0);
          p1 = __builtin_amdgcn_mfma_f32_32x32x16_bf16(kf[0][1], qf[0], negm, 0, 0, 0);
#pragma unroll
          for (int d0 = 1; d0 < 4; ++d0) p1 = __builtin_amdgcn_mfma_f32_32x32x16_bf16(kf[d0][1], qf[d0], p1, 0, 0, 0); }
#define AT_SOFTMAX(P, OTHER, PK, FIRST) do { \
        float tmax = max3f(P[0], P[1], P[2]); \
        _Pragma("unroll") for (int r = 3; r < 15; r += 2) tmax = max3f(tmax, P[r], P[r + 1]); \
        tmax = __builtin_fmaxf(tmax, P[15]); { auto rr_ = __builtin_amdgcn_permlane32_swap(__float_as_uint(tmax), __float_as_uint(tmax), false, false); tmax = __builtin_fmaxf(__uint_as_float(rr_[0]), __uint_as_float(rr_[1])); } \
        if (FIRST) { mref = tmax; \
            _Pragma("unroll") for (int r = 0; r < 16; ++r) { P[r] -= tmax; OTHER[r] -= tmax; negm[r] = -mref; } \
        } else if (__any(tmax > 8.0f)) { \
            const float dl = __builtin_fmaxf(tmax, 0.f); mref += dl; const float al = __builtin_amdgcn_exp2f(-dl); lsum *= al; \
            _Pragma("unroll") for (int r = 0; r < 16; ++r) { P[r] -= dl; OTHER[r] -= dl; negm[r] = -mref; } \
            _Pragma("unroll") for (int db = 0; db < 4; ++db) _Pragma("unroll") for (int r = 0; r < 16; ++r) o[db][r] *= al; \
        } \
        float ls0_ = 0.f, ls1_ = 0.f, ls2_ = 0.f, ls3_ = 0.f; \
        _Pragma("unroll") for (int r = 0; r < 16; r += 4) { P[r] = __builtin_amdgcn_exp2f(P[r]); P[r + 1] = __builtin_amdgcn_exp2f(P[r + 1]); P[r + 2] = __builtin_amdgcn_exp2f(P[r + 2]); P[r + 3] = __builtin_amdgcn_exp2f(P[r + 3]); \
            ls0_ += P[r]; ls1_ += P[r + 1]; ls2_ += P[r + 2]; ls3_ += P[r + 3]; } \
        lsum += (ls0_ + ls1_) + (ls2_ + ls3_); \
        _Pragma("unroll") for (int s_ = 0; s_ < 2; ++s_) { v4u w_; \
            w_.x = cvtpk(P[8 * s_ + 0], P[8 * s_ + 1]); w_.y = cvtpk(P[8 * s_ + 2], P[8 * s_ + 3]); w_.z = cvtpk(P[8 * s_ + 4], P[8 * s_ + 5]); w_.w = cvtpk(P[8 * s_ + 6], P[8 * s_ + 7]); \
            PK[s_] = __builtin_bit_cast(bf16x8, w_); } } while (0)
        bf16x8 pka[2], pkb[2];
        f32x16 dummy_;
        AT_SOFTMAX(p0, p1, pka, t == 0);
        if (more) AT_WAITV(2); else AT_WAITV(0);
        AT_BAR();
        if (lead) { if (more) AT_DMAV(t + 1, bo ^ AT_TILE); } else { if (t + 2 < NT) AT_DMAK(t + 2, bo); }
        { s16x4 va_[4][2][2], vc_[4][2][2];
#define AT_VLOAD(dst, kh_) do { _Pragma("unroll") for (int d_ = 0; d_ < 4; ++d_) { const unsigned va = vb_ ^ (unsigned)(d_ << 6); \
            _Pragma("unroll") for (int s_ = 0; s_ < 2; ++s_) { dst[d_][s_][0] = vtr(F.lds + va + (32 * (kh_) + 16 * s_) * 256); dst[d_][s_][1] = vtr(F.lds + va + (32 * (kh_) + 16 * s_ + 8) * 256); } } } while (0)
#define AT_VMMA(src, PK) do { _Pragma("unroll") for (int s_ = 0; s_ < 2; ++s_) _Pragma("unroll") for (int d_ = 0; d_ < 4; ++d_) { \
            const bf16x8 vf = (bf16x8){src[d_][s_][0][0], src[d_][s_][0][1], src[d_][s_][0][2], src[d_][s_][0][3], src[d_][s_][1][0], src[d_][s_][1][1], src[d_][s_][1][2], src[d_][s_][1][3]}; \
            o[d_] = __builtin_amdgcn_mfma_f32_32x32x16_bf16(vf, PK[s_], o[d_], 0, 0, 0); } } while (0)
          AT_VLOAD(va_, 0); __builtin_amdgcn_sched_barrier(0);
          AT_VLOAD(vc_, 1); __builtin_amdgcn_sched_barrier(0);
          AT_VMMA(va_, pka);
          AT_SOFTMAX(p1, dummy_, pkb, false);
          AT_VMMA(vc_, pkb);
          __builtin_amdgcn_sched_barrier(0);
#undef AT_VLOAD
#undef AT_VMMA
        }
#undef AT_SOFTMAX
        if (lead) { if (more) AT_WAITV(2); } else { if (t + 2 < NT) AT_WAITV(2); else AT_WAITV(0); }
        AT_BAR();
    }
    if (lead) AT_BAR();
    const float lt = lsum + __shfl_xor(lsum, 32);
    LAS float* xs = (LAS float*)(F.lds + AT_XB) + qg * 4096 + lane;
    if (!lead) { const float sc1 = lam / lt;
#pragma unroll
        for (int db = 0; db < 4; ++db)
#pragma unroll
            for (int r = 0; r < 16; ++r) xs[(db * 16 + r) * 64] = o[db][r] * sc1; }
    __syncthreads();
    if (lead) {
        const float i0 = 1.0f / lt; float ss = 0.f;
#pragma unroll
        for (int db = 0; db < 4; ++db)
#pragma unroll
            for (int r = 0; r < 16; ++r) { const float v = o[db][r] * i0 - xs[(db * 16 + r) * 64]; o[db][r] = v; ss += v * v; }
        ss += __shfl_xor(ss, 32);
        const float rs = oscale / sqrtf(ss * (1.0f / 128.0f) + LN_EPS);
        bf16* yp = F.Y + (size_t)qrow * YW + h * 128 + 4 * hi;
#pragma unroll
        for (int db = 0; db < 4; ++db)
#pragma unroll
            for (int g4 = 0; g4 < 4; ++g4) { const int d = 32 * db + 8 * g4; const f32x4 gv = *(const f32x4*)(subg + d + 4 * hi);
                v2u w; w.x = cvtpk(o[db][4 * g4 + 0] * rs * gv[0], o[db][4 * g4 + 1] * rs * gv[1]); w.y = cvtpk(o[db][4 * g4 + 2] * rs * gv[2], o[db][4 * g4 + 3] * rs * gv[3]);
                *(GAS v2u*)(yp + d) = w; }
    }
#undef AT_DMAK
#undef AT_DMAV
}

constexpr int GM_ST = 0, GM_VT = 1024, GM_VP = 272;
__device__ __forceinline__ void gmlp_unit(Frame& F, int row0, int l) {
    int tid_ = F.ltid(); asm volatile("" : "+v"(tid_)); const int tid = tid_, lane = tid & 63, wid = __builtin_amdgcn_readfirstlane(F.ltid() >> 6);
    typedef float f32x2v __attribute__((ext_vector_type(2)));
    LAS f32x2v* st = (LAS f32x2v*)(F.lds + GM_ST); LAS unsigned char* vt = F.lds + GM_VT;
    const bf16* Z = F.Z;
    __syncthreads();
#pragma unroll
    for (int hb = 0; hb < 2; ++hb) {
        v4u va[8], vb[8];
#pragma unroll
        for (int i = 0; i < 8; ++i) { const bf16* vp = Z + (size_t)(row0 + wid * 16 + hb * 8 + i) * INW + BU_OFF + BW + lane * 16; va[i] = *(const GAS v4u*)(vp); vb[i] = *(const GAS v4u*)(vp + 8); }
#pragma unroll
        for (int i = 0; i < 8; ++i) { const v4u a = va[i], b2 = vb[i];
            const float x[16] = {bflo(a.x), bfhi(a.x), bflo(a.y), bfhi(a.y), bflo(a.z), bfhi(a.z), bflo(a.w), bfhi(a.w), bflo(b2.x), bfhi(b2.x), bflo(b2.y), bfhi(b2.y), bflo(b2.z), bfhi(b2.z), bflo(b2.w), bfhi(b2.w)};
            float s = 0.f;
#pragma unroll
            for (int e = 0; e < 16; ++e) s += x[e];
            const float mean = wave_sum(s) * (1.0f / 1024.0f); float q = 0.f;
#pragma unroll
            for (int e = 0; e < 16; ++e) { const float dd = x[e] - mean; q += dd * dd; }
            const float rstd = 1.0f / sqrtf(wave_sum(q) * (1.0f / 1024.0f) + LN_EPS);
            if (lane == 0) st[wid * 16 + hb * 8 + i] = (f32x2v){mean, rstd}; }
    }
    const float* lng = F.gln_g + (size_t)l * BW; const float* lnb = F.gln_b + (size_t)l * BW;
    const int j = tid & 127, cc = tid >> 7;
    const int fr = lane & 15, fq = lane >> 4, tok = wid * 16 + fr;
    const bf16* vsrc = Z + (size_t)(row0 + j) * INW + BU_OFF + BW + cc * 32;
    v4u vr[4];
#pragma unroll
    for (int q4 = 0; q4 < 4; ++q4) vr[q4] = *(const GAS v4u*)(vsrc + q4 * 8);
    __syncthreads();
    const f32x2v sj = st[j];
#pragma unroll 1
    for (int g = 0; g < 8; ++g) {
        bf16x8 wf[4]; v2u uu[8];
        const bf16* wg = F.Wsp + ((size_t)l * 8 + g) * 16384 + (size_t)tok * 128 + fq * 8;
#pragma unroll
        for (int ks = 0; ks < 4; ++ks) wf[ks] = *(const GAS bf16x8*)(wg + ks * 32);
        const bf16* up = Z + (size_t)(row0 + tok) * INW + BU_OFF + g * 128 + 4 * fq;
#pragma unroll
        for (int ct = 0; ct < 8; ++ct) uu[ct] = *(const GAS v2u*)(up + ct * 16);
        const float bias = F.b_sp[((size_t)l * 8 + g) * 128 + tok];
#pragma unroll
        for (int q4 = 0; q4 < 4; ++q4) { const v4u a = vr[q4]; const int c0 = cc * 32 + q4 * 8;
            const f32x4 g0 = *(const f32x4*)(lng + g * 128 + c0), g1 = *(const f32x4*)(lng + g * 128 + c0 + 4), b0 = *(const f32x4*)(lnb + g * 128 + c0), b1 = *(const f32x4*)(lnb + g * 128 + c0 + 4);
            const float xv[8] = {bflo(a.x), bfhi(a.x), bflo(a.y), bfhi(a.y), bflo(a.z), bfhi(a.z), bflo(a.w), bfhi(a.w)};
#pragma unroll
            for (int e = 0; e < 8; ++e) { const float gg = e < 4 ? g0[e & 3] : g1[e & 3], bb = e < 4 ? b0[e & 3] : b1[e & 3]; const float y = (xv[e] - sj.x) * sj.y * gg + bb;
                *(LAS bf16*)(vt + (c0 + e) * GM_VP + j * 2) = (bf16)f2bf(y); } }
        if (g < 7) {
#pragma unroll
            for (int q4 = 0; q4 < 4; ++q4) vr[q4] = *(const GAS v4u*)(vsrc + (g + 1) * 128 + q4 * 8);
        }
        __syncthreads();
#pragma unroll
        for (int ct = 0; ct < 8; ++ct) { f32x4 acc = {0.f, 0.f, 0.f, 0.f};
#pragma unroll
            for (int ks = 0; ks < 4; ++ks) { const bf16x8 af = *(const LAS bf16x8*)(vt + (ct * 16 + fr) * GM_VP + (ks * 32 + fq * 8) * 2); acc = __builtin_amdgcn_mfma_f32_16x16x32_bf16(af, wf[ks], acc, 0, 0, 0); }
            const v2u u2 = uu[ct];
            v2u w; w.x = cvtpk(bflo(u2.x) * (acc[0] + bias), bfhi(u2.x) * (acc[1] + bias)); w.y = cvtpk(bflo(u2.y) * (acc[2] + bias), bfhi(u2.y) * (acc[3] + bias));
            *(GAS v2u*)(F.Y + (size_t)(row0 + tok) * YW + BW + g * 128 + ct * 16 + 4 * fq) = w; }
        __syncthreads();
    }
}

constexpr int PL_DP = 528;
template <int GI> __device__ __forceinline__ void pool_unit(Frame& F, int row0, int l) {
    int tid_ = F.ltid(); asm volatile("" : "+v"(tid_)); const int tid = tid_, lane = tid & 63, wid = __builtin_amdgcn_readfirstlane(F.ltid() >> 6);
    LAS unsigned char* dt = F.lds;
    const bf16* Z = F.Z;
    constexpr int W = 2 << GI, HW = W / 2, NR = 8 + W - 1;
    const int seqlen = row0 < MLAT ? SEQ : CTXL; const int s0 = row0 < MLAT ? (row0 & ~(SEQ - 1)) : MLAT + ((row0 - MLAT) & ~(CTXL - 1));
    const int fr = lane & 15, fq = lane >> 4;
    bf16x8 wa[8][2];
    { const bf16* wp = F.Wpool + ((size_t)l * 4 + GI) * 65536 + (size_t)(wid * 32 + fr) * 256 + fq * 8;
#pragma unroll
      for (int ks = 0; ks < 8; ++ks) { wa[ks][0] = *(const GAS bf16x8*)(wp + ks * 32); wa[ks][1] = *(const GAS bf16x8*)(wp + 16 * 256 + ks * 32); } }
    __syncthreads();
    { const int ch = tid & 31, tg = tid >> 5;
      const bf16* zc = Z + C_OFF + GI * 256 + ch * 8; const int p0 = row0 - s0 + tg * 8;
      v4u rw[NR];
#pragma unroll
      for (int k = 0; k < NR; ++k) { const int q = p0 - HW + k; const bool ok = (q >= 0) && (q < seqlen); const int qq = ok ? q : p0; const v4u a = *(const GAS v4u*)(zc + (size_t)(s0 + qq) * INW); rw[k] = ok ? a : (v4u){0u, 0u, 0u, 0u}; }
      float sum[8] = {0.f, 0.f, 0.f, 0.f, 0.f, 0.f, 0.f, 0.f};
#pragma unroll
      for (int k = 0; k < W; ++k) { const v4u a = rw[k]; sum[0] += bflo(a.x); sum[1] += bfhi(a.x); sum[2] += bflo(a.y); sum[3] += bfhi(a.y); sum[4] += bflo(a.z); sum[5] += bfhi(a.z); sum[6] += bflo(a.w); sum[7] += bfhi(a.w); }
#pragma unroll
      for (int i = 0; i < 8; ++i) { const int p = p0 + i; const int lo = p - HW < 0 ? 0 : p - HW; const int hi = p - HW + W > seqlen ? seqlen : p - HW + W; const float inv = 1.0f / (float)(hi - lo);
          const v4u zz = rw[i + HW];
          v4u o; o.x = pk2(sum[0] * inv - bflo(zz.x), sum[1] * inv - bfhi(zz.x)); o.y = pk2(sum[2] * inv - bflo(zz.y), sum[3] * inv - bfhi(zz.y));
          o.z = pk2(sum[4] * inv - bflo(zz.z), sum[5] * inv - bfhi(zz.z)); o.w = pk2(sum[6] * inv - bflo(zz.w), sum[7] * inv - bfhi(zz.w));
          *(LAS v4u*)(dt + (tg * 8 + i) * PL_DP + ch * 16) = o;
          if (i < 7) { const v4u a = rw[i + W], b = rw[i];
              sum[0] += bflo(a.x) - bflo(b.x); sum[1] += bfhi(a.x) - bfhi(b.x); sum[2] += bflo(a.y) - bflo(b.y); sum[3] += bfhi(a.y) - bfhi(b.y);
              sum[4] += bflo(a.z) - bflo(b.z); sum[5] += bfhi(a.z) - bfhi(b.z); sum[6] += bflo(a.w) - bflo(b.w); sum[7] += bfhi(a.w) - bfhi(b.w); } } }
    __syncthreads();
    { f32x4 acc[2][8];
#pragma unroll
      for (int a = 0; a < 2; ++a)
#pragma unroll
          for (int tt = 0; tt < 8; ++tt) acc[a][tt] = (f32x4){0.f, 0.f, 0.f, 0.f};
#pragma unroll
      for (int ks = 0; ks < 8; ++ks) {
#pragma unroll
          for (int tt = 0; tt < 8; ++tt) { const bf16x8 bfr = *(const LAS bf16x8*)(dt + (tt * 16 + fr) * PL_DP + (ks * 32 + fq * 8) * 2);
              acc[0][tt] = __builtin_amdgcn_mfma_f32_16x16x32_bf16(wa[ks][0], bfr, acc[0][tt], 0, 0, 0); acc[1][tt] = __builtin_amdgcn_mfma_f32_16x16x32_bf16(wa[ks][1], bfr, acc[1][tt], 0, 0, 0); } }
      const float* ps = F.pool_scale + (size_t)l * BW + GI * 256;
#pragma unroll
      for (int a = 0; a < 2; ++a) { const int dd = wid * 32 + a * 16 + 4 * fq; const f32x4 sc = *(const f32x4*)(ps + dd);
#pragma unroll
          for (int tt = 0; tt < 8; ++tt) { const f32x4 v = acc[a][tt] * sc; v2u wv; wv.x = cvtpk(v[0], v[1]); wv.y = cvtpk(v[2], v[3]);
              *(GAS v2u*)(F.Y + (size_t)(row0 + tt * 16 + fr) * YW + 2 * BW + GI * 256 + dd) = wv; } } }
}
__device__ __forceinline__ void pool_dispatch(Frame& F, int row0, int g, int l) {
    if (g == 0) pool_unit<0>(F, row0, l); else if (g == 1) pool_unit<1>(F, row0, l); else if (g == 2) pool_unit<2>(F, row0, l); else pool_unit<3>(F, row0, l);
}

#ifndef MIXM
#define MIXM 7
#endif
__device__ __forceinline__ void phase_mixers(Frame& F, int l, float lam_init) {
    const bool last = (l == DEPTH - 1);
    float d01 = 0.f, d23 = 0.f; const float* lq = F.lam_qk + (size_t)l * 256;
    for (int i = 0; i < 64; ++i) { d01 += lq[i] * lq[64 + i]; d23 += lq[128 + i] * lq[192 + i]; }
    const float lam = __expf(d01) - __expf(d23) + lam_init; const float oscale = 1.0f - lam_init;
    const float* subg = F.subln_g + (size_t)l * 128;
#ifndef REP_ATT
#define REP_ATT 1
#endif
#ifndef REP_GP
#define REP_GP 1
#endif
#pragma nounroll
    for (int i = 0; i < 5 * REP_ATT; ++i) { const int uid = F.vcu + F.G * (i % 5);
        if (!(MIXM & 1)) continue;
        if (uid < 1024) attn_unit(F, uid >> 8, (uid >> 5) & 7, uid & 31, false, lam, oscale, subg);
        else if (!last && uid < 1088) attn_unit(F, (uid - 1024) >> 4, ((uid - 1024) >> 1) & 7, uid & 1, true, lam, oscale, subg);
        if (TAILWORK == 2 && !last && i == (F.vcu & 3)) { __syncthreads(); const int gw_ = F.vcu * NWAVES + __builtin_amdgcn_readfirstlane(F.ltid() >> 6); ada_partial_layer(F, l + 1, gw_, F.G * NWAVES); cvt_layer(F, l + 1, gw_, F.G * NWAVES); } }
    const int nchunk = last ? MLAT / 128 : MTOT / 128;
#pragma nounroll
    for (int rgp = 0; rgp < REP_GP; ++rgp) {
    if (MIXM & 2) for (int cidx = F.G - 1 - F.vcu; cidx < nchunk; cidx += F.G) gmlp_unit(F, cidx * 128, l);
    if (MIXM & 4) { const int nfree = F.G - nchunk, npool = nchunk * 4;
        if (nfree > 0 && F.G == 256) {
            if (F.vcu < nfree) { for (int k = 0; k < 4; ++k) { const int u = F.vcu * 4 + k; if (u < npool) pool_dispatch(F, (u >> 2) * 128, u & 3, l); } }
            else { for (int u = nfree * 4 + (F.vcu - nfree); u < npool; u += nchunk) pool_dispatch(F, (u >> 2) * 128, u & 3, l); }
        } else { for (int u = F.vcu; u < npool; u += F.G) pool_dispatch(F, (u >> 2) * 128, u & 3, l); } }
    }
    __syncthreads();
}

#ifndef ALIGN_BIG
#define ALIGN_BIG true
#endif
#ifndef STAGGER
#define STAGGER 0
#endif
__device__ __forceinline__ void phase_stagger(int slot) { if (STAGGER) for (int i = 0; i < slot * 3; ++i) __builtin_amdgcn_s_sleep(8); }
#ifndef MK_ONE_LAUNCH
#define MK_ONE_LAUNCH 1
#endif
constexpr int NPHASE = 3 + 8 * DEPTH;
struct Args { const float* in[23]; float* out; unsigned char* ws; int ph_lo, ph_hi; float lam_init[4]; };
__global__ void __launch_bounds__(NWAVES * 64, 2) fwd(Args args) {
    extern __shared__ __attribute__((aligned(16))) unsigned char lds[];
    Frame F;
    F.lds = (LAS unsigned char*)lds;
    F.MISC = (volatile LAS unsigned*)(F.lds + MISC_OFF);
    F.G = gridDim.x; { const int bx = blockIdx.x; F.bx = bx; F.vcu = (F.G % 8 == 0) ? (bx % 8) * (F.G / 8) + bx / 8 : bx; }
    unsigned char* ws = args.ws;
    F.ctl = (gu32*)(ws + WS_CTL);
    frame_ptrs(F);
    for (int u = F.ltid(); u < (LDS_BYTES - LDSCTL_OFF) / 4; u += NWAVES * 64) ((LAS unsigned*)(F.lds + LDSCTL_OFF))[u] = 0u;
    __syncthreads();
#if MK_ONE_LAUNCH
    constexpr int lo = 0, hi = NPHASE; constexpr bool use_bar = true;
#else
    const int lo = args.ph_lo, hi = args.ph_hi;
    const bool use_bar = (hi - lo) > 1;
#endif
    XcdBarrier bar; bar.bar = (unsigned*)(F.ctl + CW_BAR); bar.x = 0; bar.st = nullptr;
    if (use_bar) bar = xcd_barrier_post((unsigned*)(F.ctl + CW_BAR), F.MISC + 8);
#ifndef PHM
#define PHM 0xFFFF
#endif
#define IN(k) (lo <= (k) && (k) < hi)
#define KIND(b) ((PHM >> (b)) & 1)
#ifndef REP_MASK
#define REP_MASK 0
#endif
#define NREP(b) (((REP_MASK >> (b)) & 1) ? 2 : 1)
#define BARRIER() do { XcdBarrier b_ = bar; asm volatile("" : "+s"(b_.x)); xcd_barrier(b_); } while (0)
#ifndef DRY_EPI
#define DRY_EPI 0
#endif
#ifndef BAR_REP
#define BAR_REP 1
#endif
#define SEAM(k) do { if (IN(k) && IN((k) + 1)) { for (int br_ = 0; br_ < BAR_REP; ++br_) BARRIER(); } } while (0)

    if (KIND(0) && IN(0)) { for (int rep = 0; rep < NREP(0); ++rep) { frame_ptrs(F); phase_a1(F); if (rep + 1 < NREP(0)) BARRIER(); } } SEAM(0);
    if (KIND(1) && IN(1)) { frame_ptrs(F); phase_a2(F); } SEAM(1);
    if (KIND(2) && IN(2)) { frame_ptrs(F); phase_a3(F); } SEAM(2);

#pragma nounroll
    for (int l = 0; l < DEPTH; ++l) {
        const int pb = 3 + 8 * l; const bool last = (l == DEPTH - 1);
        { int g_ = F.G, v_ = F.vcu, b_ = F.bx; asm volatile("" : "+s"(g_), "+s"(v_), "+s"(b_)); F.G = g_; F.vcu = v_; F.bx = b_; }
        const int Mrows = last ? MLAT : MTOT;
        if (KIND(3) && IN(pb + 0)) for (int rep = 0; rep < NREP(3); ++rep) { if (rep) BARRIER(); frame_ptrs(F);
            pg8::Gemm g{F.HA, F.Win + (size_t)l * INW * D, MTOT, INW, D, D, D}; pg8::StaticOrder S; S.init(MTOT, INW, F.G, F.bx);
            pg8::EpiInProj E{F.Z, F.rope, QSCALE, INW, MLAT, F.KB, F.VB, (rep && DRY_EPI) ? 1 : 0};
            phase_stagger((F.bx >> 3) & 7);
            pg8::gemm_phase<pg8::EpiInProj, pg8::StaticOrder, ALIGN_BIG, true>(F.lds + RING_OFF, g, S, E);
        }
        SEAM(pb + 0);
        if (KIND(4) && IN(pb + 1)) for (int rep = 0; rep < NREP(4); ++rep) { if (rep) BARRIER(); frame_ptrs(F); phase_mixers(F, l, args.lam_init[l]); }
        SEAM(pb + 1);
        if (KIND(5) && IN(pb + 2)) for (int rep = 0; rep < NREP(5); ++rep) { if (rep) BARRIER(); frame_ptrs(F);
            pg8::Gemm g{F.Y, F.Wbr + (size_t)l * D * YW, Mrows, D, YW, YW, YW}; pg8::StaticOrder S; S.init(Mrows, D, F.G, F.bx);
            pg8::EpiGate E{F.Z + G_OFF, INW, F.MG, D};
            pg8::gemm_phase<pg8::EpiGate, pg8::StaticOrder, true, true>(F.lds + RING_OFF, g, S, E);
        }
        SEAM(pb + 2);
        if (KIND(6) && IN(pb + 3)) for (int rep = 0; rep < NREP(6); ++rep) { if (rep) BARRIER(); frame_ptrs(F);
            void* tw = rep ? (void*)(F.Z + (size_t)134 * MiB) : (void*)F.Y;
            { pg8::Gemm g{F.MG, F.Wout + (size_t)l * D * D, MLAT, D, D, D, D}; pg8::StaticOrder S; S.init(MLAT, D, F.G, F.bx);
              pg8::EpiResidT<false> E{F.mods + (size_t)l * 5 * INW + 2 * D, INW, tw, D, 1, MLAT};
              pg8::gemm_phase<pg8::EpiResidT<false>, pg8::StaticOrder, true, true>(F.lds + RING_OFF, g, S, E); }
            if (!last) { pg8::Gemm g{F.MG, F.Wout + (size_t)l * D * D, MTOT, D, 256, D, D}; pg8::SplitOrder S; S.init(MLAT / 256, 32, 8, 256, F.G, F.bx);
              pg8::EpiResidT<true> E{F.mods + (size_t)l * 5 * INW + 2 * D, INW, rep ? (void*)(F.Z + (size_t)170 * MiB) : (void*)(F.Z + (size_t)100 * MiB), D, 256, MLAT};
              pg8::gemm_phase<pg8::EpiResidT<true>, pg8::SplitOrder, true, true>(F.lds + RING_OFF, g, S, E); }
            if (TAILWORK == 1 && !last && F.bx >= 32 && rep == 0) ada_partial_layer(F, l + 1, (F.bx - 32) * NWAVES + __builtin_amdgcn_readfirstlane(F.ltid() >> 6), (F.G - 32) * NWAVES);
        }
        SEAM(pb + 3);
        if (KIND(7) && IN(pb + 4)) { frame_ptrs(F); if (NREP(7) > 1) { phase_ln(F, F.ln1_g + (size_t)l * D, F.ln1_b + (size_t)l * D, Mrows, false, true, l, 3 * D, last ? 0 : 8, true); BARRIER(); frame_ptrs(F); }
            phase_ln(F, F.ln1_g + (size_t)l * D, F.ln1_b + (size_t)l * D, Mrows, false, true, l, 3 * D, last ? 0 : 8); if (TAILWORK && !last) mods_reduce_layer(F, l + 1); }
        SEAM(pb + 4);
        if (KIND(8) && IN(pb + 5)) for (int rep = 0; rep < NREP(8); ++rep) { if (rep) BARRIER(); frame_ptrs(F);
            pg8::Gemm g{F.HA, F.Wgu + (size_t)l * 2 * FFH * D, Mrows, 2 * FFH, D, D, D}; pg8::StaticOrder S; S.init(Mrows, 2 * FFH, F.G, F.bx);
            pg8::EpiSwiglu E{F.Z, FFH};
            phase_stagger((F.bx >> 3) & 7);
            pg8::gemm_phase<pg8::EpiSwiglu, pg8::StaticOrder, ALIGN_BIG, true>(F.lds + RING_OFF, g, S, E);
        }
        SEAM(pb + 5);
        if (KIND(9) && IN(pb + 6)) for (int rep = 0; rep < NREP(9); ++rep) { if (rep) BARRIER(); frame_ptrs(F);
            void* tw = rep ? (void*)(F.Z + (size_t)134 * MiB) : (void*)F.Y;
            { pg8::Gemm g{F.Z, F.Wdn + (size_t)l * D * FFH, MLAT, D, FFH, FFH, FFH}; pg8::StaticOrder S; S.init(MLAT, D, F.G, F.bx);
              pg8::EpiResidT<false> E{F.mods + (size_t)l * 5 * INW + 5 * D, INW, tw, D, 1, MLAT};
              pg8::gemm_phase<pg8::EpiResidT<false>, pg8::StaticOrder, true, true>(F.lds + RING_OFF, g, S, E); }
            if (!last) { pg8::Gemm g{F.Z, F.Wdn + (size_t)l * D * FFH, MTOT, D, FFH / 4, FFH, FFH}; pg8::SplitOrder S; S.init(MLAT / 256, 32, 4, FFH / 4, F.G, F.bx);
              pg8::EpiResidT<true> E{F.mods + (size_t)l * 5 * INW + 5 * D, INW, rep ? (void*)(F.Z + (size_t)170 * MiB) : (void*)(F.Z + (size_t)100 * MiB), D, FFH / 4, MLAT};
              pg8::gemm_phase<pg8::EpiResidT<true>, pg8::SplitOrder, true, true>(F.lds + RING_OFF, g, S, E); }
            if (TAILWORK == 1 && !last && F.bx >= 32 && rep == 0) { __syncthreads(); cvt_layer(F, l + 1, (F.bx - 32) * NWAVES + __builtin_amdgcn_readfirstlane(F.ltid() >> 6), (F.G - 32) * NWAVES); }
        }
        SEAM(pb + 6);
        if (KIND(7) && IN(pb + 7)) { frame_ptrs(F); phase_ln(F, F.ln2_g + (size_t)l * D, F.ln2_b + (size_t)l * D, Mrows, last, !last, last ? l : l + 1, 0, last ? 0 : 4); }
        if (!last) SEAM(pb + 7);
    }
#undef IN
#undef SEAM
}

extern "C" void kernel_launch(void* const* d_in, const int* in_sizes, int n_in, void* d_out, int out_size, void* d_ws, size_t ws_size, hipStream_t stream) {
    static int grid = 0;
    if (grid == 0) {
        if (n_in != 23 || in_sizes[0] != MLAT * D || out_size != MLAT * D || ws_size < WS_END) {
            fprintf(stderr, "kernel_launch: unexpected shapes / workspace (n_in %d, in0 %d, out %d, ws %zu, need %zu); nothing launched\n", n_in, n_in > 0 ? in_sizes[0] : -1, out_size, ws_size, (size_t)WS_END); grid = -1; return; }
        int dev = 0, cus = 0, per_cu = 0;
        if (hipGetDevice(&dev) != hipSuccess || hipDeviceGetAttribute(&cus, hipDeviceAttributeMultiprocessorCount, dev) != hipSuccess) { grid = -1; return; }
        if (hipFuncSetAttribute((const void*)fwd, hipFuncAttributeMaxDynamicSharedMemorySize, LDS_BYTES) != hipSuccess) { fprintf(stderr, "kernel_launch: hipFuncSetAttribute failed\n"); grid = -1; return; }
        if (hipOccupancyMaxActiveBlocksPerMultiprocessor(&per_cu, (const void*)fwd, NWAVES * 64, LDS_BYTES) != hipSuccess || per_cu < 1) fprintf(stderr, "kernel_launch: occupancy query reports %d\n", per_cu);
        (void)hipGetLastError();
        grid = cus;
    }
    if (grid < 0) return;
    if (hipMemsetAsync((char*)d_ws + WS_CTL, 0, CTL_ZERO_BYTES, stream) != hipSuccess) return;
    Args a{};
    for (int i = 0; i < 23; ++i) a.in[i] = (const float*)d_in[i];
    a.out = (float*)d_out; a.ws = (unsigned char*)d_ws;
    for (int l = 0; l < DEPTH; ++l) a.lam_init[l] = (float)(0.8 - 0.6 * exp(-0.3 * (double)l));
#if MK_ONE_LAUNCH
    a.ph_lo = 0; a.ph_hi = NPHASE;
    hipLaunchKernelGGL(fwd, dim3(grid), dim3(NWAVES * 64), LDS_BYTES, stream, a);
#else
    for (int p = 0; p < NPHASE; ++p) { a.ph_lo = p; a.ph_hi = p + 1; hipLaunchKernelGGL(fwd, dim3(grid), dim3(NWAVES * 64), LDS_BYTES, stream, a); }
#endif
}
```

```cpp
#include <hip/hip_runtime.h>
#include <cstdio>
#include <cstdint>
#include <cmath>
namespace pg8 {
#define PG8_LAS __attribute__((address_space(3)))
typedef unsigned short bf16_t;
typedef short bf16x8 __attribute__((ext_vector_type(8)));
typedef float f32x4 __attribute__((ext_vector_type(4)));
typedef unsigned u32x4 __attribute__((ext_vector_type(4)));
constexpr int BM = 256, BK = 64, HALF = 128, HTB = HALF * BK * 2  , STAGE_BYTES = 8 * HTB, NXCD = 8, WGM = 8;

__host__ __device__ __forceinline__ int lds_byte(int r, int c) { const int st = (r >> 4) * 2 + (c >> 5), rr = r & 15, cc = c & 31, ob = rr * 64 + cc * 2; return st * 1024 + (ob ^ (((ob >> 9) & 1) << 5)); }
__host__ __device__ __forceinline__ void stage_rc(int b, int& R, int& C) { const int st = b / 1024, sb = b % 1024, swz = sb ^ (((sb >> 9) & 1) << 5); R = (st >> 1) * 16 + swz / 64; C = (st & 1) * 32 + (swz % 64) / 2; }
__host__ __device__ __forceinline__ int perm32(int rho) { const int n = rho >> 4, i = rho & 15; return 8 * (i >> 2) + 4 * n + (i & 3); }

struct Unit { int pm, pn, ka; };
struct Gemm { const bf16_t* A; const bf16_t* Bt; int M, N, K, lda, ldb; };

struct StaticOrder {
    int nM, nN, nwg, G, c;
    __host__ __device__ void init(int M, int N, int G_, int c_) { nM = M / BM; nN = N / BM; nwg = nM * nN; G = G_; c = c_; }
    __host__ __device__ bool next(int i, Unit& u) const {
        const long L = (long)i * G + c; if (L >= nwg) return false;
        int wgid = (int)L; { const int q = nwg / NXCD, r = nwg % NXCD, xcd = wgid % NXCD, off = wgid / NXCD; wgid = (xcd < r ? xcd * (q + 1) : r * (q + 1) + (xcd - r) * q) + off; }
        const int nig = WGM * nN, gid = wgid / nig, fm = gid * WGM, gsz = (nM - fm) < WGM ? (nM - fm) : WGM;
        u.pm = fm + ((wgid % nig) % gsz); u.pn = (wgid % nig) / gsz; u.ka = 0; return true;
    }
    __device__ __forceinline__ void a_ready(const Unit&) const {}
    __device__ __forceinline__ void done(const Unit&) const {}
};

struct SplitOrder {
    int nsplit, klen, G, c, pm0, ntile;
    __host__ __device__ void init(int pm0_, int ntile_, int nsplit_, int klen_, int G_, int c_) { pm0 = pm0_; ntile = ntile_; nsplit = nsplit_; klen = klen_; G = G_; c = c_; }
    __host__ __device__ bool next(int i, Unit& u) const { const int L = i * G + c; if (L >= ntile * nsplit) return false; const int tt = L / nsplit; u.pm = pm0 + (tt & 3); u.pn = tt >> 2; u.ka = (L - tt * nsplit) * klen; return true; }
    __device__ __forceinline__ void a_ready(const Unit&) const {}
    __device__ __forceinline__ void done(const Unit&) const {}
};
__device__ __forceinline__ unsigned cvt_pk_bf16(float lo, float hi) { unsigned r; asm volatile("v_cvt_pk_bf16_f32 %0, %1, %2" : "=v"(r) : "v"(lo), "v"(hi)); return r; }
typedef float f32x2 __attribute__((ext_vector_type(2)));
__device__ __forceinline__ f32x2 gelu_pk(f32x2 v) {
    const f32x2 av = __builtin_elementwise_abs(v), d = av * 0.2316418882f + 1.0f;
    f32x2 t; t.x = __builtin_amdgcn_rcpf(d.x); t.y = __builtin_amdgcn_rcpf(d.y);
    f32x2 q = t * 0.5307027145f + (-0.7265760135f); q = q * t + 0.7107068705f; q = q * t + (-0.142248368f); q = q * t + 0.127414796f; q = q * t;
    const f32x2 s = (v * v) * (-0.72134752044f);
    f32x2 e; e.x = __builtin_amdgcn_exp2f(s.x); e.y = __builtin_amdgcn_exp2f(s.y);
    const f32x2 m = v * (q * e), r = v - m;
    f32x2 o; o.x = v.x < 0.f ? m.x : r.x; o.y = v.y < 0.f ? m.y : r.y; return o;
}

#ifndef GATE_NT
#define GATE_NT 0
#endif
#if GATE_NT
#define GATE_LD(p) __builtin_nontemporal_load(p)
#else
#define GATE_LD(p) (*(p))
#endif
#ifndef EPI_NT
#define EPI_NT 0
#endif
typedef unsigned u32x2 __attribute__((ext_vector_type(2)));
__device__ __forceinline__ float bf_lo(unsigned w) { return __uint_as_float(w << 16); }
__device__ __forceinline__ float bf_hi(unsigned w) { return __uint_as_float(w & 0xffff0000u); }
__device__ __forceinline__ void store8_bf16(bf16_t* p, const f32x4 v0, const f32x4 v1) {
    u32x4 w; w.x = cvt_pk_bf16(v0[0], v0[1]); w.y = cvt_pk_bf16(v0[2], v0[3]); w.z = cvt_pk_bf16(v1[0], v1[1]); w.w = cvt_pk_bf16(v1[2], v1[3]);
#if EPI_NT
    __builtin_nontemporal_store(w, (u32x4*)p);
#else
    *(u32x4*)p = w;
#endif
}
__device__ __forceinline__ float sigmoid_f(float x) { return __builtin_amdgcn_rcpf(1.0f + __builtin_amdgcn_exp2f(x * -1.4426950408889634f)); }

struct EpiInProj {
    static constexpr bool PERM = true, AFTER_DRAIN = false; static constexpr int KSEG = 0;
    bf16_t* Z; const float* rope; float qscale; int ldc; int nlat; bf16_t* Kb; bf16_t* Vb; int dry;
    __device__ __forceinline__ void kseg(f32x4 (&)[2][2][4][2], const Unit&, int, int, int, int, int) const {}
    __device__ __forceinline__ void operator()(const f32x4 (&acc)[2][2][4][2], const Unit& u, int wr, int wc, int fr, int fq) const {
        const int pn = u.pn; const int row0 = u.pm * BM + wr * 64 + fr; const int col0 = pn * BM + wc * 32 + 8 * fq;
        if (dry) { float s_ = 0.f;
#pragma unroll
            for (int a_ = 0; a_ < 2; ++a_)
#pragma unroll
                for (int b_ = 0; b_ < 2; ++b_)
#pragma unroll
                    for (int m_ = 0; m_ < 4; ++m_)
#pragma unroll
                        for (int n_ = 0; n_ < 2; ++n_) s_ += acc[a_][b_][m_][n_][0];
            if (s_ != s_) Z[0] = 0; return; }
        if (pn < 8) {
            const float sc = pn < 4 ? qscale : 1.0f;
#pragma unroll
            for (int ai = 0; ai < 2; ++ai)
#pragma unroll
                for (int m = 0; m < 4; ++m) {
                    const int row = row0 + ai * HALF + m * 16; const int t = row & 4095; const int pos = (wc & 1) ? (t & 63) : (t >> 6);
                    f32x4 cs0 = *(const f32x4*)(rope + (pos * 16 + 4 * fq) * 2), cs1 = *(const f32x4*)(rope + (pos * 16 + 4 * fq) * 2 + 4);
                    if (row >= nlat) { cs0 = (f32x4){1.f, 0.f, 1.f, 0.f}; cs1 = cs0; }
                    bf16_t* rowp = Z + (size_t)row * ldc + col0;
                    if (pn >= 4) { const int bb = row < nlat ? (row >> 12) : ((row - nlat) >> 8), key = row < nlat ? 256 + (row & 4095) : ((row - nlat) & 255);
                        rowp = Kb + ((size_t)(bb * 8 + 2 * (pn - 4)) * 4352 + key) * 128 + wc * 32 + 8 * fq; }
#pragma unroll
                    for (int bj = 0; bj < 2; ++bj) {
                        const f32x4 a = acc[ai][bj][m][0], b = acc[ai][bj][m][1];
                        f32x4 o0, o1;
                        o0[0] = (a[0] * cs0[0] - a[1] * cs0[1]) * sc; o0[1] = (a[0] * cs0[1] + a[1] * cs0[0]) * sc;
                        o0[2] = (a[2] * cs0[2] - a[3] * cs0[3]) * sc; o0[3] = (a[2] * cs0[3] + a[3] * cs0[2]) * sc;
                        o1[0] = (b[0] * cs1[0] - b[1] * cs1[1]) * sc; o1[1] = (b[0] * cs1[1] + b[1] * cs1[0]) * sc;
                        o1[2] = (b[2] * cs1[2] - b[3] * cs1[3]) * sc; o1[3] = (b[2] * cs1[3] + b[3] * cs1[2]) * sc;
                        store8_bf16(rowp + (pn >= 4 ? (size_t)bj * 4352 * 128 : (size_t)bj * HALF), o0, o1);
                    }
                }
        } else if (pn < 12) {
#pragma unroll
            for (int ai = 0; ai < 2; ++ai)
#pragma unroll
                for (int m = 0; m < 4; ++m) { const int row = row0 + ai * HALF + m * 16; const int bb = row < nlat ? (row >> 12) : ((row - nlat) >> 8), key = row < nlat ? 256 + (row & 4095) : ((row - nlat) & 255);
                    bf16_t* rowp = Vb + ((size_t)(bb * 8 + 2 * (pn - 8)) * 4352 + key) * 128 + wc * 32 + 8 * fq;
#pragma unroll
                    for (int bj = 0; bj < 2; ++bj) store8_bf16(rowp + (size_t)bj * 4352 * 128, acc[ai][bj][m][0], acc[ai][bj][m][1]); }
        } else if (pn >= 20 && pn < 24) {
#pragma unroll
            for (int ai = 0; ai < 2; ++ai)
#pragma unroll
                for (int m = 0; m < 4; ++m) { bf16_t* rowp = Z + (size_t)(row0 + ai * HALF + m * 16) * ldc + col0;
#pragma unroll
                    for (int bj = 0; bj < 2; ++bj) store8_bf16(rowp + bj * HALF, acc[ai][bj][m][0], acc[ai][bj][m][1]); }
        } else if (pn < 20) {
#pragma unroll
            for (int ai = 0; ai < 2; ++ai)
#pragma unroll
                for (int m = 0; m < 4; ++m) { bf16_t* rowp = Z + (size_t)(row0 + ai * HALF + m * 16) * ldc + col0;
#pragma unroll
                    for (int bj = 0; bj < 2; ++bj) { const f32x4 v0 = acc[ai][bj][m][0], v1 = acc[ai][bj][m][1];
                        const f32x2 a = gelu_pk((f32x2){v0[0], v0[1]}), b = gelu_pk((f32x2){v0[2], v0[3]}), c = gelu_pk((f32x2){v1[0], v1[1]}), d = gelu_pk((f32x2){v1[2], v1[3]});
                        store8_bf16(rowp + bj * HALF, (f32x4){a.x, a.y, b.x, b.y}, (f32x4){c.x, c.y, d.x, d.y}); } }
        } else {
#pragma unroll
            for (int ai = 0; ai < 2; ++ai)
#pragma unroll
                for (int m = 0; m < 4; ++m) { bf16_t* rowp = Z + (size_t)(row0 + ai * HALF + m * 16) * ldc + col0;
#pragma unroll
                    for (int bj = 0; bj < 2; ++bj) { const f32x4 v0 = acc[ai][bj][m][0], v1 = acc[ai][bj][m][1]; f32x4 o0, o1;
#pragma unroll
                        for (int i = 0; i < 4; ++i) { o0[i] = __builtin_fmaxf(sigmoid_f(v0[i]), 1e-12f); o1[i] = __builtin_fmaxf(sigmoid_f(v1[i]), 1e-12f); }
                        store8_bf16(rowp + bj * HALF, o0, o1); } }
        }
    }
};

struct EpiGate {
    static constexpr bool PERM = true, AFTER_DRAIN = false; static constexpr int KSEG = 16;
    const bf16_t* G; int ldg; bf16_t* O; int ldo;
    __device__ __forceinline__ void kseg(f32x4 (&acc)[2][2][4][2], const Unit& u, int seg, int wr, int wc, int fr, int fq) const {
        const int row0 = u.pm * BM + wr * 64 + fr; const int col0 = u.pn * BM + wc * 32 + 8 * fq;
#pragma unroll
        for (int ai = 0; ai < 2; ++ai) {
            u32x4 ga[4][2], gb[4][2];
#pragma unroll
            for (int m = 0; m < 4; ++m) { const bf16_t* gp = G + (size_t)(row0 + ai * HALF + m * 16) * ldg + (seg - 1) * 2048 + col0;
#pragma unroll
                for (int bj = 0; bj < 2; ++bj) { ga[m][bj] = GATE_LD((const u32x4*)(gp + bj * HALF)); gb[m][bj] = GATE_LD((const u32x4*)(gp + 2048 + bj * HALF)); } }
#pragma unroll
            for (int m = 0; m < 4; ++m)
#pragma unroll
                for (int bj = 0; bj < 2; ++bj) { const u32x4 a = ga[m][bj], b = gb[m][bj];
                    f32x4 r0, r1;
                    r0[0] = bf_lo(a.x) * __builtin_amdgcn_rcpf(bf_lo(b.x)); r0[1] = bf_hi(a.x) * __builtin_amdgcn_rcpf(bf_hi(b.x));
                    r0[2] = bf_lo(a.y) * __builtin_amdgcn_rcpf(bf_lo(b.y)); r0[3] = bf_hi(a.y) * __builtin_amdgcn_rcpf(bf_hi(b.y));
                    r1[0] = bf_lo(a.z) * __builtin_amdgcn_rcpf(bf_lo(b.z)); r1[1] = bf_hi(a.z) * __builtin_amdgcn_rcpf(bf_hi(b.z));
                    r1[2] = bf_lo(a.w) * __builtin_amdgcn_rcpf(bf_lo(b.w)); r1[3] = bf_hi(a.w) * __builtin_amdgcn_rcpf(bf_hi(b.w));
                    acc[ai][bj][m][0] *= r0; acc[ai][bj][m][1] *= r1; }
            asm volatile("" ::: "memory"); }
    }
    __device__ __forceinline__ void operator()(const f32x4 (&acc)[2][2][4][2], const Unit& u, int wr, int wc, int fr, int fq) const {
        const int row0 = u.pm * BM + wr * 64 + fr; const int col0 = u.pn * BM + wc * 32 + 8 * fq;
        u32x4 gg[2][4][2];
#pragma unroll
        for (int ai = 0; ai < 2; ++ai)
#pragma unroll
            for (int m = 0; m < 4; ++m) { const bf16_t* gp = G + (size_t)(row0 + ai * HALF + m * 16) * ldg + 2 * 2048 + col0;
#pragma unroll
                for (int bj = 0; bj < 2; ++bj) gg[ai][m][bj] = GATE_LD((const u32x4*)(gp + bj * HALF)); }
#pragma unroll
        for (int ai = 0; ai < 2; ++ai)
#pragma unroll
            for (int m = 0; m < 4; ++m) { bf16_t* op = O + (size_t)(row0 + ai * HALF + m * 16) * ldo + col0;
#pragma unroll
                for (int bj = 0; bj < 2; ++bj) { const u32x4 g = gg[ai][m][bj];
                    const f32x4 g0 = (f32x4){bf_lo(g.x), bf_hi(g.x), bf_lo(g.y), bf_hi(g.y)}, g1 = (f32x4){bf_lo(g.z), bf_hi(g.z), bf_lo(g.w), bf_hi(g.w)};
                    store8_bf16(op + bj * HALF, acc[ai][bj][m][0] * g0, acc[ai][bj][m][1] * g1); } }
    }
};

template <bool SLAB> struct EpiResidT {
    static constexpr bool PERM = !SLAB, AFTER_DRAIN = false; static constexpr int KSEG = 0;
    const float* gv; int gstride; void* Tw; int ldc; int klen, nlat;
    __device__ __forceinline__ void kseg(f32x4 (&)[2][2][4][2], const Unit&, int, int, int, int, int) const {}
    __device__ __forceinline__ void operator()(const f32x4 (&acc)[2][2][4][2], const Unit& u, int wr, int wc, int fr, int fq) const {
        const int row0 = u.pm * BM + wr * 64 + fr; const int grp = u.pm < 64 ? (u.pm >> 4) : 4;
        if constexpr (SLAB) {
            const int col0 = u.pn * BM + wc * 32 + 4 * fq;
            f32x4 g[2][2];
#pragma unroll
            for (int bj = 0; bj < 2; ++bj)
#pragma unroll
                for (int n = 0; n < 2; ++n) g[bj][n] = *(const f32x4*)(gv + (size_t)grp * gstride + col0 + bj * HALF + n * 16);
#pragma unroll
            for (int ai = 0; ai < 2; ++ai)
#pragma unroll
                for (int m = 0; m < 4; ++m) { float* pp = (float*)Tw + ((size_t)(u.ka / klen) * 1024 + (size_t)(row0 + ai * HALF + m * 16 - nlat)) * ldc + col0;
#pragma unroll
                    for (int bj = 0; bj < 2; ++bj)
#pragma unroll
                        for (int n = 0; n < 2; ++n) *(f32x4*)(pp + bj * HALF + n * 16) = g[bj][n] * acc[ai][bj][m][n]; }
        } else {
            const int col0 = u.pn * BM + wc * 32 + 8 * fq;
            f32x4 g[2][2];
#pragma unroll
            for (int bj = 0; bj < 2; ++bj)
#pragma unroll
                for (int n = 0; n < 2; ++n) g[bj][n] = *(const f32x4*)(gv + (size_t)grp * gstride + col0 + bj * HALF + n * 4);
#pragma unroll
            for (int ai = 0; ai < 2; ++ai)
#pragma unroll
                for (int m = 0; m < 4; ++m) { bf16_t* tp = (bf16_t*)Tw + (size_t)(row0 + ai * HALF + m * 16) * ldc + col0;
#pragma unroll
                    for (int bj = 0; bj < 2; ++bj) store8_bf16(tp + bj * HALF, g[bj][0] * acc[ai][bj][m][0], g[bj][1] * acc[ai][bj][m][1]); }
        }
    }
};

struct EpiSwiglu {
    static constexpr bool PERM = true, AFTER_DRAIN = false; static constexpr int KSEG = 0;
    bf16_t* H; int ldc;
    __device__ __forceinline__ void kseg(f32x4 (&)[2][2][4][2], const Unit&, int, int, int, int, int) const {}
    __device__ __forceinline__ void operator()(const f32x4 (&acc)[2][2][4][2], const Unit& u, int wr, int wc, int fr, int fq) const {
        const int row0 = u.pm * BM + wr * 64 + fr, col0 = u.pn * HALF + wc * 32 + 8 * fq;
#pragma unroll
        for (int ai = 0; ai < 2; ++ai)
#pragma unroll
            for (int m = 0; m < 4; ++m) { bf16_t* rowp = H + (size_t)(row0 + ai * HALF + m * 16) * ldc + col0; f32x4 o[2];
#pragma unroll
                for (int n = 0; n < 2; ++n) { const f32x4 gt = acc[ai][0][m][n], up = acc[ai][1][m][n];
#pragma unroll
                    for (int i = 0; i < 4; ++i) o[n][i] = gt[i] * sigmoid_f(gt[i]) * up[i]; }
                store8_bf16(rowp, o[0], o[1]); }
    }
};
template <class Epi, class Sched, bool ALIGN_EPI = false, bool SP2 = false>
__device__ __forceinline__ void gemm_phase(PG8_LAS unsigned char* lds, const Gemm g, const Sched& S, const Epi& E) {
    int tid_ = threadIdx.x; asm volatile("" : "+v"(tid_));
    const int tid = tid_, wid = __builtin_amdgcn_readfirstlane(tid >> 6), lane = tid & 63, wr = wid >> 2, wc = wid & 3, fr = lane & 15, fq = lane >> 4;
    const int K = g.K, nt = K / BK;
    unsigned voffA[2], voffB[2];
#pragma unroll
    for (int i = 0; i < 2; ++i) { int R, C; stage_rc(tid * 16 + i * 8192, R, C); const int Rb = Epi::PERM ? ((R & ~31) + perm32(R & 31)) : R;
        voffA[i] = (unsigned)(R * g.lda + C) * 2u; voffB[i] = (unsigned)(Rb * g.ldb + C) * 2u; }
    const size_t kstep = (size_t)(BK * 2);
    const size_t hstepA = (size_t)HALF * g.lda * 2, hstepB = (size_t)HALF * g.ldb * 2;
    const size_t tstepA = 2 * hstepA, tstepB = 2 * hstepB;
    const unsigned ldsw = (unsigned)wid * 1024u;
    const int aoff = lds_byte(wr * 64 + fr, fq * 8), boff = lds_byte(wc * 32 + fr, fq * 8);
#define PG8_SA(b, h) (((b) * 2 + (h)) * HTB)
#define PG8_SB(b, h) ((4 + (b) * 2 + (h)) * HTB)
#define PG8_STAGE(bufoff, gbase, voff) do { _Pragma("unroll") for (int _i = 0; _i < 2; ++_i) \
        __builtin_amdgcn_global_load_lds((const unsigned*)((const char*)(gbase) + (voff)[_i]), (PG8_LAS unsigned*)(lds + (bufoff) + ldsw + _i * 8192), 16, 0, 0); } while (0)
#define PG8_LDA(dst, b, h) do { _Pragma("unroll") for (int m = 0; m < 4; ++m) _Pragma("unroll") for (int k = 0; k < 2; ++k) dst[m][k] = *(const PG8_LAS bf16x8*)(lds + PG8_SA(b, h) + aoff + m * 2048 + k * 1024); } while (0)
#define PG8_LDB(dst, b, h) do { _Pragma("unroll") for (int n = 0; n < 2; ++n) _Pragma("unroll") for (int k = 0; k < 2; ++k) dst[n][k] = *(const PG8_LAS bf16x8*)(lds + PG8_SB(b, h) + boff + n * 2048 + k * 1024); } while (0)
#define PG8_MMA(ai, bj, At, Bt) do { __builtin_amdgcn_s_setprio(1); _Pragma("unroll") for (int m = 0; m < 4; ++m) _Pragma("unroll") for (int n = 0; n < 2; ++n) _Pragma("unroll") for (int k = 0; k < 2; ++k) \
        acc[ai][bj][m][n] = __builtin_amdgcn_mfma_f32_16x16x32_bf16(Bt[n][k], At[m][k], acc[ai][bj][m][n], 0, 0, 0); __builtin_amdgcn_s_setprio(0); } while (0)
#define PG8_WAIT_V(n) asm volatile("s_waitcnt vmcnt(" #n ")" ::: "memory")
#define PG8_WAIT_L(n) asm volatile("s_waitcnt lgkmcnt(" #n ")" ::: "memory")
#define PG8_BAR __builtin_amdgcn_s_barrier()
#define PG8_SCHED __builtin_amdgcn_sched_barrier(0)
    Unit cur, nxt; int ui = 0;
    if (!S.next(0, cur)) return;
    f32x4 acc[2][2][4][2];
#pragma unroll
    for (int a = 0; a < 2; ++a)
#pragma unroll
        for (int b = 0; b < 2; ++b)
#pragma unroll
            for (int m = 0; m < 4; ++m)
#pragma unroll
                for (int n = 0; n < 2; ++n) acc[a][b][m][n] = (f32x4){0.f, 0.f, 0.f, 0.f};
    bf16x8 At[4][2], B0[2][2], B1[2][2];
    const char* cA = (const char*)g.A + (size_t)cur.pm * tstepA + (size_t)cur.ka * 2; const char* cB = (const char*)g.Bt + (size_t)cur.pn * tstepB + (size_t)cur.ka * 2;
    S.a_ready(cur);
    if constexpr (SP2) {
        PG8_STAGE(PG8_SB(0, 0), cB, voffB); PG8_STAGE(PG8_SB(0, 1), cB + hstepB, voffB); PG8_STAGE(PG8_SA(0, 0), cA, voffA); PG8_STAGE(PG8_SA(0, 1), cA + hstepA, voffA);
        if (wr == 1) PG8_BAR;
        PG8_WAIT_V(2); PG8_BAR;
        PG8_STAGE(PG8_SB(1, 0), cB + kstep, voffB); PG8_STAGE(PG8_SA(1, 0), cA + kstep, voffA); PG8_STAGE(PG8_SB(1, 1), cB + hstepB + kstep, voffB);
        PG8_WAIT_V(6); PG8_BAR;
    } else {
        PG8_STAGE(PG8_SB(0, 0), cB, voffB); PG8_STAGE(PG8_SA(0, 0), cA, voffA); PG8_STAGE(PG8_SB(0, 1), cB + hstepB, voffB); PG8_STAGE(PG8_SA(0, 1), cA + hstepA, voffA);
        if (wr == 1) PG8_BAR;
        PG8_WAIT_V(4); PG8_BAR;
        PG8_STAGE(PG8_SB(1, 0), cB + kstep, voffB); PG8_STAGE(PG8_SA(1, 0), cA + kstep, voffA); PG8_STAGE(PG8_SB(1, 1), cB + hstepB + kstep, voffB);
        PG8_WAIT_V(6); PG8_BAR;
    }
    for (;;) {
        const bool has_next = S.next(ui + 1, nxt);
        const char* nA = has_next ? (const char*)g.A + (size_t)nxt.pm * tstepA + (size_t)nxt.ka * 2 : cA; const char* nB = has_next ? (const char*)g.Bt + (size_t)nxt.pn * tstepB + (size_t)nxt.ka * 2 : cB;
        for (int t = 0; t < nt; t += 2) {
            const bool last = (t == nt - 2);
            if constexpr (Epi::KSEG > 0) { if (t > 0 && (t % Epi::KSEG) == 0) E.kseg(acc, cur, t / Epi::KSEG, wr, wc, fr, fq); }
            const char* a1 = cA + (size_t)(t + 1) * kstep;
            const char* a2 = last ? nA : cA + (size_t)(t + 2) * kstep; const char* b2 = last ? nB : cB + (size_t)(t + 2) * kstep;
            const char* a3 = a2 + kstep; const char* b3 = b2 + kstep;
            if (last && has_next) S.a_ready(nxt);
            if constexpr (SP2) {
            PG8_LDB(B0, 0, 0); PG8_LDB(B1, 0, 1); PG8_SCHED; PG8_LDA(At, 0, 0); PG8_STAGE(PG8_SA(1, 1), a1 + hstepA, voffA);
            PG8_WAIT_V(8); PG8_WAIT_L(0); PG8_BAR; PG8_MMA(0, 0, At, B0); PG8_MMA(0, 1, At, B1); PG8_BAR; PG8_SCHED;
            PG8_LDA(At, 0, 1); PG8_STAGE(PG8_SB(0, 0), b2, voffB); PG8_STAGE(PG8_SB(0, 1), b2 + hstepB, voffB); PG8_STAGE(PG8_SA(0, 0), a2, voffA);
            PG8_WAIT_V(8); PG8_WAIT_L(0); PG8_BAR; PG8_MMA(1, 0, At, B0); PG8_MMA(1, 1, At, B1); PG8_BAR; PG8_SCHED;
            PG8_LDB(B0, 1, 0); PG8_LDB(B1, 1, 1); PG8_SCHED; PG8_LDA(At, 1, 0); PG8_STAGE(PG8_SA(0, 1), a2 + hstepA, voffA);
            PG8_WAIT_V(8); PG8_WAIT_L(0); PG8_BAR; PG8_MMA(0, 0, At, B0); PG8_MMA(0, 1, At, B1); PG8_BAR; PG8_SCHED;
            PG8_LDA(At, 1, 1); PG8_STAGE(PG8_SB(1, 0), b3, voffB); PG8_STAGE(PG8_SB(1, 1), b3 + hstepB, voffB); PG8_STAGE(PG8_SA(1, 0), a3, voffA);
            PG8_WAIT_V(8); PG8_WAIT_L(0); PG8_BAR; PG8_MMA(1, 0, At, B0); PG8_MMA(1, 1, At, B1); PG8_BAR; PG8_SCHED;
            } else {
            PG8_LDB(B0, 0, 0); PG8_SCHED; PG8_LDA(At, 0, 0); PG8_STAGE(PG8_SA(1, 1), a1 + hstepA, voffA);
            PG8_WAIT_L(8); PG8_BAR; PG8_WAIT_L(0); PG8_MMA(0, 0, At, B0); PG8_BAR; PG8_SCHED;
            PG8_LDB(B1, 0, 1); PG8_STAGE(PG8_SB(0, 0), b2, voffB);
            PG8_BAR; PG8_WAIT_L(0); PG8_MMA(0, 1, At, B1); PG8_BAR;
            PG8_LDA(At, 0, 1); PG8_STAGE(PG8_SA(0, 0), a2, voffA);
            PG8_BAR; PG8_WAIT_L(0); PG8_MMA(1, 0, At, B0); PG8_BAR; PG8_SCHED;
            PG8_STAGE(PG8_SB(0, 1), b2 + hstepB, voffB);
            PG8_WAIT_V(6); PG8_BAR; PG8_MMA(1, 1, At, B1); PG8_BAR;
            PG8_LDB(B0, 1, 0); PG8_SCHED; PG8_LDA(At, 1, 0); PG8_STAGE(PG8_SA(0, 1), a2 + hstepA, voffA);
            PG8_WAIT_L(8); PG8_BAR; PG8_WAIT_L(0); PG8_MMA(0, 0, At, B0); PG8_BAR; PG8_SCHED;
            PG8_LDB(B1, 1, 1); PG8_STAGE(PG8_SB(1, 0), b3, voffB);
            PG8_BAR; PG8_WAIT_L(0); PG8_MMA(0, 1, At, B1); PG8_BAR;
            PG8_LDA(At, 1, 1); PG8_STAGE(PG8_SA(1, 0), a3, voffA);
            PG8_BAR; PG8_WAIT_L(0); PG8_MMA(1, 0, At, B0); PG8_BAR; PG8_SCHED;
            PG8_STAGE(PG8_SB(1, 1), b3 + hstepB, voffB);
            PG8_WAIT_V(6); PG8_BAR; PG8_MMA(1, 1, At, B1); PG8_BAR;
            }
        }
        if constexpr (ALIGN_EPI) { if (wr == 0) PG8_BAR; }
        if constexpr (!Epi::AFTER_DRAIN) { E(acc, cur, wr, wc, fr, fq); S.done(cur); }
        if (!has_next) break;
#pragma unroll
        for (int a = 0; a < 2; ++a)
#pragma unroll
            for (int b = 0; b < 2; ++b)
#pragma unroll
                for (int m = 0; m < 4; ++m)
#pragma unroll
                    for (int n = 0; n < 2; ++n) acc[a][b][m][n] = (f32x4){0.f, 0.f, 0.f, 0.f};
        cur = nxt; cA = nA; cB = nB; ++ui;
        if constexpr (ALIGN_EPI) { if (wr == 1) PG8_BAR; }
    }
    PG8_WAIT_V(0);
    if constexpr (!ALIGN_EPI) { if (wr == 0) PG8_BAR; }
    PG8_BAR;
    if constexpr (Epi::AFTER_DRAIN) { E.fused(acc, cur, wr, wc, fr, fq, lds, wid, lane); S.done(cur); }
#undef PG8_SA
#undef PG8_SB
#undef PG8_STAGE
#undef PG8_LDA
#undef PG8_LDB
#undef PG8_MMA
#undef PG8_WAIT_V
#undef PG8_WAIT_L
#undef PG8_BAR
#undef PG8_SCHED
}
}

constexpr int NWAVES = 8;
constexpr int D = 2048, NBATCH = 4, SEQ = 4096, DEPTH = 4, CTXL = 256;
constexpr int MLAT = NBATCH * SEQ, MCTX = NBATCH * CTXL, MTOT = MLAT + MCTX;
constexpr int INW = 12288, BW = 1024, FFH = 5632, NHEAD = 8;
constexpr int Q_OFF = 0, K_OFF = 1024, V_OFF = 2048, BU_OFF = 3072, C_OFF = 5120, G_OFF = 6144;
constexpr int YW = 3 * BW;
constexpr float LN_EPS = 1e-6f;
constexpr float ALPHA = 1.681792830507429f;
constexpr float QSCALE = 0.125f * 1.4426950408889634f;

constexpr size_t MiB = 1u << 20;
constexpr size_t WS_CTL = 0, CTL_ZERO_BYTES = 1 * MiB;
constexpr size_t WS_ROPE = 1 * MiB;
constexpr size_t WS_MODS = 2 * MiB;
constexpr size_t WS_MODP = 4 * MiB;
constexpr size_t WS_WSP = 20 * MiB;
constexpr size_t WS_WPOOL = 21 * MiB;
constexpr size_t WS_WIN = 24 * MiB;
constexpr size_t WS_WBR = 216 * MiB;
constexpr size_t WS_WOUT = 264 * MiB;
constexpr size_t WS_WGU = 296 * MiB;
constexpr size_t WS_WDN = 472 * MiB;
constexpr size_t WS_X = 560 * MiB;
constexpr size_t WS_HA = 696 * MiB;
constexpr size_t WS_Y = 764 * MiB;
constexpr size_t WS_MG = 866 * MiB;
constexpr size_t WS_Z = 934 * MiB;
constexpr size_t WS_KB = 1342 * MiB, WS_VB = 1378 * MiB;
constexpr size_t WS_END = 1414 * MiB;
static_assert(WS_MODP + 16ull * 4 * 5 * 12288 * 4 <= WS_WSP && WS_WIN + 4ull * 12288 * 2048 * 2 <= WS_WBR && WS_WBR + 4ull * 2048 * 3072 * 2 <= WS_WOUT && WS_WOUT + 4ull * 2048 * 2048 * 2 <= WS_WGU, "ws map 1");
static_assert(WS_WGU + 4ull * 11264 * 2048 * 2 <= WS_WDN && WS_WDN + 4ull * 2048 * 5632 * 2 <= WS_X && WS_X + (size_t)MTOT * D * 4 <= WS_HA && WS_HA + (size_t)MTOT * D * 2 <= WS_Y, "ws map 2");
static_assert(WS_Y + (size_t)MTOT * YW * 2 <= WS_MG && WS_MG + (size_t)MTOT * D * 2 <= WS_Z && WS_Z + (size_t)MTOT * INW * 2 <= WS_KB && WS_KB + 32ull * 4352 * 256 <= WS_VB && WS_VB + 32ull * 4352 * 256 <= WS_END, "ws map 3");
constexpr int CW_BAR = 4096;

constexpr int RING_OFF = 0, RING_BYTES = 131072;
constexpr int LDSCTL_OFF = RING_BYTES, MISC_OFF = LDSCTL_OFF + 320;
constexpr int LDS_BYTES = 147456;

#define GAS __attribute__((address_space(1)))
#define LAS __attribute__((address_space(3)))
typedef unsigned short bf16;
typedef unsigned v4u __attribute__((ext_vector_type(4)));
typedef unsigned v2u __attribute__((ext_vector_type(2)));
typedef float f32x4 __attribute__((ext_vector_type(4)));
typedef float f32x16 __attribute__((ext_vector_type(16)));
typedef short bf16x8 __attribute__((ext_vector_type(8)));
typedef short s16x4 __attribute__((ext_vector_type(4)));
typedef GAS unsigned gu32;
#define RLX_AGENT __ATOMIC_RELAXED, __HIP_MEMORY_SCOPE_AGENT
#define LDS_WAIT() asm volatile("s_waitcnt lgkmcnt(0)" ::: "memory")
#define VM_WAIT() asm volatile("s_waitcnt vmcnt(0)" ::: "memory")
__device__ __forceinline__ unsigned f2bf(float f) { unsigned u = __builtin_bit_cast(unsigned, f); return (u + 0x7fffu + ((u >> 16) & 1u)) >> 16; }
__device__ __forceinline__ unsigned pk2(float lo, float hi) { return f2bf(lo) | (f2bf(hi) << 16); }
__device__ __forceinline__ unsigned cvtpk(float lo, float hi) { unsigned r; asm volatile("v_cvt_pk_bf16_f32 %0, %1, %2" : "=v"(r) : "v"(lo), "v"(hi)); return r; }
__device__ __forceinline__ float bflo(unsigned w) { return __uint_as_float(w << 16); }
__device__ __forceinline__ float bfhi(unsigned w) { return __uint_as_float(w & 0xffff0000u); }

#define XB_TMO      128
#define XB_XCNT(j)  (256  + 64 * (j))
#define XB_XSUB(j)  (1280 + 64 * (j))
#define XB_XGEN(j)  (2304 + 64 * (j))
#define XB_TOP      3328
#define XB_TOPGEN   3392
#define XCD_BAR_WORDS 3456
#define XB_SPIN_CAP (1u << 18)

__device__ __forceinline__ unsigned xb_ld(unsigned* p)              { return __hip_atomic_load(p, __ATOMIC_RELAXED, __HIP_MEMORY_SCOPE_AGENT); }
__device__ __forceinline__ unsigned xb_add(unsigned* p, unsigned v) { return __hip_atomic_fetch_add(p, v, __ATOMIC_RELAXED, __HIP_MEMORY_SCOPE_AGENT); }
__device__ __forceinline__ unsigned xb_xcc_id() { return (unsigned)__builtin_amdgcn_s_getreg((3 << 11) | 20) & 0xFu; }
#define XB_SPIN(cond, bar) do { unsigned _sp = 0; while (cond) { __builtin_amdgcn_s_sleep(1); \
    if ((++_sp & 255u) == 0u) { if (xb_ld(&(bar)[XB_TMO])) break; if (_sp > XB_SPIN_CAP) { atomicAdd(&(bar)[XB_TMO], 1u); break; } } } } while (0)

struct XcdBarrier {
    unsigned* bar; unsigned x;
    volatile LAS unsigned* st;
};

__device__ __forceinline__ XcdBarrier xcd_barrier_post(unsigned* bar, volatile LAS unsigned* st) {
    XcdBarrier b; b.bar = bar; b.x = xb_xcc_id(); b.st = st;
    if (threadIdx.x == 0) (void)xb_add(&bar[XB_XCNT(b.x)], 1u);
    return b;
}
__device__ __forceinline__ void xcd_barrier_complete(unsigned* bar, unsigned x, unsigned& nloc, unsigned& nx) {
    const unsigned G = gridDim.x * gridDim.y * gridDim.z;
    unsigned sum, cnt, mine, sp = 0u;
    for (;;) {
        sum = 0u; cnt = 0u; mine = 0u;
#pragma unroll
        for (unsigned j = 0; j < 16; ++j) { const unsigned c = xb_ld(&bar[XB_XCNT(j)]); sum += c; cnt += (c > 0u) ? 1u : 0u; mine = (j == x) ? c : mine; }
        if (sum == G) break;
        __builtin_amdgcn_s_sleep(1);
        if ((++sp & 255u) == 0u) { if (xb_ld(&bar[XB_TMO])) break; if (sp > XB_SPIN_CAP) { atomicAdd(&bar[XB_TMO], 1u); break; } }
    }
    nloc = mine > 0u ? mine : 1u; nx = cnt > 0u ? cnt : 1u;
}

__device__ __forceinline__ void xcd_barrier(const XcdBarrier& b) {
    asm volatile("s_waitcnt vmcnt(0)" ::: "memory");
    __syncthreads();
    if (threadIdx.x == 0) {
        unsigned* bar = b.bar;
        __builtin_amdgcn_s_waitcnt(0);
        unsigned nloc = b.st[0], nx = b.st[1];
        if (nloc == 0u) { xcd_barrier_complete(bar, b.x, nloc, nx); b.st[0] = nloc; b.st[1] = nx; }
        const unsigned old = xb_add(&bar[XB_XSUB(b.x)], 1u);
        const unsigned gen = old / nloc;
        if (old + 1u == (gen + 1u) * nloc) {
            __builtin_amdgcn_fence(__ATOMIC_RELEASE, "agent");
            asm volatile("s_waitcnt vmcnt(0)" ::: "memory");
            const unsigned og = xb_add(&bar[XB_TOP], 1u);
            const unsigned tg = og / nx;
            if (og + 1u == (tg + 1u) * nx) xb_add(&bar[XB_TOPGEN], 1u);
            else XB_SPIN(xb_ld(&bar[XB_TOPGEN]) == tg, bar);
            __builtin_amdgcn_fence(__ATOMIC_ACQUIRE, "agent");
            xb_add(&bar[XB_XGEN(b.x)], 1u);
            asm volatile("s_waitcnt vmcnt(0)" ::: "memory");
        } else {
            XB_SPIN(xb_ld(&bar[XB_XGEN(b.x)]) == gen, bar);
            __builtin_amdgcn_fence(__ATOMIC_ACQUIRE, "agent");
            asm volatile("s_waitcnt vmcnt(0)" ::: "memory");
        }
    }
    __syncthreads();
}


struct Frame {
    LAS unsigned char* lds;
    volatile LAS unsigned* MISC;
    gu32* ctl;
    int vcu, G, bx;
    __device__ __forceinline__ int ltid() const { int t = threadIdx.x; asm volatile("" : "+v"(t)); return t; }
    const float *x, *c, *ctx, *cctx, *w_ada, *b_ada, *w_in, *lam_qk, *subln_g, *gln_g, *gln_b, *w_sp, *b_sp, *w_pool, *pool_scale, *w_branch, *w_out, *ln1_g, *ln1_b, *w_gu, *w_down, *ln2_g, *ln2_b;
    float* out;
    float *rope, *mods, *modp, *X;
    bf16 *Wsp, *Wpool, *Win, *Wbr, *Wout, *Wgu, *Wdn, *HA, *Y, *MG, *Z, *KB, *VB;
};

typedef __attribute__((address_space(4))) const unsigned char* kptr_t;
__device__ __forceinline__ void frame_ptrs(Frame& F) {
    kptr_t kp = (kptr_t)__builtin_amdgcn_kernarg_segment_ptr(); asm volatile("" : "+s"(kp));
#define KIN(i) (*(const float* const __attribute__((address_space(4)))*)(kp + 8 * (i)))
    F.x = KIN(0); F.c = KIN(1); F.ctx = KIN(2); F.cctx = KIN(3); F.w_ada = KIN(4); F.b_ada = KIN(5); F.w_in = KIN(6); F.lam_qk = KIN(7); F.subln_g = KIN(8);
    F.gln_g = KIN(9); F.gln_b = KIN(10); F.w_sp = KIN(11); F.b_sp = KIN(12); F.w_pool = KIN(13); F.pool_scale = KIN(14); F.w_branch = KIN(15); F.w_out = KIN(16);
    F.ln1_g = KIN(17); F.ln1_b = KIN(18); F.w_gu = KIN(19); F.w_down = KIN(20); F.ln2_g = KIN(21); F.ln2_b = KIN(22);
#undef KIN
    F.out = *(float* const __attribute__((address_space(4)))*)(kp + 184);
    unsigned char* ws = *(unsigned char* const __attribute__((address_space(4)))*)(kp + 192);
    F.rope = (float*)(ws + WS_ROPE); F.mods = (float*)(ws + WS_MODS); F.modp = (float*)(ws + WS_MODP); F.X = (float*)(ws + WS_X);
    F.Wsp = (bf16*)(ws + WS_WSP); F.Wpool = (bf16*)(ws + WS_WPOOL); F.Win = (bf16*)(ws + WS_WIN); F.Wbr = (bf16*)(ws + WS_WBR); F.Wout = (bf16*)(ws + WS_WOUT); F.Wgu = (bf16*)(ws + WS_WGU); F.Wdn = (bf16*)(ws + WS_WDN);
    F.HA = (bf16*)(ws + WS_HA); F.Y = (bf16*)(ws + WS_Y); F.MG = (bf16*)(ws + WS_MG); F.Z = (bf16*)(ws + WS_Z); F.KB = (bf16*)(ws + WS_KB); F.VB = (bf16*)(ws + WS_VB);
}
__device__ __forceinline__ float wave_sum(float v) {
#pragma unroll
    for (int o = 1; o < 64; o <<= 1) v += __shfl_xor(v, o);
    return v;
}

__device__ __forceinline__ void cvt_item(const float* W, int N, int k0, int ncol0, bool perm, bf16* WT, size_t drow0, int ldk, int dk0, LAS float* scr, int lane) {
#pragma unroll 8
    for (int i = 0; i < 32; ++i) { const int kk = 2 * i + (lane >> 5); scr[kk * 33 + (lane & 31)] = __builtin_nontemporal_load(W + (size_t)(k0 + kk) * N + ncol0 + (lane & 31)); }
    LDS_WAIT(); asm volatile("" ::: "memory");
    const int c = lane & 7;
#pragma unroll
    for (int j = 0; j < 4; ++j) { const int n = (lane >> 3) + 8 * j; const int ns = perm ? ((n & 1) * 16 + (n >> 1)) : n; const LAS float* s = scr + (8 * c) * 33 + ns;
        v4u o; o.x = pk2(s[0 * 33], s[1 * 33]); o.y = pk2(s[2 * 33], s[3 * 33]); o.z = pk2(s[4 * 33], s[5 * 33]); o.w = pk2(s[6 * 33], s[7 * 33]);
        *(GAS v4u*)(WT + (drow0 + n) * (size_t)ldk + dk0 + k0 + 8 * c) = o; }
    LDS_WAIT(); asm volatile("" ::: "memory");
}
constexpr int CV_IN = 32 * 384, CV_GU = 32 * 352, CV_DN = 88 * 64, CV_BR = 3 * 16 * 64, CV_OUT = 32 * 64, CV_POOL = 4 * 4 * 8, CV_LAYER = CV_IN + CV_GU + CV_DN + CV_BR + CV_OUT + CV_POOL;
__device__ __forceinline__ void cvt_dispatch(Frame& F, int it, LAS float* scr) {
    const int l = it / CV_LAYER; int r = it - l * CV_LAYER;
    if (r < CV_IN) { const int kb = r / 384, nb = r - kb * 384;
        cvt_item(F.w_in + (size_t)l * D * INW, INW, 64 * kb, 32 * nb, nb < 64, F.Win + (size_t)l * INW * D, (size_t)32 * nb, D, 0, scr, (F.ltid() & 63)); return; }
    r -= CV_IN;
    if (r < CV_GU) { const int kb = r / 352, nb = r - kb * 352; const int tpn = nb >> 3, half = (nb >> 2) & 1, jj0 = (nb & 3) * 32;
        cvt_item(F.w_gu + (size_t)l * D * 2 * FFH, 2 * FFH, 64 * kb, half * FFH + 128 * tpn + jj0, false, F.Wgu + (size_t)l * 2 * FFH * D, (size_t)32 * nb, D, 0, scr, (F.ltid() & 63)); return; }
    r -= CV_GU;
    if (r < CV_DN) { const int kb = r >> 6, nb = r & 63;
        cvt_item(F.w_down + (size_t)l * FFH * D, D, 64 * kb, 32 * nb, false, F.Wdn + (size_t)l * D * FFH, (size_t)32 * nb, FFH, 0, scr, (F.ltid() & 63)); return; }
    r -= CV_DN;
    if (r < CV_BR) { const int n = r >> 10, rr = r & 1023, kb = rr >> 6, nb = rr & 63;
        cvt_item(F.w_branch + ((size_t)l * 3 + n) * BW * D, D, 64 * kb, 32 * nb, false, F.Wbr + (size_t)l * D * YW, (size_t)32 * nb, YW, BW * n, scr, (F.ltid() & 63)); return; }
    r -= CV_BR;
    if (r < CV_OUT) { const int kb = r >> 6, nb = r & 63;
        cvt_item(F.w_out + (size_t)l * D * D, D, 64 * kb, 32 * nb, false, F.Wout + (size_t)l * D * D, (size_t)32 * nb, D, 0, scr, (F.ltid() & 63)); return; }
    r -= CV_OUT;
    { const int g = r >> 5, rr = r & 31, kb = rr >> 3, nb = rr & 7;
        cvt_item(F.w_pool + ((size_t)l * 4 + g) * 65536, 256, 64 * kb, 32 * nb, false, F.Wpool + ((size_t)l * 4 + g) * 65536, (size_t)32 * nb, 256, 0, scr, (F.ltid() & 63)); }
}

__device__ __forceinline__ double rope_inv(int p) {
    const double t[16] = {1.0, 0.5623413251903491, 0.31622776601683794, 0.1778279410038923, 0.1, 0.05623413251903491, 0.03162277660168379, 0.01778279410038923,
                          0.01, 0.005623413251903491, 0.003162277660168379, 0.001778279410038923, 0.001, 0.0005623413251903491, 0.00031622776601683794, 0.0001778279410038923};
    double r = t[0];
#pragma unroll
    for (int i = 1; i < 16; ++i) r = (p == i) ? t[i] : r;
    return r;
}
#ifndef TAILWORK
#define TAILWORK 0
#endif
__device__ __forceinline__ void ada_partial_layer(Frame& F, int l, int gw, int NGW) {
    LAS float* scs = (LAS float*)(F.lds);
    __syncthreads();
    for (int i = F.ltid(); i < 5 * D; i += NWAVES * 64) { const int g = i >> 11, k = i & 2047; const float v = g < 4 ? F.c[g * D + k] : F.cctx[k]; scs[i] = v / (1.0f + __expf(-v)); }
    __syncthreads();
    for (int it = gw; it < 16 * 48; it += NGW) {
        const int ks = it / 48, cgw = it - ks * 48; const int col = cgw * 256 + (F.ltid() & 63) * 4;
        const float* wp = F.w_ada + ((size_t)l * D + ks * 128) * INW + col;
        f32x4 a0 = {0.f, 0.f, 0.f, 0.f}, a1 = a0, a2 = a0, a3 = a0, a4 = a0;
#pragma unroll 8
        for (int k = 0; k < 128; ++k) { const f32x4 w = __builtin_nontemporal_load((const GAS f32x4*)(wp + (size_t)k * INW)); const int kk = ks * 128 + k;
            a0 += w * scs[kk]; a1 += w * scs[D + kk]; a2 += w * scs[2 * D + kk]; a3 += w * scs[3 * D + kk]; a4 += w * scs[4 * D + kk]; }
        float* pp = F.modp + (((size_t)ks * 4 + l) * 5) * INW + col;
        *(f32x4*)(pp) = a0; *(f32x4*)(pp + INW) = a1; *(f32x4*)(pp + 2 * INW) = a2; *(f32x4*)(pp + 3 * INW) = a3; *(f32x4*)(pp + 4 * INW) = a4;
    }
    __syncthreads();
}
__device__ __forceinline__ void cvt_layer(Frame& F, int l, int gw, int NGW) {
    LAS float* scr = (LAS float*)(F.lds + __builtin_amdgcn_readfirstlane(F.ltid() >> 6) * 16384);
    for (int it = gw; it < CV_LAYER; it += NGW) cvt_dispatch(F, l * CV_LAYER + it, scr);
}
__device__ __forceinline__ void mods_reduce_layer(Frame& F, int l) {
    const int gt = F.vcu * NWAVES * 64 + F.ltid(), NGT = F.G * NWAVES * 64;
    for (int i = gt; i < 5 * (INW / 4); i += NGT) { const int g = i / (INW / 4), j = (i - g * (INW / 4)) * 4;
        f32x4 sm = *(const f32x4*)(F.b_ada + (size_t)l * INW + j);
#pragma unroll
        for (int ks = 0; ks < 16; ++ks) sm += *(const f32x4*)(F.modp + (((size_t)ks * 4 + l) * 5 + g) * INW + j);
        *(f32x4*)(F.mods + ((size_t)l * 5 + g) * INW + j) = sm; }
}
__device__ __forceinline__ void phase_a1(Frame& F) {
    const int gw = F.vcu * NWAVES + __builtin_amdgcn_readfirstlane(F.ltid() >> 6), NGW = F.G * NWAVES;
#pragma nounroll
    for (int l = 0; l < (TAILWORK ? 1 : DEPTH); ++l) ada_partial_layer(F, l, gw, NGW);
#pragma nounroll
    for (int l = 0; l < (TAILWORK ? 1 : DEPTH); ++l) cvt_layer(F, l, gw, NGW);
    for (int it = gw; it < (DEPTH * 8 * 128 * 128) / 512; it += NGW) { const size_t e = (size_t)it * 512 + (F.ltid() & 63) * 8;
        const f32x4 a = *(const f32x4*)(F.w_sp + e), b = *(const f32x4*)(F.w_sp + e + 4);
        v4u o; o.x = pk2(a[0], a[1]); o.y = pk2(a[2], a[3]); o.z = pk2(b[0], b[1]); o.w = pk2(b[2], b[3]); *(v4u*)(F.Wsp + e) = o; }
    if (gw == 0) {
        for (int e = (F.ltid() & 63); e < 1024; e += 64) { const int pos = e >> 4, pr = e & 15;
            const double ang = (double)pos * rope_inv(pr); const double twopi = 6.283185307179586476925286766559;
            const double kq = __builtin_rint(ang / twopi); const double rr = ang - kq * twopi; const double r2 = rr * rr;
            double sn = 1.0, cs = 1.0;
#pragma unroll
            for (int n = 14; n >= 1; --n) { sn = 1.0 - sn * r2 / (double)((2 * n) * (2 * n + 1)); cs = 1.0 - cs * r2 / (double)((2 * n - 1) * (2 * n)); }
            sn *= rr;
            F.rope[2 * e] = (float)cs; F.rope[2 * e + 1] = (float)sn; }
    }
}
__device__ __forceinline__ void phase_a2(Frame& F) {
#pragma nounroll
    for (int l = 0; l < (TAILWORK ? 1 : DEPTH); ++l) mods_reduce_layer(F, l); }
__device__ __forceinline__ void ln_row(const float* src, const bf16* tadd, const float* part, int npart, const float* gam, const float* bet, float* xo, float xs, bf16* ho, const float* sc, const float* sh, int lane) {
    f32x4 v[8]; float s = 0.f;
#pragma unroll
    for (int j = 0; j < 8; ++j) v[j] = __builtin_nontemporal_load((const GAS f32x4*)(src + 4 * lane + 256 * j));
    if (tadd) {
#pragma unroll
        for (int j = 0; j < 8; ++j) { const v2u t2 = *(const GAS v2u*)(tadd + 4 * lane + 256 * j); v[j] += (f32x4){bflo(t2.x), bfhi(t2.x), bflo(t2.y), bfhi(t2.y)}; } }
    for (int p = 0; p < npart; ++p) {
#pragma unroll
        for (int j = 0; j < 8; ++j) v[j] += __builtin_nontemporal_load((const GAS f32x4*)(part + (size_t)p * 1024 * D + 4 * lane + 256 * j)); }
#pragma unroll
    for (int j = 0; j < 8; ++j) s += (v[j][0] + v[j][1]) + (v[j][2] + v[j][3]);
    const float mean = wave_sum(s) * (1.f / D); float s2 = 0.f;
#pragma unroll
    for (int j = 0; j < 8; ++j) { v[j] = v[j] - mean; s2 += (v[j][0] * v[j][0] + v[j][1] * v[j][1]) + (v[j][2] * v[j][2] + v[j][3] * v[j][3]); }
    const float rstd = 1.0f / sqrtf(wave_sum(s2) * (1.f / D) + LN_EPS);
#pragma unroll
    for (int j = 0; j < 8; ++j) { const int col = 4 * lane + 256 * j; f32x4 xn = v[j] * rstd;
        if (gam) xn = xn * *(const f32x4*)(gam + col) + *(const f32x4*)(bet + col);
        if (xo) __builtin_nontemporal_store(xn * xs, (GAS f32x4*)(xo + col));
        if (ho) { const f32x4 hv = xn * (1.0f + *(const f32x4*)(sc + col)) + *(const f32x4*)(sh + col); v2u o; o.x = pk2(hv[0], hv[1]); o.y = pk2(hv[2], hv[3]); __builtin_nontemporal_store(o, (GAS v2u*)(ho + col)); } }
}
__device__ __forceinline__ int row_group(int row) { return row < MLAT ? (row >> 12) : 4; }
__device__ __forceinline__ void phase_a3(Frame& F) {
    const int gw = F.vcu * NWAVES + __builtin_amdgcn_readfirstlane(F.ltid() >> 6), NGW = F.G * NWAVES;
    for (int row = gw; row < MTOT; row += NGW) { const float* src = row < MLAT ? F.x + (size_t)row * D : F.ctx + (size_t)(row - MLAT) * D; const float* md = F.mods + (size_t)row_group(row) * INW;
        ln_row(src, nullptr, nullptr, 0, nullptr, nullptr, F.X + (size_t)row * D, ALPHA, F.HA + (size_t)row * D, md + D, md, (F.ltid() & 63)); }
}
#ifndef LN_NT
#define LN_NT 1
#endif
#if LN_NT
#define LN_LD(p) __builtin_nontemporal_load(p)
#define LN_ST(p, v) __builtin_nontemporal_store((v), (p))
#else
#define LN_LD(p) (*(p))
#define LN_ST(p, v) (*(p) = (v))
#endif
__device__ __forceinline__ void ln_finish(f32x4 (&v)[8], const float* gam, const float* bet, float* xo, float xs, bf16* ho, const float* sc, const float* sh, int lane) {
    float s = 0.f;
#pragma unroll
    for (int j = 0; j < 8; ++j) s += (v[j][0] + v[j][1]) + (v[j][2] + v[j][3]);
    const float mean = wave_sum(s) * (1.f / D); float s2 = 0.f;
#pragma unroll
    for (int j = 0; j < 8; ++j) { v[j] = v[j] - mean; s2 += (v[j][0] * v[j][0] + v[j][1] * v[j][1]) + (v[j][2] * v[j][2] + v[j][3] * v[j][3]); }
    const float rstd = 1.0f / sqrtf(wave_sum(s2) * (1.f / D) + LN_EPS);
#pragma unroll
    for (int j = 0; j < 8; ++j) { const int col = 4 * lane + 256 * j; f32x4 xn = v[j] * rstd;
        xn = xn * *(const f32x4*)(gam + col) + *(const f32x4*)(bet + col);
        if (xo) LN_ST((GAS f32x4*)(xo + col), xn * xs);
        if (ho) { const f32x4 hv = xn * (1.0f + *(const f32x4*)(sc + col)) + *(const f32x4*)(sh + col); v2u o; o.x = pk2(hv[0], hv[1]); o.y = pk2(hv[2], hv[3]); LN_ST((GAS v2u*)(ho + col), o); } }
}
__device__ __forceinline__ void phase_ln(Frame& F, const float* gam, const float* bet, int nrows, bool to_out, bool want_h, int lm, int moff, int nsplit, bool dry = false) {
    const int gw = F.vcu * NWAVES + __builtin_amdgcn_readfirstlane(F.ltid() >> 6), NGW = F.G * NWAVES; const int lane = F.ltid() & 63;
    f32x4 xa[8]; v2u ta[8];
    int row = gw;
    if (row < MLAT) {
#pragma unroll
        for (int j = 0; j < 8; ++j) { xa[j] = LN_LD((const GAS f32x4*)(F.X + (size_t)row * D + 4 * lane + 256 * j)); ta[j] = LN_LD((const GAS v2u*)(F.Y + (size_t)row * D + 4 * lane + 256 * j)); } }
    for (; row < MLAT; row += NGW) {
        f32x4 v[8];
#pragma unroll
        for (int j = 0; j < 8; ++j) v[j] = xa[j] + (f32x4){bflo(ta[j].x), bfhi(ta[j].x), bflo(ta[j].y), bfhi(ta[j].y)};
        const int nx = row + NGW;
        if (nx < MLAT) {
#pragma unroll
            for (int j = 0; j < 8; ++j) { xa[j] = LN_LD((const GAS f32x4*)(F.X + (size_t)nx * D + 4 * lane + 256 * j)); ta[j] = LN_LD((const GAS v2u*)(F.Y + (size_t)nx * D + 4 * lane + 256 * j)); } }
        const float* md = F.mods + ((size_t)lm * 5 + (row >> 12)) * INW + moff;
        ln_finish(v, gam, bet, dry ? (float*)(F.Z + (size_t)134 * MiB) + (size_t)row * D : (to_out ? F.out + (size_t)row * D : F.X + (size_t)row * D), to_out ? 1.0f : ALPHA, want_h ? (dry ? F.MG : F.HA) + (size_t)row * D : nullptr, md + D, md, lane);
    }
    for (; row < nrows; row += NGW) { const float* md = F.mods + ((size_t)lm * 5 + 4) * INW + moff;
        ln_row(F.X + (size_t)row * D, nullptr, (const float*)(F.Z + (size_t)100 * MiB) + (size_t)(row - MLAT) * D, nsplit, gam, bet, dry ? (float*)(F.Z + (size_t)134 * MiB) + (size_t)row * D : (to_out ? F.out + (size_t)row * D : F.X + (size_t)row * D), to_out ? 1.0f : ALPHA, want_h ? (dry ? F.MG : F.HA) + (size_t)row * D : nullptr, md + D, md, lane); }
}

constexpr int AT_KB = 0, AT_VB = 32768, AT_TILE = 16384, AT_XB = 65536;
__device__ __forceinline__ s16x4 vtr(const LAS unsigned char* p) { typedef short v4i16_t __attribute__((ext_vector_type(4))); return __builtin_bit_cast(s16x4, __builtin_amdgcn_ds_read_tr16_b64_v4i16((LAS v4i16_t*)p)); }
__device__ __forceinline__ float max3f(float a, float b, float c) { float r; asm("v_max3_f32 %0, %1, %2, %3" : "=v"(r) : "v"(a), "v"(b), "v"(c)); return r; }
__device__ __forceinline__ void glds16(const void* gsrc, unsigned lds_dst) { unsigned keep;
    asm volatile("s_mov_b32 %0, m0\n\ts_mov_b32 m0, %2\n\ts_nop 0\n\tglobal_load_lds_dwordx4 %1, off\n\ts_mov_b32 m0, %0" : "=&s"(keep) : "v"(gsrc), "s"(lds_dst) : "memory"); }
#define AT_WAITV(n) asm volatile("s_waitcnt vmcnt(" #n ")" ::: "memory")
#define AT_BAR() asm volatile("s_waitcnt lgkmcnt(0)\n\ts_barrier" ::: "memory")
__device__ __forceinline__ void attn_unit(Frame& F, int b, int h, int qb, bool ctxq, float lam, float oscale, const float* subg) {
    int lane_ = (F.ltid() & 63); asm volatile("" : "+v"(lane_));
    const int lane = lane_, wid = __builtin_amdgcn_readfirstlane(F.ltid() >> 6), r32 = lane & 31, hi = lane >> 5, m = wid >> 2, qg = wid & 3; const bool lead = wid < 4;
    const bf16* Z = F.Z;
    const int qrow = (ctxq ? MLAT + b * CTXL : b * SEQ) + qb * 128 + qg * 32 + r32;
    bf16x8 qf[4];
#pragma unroll
    for (int d0 = 0; d0 < 4; ++d0) qf[d0] = *(const GAS bf16x8*)(Z + (size_t)qrow * INW + Q_OFF + h * 128 + m * 64 + d0 * 16 + hi * 8);
    const int NT = ctxq ? 4 : 68;
    const bf16* Kbh = F.KB + (size_t)(b * 8 + h) * 4352 * 128; const bf16* Vbh = F.VB + (size_t)(b * 8 + h) * 4352 * 128;
    const unsigned lds0 = (unsigned)(size_t)F.lds;
    const int prow = 8 * wid + (lane >> 4), ppos = lane & 15;
    const unsigned koff0 = (unsigned)(prow * 128 + ((ppos ^ (prow & 15)) * 8)), koff1 = (unsigned)((prow + 4) * 128 + ((ppos ^ ((prow + 4) & 15)) * 8));
    const unsigned voff0 = (unsigned)(prow * 128 + ((ppos ^ (4 * (prow & 3))) * 8)), voff1 = voff0 + 4 * 128;
    const unsigned kdst = (unsigned)__builtin_amdgcn_readfirstlane((int)(lds0 + AT_KB + wid * 2048)), vdst = (unsigned)__builtin_amdgcn_readfirstlane((int)(lds0 + AT_VB + wid * 2048));
#define AT_DMAK(t, bufo) do { const bf16* tb_ = Kbh + (size_t)(t) * 8192; glds16(tb_ + koff0, kdst + (bufo)); glds16(tb_ + koff1, kdst + (bufo) + 1024); } while (0)
#define AT_DMAV(t, bufo) do { const bf16* tb_ = Vbh + (size_t)(t) * 8192; glds16(tb_ + voff0, vdst + (bufo)); glds16(tb_ + voff1, vdst + (bufo) + 1024); } while (0)
    f32x16 o[4];
#pragma unroll
    for (int db = 0; db < 4; ++db)
#pragma unroll
        for (int r = 0; r < 16; ++r) o[db][r] = 0.f;
    float mref = 0.f, lsum = 0.f;
    f32x16 negm;
#pragma unroll
    for (int r = 0; r < 16; ++r) negm[r] = 0.f;
    const unsigned kaddr0 = AT_KB + r32 * 256 + (((8 * m + hi) ^ (r32 & 15)) << 4);
    const int a4 = (lane & 15) >> 2, cc = 2 * ((lane >> 4) & 1) + ((lane & 3) >> 1);
    const unsigned vaddr0 = AT_VB + (4 * hi + a4) * 256 + ((4 * a4 + cc) << 4) + 8 * (lane & 1);
    __syncthreads();
    AT_DMAK(0, 0); AT_DMAV(0, 0);
    AT_WAITV(2); AT_BAR();
    if (!lead) { if (NT > 1) { AT_DMAK(1, AT_TILE); AT_WAITV(2); } else AT_WAITV(0); AT_BAR(); }
    for (int t = 0; t < NT; ++t) {
        const unsigned bo = (t & 1) ? AT_TILE : 0; const bool more = (t + 1 < NT);
        if (more) { if (lead) AT_DMAK(t + 1, bo ^ AT_TILE); else AT_DMAV(t + 1, bo ^ AT_TILE); }
        unsigned kb_ = kaddr0 + bo, vb_ = vaddr0 + bo; asm volatile("" : "+v"(kb_), "+v"(vb_));
        f32x16 p0, p1;
        { bf16x8 kf[4][2];
#pragma unroll
          for (int d0 = 0; d0 < 4; ++d0) { const unsigned ka = kb_ ^ (unsigned)((2 * d0) << 4); kf[d0][0] = *(const LAS bf16x8*)(F.lds + ka); kf[d0][1] = *(const LAS bf16x8*)(F.lds + ka + 32 * 256); }
          __builtin_amdgcn_sched_barrier(0);
          p0 = __builtin_amdgcn_mfma_f32_32x32x16_bf16(kf[0][0], qf[0], negm, 0, 0, 0);
#pragma unroll
          for (int d0 = 1; d0 < 4; ++d0) p0 = __builtin_amdgcn_mfma_f32_32x32x16_bf16(kf[d0][0], qf[d0], p0, 0, 0, 0);
          p1 = __builtin_amdgcn_mfma_f32_32x32x16_bf16(kf[0][1], qf[0], negm, 0, 0, 0);
#pragma unroll
          for (int d0 = 1; d0 < 4; ++d0) p1 = __builtin_amdgcn_mfma_f32_32x32x16_bf16(kf[d0][1], qf[d0], p1, 0, 0, 0); }
#define AT_SOFTMAX(P, OTHER, PK, FIRST) do { \
        float tmax = max3f(P[0], P[1], P[2]); \
        _Pragma("unroll") for (int r = 3; r < 15; r += 2) tmax = max3f(tmax, P[r], P[r + 1]); \
        tmax = __builtin_fmaxf(tmax, P[15]); { auto rr_ = __builtin_amdgcn_permlane32_swap(__float_as_uint(tmax), __float_as_uint(tmax), false, false); tmax = __builtin_fmaxf(__uint_as_float(rr_[0]), __uint_as_float(rr_[1])); } \
        if (FIRST) { mref = tmax; \
            _Pragma("unroll") for (int r = 0; r < 16; ++r) { P[r] -= tmax; OTHER[r] -= tmax; negm[r] = -mref; } \
        } else if (__any(tmax > 8.0f)) { \
            const float dl = __builtin_fmaxf(tmax, 0.f); mref += dl; const float al = __builtin_amdgcn_exp2f(-dl); lsum *= al; \
            _Pragma("unroll") for (int r = 0; r < 16; ++r) { P[r] -= dl; OTHER[r] -= dl; negm[r] = -mref; } \
            _Pragma("unroll") for (int db = 0; db < 4; ++db) _Pragma("unroll") for (int r = 0; r < 16; ++r) o[db][r] *= al; \
        } \
        float ls0_ = 0.f, ls1_ = 0.f, ls2_ = 0.f, ls3_ = 0.f; \
        _Pragma("unroll") for (int r = 0; r < 16; r += 4) { P[r] = __builtin_amdgcn_exp2f(P[r]); P[r + 1] = __builtin_amdgcn_exp2f(P[r + 1]); P[r + 2] = __builtin_amdgcn_exp2f(P[r + 2]); P[r + 3] = __builtin_amdgcn_exp2f(P[r + 3]); \
            ls0_ += P[r]; ls1_ += P[r + 1]; ls2_ += P[r + 2]; ls3_ += P[r + 3]; } \
        lsum += (ls0_ + ls1_) + (ls2_ + ls3_); \
        _Pragma("unroll") for (int s_ = 0; s_ < 2; ++s_) { v4u w_; \
            w_.x = cvtpk(P[8 * s_ + 0], P[8 * s_ + 1]); w_.y = cvtpk(P[8 * s_ + 2], P[8 * s_ + 3]); w_.z = cvtpk(P[8 * s_ + 4], P[8 * s_ + 5]); w_.w = cvtpk(P[8 * s_ + 6], P[8 * s_ + 7]); \
            PK[s_] = __builtin_bit_cast(bf16x8, w_); } } while (0)
        bf16x8 pka[2], pkb[2];
        f32x16 dummy_;
        AT_SOFTMAX(p0, p1, pka, t == 0);
        if (more) AT_WAITV(2); else AT_WAITV(0);
        AT_BAR();
        if (lead) { if (more) AT_DMAV(t + 1, bo ^ AT_TILE); } else { if (t + 2 < NT) AT_DMAK(t + 2, bo); }
        { s16x4 va_[4][2][2], vc_[4][2][2];
#define AT_VLOAD(dst, kh_) do { _Pragma("unroll") for (int d_ = 0; d_ < 4; ++d_) { const unsigned va = vb_ ^ (unsigned)(d_ << 6); \
            _Pragma("unroll") for (int s_ = 0; s_ < 2; ++s_) { dst[d_][s_][0] = vtr(F.lds + va + (32 * (kh_) + 16 * s_) * 256); dst[d_][s_][1] = vtr(F.lds + va + (32 * (kh_) + 16 * s_ + 8) * 256); } } } while (0)
#define AT_VMMA(src, PK) do { _Pragma("unroll") for (int s_ = 0; s_ < 2; ++s_) _Pragma("unroll") for (int d_ = 0; d_ < 4; ++d_) { \
            const bf16x8 vf = (bf16x8){src[d_][s_][0][0], src[d_][s_][0][1], src[d_][s_][0][2], src[d_][s_][0][3], src[d_][s_][1][0], src[d_][s_][1][1], src[d_][s_][1][2], src[d_][s_][1][3]}; \
            o[d_] = __builtin_amdgcn_mfma_f32_32x32x16_bf16(vf, PK[s_], o[d_], 0, 0, 0); } } while (0)
          AT_VLOAD(va_, 0); __builtin_amdgcn_sched_barrier(0);
          AT_VLOAD(vc_, 1); __builtin_amdgcn_sched_barrier(0);
          AT_VMMA(va_, pka);
          AT_SOFTMAX(p1, dummy_, pkb, false);
          AT_VMMA(vc_, pkb);
          __builtin_amdgcn_sched_barrier(0);
#undef AT_VLOAD
#undef AT_VMMA
        }
#undef AT_SOFTMAX
        if (lead) { if (more) AT_WAITV(2); } else { if (t + 2 < NT) AT_WAITV(2); else AT_WAITV(0); }
        AT_BAR();
    }
    if (lead) AT_BAR();
    const float lt = lsum + __shfl_xor(lsum, 32);
    LAS float* xs = (LAS float*)(F.lds + AT_XB) + qg * 4096 + lane;
    if (!lead) { const float sc1 = lam / lt;
#pragma unroll
        for (int db = 0; db < 4; ++db)
#pragma unroll
            for (int r = 0; r < 16; ++r) xs[(db * 16 + r) * 64] = o[db][r] * sc1; }
    __syncthreads();
    if (lead) {
        const float i0 = 1.0f / lt; float ss = 0.f;
#pragma unroll
        for (int db = 0; db < 4; ++db)
#pragma unroll
            for (int r = 0; r < 16; ++r) { const float v = o[db][r] * i0 - xs[(db * 16 + r) * 64]; o[db][r] = v; ss += v * v; }
        ss += __shfl_xor(ss, 32);
        const float rs = oscale / sqrtf(ss * (1.0f / 128.0f) + LN_EPS);
        bf16* yp = F.Y + (size_t)qrow * YW + h * 128 + 4 * hi;
#pragma unroll
        for (int db = 0; db < 4; ++db)
#pragma unroll
            for (int g4 = 0; g4 < 4; ++g4) { const int d = 32 * db + 8 * g4; const f32x4 gv = *(const f32x4*)(subg + d + 4 * hi);
                v2u w; w.x = cvtpk(o[db][4 * g4 + 0] * rs * gv[0], o[db][4 * g4 + 1] * rs * gv[1]); w.y = cvtpk(o[db][4 * g4 + 2] * rs * gv[2], o[db][4 * g4 + 3] * rs * gv[3]);
                *(GAS v2u*)(yp + d) = w; }
    }
#undef AT_DMAK
#undef AT_DMAV
}

constexpr int GM_ST = 0, GM_VT = 1024, GM_VP = 272;
__device__ __forceinline__ void gmlp_unit(Frame& F, int row0, int l) {
    int tid_ = F.ltid(); asm volatile("" : "+v"(tid_)); const int tid = tid_, lane = tid & 63, wid = __builtin_amdgcn_readfirstlane(F.ltid() >> 6);
    typedef float f32x2v __attribute__((ext_vector_type(2)));
    LAS f32x2v* st = (LAS f32x2v*)(F.lds + GM_ST); LAS unsigned char* vt = F.lds + GM_VT;
    const bf16* Z = F.Z;
    __syncthreads();
#pragma unroll
    for (int hb = 0; hb < 2; ++hb) {
        v4u va[8], vb[8];
#pragma unroll
        for (int i = 0; i < 8; ++i) { const bf16* vp = Z + (size_t)(row0 + wid * 16 + hb * 8 + i) * INW + BU_OFF + BW + lane * 16; va[i] = *(const GAS v4u*)(vp); vb[i] = *(const GAS v4u*)(vp + 8); }
#pragma unroll
        for (int i = 0; i < 8; ++i) { const v4u a = va[i], b2 = vb[i];
            const float x[16] = {bflo(a.x), bfhi(a.x), bflo(a.y), bfhi(a.y), bflo(a.z), bfhi(a.z), bflo(a.w), bfhi(a.w), bflo(b2.x), bfhi(b2.x), bflo(b2.y), bfhi(b2.y), bflo(b2.z), bfhi(b2.z), bflo(b2.w), bfhi(b2.w)};
            float s = 0.f;
#pragma unroll
            for (int e = 0; e < 16; ++e) s += x[e];
            const float mean = wave_sum(s) * (1.0f / 1024.0f); float q = 0.f;
#pragma unroll
            for (int e = 0; e < 16; ++e) { const float dd = x[e] - mean; q += dd * dd; }
            const float rstd = 1.0f / sqrtf(wave_sum(q) * (1.0f / 1024.0f) + LN_EPS);
            if (lane == 0) st[wid * 16 + hb * 8 + i] = (f32x2v){mean, rstd}; }
    }
    const float* lng = F.gln_g + (size_t)l * BW; const float* lnb = F.gln_b + (size_t)l * BW;
    const int j = tid & 127, cc = tid >> 7;
    const int fr = lane & 15, fq = lane >> 4, tok = wid * 16 + fr;
    const bf16* vsrc = Z + (size_t)(row0 + j) * INW + BU_OFF + BW + cc * 32;
    v4u vr[4];
#pragma unroll
    for (int q4 = 0; q4 < 4; ++q4) vr[q4] = *(const GAS v4u*)(vsrc + q4 * 8);
    __syncthreads();
    const f32x2v sj = st[j];
#pragma unroll 1
    for (int g = 0; g < 8; ++g) {
        bf16x8 wf[4]; v2u uu[8];
        const bf16* wg = F.Wsp + ((size_t)l * 8 + g) * 16384 + (size_t)tok * 128 + fq * 8;
#pragma unroll
        for (int ks = 0; ks < 4; ++ks) wf[ks] = *(const GAS bf16x8*)(wg + ks * 32);
        const bf16* up = Z + (size_t)(row0 + tok) * INW + BU_OFF + g * 128 + 4 * fq;
#pragma unroll
        for (int ct = 0; ct < 8; ++ct) uu[ct] = *(const GAS v2u*)(up + ct * 16);
        const float bias = F.b_sp[((size_t)l * 8 + g) * 128 + tok];
#pragma unroll
        for (int q4 = 0; q4 < 4; ++q4) { const v4u a = vr[q4]; const int c0 = cc * 32 + q4 * 8;
            const f32x4 g0 = *(const f32x4*)(lng + g * 128 + c0), g1 = *(const f32x4*)(lng + g * 128 + c0 + 4), b0 = *(const f32x4*)(lnb + g * 128 + c0), b1 = *(const f32x4*)(lnb + g * 128 + c0 + 4);
            const float xv[8] = {bflo(a.x), bfhi(a.x), bflo(a.y), bfhi(a.y), bflo(a.z), bfhi(a.z), bflo(a.w), bfhi(a.w)};
#pragma unroll
            for (int e = 0; e < 8; ++e) { const float gg = e < 4 ? g0[e & 3] : g1[e & 3], bb = e < 4 ? b0[e & 3] : b1[e & 3]; const float y = (xv[e] - sj.x) * sj.y * gg + bb;
                *(LAS bf16*)(vt + (c0 + e) * GM_VP + j * 2) = (bf16)f2bf(y); } }
        if (g < 7) {
#pragma unroll
            for (int q4 = 0; q4 < 4; ++q4) vr[q4] = *(const GAS v4u*)(vsrc + (g + 1) * 128 + q4 * 8);
        }
        __syncthreads();
#pragma unroll
        for (int ct = 0; ct < 8; ++ct) { f32x4 acc = {0.f, 0.f, 0.f, 0.f};
#pragma unroll
            for (int ks = 0; ks < 4; ++ks) { const bf16x8 af = *(const LAS bf16x8*)(vt + (ct * 16 + fr) * GM_VP + (ks * 32 + fq * 8) * 2); acc = __builtin_amdgcn_mfma_f32_16x16x32_bf16(af, wf[ks], acc, 0, 0, 0); }
            const v2u u2 = uu[ct];
            v2u w; w.x = cvtpk(bflo(u2.x) * (acc[0] + bias), bfhi(u2.x) * (acc[1] + bias)); w.y = cvtpk(bflo(u2.y) * (acc[2] + bias), bfhi(u2.y) * (acc[3] + bias));
            *(GAS v2u*)(F.Y + (size_t)(row0 + tok) * YW + BW + g * 128 + ct * 16 + 4 * fq) = w; }
        __syncthreads();
    }
}

constexpr int PL_DP = 528;
template <int GI> __device__ __forceinline__ void pool_unit(Frame& F, int row0, int l) {
    int tid_ = F.ltid(); asm volatile("" : "+v"(tid_)); const int tid = tid_, lane = tid & 63, wid = __builtin_amdgcn_readfirstlane(F.ltid() >> 6);
    LAS unsigned char* dt = F.lds;
    const bf16* Z = F.Z;
    constexpr int W = 2 << GI, HW = W / 2, NR = 8 + W - 1;
    const int seqlen = row0 < MLAT ? SEQ : CTXL; const int s0 = row0 < MLAT ? (row0 & ~(SEQ - 1)) : MLAT + ((row0 - MLAT) & ~(CTXL - 1));
    const int fr = lane & 15, fq = lane >> 4;
    bf16x8 wa[8][2];
    { const bf16* wp = F.Wpool + ((size_t)l * 4 + GI) * 65536 + (size_t)(wid * 32 + fr) * 256 + fq * 8;
#pragma unroll
      for (int ks = 0; ks < 8; ++ks) { wa[ks][0] = *(const GAS bf16x8*)(wp + ks * 32); wa[ks][1] = *(const GAS bf16x8*)(wp + 16 * 256 + ks * 32); } }
    __syncthreads();
    { const int ch = tid & 31, tg = tid >> 5;
      const bf16* zc = Z + C_OFF + GI * 256 + ch * 8; const int p0 = row0 - s0 + tg * 8;
      v4u rw[NR];
#pragma unroll
      for (int k = 0; k < NR; ++k) { const int q = p0 - HW + k; const bool ok = (q >= 0) && (q < seqlen); const int qq = ok ? q : p0; const v4u a = *(const GAS v4u*)(zc + (size_t)(s0 + qq) * INW); rw[k] = ok ? a : (v4u){0u, 0u, 0u, 0u}; }
      float sum[8] = {0.f, 0.f, 0.f, 0.f, 0.f, 0.f, 0.f, 0.f};
#pragma unroll
      for (int k = 0; k < W; ++k) { const v4u a = rw[k]; sum[0] += bflo(a.x); sum[1] += bfhi(a.x); sum[2] += bflo(a.y); sum[3] += bfhi(a.y); sum[4] += bflo(a.z); sum[5] += bfhi(a.z); sum[6] += bflo(a.w); sum[7] += bfhi(a.w); }
#pragma unroll
      for (int i = 0; i < 8; ++i) { const int p = p0 + i; const int lo = p - HW < 0 ? 0 : p - HW; const int hi = p - HW + W > seqlen ? seqlen : p - HW + W; const float inv = 1.0f / (float)(hi - lo);
          const v4u zz = rw[i + HW];
          v4u o; o.x = pk2(sum[0] * inv - bflo(zz.x), sum[1] * inv - bfhi(zz.x)); o.y = pk2(sum[2] * inv - bflo(zz.y), sum[3] * inv - bfhi(zz.y));
          o.z = pk2(sum[4] * inv - bflo(zz.z), sum[5] * inv - bfhi(zz.z)); o.w = pk2(sum[6] * inv - bflo(zz.w), sum[7] * inv - bfhi(zz.w));
          *(LAS v4u*)(dt + (tg * 8 + i) * PL_DP + ch * 16) = o;
          if (i < 7) { const v4u a = rw[i + W], b = rw[i];
              sum[0] += bflo(a.x) - bflo(b.x); sum[1] += bfhi(a.x) - bfhi(b.x); sum[2] += bflo(a.y) - bflo(b.y); sum[3] += bfhi(a.y) - bfhi(b.y);
              sum[4] += bflo(a.z) - bflo(b.z); sum[5] += bfhi(a.z) - bfhi(b.z); sum[6] += bflo(a.w) - bflo(b.w); sum[7] += bfhi(a.w) - bfhi(b.w); } } }
    __syncthreads();
    { f32x4 acc[2][8];
#pragma unroll
      for (int a = 0; a < 2; ++a)
#pragma unroll
          for (int tt = 0; tt < 8; ++tt) acc[a][tt] = (f32x4){0.f, 0.f, 0.f, 0.f};
#pragma unroll
      for (int ks = 0; ks < 8; ++ks) {
#pragma unroll
          for (int tt = 0; tt < 8; ++tt) { const bf16x8 bfr = *(const LAS bf16x8*)(dt + (tt * 16 + fr) * PL_DP + (ks * 32 + fq * 8) * 2);
              acc[0][tt] = __builtin_amdgcn_mfma_f32_16x16x32_bf16(wa[ks][0], bfr, acc[0][tt], 0, 0, 0); acc[1][tt] = __builtin_amdgcn_mfma_f32_16x16x32_bf16(wa[ks][1], bfr, acc[1][tt], 0, 0, 0); } }
      const float* ps = F.pool_scale + (size_t)l * BW + GI * 256;
#pragma unroll
      for (int a = 0; a < 2; ++a) { const int dd = wid * 32 + a * 16 + 4 * fq; const f32x4 sc = *(const f32x4*)(ps + dd);
#pragma unroll
          for (int tt = 0; tt < 8; ++tt) { const f32x4 v = acc[a][tt] * sc; v2u wv; wv.x = cvtpk(v[0], v[1]); wv.y = cvtpk(v[2], v[3]);
              *(GAS v2u*)(F.Y + (size_t)(row0 + tt * 16 + fr) * YW + 2 * BW + GI * 256 + dd) = wv; } } }
}
__device__ __forceinline__ void pool_dispatch(Frame& F, int row0, int g, int l) {
    if (g == 0) pool_unit<0>(F, row0, l); else if (g == 1) pool_unit<1>(F, row0, l); else if (g == 2) pool_unit<2>(F, row0, l); else pool_unit<3>(F, row0, l);
}

#ifndef MIXM
#define MIXM 7
#endif
__device__ __forceinline__ void phase_mixers(Frame& F, int l, float lam_init) {
    const bool last = (l == DEPTH - 1);
    float d01 = 0.f, d23 = 0.f; const float* lq = F.lam_qk + (size_t)l * 256;
    for (int i = 0; i < 64; ++i) { d01 += lq[i] * lq[64 + i]; d23 += lq[128 + i] * lq[192 + i]; }
    const float lam = __expf(d01) - __expf(d23) + lam_init; const float oscale = 1.0f - lam_init;
    const float* subg = F.subln_g + (size_t)l * 128;
#ifndef REP_ATT
#define REP_ATT 1
#endif
#ifndef REP_GP
#define REP_GP 1
#endif
#pragma nounroll
    for (int i = 0; i < 5 * REP_ATT; ++i) { const int uid = F.vcu + F.G * (i % 5);
        if (!(MIXM & 1)) continue;
        if (uid < 1024) attn_unit(F, uid >> 8, (uid >> 5) & 7, uid & 31, false, lam, oscale, subg);
        else if (!last && uid < 1088) attn_unit(F, (uid - 1024) >> 4, ((uid - 1024) >> 1) & 7, uid & 1, true, lam, oscale, subg);
        if (TAILWORK == 2 && !last && i == (F.vcu & 3)) { __syncthreads(); const int gw_ = F.vcu * NWAVES + __builtin_amdgcn_readfirstlane(F.ltid() >> 6); ada_partial_layer(F, l + 1, gw_, F.G * NWAVES); cvt_layer(F, l + 1, gw_, F.G * NWAVES); } }
    const int nchunk = last ? MLAT / 128 : MTOT / 128;
#pragma nounroll
    for (int rgp = 0; rgp < REP_GP; ++rgp) {
    if (MIXM & 2) for (int cidx = F.G - 1 - F.vcu; cidx < nchunk; cidx += F.G) gmlp_unit(F, cidx * 128, l);
    if (MIXM & 4) { const int nfree = F.G - nchunk, npool = nchunk * 4;
        if (nfree > 0 && F.G == 256) {
            if (F.vcu < nfree) { for (int k = 0; k < 4; ++k) { const int u = F.vcu * 4 + k; if (u < npool) pool_dispatch(F, (u >> 2) * 128, u & 3, l); } }
            else { for (int u = nfree * 4 + (F.vcu - nfree); u < npool; u += nchunk) pool_dispatch(F, (u >> 2) * 128, u & 3, l); }
        } else { for (int u = F.vcu; u < npool; u += F.G) pool_dispatch(F, (u >> 2) * 128, u & 3, l); } }
    }
    __syncthreads();
}

#ifndef SP2_BIG
#define SP2_BIG true
#endif
#ifndef ALIGN_BIG
#define ALIGN_BIG true
#endif
#ifndef STAGGER
#define STAGGER 0
#endif
__device__ __forceinline__ void phase_stagger(int slot) { if (STAGGER) for (int i = 0; i < slot * 3; ++i) __builtin_amdgcn_s_sleep(8); }
#ifndef MK_ONE_LAUNCH
#define MK_ONE_LAUNCH 1
#endif
constexpr int NPHASE = 3 + 8 * DEPTH;
struct Args { const float* in[23]; float* out; unsigned char* ws; int ph_lo, ph_hi; float lam_init[4]; };
__global__ void __launch_bounds__(NWAVES * 64, 2) fwd(Args args) {
    extern __shared__ __attribute__((aligned(16))) unsigned char lds[];
    Frame F;
    F.lds = (LAS unsigned char*)lds;
    F.MISC = (volatile LAS unsigned*)(F.lds + MISC_OFF);
    F.G = gridDim.x; { const int bx = blockIdx.x; F.bx = bx; F.vcu = (F.G % 8 == 0) ? (bx % 8) * (F.G / 8) + bx / 8 : bx; }
    unsigned char* ws = args.ws;
    F.ctl = (gu32*)(ws + WS_CTL);
    frame_ptrs(F);
    for (int u = F.ltid(); u < (LDS_BYTES - LDSCTL_OFF) / 4; u += NWAVES * 64) ((LAS unsigned*)(F.lds + LDSCTL_OFF))[u] = 0u;
    __syncthreads();
#if MK_ONE_LAUNCH
    constexpr int lo = 0, hi = NPHASE; constexpr bool use_bar = true;
#else
    const int lo = args.ph_lo, hi = args.ph_hi;
    const bool use_bar = (hi - lo) > 1;
#endif
    XcdBarrier bar; bar.bar = (unsigned*)(F.ctl + CW_BAR); bar.x = 0; bar.st = nullptr;
    if (use_bar) bar = xcd_barrier_post((unsigned*)(F.ctl + CW_BAR), F.MISC + 8);
#ifndef PHM
#define PHM 0xFFFF
#endif
#define IN(k) (lo <= (k) && (k) < hi)
#define KIND(b) ((PHM >> (b)) & 1)
#ifndef REP_MASK
#define REP_MASK 0
#endif
#define NREP(b) (((REP_MASK >> (b)) & 1) ? 2 : 1)
#define BARRIER() do { XcdBarrier b_ = bar; asm volatile("" : "+s"(b_.x)); xcd_barrier(b_); } while (0)
#ifndef DRY_EPI
#define DRY_EPI 0
#endif
#ifndef BAR_REP
#define BAR_REP 1
#endif
#define SEAM(k) do { if (IN(k) && IN((k) + 1)) { for (int br_ = 0; br_ < BAR_REP; ++br_) BARRIER(); } } while (0)

    if (KIND(0) && IN(0)) { for (int rep = 0; rep < NREP(0); ++rep) { frame_ptrs(F); phase_a1(F); if (rep + 1 < NREP(0)) BARRIER(); } } SEAM(0);
    if (KIND(1) && IN(1)) { frame_ptrs(F); phase_a2(F); } SEAM(1);
    if (KIND(2) && IN(2)) { frame_ptrs(F); phase_a3(F); } SEAM(2);

#pragma nounroll
    for (int l = 0; l < DEPTH; ++l) {
        const int pb = 3 + 8 * l; const bool last = (l == DEPTH - 1);
        { int g_ = F.G, v_ = F.vcu, b_ = F.bx; asm volatile("" : "+s"(g_), "+s"(v_), "+s"(b_)); F.G = g_; F.vcu = v_; F.bx = b_; }
        const int Mrows = last ? MLAT : MTOT;
        if (KIND(3) && IN(pb + 0)) for (int rep = 0; rep < NREP(3); ++rep) { if (rep) BARRIER(); frame_ptrs(F);
            pg8::Gemm g{F.HA, F.Win + (size_t)l * INW * D, MTOT, INW, D, D, D}; pg8::StaticOrder S; S.init(MTOT, INW, F.G, F.bx);
            pg8::EpiInProj E{F.Z, F.rope, QSCALE, INW, MLAT, F.KB, F.VB, (rep && DRY_EPI) ? 1 : 0};
            phase_stagger((F.bx >> 3) & 7);
            pg8::gemm_phase<pg8::EpiInProj, pg8::StaticOrder, ALIGN_BIG, SP2_BIG>(F.lds + RING_OFF, g, S, E);
        }
        SEAM(pb + 0);
        if (KIND(4) && IN(pb + 1)) for (int rep = 0; rep < NREP(4); ++rep) { if (rep) BARRIER(); frame_ptrs(F); phase_mixers(F, l, args.lam_init[l]); }
        SEAM(pb + 1);
        if (KIND(5) && IN(pb + 2)) for (int rep = 0; rep < NREP(5); ++rep) { if (rep) BARRIER(); frame_ptrs(F);
            pg8::Gemm g{F.Y, F.Wbr + (size_t)l * D * YW, Mrows, D, YW, YW, YW}; pg8::StaticOrder S; S.init(Mrows, D, F.G, F.bx);
            pg8::EpiGate E{F.Z + G_OFF, INW, F.MG, D};
            pg8::gemm_phase<pg8::EpiGate, pg8::StaticOrder, true, true>(F.lds + RING_OFF, g, S, E);
        }
        SEAM(pb + 2);
        if (KIND(6) && IN(pb + 3)) for (int rep = 0; rep < NREP(6); ++rep) { if (rep) BARRIER(); frame_ptrs(F);
            void* tw = rep ? (void*)(F.Z + (size_t)134 * MiB) : (void*)F.Y;
            { pg8::Gemm g{F.MG, F.Wout + (size_t)l * D * D, MLAT, D, D, D, D}; pg8::StaticOrder S; S.init(MLAT, D, F.G, F.bx);
              pg8::EpiResidT<false> E{F.mods + (size_t)l * 5 * INW + 2 * D, INW, tw, D, 1, MLAT};
              pg8::gemm_phase<pg8::EpiResidT<false>, pg8::StaticOrder, true, true>(F.lds + RING_OFF, g, S, E); }
            if (!last) { pg8::Gemm g{F.MG, F.Wout + (size_t)l * D * D, MTOT, D, 256, D, D}; pg8::SplitOrder S; S.init(MLAT / 256, 32, 8, 256, F.G, F.bx);
              pg8::EpiResidT<true> E{F.mods + (size_t)l * 5 * INW + 2 * D, INW, rep ? (void*)(F.Z + (size_t)170 * MiB) : (void*)(F.Z + (size_t)100 * MiB), D, 256, MLAT};
              pg8::gemm_phase<pg8::EpiResidT<true>, pg8::SplitOrder, true, true>(F.lds + RING_OFF, g, S, E); }
            if (TAILWORK == 1 && !last && F.bx >= 32 && rep == 0) ada_partial_layer(F, l + 1, (F.bx - 32) * NWAVES + __builtin_amdgcn_readfirstlane(F.ltid() >> 6), (F.G - 32) * NWAVES);
        }
        SEAM(pb + 3);
        if (KIND(7) && IN(pb + 4)) { frame_ptrs(F); if (NREP(7) > 1) { phase_ln(F, F.ln1_g + (size_t)l * D, F.ln1_b + (size_t)l * D, Mrows, false, true, l, 3 * D, last ? 0 : 8, true); BARRIER(); frame_ptrs(F); }
            phase_ln(F, F.ln1_g + (size_t)l * D, F.ln1_b + (size_t)l * D, Mrows, false, true, l, 3 * D, last ? 0 : 8); if (TAILWORK && !last) mods_reduce_layer(F, l + 1); }
        SEAM(pb + 4);
        if (KIND(8) && IN(pb + 5)) for (int rep = 0; rep < NREP(8); ++rep) { if (rep) BARRIER(); frame_ptrs(F);
            pg8::Gemm g{F.HA, F.Wgu + (size_t)l * 2 * FFH * D, Mrows, 2 * FFH, D, D, D}; pg8::StaticOrder S; S.init(Mrows, 2 * FFH, F.G, F.bx);
            pg8::EpiSwiglu E{F.Z, FFH};
            phase_stagger((F.bx >> 3) & 7);
            pg8::gemm_phase<pg8::EpiSwiglu, pg8::StaticOrder, ALIGN_BIG, SP2_BIG>(F.lds + RING_OFF, g, S, E);
        }
        SEAM(pb + 5);
        if (KIND(9) && IN(pb + 6)) for (int rep = 0; rep < NREP(9); ++rep) { if (rep) BARRIER(); frame_ptrs(F);
            void* tw = rep ? (void*)(F.Z + (size_t)134 * MiB) : (void*)F.Y;
            { pg8::Gemm g{F.Z, F.Wdn + (size_t)l * D * FFH, MLAT, D, FFH, FFH, FFH}; pg8::StaticOrder S; S.init(MLAT, D, F.G, F.bx);
              pg8::EpiResidT<false> E{F.mods + (size_t)l * 5 * INW + 5 * D, INW, tw, D, 1, MLAT};
              pg8::gemm_phase<pg8::EpiResidT<false>, pg8::StaticOrder, true, true>(F.lds + RING_OFF, g, S, E); }
            if (!last) { pg8::Gemm g{F.Z, F.Wdn + (size_t)l * D * FFH, MTOT, D, FFH / 4, FFH, FFH}; pg8::SplitOrder S; S.init(MLAT / 256, 32, 4, FFH / 4, F.G, F.bx);
              pg8::EpiResidT<true> E{F.mods + (size_t)l * 5 * INW + 5 * D, INW, rep ? (void*)(F.Z + (size_t)170 * MiB) : (void*)(F.Z + (size_t)100 * MiB), D, FFH / 4, MLAT};
              pg8::gemm_phase<pg8::EpiResidT<true>, pg8::SplitOrder, true, true>(F.lds + RING_OFF, g, S, E); }
            if (TAILWORK == 1 && !last && F.bx >= 32 && rep == 0) { __syncthreads(); cvt_layer(F, l + 1, (F.bx - 32) * NWAVES + __builtin_amdgcn_readfirstlane(F.ltid() >> 6), (F.G - 32) * NWAVES); }
        }
        SEAM(pb + 6);
        if (KIND(7) && IN(pb + 7)) { frame_ptrs(F); phase_ln(F, F.ln2_g + (size_t)l * D, F.ln2_b + (size_t)l * D, Mrows, last, !last, last ? l : l + 1, 0, last ? 0 : 4); }
        if (!last) SEAM(pb + 7);
    }
#undef IN
#undef SEAM
}

extern "C" void kernel_launch(void* const* d_in, const int* in_sizes, int n_in, void* d_out, int out_size, void* d_ws, size_t ws_size, hipStream_t stream) {
    static int grid = 0;
    if (grid == 0) {
        if (n_in != 23 || in_sizes[0] != MLAT * D || out_size != MLAT * D || ws_size < WS_END) {
            fprintf(stderr, "kernel_launch: unexpected shapes / workspace (n_in %d, in0 %d, out %d, ws %zu, need %zu); nothing launched\n", n_in, n_in > 0 ? in_sizes[0] : -1, out_size, ws_size, (size_t)WS_END); grid = -1; return; }
        int dev = 0, cus = 0, per_cu = 0;
        if (hipGetDevice(&dev) != hipSuccess || hipDeviceGetAttribute(&cus, hipDeviceAttributeMultiprocessorCount, dev) != hipSuccess) { grid = -1; return; }
        if (hipFuncSetAttribute((const void*)fwd, hipFuncAttributeMaxDynamicSharedMemorySize, LDS_BYTES) != hipSuccess) { fprintf(stderr, "kernel_launch: hipFuncSetAttribute failed\n"); grid = -1; return; }
        if (hipOccupancyMaxActiveBlocksPerMultiprocessor(&per_cu, (const void*)fwd, NWAVES * 64, LDS_BYTES) != hipSuccess || per_cu < 1) fprintf(stderr, "kernel_launch: occupancy query reports %d\n", per_cu);
        (void)hipGetLastError();
        grid = cus;
    }
    if (grid < 0) return;
    if (hipMemsetAsync((char*)d_ws + WS_CTL, 0, CTL_ZERO_BYTES, stream) != hipSuccess) return;
    Args a{};
    for (int i = 0; i < 23; ++i) a.in[i] = (const float*)d_in[i];
    a.out = (float*)d_out; a.ws = (unsigned char*)d_ws;
    for (int l = 0; l < DEPTH; ++l) a.lam_init[l] = (float)(0.8 - 0.6 * exp(-0.3 * (double)l));
#if MK_ONE_LAUNCH
    a.ph_lo = 0; a.ph_hi = NPHASE;
    hipLaunchKernelGGL(fwd, dim3(grid), dim3(NWAVES * 64), LDS_BYTES, stream, a);
#else
    for (int p = 0; p < NPHASE; ++p) { a.ph_lo = p; a.ph_hi = p + 1; hipLaunchKernelGGL(fwd, dim3(grid), dim3(NWAVES * 64), LDS_BYTES, stream, a); }
#endif
}
```

```cpp
#include <hip/hip_runtime.h>
#include <cstdio>
#include <cstdint>
#include <cmath>
namespace pg8 {
#define PG8_LAS __attribute__((address_space(3)))
typedef unsigned short bf16_t;
typedef short bf16x8 __attribute__((ext_vector_type(8)));
typedef float f32x4 __attribute__((ext_vector_type(4)));
typedef unsigned u32x4 __attribute__((ext_vector_type(4)));
constexpr int BM = 256, BK = 64, HALF = 128, HTB = HALF * BK * 2  , STAGE_BYTES = 8 * HTB, NXCD = 8, WGM = 4;

__host__ __device__ __forceinline__ int lds_byte(int r, int c) { const int st = (r >> 4) * 2 + (c >> 5), rr = r & 15, cc = c & 31, ob = rr * 64 + cc * 2; return st * 1024 + (ob ^ (((ob >> 9) & 1) << 5)); }
__host__ __device__ __forceinline__ void stage_rc(int b, int& R, int& C) { const int st = b / 1024, sb = b % 1024, swz = sb ^ (((sb >> 9) & 1) << 5); R = (st >> 1) * 16 + swz / 64; C = (st & 1) * 32 + (swz % 64) / 2; }
__host__ __device__ __forceinline__ int perm32(int rho) { const int n = rho >> 4, i = rho & 15; return 8 * (i >> 2) + 4 * n + (i & 3); }

struct Unit { int pm, pn, ka; };
struct Gemm { const bf16_t* A; const bf16_t* Bt; int M, N, K, lda, ldb; };

struct StaticOrder {
    int nM, nN, nwg, G, c, wgm;
    __host__ __device__ void init(int M, int N, int G_, int c_, int wgm_ = WGM) { nM = M / BM; nN = N / BM; nwg = nM * nN; G = G_; c = c_; wgm = wgm_; }
    __host__ __device__ bool next(int i, Unit& u) const {
        const long L = (long)i * G + c; if (L >= nwg) return false;
        int wgid = (int)L; { const int q = nwg / NXCD, r = nwg % NXCD, xcd = wgid % NXCD, off = wgid / NXCD; wgid = (xcd < r ? xcd * (q + 1) : r * (q + 1) + (xcd - r) * q) + off; }
        const int nig = wgm * nN, gid = wgid / nig, fm = gid * wgm, gsz = (nM - fm) < wgm ? (nM - fm) : wgm;
        u.pm = fm + ((wgid % nig) % gsz); u.pn = (wgid % nig) / gsz; u.ka = 0; return true;
    }
    __device__ __forceinline__ void a_ready(const Unit&) const {}
    __device__ __forceinline__ void done(const Unit&) const {}
};

struct SplitOrder {
    int nsplit, klen, G, c, pm0, ntile;
    __host__ __device__ void init(int pm0_, int ntile_, int nsplit_, int klen_, int G_, int c_) { pm0 = pm0_; ntile = ntile_; nsplit = nsplit_; klen = klen_; G = G_; c = c_; }
    __host__ __device__ bool next(int i, Unit& u) const { const int L = i * G + c; if (L >= ntile * nsplit) return false; const int tt = L / nsplit; u.pm = pm0 + (tt & 3); u.pn = tt >> 2; u.ka = (L - tt * nsplit) * klen; return true; }
    __device__ __forceinline__ void a_ready(const Unit&) const {}
    __device__ __forceinline__ void done(const Unit&) const {}
};
__device__ __forceinline__ unsigned cvt_pk_bf16(float lo, float hi) { unsigned r; asm volatile("v_cvt_pk_bf16_f32 %0, %1, %2" : "=v"(r) : "v"(lo), "v"(hi)); return r; }
typedef float f32x2 __attribute__((ext_vector_type(2)));
__device__ __forceinline__ f32x2 gelu_pk(f32x2 v) {
    const f32x2 av = __builtin_elementwise_abs(v), d = av * 0.2316418882f + 1.0f;
    f32x2 t; t.x = __builtin_amdgcn_rcpf(d.x); t.y = __builtin_amdgcn_rcpf(d.y);
    f32x2 q = t * 0.5307027145f + (-0.7265760135f); q = q * t + 0.7107068705f; q = q * t + (-0.142248368f); q = q * t + 0.127414796f; q = q * t;
    const f32x2 s = (v * v) * (-0.72134752044f);
    f32x2 e; e.x = __builtin_amdgcn_exp2f(s.x); e.y = __builtin_amdgcn_exp2f(s.y);
    const f32x2 m = v * (q * e), r = v - m;
    f32x2 o; o.x = v.x < 0.f ? m.x : r.x; o.y = v.y < 0.f ? m.y : r.y; return o;
}

#ifndef GATE_NT
#define GATE_NT 0
#endif
#if GATE_NT
#define GATE_LD(p) __builtin_nontemporal_load(p)
#else
#define GATE_LD(p) (*(p))
#endif
#ifndef EPI_NT
#define EPI_NT 0
#endif
typedef unsigned u32x2 __attribute__((ext_vector_type(2)));
__device__ __forceinline__ float bf_lo(unsigned w) { return __uint_as_float(w << 16); }
__device__ __forceinline__ float bf_hi(unsigned w) { return __uint_as_float(w & 0xffff0000u); }
__device__ __forceinline__ void store8_bf16(bf16_t* p, const f32x4 v0, const f32x4 v1) {
    u32x4 w; w.x = cvt_pk_bf16(v0[0], v0[1]); w.y = cvt_pk_bf16(v0[2], v0[3]); w.z = cvt_pk_bf16(v1[0], v1[1]); w.w = cvt_pk_bf16(v1[2], v1[3]);
#if EPI_NT
    __builtin_nontemporal_store(w, (u32x4*)p);
#else
    *(u32x4*)p = w;
#endif
}
__device__ __forceinline__ float sigmoid_f(float x) { return __builtin_amdgcn_rcpf(1.0f + __builtin_amdgcn_exp2f(x * -1.4426950408889634f)); }

struct EpiInProj {
    static constexpr bool PERM = true, AFTER_DRAIN = false; static constexpr int KSEG = 0;
    bf16_t* Z; const float* rope; float qscale; int ldc; int nlat; bf16_t* Kb; bf16_t* Vb; int dry;
    __device__ __forceinline__ void kseg(f32x4 (&)[2][2][4][2], const Unit&, int, int, int, int, int) const {}
    __device__ __forceinline__ void operator()(const f32x4 (&acc)[2][2][4][2], const Unit& u, int wr, int wc, int fr, int fq) const {
        const int pn = u.pn; const int row0 = u.pm * BM + wr * 64 + fr; const int col0 = pn * BM + wc * 32 + 8 * fq;
        if (dry) { float s_ = 0.f;
#pragma unroll
            for (int a_ = 0; a_ < 2; ++a_)
#pragma unroll
                for (int b_ = 0; b_ < 2; ++b_)
#pragma unroll
                    for (int m_ = 0; m_ < 4; ++m_)
#pragma unroll
                        for (int n_ = 0; n_ < 2; ++n_) s_ += acc[a_][b_][m_][n_][0];
            if (s_ != s_) Z[0] = 0; return; }
        if (pn < 8) {
            const float sc = pn < 4 ? qscale : 1.0f;
#pragma unroll
            for (int ai = 0; ai < 2; ++ai)
#pragma unroll
                for (int m = 0; m < 4; ++m) {
                    const int row = row0 + ai * HALF + m * 16; const int t = row & 4095; const int pos = (wc & 1) ? (t & 63) : (t >> 6);
                    f32x4 cs0 = *(const f32x4*)(rope + (pos * 16 + 4 * fq) * 2), cs1 = *(const f32x4*)(rope + (pos * 16 + 4 * fq) * 2 + 4);
                    if (row >= nlat) { cs0 = (f32x4){1.f, 0.f, 1.f, 0.f}; cs1 = cs0; }
                    bf16_t* rowp = Z + (size_t)row * ldc + col0;
                    if (pn >= 4) { const int bb = row < nlat ? (row >> 12) : ((row - nlat) >> 8), key = row < nlat ? 256 + (row & 4095) : ((row - nlat) & 255);
                        rowp = Kb + ((size_t)(bb * 8 + 2 * (pn - 4)) * 4352 + key) * 128 + wc * 32 + 8 * fq; }
#pragma unroll
                    for (int bj = 0; bj < 2; ++bj) {
                        const f32x4 a = acc[ai][bj][m][0], b = acc[ai][bj][m][1];
                        f32x4 o0, o1;
                        o0[0] = (a[0] * cs0[0] - a[1] * cs0[1]) * sc; o0[1] = (a[0] * cs0[1] + a[1] * cs0[0]) * sc;
                        o0[2] = (a[2] * cs0[2] - a[3] * cs0[3]) * sc; o0[3] = (a[2] * cs0[3] + a[3] * cs0[2]) * sc;
                        o1[0] = (b[0] * cs1[0] - b[1] * cs1[1]) * sc; o1[1] = (b[0] * cs1[1] + b[1] * cs1[0]) * sc;
                        o1[2] = (b[2] * cs1[2] - b[3] * cs1[3]) * sc; o1[3] = (b[2] * cs1[3] + b[3] * cs1[2]) * sc;
                        store8_bf16(rowp + (pn >= 4 ? (size_t)bj * 4352 * 128 : (size_t)bj * HALF), o0, o1);
                    }
                }
        } else if (pn < 12) {
#pragma unroll
            for (int ai = 0; ai < 2; ++ai)
#pragma unroll
                for (int m = 0; m < 4; ++m) { const int row = row0 + ai * HALF + m * 16; const int bb = row < nlat ? (row >> 12) : ((row - nlat) >> 8), key = row < nlat ? 256 + (row & 4095) : ((row - nlat) & 255);
                    bf16_t* rowp = Vb + ((size_t)(bb * 8 + 2 * (pn - 8)) * 4352 + key) * 128 + wc * 32 + 8 * fq;
#pragma unroll
                    for (int bj = 0; bj < 2; ++bj) store8_bf16(rowp + (size_t)bj * 4352 * 128, acc[ai][bj][m][0], acc[ai][bj][m][1]); }
        } else if (pn >= 20 && pn < 24) {
#pragma unroll
            for (int ai = 0; ai < 2; ++ai)
#pragma unroll
                for (int m = 0; m < 4; ++m) { bf16_t* rowp = Z + (size_t)(row0 + ai * HALF + m * 16) * ldc + col0;
#pragma unroll
                    for (int bj = 0; bj < 2; ++bj) store8_bf16(rowp + bj * HALF, acc[ai][bj][m][0], acc[ai][bj][m][1]); }
        } else if (pn < 20) {
#pragma unroll
            for (int ai = 0; ai < 2; ++ai)
#pragma unroll
                for (int m = 0; m < 4; ++m) { bf16_t* rowp = Z + (size_t)(row0 + ai * HALF + m * 16) * ldc + col0;
#pragma unroll
                    for (int bj = 0; bj < 2; ++bj) { const f32x4 v0 = acc[ai][bj][m][0], v1 = acc[ai][bj][m][1];
                        const f32x2 a = gelu_pk((f32x2){v0[0], v0[1]}), b = gelu_pk((f32x2){v0[2], v0[3]}), c = gelu_pk((f32x2){v1[0], v1[1]}), d = gelu_pk((f32x2){v1[2], v1[3]});
                        store8_bf16(rowp + bj * HALF, (f32x4){a.x, a.y, b.x, b.y}, (f32x4){c.x, c.y, d.x, d.y}); } }
        } else {
#pragma unroll
            for (int ai = 0; ai < 2; ++ai)
#pragma unroll
                for (int m = 0; m < 4; ++m) { bf16_t* rowp = Z + (size_t)(row0 + ai * HALF + m * 16) * ldc + col0;
#pragma unroll
                    for (int bj = 0; bj < 2; ++bj) { const f32x4 v0 = acc[ai][bj][m][0], v1 = acc[ai][bj][m][1]; f32x4 o0, o1;
#pragma unroll
                        for (int i = 0; i < 4; ++i) { o0[i] = __builtin_fmaxf(sigmoid_f(v0[i]), 1e-12f); o1[i] = __builtin_fmaxf(sigmoid_f(v1[i]), 1e-12f); }
                        store8_bf16(rowp + bj * HALF, o0, o1); } }
        }
    }
};

struct EpiGate {
    static constexpr bool PERM = true, AFTER_DRAIN = false; static constexpr int KSEG = 16;
    const bf16_t* G; int ldg; bf16_t* O; int ldo;
    __device__ __forceinline__ void kseg(f32x4 (&acc)[2][2][4][2], const Unit& u, int seg, int wr, int wc, int fr, int fq) const {
        const int row0 = u.pm * BM + wr * 64 + fr; const int col0 = u.pn * BM + wc * 32 + 8 * fq;
#pragma unroll
        for (int ai = 0; ai < 2; ++ai) {
            u32x4 ga[4][2], gb[4][2];
#pragma unroll
            for (int m = 0; m < 4; ++m) { const bf16_t* gp = G + (size_t)(row0 + ai * HALF + m * 16) * ldg + (seg - 1) * 2048 + col0;
#pragma unroll
                for (int bj = 0; bj < 2; ++bj) { ga[m][bj] = GATE_LD((const u32x4*)(gp + bj * HALF)); gb[m][bj] = GATE_LD((const u32x4*)(gp + 2048 + bj * HALF)); } }
#pragma unroll
            for (int m = 0; m < 4; ++m)
#pragma unroll
                for (int bj = 0; bj < 2; ++bj) { const u32x4 a = ga[m][bj], b = gb[m][bj];
                    f32x4 r0, r1;
                    r0[0] = bf_lo(a.x) * __builtin_amdgcn_rcpf(bf_lo(b.x)); r0[1] = bf_hi(a.x) * __builtin_amdgcn_rcpf(bf_hi(b.x));
                    r0[2] = bf_lo(a.y) * __builtin_amdgcn_rcpf(bf_lo(b.y)); r0[3] = bf_hi(a.y) * __builtin_amdgcn_rcpf(bf_hi(b.y));
                    r1[0] = bf_lo(a.z) * __builtin_amdgcn_rcpf(bf_lo(b.z)); r1[1] = bf_hi(a.z) * __builtin_amdgcn_rcpf(bf_hi(b.z));
                    r1[2] = bf_lo(a.w) * __builtin_amdgcn_rcpf(bf_lo(b.w)); r1[3] = bf_hi(a.w) * __builtin_amdgcn_rcpf(bf_hi(b.w));
                    acc[ai][bj][m][0] *= r0; acc[ai][bj][m][1] *= r1; }
            asm volatile("" ::: "memory"); }
    }
    __device__ __forceinline__ void operator()(const f32x4 (&acc)[2][2][4][2], const Unit& u, int wr, int wc, int fr, int fq) const {
        const int row0 = u.pm * BM + wr * 64 + fr; const int col0 = u.pn * BM + wc * 32 + 8 * fq;
        u32x4 gg[2][4][2];
#pragma unroll
        for (int ai = 0; ai < 2; ++ai)
#pragma unroll
            for (int m = 0; m < 4; ++m) { const bf16_t* gp = G + (size_t)(row0 + ai * HALF + m * 16) * ldg + 2 * 2048 + col0;
#pragma unroll
                for (int bj = 0; bj < 2; ++bj) gg[ai][m][bj] = GATE_LD((const u32x4*)(gp + bj * HALF)); }
#pragma unroll
        for (int ai = 0; ai < 2; ++ai)
#pragma unroll
            for (int m = 0; m < 4; ++m) { bf16_t* op = O + (size_t)(row0 + ai * HALF + m * 16) * ldo + col0;
#pragma unroll
                for (int bj = 0; bj < 2; ++bj) { const u32x4 g = gg[ai][m][bj];
                    const f32x4 g0 = (f32x4){bf_lo(g.x), bf_hi(g.x), bf_lo(g.y), bf_hi(g.y)}, g1 = (f32x4){bf_lo(g.z), bf_hi(g.z), bf_lo(g.w), bf_hi(g.w)};
                    store8_bf16(op + bj * HALF, acc[ai][bj][m][0] * g0, acc[ai][bj][m][1] * g1); } }
    }
};

template <bool SLAB> struct EpiResidT {
    static constexpr bool PERM = !SLAB, AFTER_DRAIN = false; static constexpr int KSEG = 0;
    const float* gv; int gstride; void* Tw; int ldc; int klen, nlat;
    __device__ __forceinline__ void kseg(f32x4 (&)[2][2][4][2], const Unit&, int, int, int, int, int) const {}
    __device__ __forceinline__ void operator()(const f32x4 (&acc)[2][2][4][2], const Unit& u, int wr, int wc, int fr, int fq) const {
        const int row0 = u.pm * BM + wr * 64 + fr; const int grp = u.pm < 64 ? (u.pm >> 4) : 4;
        if constexpr (SLAB) {
            const int col0 = u.pn * BM + wc * 32 + 4 * fq;
            f32x4 g[2][2];
#pragma unroll
            for (int bj = 0; bj < 2; ++bj)
#pragma unroll
                for (int n = 0; n < 2; ++n) g[bj][n] = *(const f32x4*)(gv + (size_t)grp * gstride + col0 + bj * HALF + n * 16);
#pragma unroll
            for (int ai = 0; ai < 2; ++ai)
#pragma unroll
                for (int m = 0; m < 4; ++m) { float* pp = (float*)Tw + ((size_t)(u.ka / klen) * 1024 + (size_t)(row0 + ai * HALF + m * 16 - nlat)) * ldc + col0;
#pragma unroll
                    for (int bj = 0; bj < 2; ++bj)
#pragma unroll
                        for (int n = 0; n < 2; ++n) *(f32x4*)(pp + bj * HALF + n * 16) = g[bj][n] * acc[ai][bj][m][n]; }
        } else {
            const int col0 = u.pn * BM + wc * 32 + 8 * fq;
            f32x4 g[2][2];
#pragma unroll
            for (int bj = 0; bj < 2; ++bj)
#pragma unroll
                for (int n = 0; n < 2; ++n) g[bj][n] = *(const f32x4*)(gv + (size_t)grp * gstride + col0 + bj * HALF + n * 4);
#pragma unroll
            for (int ai = 0; ai < 2; ++ai)
#pragma unroll
                for (int m = 0; m < 4; ++m) { bf16_t* tp = (bf16_t*)Tw + (size_t)(row0 + ai * HALF + m * 16) * ldc + col0;
#pragma unroll
                    for (int bj = 0; bj < 2; ++bj) store8_bf16(tp + bj * HALF, g[bj][0] * acc[ai][bj][m][0], g[bj][1] * acc[ai][bj][m][1]); }
        }
    }
};

struct EpiSwiglu {
    static constexpr bool PERM = true, AFTER_DRAIN = false; static constexpr int KSEG = 0;
    bf16_t* H; int ldc;
    __device__ __forceinline__ void kseg(f32x4 (&)[2][2][4][2], const Unit&, int, int, int, int, int) const {}
    __device__ __forceinline__ void operator()(const f32x4 (&acc)[2][2][4][2], const Unit& u, int wr, int wc, int fr, int fq) const {
        const int row0 = u.pm * BM + wr * 64 + fr, col0 = u.pn * HALF + wc * 32 + 8 * fq;
#pragma unroll
        for (int ai = 0; ai < 2; ++ai)
#pragma unroll
            for (int m = 0; m < 4; ++m) { bf16_t* rowp = H + (size_t)(row0 + ai * HALF + m * 16) * ldc + col0; f32x4 o[2];
#pragma unroll
                for (int n = 0; n < 2; ++n) { const f32x4 gt = acc[ai][0][m][n], up = acc[ai][1][m][n];
#pragma unroll
                    for (int i = 0; i < 4; ++i) o[n][i] = gt[i] * sigmoid_f(gt[i]) * up[i]; }
                store8_bf16(rowp, o[0], o[1]); }
    }
};
template <class Epi, class Sched, bool ALIGN_EPI = false, bool SP2 = false>
__device__ __forceinline__ void gemm_phase(PG8_LAS unsigned char* lds, const Gemm g, const Sched& S, const Epi& E) {
    int tid_ = threadIdx.x; asm volatile("" : "+v"(tid_));
    const int tid = tid_, wid = __builtin_amdgcn_readfirstlane(tid >> 6), lane = tid & 63, wr = wid >> 2, wc = wid & 3, fr = lane & 15, fq = lane >> 4;
    const int K = g.K, nt = K / BK;
    unsigned voffA[2], voffB[2];
#pragma unroll
    for (int i = 0; i < 2; ++i) { int R, C; stage_rc(tid * 16 + i * 8192, R, C); const int Rb = Epi::PERM ? ((R & ~31) + perm32(R & 31)) : R;
        voffA[i] = (unsigned)(R * g.lda + C) * 2u; voffB[i] = (unsigned)(Rb * g.ldb + C) * 2u; }
    const size_t kstep = (size_t)(BK * 2);
    const size_t hstepA = (size_t)HALF * g.lda * 2, hstepB = (size_t)HALF * g.ldb * 2;
    const size_t tstepA = 2 * hstepA, tstepB = 2 * hstepB;
    const unsigned ldsw = (unsigned)wid * 1024u;
    const int aoff = lds_byte(wr * 64 + fr, fq * 8), boff = lds_byte(wc * 32 + fr, fq * 8);
#define PG8_SA(b, h) (((b) * 2 + (h)) * HTB)
#define PG8_SB(b, h) ((4 + (b) * 2 + (h)) * HTB)
#define PG8_STAGE(bufoff, gbase, voff) do { _Pragma("unroll") for (int _i = 0; _i < 2; ++_i) \
        __builtin_amdgcn_global_load_lds((const unsigned*)((const char*)(gbase) + (voff)[_i]), (PG8_LAS unsigned*)(lds + (bufoff) + ldsw + _i * 8192), 16, 0, 0); } while (0)
#define PG8_LDA(dst, b, h) do { _Pragma("unroll") for (int m = 0; m < 4; ++m) _Pragma("unroll") for (int k = 0; k < 2; ++k) dst[m][k] = *(const PG8_LAS bf16x8*)(lds + PG8_SA(b, h) + aoff + m * 2048 + k * 1024); } while (0)
#define PG8_LDB(dst, b, h) do { _Pragma("unroll") for (int n = 0; n < 2; ++n) _Pragma("unroll") for (int k = 0; k < 2; ++k) dst[n][k] = *(const PG8_LAS bf16x8*)(lds + PG8_SB(b, h) + boff + n * 2048 + k * 1024); } while (0)
#define PG8_MMA(ai, bj, At, Bt) do { __builtin_amdgcn_s_setprio(1); _Pragma("unroll") for (int m = 0; m < 4; ++m) _Pragma("unroll") for (int n = 0; n < 2; ++n) _Pragma("unroll") for (int k = 0; k < 2; ++k) \
        acc[ai][bj][m][n] = __builtin_amdgcn_mfma_f32_16x16x32_bf16(Bt[n][k], At[m][k], acc[ai][bj][m][n], 0, 0, 0); __builtin_amdgcn_s_setprio(0); } while (0)
#define PG8_WAIT_V(n) asm volatile("s_waitcnt vmcnt(" #n ")" ::: "memory")
#define PG8_WAIT_L(n) asm volatile("s_waitcnt lgkmcnt(" #n ")" ::: "memory")
#define PG8_BAR __builtin_amdgcn_s_barrier()
#define PG8_SCHED __builtin_amdgcn_sched_barrier(0)
    Unit cur, nxt; int ui = 0;
    if (!S.next(0, cur)) return;
    f32x4 acc[2][2][4][2];
#pragma unroll
    for (int a = 0; a < 2; ++a)
#pragma unroll
        for (int b = 0; b < 2; ++b)
#pragma unroll
            for (int m = 0; m < 4; ++m)
#pragma unroll
                for (int n = 0; n < 2; ++n) acc[a][b][m][n] = (f32x4){0.f, 0.f, 0.f, 0.f};
    bf16x8 At[4][2], B0[2][2], B1[2][2];
    const char* cA = (const char*)g.A + (size_t)cur.pm * tstepA + (size_t)cur.ka * 2; const char* cB = (const char*)g.Bt + (size_t)cur.pn * tstepB + (size_t)cur.ka * 2;
    S.a_ready(cur);
    if constexpr (SP2) {
        PG8_STAGE(PG8_SB(0, 0), cB, voffB); PG8_STAGE(PG8_SB(0, 1), cB + hstepB, voffB); PG8_STAGE(PG8_SA(0, 0), cA, voffA); PG8_STAGE(PG8_SA(0, 1), cA + hstepA, voffA);
        if (wr == 1) PG8_BAR;
        PG8_WAIT_V(2); PG8_BAR;
        PG8_STAGE(PG8_SB(1, 0), cB + kstep, voffB); PG8_STAGE(PG8_SA(1, 0), cA + kstep, voffA); PG8_STAGE(PG8_SB(1, 1), cB + hstepB + kstep, voffB);
        PG8_WAIT_V(6); PG8_BAR;
    } else {
        PG8_STAGE(PG8_SB(0, 0), cB, voffB); PG8_STAGE(PG8_SA(0, 0), cA, voffA); PG8_STAGE(PG8_SB(0, 1), cB + hstepB, voffB); PG8_STAGE(PG8_SA(0, 1), cA + hstepA, voffA);
        if (wr == 1) PG8_BAR;
        PG8_WAIT_V(4); PG8_BAR;
        PG8_STAGE(PG8_SB(1, 0), cB + kstep, voffB); PG8_STAGE(PG8_SA(1, 0), cA + kstep, voffA); PG8_STAGE(PG8_SB(1, 1), cB + hstepB + kstep, voffB);
        PG8_WAIT_V(6); PG8_BAR;
    }
    for (;;) {
        const bool has_next = S.next(ui + 1, nxt);
        const char* nA = has_next ? (const char*)g.A + (size_t)nxt.pm * tstepA + (size_t)nxt.ka * 2 : cA; const char* nB = has_next ? (const char*)g.Bt + (size_t)nxt.pn * tstepB + (size_t)nxt.ka * 2 : cB;
        for (int t = 0; t < nt; t += 2) {
            const bool last = (t == nt - 2);
            if constexpr (Epi::KSEG > 0) { if (t > 0 && (t % Epi::KSEG) == 0) E.kseg(acc, cur, t / Epi::KSEG, wr, wc, fr, fq); }
            const char* a1 = cA + (size_t)(t + 1) * kstep;
            const char* a2 = last ? nA : cA + (size_t)(t + 2) * kstep; const char* b2 = last ? nB : cB + (size_t)(t + 2) * kstep;
            const char* a3 = a2 + kstep; const char* b3 = b2 + kstep;
            if (last && has_next) S.a_ready(nxt);
            if constexpr (SP2) {
            PG8_LDB(B0, 0, 0); PG8_LDB(B1, 0, 1); PG8_SCHED; PG8_LDA(At, 0, 0); PG8_STAGE(PG8_SA(1, 1), a1 + hstepA, voffA);
            PG8_WAIT_V(8); PG8_WAIT_L(0); PG8_BAR; PG8_MMA(0, 0, At, B0); PG8_MMA(0, 1, At, B1); PG8_BAR; PG8_SCHED;
            PG8_LDA(At, 0, 1); PG8_STAGE(PG8_SB(0, 0), b2, voffB); PG8_STAGE(PG8_SB(0, 1), b2 + hstepB, voffB); PG8_STAGE(PG8_SA(0, 0), a2, voffA);
            PG8_WAIT_V(8); PG8_WAIT_L(0); PG8_BAR; PG8_MMA(1, 0, At, B0); PG8_MMA(1, 1, At, B1); PG8_BAR; PG8_SCHED;
            PG8_LDB(B0, 1, 0); PG8_LDB(B1, 1, 1); PG8_SCHED; PG8_LDA(At, 1, 0); PG8_STAGE(PG8_SA(0, 1), a2 + hstepA, voffA);
            PG8_WAIT_V(8); PG8_WAIT_L(0); PG8_BAR; PG8_MMA(0, 0, At, B0); PG8_MMA(0, 1, At, B1); PG8_BAR; PG8_SCHED;
            PG8_LDA(At, 1, 1); PG8_STAGE(PG8_SB(1, 0), b3, voffB); PG8_STAGE(PG8_SB(1, 1), b3 + hstepB, voffB); PG8_STAGE(PG8_SA(1, 0), a3, voffA);
            PG8_WAIT_V(8); PG8_WAIT_L(0); PG8_BAR; PG8_MMA(1, 0, At, B0); PG8_MMA(1, 1, At, B1); PG8_BAR; PG8_SCHED;
            } else {
            PG8_LDB(B0, 0, 0); PG8_SCHED; PG8_LDA(At, 0, 0); PG8_STAGE(PG8_SA(1, 1), a1 + hstepA, voffA);
            PG8_WAIT_L(8); PG8_BAR; PG8_WAIT_L(0); PG8_MMA(0, 0, At, B0); PG8_BAR; PG8_SCHED;
            PG8_LDB(B1, 0, 1); PG8_STAGE(PG8_SB(0, 0), b2, voffB);
            PG8_BAR; PG8_WAIT_L(0); PG8_MMA(0, 1, At, B1); PG8_BAR;
            PG8_LDA(At, 0, 1); PG8_STAGE(PG8_SA(0, 0), a2, voffA);
            PG8_BAR; PG8_WAIT_L(0); PG8_MMA(1, 0, At, B0); PG8_BAR; PG8_SCHED;
            PG8_STAGE(PG8_SB(0, 1), b2 + hstepB, voffB);
            PG8_WAIT_V(6); PG8_BAR; PG8_MMA(1, 1, At, B1); PG8_BAR;
            PG8_LDB(B0, 1, 0); PG8_SCHED; PG8_LDA(At, 1, 0); PG8_STAGE(PG8_SA(0, 1), a2 + hstepA, voffA);
            PG8_WAIT_L(8); PG8_BAR; PG8_WAIT_L(0); PG8_MMA(0, 0, At, B0); PG8_BAR; PG8_SCHED;
            PG8_LDB(B1, 1, 1); PG8_STAGE(PG8_SB(1, 0), b3, voffB);
            PG8_BAR; PG8_WAIT_L(0); PG8_MMA(0, 1, At, B1); PG8_BAR;
            PG8_LDA(At, 1, 1); PG8_STAGE(PG8_SA(1, 0), a3, voffA);
            PG8_BAR; PG8_WAIT_L(0); PG8_MMA(1, 0, At, B0); PG8_BAR; PG8_SCHED;
            PG8_STAGE(PG8_SB(1, 1), b3 + hstepB, voffB);
            PG8_WAIT_V(6); PG8_BAR; PG8_MMA(1, 1, At, B1); PG8_BAR;
            }
        }
        if constexpr (ALIGN_EPI) { if (wr == 0) PG8_BAR; }
        if constexpr (!Epi::AFTER_DRAIN) { E(acc, cur, wr, wc, fr, fq); S.done(cur); }
        if (!has_next) break;
#pragma unroll
        for (int a = 0; a < 2; ++a)
#pragma unroll
            for (int b = 0; b < 2; ++b)
#pragma unroll
                for (int m = 0; m < 4; ++m)
#pragma unroll
                    for (int n = 0; n < 2; ++n) acc[a][b][m][n] = (f32x4){0.f, 0.f, 0.f, 0.f};
        cur = nxt; cA = nA; cB = nB; ++ui;
        if constexpr (ALIGN_EPI) { if (wr == 1) PG8_BAR; }
    }
    PG8_WAIT_V(0);
    if constexpr (!ALIGN_EPI) { if (wr == 0) PG8_BAR; }
    PG8_BAR;
    if constexpr (Epi::AFTER_DRAIN) { E.fused(acc, cur, wr, wc, fr, fq, lds, wid, lane); S.done(cur); }
#undef PG8_SA
#undef PG8_SB
#undef PG8_STAGE
#undef PG8_LDA
#undef PG8_LDB
#undef PG8_MMA
#undef PG8_WAIT_V
#undef PG8_WAIT_L
#undef PG8_BAR
#undef PG8_SCHED
}
}

constexpr int NWAVES = 8;
constexpr int D = 2048, NBATCH = 4, SEQ = 4096, DEPTH = 4, CTXL = 256;
constexpr int MLAT = NBATCH * SEQ, MCTX = NBATCH * CTXL, MTOT = MLAT + MCTX;
constexpr int INW = 12288, BW = 1024, FFH = 5632, NHEAD = 8;
constexpr int Q_OFF = 0, K_OFF = 1024, V_OFF = 2048, BU_OFF = 3072, C_OFF = 5120, G_OFF = 6144;
constexpr int YW = 3 * BW;
constexpr float LN_EPS = 1e-6f;
constexpr float ALPHA = 1.681792830507429f;
constexpr float QSCALE = 0.125f * 1.4426950408889634f;

constexpr size_t MiB = 1u << 20;
constexpr size_t WS_CTL = 0, CTL_ZERO_BYTES = 1 * MiB;
constexpr size_t WS_ROPE = 1 * MiB;
constexpr size_t WS_MODS = 2 * MiB;
constexpr size_t WS_MODP = 4 * MiB;
constexpr size_t WS_WSP = 20 * MiB;
constexpr size_t WS_WPOOL = 21 * MiB;
constexpr size_t WS_WIN = 24 * MiB;
constexpr size_t WS_WBR = 216 * MiB;
constexpr size_t WS_WOUT = 264 * MiB;
constexpr size_t WS_WGU = 296 * MiB;
constexpr size_t WS_WDN = 472 * MiB;
constexpr size_t WS_X = 560 * MiB;
constexpr size_t WS_HA = 696 * MiB;
constexpr size_t WS_Y = 764 * MiB;
constexpr size_t WS_MG = 866 * MiB;
constexpr size_t WS_Z = 934 * MiB;
constexpr size_t WS_KB = 1342 * MiB, WS_VB = 1378 * MiB;
constexpr size_t WS_END = 1414 * MiB;
static_assert(WS_MODP + 16ull * 4 * 5 * 12288 * 4 <= WS_WSP && WS_WIN + 4ull * 12288 * 2048 * 2 <= WS_WBR && WS_WBR + 4ull * 2048 * 3072 * 2 <= WS_WOUT && WS_WOUT + 4ull * 2048 * 2048 * 2 <= WS_WGU, "ws map 1");
static_assert(WS_WGU + 4ull * 11264 * 2048 * 2 <= WS_WDN && WS_WDN + 4ull * 2048 * 5632 * 2 <= WS_X && WS_X + (size_t)MTOT * D * 4 <= WS_HA && WS_HA + (size_t)MTOT * D * 2 <= WS_Y, "ws map 2");
static_assert(WS_Y + (size_t)MTOT * YW * 2 <= WS_MG && WS_MG + (size_t)MTOT * D * 2 <= WS_Z && WS_Z + (size_t)MTOT * INW * 2 <= WS_KB && WS_KB + 32ull * 4352 * 256 <= WS_VB && WS_VB + 32ull * 4352 * 256 <= WS_END, "ws map 3");
constexpr int CW_BAR = 4096;

constexpr int RING_OFF = 0, RING_BYTES = 131072;
constexpr int LDSCTL_OFF = RING_BYTES, MISC_OFF = LDSCTL_OFF + 320;
constexpr int LDS_BYTES = 147456;

#define GAS __attribute__((address_space(1)))
#define LAS __attribute__((address_space(3)))
typedef unsigned short bf16;
typedef unsigned v4u __attribute__((ext_vector_type(4)));
typedef unsigned v2u __attribute__((ext_vector_type(2)));
typedef float f32x4 __attribute__((ext_vector_type(4)));
typedef float f32x16 __attribute__((ext_vector_type(16)));
typedef short bf16x8 __attribute__((ext_vector_type(8)));
typedef short s16x4 __attribute__((ext_vector_type(4)));
typedef GAS unsigned gu32;
#define RLX_AGENT __ATOMIC_RELAXED, __HIP_MEMORY_SCOPE_AGENT
#define LDS_WAIT() asm volatile("s_waitcnt lgkmcnt(0)" ::: "memory")
#define VM_WAIT() asm volatile("s_waitcnt vmcnt(0)" ::: "memory")
__device__ __forceinline__ unsigned f2bf(float f) { unsigned u = __builtin_bit_cast(unsigned, f); return (u + 0x7fffu + ((u >> 16) & 1u)) >> 16; }
__device__ __forceinline__ unsigned pk2(float lo, float hi) { return f2bf(lo) | (f2bf(hi) << 16); }
__device__ __forceinline__ unsigned cvtpk(float lo, float hi) { unsigned r; asm volatile("v_cvt_pk_bf16_f32 %0, %1, %2" : "=v"(r) : "v"(lo), "v"(hi)); return r; }
__device__ __forceinline__ float bflo(unsigned w) { return __uint_as_float(w << 16); }
__device__ __forceinline__ float bfhi(unsigned w) { return __uint_as_float(w & 0xffff0000u); }

#define XB_TMO      128
#define XB_XCNT(j)  (256  + 64 * (j))
#define XB_XSUB(j)  (1280 + 64 * (j))
#define XB_XGEN(j)  (2304 + 64 * (j))
#define XB_TOP      3328
#define XB_TOPGEN   3392
#define XCD_BAR_WORDS 3456
#define XB_SPIN_CAP (1u << 18)

__device__ __forceinline__ unsigned xb_ld(unsigned* p)              { return __hip_atomic_load(p, __ATOMIC_RELAXED, __HIP_MEMORY_SCOPE_AGENT); }
__device__ __forceinline__ unsigned xb_add(unsigned* p, unsigned v) { return __hip_atomic_fetch_add(p, v, __ATOMIC_RELAXED, __HIP_MEMORY_SCOPE_AGENT); }
__device__ __forceinline__ unsigned xb_xcc_id() { return (unsigned)__builtin_amdgcn_s_getreg((3 << 11) | 20) & 0xFu; }
#define XB_SPIN(cond, bar) do { unsigned _sp = 0; while (cond) { __builtin_amdgcn_s_sleep(1); \
    if ((++_sp & 255u) == 0u) { if (xb_ld(&(bar)[XB_TMO])) break; if (_sp > XB_SPIN_CAP) { atomicAdd(&(bar)[XB_TMO], 1u); break; } } } } while (0)

struct XcdBarrier {
    unsigned* bar; unsigned x;
    volatile LAS unsigned* st;
};

__device__ __forceinline__ XcdBarrier xcd_barrier_post(unsigned* bar, volatile LAS unsigned* st) {
    XcdBarrier b; b.bar = bar; b.x = xb_xcc_id(); b.st = st;
    if (threadIdx.x == 0) (void)xb_add(&bar[XB_XCNT(b.x)], 1u);
    return b;
}
__device__ __forceinline__ void xcd_barrier_complete(unsigned* bar, unsigned x, unsigned& nloc, unsigned& nx) {
    const unsigned G = gridDim.x * gridDim.y * gridDim.z;
    unsigned sum, cnt, mine, sp = 0u;
    for (;;) {
        sum = 0u; cnt = 0u; mine = 0u;
#pragma unroll
        for (unsigned j = 0; j < 16; ++j) { const unsigned c = xb_ld(&bar[XB_XCNT(j)]); sum += c; cnt += (c > 0u) ? 1u : 0u; mine = (j == x) ? c : mine; }
        if (sum == G) break;
        __builtin_amdgcn_s_sleep(1);
        if ((++sp & 255u) == 0u) { if (xb_ld(&bar[XB_TMO])) break; if (sp > XB_SPIN_CAP) { atomicAdd(&bar[XB_TMO], 1u); break; } }
    }
    nloc = mine > 0u ? mine : 1u; nx = cnt > 0u ? cnt : 1u;
}

__device__ __forceinline__ void xcd_barrier(const XcdBarrier& b) {
    asm volatile("s_waitcnt vmcnt(0)" ::: "memory");
    __syncthreads();
    if (threadIdx.x == 0) {
        unsigned* bar = b.bar;
        __builtin_amdgcn_s_waitcnt(0);
        unsigned nloc = b.st[0], nx = b.st[1];
        if (nloc == 0u) { xcd_barrier_complete(bar, b.x, nloc, nx); b.st[0] = nloc; b.st[1] = nx; }
        const unsigned old = xb_add(&bar[XB_XSUB(b.x)], 1u);
        const unsigned gen = old / nloc;
        if (old + 1u == (gen + 1u) * nloc) {
            __builtin_amdgcn_fence(__ATOMIC_RELEASE, "agent");
            asm volatile("s_waitcnt vmcnt(0)" ::: "memory");
            const unsigned og = xb_add(&bar[XB_TOP], 1u);
            const unsigned tg = og / nx;
            if (og + 1u == (tg + 1u) * nx) xb_add(&bar[XB_TOPGEN], 1u);
            else XB_SPIN(xb_ld(&bar[XB_TOPGEN]) == tg, bar);
            __builtin_amdgcn_fence(__ATOMIC_ACQUIRE, "agent");
            xb_add(&bar[XB_XGEN(b.x)], 1u);
            asm volatile("s_waitcnt vmcnt(0)" ::: "memory");
        } else {
            XB_SPIN(xb_ld(&bar[XB_XGEN(b.x)]) == gen, bar);
            __builtin_amdgcn_fence(__ATOMIC_ACQUIRE, "agent");
            asm volatile("s_waitcnt vmcnt(0)" ::: "memory");
        }
    }
    __syncthreads();
}


struct Frame {
    LAS unsigned char* lds;
    volatile LAS unsigned* MISC;
    gu32* ctl;
    int vcu, G, bx;
    __device__ __forceinline__ int ltid() const { int t = threadIdx.x; asm volatile("" : "+v"(t)); return t; }
    const float *x, *c, *ctx, *cctx, *w_ada, *b_ada, *w_in, *lam_qk, *subln_g, *gln_g, *gln_b, *w_sp, *b_sp, *w_pool, *pool_scale, *w_branch, *w_out, *ln1_g, *ln1_b, *w_gu, *w_down, *ln2_g, *ln2_b;
    float* out;
    float *rope, *mods, *modp, *X;
    bf16 *Wsp, *Wpool, *Win, *Wbr, *Wout, *Wgu, *Wdn, *HA, *Y, *MG, *Z, *KB, *VB;
};

typedef __attribute__((address_space(4))) const unsigned char* kptr_t;
__device__ __forceinline__ void frame_ptrs(Frame& F) {
    kptr_t kp = (kptr_t)__builtin_amdgcn_kernarg_segment_ptr(); asm volatile("" : "+s"(kp));
#define KIN(i) (*(const float* const __attribute__((address_space(4)))*)(kp + 8 * (i)))
    F.x = KIN(0); F.c = KIN(1); F.ctx = KIN(2); F.cctx = KIN(3); F.w_ada = KIN(4); F.b_ada = KIN(5); F.w_in = KIN(6); F.lam_qk = KIN(7); F.subln_g = KIN(8);
    F.gln_g = KIN(9); F.gln_b = KIN(10); F.w_sp = KIN(11); F.b_sp = KIN(12); F.w_pool = KIN(13); F.pool_scale = KIN(14); F.w_branch = KIN(15); F.w_out = KIN(16);
    F.ln1_g = KIN(17); F.ln1_b = KIN(18); F.w_gu = KIN(19); F.w_down = KIN(20); F.ln2_g = KIN(21); F.ln2_b = KIN(22);
#undef KIN
    F.out = *(float* const __attribute__((address_space(4)))*)(kp + 184);
    unsigned char* ws = *(unsigned char* const __attribute__((address_space(4)))*)(kp + 192);
    F.rope = (float*)(ws + WS_ROPE); F.mods = (float*)(ws + WS_MODS); F.modp = (float*)(ws + WS_MODP); F.X = (float*)(ws + WS_X);
    F.Wsp = (bf16*)(ws + WS_WSP); F.Wpool = (bf16*)(ws + WS_WPOOL); F.Win = (bf16*)(ws + WS_WIN); F.Wbr = (bf16*)(ws + WS_WBR); F.Wout = (bf16*)(ws + WS_WOUT); F.Wgu = (bf16*)(ws + WS_WGU); F.Wdn = (bf16*)(ws + WS_WDN);
    F.HA = (bf16*)(ws + WS_HA); F.Y = (bf16*)(ws + WS_Y); F.MG = (bf16*)(ws + WS_MG); F.Z = (bf16*)(ws + WS_Z); F.KB = (bf16*)(ws + WS_KB); F.VB = (bf16*)(ws + WS_VB);
}
__device__ __forceinline__ float wave_sum(float v) {
#pragma unroll
    for (int o = 1; o < 64; o <<= 1) v += __shfl_xor(v, o);
    return v;
}

__device__ __forceinline__ void cvt_item(const float* W, int N, int k0, int ncol0, bool perm, bf16* WT, size_t drow0, int ldk, int dk0, LAS float* scr, int lane) {
#pragma unroll 8
    for (int i = 0; i < 32; ++i) { const int kk = 2 * i + (lane >> 5); scr[kk * 33 + (lane & 31)] = __builtin_nontemporal_load(W + (size_t)(k0 + kk) * N + ncol0 + (lane & 31)); }
    LDS_WAIT(); asm volatile("" ::: "memory");
    const int c = lane & 7;
#pragma unroll
    for (int j = 0; j < 4; ++j) { const int n = (lane >> 3) + 8 * j; const int ns = perm ? ((n & 1) * 16 + (n >> 1)) : n; const LAS float* s = scr + (8 * c) * 33 + ns;
        v4u o; o.x = pk2(s[0 * 33], s[1 * 33]); o.y = pk2(s[2 * 33], s[3 * 33]); o.z = pk2(s[4 * 33], s[5 * 33]); o.w = pk2(s[6 * 33], s[7 * 33]);
        *(GAS v4u*)(WT + (drow0 + n) * (size_t)ldk + dk0 + k0 + 8 * c) = o; }
    LDS_WAIT(); asm volatile("" ::: "memory");
}
constexpr int CV_IN = 32 * 384, CV_GU = 32 * 352, CV_DN = 88 * 64, CV_BR = 3 * 16 * 64, CV_OUT = 32 * 64, CV_POOL = 4 * 4 * 8, CV_LAYER = CV_IN + CV_GU + CV_DN + CV_BR + CV_OUT + CV_POOL;
__device__ __forceinline__ void cvt_dispatch(Frame& F, int it, LAS float* scr) {
    const int l = it / CV_LAYER; int r = it - l * CV_LAYER;
    if (r < CV_IN) { const int kb = r / 384, nb = r - kb * 384;
        cvt_item(F.w_in + (size_t)l * D * INW, INW, 64 * kb, 32 * nb, nb < 64, F.Win + (size_t)l * INW * D, (size_t)32 * nb, D, 0, scr, (F.ltid() & 63)); return; }
    r -= CV_IN;
    if (r < CV_GU) { const int kb = r / 352, nb = r - kb * 352; const int tpn = nb >> 3, half = (nb >> 2) & 1, jj0 = (nb & 3) * 32;
        cvt_item(F.w_gu + (size_t)l * D * 2 * FFH, 2 * FFH, 64 * kb, half * FFH + 128 * tpn + jj0, false, F.Wgu + (size_t)l * 2 * FFH * D, (size_t)32 * nb, D, 0, scr, (F.ltid() & 63)); return; }
    r -= CV_GU;
    if (r < CV_DN) { const int kb = r >> 6, nb = r & 63;
        cvt_item(F.w_down + (size_t)l * FFH * D, D, 64 * kb, 32 * nb, false, F.Wdn + (size_t)l * D * FFH, (size_t)32 * nb, FFH, 0, scr, (F.ltid() & 63)); return; }
    r -= CV_DN;
    if (r < CV_BR) { const int n = r >> 10, rr = r & 1023, kb = rr >> 6, nb = rr & 63;
        cvt_item(F.w_branch + ((size_t)l * 3 + n) * BW * D, D, 64 * kb, 32 * nb, false, F.Wbr + (size_t)l * D * YW, (size_t)32 * nb, YW, BW * n, scr, (F.ltid() & 63)); return; }
    r -= CV_BR;
    if (r < CV_OUT) { const int kb = r >> 6, nb = r & 63;
        cvt_item(F.w_out + (size_t)l * D * D, D, 64 * kb, 32 * nb, false, F.Wout + (size_t)l * D * D, (size_t)32 * nb, D, 0, scr, (F.ltid() & 63)); return; }
    r -= CV_OUT;
    { const int g = r >> 5, rr = r & 31, kb = rr >> 3, nb = rr & 7;
        cvt_item(F.w_pool + ((size_t)l * 4 + g) * 65536, 256, 64 * kb, 32 * nb, false, F.Wpool + ((size_t)l * 4 + g) * 65536, (size_t)32 * nb, 256, 0, scr, (F.ltid() & 63)); }
}

__device__ __forceinline__ double rope_inv(int p) {
    const double t[16] = {1.0, 0.5623413251903491, 0.31622776601683794, 0.1778279410038923, 0.1, 0.05623413251903491, 0.03162277660168379, 0.01778279410038923,
                          0.01, 0.005623413251903491, 0.003162277660168379, 0.001778279410038923, 0.001, 0.0005623413251903491, 0.00031622776601683794, 0.0001778279410038923};
    double r = t[0];
#pragma unroll
    for (int i = 1; i < 16; ++i) r = (p == i) ? t[i] : r;
    return r;
}
#ifndef TAILWORK
#define TAILWORK 0
#endif
__device__ __forceinline__ void ada_partial_layer(Frame& F, int l, int gw, int NGW) {
    LAS float* scs = (LAS float*)(F.lds);
    __syncthreads();
    for (int i = F.ltid(); i < 5 * D; i += NWAVES * 64) { const int g = i >> 11, k = i & 2047; const float v = g < 4 ? F.c[g * D + k] : F.cctx[k]; scs[i] = v / (1.0f + __expf(-v)); }
    __syncthreads();
    for (int it = gw; it < 16 * 48; it += NGW) {
        const int ks = it / 48, cgw = it - ks * 48; const int col = cgw * 256 + (F.ltid() & 63) * 4;
        const float* wp = F.w_ada + ((size_t)l * D + ks * 128) * INW + col;
        f32x4 a0 = {0.f, 0.f, 0.f, 0.f}, a1 = a0, a2 = a0, a3 = a0, a4 = a0;
#pragma unroll 8
        for (int k = 0; k < 128; ++k) { const f32x4 w = __builtin_nontemporal_load((const GAS f32x4*)(wp + (size_t)k * INW)); const int kk = ks * 128 + k;
            a0 += w * scs[kk]; a1 += w * scs[D + kk]; a2 += w * scs[2 * D + kk]; a3 += w * scs[3 * D + kk]; a4 += w * scs[4 * D + kk]; }
        float* pp = F.modp + (((size_t)ks * 4 + l) * 5) * INW + col;
        *(f32x4*)(pp) = a0; *(f32x4*)(pp + INW) = a1; *(f32x4*)(pp + 2 * INW) = a2; *(f32x4*)(pp + 3 * INW) = a3; *(f32x4*)(pp + 4 * INW) = a4;
    }
    __syncthreads();
}
__device__ __forceinline__ void cvt_layer(Frame& F, int l, int gw, int NGW) {
    LAS float* scr = (LAS float*)(F.lds + __builtin_amdgcn_readfirstlane(F.ltid() >> 6) * 16384);
    for (int it = gw; it < CV_LAYER; it += NGW) cvt_dispatch(F, l * CV_LAYER + it, scr);
}
__device__ __forceinline__ void mods_reduce_layer(Frame& F, int l) {
    const int gt = F.vcu * NWAVES * 64 + F.ltid(), NGT = F.G * NWAVES * 64;
    for (int i = gt; i < 5 * (INW / 4); i += NGT) { const int g = i / (INW / 4), j = (i - g * (INW / 4)) * 4;
        f32x4 sm = *(const f32x4*)(F.b_ada + (size_t)l * INW + j);
#pragma unroll
        for (int ks = 0; ks < 16; ++ks) sm += *(const f32x4*)(F.modp + (((size_t)ks * 4 + l) * 5 + g) * INW + j);
        *(f32x4*)(F.mods + ((size_t)l * 5 + g) * INW + j) = sm; }
}
__device__ __forceinline__ void phase_a1(Frame& F) {
    const int gw = F.vcu * NWAVES + __builtin_amdgcn_readfirstlane(F.ltid() >> 6), NGW = F.G * NWAVES;
#pragma nounroll
    for (int l = 0; l < (TAILWORK ? 1 : DEPTH); ++l) ada_partial_layer(F, l, gw, NGW);
#pragma nounroll
    for (int l = 0; l < (TAILWORK ? 1 : DEPTH); ++l) cvt_layer(F, l, gw, NGW);
    for (int it = gw; it < (DEPTH * 8 * 128 * 128) / 512; it += NGW) { const size_t e = (size_t)it * 512 + (F.ltid() & 63) * 8;
        const f32x4 a = *(const f32x4*)(F.w_sp + e), b = *(const f32x4*)(F.w_sp + e + 4);
        v4u o; o.x = pk2(a[0], a[1]); o.y = pk2(a[2], a[3]); o.z = pk2(b[0], b[1]); o.w = pk2(b[2], b[3]); *(v4u*)(F.Wsp + e) = o; }
    if (gw == 0) {
        for (int e = (F.ltid() & 63); e < 1024; e += 64) { const int pos = e >> 4, pr = e & 15;
            const double ang = (double)pos * rope_inv(pr); const double twopi = 6.283185307179586476925286766559;
            const double kq = __builtin_rint(ang / twopi); const double rr = ang - kq * twopi; const double r2 = rr * rr;
            double sn = 1.0, cs = 1.0;
#pragma unroll
            for (int n = 14; n >= 1; --n) { sn = 1.0 - sn * r2 / (double)((2 * n) * (2 * n + 1)); cs = 1.0 - cs * r2 / (double)((2 * n - 1) * (2 * n)); }
            sn *= rr;
            F.rope[2 * e] = (float)cs; F.rope[2 * e + 1] = (float)sn; }
    }
}
__device__ __forceinline__ void phase_a2(Frame& F) {
#pragma nounroll
    for (int l = 0; l < (TAILWORK ? 1 : DEPTH); ++l) mods_reduce_layer(F, l); }
__device__ __forceinline__ void ln_row(const float* src, const bf16* tadd, const float* part, int npart, const float* gam, const float* bet, float* xo, float xs, bf16* ho, const float* sc, const float* sh, int lane) {
    f32x4 v[8]; float s = 0.f;
#pragma unroll
    for (int j = 0; j < 8; ++j) v[j] = __builtin_nontemporal_load((const GAS f32x4*)(src + 4 * lane + 256 * j));
    if (tadd) {
#pragma unroll
        for (int j = 0; j < 8; ++j) { const v2u t2 = *(const GAS v2u*)(tadd + 4 * lane + 256 * j); v[j] += (f32x4){bflo(t2.x), bfhi(t2.x), bflo(t2.y), bfhi(t2.y)}; } }
    for (int p = 0; p < npart; ++p) {
#pragma unroll
        for (int j = 0; j < 8; ++j) v[j] += __builtin_nontemporal_load((const GAS f32x4*)(part + (size_t)p * 1024 * D + 4 * lane + 256 * j)); }
#pragma unroll
    for (int j = 0; j < 8; ++j) s += (v[j][0] + v[j][1]) + (v[j][2] + v[j][3]);
    const float mean = wave_sum(s) * (1.f / D); float s2 = 0.f;
#pragma unroll
    for (int j = 0; j < 8; ++j) { v[j] = v[j] - mean; s2 += (v[j][0] * v[j][0] + v[j][1] * v[j][1]) + (v[j][2] * v[j][2] + v[j][3] * v[j][3]); }
    const float rstd = 1.0f / sqrtf(wave_sum(s2) * (1.f / D) + LN_EPS);
#pragma unroll
    for (int j = 0; j < 8; ++j) { const int col = 4 * lane + 256 * j; f32x4 xn = v[j] * rstd;
        if (gam) xn = xn * *(const f32x4*)(gam + col) + *(const f32x4*)(bet + col);
        if (xo) __builtin_nontemporal_store(xn * xs, (GAS f32x4*)(xo + col));
        if (ho) { const f32x4 hv = xn * (1.0f + *(const f32x4*)(sc + col)) + *(const f32x4*)(sh + col); v2u o; o.x = pk2(hv[0], hv[1]); o.y = pk2(hv[2], hv[3]); __builtin_nontemporal_store(o, (GAS v2u*)(ho + col)); } }
}
__device__ __forceinline__ int row_group(int row) { return row < MLAT ? (row >> 12) : 4; }
__device__ __forceinline__ void phase_a3(Frame& F) {
    const int gw = F.vcu * NWAVES + __builtin_amdgcn_readfirstlane(F.ltid() >> 6), NGW = F.G * NWAVES;
    for (int row = gw; row < MTOT; row += NGW) { const float* src = row < MLAT ? F.x + (size_t)row * D : F.ctx + (size_t)(row - MLAT) * D; const float* md = F.mods + (size_t)row_group(row) * INW;
        ln_row(src, nullptr, nullptr, 0, nullptr, nullptr, F.X + (size_t)row * D, ALPHA, F.HA + (size_t)row * D, md + D, md, (F.ltid() & 63)); }
}
#ifndef LN_NT
#define LN_NT 1
#endif
#if LN_NT
#define LN_LD(p) __builtin_nontemporal_load(p)
#define LN_ST(p, v) __builtin_nontemporal_store((v), (p))
#else
#define LN_LD(p) (*(p))
#define LN_ST(p, v) (*(p) = (v))
#endif
__device__ __forceinline__ void ln_finish(f32x4 (&v)[8], const float* gam, const float* bet, float* xo, float xs, bf16* ho, const float* sc, const float* sh, int lane) {
    float s = 0.f;
#pragma unroll
    for (int j = 0; j < 8; ++j) s += (v[j][0] + v[j][1]) + (v[j][2] + v[j][3]);
    const float mean = wave_sum(s) * (1.f / D); float s2 = 0.f;
#pragma unroll
    for (int j = 0; j < 8; ++j) { v[j] = v[j] - mean; s2 += (v[j][0] * v[j][0] + v[j][1] * v[j][1]) + (v[j][2] * v[j][2] + v[j][3] * v[j][3]); }
    const float rstd = 1.0f / sqrtf(wave_sum(s2) * (1.f / D) + LN_EPS);
#pragma unroll
    for (int j = 0; j < 8; ++j) { const int col = 4 * lane + 256 * j; f32x4 xn = v[j] * rstd;
        xn = xn * *(const f32x4*)(gam + col) + *(const f32x4*)(bet + col);
        if (xo) LN_ST((GAS f32x4*)(xo + col), xn * xs);
        if (ho) { const f32x4 hv = xn * (1.0f + *(const f32x4*)(sc + col)) + *(const f32x4*)(sh + col); v2u o; o.x = pk2(hv[0], hv[1]); o.y = pk2(hv[2], hv[3]); LN_ST((GAS v2u*)(ho + col), o); } }
}
__device__ __forceinline__ void phase_ln(Frame& F, const float* gam, const float* bet, int nrows, bool to_out, bool want_h, int lm, int moff, int nsplit, bool dry = false) {
    const int gw = F.vcu * NWAVES + __builtin_amdgcn_readfirstlane(F.ltid() >> 6), NGW = F.G * NWAVES; const int lane = F.ltid() & 63;
    f32x4 xa[8]; v2u ta[8];
    int row = gw;
    if (row < MLAT) {
#pragma unroll
        for (int j = 0; j < 8; ++j) { xa[j] = LN_LD((const GAS f32x4*)(F.X + (size_t)row * D + 4 * lane + 256 * j)); ta[j] = LN_LD((const GAS v2u*)(F.Y + (size_t)row * D + 4 * lane + 256 * j)); } }
    for (; row < MLAT; row += NGW) {
        f32x4 v[8];
#pragma unroll
        for (int j = 0; j < 8; ++j) v[j] = xa[j] + (f32x4){bflo(ta[j].x), bfhi(ta[j].x), bflo(ta[j].y), bfhi(ta[j].y)};
        const int nx = row + NGW;
        if (nx < MLAT) {
#pragma unroll
            for (int j = 0; j < 8; ++j) { xa[j] = LN_LD((const GAS f32x4*)(F.X + (size_t)nx * D + 4 * lane + 256 * j)); ta[j] = LN_LD((const GAS v2u*)(F.Y + (size_t)nx * D + 4 * lane + 256 * j)); } }
        const float* md = F.mods + ((size_t)lm * 5 + (row >> 12)) * INW + moff;
        ln_finish(v, gam, bet, dry ? (float*)(F.Z + (size_t)134 * MiB) + (size_t)row * D : (to_out ? F.out + (size_t)row * D : F.X + (size_t)row * D), to_out ? 1.0f : ALPHA, want_h ? (dry ? F.MG : F.HA) + (size_t)row * D : nullptr, md + D, md, lane);
    }
    for (; row < nrows; row += NGW) { const float* md = F.mods + ((size_t)lm * 5 + 4) * INW + moff;
        ln_row(F.X + (size_t)row * D, nullptr, (const float*)(F.Z + (size_t)100 * MiB) + (size_t)(row - MLAT) * D, nsplit, gam, bet, dry ? (float*)(F.Z + (size_t)134 * MiB) + (size_t)row * D : (to_out ? F.out + (size_t)row * D : F.X + (size_t)row * D), to_out ? 1.0f : ALPHA, want_h ? (dry ? F.MG : F.HA) + (size_t)row * D : nullptr, md + D, md, lane); }
}

constexpr int AT_KB = 0, AT_VB = 32768, AT_TILE = 16384, AT_XB = 65536;
__device__ __forceinline__ s16x4 vtr(const LAS unsigned char* p) { typedef short v4i16_t __attribute__((ext_vector_type(4))); return __builtin_bit_cast(s16x4, __builtin_amdgcn_ds_read_tr16_b64_v4i16((LAS v4i16_t*)p)); }
__device__ __forceinline__ float max3f(float a, float b, float c) { float r; asm("v_max3_f32 %0, %1, %2, %3" : "=v"(r) : "v"(a), "v"(b), "v"(c)); return r; }
__device__ __forceinline__ void glds16(const void* gsrc, unsigned lds_dst) { unsigned keep;
    asm volatile("s_mov_b32 %0, m0\n\ts_mov_b32 m0, %2\n\ts_nop 0\n\tglobal_load_lds_dwordx4 %1, off\n\ts_mov_b32 m0, %0" : "=&s"(keep) : "v"(gsrc), "s"(lds_dst) : "memory"); }
#define AT_WAITV(n) asm volatile("s_waitcnt vmcnt(" #n ")" ::: "memory")
#define AT_BAR() asm volatile("s_waitcnt lgkmcnt(0)\n\ts_barrier" ::: "memory")
__device__ __forceinline__ void attn_unit(Frame& F, int b, int h, int qb, bool ctxq, float lam, float oscale, const float* subg) {
    int lane_ = (F.ltid() & 63); asm volatile("" : "+v"(lane_));
    const int lane = lane_, wid = __builtin_amdgcn_readfirstlane(F.ltid() >> 6), r32 = lane & 31, hi = lane >> 5, m = wid >> 2, qg = wid & 3; const bool lead = wid < 4;
    const bf16* Z = F.Z;
    const int qrow = (ctxq ? MLAT + b * CTXL : b * SEQ) + qb * 128 + qg * 32 + r32;
    bf16x8 qf[4];
#pragma unroll
    for (int d0 = 0; d0 < 4; ++d0) qf[d0] = *(const GAS bf16x8*)(Z + (size_t)qrow * INW + Q_OFF + h * 128 + m * 64 + d0 * 16 + hi * 8);
    const int NT = ctxq ? 4 : 68;
    const bf16* Kbh = F.KB + (size_t)(b * 8 + h) * 4352 * 128; const bf16* Vbh = F.VB + (size_t)(b * 8 + h) * 4352 * 128;
    const unsigned lds0 = (unsigned)(size_t)F.lds;
    const int prow = 8 * wid + (lane >> 4), ppos = lane & 15;
    const unsigned koff0 = (unsigned)(prow * 128 + ((ppos ^ (prow & 15)) * 8)), koff1 = (unsigned)((prow + 4) * 128 + ((ppos ^ ((prow + 4) & 15)) * 8));
    const unsigned voff0 = (unsigned)(prow * 128 + ((ppos ^ (4 * (prow & 3))) * 8)), voff1 = voff0 + 4 * 128;
    const unsigned kdst = (unsigned)__builtin_amdgcn_readfirstlane((int)(lds0 + AT_KB + wid * 2048)), vdst = (unsigned)__builtin_amdgcn_readfirstlane((int)(lds0 + AT_VB + wid * 2048));
#define AT_DMAK(t, bufo) do { const bf16* tb_ = Kbh + (size_t)(t) * 8192; glds16(tb_ + koff0, kdst + (bufo)); glds16(tb_ + koff1, kdst + (bufo) + 1024); } while (0)
#define AT_DMAV(t, bufo) do { const bf16* tb_ = Vbh + (size_t)(t) * 8192; glds16(tb_ + voff0, vdst + (bufo)); glds16(tb_ + voff1, vdst + (bufo) + 1024); } while (0)
    f32x16 o[4];
#pragma unroll
    for (int db = 0; db < 4; ++db)
#pragma unroll
        for (int r = 0; r < 16; ++r) o[db][r] = 0.f;
    float mref = 0.f, lsum = 0.f;
    f32x16 negm;
#pragma unroll
    for (int r = 0; r < 16; ++r) negm[r] = 0.f;
    const unsigned kaddr0 = AT_KB + r32 * 256 + (((8 * m + hi) ^ (r32 & 15)) << 4);
    const int a4 = (lane & 15) >> 2, cc = 2 * ((lane >> 4) & 1) + ((lane & 3) >> 1);
    const unsigned vaddr0 = AT_VB + (4 * hi + a4) * 256 + ((4 * a4 + cc) << 4) + 8 * (lane & 1);
    __syncthreads();
    AT_DMAK(0, 0); AT_DMAV(0, 0);
    AT_WAITV(2); AT_BAR();
    if (!lead) { if (NT > 1) { AT_DMAK(1, AT_TILE); AT_WAITV(2); } else AT_WAITV(0); AT_BAR(); }
    for (int t = 0; t < NT; ++t) {
        const unsigned bo = (t & 1) ? AT_TILE : 0; const bool more = (t + 1 < NT);
        if (more) { if (lead) AT_DMAK(t + 1, bo ^ AT_TILE); else AT_DMAV(t + 1, bo ^ AT_TILE); }
        unsigned kb_ = kaddr0 + bo, vb_ = vaddr0 + bo; asm volatile("" : "+v"(kb_), "+v"(vb_));
        f32x16 p0, p1;
        { bf16x8 kf[4][2];
#pragma unroll
          for (int d0 = 0; d0 < 4; ++d0) { const unsigned ka = kb_ ^ (unsigned)((2 * d0) << 4); kf[d0][0] = *(const LAS bf16x8*)(F.lds + ka); kf[d0][1] = *(const LAS bf16x8*)(F.lds + ka + 32 * 256); }
          __builtin_amdgcn_sched_barrier(0);
          p0 = __builtin_amdgcn_mfma_f32_32x32x16_bf16(kf[0][0], qf[0], negm, 0, 0, 0);
#pragma unroll
          for (int d0 = 1; d0 < 4; ++d0) p0 = __builtin_amdgcn_mfma_f32_32x32x16_bf16(kf[d0][0], qf[d0], p0, 0, 0, 0);
          p1 = __builtin_amdgcn_mfma_f32_32x32x16_bf16(kf[0][1], qf[0], negm, 0, 0, 0);
#pragma unroll
          for (int d0 = 1; d0 < 4; ++d0) p1 = __builtin_amdgcn_mfma_f32_32x32x16_bf16(kf[d0][1], qf[d0], p1, 0, 0, 0); }
#define AT_SOFTMAX(P, OTHER, PK, FIRST) do { \
        float tmax = max3f(P[0], P[1], P[2]); \
        _Pragma("unroll") for (int r = 3; r < 15; r += 2) tmax = max3f(tmax, P[r], P[r + 1]); \
        tmax = __builtin_fmaxf(tmax, P[15]); { auto rr_ = __builtin_amdgcn_permlane32_swap(__float_as_uint(tmax), __float_as_uint(tmax), false, false); tmax = __builtin_fmaxf(__uint_as_float(rr_[0]), __uint_as_float(rr_[1])); } \
        if (FIRST) { mref = tmax; \
            _Pragma("unroll") for (int r = 0; r < 16; ++r) { P[r] -= tmax; OTHER[r] -= tmax; negm[r] = -mref; } \
        } else if (__any(tmax > 8.0f)) { \
            const float dl = __builtin_fmaxf(tmax, 0.f); mref += dl; const float al = __builtin_amdgcn_exp2f(-dl); lsum *= al; \
            _Pragma("unroll") for (int r = 0; r < 16; ++r) { P[r] -= dl; OTHER[r] -= dl; negm[r] = -mref; } \
            _Pragma("unroll") for (int db = 0; db < 4; ++db) _Pragma("unroll") for (int r = 0; r < 16; ++r) o[db][r] *= al; \
        } \
        float ls0_ = 0.f, ls1_ = 0.f, ls2_ = 0.f, ls3_ = 0.f; \
        _Pragma("unroll") for (int r = 0; r < 16; r += 4) { P[r] = __builtin_amdgcn_exp2f(P[r]); P[r + 1] = __builtin_amdgcn_exp2f(P[r + 1]); P[r + 2] = __builtin_amdgcn_exp2f(P[r + 2]); P[r + 3] = __builtin_amdgcn_exp2f(P[r + 3]); \
            ls0_ += P[r]; ls1_ += P[r + 1]; ls2_ += P[r + 2]; ls3_ += P[r + 3]; } \
        lsum += (ls0_ + ls1_) + (ls2_ + ls3_); \
        _Pragma("unroll") for (int s_ = 0; s_ < 2; ++s_) { v4u w_; \
            w_.x = cvtpk(P[8 * s_ + 0], P[8 * s_ + 1]); w_.y = cvtpk(P[8 * s_ + 2], P[8 * s_ + 3]); w_.z = cvtpk(P[8 * s_ + 4], P[8 * s_ + 5]); w_.w = cvtpk(P[8 * s_ + 6], P[8 * s_ + 7]); \
            PK[s_] = __builtin_bit_cast(bf16x8, w_); } } while (0)
        bf16x8 pka[2], pkb[2];
        f32x16 dummy_;
        AT_SOFTMAX(p0, p1, pka, t == 0);
        if (more) AT_WAITV(2); else AT_WAITV(0);
        AT_BAR();
        if (lead) { if (more) AT_DMAV(t + 1, bo ^ AT_TILE); } else { if (t + 2 < NT) AT_DMAK(t + 2, bo); }
        { s16x4 va_[4][2][2], vc_[4][2][2];
#define AT_VLOAD(dst, kh_) do { _Pragma("unroll") for (int d_ = 0; d_ < 4; ++d_) { const unsigned va = vb_ ^ (unsigned)(d_ << 6); \
            _Pragma("unroll") for (int s_ = 0; s_ < 2; ++s_) { dst[d_][s_][0] = vtr(F.lds + va + (32 * (kh_) + 16 * s_) * 256); dst[d_][s_][1] = vtr(F.lds + va + (32 * (kh_) + 16 * s_ + 8) * 256); } } } while (0)
#define AT_VMMA(src, PK) do { _Pragma("unroll") for (int s_ = 0; s_ < 2; ++s_) _Pragma("unroll") for (int d_ = 0; d_ < 4; ++d_) { \
            const bf16x8 vf = (bf16x8){src[d_][s_][0][0], src[d_][s_][0][1], src[d_][s_][0][2], src[d_][s_][0][3], src[d_][s_][1][0], src[d_][s_][1][1], src[d_][s_][1][2], src[d_][s_][1][3]}; \
            o[d_] = __builtin_amdgcn_mfma_f32_32x32x16_bf16(vf, PK[s_], o[d_], 0, 0, 0); } } while (0)
          AT_VLOAD(va_, 0); __builtin_amdgcn_sched_barrier(0);
          AT_VLOAD(vc_, 1); __builtin_amdgcn_sched_barrier(0);
          AT_VMMA(va_, pka);
          AT_SOFTMAX(p1, dummy_, pkb, false);
          AT_VMMA(vc_, pkb);
          __builtin_amdgcn_sched_barrier(0);
#undef AT_VLOAD
#undef AT_VMMA
        }
#undef AT_SOFTMAX
        if (lead) { if (more) AT_WAITV(2); } else { if (t + 2 < NT) AT_WAITV(2); else AT_WAITV(0); }
        AT_BAR();
    }
    if (lead) AT_BAR();
    const float lt = lsum + __shfl_xor(lsum, 32);
    LAS float* xs = (LAS float*)(F.lds + AT_XB) + qg * 4096 + lane;
    if (!lead) { const float sc1 = lam / lt;
#pragma unroll
        for (int db = 0; db < 4; ++db)
#pragma unroll
            for (int r = 0; r < 16; ++r) xs[(db * 16 + r) * 64] = o[db][r] * sc1; }
    __syncthreads();
    if (lead) {
        const float i0 = 1.0f / lt; float ss = 0.f;
#pragma unroll
        for (int db = 0; db < 4; ++db)
#pragma unroll
            for (int r = 0; r < 16; ++r) { const float v = o[db][r] * i0 - xs[(db * 16 + r) * 64]; o[db][r] = v; ss += v * v; }
        ss += __shfl_xor(ss, 32);
        const float rs = oscale / sqrtf(ss * (1.0f / 128.0f) + LN_EPS);
        bf16* yp = F.Y + (size_t)qrow * YW + h * 128 + 4 * hi;
#pragma unroll
        for (int db = 0; db < 4; ++db)
#pragma unroll
            for (int g4 = 0; g4 < 4; ++g4) { const int d = 32 * db + 8 * g4; const f32x4 gv = *(const f32x4*)(subg + d + 4 * hi);
                v2u w; w.x = cvtpk(o[db][4 * g4 + 0] * rs * gv[0], o[db][4 * g4 + 1] * rs * gv[1]); w.y = cvtpk(o[db][4 * g4 + 2] * rs * gv[2], o[db][4 * g4 + 3] * rs * gv[3]);
                *(GAS v2u*)(yp + d) = w; }
    }
#undef AT_DMAK
#undef AT_DMAV
}

constexpr int GM_ST = 0, GM_VT = 1024, GM_VP = 272;
__device__ __forceinline__ void gmlp_unit(Frame& F, int row0, int l) {
    int tid_ = F.ltid(); asm volatile("" : "+v"(tid_)); const int tid = tid_, lane = tid & 63, wid = __builtin_amdgcn_readfirstlane(F.ltid() >> 6);
    typedef float f32x2v __attribute__((ext_vector_type(2)));
    LAS f32x2v* st = (LAS f32x2v*)(F.lds + GM_ST); LAS unsigned char* vt = F.lds + GM_VT;
    const bf16* Z = F.Z;
    __syncthreads();
#pragma unroll
    for (int hb = 0; hb < 2; ++hb) {
        v4u va[8], vb[8];
#pragma unroll
        for (int i = 0; i < 8; ++i) { const bf16* vp = Z + (size_t)(row0 + wid * 16 + hb * 8 + i) * INW + BU_OFF + BW + lane * 16; va[i] = *(const GAS v4u*)(vp); vb[i] = *(const GAS v4u*)(vp + 8); }
#pragma unroll
        for (int i = 0; i < 8; ++i) { const v4u a = va[i], b2 = vb[i];
            const float x[16] = {bflo(a.x), bfhi(a.x), bflo(a.y), bfhi(a.y), bflo(a.z), bfhi(a.z), bflo(a.w), bfhi(a.w), bflo(b2.x), bfhi(b2.x), bflo(b2.y), bfhi(b2.y), bflo(b2.z), bfhi(b2.z), bflo(b2.w), bfhi(b2.w)};
            float s = 0.f;
#pragma unroll
            for (int e = 0; e < 16; ++e) s += x[e];
            const float mean = wave_sum(s) * (1.0f / 1024.0f); float q = 0.f;
#pragma unroll
            for (int e = 0; e < 16; ++e) { const float dd = x[e] - mean; q += dd * dd; }
            const float rstd = 1.0f / sqrtf(wave_sum(q) * (1.0f / 1024.0f) + LN_EPS);
            if (lane == 0) st[wid * 16 + hb * 8 + i] = (f32x2v){mean, rstd}; }
    }
    const float* lng = F.gln_g + (size_t)l * BW; const float* lnb = F.gln_b + (size_t)l * BW;
    const int j = tid & 127, cc = tid >> 7;
    const int fr = lane & 15, fq = lane >> 4, tok = wid * 16 + fr;
    const bf16* vsrc = Z + (size_t)(row0 + j) * INW + BU_OFF + BW + cc * 32;
    v4u vr[4];
#pragma unroll
    for (int q4 = 0; q4 < 4; ++q4) vr[q4] = *(const GAS v4u*)(vsrc + q4 * 8);
    __syncthreads();
    const f32x2v sj = st[j];
#pragma unroll 1
    for (int g = 0; g < 8; ++g) {
        bf16x8 wf[4]; v2u uu[8];
        const bf16* wg = F.Wsp + ((size_t)l * 8 + g) * 16384 + (size_t)tok * 128 + fq * 8;
#pragma unroll
        for (int ks = 0; ks < 4; ++ks) wf[ks] = *(const GAS bf16x8*)(wg + ks * 32);
        const bf16* up = Z + (size_t)(row0 + tok) * INW + BU_OFF + g * 128 + 4 * fq;
#pragma unroll
        for (int ct = 0; ct < 8; ++ct) uu[ct] = *(const GAS v2u*)(up + ct * 16);
        const float bias = F.b_sp[((size_t)l * 8 + g) * 128 + tok];
#pragma unroll
        for (int q4 = 0; q4 < 4; ++q4) { const v4u a = vr[q4]; const int c0 = cc * 32 + q4 * 8;
            const f32x4 g0 = *(const f32x4*)(lng + g * 128 + c0), g1 = *(const f32x4*)(lng + g * 128 + c0 + 4), b0 = *(const f32x4*)(lnb + g * 128 + c0), b1 = *(const f32x4*)(lnb + g * 128 + c0 + 4);
            const float xv[8] = {bflo(a.x), bfhi(a.x), bflo(a.y), bfhi(a.y), bflo(a.z), bfhi(a.z), bflo(a.w), bfhi(a.w)};
#pragma unroll
            for (int e = 0; e < 8; ++e) { const float gg = e < 4 ? g0[e & 3] : g1[e & 3], bb = e < 4 ? b0[e & 3] : b1[e & 3]; const float y = (xv[e] - sj.x) * sj.y * gg + bb;
                *(LAS bf16*)(vt + (c0 + e) * GM_VP + j * 2) = (bf16)f2bf(y); } }
        if (g < 7) {
#pragma unroll
            for (int q4 = 0; q4 < 4; ++q4) vr[q4] = *(const GAS v4u*)(vsrc + (g + 1) * 128 + q4 * 8);
        }
        __syncthreads();
#pragma unroll
        for (int ct = 0; ct < 8; ++ct) { f32x4 acc = {0.f, 0.f, 0.f, 0.f};
#pragma unroll
            for (int ks = 0; ks < 4; ++ks) { const bf16x8 af = *(const LAS bf16x8*)(vt + (ct * 16 + fr) * GM_VP + (ks * 32 + fq * 8) * 2); acc = __builtin_amdgcn_mfma_f32_16x16x32_bf16(af, wf[ks], acc, 0, 0, 0); }
            const v2u u2 = uu[ct];
            v2u w; w.x = cvtpk(bflo(u2.x) * (acc[0] + bias), bfhi(u2.x) * (acc[1] + bias)); w.y = cvtpk(bflo(u2.y) * (acc[2] + bias), bfhi(u2.y) * (acc[3] + bias));
            *(GAS v2u*)(F.Y + (size_t)(row0 + tok) * YW + BW + g * 128 + ct * 16 + 4 * fq) = w; }
        __syncthreads();
    }
}

constexpr int PL_DP = 528;
template <int GI> __device__ __forceinline__ void pool_unit(Frame& F, int row0, int l) {
    int tid_ = F.ltid(); asm volatile("" : "+v"(tid_)); const int tid = tid_, lane = tid & 63, wid = __builtin_amdgcn_readfirstlane(F.ltid() >> 6);
    LAS unsigned char* dt = F.lds;
    const bf16* Z = F.Z;
    constexpr int W = 2 << GI, HW = W / 2, NR = 8 + W - 1;
    const int seqlen = row0 < MLAT ? SEQ : CTXL; const int s0 = row0 < MLAT ? (row0 & ~(SEQ - 1)) : MLAT + ((row0 - MLAT) & ~(CTXL - 1));
    const int fr = lane & 15, fq = lane >> 4;
    bf16x8 wa[8][2];
    { const bf16* wp = F.Wpool + ((size_t)l * 4 + GI) * 65536 + (size_t)(wid * 32 + fr) * 256 + fq * 8;
#pragma unroll
      for (int ks = 0; ks < 8; ++ks) { wa[ks][0] = *(const GAS bf16x8*)(wp + ks * 32); wa[ks][1] = *(const GAS bf16x8*)(wp + 16 * 256 + ks * 32); } }
    __syncthreads();
    { const int ch = tid & 31, tg = tid >> 5;
      const bf16* zc = Z + C_OFF + GI * 256 + ch * 8; const int p0 = row0 - s0 + tg * 8;
      v4u rw[NR];
#pragma unroll
      for (int k = 0; k < NR; ++k) { const int q = p0 - HW + k; const bool ok = (q >= 0) && (q < seqlen); const int qq = ok ? q : p0; const v4u a = *(const GAS v4u*)(zc + (size_t)(s0 + qq) * INW); rw[k] = ok ? a : (v4u){0u, 0u, 0u, 0u}; }
      float sum[8] = {0.f, 0.f, 0.f, 0.f, 0.f, 0.f, 0.f, 0.f};
#pragma unroll
      for (int k = 0; k < W; ++k) { const v4u a = rw[k]; sum[0] += bflo(a.x); sum[1] += bfhi(a.x); sum[2] += bflo(a.y); sum[3] += bfhi(a.y); sum[4] += bflo(a.z); sum[5] += bfhi(a.z); sum[6] += bflo(a.w); sum[7] += bfhi(a.w); }
#pragma unroll
      for (int i = 0; i < 8; ++i) { const int p = p0 + i; const int lo = p - HW < 0 ? 0 : p - HW; const int hi = p - HW + W > seqlen ? seqlen : p - HW + W; const float inv = 1.0f / (float)(hi - lo);
          const v4u zz = rw[i + HW];
          v4u o; o.x = pk2(sum[0] * inv - bflo(zz.x), sum[1] * inv - bfhi(zz.x)); o.y = pk2(sum[2] * inv - bflo(zz.y), sum[3] * inv - bfhi(zz.y));
          o.z = pk2(sum[4] * inv - bflo(zz.z), sum[5] * inv - bfhi(zz.z)); o.w = pk2(sum[6] * inv - bflo(zz.w), sum[7] * inv - bfhi(zz.w));
          *(LAS v4u*)(dt + (tg * 8 + i) * PL_DP + ch * 16) = o;
          if (i < 7) { const v4u a = rw[i + W], b = rw[i];
              sum[0] += bflo(a.x) - bflo(b.x); sum[1] += bfhi(a.x) - bfhi(b.x); sum[2] += bflo(a.y) - bflo(b.y); sum[3] += bfhi(a.y) - bfhi(b.y);
              sum[4] += bflo(a.z) - bflo(b.z); sum[5] += bfhi(a.z) - bfhi(b.z); sum[6] += bflo(a.w) - bflo(b.w); sum[7] += bfhi(a.w) - bfhi(b.w); } } }
    __syncthreads();
    { f32x4 acc[2][8];
#pragma unroll
      for (int a = 0; a < 2; ++a)
#pragma unroll
          for (int tt = 0; tt < 8; ++tt) acc[a][tt] = (f32x4){0.f, 0.f, 0.f, 0.f};
#pragma unroll
      for (int ks = 0; ks < 8; ++ks) {
#pragma unroll
          for (int tt = 0; tt < 8; ++tt) { const bf16x8 bfr = *(const LAS bf16x8*)(dt + (tt * 16 + fr) * PL_DP + (ks * 32 + fq * 8) * 2);
              acc[0][tt] = __builtin_amdgcn_mfma_f32_16x16x32_bf16(wa[ks][0], bfr, acc[0][tt], 0, 0, 0); acc[1][tt] = __builtin_amdgcn_mfma_f32_16x16x32_bf16(wa[ks][1], bfr, acc[1][tt], 0, 0, 0); } }
      const float* ps = F.pool_scale + (size_t)l * BW + GI * 256;
#pragma unroll
      for (int a = 0; a < 2; ++a) { const int dd = wid * 32 + a * 16 + 4 * fq; const f32x4 sc = *(const f32x4*)(ps + dd);
#pragma unroll
          for (int tt = 0; tt < 8; ++tt) { const f32x4 v = acc[a][tt] * sc; v2u wv; wv.x = cvtpk(v[0], v[1]); wv.y = cvtpk(v[2], v[3]);
              *(GAS v2u*)(F.Y + (size_t)(row0 + tt * 16 + fr) * YW + 2 * BW + GI * 256 + dd) = wv; } } }
}
__device__ __forceinline__ void pool_dispatch(Frame& F, int row0, int g, int l) {
    if (g == 0) pool_unit<0>(F, row0, l); else if (g == 1) pool_unit<1>(F, row0, l); else if (g == 2) pool_unit<2>(F, row0, l); else pool_unit<3>(F, row0, l);
}

#ifndef MIXM
#define MIXM 7
#endif
__device__ __forceinline__ void phase_mixers(Frame& F, int l, float lam_init) {
    const bool last = (l == DEPTH - 1);
    float d01 = 0.f, d23 = 0.f; const float* lq = F.lam_qk + (size_t)l * 256;
    for (int i = 0; i < 64; ++i) { d01 += lq[i] * lq[64 + i]; d23 += lq[128 + i] * lq[192 + i]; }
    const float lam = __expf(d01) - __expf(d23) + lam_init; const float oscale = 1.0f - lam_init;
    const float* subg = F.subln_g + (size_t)l * 128;
#ifndef REP_ATT
#define REP_ATT 1
#endif
#ifndef REP_GP
#define REP_GP 1
#endif
#pragma nounroll
    for (int i = 0; i < 5 * REP_ATT; ++i) { const int uid = F.vcu + F.G * (i % 5);
        if (!(MIXM & 1)) continue;
        if (uid < 1024) attn_unit(F, uid >> 8, (uid >> 5) & 7, uid & 31, false, lam, oscale, subg);
        else if (!last && uid < 1088) attn_unit(F, (uid - 1024) >> 4, ((uid - 1024) >> 1) & 7, uid & 1, true, lam, oscale, subg);
        if (TAILWORK == 2 && !last && i == (F.vcu & 3)) { __syncthreads(); const int gw_ = F.vcu * NWAVES + __builtin_amdgcn_readfirstlane(F.ltid() >> 6); ada_partial_layer(F, l + 1, gw_, F.G * NWAVES); cvt_layer(F, l + 1, gw_, F.G * NWAVES); } }
    const int nchunk = last ? MLAT / 128 : MTOT / 128;
#pragma nounroll
    for (int rgp = 0; rgp < REP_GP; ++rgp) {
    if (MIXM & 2) for (int cidx = F.G - 1 - F.vcu; cidx < nchunk; cidx += F.G) gmlp_unit(F, cidx * 128, l);
    if (MIXM & 4) { const int nfree = F.G - nchunk, npool = nchunk * 4;
        if (nfree > 0 && F.G == 256) {
            if (F.vcu < nfree) { for (int k = 0; k < 4; ++k) { const int u = F.vcu * 4 + k; if (u < npool) pool_dispatch(F, (u >> 2) * 128, u & 3, l); } }
            else { for (int u = nfree * 4 + (F.vcu - nfree); u < npool; u += nchunk) pool_dispatch(F, (u >> 2) * 128, u & 3, l); }
        } else { for (int u = F.vcu; u < npool; u += F.G) pool_dispatch(F, (u >> 2) * 128, u & 3, l); } }
    }
    __syncthreads();
}

#ifndef WGM_P1
#define WGM_P1 4
#endif
#ifndef WGM_P5
#define WGM_P5 4
#endif
#ifndef WGM_N8
#define WGM_N8 4
#endif
#ifndef SP2_BIG
#define SP2_BIG true
#endif
#ifndef ALIGN_BIG
#define ALIGN_BIG true
#endif
#ifndef STAGGER
#define STAGGER 0
#endif
__device__ __forceinline__ void phase_stagger(int slot) { if (STAGGER) for (int i = 0; i < slot * 3; ++i) __builtin_amdgcn_s_sleep(8); }
#ifndef MK_ONE_LAUNCH
#define MK_ONE_LAUNCH 1
#endif
constexpr int NPHASE = 3 + 8 * DEPTH;
struct Args { const float* in[23]; float* out; unsigned char* ws; int ph_lo, ph_hi; float lam_init[4]; };
__global__ void __launch_bounds__(NWAVES * 64, 2) fwd(Args args) {
    extern __shared__ __attribute__((aligned(16))) unsigned char lds[];
    Frame F;
    F.lds = (LAS unsigned char*)lds;
    F.MISC = (volatile LAS unsigned*)(F.lds + MISC_OFF);
    F.G = gridDim.x; { const int bx = blockIdx.x; F.bx = bx; F.vcu = (F.G % 8 == 0) ? (bx % 8) * (F.G / 8) + bx / 8 : bx; }
    unsigned char* ws = args.ws;
    F.ctl = (gu32*)(ws + WS_CTL);
    frame_ptrs(F);
    for (int u = F.ltid(); u < (LDS_BYTES - LDSCTL_OFF) / 4; u += NWAVES * 64) ((LAS unsigned*)(F.lds + LDSCTL_OFF))[u] = 0u;
    __syncthreads();
#if MK_ONE_LAUNCH
    constexpr int lo = 0, hi = NPHASE; constexpr bool use_bar = true;
#else
    const int lo = args.ph_lo, hi = args.ph_hi;
    const bool use_bar = (hi - lo) > 1;
#endif
    XcdBarrier bar; bar.bar = (unsigned*)(F.ctl + CW_BAR); bar.x = 0; bar.st = nullptr;
    if (use_bar) bar = xcd_barrier_post((unsigned*)(F.ctl + CW_BAR), F.MISC + 8);
#ifndef PHM
#define PHM 0xFFFF
#endif
#define IN(k) (lo <= (k) && (k) < hi)
#define KIND(b) ((PHM >> (b)) & 1)
#ifndef REP_MASK
#define REP_MASK 0
#endif
#define NREP(b) (((REP_MASK >> (b)) & 1) ? 2 : 1)
#define BARRIER() do { XcdBarrier b_ = bar; asm volatile("" : "+s"(b_.x)); xcd_barrier(b_); } while (0)
#ifndef DRY_EPI
#define DRY_EPI 0
#endif
#ifndef BAR_REP
#define BAR_REP 1
#endif
#define SEAM(k) do { if (IN(k) && IN((k) + 1)) { for (int br_ = 0; br_ < BAR_REP; ++br_) BARRIER(); } } while (0)

    if (KIND(0) && IN(0)) { for (int rep = 0; rep < NREP(0); ++rep) { frame_ptrs(F); phase_a1(F); if (rep + 1 < NREP(0)) BARRIER(); } } SEAM(0);
    if (KIND(1) && IN(1)) { frame_ptrs(F); phase_a2(F); } SEAM(1);
    if (KIND(2) && IN(2)) { frame_ptrs(F); phase_a3(F); } SEAM(2);

#pragma nounroll
    for (int l = 0; l < DEPTH; ++l) {
        const int pb = 3 + 8 * l; const bool last = (l == DEPTH - 1);
        { int g_ = F.G, v_ = F.vcu, b_ = F.bx; asm volatile("" : "+s"(g_), "+s"(v_), "+s"(b_)); F.G = g_; F.vcu = v_; F.bx = b_; }
        const int Mrows = last ? MLAT : MTOT;
        if (KIND(3) && IN(pb + 0)) for (int rep = 0; rep < NREP(3); ++rep) { if (rep) BARRIER(); frame_ptrs(F);
            pg8::Gemm g{F.HA, F.Win + (size_t)l * INW * D, MTOT, INW, D, D, D}; pg8::StaticOrder S; S.init(MTOT, INW, F.G, F.bx, WGM_P1);
            pg8::EpiInProj E{F.Z, F.rope, QSCALE, INW, MLAT, F.KB, F.VB, (rep && DRY_EPI) ? 1 : 0};
            phase_stagger((F.bx >> 3) & 7);
            pg8::gemm_phase<pg8::EpiInProj, pg8::StaticOrder, ALIGN_BIG, SP2_BIG>(F.lds + RING_OFF, g, S, E);
        }
        SEAM(pb + 0);
        if (KIND(4) && IN(pb + 1)) for (int rep = 0; rep < NREP(4); ++rep) { if (rep) BARRIER(); frame_ptrs(F); phase_mixers(F, l, args.lam_init[l]); }
        SEAM(pb + 1);
        if (KIND(5) && IN(pb + 2)) for (int rep = 0; rep < NREP(5); ++rep) { if (rep) BARRIER(); frame_ptrs(F);
            pg8::Gemm g{F.Y, F.Wbr + (size_t)l * D * YW, Mrows, D, YW, YW, YW}; pg8::StaticOrder S; S.init(Mrows, D, F.G, F.bx, WGM_N8);
            pg8::EpiGate E{F.Z + G_OFF, INW, F.MG, D};
            pg8::gemm_phase<pg8::EpiGate, pg8::StaticOrder, true, true>(F.lds + RING_OFF, g, S, E);
        }
        SEAM(pb + 2);
        if (KIND(6) && IN(pb + 3)) for (int rep = 0; rep < NREP(6); ++rep) { if (rep) BARRIER(); frame_ptrs(F);
            void* tw = rep ? (void*)(F.Z + (size_t)134 * MiB) : (void*)F.Y;
            { pg8::Gemm g{F.MG, F.Wout + (size_t)l * D * D, MLAT, D, D, D, D}; pg8::StaticOrder S; S.init(MLAT, D, F.G, F.bx, WGM_N8);
              pg8::EpiResidT<false> E{F.mods + (size_t)l * 5 * INW + 2 * D, INW, tw, D, 1, MLAT};
              pg8::gemm_phase<pg8::EpiResidT<false>, pg8::StaticOrder, true, true>(F.lds + RING_OFF, g, S, E); }
            if (!last) { pg8::Gemm g{F.MG, F.Wout + (size_t)l * D * D, MTOT, D, 256, D, D}; pg8::SplitOrder S; S.init(MLAT / 256, 32, 8, 256, F.G, F.bx);
              pg8::EpiResidT<true> E{F.mods + (size_t)l * 5 * INW + 2 * D, INW, rep ? (void*)(F.Z + (size_t)170 * MiB) : (void*)(F.Z + (size_t)100 * MiB), D, 256, MLAT};
              pg8::gemm_phase<pg8::EpiResidT<true>, pg8::SplitOrder, true, true>(F.lds + RING_OFF, g, S, E); }
            if (TAILWORK == 1 && !last && F.bx >= 32 && rep == 0) ada_partial_layer(F, l + 1, (F.bx - 32) * NWAVES + __builtin_amdgcn_readfirstlane(F.ltid() >> 6), (F.G - 32) * NWAVES);
        }
        SEAM(pb + 3);
        if (KIND(7) && IN(pb + 4)) { frame_ptrs(F); if (NREP(7) > 1) { phase_ln(F, F.ln1_g + (size_t)l * D, F.ln1_b + (size_t)l * D, Mrows, false, true, l, 3 * D, last ? 0 : 8, true); BARRIER(); frame_ptrs(F); }
            phase_ln(F, F.ln1_g + (size_t)l * D, F.ln1_b + (size_t)l * D, Mrows, false, true, l, 3 * D, last ? 0 : 8); if (TAILWORK && !last) mods_reduce_layer(F, l + 1); }
        SEAM(pb + 4);
        if (KIND(8) && IN(pb + 5)) for (int rep = 0; rep < NREP(8); ++rep) { if (rep) BARRIER(); frame_ptrs(F);
            pg8::Gemm g{F.HA, F.Wgu + (size_t)l * 2 * FFH * D, Mrows, 2 * FFH, D, D, D}; pg8::StaticOrder S; S.init(Mrows, 2 * FFH, F.G, F.bx, WGM_P5);
            pg8::EpiSwiglu E{F.Z, FFH};
            phase_stagger((F.bx >> 3) & 7);
            pg8::gemm_phase<pg8::EpiSwiglu, pg8::StaticOrder, ALIGN_BIG, SP2_BIG>(F.lds + RING_OFF, g, S, E);
        }
        SEAM(pb + 5);
        if (KIND(9) && IN(pb + 6)) for (int rep = 0; rep < NREP(9); ++rep) { if (rep) BARRIER(); frame_ptrs(F);
            void* tw = rep ? (void*)(F.Z + (size_t)134 * MiB) : (void*)F.Y;
            { pg8::Gemm g{F.Z, F.Wdn + (size_t)l * D * FFH, MLAT, D, FFH, FFH, FFH}; pg8::StaticOrder S; S.init(MLAT, D, F.G, F.bx, WGM_N8);
              pg8::EpiResidT<false> E{F.mods + (size_t)l * 5 * INW + 5 * D, INW, tw, D, 1, MLAT};
              pg8::gemm_phase<pg8::EpiResidT<false>, pg8::StaticOrder, true, true>(F.lds + RING_OFF, g, S, E); }
            if (!last) { pg8::Gemm g{F.Z, F.Wdn + (size_t)l * D * FFH, MTOT, D, FFH / 4, FFH, FFH}; pg8::SplitOrder S; S.init(MLAT / 256, 32, 4, FFH / 4, F.G, F.bx);
              pg8::EpiResidT<true> E{F.mods + (size_t)l * 5 * INW + 5 * D, INW, rep ? (void*)(F.Z + (size_t)170 * MiB) : (void*)(F.Z + (size_t)100 * MiB), D, FFH / 4, MLAT};
              pg8::gemm_phase<pg8::EpiResidT<true>, pg8::SplitOrder, true, true>(F.lds + RING_OFF, g, S, E); }
            if (TAILWORK == 1 && !last && F.bx >= 32 && rep == 0) { __syncthreads(); cvt_layer(F, l + 1, (F.bx - 32) * NWAVES + __builtin_amdgcn_readfirstlane(F.ltid() >> 6), (F.G - 32) * NWAVES); }
        }
        SEAM(pb + 6);
        if (KIND(7) && IN(pb + 7)) { frame_ptrs(F); phase_ln(F, F.ln2_g + (size_t)l * D, F.ln2_b + (size_t)l * D, Mrows, last, !last, last ? l : l + 1, 0, last ? 0 : 4); }
        if (!last) SEAM(pb + 7);
    }
#undef IN
#undef SEAM
}

extern "C" void kernel_launch(void* const* d_in, const int* in_sizes, int n_in, void* d_out, int out_size, void* d_ws, size_t ws_size, hipStream_t stream) {
    static int grid = 0;
    if (grid == 0) {
        if (n_in != 23 || in_sizes[0] != MLAT * D || out_size != MLAT * D || ws_size < WS_END) {
            fprintf(stderr, "kernel_launch: unexpected shapes / workspace (n_in %d, in0 %d, out %d, ws %zu, need %zu); nothing launched\n", n_in, n_in > 0 ? in_sizes[0] : -1, out_size, ws_size, (size_t)WS_END); grid = -1; return; }
        int dev = 0, cus = 0, per_cu = 0;
        if (hipGetDevice(&dev) != hipSuccess || hipDeviceGetAttribute(&cus, hipDeviceAttributeMultiprocessorCount, dev) != hipSuccess) { grid = -1; return; }
        if (hipFuncSetAttribute((const void*)fwd, hipFuncAttributeMaxDynamicSharedMemorySize, LDS_BYTES) != hipSuccess) { fprintf(stderr, "kernel_launch: hipFuncSetAttribute failed\n"); grid = -1; return; }
        if (hipOccupancyMaxActiveBlocksPerMultiprocessor(&per_cu, (const void*)fwd, NWAVES * 64, LDS_BYTES) != hipSuccess || per_cu < 1) fprintf(stderr, "kernel_launch: occupancy query reports %d\n", per_cu);
        (void)hipGetLastError();
        grid = cus;
    }
    if (grid < 0) return;
    if (hipMemsetAsync((char*)d_ws + WS_CTL, 0, CTL_ZERO_BYTES, stream) != hipSuccess) return;
    Args a{};
    for (int i = 0; i < 23; ++i) a.in[i] = (const float*)d_in[i];
    a.out = (float*)d_out; a.ws = (unsigned char*)d_ws;
    for (int l = 0; l < DEPTH; ++l) a.lam_init[l] = (float)(0.8 - 0.6 * exp(-0.3 * (double)l));
#if MK_ONE_LAUNCH
    a.ph_lo = 0; a.ph_hi = NPHASE;
    hipLaunchKernelGGL(fwd, dim3(grid), dim3(NWAVES * 64), LDS_BYTES, stream, a);
#else
    for (int p = 0; p < NPHASE; ++p) { a.ph_lo = p; a.ph_hi = p + 1; hipLaunchKernelGGL(fwd, dim3(grid), dim3(NWAVES * 64), LDS_BYTES, stream, a); }
#endif
}
```

```cpp
#include <hip/hip_runtime.h>
#include <cstdio>
#include <cstdint>
#include <cmath>
namespace pg8 {
#define PG8_LAS __attribute__((address_space(3)))
typedef unsigned short bf16_t;
typedef short bf16x8 __attribute__((ext_vector_type(8)));
typedef float f32x4 __attribute__((ext_vector_type(4)));
typedef unsigned u32x4 __attribute__((ext_vector_type(4)));
constexpr int BM = 256, BK = 64, HALF = 128, HTB = HALF * BK * 2  , STAGE_BYTES = 8 * HTB, NXCD = 8, WGM = 4;

__host__ __device__ __forceinline__ int lds_byte(int r, int c) { const int st = (r >> 4) * 2 + (c >> 5), rr = r & 15, cc = c & 31, ob = rr * 64 + cc * 2; return st * 1024 + (ob ^ (((ob >> 9) & 1) << 5)); }
__host__ __device__ __forceinline__ void stage_rc(int b, int& R, int& C) { const int st = b / 1024, sb = b % 1024, swz = sb ^ (((sb >> 9) & 1) << 5); R = (st >> 1) * 16 + swz / 64; C = (st & 1) * 32 + (swz % 64) / 2; }
__host__ __device__ __forceinline__ int perm32(int rho) { const int n = rho >> 4, i = rho & 15; return 8 * (i >> 2) + 4 * n + (i & 3); }

struct Unit { int pm, pn, ka; };
struct Gemm { const bf16_t* A; const bf16_t* Bt; int M, N, K, lda, ldb; };

struct StaticOrder {
    int nM, nN, nwg, G, c, wgm;
    __host__ __device__ void init(int M, int N, int G_, int c_, int wgm_ = WGM) { nM = M / BM; nN = N / BM; nwg = nM * nN; G = G_; c = c_; wgm = wgm_; }
    __host__ __device__ bool next(int i, Unit& u) const {
        const long L = (long)i * G + c; if (L >= nwg) return false;
        int wgid = (int)L; { const int q = nwg / NXCD, r = nwg % NXCD, xcd = wgid % NXCD, off = wgid / NXCD; wgid = (xcd < r ? xcd * (q + 1) : r * (q + 1) + (xcd - r) * q) + off; }
        const int nig = wgm * nN, gid = wgid / nig, fm = gid * wgm, gsz = (nM - fm) < wgm ? (nM - fm) : wgm;
        u.pm = fm + ((wgid % nig) % gsz); u.pn = (wgid % nig) / gsz; u.ka = 0; return true;
    }
    __device__ __forceinline__ void a_ready(const Unit&) const {}
    __device__ __forceinline__ void done(const Unit&) const {}
};

struct SplitOrder {
    int nsplit, klen, G, c, pm0, ntile;
    __host__ __device__ void init(int pm0_, int ntile_, int nsplit_, int klen_, int G_, int c_) { pm0 = pm0_; ntile = ntile_; nsplit = nsplit_; klen = klen_; G = G_; c = c_; }
    __host__ __device__ bool next(int i, Unit& u) const { const int L = i * G + c; if (L >= ntile * nsplit) return false; const int tt = L / nsplit; u.pm = pm0 + (tt & 3); u.pn = tt >> 2; u.ka = (L - tt * nsplit) * klen; return true; }
    __device__ __forceinline__ void a_ready(const Unit&) const {}
    __device__ __forceinline__ void done(const Unit&) const {}
};
__device__ __forceinline__ unsigned cvt_pk_bf16(float lo, float hi) { unsigned r; asm volatile("v_cvt_pk_bf16_f32 %0, %1, %2" : "=v"(r) : "v"(lo), "v"(hi)); return r; }
typedef float f32x2 __attribute__((ext_vector_type(2)));
__device__ __forceinline__ f32x2 gelu_pk(f32x2 v) {
    const f32x2 av = __builtin_elementwise_abs(v), d = av * 0.2316418882f + 1.0f;
    f32x2 t; t.x = __builtin_amdgcn_rcpf(d.x); t.y = __builtin_amdgcn_rcpf(d.y);
    f32x2 q = t * 0.5307027145f + (-0.7265760135f); q = q * t + 0.7107068705f; q = q * t + (-0.142248368f); q = q * t + 0.127414796f; q = q * t;
    const f32x2 s = (v * v) * (-0.72134752044f);
    f32x2 e; e.x = __builtin_amdgcn_exp2f(s.x); e.y = __builtin_amdgcn_exp2f(s.y);
    const f32x2 m = v * (q * e), r = v - m;
    f32x2 o; o.x = v.x < 0.f ? m.x : r.x; o.y = v.y < 0.f ? m.y : r.y; return o;
}

#ifndef GATE_NT
#define GATE_NT 0
#endif
#if GATE_NT
#define GATE_LD(p) __builtin_nontemporal_load(p)
#else
#define GATE_LD(p) (*(p))
#endif
#ifndef GATE_ST_NT
#define GATE_ST_NT 0
#endif
#ifndef EPI_NT
#define EPI_NT 0
#endif
typedef unsigned u32x2 __attribute__((ext_vector_type(2)));
__device__ __forceinline__ float bf_lo(unsigned w) { return __uint_as_float(w << 16); }
__device__ __forceinline__ float bf_hi(unsigned w) { return __uint_as_float(w & 0xffff0000u); }
__device__ __forceinline__ void store8_bf16(bf16_t* p, const f32x4 v0, const f32x4 v1) {
    u32x4 w; w.x = cvt_pk_bf16(v0[0], v0[1]); w.y = cvt_pk_bf16(v0[2], v0[3]); w.z = cvt_pk_bf16(v1[0], v1[1]); w.w = cvt_pk_bf16(v1[2], v1[3]);
#if EPI_NT
    __builtin_nontemporal_store(w, (u32x4*)p);
#else
    *(u32x4*)p = w;
#endif
}
__device__ __forceinline__ float sigmoid_f(float x) { return __builtin_amdgcn_rcpf(1.0f + __builtin_amdgcn_exp2f(x * -1.4426950408889634f)); }

struct EpiInProj {
    static constexpr bool PERM = true, AFTER_DRAIN = false; static constexpr int KSEG = 0;
    bf16_t* Z; const float* rope; float qscale; int ldc; int nlat; bf16_t* Kb; bf16_t* Vb; int dry;
    __device__ __forceinline__ void kseg(f32x4 (&)[2][2][4][2], const Unit&, int, int, int, int, int) const {}
    __device__ __forceinline__ void operator()(const f32x4 (&acc)[2][2][4][2], const Unit& u, int wr, int wc, int fr, int fq) const {
        const int pn = u.pn; const int row0 = u.pm * BM + wr * 64 + fr; const int col0 = pn * BM + wc * 32 + 8 * fq;
        if (dry) { float s_ = 0.f;
#pragma unroll
            for (int a_ = 0; a_ < 2; ++a_)
#pragma unroll
                for (int b_ = 0; b_ < 2; ++b_)
#pragma unroll
                    for (int m_ = 0; m_ < 4; ++m_)
#pragma unroll
                        for (int n_ = 0; n_ < 2; ++n_) s_ += acc[a_][b_][m_][n_][0];
            if (s_ != s_) Z[0] = 0; return; }
        if (pn < 8) {
            const float sc = pn < 4 ? qscale : 1.0f;
#pragma unroll
            for (int ai = 0; ai < 2; ++ai)
#pragma unroll
                for (int m = 0; m < 4; ++m) {
                    const int row = row0 + ai * HALF + m * 16; const int t = row & 4095; const int pos = (wc & 1) ? (t & 63) : (t >> 6);
                    f32x4 cs0 = *(const f32x4*)(rope + (pos * 16 + 4 * fq) * 2), cs1 = *(const f32x4*)(rope + (pos * 16 + 4 * fq) * 2 + 4);
                    if (row >= nlat) { cs0 = (f32x4){1.f, 0.f, 1.f, 0.f}; cs1 = cs0; }
                    bf16_t* rowp = Z + (size_t)row * ldc + col0;
                    if (pn >= 4) { const int bb = row < nlat ? (row >> 12) : ((row - nlat) >> 8), key = row < nlat ? 256 + (row & 4095) : ((row - nlat) & 255);
                        rowp = Kb + ((size_t)(bb * 8 + 2 * (pn - 4)) * 4352 + key) * 128 + wc * 32 + 8 * fq; }
#pragma unroll
                    for (int bj = 0; bj < 2; ++bj) {
                        const f32x4 a = acc[ai][bj][m][0], b = acc[ai][bj][m][1];
                        f32x4 o0, o1;
                        o0[0] = (a[0] * cs0[0] - a[1] * cs0[1]) * sc; o0[1] = (a[0] * cs0[1] + a[1] * cs0[0]) * sc;
                        o0[2] = (a[2] * cs0[2] - a[3] * cs0[3]) * sc; o0[3] = (a[2] * cs0[3] + a[3] * cs0[2]) * sc;
                        o1[0] = (b[0] * cs1[0] - b[1] * cs1[1]) * sc; o1[1] = (b[0] * cs1[1] + b[1] * cs1[0]) * sc;
                        o1[2] = (b[2] * cs1[2] - b[3] * cs1[3]) * sc; o1[3] = (b[2] * cs1[3] + b[3] * cs1[2]) * sc;
                        store8_bf16(rowp + (pn >= 4 ? (size_t)bj * 4352 * 128 : (size_t)bj * HALF), o0, o1);
                    }
                }
        } else if (pn < 12) {
#pragma unroll
            for (int ai = 0; ai < 2; ++ai)
#pragma unroll
                for (int m = 0; m < 4; ++m) { const int row = row0 + ai * HALF + m * 16; const int bb = row < nlat ? (row >> 12) : ((row - nlat) >> 8), key = row < nlat ? 256 + (row & 4095) : ((row - nlat) & 255);
                    bf16_t* rowp = Vb + ((size_t)(bb * 8 + 2 * (pn - 8)) * 4352 + key) * 128 + wc * 32 + 8 * fq;
#pragma unroll
                    for (int bj = 0; bj < 2; ++bj) store8_bf16(rowp + (size_t)bj * 4352 * 128, acc[ai][bj][m][0], acc[ai][bj][m][1]); }
        } else if (pn >= 20 && pn < 24) {
#pragma unroll
            for (int ai = 0; ai < 2; ++ai)
#pragma unroll
                for (int m = 0; m < 4; ++m) { bf16_t* rowp = Z + (size_t)(row0 + ai * HALF + m * 16) * ldc + col0;
#pragma unroll
                    for (int bj = 0; bj < 2; ++bj) store8_bf16(rowp + bj * HALF, acc[ai][bj][m][0], acc[ai][bj][m][1]); }
        } else if (pn < 20) {
#pragma unroll
            for (int ai = 0; ai < 2; ++ai)
#pragma unroll
                for (int m = 0; m < 4; ++m) { bf16_t* rowp = Z + (size_t)(row0 + ai * HALF + m * 16) * ldc + col0;
#pragma unroll
                    for (int bj = 0; bj < 2; ++bj) { const f32x4 v0 = acc[ai][bj][m][0], v1 = acc[ai][bj][m][1];
                        const f32x2 a = gelu_pk((f32x2){v0[0], v0[1]}), b = gelu_pk((f32x2){v0[2], v0[3]}), c = gelu_pk((f32x2){v1[0], v1[1]}), d = gelu_pk((f32x2){v1[2], v1[3]});
                        store8_bf16(rowp + bj * HALF, (f32x4){a.x, a.y, b.x, b.y}, (f32x4){c.x, c.y, d.x, d.y}); } }
        } else {
#pragma unroll
            for (int ai = 0; ai < 2; ++ai)
#pragma unroll
                for (int m = 0; m < 4; ++m) { bf16_t* rowp = Z + (size_t)(row0 + ai * HALF + m * 16) * ldc + col0;
#pragma unroll
                    for (int bj = 0; bj < 2; ++bj) { const f32x4 v0 = acc[ai][bj][m][0], v1 = acc[ai][bj][m][1]; f32x4 o0, o1;
#pragma unroll
                        for (int i = 0; i < 4; ++i) { o0[i] = __builtin_fmaxf(sigmoid_f(v0[i]), 1e-12f); o1[i] = __builtin_fmaxf(sigmoid_f(v1[i]), 1e-12f); }
#if GATE_ST_NT
                        { u32x4 w; w.x = cvt_pk_bf16(o0[0], o0[1]); w.y = cvt_pk_bf16(o0[2], o0[3]); w.z = cvt_pk_bf16(o1[0], o1[1]); w.w = cvt_pk_bf16(o1[2], o1[3]); __builtin_nontemporal_store(w, (u32x4*)(rowp + bj * HALF)); } } }
#else
                        store8_bf16(rowp + bj * HALF, o0, o1); } }
#endif
        }
    }
};

struct EpiGate {
    static constexpr bool PERM = true, AFTER_DRAIN = false; static constexpr int KSEG = 16;
    const bf16_t* G; int ldg; bf16_t* O; int ldo;
    __device__ __forceinline__ void kseg(f32x4 (&acc)[2][2][4][2], const Unit& u, int seg, int wr, int wc, int fr, int fq) const {
        const int row0 = u.pm * BM + wr * 64 + fr; const int col0 = u.pn * BM + wc * 32 + 8 * fq;
#pragma unroll
        for (int ai = 0; ai < 2; ++ai) {
            u32x4 ga[4][2], gb[4][2];
#pragma unroll
            for (int m = 0; m < 4; ++m) { const bf16_t* gp = G + (size_t)(row0 + ai * HALF + m * 16) * ldg + (seg - 1) * 2048 + col0;
#pragma unroll
                for (int bj = 0; bj < 2; ++bj) { ga[m][bj] = GATE_LD((const u32x4*)(gp + bj * HALF)); gb[m][bj] = GATE_LD((const u32x4*)(gp + 2048 + bj * HALF)); } }
#pragma unroll
            for (int m = 0; m < 4; ++m)
#pragma unroll
                for (int bj = 0; bj < 2; ++bj) { const u32x4 a = ga[m][bj], b = gb[m][bj];
                    f32x4 r0, r1;
                    r0[0] = bf_lo(a.x) * __builtin_amdgcn_rcpf(bf_lo(b.x)); r0[1] = bf_hi(a.x) * __builtin_amdgcn_rcpf(bf_hi(b.x));
                    r0[2] = bf_lo(a.y) * __builtin_amdgcn_rcpf(bf_lo(b.y)); r0[3] = bf_hi(a.y) * __builtin_amdgcn_rcpf(bf_hi(b.y));
                    r1[0] = bf_lo(a.z) * __builtin_amdgcn_rcpf(bf_lo(b.z)); r1[1] = bf_hi(a.z) * __builtin_amdgcn_rcpf(bf_hi(b.z));
                    r1[2] = bf_lo(a.w) * __builtin_amdgcn_rcpf(bf_lo(b.w)); r1[3] = bf_hi(a.w) * __builtin_amdgcn_rcpf(bf_hi(b.w));
                    acc[ai][bj][m][0] *= r0; acc[ai][bj][m][1] *= r1; }
            asm volatile("" ::: "memory"); }
    }
    __device__ __forceinline__ void operator()(const f32x4 (&acc)[2][2][4][2], const Unit& u, int wr, int wc, int fr, int fq) const {
        const int row0 = u.pm * BM + wr * 64 + fr; const int col0 = u.pn * BM + wc * 32 + 8 * fq;
        u32x4 gg[2][4][2];
#pragma unroll
        for (int ai = 0; ai < 2; ++ai)
#pragma unroll
            for (int m = 0; m < 4; ++m) { const bf16_t* gp = G + (size_t)(row0 + ai * HALF + m * 16) * ldg + 2 * 2048 + col0;
#pragma unroll
                for (int bj = 0; bj < 2; ++bj) gg[ai][m][bj] = GATE_LD((const u32x4*)(gp + bj * HALF)); }
#pragma unroll
        for (int ai = 0; ai < 2; ++ai)
#pragma unroll
            for (int m = 0; m < 4; ++m) { bf16_t* op = O + (size_t)(row0 + ai * HALF + m * 16) * ldo + col0;
#pragma unroll
                for (int bj = 0; bj < 2; ++bj) { const u32x4 g = gg[ai][m][bj];
                    const f32x4 g0 = (f32x4){bf_lo(g.x), bf_hi(g.x), bf_lo(g.y), bf_hi(g.y)}, g1 = (f32x4){bf_lo(g.z), bf_hi(g.z), bf_lo(g.w), bf_hi(g.w)};
                    store8_bf16(op + bj * HALF, acc[ai][bj][m][0] * g0, acc[ai][bj][m][1] * g1); } }
    }
};

template <bool SLAB> struct EpiResidT {
    static constexpr bool PERM = !SLAB, AFTER_DRAIN = false; static constexpr int KSEG = 0;
    const float* gv; int gstride; void* Tw; int ldc; int klen, nlat;
    __device__ __forceinline__ void kseg(f32x4 (&)[2][2][4][2], const Unit&, int, int, int, int, int) const {}
    __device__ __forceinline__ void operator()(const f32x4 (&acc)[2][2][4][2], const Unit& u, int wr, int wc, int fr, int fq) const {
        const int row0 = u.pm * BM + wr * 64 + fr; const int grp = u.pm < 64 ? (u.pm >> 4) : 4;
        if constexpr (SLAB) {
            const int col0 = u.pn * BM + wc * 32 + 4 * fq;
            f32x4 g[2][2];
#pragma unroll
            for (int bj = 0; bj < 2; ++bj)
#pragma unroll
                for (int n = 0; n < 2; ++n) g[bj][n] = *(const f32x4*)(gv + (size_t)grp * gstride + col0 + bj * HALF + n * 16);
#pragma unroll
            for (int ai = 0; ai < 2; ++ai)
#pragma unroll
                for (int m = 0; m < 4; ++m) { float* pp = (float*)Tw + ((size_t)(u.ka / klen) * 1024 + (size_t)(row0 + ai * HALF + m * 16 - nlat)) * ldc + col0;
#pragma unroll
                    for (int bj = 0; bj < 2; ++bj)
#pragma unroll
                        for (int n = 0; n < 2; ++n) *(f32x4*)(pp + bj * HALF + n * 16) = g[bj][n] * acc[ai][bj][m][n]; }
        } else {
            const int col0 = u.pn * BM + wc * 32 + 8 * fq;
            f32x4 g[2][2];
#pragma unroll
            for (int bj = 0; bj < 2; ++bj)
#pragma unroll
                for (int n = 0; n < 2; ++n) g[bj][n] = *(const f32x4*)(gv + (size_t)grp * gstride + col0 + bj * HALF + n * 4);
#pragma unroll
            for (int ai = 0; ai < 2; ++ai)
#pragma unroll
                for (int m = 0; m < 4; ++m) { bf16_t* tp = (bf16_t*)Tw + (size_t)(row0 + ai * HALF + m * 16) * ldc + col0;
#pragma unroll
                    for (int bj = 0; bj < 2; ++bj) store8_bf16(tp + bj * HALF, g[bj][0] * acc[ai][bj][m][0], g[bj][1] * acc[ai][bj][m][1]); }
        }
    }
};

struct EpiSwiglu {
    static constexpr bool PERM = true, AFTER_DRAIN = false; static constexpr int KSEG = 0;
    bf16_t* H; int ldc;
    __device__ __forceinline__ void kseg(f32x4 (&)[2][2][4][2], const Unit&, int, int, int, int, int) const {}
    __device__ __forceinline__ void operator()(const f32x4 (&acc)[2][2][4][2], const Unit& u, int wr, int wc, int fr, int fq) const {
        const int row0 = u.pm * BM + wr * 64 + fr, col0 = u.pn * HALF + wc * 32 + 8 * fq;
#pragma unroll
        for (int ai = 0; ai < 2; ++ai)
#pragma unroll
            for (int m = 0; m < 4; ++m) { bf16_t* rowp = H + (size_t)(row0 + ai * HALF + m * 16) * ldc + col0; f32x4 o[2];
#pragma unroll
                for (int n = 0; n < 2; ++n) { const f32x4 gt = acc[ai][0][m][n], up = acc[ai][1][m][n];
#pragma unroll
                    for (int i = 0; i < 4; ++i) o[n][i] = gt[i] * sigmoid_f(gt[i]) * up[i]; }
                store8_bf16(rowp, o[0], o[1]); }
    }
};
template <class Epi, class Sched, bool ALIGN_EPI = false, bool SP2 = false>
__device__ __forceinline__ void gemm_phase(PG8_LAS unsigned char* lds, const Gemm g, const Sched& S, const Epi& E) {
    int tid_ = threadIdx.x; asm volatile("" : "+v"(tid_));
    const int tid = tid_, wid = __builtin_amdgcn_readfirstlane(tid >> 6), lane = tid & 63, wr = wid >> 2, wc = wid & 3, fr = lane & 15, fq = lane >> 4;
    const int K = g.K, nt = K / BK;
    unsigned voffA[2], voffB[2];
#pragma unroll
    for (int i = 0; i < 2; ++i) { int R, C; stage_rc(tid * 16 + i * 8192, R, C); const int Rb = Epi::PERM ? ((R & ~31) + perm32(R & 31)) : R;
        voffA[i] = (unsigned)(R * g.lda + C) * 2u; voffB[i] = (unsigned)(Rb * g.ldb + C) * 2u; }
    const size_t kstep = (size_t)(BK * 2);
    const size_t hstepA = (size_t)HALF * g.lda * 2, hstepB = (size_t)HALF * g.ldb * 2;
    const size_t tstepA = 2 * hstepA, tstepB = 2 * hstepB;
    const unsigned ldsw = (unsigned)wid * 1024u;
    const int aoff = lds_byte(wr * 64 + fr, fq * 8), boff = lds_byte(wc * 32 + fr, fq * 8);
#define PG8_SA(b, h) (((b) * 2 + (h)) * HTB)
#define PG8_SB(b, h) ((4 + (b) * 2 + (h)) * HTB)
#define PG8_STAGE(bufoff, gbase, voff) do { _Pragma("unroll") for (int _i = 0; _i < 2; ++_i) \
        __builtin_amdgcn_global_load_lds((const unsigned*)((const char*)(gbase) + (voff)[_i]), (PG8_LAS unsigned*)(lds + (bufoff) + ldsw + _i * 8192), 16, 0, 0); } while (0)
#define PG8_LDA(dst, b, h) do { _Pragma("unroll") for (int m = 0; m < 4; ++m) _Pragma("unroll") for (int k = 0; k < 2; ++k) dst[m][k] = *(const PG8_LAS bf16x8*)(lds + PG8_SA(b, h) + aoff + m * 2048 + k * 1024); } while (0)
#define PG8_LDB(dst, b, h) do { _Pragma("unroll") for (int n = 0; n < 2; ++n) _Pragma("unroll") for (int k = 0; k < 2; ++k) dst[n][k] = *(const PG8_LAS bf16x8*)(lds + PG8_SB(b, h) + boff + n * 2048 + k * 1024); } while (0)
#define PG8_MMA(ai, bj, At, Bt) do { __builtin_amdgcn_s_setprio(1); _Pragma("unroll") for (int m = 0; m < 4; ++m) _Pragma("unroll") for (int n = 0; n < 2; ++n) _Pragma("unroll") for (int k = 0; k < 2; ++k) \
        acc[ai][bj][m][n] = __builtin_amdgcn_mfma_f32_16x16x32_bf16(Bt[n][k], At[m][k], acc[ai][bj][m][n], 0, 0, 0); __builtin_amdgcn_s_setprio(0); } while (0)
#define PG8_WAIT_V(n) asm volatile("s_waitcnt vmcnt(" #n ")" ::: "memory")
#define PG8_WAIT_L(n) asm volatile("s_waitcnt lgkmcnt(" #n ")" ::: "memory")
#define PG8_BAR __builtin_amdgcn_s_barrier()
#define PG8_SCHED __builtin_amdgcn_sched_barrier(0)
    Unit cur, nxt; int ui = 0;
    if (!S.next(0, cur)) return;
    f32x4 acc[2][2][4][2];
#pragma unroll
    for (int a = 0; a < 2; ++a)
#pragma unroll
        for (int b = 0; b < 2; ++b)
#pragma unroll
            for (int m = 0; m < 4; ++m)
#pragma unroll
                for (int n = 0; n < 2; ++n) acc[a][b][m][n] = (f32x4){0.f, 0.f, 0.f, 0.f};
    bf16x8 At[4][2], B0[2][2], B1[2][2];
    const char* cA = (const char*)g.A + (size_t)cur.pm * tstepA + (size_t)cur.ka * 2; const char* cB = (const char*)g.Bt + (size_t)cur.pn * tstepB + (size_t)cur.ka * 2;
    S.a_ready(cur);
    if constexpr (SP2) {
        PG8_STAGE(PG8_SB(0, 0), cB, voffB); PG8_STAGE(PG8_SB(0, 1), cB + hstepB, voffB); PG8_STAGE(PG8_SA(0, 0), cA, voffA); PG8_STAGE(PG8_SA(0, 1), cA + hstepA, voffA);
        if (wr == 1) PG8_BAR;
        PG8_WAIT_V(2); PG8_BAR;
        PG8_STAGE(PG8_SB(1, 0), cB + kstep, voffB); PG8_STAGE(PG8_SA(1, 0), cA + kstep, voffA); PG8_STAGE(PG8_SB(1, 1), cB + hstepB + kstep, voffB);
        PG8_WAIT_V(6); PG8_BAR;
    } else {
        PG8_STAGE(PG8_SB(0, 0), cB, voffB); PG8_STAGE(PG8_SA(0, 0), cA, voffA); PG8_STAGE(PG8_SB(0, 1), cB + hstepB, voffB); PG8_STAGE(PG8_SA(0, 1), cA + hstepA, voffA);
        if (wr == 1) PG8_BAR;
        PG8_WAIT_V(4); PG8_BAR;
        PG8_STAGE(PG8_SB(1, 0), cB + kstep, voffB); PG8_STAGE(PG8_SA(1, 0), cA + kstep, voffA); PG8_STAGE(PG8_SB(1, 1), cB + hstepB + kstep, voffB);
        PG8_WAIT_V(6); PG8_BAR;
    }
    for (;;) {
        const bool has_next = S.next(ui + 1, nxt);
        const char* nA = has_next ? (const char*)g.A + (size_t)nxt.pm * tstepA + (size_t)nxt.ka * 2 : cA; const char* nB = has_next ? (const char*)g.Bt + (size_t)nxt.pn * tstepB + (size_t)nxt.ka * 2 : cB;
        for (int t = 0; t < nt; t += 2) {
            const bool last = (t == nt - 2);
            if constexpr (Epi::KSEG > 0) { if (t > 0 && (t % Epi::KSEG) == 0) E.kseg(acc, cur, t / Epi::KSEG, wr, wc, fr, fq); }
            const char* a1 = cA + (size_t)(t + 1) * kstep;
            const char* a2 = last ? nA : cA + (size_t)(t + 2) * kstep; const char* b2 = last ? nB : cB + (size_t)(t + 2) * kstep;
            const char* a3 = a2 + kstep; const char* b3 = b2 + kstep;
            if (last && has_next) S.a_ready(nxt);
            if constexpr (SP2) {
            PG8_LDB(B0, 0, 0); PG8_LDB(B1, 0, 1); PG8_SCHED; PG8_LDA(At, 0, 0); PG8_STAGE(PG8_SA(1, 1), a1 + hstepA, voffA);
            PG8_WAIT_V(8); PG8_WAIT_L(0); PG8_BAR; PG8_MMA(0, 0, At, B0); PG8_MMA(0, 1, At, B1); PG8_BAR; PG8_SCHED;
            PG8_LDA(At, 0, 1); PG8_STAGE(PG8_SB(0, 0), b2, voffB); PG8_STAGE(PG8_SB(0, 1), b2 + hstepB, voffB); PG8_STAGE(PG8_SA(0, 0), a2, voffA);
            PG8_WAIT_V(8); PG8_WAIT_L(0); PG8_BAR; PG8_MMA(1, 0, At, B0); PG8_MMA(1, 1, At, B1); PG8_BAR; PG8_SCHED;
            PG8_LDB(B0, 1, 0); PG8_LDB(B1, 1, 1); PG8_SCHED; PG8_LDA(At, 1, 0); PG8_STAGE(PG8_SA(0, 1), a2 + hstepA, voffA);
            PG8_WAIT_V(8); PG8_WAIT_L(0); PG8_BAR; PG8_MMA(0, 0, At, B0); PG8_MMA(0, 1, At, B1); PG8_BAR; PG8_SCHED;
            PG8_LDA(At, 1, 1); PG8_STAGE(PG8_SB(1, 0), b3, voffB); PG8_STAGE(PG8_SB(1, 1), b3 + hstepB, voffB); PG8_STAGE(PG8_SA(1, 0), a3, voffA);
            PG8_WAIT_V(8); PG8_WAIT_L(0); PG8_BAR; PG8_MMA(1, 0, At, B0); PG8_MMA(1, 1, At, B1); PG8_BAR; PG8_SCHED;
            } else {
            PG8_LDB(B0, 0, 0); PG8_SCHED; PG8_LDA(At, 0, 0); PG8_STAGE(PG8_SA(1, 1), a1 + hstepA, voffA);
            PG8_WAIT_L(8); PG8_BAR; PG8_WAIT_L(0); PG8_MMA(0, 0, At, B0); PG8_BAR; PG8_SCHED;
            PG8_LDB(B1, 0, 1); PG8_STAGE(PG8_SB(0, 0), b2, voffB);
            PG8_BAR; PG8_WAIT_L(0); PG8_MMA(0, 1, At, B1); PG8_BAR;
            PG8_LDA(At, 0, 1); PG8_STAGE(PG8_SA(0, 0), a2, voffA);
            PG8_BAR; PG8_WAIT_L(0); PG8_MMA(1, 0, At, B0); PG8_BAR; PG8_SCHED;
            PG8_STAGE(PG8_SB(0, 1), b2 + hstepB, voffB);
            PG8_WAIT_V(6); PG8_BAR; PG8_MMA(1, 1, At, B1); PG8_BAR;
            PG8_LDB(B0, 1, 0); PG8_SCHED; PG8_LDA(At, 1, 0); PG8_STAGE(PG8_SA(0, 1), a2 + hstepA, voffA);
            PG8_WAIT_L(8); PG8_BAR; PG8_WAIT_L(0); PG8_MMA(0, 0, At, B0); PG8_BAR; PG8_SCHED;
            PG8_LDB(B1, 1, 1); PG8_STAGE(PG8_SB(1, 0), b3, voffB);
            PG8_BAR; PG8_WAIT_L(0); PG8_MMA(0, 1, At, B1); PG8_BAR;
            PG8_LDA(At, 1, 1); PG8_STAGE(PG8_SA(1, 0), a3, voffA);
            PG8_BAR; PG8_WAIT_L(0); PG8_MMA(1, 0, At, B0); PG8_BAR; PG8_SCHED;
            PG8_STAGE(PG8_SB(1, 1), b3 + hstepB, voffB);
            PG8_WAIT_V(6); PG8_BAR; PG8_MMA(1, 1, At, B1); PG8_BAR;
            }
        }
        if constexpr (ALIGN_EPI) { if (wr == 0) PG8_BAR; }
        if constexpr (!Epi::AFTER_DRAIN) { E(acc, cur, wr, wc, fr, fq); S.done(cur); }
        if (!has_next) break;
#pragma unroll
        for (int a = 0; a < 2; ++a)
#pragma unroll
            for (int b = 0; b < 2; ++b)
#pragma unroll
                for (int m = 0; m < 4; ++m)
#pragma unroll
                    for (int n = 0; n < 2; ++n) acc[a][b][m][n] = (f32x4){0.f, 0.f, 0.f, 0.f};
        cur = nxt; cA = nA; cB = nB; ++ui;
        if constexpr (ALIGN_EPI) { if (wr == 1) PG8_BAR; }
    }
    PG8_WAIT_V(0);
    if constexpr (!ALIGN_EPI) { if (wr == 0) PG8_BAR; }
    PG8_BAR;
    if constexpr (Epi::AFTER_DRAIN) { E.fused(acc, cur, wr, wc, fr, fq, lds, wid, lane); S.done(cur); }
#undef PG8_SA
#undef PG8_SB
#undef PG8_STAGE
#undef PG8_LDA
#undef PG8_LDB
#undef PG8_MMA
#undef PG8_WAIT_V
#undef PG8_WAIT_L
#undef PG8_BAR
#undef PG8_SCHED
}
}

constexpr int NWAVES = 8;
constexpr int D = 2048, NBATCH = 4, SEQ = 4096, DEPTH = 4, CTXL = 256;
constexpr int MLAT = NBATCH * SEQ, MCTX = NBATCH * CTXL, MTOT = MLAT + MCTX;
constexpr int INW = 12288, BW = 1024, FFH = 5632, NHEAD = 8;
constexpr int Q_OFF = 0, K_OFF = 1024, V_OFF = 2048, BU_OFF = 3072, C_OFF = 5120, G_OFF = 6144;
constexpr int YW = 3 * BW;
constexpr float LN_EPS = 1e-6f;
constexpr float ALPHA = 1.681792830507429f;
constexpr float QSCALE = 0.125f * 1.4426950408889634f;

constexpr size_t MiB = 1u << 20;
constexpr size_t WS_CTL = 0, CTL_ZERO_BYTES = 1 * MiB;
constexpr size_t WS_ROPE = 1 * MiB;
constexpr size_t WS_MODS = 2 * MiB;
constexpr size_t WS_MODP = 4 * MiB;
constexpr size_t WS_WSP = 20 * MiB;
constexpr size_t WS_WPOOL = 21 * MiB;
constexpr size_t WS_WIN = 24 * MiB;
constexpr size_t WS_WBR = 216 * MiB;
constexpr size_t WS_WOUT = 264 * MiB;
constexpr size_t WS_WGU = 296 * MiB;
constexpr size_t WS_WDN = 472 * MiB;
constexpr size_t WS_X = 560 * MiB;
constexpr size_t WS_HA = 696 * MiB;
constexpr size_t WS_Y = 764 * MiB;
constexpr size_t WS_MG = 866 * MiB;
constexpr size_t WS_Z = 934 * MiB;
constexpr size_t WS_KB = 1342 * MiB, WS_VB = 1378 * MiB;
constexpr size_t WS_END = 1414 * MiB;
static_assert(WS_MODP + 16ull * 4 * 5 * 12288 * 4 <= WS_WSP && WS_WIN + 4ull * 12288 * 2048 * 2 <= WS_WBR && WS_WBR + 4ull * 2048 * 3072 * 2 <= WS_WOUT && WS_WOUT + 4ull * 2048 * 2048 * 2 <= WS_WGU, "ws map 1");
static_assert(WS_WGU + 4ull * 11264 * 2048 * 2 <= WS_WDN && WS_WDN + 4ull * 2048 * 5632 * 2 <= WS_X && WS_X + (size_t)MTOT * D * 4 <= WS_HA && WS_HA + (size_t)MTOT * D * 2 <= WS_Y, "ws map 2");
static_assert(WS_Y + (size_t)MTOT * YW * 2 <= WS_MG && WS_MG + (size_t)MTOT * D * 2 <= WS_Z && WS_Z + (size_t)MTOT * INW * 2 <= WS_KB && WS_KB + 32ull * 4352 * 256 <= WS_VB && WS_VB + 32ull * 4352 * 256 <= WS_END, "ws map 3");
constexpr int CW_BAR = 4096;

constexpr int RING_OFF = 0, RING_BYTES = 131072;
constexpr int LDSCTL_OFF = RING_BYTES, MISC_OFF = LDSCTL_OFF + 320;
constexpr int LDS_BYTES = 147456;

#define GAS __attribute__((address_space(1)))
#define LAS __attribute__((address_space(3)))
typedef unsigned short bf16;
typedef unsigned v4u __attribute__((ext_vector_type(4)));
typedef unsigned v2u __attribute__((ext_vector_type(2)));
typedef float f32x4 __attribute__((ext_vector_type(4)));
typedef float f32x16 __attribute__((ext_vector_type(16)));
typedef short bf16x8 __attribute__((ext_vector_type(8)));
typedef short s16x4 __attribute__((ext_vector_type(4)));
typedef GAS unsigned gu32;
#define RLX_AGENT __ATOMIC_RELAXED, __HIP_MEMORY_SCOPE_AGENT
#define LDS_WAIT() asm volatile("s_waitcnt lgkmcnt(0)" ::: "memory")
#define VM_WAIT() asm volatile("s_waitcnt vmcnt(0)" ::: "memory")
__device__ __forceinline__ unsigned f2bf(float f) { unsigned u = __builtin_bit_cast(unsigned, f); return (u + 0x7fffu + ((u >> 16) & 1u)) >> 16; }
__device__ __forceinline__ unsigned pk2(float lo, float hi) { return f2bf(lo) | (f2bf(hi) << 16); }
__device__ __forceinline__ unsigned cvtpk(float lo, float hi) { unsigned r; asm volatile("v_cvt_pk_bf16_f32 %0, %1, %2" : "=v"(r) : "v"(lo), "v"(hi)); return r; }
__device__ __forceinline__ float bflo(unsigned w) { return __uint_as_float(w << 16); }
__device__ __forceinline__ float bfhi(unsigned w) { return __uint_as_float(w & 0xffff0000u); }

#define XB_TMO      128
#define XB_XCNT(j)  (256  + 64 * (j))
#define XB_XSUB(j)  (1280 + 64 * (j))
#define XB_XGEN(j)  (2304 + 64 * (j))
#define XB_TOP      3328
#define XB_TOPGEN   3392
#define XCD_BAR_WORDS 3456
#define XB_SPIN_CAP (1u << 18)

__device__ __forceinline__ unsigned xb_ld(unsigned* p)              { return __hip_atomic_load(p, __ATOMIC_RELAXED, __HIP_MEMORY_SCOPE_AGENT); }
__device__ __forceinline__ unsigned xb_add(unsigned* p, unsigned v) { return __hip_atomic_fetch_add(p, v, __ATOMIC_RELAXED, __HIP_MEMORY_SCOPE_AGENT); }
__device__ __forceinline__ unsigned xb_xcc_id() { return (unsigned)__builtin_amdgcn_s_getreg((3 << 11) | 20) & 0xFu; }
#define XB_SPIN(cond, bar) do { unsigned _sp = 0; while (cond) { __builtin_amdgcn_s_sleep(1); \
    if ((++_sp & 255u) == 0u) { if (xb_ld(&(bar)[XB_TMO])) break; if (_sp > XB_SPIN_CAP) { atomicAdd(&(bar)[XB_TMO], 1u); break; } } } } while (0)

struct XcdBarrier {
    unsigned* bar; unsigned x;
    volatile LAS unsigned* st;
};

__device__ __forceinline__ XcdBarrier xcd_barrier_post(unsigned* bar, volatile LAS unsigned* st) {
    XcdBarrier b; b.bar = bar; b.x = xb_xcc_id(); b.st = st;
    if (threadIdx.x == 0) (void)xb_add(&bar[XB_XCNT(b.x)], 1u);
    return b;
}
__device__ __forceinline__ void xcd_barrier_complete(unsigned* bar, unsigned x, unsigned& nloc, unsigned& nx) {
    const unsigned G = gridDim.x * gridDim.y * gridDim.z;
    unsigned sum, cnt, mine, sp = 0u;
    for (;;) {
        sum = 0u; cnt = 0u; mine = 0u;
#pragma unroll
        for (unsigned j = 0; j < 16; ++j) { const unsigned c = xb_ld(&bar[XB_XCNT(j)]); sum += c; cnt += (c > 0u) ? 1u : 0u; mine = (j == x) ? c : mine; }
        if (sum == G) break;
        __builtin_amdgcn_s_sleep(1);
        if ((++sp & 255u) == 0u) { if (xb_ld(&bar[XB_TMO])) break; if (sp > XB_SPIN_CAP) { atomicAdd(&bar[XB_TMO], 1u); break; } }
    }
    nloc = mine > 0u ? mine : 1u; nx = cnt > 0u ? cnt : 1u;
}

__device__ __forceinline__ void xcd_barrier(const XcdBarrier& b) {
    asm volatile("s_waitcnt vmcnt(0)" ::: "memory");
    __syncthreads();
    if (threadIdx.x == 0) {
        unsigned* bar = b.bar;
        __builtin_amdgcn_s_waitcnt(0);
        unsigned nloc = b.st[0], nx = b.st[1];
        if (nloc == 0u) { xcd_barrier_complete(bar, b.x, nloc, nx); b.st[0] = nloc; b.st[1] = nx; }
        const unsigned old = xb_add(&bar[XB_XSUB(b.x)], 1u);
        const unsigned gen = old / nloc;
        if (old + 1u == (gen + 1u) * nloc) {
            __builtin_amdgcn_fence(__ATOMIC_RELEASE, "agent");
            asm volatile("s_waitcnt vmcnt(0)" ::: "memory");
            const unsigned og = xb_add(&bar[XB_TOP], 1u);
            const unsigned tg = og / nx;
            if (og + 1u == (tg + 1u) * nx) xb_add(&bar[XB_TOPGEN], 1u);
            else XB_SPIN(xb_ld(&bar[XB_TOPGEN]) == tg, bar);
            __builtin_amdgcn_fence(__ATOMIC_ACQUIRE, "agent");
            xb_add(&bar[XB_XGEN(b.x)], 1u);
            asm volatile("s_waitcnt vmcnt(0)" ::: "memory");
        } else {
            XB_SPIN(xb_ld(&bar[XB_XGEN(b.x)]) == gen, bar);
            __builtin_amdgcn_fence(__ATOMIC_ACQUIRE, "agent");
            asm volatile("s_waitcnt vmcnt(0)" ::: "memory");
        }
    }
    __syncthreads();
}


struct Frame {
    LAS unsigned char* lds;
    volatile LAS unsigned* MISC;
    gu32* ctl;
    int vcu, G, bx;
    __device__ __forceinline__ int ltid() const { int t = threadIdx.x; asm volatile("" : "+v"(t)); return t; }
    const float *x, *c, *ctx, *cctx, *w_ada, *b_ada, *w_in, *lam_qk, *subln_g, *gln_g, *gln_b, *w_sp, *b_sp, *w_pool, *pool_scale, *w_branch, *w_out, *ln1_g, *ln1_b, *w_gu, *w_down, *ln2_g, *ln2_b;
    float* out;
    float *rope, *mods, *modp, *X;
    bf16 *Wsp, *Wpool, *Win, *Wbr, *Wout, *Wgu, *Wdn, *HA, *Y, *MG, *Z, *KB, *VB;
};

typedef __attribute__((address_space(4))) const unsigned char* kptr_t;
__device__ __forceinline__ void frame_ptrs(Frame& F) {
    kptr_t kp = (kptr_t)__builtin_amdgcn_kernarg_segment_ptr(); asm volatile("" : "+s"(kp));
#define KIN(i) (*(const float* const __attribute__((address_space(4)))*)(kp + 8 * (i)))
    F.x = KIN(0); F.c = KIN(1); F.ctx = KIN(2); F.cctx = KIN(3); F.w_ada = KIN(4); F.b_ada = KIN(5); F.w_in = KIN(6); F.lam_qk = KIN(7); F.subln_g = KIN(8);
    F.gln_g = KIN(9); F.gln_b = KIN(10); F.w_sp = KIN(11); F.b_sp = KIN(12); F.w_pool = KIN(13); F.pool_scale = KIN(14); F.w_branch = KIN(15); F.w_out = KIN(16);
    F.ln1_g = KIN(17); F.ln1_b = KIN(18); F.w_gu = KIN(19); F.w_down = KIN(20); F.ln2_g = KIN(21); F.ln2_b = KIN(22);
#undef KIN
    F.out = *(float* const __attribute__((address_space(4)))*)(kp + 184);
    unsigned char* ws = *(unsigned char* const __attribute__((address_space(4)))*)(kp + 192);
    F.rope = (float*)(ws + WS_ROPE); F.mods = (float*)(ws + WS_MODS); F.modp = (float*)(ws + WS_MODP); F.X = (float*)(ws + WS_X);
    F.Wsp = (bf16*)(ws + WS_WSP); F.Wpool = (bf16*)(ws + WS_WPOOL); F.Win = (bf16*)(ws + WS_WIN); F.Wbr = (bf16*)(ws + WS_WBR); F.Wout = (bf16*)(ws + WS_WOUT); F.Wgu = (bf16*)(ws + WS_WGU); F.Wdn = (bf16*)(ws + WS_WDN);
    F.HA = (bf16*)(ws + WS_HA); F.Y = (bf16*)(ws + WS_Y); F.MG = (bf16*)(ws + WS_MG); F.Z = (bf16*)(ws + WS_Z); F.KB = (bf16*)(ws + WS_KB); F.VB = (bf16*)(ws + WS_VB);
}
__device__ __forceinline__ float wave_sum(float v) {
    v += __builtin_bit_cast(float, __builtin_amdgcn_update_dpp(0, __builtin_bit_cast(int, v), 0xB1, 0xF, 0xF, true));
    v += __builtin_bit_cast(float, __builtin_amdgcn_update_dpp(0, __builtin_bit_cast(int, v), 0x4E, 0xF, 0xF, true));
    v += __builtin_bit_cast(float, __builtin_amdgcn_update_dpp(0, __builtin_bit_cast(int, v), 0x141, 0xF, 0xF, true));
    v += __builtin_bit_cast(float, __builtin_amdgcn_update_dpp(0, __builtin_bit_cast(int, v), 0x140, 0xF, 0xF, true));
    v += __shfl_xor(v, 16);
    { auto rr = __builtin_amdgcn_permlane32_swap(__float_as_uint(v), __float_as_uint(v), false, false); v = __uint_as_float(rr[0]) + __uint_as_float(rr[1]); }
    return v;
}

__device__ __forceinline__ void cvt_item(const float* W, int N, int k0, int ncol0, bool perm, bf16* WT, size_t drow0, int ldk, int dk0, LAS float* scr, int lane) {
#pragma unroll 8
    for (int i = 0; i < 32; ++i) { const int kk = 2 * i + (lane >> 5); scr[kk * 33 + (lane & 31)] = __builtin_nontemporal_load(W + (size_t)(k0 + kk) * N + ncol0 + (lane & 31)); }
    LDS_WAIT(); asm volatile("" ::: "memory");
    const int c = lane & 7;
#pragma unroll
    for (int j = 0; j < 4; ++j) { const int n = (lane >> 3) + 8 * j; const int ns = perm ? ((n & 1) * 16 + (n >> 1)) : n; const LAS float* s = scr + (8 * c) * 33 + ns;
        v4u o; o.x = pk2(s[0 * 33], s[1 * 33]); o.y = pk2(s[2 * 33], s[3 * 33]); o.z = pk2(s[4 * 33], s[5 * 33]); o.w = pk2(s[6 * 33], s[7 * 33]);
        *(GAS v4u*)(WT + (drow0 + n) * (size_t)ldk + dk0 + k0 + 8 * c) = o; }
    LDS_WAIT(); asm volatile("" ::: "memory");
}
constexpr int CV_IN = 32 * 384, CV_GU = 32 * 352, CV_DN = 88 * 64, CV_BR = 3 * 16 * 64, CV_OUT = 32 * 64, CV_POOL = 4 * 4 * 8, CV_LAYER = CV_IN + CV_GU + CV_DN + CV_BR + CV_OUT + CV_POOL;
__device__ __forceinline__ void cvt_dispatch(Frame& F, int it, LAS float* scr) {
    const int l = it / CV_LAYER; int r = it - l * CV_LAYER;
    if (r < CV_IN) { const int kb = r / 384, nb = r - kb * 384;
        cvt_item(F.w_in + (size_t)l * D * INW, INW, 64 * kb, 32 * nb, nb < 64, F.Win + (size_t)l * INW * D, (size_t)32 * nb, D, 0, scr, (F.ltid() & 63)); return; }
    r -= CV_IN;
    if (r < CV_GU) { const int kb = r / 352, nb = r - kb * 352; const int tpn = nb >> 3, half = (nb >> 2) & 1, jj0 = (nb & 3) * 32;
        cvt_item(F.w_gu + (size_t)l * D * 2 * FFH, 2 * FFH, 64 * kb, half * FFH + 128 * tpn + jj0, false, F.Wgu + (size_t)l * 2 * FFH * D, (size_t)32 * nb, D, 0, scr, (F.ltid() & 63)); return; }
    r -= CV_GU;
    if (r < CV_DN) { const int kb = r >> 6, nb = r & 63;
        cvt_item(F.w_down + (size_t)l * FFH * D, D, 64 * kb, 32 * nb, false, F.Wdn + (size_t)l * D * FFH, (size_t)32 * nb, FFH, 0, scr, (F.ltid() & 63)); return; }
    r -= CV_DN;
    if (r < CV_BR) { const int n = r >> 10, rr = r & 1023, kb = rr >> 6, nb = rr & 63;
        cvt_item(F.w_branch + ((size_t)l * 3 + n) * BW * D, D, 64 * kb, 32 * nb, false, F.Wbr + (size_t)l * D * YW, (size_t)32 * nb, YW, BW * n, scr, (F.ltid() & 63)); return; }
    r -= CV_BR;
    if (r < CV_OUT) { const int kb = r >> 6, nb = r & 63;
        cvt_item(F.w_out + (size_t)l * D * D, D, 64 * kb, 32 * nb, false, F.Wout + (size_t)l * D * D, (size_t)32 * nb, D, 0, scr, (F.ltid() & 63)); return; }
    r -= CV_OUT;
    { const int g = r >> 5, rr = r & 31, kb = rr >> 3, nb = rr & 7;
        cvt_item(F.w_pool + ((size_t)l * 4 + g) * 65536, 256, 64 * kb, 32 * nb, false, F.Wpool + ((size_t)l * 4 + g) * 65536, (size_t)32 * nb, 256, 0, scr, (F.ltid() & 63)); }
}

__device__ __forceinline__ double rope_inv(int p) {
    const double t[16] = {1.0, 0.5623413251903491, 0.31622776601683794, 0.1778279410038923, 0.1, 0.05623413251903491, 0.03162277660168379, 0.01778279410038923,
                          0.01, 0.005623413251903491, 0.003162277660168379, 0.001778279410038923, 0.001, 0.0005623413251903491, 0.00031622776601683794, 0.0001778279410038923};
    double r = t[0];
#pragma unroll
    for (int i = 1; i < 16; ++i) r = (p == i) ? t[i] : r;
    return r;
}
#ifndef TAILWORK
#define TAILWORK 0
#endif
__device__ __forceinline__ void ada_partial_layer(Frame& F, int l, int gw, int NGW) {
    LAS float* scs = (LAS float*)(F.lds);
    __syncthreads();
    for (int i = F.ltid(); i < 5 * D; i += NWAVES * 64) { const int g = i >> 11, k = i & 2047; const float v = g < 4 ? F.c[g * D + k] : F.cctx[k]; scs[i] = v / (1.0f + __expf(-v)); }
    __syncthreads();
    for (int it = gw; it < 16 * 48; it += NGW) {
        const int ks = it / 48, cgw = it - ks * 48; const int col = cgw * 256 + (F.ltid() & 63) * 4;
        const float* wp = F.w_ada + ((size_t)l * D + ks * 128) * INW + col;
        f32x4 a0 = {0.f, 0.f, 0.f, 0.f}, a1 = a0, a2 = a0, a3 = a0, a4 = a0;
#pragma unroll 8
        for (int k = 0; k < 128; ++k) { const f32x4 w = __builtin_nontemporal_load((const GAS f32x4*)(wp + (size_t)k * INW)); const int kk = ks * 128 + k;
            a0 += w * scs[kk]; a1 += w * scs[D + kk]; a2 += w * scs[2 * D + kk]; a3 += w * scs[3 * D + kk]; a4 += w * scs[4 * D + kk]; }
        float* pp = F.modp + (((size_t)ks * 4 + l) * 5) * INW + col;
        *(f32x4*)(pp) = a0; *(f32x4*)(pp + INW) = a1; *(f32x4*)(pp + 2 * INW) = a2; *(f32x4*)(pp + 3 * INW) = a3; *(f32x4*)(pp + 4 * INW) = a4;
    }
    __syncthreads();
}
__device__ __forceinline__ void cvt_layer(Frame& F, int l, int gw, int NGW) {
    LAS float* scr = (LAS float*)(F.lds + __builtin_amdgcn_readfirstlane(F.ltid() >> 6) * 16384);
    for (int it = gw; it < CV_LAYER; it += NGW) cvt_dispatch(F, l * CV_LAYER + it, scr);
}
__device__ __forceinline__ void mods_reduce_layer(Frame& F, int l) {
    const int gt = F.vcu * NWAVES * 64 + F.ltid(), NGT = F.G * NWAVES * 64;
    for (int i = gt; i < 5 * (INW / 4); i += NGT) { const int g = i / (INW / 4), j = (i - g * (INW / 4)) * 4;
        f32x4 sm = *(const f32x4*)(F.b_ada + (size_t)l * INW + j);
#pragma unroll
        for (int ks = 0; ks < 16; ++ks) sm += *(const f32x4*)(F.modp + (((size_t)ks * 4 + l) * 5 + g) * INW + j);
        *(f32x4*)(F.mods + ((size_t)l * 5 + g) * INW + j) = sm; }
}
__device__ __forceinline__ void phase_a1(Frame& F) {
    const int gw = F.vcu * NWAVES + __builtin_amdgcn_readfirstlane(F.ltid() >> 6), NGW = F.G * NWAVES;
#pragma nounroll
    for (int l = 0; l < (TAILWORK ? 1 : DEPTH); ++l) ada_partial_layer(F, l, gw, NGW);
#pragma nounroll
    for (int l = 0; l < (TAILWORK ? 1 : DEPTH); ++l) cvt_layer(F, l, gw, NGW);
    for (int it = gw; it < (DEPTH * 8 * 128 * 128) / 512; it += NGW) { const size_t e = (size_t)it * 512 + (F.ltid() & 63) * 8;
        const f32x4 a = *(const f32x4*)(F.w_sp + e), b = *(const f32x4*)(F.w_sp + e + 4);
        v4u o; o.x = pk2(a[0], a[1]); o.y = pk2(a[2], a[3]); o.z = pk2(b[0], b[1]); o.w = pk2(b[2], b[3]); *(v4u*)(F.Wsp + e) = o; }
    if (gw == 0) {
        for (int e = (F.ltid() & 63); e < 1024; e += 64) { const int pos = e >> 4, pr = e & 15;
            const double ang = (double)pos * rope_inv(pr); const double twopi = 6.283185307179586476925286766559;
            const double kq = __builtin_rint(ang / twopi); const double rr = ang - kq * twopi; const double r2 = rr * rr;
            double sn = 1.0, cs = 1.0;
#pragma unroll
            for (int n = 14; n >= 1; --n) { sn = 1.0 - sn * r2 / (double)((2 * n) * (2 * n + 1)); cs = 1.0 - cs * r2 / (double)((2 * n - 1) * (2 * n)); }
            sn *= rr;
            F.rope[2 * e] = (float)cs; F.rope[2 * e + 1] = (float)sn; }
    }
}
__device__ __forceinline__ void phase_a2(Frame& F) {
#pragma nounroll
    for (int l = 0; l < (TAILWORK ? 1 : DEPTH); ++l) mods_reduce_layer(F, l); }
__device__ __forceinline__ void ln_row(const float* src, const bf16* tadd, const float* part, int npart, const float* gam, const float* bet, float* xo, float xs, bf16* ho, const float* sc, const float* sh, int lane) {
    f32x4 v[8]; float s = 0.f;
#pragma unroll
    for (int j = 0; j < 8; ++j) v[j] = __builtin_nontemporal_load((const GAS f32x4*)(src + 4 * lane + 256 * j));
    if (tadd) {
#pragma unroll
        for (int j = 0; j < 8; ++j) { const v2u t2 = *(const GAS v2u*)(tadd + 4 * lane + 256 * j); v[j] += (f32x4){bflo(t2.x), bfhi(t2.x), bflo(t2.y), bfhi(t2.y)}; } }
    for (int p = 0; p < npart; ++p) {
#pragma unroll
        for (int j = 0; j < 8; ++j) v[j] += __builtin_nontemporal_load((const GAS f32x4*)(part + (size_t)p * 1024 * D + 4 * lane + 256 * j)); }
#pragma unroll
    for (int j = 0; j < 8; ++j) s += (v[j][0] + v[j][1]) + (v[j][2] + v[j][3]);
    const float mean = wave_sum(s) * (1.f / D); float s2 = 0.f;
#pragma unroll
    for (int j = 0; j < 8; ++j) { v[j] = v[j] - mean; s2 += (v[j][0] * v[j][0] + v[j][1] * v[j][1]) + (v[j][2] * v[j][2] + v[j][3] * v[j][3]); }
    const float rstd = 1.0f / sqrtf(wave_sum(s2) * (1.f / D) + LN_EPS);
#pragma unroll
    for (int j = 0; j < 8; ++j) { const int col = 4 * lane + 256 * j; f32x4 xn = v[j] * rstd;
        if (gam) xn = xn * *(const f32x4*)(gam + col) + *(const f32x4*)(bet + col);
        if (xo) __builtin_nontemporal_store(xn * xs, (GAS f32x4*)(xo + col));
        if (ho) { const f32x4 hv = xn * (1.0f + *(const f32x4*)(sc + col)) + *(const f32x4*)(sh + col); v2u o; o.x = pk2(hv[0], hv[1]); o.y = pk2(hv[2], hv[3]); __builtin_nontemporal_store(o, (GAS v2u*)(ho + col)); } }
}
__device__ __forceinline__ int row_group(int row) { return row < MLAT ? (row >> 12) : 4; }
__device__ __forceinline__ void phase_a3(Frame& F) {
    const int gw = F.vcu * NWAVES + __builtin_amdgcn_readfirstlane(F.ltid() >> 6), NGW = F.G * NWAVES;
    for (int row = gw; row < MTOT; row += NGW) { const float* src = row < MLAT ? F.x + (size_t)row * D : F.ctx + (size_t)(row - MLAT) * D; const float* md = F.mods + (size_t)row_group(row) * INW;
        ln_row(src, nullptr, nullptr, 0, nullptr, nullptr, F.X + (size_t)row * D, ALPHA, F.HA + (size_t)row * D, md + D, md, (F.ltid() & 63)); }
}
#ifndef LN_NT
#define LN_NT 1
#endif
#if LN_NT
#define LN_LD(p) __builtin_nontemporal_load(p)
#define LN_ST(p, v) __builtin_nontemporal_store((v), (p))
#else
#define LN_LD(p) (*(p))
#define LN_ST(p, v) (*(p) = (v))
#endif
__device__ __forceinline__ void ln_finish(f32x4 (&v)[8], const float* gam, const float* bet, float* xo, float xs, bf16* ho, const float* sc, const float* sh, int lane) {
    float s = 0.f;
#pragma unroll
    for (int j = 0; j < 8; ++j) s += (v[j][0] + v[j][1]) + (v[j][2] + v[j][3]);
    const float mean = wave_sum(s) * (1.f / D); float s2 = 0.f;
#pragma unroll
    for (int j = 0; j < 8; ++j) { v[j] = v[j] - mean; s2 += (v[j][0] * v[j][0] + v[j][1] * v[j][1]) + (v[j][2] * v[j][2] + v[j][3] * v[j][3]); }
    const float rstd = 1.0f / sqrtf(wave_sum(s2) * (1.f / D) + LN_EPS);
#pragma unroll
    for (int j = 0; j < 8; ++j) { const int col = 4 * lane + 256 * j; f32x4 xn = v[j] * rstd;
        xn = xn * *(const f32x4*)(gam + col) + *(const f32x4*)(bet + col);
        if (xo) LN_ST((GAS f32x4*)(xo + col), xn * xs);
        if (ho) { const f32x4 hv = xn * (1.0f + *(const f32x4*)(sc + col)) + *(const f32x4*)(sh + col); v2u o; o.x = pk2(hv[0], hv[1]); o.y = pk2(hv[2], hv[3]); LN_ST((GAS v2u*)(ho + col), o); } }
}
__device__ __forceinline__ void phase_ln(Frame& F, const float* gam, const float* bet, int nrows, bool to_out, bool want_h, int lm, int moff, int nsplit, bool dry = false) {
    const int gw = F.vcu * NWAVES + __builtin_amdgcn_readfirstlane(F.ltid() >> 6), NGW = F.G * NWAVES; const int lane = F.ltid() & 63;
    f32x4 xa[8]; v2u ta[8];
    int row = gw;
    if (row < MLAT) {
#pragma unroll
        for (int j = 0; j < 8; ++j) { xa[j] = LN_LD((const GAS f32x4*)(F.X + (size_t)row * D + 4 * lane + 256 * j)); ta[j] = LN_LD((const GAS v2u*)(F.Y + (size_t)row * D + 4 * lane + 256 * j)); } }
    for (; row < MLAT; row += NGW) {
        f32x4 v[8];
#pragma unroll
        for (int j = 0; j < 8; ++j) v[j] = xa[j] + (f32x4){bflo(ta[j].x), bfhi(ta[j].x), bflo(ta[j].y), bfhi(ta[j].y)};
        const int nx = row + NGW;
        if (nx < MLAT) {
#pragma unroll
            for (int j = 0; j < 8; ++j) { xa[j] = LN_LD((const GAS f32x4*)(F.X + (size_t)nx * D + 4 * lane + 256 * j)); ta[j] = LN_LD((const GAS v2u*)(F.Y + (size_t)nx * D + 4 * lane + 256 * j)); } }
        const float* md = F.mods + ((size_t)lm * 5 + (row >> 12)) * INW + moff;
        ln_finish(v, gam, bet, dry ? (float*)(F.Z + (size_t)134 * MiB) + (size_t)row * D : (to_out ? F.out + (size_t)row * D : F.X + (size_t)row * D), to_out ? 1.0f : ALPHA, want_h ? (dry ? F.MG : F.HA) + (size_t)row * D : nullptr, md + D, md, lane);
    }
    for (; row < nrows; row += NGW) { const float* md = F.mods + ((size_t)lm * 5 + 4) * INW + moff;
        ln_row(F.X + (size_t)row * D, nullptr, (const float*)(F.Z + (size_t)100 * MiB) + (size_t)(row - MLAT) * D, nsplit, gam, bet, dry ? (float*)(F.Z + (size_t)134 * MiB) + (size_t)row * D : (to_out ? F.out + (size_t)row * D : F.X + (size_t)row * D), to_out ? 1.0f : ALPHA, want_h ? (dry ? F.MG : F.HA) + (size_t)row * D : nullptr, md + D, md, lane); }
}

constexpr int AT_KB = 0, AT_VB = 32768, AT_TILE = 16384, AT_XB = 65536;
__device__ __forceinline__ s16x4 vtr(const LAS unsigned char* p) { typedef short v4i16_t __attribute__((ext_vector_type(4))); return __builtin_bit_cast(s16x4, __builtin_amdgcn_ds_read_tr16_b64_v4i16((LAS v4i16_t*)p)); }
__device__ __forceinline__ float max3f(float a, float b, float c) { float r; asm("v_max3_f32 %0, %1, %2, %3" : "=v"(r) : "v"(a), "v"(b), "v"(c)); return r; }
__device__ __forceinline__ float max2f(float a, float b) { float r; asm("v_max_f32_e32 %0, %1, %2" : "=v"(r) : "v"(a), "v"(b)); return r; }
__device__ __forceinline__ void glds16(const void* gsrc, unsigned lds_dst) { unsigned keep;
    asm volatile("s_mov_b32 %0, m0\n\ts_mov_b32 m0, %2\n\ts_nop 0\n\tglobal_load_lds_dwordx4 %1, off\n\ts_mov_b32 m0, %0" : "=&s"(keep) : "v"(gsrc), "s"(lds_dst) : "memory"); }
#ifndef XTRA_EXP
#define XTRA_EXP 0
#endif
#define AT_WAITV(n) asm volatile("s_waitcnt vmcnt(" #n ")" ::: "memory")
#define AT_BAR() asm volatile("s_waitcnt lgkmcnt(0)\n\ts_barrier" ::: "memory")
__device__ __forceinline__ void attn_unit(Frame& F, int b, int h, int qb, bool ctxq, float lam, float oscale, const float* subg) {
    int lane_ = (F.ltid() & 63); asm volatile("" : "+v"(lane_));
    const int lane = lane_, wid = __builtin_amdgcn_readfirstlane(F.ltid() >> 6), r32 = lane & 31, hi = lane >> 5, m = wid >> 2, qg = wid & 3; const bool lead = wid < 4;
    const bf16* Z = F.Z;
    const int qrow = (ctxq ? MLAT + b * CTXL : b * SEQ) + qb * 128 + qg * 32 + r32;
    bf16x8 qf[4];
#pragma unroll
    for (int d0 = 0; d0 < 4; ++d0) qf[d0] = *(const GAS bf16x8*)(Z + (size_t)qrow * INW + Q_OFF + h * 128 + m * 64 + d0 * 16 + hi * 8);
    const int NT = ctxq ? 4 : 68;
    const bf16* Kbh = F.KB + (size_t)(b * 8 + h) * 4352 * 128; const bf16* Vbh = F.VB + (size_t)(b * 8 + h) * 4352 * 128;
    const unsigned lds0 = (unsigned)(size_t)F.lds;
    const int prow = 8 * wid + (lane >> 4), ppos = lane & 15;
    const unsigned koff0 = (unsigned)(prow * 128 + ((ppos ^ (prow & 15)) * 8)), koff1 = (unsigned)((prow + 4) * 128 + ((ppos ^ ((prow + 4) & 15)) * 8));
    const unsigned voff0 = (unsigned)(prow * 128 + ((ppos ^ (4 * (prow & 3))) * 8)), voff1 = voff0 + 4 * 128;
    const unsigned kdst = (unsigned)__builtin_amdgcn_readfirstlane((int)(lds0 + AT_KB + wid * 2048)), vdst = (unsigned)__builtin_amdgcn_readfirstlane((int)(lds0 + AT_VB + wid * 2048));
#define AT_DMAK(t, bufo) do { const bf16* tb_ = Kbh + (size_t)(t) * 8192; glds16(tb_ + koff0, kdst + (bufo)); glds16(tb_ + koff1, kdst + (bufo) + 1024); } while (0)
#define AT_DMAV(t, bufo) do { const bf16* tb_ = Vbh + (size_t)(t) * 8192; glds16(tb_ + voff0, vdst + (bufo)); glds16(tb_ + voff1, vdst + (bufo) + 1024); } while (0)
    f32x16 o[4];
#pragma unroll
    for (int db = 0; db < 4; ++db)
#pragma unroll
        for (int r = 0; r < 16; ++r) o[db][r] = 0.f;
    float mref = 0.f, lsum = 0.f;
    f32x16 negm;
#pragma unroll
    for (int r = 0; r < 16; ++r) negm[r] = 0.f;
    const unsigned kaddr0 = AT_KB + r32 * 256 + (((8 * m + hi) ^ (r32 & 15)) << 4);
    const int a4 = (lane & 15) >> 2, cc = 2 * ((lane >> 4) & 1) + ((lane & 3) >> 1);
    const unsigned vaddr0 = AT_VB + (4 * hi + a4) * 256 + ((4 * a4 + cc) << 4) + 8 * (lane & 1);
    __syncthreads();
    AT_DMAK(0, 0); AT_DMAV(0, 0);
    AT_WAITV(2); AT_BAR();
    if (!lead) { if (NT > 1) { AT_DMAK(1, AT_TILE); AT_WAITV(2); } else AT_WAITV(0); AT_BAR(); }
    for (int t = 0; t < NT; ++t) {
        const unsigned bo = (t & 1) ? AT_TILE : 0; const bool more = (t + 1 < NT);
        if (more) { if (lead) AT_DMAK(t + 1, bo ^ AT_TILE); else AT_DMAV(t + 1, bo ^ AT_TILE); }
        unsigned kb_ = kaddr0 + bo, vb_ = vaddr0 + bo; asm volatile("" : "+v"(kb_), "+v"(vb_));
        f32x16 p0, p1;
        { bf16x8 kf[4][2];
#pragma unroll
          for (int d0 = 0; d0 < 4; ++d0) { const unsigned ka = kb_ ^ (unsigned)((2 * d0) << 4); kf[d0][0] = *(const LAS bf16x8*)(F.lds + ka); kf[d0][1] = *(const LAS bf16x8*)(F.lds + ka + 32 * 256); }
          __builtin_amdgcn_sched_barrier(0);
          p0 = __builtin_amdgcn_mfma_f32_32x32x16_bf16(kf[0][0], qf[0], negm, 0, 0, 0);
#pragma unroll
          for (int d0 = 1; d0 < 4; ++d0) p0 = __builtin_amdgcn_mfma_f32_32x32x16_bf16(kf[d0][0], qf[d0], p0, 0, 0, 0);
          p1 = __builtin_amdgcn_mfma_f32_32x32x16_bf16(kf[0][1], qf[0], negm, 0, 0, 0);
#pragma unroll
          for (int d0 = 1; d0 < 4; ++d0) p1 = __builtin_amdgcn_mfma_f32_32x32x16_bf16(kf[d0][1], qf[d0], p1, 0, 0, 0); }
        { float tmax = max3f(p0[0], p1[0], p0[1]);
#pragma unroll
          for (int r = 1; r < 15; ++r) tmax = max3f(tmax, p1[r], p0[r + 1]);
          tmax = max2f(tmax, p1[15]); { auto rr_ = __builtin_amdgcn_permlane32_swap(__float_as_uint(tmax), __float_as_uint(tmax), false, false); tmax = max2f(__uint_as_float(rr_[0]), __uint_as_float(rr_[1])); }
          if (t == 0) { mref = tmax;
#pragma unroll
              for (int r = 0; r < 16; ++r) { p0[r] -= tmax; p1[r] -= tmax; negm[r] = -mref; }
          } else if (__any(tmax > 8.0f)) {
              const float dl = __builtin_fmaxf(tmax, 0.f); mref += dl; const float al = __builtin_amdgcn_exp2f(-dl); lsum *= al;
#pragma unroll
              for (int r = 0; r < 16; ++r) { p0[r] -= dl; p1[r] -= dl; negm[r] = -mref; }
#pragma unroll
              for (int db = 0; db < 4; ++db)
#pragma unroll
                  for (int r = 0; r < 16; ++r) o[db][r] *= al;
          } }
#define AT_SOFTMAX(P, PK) do { \
        if (XTRA_EXP) { float d0_ = P[0], d1_ = P[1], d2_ = P[2], d3_ = P[3]; _Pragma("unroll") for (int x_ = 0; x_ < XTRA_EXP / 4; ++x_) asm volatile("v_exp_f32 %0, %0\n\tv_exp_f32 %1, %1\n\tv_exp_f32 %2, %2\n\tv_exp_f32 %3, %3" : "+v"(d0_), "+v"(d1_), "+v"(d2_), "+v"(d3_)); } \
        float ls0_ = 0.f, ls1_ = 0.f, ls2_ = 0.f, ls3_ = 0.f; \
        _Pragma("unroll") for (int r = 0; r < 16; r += 4) { P[r] = __builtin_amdgcn_exp2f(P[r]); P[r + 1] = __builtin_amdgcn_exp2f(P[r + 1]); P[r + 2] = __builtin_amdgcn_exp2f(P[r + 2]); P[r + 3] = __builtin_amdgcn_exp2f(P[r + 3]); \
            ls0_ += P[r]; ls1_ += P[r + 1]; ls2_ += P[r + 2]; ls3_ += P[r + 3]; } \
        lsum += (ls0_ + ls1_) + (ls2_ + ls3_); \
        _Pragma("unroll") for (int s_ = 0; s_ < 2; ++s_) { v4u w_; \
            w_.x = cvtpk(P[8 * s_ + 0], P[8 * s_ + 1]); w_.y = cvtpk(P[8 * s_ + 2], P[8 * s_ + 3]); w_.z = cvtpk(P[8 * s_ + 4], P[8 * s_ + 5]); w_.w = cvtpk(P[8 * s_ + 6], P[8 * s_ + 7]); \
            PK[s_] = __builtin_bit_cast(bf16x8, w_); } } while (0)
        bf16x8 pka[2], pkb[2];
        AT_SOFTMAX(p0, pka);
        if (more) AT_WAITV(2); else AT_WAITV(0);
        AT_BAR();
        if (lead) { if (more) AT_DMAV(t + 1, bo ^ AT_TILE); } else { if (t + 2 < NT) AT_DMAK(t + 2, bo); }
        { s16x4 va_[4][2][2], vc_[4][2][2];
#define AT_VLOAD(dst, kh_) do { _Pragma("unroll") for (int d_ = 0; d_ < 4; ++d_) { const unsigned va = vb_ ^ (unsigned)(d_ << 6); \
            _Pragma("unroll") for (int s_ = 0; s_ < 2; ++s_) { dst[d_][s_][0] = vtr(F.lds + va + (32 * (kh_) + 16 * s_) * 256); dst[d_][s_][1] = vtr(F.lds + va + (32 * (kh_) + 16 * s_ + 8) * 256); } } } while (0)
#define AT_VMMA(src, PK) do { _Pragma("unroll") for (int s_ = 0; s_ < 2; ++s_) _Pragma("unroll") for (int d_ = 0; d_ < 4; ++d_) { \
            const bf16x8 vf = (bf16x8){src[d_][s_][0][0], src[d_][s_][0][1], src[d_][s_][0][2], src[d_][s_][0][3], src[d_][s_][1][0], src[d_][s_][1][1], src[d_][s_][1][2], src[d_][s_][1][3]}; \
            o[d_] = __builtin_amdgcn_mfma_f32_32x32x16_bf16(vf, PK[s_], o[d_], 0, 0, 0); } } while (0)
          AT_VLOAD(va_, 0); __builtin_amdgcn_sched_barrier(0);
          AT_VLOAD(vc_, 1); __builtin_amdgcn_sched_barrier(0);
          AT_VMMA(va_, pka);
          AT_SOFTMAX(p1, pkb);
          AT_VMMA(vc_, pkb);
          __builtin_amdgcn_sched_barrier(0);
#undef AT_VLOAD
#undef AT_VMMA
        }
#undef AT_SOFTMAX
        if (lead) { if (more) AT_WAITV(2); } else { if (t + 2 < NT) AT_WAITV(2); else AT_WAITV(0); }
        AT_BAR();
    }
    if (lead) AT_BAR();
    const float lt = lsum + __shfl_xor(lsum, 32);
    LAS float* xs = (LAS float*)(F.lds + AT_XB) + qg * 4096 + lane;
    if (!lead) { const float sc1 = lam / lt;
#pragma unroll
        for (int db = 0; db < 4; ++db)
#pragma unroll
            for (int r = 0; r < 16; ++r) xs[(db * 16 + r) * 64] = o[db][r] * sc1; }
    __syncthreads();
    if (lead) {
        const float i0 = 1.0f / lt; float ss = 0.f;
#pragma unroll
        for (int db = 0; db < 4; ++db)
#pragma unroll
            for (int r = 0; r < 16; ++r) { const float v = o[db][r] * i0 - xs[(db * 16 + r) * 64]; o[db][r] = v; ss += v * v; }
        ss += __shfl_xor(ss, 32);
        const float rs = oscale / sqrtf(ss * (1.0f / 128.0f) + LN_EPS);
        bf16* yp = F.Y + (size_t)qrow * YW + h * 128 + 4 * hi;
#pragma unroll
        for (int db = 0; db < 4; ++db)
#pragma unroll
            for (int g4 = 0; g4 < 4; ++g4) { const int d = 32 * db + 8 * g4; const f32x4 gv = *(const f32x4*)(subg + d + 4 * hi);
                v2u w; w.x = cvtpk(o[db][4 * g4 + 0] * rs * gv[0], o[db][4 * g4 + 1] * rs * gv[1]); w.y = cvtpk(o[db][4 * g4 + 2] * rs * gv[2], o[db][4 * g4 + 3] * rs * gv[3]);
                *(GAS v2u*)(yp + d) = w; }
    }
#undef AT_DMAK
#undef AT_DMAV
}

constexpr int GM_ST = 0, GM_VT = 1024, GM_VP = 272;
__device__ __forceinline__ void gmlp_unit(Frame& F, int row0, int l) {
    int tid_ = F.ltid(); asm volatile("" : "+v"(tid_)); const int tid = tid_, lane = tid & 63, wid = __builtin_amdgcn_readfirstlane(F.ltid() >> 6);
    typedef float f32x2v __attribute__((ext_vector_type(2)));
    LAS f32x2v* st = (LAS f32x2v*)(F.lds + GM_ST); LAS unsigned char* vt = F.lds + GM_VT;
    const bf16* Z = F.Z;
    __syncthreads();
#pragma unroll
    for (int hb = 0; hb < 2; ++hb) {
        v4u va[8], vb[8];
#pragma unroll
        for (int i = 0; i < 8; ++i) { const bf16* vp = Z + (size_t)(row0 + wid * 16 + hb * 8 + i) * INW + BU_OFF + BW + lane * 16; va[i] = *(const GAS v4u*)(vp); vb[i] = *(const GAS v4u*)(vp + 8); }
#pragma unroll
        for (int i = 0; i < 8; ++i) { const v4u a = va[i], b2 = vb[i];
            const float x[16] = {bflo(a.x), bfhi(a.x), bflo(a.y), bfhi(a.y), bflo(a.z), bfhi(a.z), bflo(a.w), bfhi(a.w), bflo(b2.x), bfhi(b2.x), bflo(b2.y), bfhi(b2.y), bflo(b2.z), bfhi(b2.z), bflo(b2.w), bfhi(b2.w)};
            float s = 0.f;
#pragma unroll
            for (int e = 0; e < 16; ++e) s += x[e];
            const float mean = wave_sum(s) * (1.0f / 1024.0f); float q = 0.f;
#pragma unroll
            for (int e = 0; e < 16; ++e) { const float dd = x[e] - mean; q += dd * dd; }
            const float rstd = 1.0f / sqrtf(wave_sum(q) * (1.0f / 1024.0f) + LN_EPS);
            if (lane == 0) st[wid * 16 + hb * 8 + i] = (f32x2v){mean, rstd}; }
    }
    const float* lng = F.gln_g + (size_t)l * BW; const float* lnb = F.gln_b + (size_t)l * BW;
    const int j = tid & 127, cc = tid >> 7;
    const int fr = lane & 15, fq = lane >> 4, tok = wid * 16 + fr;
    const bf16* vsrc = Z + (size_t)(row0 + j) * INW + BU_OFF + BW + cc * 32;
    v4u vr[4];
#pragma unroll
    for (int q4 = 0; q4 < 4; ++q4) vr[q4] = *(const GAS v4u*)(vsrc + q4 * 8);
    __syncthreads();
    const f32x2v sj = st[j];
#pragma unroll 1
    for (int g = 0; g < 8; ++g) {
        bf16x8 wf[4]; v2u uu[8];
        const bf16* wg = F.Wsp + ((size_t)l * 8 + g) * 16384 + (size_t)tok * 128 + fq * 8;
#pragma unroll
        for (int ks = 0; ks < 4; ++ks) wf[ks] = *(const GAS bf16x8*)(wg + ks * 32);
        const bf16* up = Z + (size_t)(row0 + tok) * INW + BU_OFF + g * 128 + 4 * fq;
#pragma unroll
        for (int ct = 0; ct < 8; ++ct) uu[ct] = *(const GAS v2u*)(up + ct * 16);
        const float bias = F.b_sp[((size_t)l * 8 + g) * 128 + tok];
#pragma unroll
        for (int q4 = 0; q4 < 4; ++q4) { const v4u a = vr[q4]; const int c0 = cc * 32 + q4 * 8;
            const f32x4 g0 = *(const f32x4*)(lng + g * 128 + c0), g1 = *(const f32x4*)(lng + g * 128 + c0 + 4), b0 = *(const f32x4*)(lnb + g * 128 + c0), b1 = *(const f32x4*)(lnb + g * 128 + c0 + 4);
            const float xv[8] = {bflo(a.x), bfhi(a.x), bflo(a.y), bfhi(a.y), bflo(a.z), bfhi(a.z), bflo(a.w), bfhi(a.w)};
#pragma unroll
            for (int e = 0; e < 8; ++e) { const float gg = e < 4 ? g0[e & 3] : g1[e & 3], bb = e < 4 ? b0[e & 3] : b1[e & 3]; const float y = (xv[e] - sj.x) * sj.y * gg + bb;
                *(LAS bf16*)(vt + (c0 + e) * GM_VP + j * 2) = (bf16)f2bf(y); } }
        if (g < 7) {
#pragma unroll
            for (int q4 = 0; q4 < 4; ++q4) vr[q4] = *(const GAS v4u*)(vsrc + (g + 1) * 128 + q4 * 8);
        }
        __syncthreads();
#pragma unroll
        for (int ct = 0; ct < 8; ++ct) { f32x4 acc = {0.f, 0.f, 0.f, 0.f};
#pragma unroll
            for (int ks = 0; ks < 4; ++ks) { const bf16x8 af = *(const LAS bf16x8*)(vt + (ct * 16 + fr) * GM_VP + (ks * 32 + fq * 8) * 2); acc = __builtin_amdgcn_mfma_f32_16x16x32_bf16(af, wf[ks], acc, 0, 0, 0); }
            const v2u u2 = uu[ct];
            v2u w; w.x = cvtpk(bflo(u2.x) * (acc[0] + bias), bfhi(u2.x) * (acc[1] + bias)); w.y = cvtpk(bflo(u2.y) * (acc[2] + bias), bfhi(u2.y) * (acc[3] + bias));
            *(GAS v2u*)(F.Y + (size_t)(row0 + tok) * YW + BW + g * 128 + ct * 16 + 4 * fq) = w; }
        __syncthreads();
    }
}

constexpr int PL_DP = 528;
template <int GI> __device__ __forceinline__ void pool_unit(Frame& F, int row0, int l) {
    int tid_ = F.ltid(); asm volatile("" : "+v"(tid_)); const int tid = tid_, lane = tid & 63, wid = __builtin_amdgcn_readfirstlane(F.ltid() >> 6);
    LAS unsigned char* dt = F.lds;
    const bf16* Z = F.Z;
    constexpr int W = 2 << GI, HW = W / 2, NR = 8 + W - 1;
    const int seqlen = row0 < MLAT ? SEQ : CTXL; const int s0 = row0 < MLAT ? (row0 & ~(SEQ - 1)) : MLAT + ((row0 - MLAT) & ~(CTXL - 1));
    const int fr = lane & 15, fq = lane >> 4;
    bf16x8 wa[8][2];
    { const bf16* wp = F.Wpool + ((size_t)l * 4 + GI) * 65536 + (size_t)(wid * 32 + fr) * 256 + fq * 8;
#pragma unroll
      for (int ks = 0; ks < 8; ++ks) { wa[ks][0] = *(const GAS bf16x8*)(wp + ks * 32); wa[ks][1] = *(const GAS bf16x8*)(wp + 16 * 256 + ks * 32); } }
    __syncthreads();
    { const int ch = tid & 31, tg = tid >> 5;
      const bf16* zc = Z + C_OFF + GI * 256 + ch * 8; const int p0 = row0 - s0 + tg * 8;
      v4u rw[NR];
#pragma unroll
      for (int k = 0; k < NR; ++k) { const int q = p0 - HW + k; const bool ok = (q >= 0) && (q < seqlen); const int qq = ok ? q : p0; const v4u a = *(const GAS v4u*)(zc + (size_t)(s0 + qq) * INW); rw[k] = ok ? a : (v4u){0u, 0u, 0u, 0u}; }
      float sum[8] = {0.f, 0.f, 0.f, 0.f, 0.f, 0.f, 0.f, 0.f};
#pragma unroll
      for (int k = 0; k < W; ++k) { const v4u a = rw[k]; sum[0] += bflo(a.x); sum[1] += bfhi(a.x); sum[2] += bflo(a.y); sum[3] += bfhi(a.y); sum[4] += bflo(a.z); sum[5] += bfhi(a.z); sum[6] += bflo(a.w); sum[7] += bfhi(a.w); }
#pragma unroll
      for (int i = 0; i < 8; ++i) { const int p = p0 + i; const int lo = p - HW < 0 ? 0 : p - HW; const int hi = p - HW + W > seqlen ? seqlen : p - HW + W; const float inv = 1.0f / (float)(hi - lo);
          const v4u zz = rw[i + HW];
          v4u o; o.x = pk2(sum[0] * inv - bflo(zz.x), sum[1] * inv - bfhi(zz.x)); o.y = pk2(sum[2] * inv - bflo(zz.y), sum[3] * inv - bfhi(zz.y));
          o.z = pk2(sum[4] * inv - bflo(zz.z), sum[5] * inv - bfhi(zz.z)); o.w = pk2(sum[6] * inv - bflo(zz.w), sum[7] * inv - bfhi(zz.w));
          *(LAS v4u*)(dt + (tg * 8 + i) * PL_DP + ch * 16) = o;
          if (i < 7) { const v4u a = rw[i + W], b = rw[i];
              sum[0] += bflo(a.x) - bflo(b.x); sum[1] += bfhi(a.x) - bfhi(b.x); sum[2] += bflo(a.y) - bflo(b.y); sum[3] += bfhi(a.y) - bfhi(b.y);
              sum[4] += bflo(a.z) - bflo(b.z); sum[5] += bfhi(a.z) - bfhi(b.z); sum[6] += bflo(a.w) - bflo(b.w); sum[7] += bfhi(a.w) - bfhi(b.w); } } }
    __syncthreads();
    { f32x4 acc[2][8];
#pragma unroll
      for (int a = 0; a < 2; ++a)
#pragma unroll
          for (int tt = 0; tt < 8; ++tt) acc[a][tt] = (f32x4){0.f, 0.f, 0.f, 0.f};
#pragma unroll
      for (int ks = 0; ks < 8; ++ks) {
#pragma unroll
          for (int tt = 0; tt < 8; ++tt) { const bf16x8 bfr = *(const LAS bf16x8*)(dt + (tt * 16 + fr) * PL_DP + (ks * 32 + fq * 8) * 2);
              acc[0][tt] = __builtin_amdgcn_mfma_f32_16x16x32_bf16(wa[ks][0], bfr, acc[0][tt], 0, 0, 0); acc[1][tt] = __builtin_amdgcn_mfma_f32_16x16x32_bf16(wa[ks][1], bfr, acc[1][tt], 0, 0, 0); } }
      const float* ps = F.pool_scale + (size_t)l * BW + GI * 256;
#pragma unroll
      for (int a = 0; a < 2; ++a) { const int dd = wid * 32 + a * 16 + 4 * fq; const f32x4 sc = *(const f32x4*)(ps + dd);
#pragma unroll
          for (int tt = 0; tt < 8; ++tt) { const f32x4 v = acc[a][tt] * sc; v2u wv; wv.x = cvtpk(v[0], v[1]); wv.y = cvtpk(v[2], v[3]);
              *(GAS v2u*)(F.Y + (size_t)(row0 + tt * 16 + fr) * YW + 2 * BW + GI * 256 + dd) = wv; } } }
}
__device__ __forceinline__ void pool_dispatch(Frame& F, int row0, int g, int l) {
    if (g == 0) pool_unit<0>(F, row0, l); else if (g == 1) pool_unit<1>(F, row0, l); else if (g == 2) pool_unit<2>(F, row0, l); else pool_unit<3>(F, row0, l);
}

#ifndef MIXM
#define MIXM 7
#endif
__device__ __forceinline__ void phase_mixers(Frame& F, int l, float lam_init) {
    const bool last = (l == DEPTH - 1);
    float d01 = 0.f, d23 = 0.f; const float* lq = F.lam_qk + (size_t)l * 256;
    for (int i = 0; i < 64; ++i) { d01 += lq[i] * lq[64 + i]; d23 += lq[128 + i] * lq[192 + i]; }
    const float lam = __expf(d01) - __expf(d23) + lam_init; const float oscale = 1.0f - lam_init;
    const float* subg = F.subln_g + (size_t)l * 128;
#ifndef REP_ATT
#define REP_ATT 1
#endif
#ifndef REP_GP
#define REP_GP 1
#endif
#pragma nounroll
    for (int i = 0; i < 5 * REP_ATT; ++i) { const int uid = F.vcu + F.G * (i % 5);
        if (!(MIXM & 1)) continue;
        if (uid < 1024) attn_unit(F, uid >> 8, (uid >> 5) & 7, uid & 31, false, lam, oscale, subg);
        else if (!last && uid < 1088) attn_unit(F, (uid - 1024) >> 4, ((uid - 1024) >> 1) & 7, uid & 1, true, lam, oscale, subg);
        if (TAILWORK == 2 && !last && i == (F.vcu & 3)) { __syncthreads(); const int gw_ = F.vcu * NWAVES + __builtin_amdgcn_readfirstlane(F.ltid() >> 6); ada_partial_layer(F, l + 1, gw_, F.G * NWAVES); cvt_layer(F, l + 1, gw_, F.G * NWAVES); } }
    const int nchunk = last ? MLAT / 128 : MTOT / 128;
#pragma nounroll
    for (int rgp = 0; rgp < REP_GP; ++rgp) {
    if (MIXM & 2) for (int cidx = F.G - 1 - F.vcu; cidx < nchunk; cidx += F.G) gmlp_unit(F, cidx * 128, l);
    if (MIXM & 4) { const int nfree = F.G - nchunk, npool = nchunk * 4;
        if (nfree > 0 && F.G == 256) {
            if (F.vcu < nfree) { for (int k = 0; k < 4; ++k) { const int u = F.vcu * 4 + k; if (u < npool) pool_dispatch(F, (u >> 2) * 128, u & 3, l); } }
            else { for (int u = nfree * 4 + (F.vcu - nfree); u < npool; u += nchunk) pool_dispatch(F, (u >> 2) * 128, u & 3, l); }
        } else { for (int u = F.vcu; u < npool; u += F.G) pool_dispatch(F, (u >> 2) * 128, u & 3, l); } }
    }
    __syncthreads();
}

#ifndef ALIGN_P3
#define ALIGN_P3 true
#endif
#ifndef WGM_P1
#define WGM_P1 4
#endif
#ifndef WGM_P5
#define WGM_P5 4
#endif
#ifndef WGM_N8
#define WGM_N8 4
#endif
#ifndef SP2_BIG
#define SP2_BIG true
#endif
#ifndef ALIGN_BIG
#define ALIGN_BIG true
#endif
#ifndef STAGGER
#define STAGGER 0
#endif
__device__ __forceinline__ void phase_stagger(int slot) { if (STAGGER) for (int i = 0; i < slot * 3; ++i) __builtin_amdgcn_s_sleep(8); }
#ifndef MK_ONE_LAUNCH
#define MK_ONE_LAUNCH 1
#endif
constexpr int NPHASE = 3 + 8 * DEPTH;
struct Args { const float* in[23]; float* out; unsigned char* ws; int ph_lo, ph_hi; float lam_init[4]; };
__global__ void __launch_bounds__(NWAVES * 64, 2) fwd(Args args) {
    extern __shared__ __attribute__((aligned(16))) unsigned char lds[];
    Frame F;
    F.lds = (LAS unsigned char*)lds;
    F.MISC = (volatile LAS unsigned*)(F.lds + MISC_OFF);
    F.G = gridDim.x; { const int bx = blockIdx.x; F.bx = bx; F.vcu = (F.G % 8 == 0) ? (bx % 8) * (F.G / 8) + bx / 8 : bx; }
    unsigned char* ws = args.ws;
    F.ctl = (gu32*)(ws + WS_CTL);
    frame_ptrs(F);
    for (int u = F.ltid(); u < (LDS_BYTES - LDSCTL_OFF) / 4; u += NWAVES * 64) ((LAS unsigned*)(F.lds + LDSCTL_OFF))[u] = 0u;
    __syncthreads();
#if MK_ONE_LAUNCH
    constexpr int lo = 0, hi = NPHASE; constexpr bool use_bar = true;
#else
    const int lo = args.ph_lo, hi = args.ph_hi;
    const bool use_bar = (hi - lo) > 1;
#endif
    XcdBarrier bar; bar.bar = (unsigned*)(F.ctl + CW_BAR); bar.x = 0; bar.st = nullptr;
    if (use_bar) bar = xcd_barrier_post((unsigned*)(F.ctl + CW_BAR), F.MISC + 8);
#ifndef PHM
#define PHM 0xFFFF
#endif
#define IN(k) (lo <= (k) && (k) < hi)
#define KIND(b) ((PHM >> (b)) & 1)
#ifndef REP_MASK
#define REP_MASK 0
#endif
#define NREP(b) (((REP_MASK >> (b)) & 1) ? 2 : 1)
#define BARRIER() do { XcdBarrier b_ = bar; asm volatile("" : "+s"(b_.x)); xcd_barrier(b_); } while (0)
#ifndef DRY_EPI
#define DRY_EPI 0
#endif
#ifndef BAR_REP
#define BAR_REP 1
#endif
#define SEAM(k) do { if (IN(k) && IN((k) + 1)) { for (int br_ = 0; br_ < BAR_REP; ++br_) BARRIER(); } } while (0)

    if (KIND(0) && IN(0)) { for (int rep = 0; rep < NREP(0); ++rep) { frame_ptrs(F); phase_a1(F); if (rep + 1 < NREP(0)) BARRIER(); } } SEAM(0);
    if (KIND(1) && IN(1)) { frame_ptrs(F); phase_a2(F); } SEAM(1);
    if (KIND(2) && IN(2)) { frame_ptrs(F); phase_a3(F); } SEAM(2);

#pragma nounroll
    for (int l = 0; l < DEPTH; ++l) {
        const int pb = 3 + 8 * l; const bool last = (l == DEPTH - 1);
        { int g_ = F.G, v_ = F.vcu, b_ = F.bx; asm volatile("" : "+s"(g_), "+s"(v_), "+s"(b_)); F.G = g_; F.vcu = v_; F.bx = b_; }
        const int Mrows = last ? MLAT : MTOT;
        if (KIND(3) && IN(pb + 0)) for (int rep = 0; rep < NREP(3); ++rep) { if (rep) BARRIER(); frame_ptrs(F);
            pg8::Gemm g{F.HA, F.Win + (size_t)l * INW * D, MTOT, INW, D, D, D}; pg8::StaticOrder S; S.init(MTOT, INW, F.G, F.bx, WGM_P1);
            pg8::EpiInProj E{F.Z, F.rope, QSCALE, INW, MLAT, F.KB, F.VB, (rep && DRY_EPI) ? 1 : 0};
            phase_stagger((F.bx >> 3) & 7);
            pg8::gemm_phase<pg8::EpiInProj, pg8::StaticOrder, ALIGN_BIG, SP2_BIG>(F.lds + RING_OFF, g, S, E);
        }
        SEAM(pb + 0);
        if (KIND(4) && IN(pb + 1)) for (int rep = 0; rep < NREP(4); ++rep) { if (rep) BARRIER(); frame_ptrs(F); phase_mixers(F, l, args.lam_init[l]); }
        SEAM(pb + 1);
        if (KIND(5) && IN(pb + 2)) for (int rep = 0; rep < NREP(5); ++rep) { if (rep) BARRIER(); frame_ptrs(F);
            pg8::Gemm g{F.Y, F.Wbr + (size_t)l * D * YW, Mrows, D, YW, YW, YW}; pg8::StaticOrder S; S.init(Mrows, D, F.G, F.bx, WGM_N8);
            pg8::EpiGate E{F.Z + G_OFF, INW, F.MG, D};
            pg8::gemm_phase<pg8::EpiGate, pg8::StaticOrder, ALIGN_P3, true>(F.lds + RING_OFF, g, S, E);
        }
        SEAM(pb + 2);
        if (KIND(6) && IN(pb + 3)) for (int rep = 0; rep < NREP(6); ++rep) { if (rep) BARRIER(); frame_ptrs(F);
            void* tw = rep ? (void*)(F.Z + (size_t)134 * MiB) : (void*)F.Y;
            { pg8::Gemm g{F.MG, F.Wout + (size_t)l * D * D, MLAT, D, D, D, D}; pg8::StaticOrder S; S.init(MLAT, D, F.G, F.bx, WGM_N8);
              pg8::EpiResidT<false> E{F.mods + (size_t)l * 5 * INW + 2 * D, INW, tw, D, 1, MLAT};
              pg8::gemm_phase<pg8::EpiResidT<false>, pg8::StaticOrder, true, true>(F.lds + RING_OFF, g, S, E); }
            if (!last) { pg8::Gemm g{F.MG, F.Wout + (size_t)l * D * D, MTOT, D, 256, D, D}; pg8::SplitOrder S; S.init(MLAT / 256, 32, 8, 256, F.G, F.bx);
              pg8::EpiResidT<true> E{F.mods + (size_t)l * 5 * INW + 2 * D, INW, rep ? (void*)(F.Z + (size_t)170 * MiB) : (void*)(F.Z + (size_t)100 * MiB), D, 256, MLAT};
              pg8::gemm_phase<pg8::EpiResidT<true>, pg8::SplitOrder, true, true>(F.lds + RING_OFF, g, S, E); }
            if (TAILWORK == 1 && !last && F.bx >= 32 && rep == 0) ada_partial_layer(F, l + 1, (F.bx - 32) * NWAVES + __builtin_amdgcn_readfirstlane(F.ltid() >> 6), (F.G - 32) * NWAVES);
        }
        SEAM(pb + 3);
        if (KIND(7) && IN(pb + 4)) { frame_ptrs(F); if (NREP(7) > 1) { phase_ln(F, F.ln1_g + (size_t)l * D, F.ln1_b + (size_t)l * D, Mrows, false, true, l, 3 * D, last ? 0 : 8, true); BARRIER(); frame_ptrs(F); }
            phase_ln(F, F.ln1_g + (size_t)l * D, F.ln1_b + (size_t)l * D, Mrows, false, true, l, 3 * D, last ? 0 : 8); if (TAILWORK && !last) mods_reduce_layer(F, l + 1); }
        SEAM(pb + 4);
        if (KIND(8) && IN(pb + 5)) for (int rep = 0; rep < NREP(8); ++rep) { if (rep) BARRIER(); frame_ptrs(F);
            pg8::Gemm g{F.HA, F.Wgu + (size_t)l * 2 * FFH * D, Mrows, 2 * FFH, D, D, D}; pg8::StaticOrder S; S.init(Mrows, 2 * FFH, F.G, F.bx, WGM_P5);
            pg8::EpiSwiglu E{F.Z, FFH};
            phase_stagger((F.bx >> 3) & 7);
            pg8::gemm_phase<pg8::EpiSwiglu, pg8::StaticOrder, ALIGN_BIG, SP2_BIG>(F.lds + RING_OFF, g, S, E);
        }
        SEAM(pb + 5);
        if (KIND(9) && IN(pb + 6)) for (int rep = 0; rep < NREP(9); ++rep) { if (rep) BARRIER(); frame_ptrs(F);
            void* tw = rep ? (void*)(F.Z + (size_t)134 * MiB) : (void*)F.Y;
            { pg8::Gemm g{F.Z, F.Wdn + (size_t)l * D * FFH, MLAT, D, FFH, FFH, FFH}; pg8::StaticOrder S; S.init(MLAT, D, F.G, F.bx, WGM_N8);
              pg8::EpiResidT<false> E{F.mods + (size_t)l * 5 * INW + 5 * D, INW, tw, D, 1, MLAT};
              pg8::gemm_phase<pg8::EpiResidT<false>, pg8::StaticOrder, true, true>(F.lds + RING_OFF, g, S, E); }
            if (!last) { pg8::Gemm g{F.Z, F.Wdn + (size_t)l * D * FFH, MTOT, D, FFH / 4, FFH, FFH}; pg8::SplitOrder S; S.init(MLAT / 256, 32, 4, FFH / 4, F.G, F.bx);
              pg8::EpiResidT<true> E{F.mods + (size_t)l * 5 * INW + 5 * D, INW, rep ? (void*)(F.Z + (size_t)170 * MiB) : (void*)(F.Z + (size_t)100 * MiB), D, FFH / 4, MLAT};
              pg8::gemm_phase<pg8::EpiResidT<true>, pg8::SplitOrder, true, true>(F.lds + RING_OFF, g, S, E); }
            if (TAILWORK == 1 && !last && F.bx >= 32 && rep == 0) { __syncthreads(); cvt_layer(F, l + 1, (F.bx - 32) * NWAVES + __builtin_amdgcn_readfirstlane(F.ltid() >> 6), (F.G - 32) * NWAVES); }
        }
        SEAM(pb + 6);
        if (KIND(7) && IN(pb + 7)) { frame_ptrs(F); phase_ln(F, F.ln2_g + (size_t)l * D, F.ln2_b + (size_t)l * D, Mrows, last, !last, last ? l : l + 1, 0, last ? 0 : 4); }
        if (!last) SEAM(pb + 7);
    }
#undef IN
#undef SEAM
}

extern "C" void kernel_launch(void* const* d_in, const int* in_sizes, int n_in, void* d_out, int out_size, void* d_ws, size_t ws_size, hipStream_t stream) {
    static int grid = 0;
    if (grid == 0) {
        if (n_in != 23 || in_sizes[0] != MLAT * D || out_size != MLAT * D || ws_size < WS_END) {
            fprintf(stderr, "kernel_launch: unexpected shapes / workspace (n_in %d, in0 %d, out %d, ws %zu, need %zu); nothing launched\n", n_in, n_in > 0 ? in_sizes[0] : -1, out_size, ws_size, (size_t)WS_END); grid = -1; return; }
        int dev = 0, cus = 0, per_cu = 0;
        if (hipGetDevice(&dev) != hipSuccess || hipDeviceGetAttribute(&cus, hipDeviceAttributeMultiprocessorCount, dev) != hipSuccess) { grid = -1; return; }
        if (hipFuncSetAttribute((const void*)fwd, hipFuncAttributeMaxDynamicSharedMemorySize, LDS_BYTES) != hipSuccess) { fprintf(stderr, "kernel_launch: hipFuncSetAttribute failed\n"); grid = -1; return; }
        if (hipOccupancyMaxActiveBlocksPerMultiprocessor(&per_cu, (const void*)fwd, NWAVES * 64, LDS_BYTES) != hipSuccess || per_cu < 1) fprintf(stderr, "kernel_launch: occupancy query reports %d\n", per_cu);
        (void)hipGetLastError();
        grid = cus;
    }
    if (grid < 0) return;
    if (hipMemsetAsync((char*)d_ws + WS_CTL, 0, CTL_ZERO_BYTES, stream) != hipSuccess) return;
    Args a{};
    for (int i = 0; i < 23; ++i) a.in[i] = (const float*)d_in[i];
    a.out = (float*)d_out; a.ws = (unsigned char*)d_ws;
    for (int l = 0; l < DEPTH; ++l) a.lam_init[l] = (float)(0.8 - 0.6 * exp(-0.3 * (double)l));
#if MK_ONE_LAUNCH
    a.ph_lo = 0; a.ph_hi = NPHASE;
    hipLaunchKernelGGL(fwd, dim3(grid), dim3(NWAVES * 64), LDS_BYTES, stream, a);
#else
    for (int p = 0; p < NPHASE; ++p) { a.ph_lo = p; a.ph_hi = p + 1; hipLaunchKernelGGL(fwd, dim3(grid), dim3(NWAVES * 64), LDS_BYTES, stream, a); }
#endif
}
```

```cpp
#include <hip/hip_runtime.h>
#include <cstdio>
#include <cstdint>
#include <cmath>
namespace pg8 {
#define PG8_LAS __attribute__((address_space(3)))
typedef unsigned short bf16_t;
typedef short bf16x8 __attribute__((ext_vector_type(8)));
typedef float f32x4 __attribute__((ext_vector_type(4)));
typedef unsigned u32x4 __attribute__((ext_vector_type(4)));
constexpr int BM = 256, BK = 64, HALF = 128, HTB = HALF * BK * 2  , STAGE_BYTES = 8 * HTB, NXCD = 8, WGM = 4;

__host__ __device__ __forceinline__ int lds_byte(int r, int c) { const int st = (r >> 4) * 2 + (c >> 5), rr = r & 15, cc = c & 31, ob = rr * 64 + cc * 2; return st * 1024 + (ob ^ (((ob >> 9) & 1) << 5)); }
__host__ __device__ __forceinline__ void stage_rc(int b, int& R, int& C) { const int st = b / 1024, sb = b % 1024, swz = sb ^ (((sb >> 9) & 1) << 5); R = (st >> 1) * 16 + swz / 64; C = (st & 1) * 32 + (swz % 64) / 2; }
__host__ __device__ __forceinline__ int perm32(int rho) { const int n = rho >> 4, i = rho & 15; return 8 * (i >> 2) + 4 * n + (i & 3); }

struct Unit { int pm, pn, ka; };
struct Gemm { const bf16_t* A; const bf16_t* Bt; int M, N, K, lda, ldb; };

struct StaticOrder {
    int nM, nN, nwg, G, c, wgm;
    __host__ __device__ void init(int M, int N, int G_, int c_, int wgm_ = WGM) { nM = M / BM; nN = N / BM; nwg = nM * nN; G = G_; c = c_; wgm = wgm_; }
    __host__ __device__ bool next(int i, Unit& u) const {
        const long L = (long)i * G + c; if (L >= nwg) return false;
        int wgid = (int)L; { const int q = nwg / NXCD, r = nwg % NXCD, xcd = wgid % NXCD, off = wgid / NXCD; wgid = (xcd < r ? xcd * (q + 1) : r * (q + 1) + (xcd - r) * q) + off; }
        const int nig = wgm * nN, gid = wgid / nig, fm = gid * wgm, gsz = (nM - fm) < wgm ? (nM - fm) : wgm;
        u.pm = fm + ((wgid % nig) % gsz); u.pn = (wgid % nig) / gsz; u.ka = 0; return true;
    }
    __device__ __forceinline__ void a_ready(const Unit&) const {}
    __device__ __forceinline__ void done(const Unit&) const {}
};

struct SplitOrder {
    int nsplit, klen, G, c, pm0, ntile;
    __host__ __device__ void init(int pm0_, int ntile_, int nsplit_, int klen_, int G_, int c_) { pm0 = pm0_; ntile = ntile_; nsplit = nsplit_; klen = klen_; G = G_; c = c_; }
    __host__ __device__ bool next(int i, Unit& u) const { const int L = i * G + c; if (L >= ntile * nsplit) return false; const int tt = L / nsplit; u.pm = pm0 + (tt & 3); u.pn = tt >> 2; u.ka = (L - tt * nsplit) * klen; return true; }
    __device__ __forceinline__ void a_ready(const Unit&) const {}
    __device__ __forceinline__ void done(const Unit&) const {}
};
__device__ __forceinline__ unsigned cvt_pk_bf16(float lo, float hi) { unsigned r; asm volatile("v_cvt_pk_bf16_f32 %0, %1, %2" : "=v"(r) : "v"(lo), "v"(hi)); return r; }
typedef float f32x2 __attribute__((ext_vector_type(2)));
__device__ __forceinline__ f32x2 gelu_pk(f32x2 v) {
    const f32x2 av = __builtin_elementwise_abs(v), d = av * 0.2316418882f + 1.0f;
    f32x2 t; t.x = __builtin_amdgcn_rcpf(d.x); t.y = __builtin_amdgcn_rcpf(d.y);
    f32x2 q = t * 0.5307027145f + (-0.7265760135f); q = q * t + 0.7107068705f; q = q * t + (-0.142248368f); q = q * t + 0.127414796f; q = q * t;
    const f32x2 s = (v * v) * (-0.72134752044f);
    f32x2 e; e.x = __builtin_amdgcn_exp2f(s.x); e.y = __builtin_amdgcn_exp2f(s.y);
    const f32x2 m = v * (q * e), r = v - m;
    f32x2 o; o.x = v.x < 0.f ? m.x : r.x; o.y = v.y < 0.f ? m.y : r.y; return o;
}

#ifndef GATE_NT
#define GATE_NT 0
#endif
#if GATE_NT
#define GATE_LD(p) __builtin_nontemporal_load(p)
#else
#define GATE_LD(p) (*(p))
#endif
#ifndef GATE_ST_NT
#define GATE_ST_NT 0
#endif
#ifndef EPI_NT
#define EPI_NT 0
#endif
typedef unsigned u32x2 __attribute__((ext_vector_type(2)));
__device__ __forceinline__ float bf_lo(unsigned w) { return __uint_as_float(w << 16); }
__device__ __forceinline__ float bf_hi(unsigned w) { return __uint_as_float(w & 0xffff0000u); }
__device__ __forceinline__ void store8_bf16(bf16_t* p, const f32x4 v0, const f32x4 v1) {
    u32x4 w; w.x = cvt_pk_bf16(v0[0], v0[1]); w.y = cvt_pk_bf16(v0[2], v0[3]); w.z = cvt_pk_bf16(v1[0], v1[1]); w.w = cvt_pk_bf16(v1[2], v1[3]);
#if EPI_NT
    __builtin_nontemporal_store(w, (u32x4*)p);
#else
    *(u32x4*)p = w;
#endif
}
__device__ __forceinline__ float sigmoid_f(float x) { return __builtin_amdgcn_rcpf(1.0f + __builtin_amdgcn_exp2f(x * -1.4426950408889634f)); }

struct EpiInProj {
    static constexpr bool PERM = true, AFTER_DRAIN = false; static constexpr int KSEG = 0;
    bf16_t* Z; const float* rope; float qscale; int ldc; int nlat; bf16_t* Kb; bf16_t* Vb; int dry;
    __device__ __forceinline__ void kseg(f32x4 (&)[2][2][4][2], const Unit&, int, int, int, int, int) const {}
    __device__ __forceinline__ void operator()(const f32x4 (&acc)[2][2][4][2], const Unit& u, int wr, int wc, int fr, int fq) const {
        const int pn = u.pn; const int row0 = u.pm * BM + wr * 64 + fr; const int col0 = pn * BM + wc * 32 + 8 * fq;
        if (dry) { float s_ = 0.f;
#pragma unroll
            for (int a_ = 0; a_ < 2; ++a_)
#pragma unroll
                for (int b_ = 0; b_ < 2; ++b_)
#pragma unroll
                    for (int m_ = 0; m_ < 4; ++m_)
#pragma unroll
                        for (int n_ = 0; n_ < 2; ++n_) s_ += acc[a_][b_][m_][n_][0];
            if (s_ != s_) Z[0] = 0; return; }
        if (pn < 8) {
            const float sc = pn < 4 ? qscale : 1.0f;
#pragma unroll
            for (int ai = 0; ai < 2; ++ai)
#pragma unroll
                for (int m = 0; m < 4; ++m) {
                    const int row = row0 + ai * HALF + m * 16; const int t = row & 4095; const int pos = (wc & 1) ? (t & 63) : (t >> 6);
                    f32x4 cs0 = *(const f32x4*)(rope + (pos * 16 + 4 * fq) * 2), cs1 = *(const f32x4*)(rope + (pos * 16 + 4 * fq) * 2 + 4);
                    if (row >= nlat) { cs0 = (f32x4){1.f, 0.f, 1.f, 0.f}; cs1 = cs0; }
                    bf16_t* rowp = Z + (size_t)row * ldc + col0;
                    if (pn >= 4) { const int bb = row < nlat ? (row >> 12) : ((row - nlat) >> 8), key = row < nlat ? 256 + (row & 4095) : ((row - nlat) & 255);
                        rowp = Kb + ((size_t)(bb * 8 + 2 * (pn - 4)) * 4352 + key) * 128 + wc * 32 + 8 * fq; }
#pragma unroll
                    for (int bj = 0; bj < 2; ++bj) {
                        const f32x4 a = acc[ai][bj][m][0], b = acc[ai][bj][m][1];
                        f32x4 o0, o1;
                        o0[0] = (a[0] * cs0[0] - a[1] * cs0[1]) * sc; o0[1] = (a[0] * cs0[1] + a[1] * cs0[0]) * sc;
                        o0[2] = (a[2] * cs0[2] - a[3] * cs0[3]) * sc; o0[3] = (a[2] * cs0[3] + a[3] * cs0[2]) * sc;
                        o1[0] = (b[0] * cs1[0] - b[1] * cs1[1]) * sc; o1[1] = (b[0] * cs1[1] + b[1] * cs1[0]) * sc;
                        o1[2] = (b[2] * cs1[2] - b[3] * cs1[3]) * sc; o1[3] = (b[2] * cs1[3] + b[3] * cs1[2]) * sc;
                        store8_bf16(rowp + (pn >= 4 ? (size_t)bj * 4352 * 128 : (size_t)bj * HALF), o0, o1);
                    }
                }
        } else if (pn < 12) {
#pragma unroll
            for (int ai = 0; ai < 2; ++ai)
#pragma unroll
                for (int m = 0; m < 4; ++m) { const int row = row0 + ai * HALF + m * 16; const int bb = row < nlat ? (row >> 12) : ((row - nlat) >> 8), key = row < nlat ? 256 + (row & 4095) : ((row - nlat) & 255);
                    bf16_t* rowp = Vb + ((size_t)(bb * 8 + 2 * (pn - 8)) * 4352 + key) * 128 + wc * 32 + 8 * fq;
#pragma unroll
                    for (int bj = 0; bj < 2; ++bj) store8_bf16(rowp + (size_t)bj * 4352 * 128, acc[ai][bj][m][0], acc[ai][bj][m][1]); }
        } else if (pn >= 20 && pn < 24) {
#pragma unroll
            for (int ai = 0; ai < 2; ++ai)
#pragma unroll
                for (int m = 0; m < 4; ++m) { bf16_t* rowp = Z + (size_t)(row0 + ai * HALF + m * 16) * ldc + col0;
#pragma unroll
                    for (int bj = 0; bj < 2; ++bj) store8_bf16(rowp + bj * HALF, acc[ai][bj][m][0], acc[ai][bj][m][1]); }
        } else if (pn < 20) {
#pragma unroll
            for (int ai = 0; ai < 2; ++ai)
#pragma unroll
                for (int m = 0; m < 4; ++m) { bf16_t* rowp = Z + (size_t)(row0 + ai * HALF + m * 16) * ldc + col0;
#pragma unroll
                    for (int bj = 0; bj < 2; ++bj) { const f32x4 v0 = acc[ai][bj][m][0], v1 = acc[ai][bj][m][1];
                        const f32x2 a = gelu_pk((f32x2){v0[0], v0[1]}), b = gelu_pk((f32x2){v0[2], v0[3]}), c = gelu_pk((f32x2){v1[0], v1[1]}), d = gelu_pk((f32x2){v1[2], v1[3]});
                        store8_bf16(rowp + bj * HALF, (f32x4){a.x, a.y, b.x, b.y}, (f32x4){c.x, c.y, d.x, d.y}); } }
        } else {
#pragma unroll
            for (int ai = 0; ai < 2; ++ai)
#pragma unroll
                for (int m = 0; m < 4; ++m) { bf16_t* rowp = Z + (size_t)(row0 + ai * HALF + m * 16) * ldc + col0;
#pragma unroll
                    for (int bj = 0; bj < 2; ++bj) { const f32x4 v0 = acc[ai][bj][m][0], v1 = acc[ai][bj][m][1]; f32x4 o0, o1;
#pragma unroll
                        for (int i = 0; i < 4; ++i) { o0[i] = __builtin_fmaxf(sigmoid_f(v0[i]), 1e-12f); o1[i] = __builtin_fmaxf(sigmoid_f(v1[i]), 1e-12f); }
#if GATE_ST_NT
                        { u32x4 w; w.x = cvt_pk_bf16(o0[0], o0[1]); w.y = cvt_pk_bf16(o0[2], o0[3]); w.z = cvt_pk_bf16(o1[0], o1[1]); w.w = cvt_pk_bf16(o1[2], o1[3]); __builtin_nontemporal_store(w, (u32x4*)(rowp + bj * HALF)); } } }
#else
                        store8_bf16(rowp + bj * HALF, o0, o1); } }
#endif
        }
    }
};

struct EpiGate {
    static constexpr bool PERM = true, AFTER_DRAIN = false; static constexpr int KSEG = 16;
    const bf16_t* G; int ldg; bf16_t* O; int ldo;
    __device__ __forceinline__ void kseg(f32x4 (&acc)[2][2][4][2], const Unit& u, int seg, int wr, int wc, int fr, int fq) const {
        const int row0 = u.pm * BM + wr * 64 + fr; const int col0 = u.pn * BM + wc * 32 + 8 * fq;
#pragma unroll
        for (int ai = 0; ai < 2; ++ai) {
            u32x4 ga[4][2], gb[4][2];
#pragma unroll
            for (int m = 0; m < 4; ++m) { const bf16_t* gp = G + (size_t)(row0 + ai * HALF + m * 16) * ldg + (seg - 1) * 2048 + col0;
#pragma unroll
                for (int bj = 0; bj < 2; ++bj) { ga[m][bj] = GATE_LD((const u32x4*)(gp + bj * HALF)); gb[m][bj] = GATE_LD((const u32x4*)(gp + 2048 + bj * HALF)); } }
#pragma unroll
            for (int m = 0; m < 4; ++m)
#pragma unroll
                for (int bj = 0; bj < 2; ++bj) { const u32x4 a = ga[m][bj], b = gb[m][bj];
                    f32x4 r0, r1;
                    r0[0] = bf_lo(a.x) * __builtin_amdgcn_rcpf(bf_lo(b.x)); r0[1] = bf_hi(a.x) * __builtin_amdgcn_rcpf(bf_hi(b.x));
                    r0[2] = bf_lo(a.y) * __builtin_amdgcn_rcpf(bf_lo(b.y)); r0[3] = bf_hi(a.y) * __builtin_amdgcn_rcpf(bf_hi(b.y));
                    r1[0] = bf_lo(a.z) * __builtin_amdgcn_rcpf(bf_lo(b.z)); r1[1] = bf_hi(a.z) * __builtin_amdgcn_rcpf(bf_hi(b.z));
                    r1[2] = bf_lo(a.w) * __builtin_amdgcn_rcpf(bf_lo(b.w)); r1[3] = bf_hi(a.w) * __builtin_amdgcn_rcpf(bf_hi(b.w));
                    acc[ai][bj][m][0] *= r0; acc[ai][bj][m][1] *= r1; }
            asm volatile("" ::: "memory"); }
    }
    __device__ __forceinline__ void operator()(const f32x4 (&acc)[2][2][4][2], const Unit& u, int wr, int wc, int fr, int fq) const {
        const int row0 = u.pm * BM + wr * 64 + fr; const int col0 = u.pn * BM + wc * 32 + 8 * fq;
        u32x4 gg[2][4][2];
#pragma unroll
        for (int ai = 0; ai < 2; ++ai)
#pragma unroll
            for (int m = 0; m < 4; ++m) { const bf16_t* gp = G + (size_t)(row0 + ai * HALF + m * 16) * ldg + 2 * 2048 + col0;
#pragma unroll
                for (int bj = 0; bj < 2; ++bj) gg[ai][m][bj] = GATE_LD((const u32x4*)(gp + bj * HALF)); }
#pragma unroll
        for (int ai = 0; ai < 2; ++ai)
#pragma unroll
            for (int m = 0; m < 4; ++m) { bf16_t* op = O + (size_t)(row0 + ai * HALF + m * 16) * ldo + col0;
#pragma unroll
                for (int bj = 0; bj < 2; ++bj) { const u32x4 g = gg[ai][m][bj];
                    const f32x4 g0 = (f32x4){bf_lo(g.x), bf_hi(g.x), bf_lo(g.y), bf_hi(g.y)}, g1 = (f32x4){bf_lo(g.z), bf_hi(g.z), bf_lo(g.w), bf_hi(g.w)};
                    store8_bf16(op + bj * HALF, acc[ai][bj][m][0] * g0, acc[ai][bj][m][1] * g1); } }
    }
};

template <bool SLAB> struct EpiResidT {
    static constexpr bool PERM = !SLAB, AFTER_DRAIN = false; static constexpr int KSEG = 0;
    const float* gv; int gstride; void* Tw; int ldc; int klen, nlat;
    __device__ __forceinline__ void kseg(f32x4 (&)[2][2][4][2], const Unit&, int, int, int, int, int) const {}
    __device__ __forceinline__ void operator()(const f32x4 (&acc)[2][2][4][2], const Unit& u, int wr, int wc, int fr, int fq) const {
        const int row0 = u.pm * BM + wr * 64 + fr; const int grp = u.pm < 64 ? (u.pm >> 4) : 4;
        if constexpr (SLAB) {
            const int col0 = u.pn * BM + wc * 32 + 4 * fq;
            f32x4 g[2][2];
#pragma unroll
            for (int bj = 0; bj < 2; ++bj)
#pragma unroll
                for (int n = 0; n < 2; ++n) g[bj][n] = *(const f32x4*)(gv + (size_t)grp * gstride + col0 + bj * HALF + n * 16);
#pragma unroll
            for (int ai = 0; ai < 2; ++ai)
#pragma unroll
                for (int m = 0; m < 4; ++m) { float* pp = (float*)Tw + ((size_t)(u.ka / klen) * 1024 + (size_t)(row0 + ai * HALF + m * 16 - nlat)) * ldc + col0;
#pragma unroll
                    for (int bj = 0; bj < 2; ++bj)
#pragma unroll
                        for (int n = 0; n < 2; ++n) *(f32x4*)(pp + bj * HALF + n * 16) = g[bj][n] * acc[ai][bj][m][n]; }
        } else {
            const int col0 = u.pn * BM + wc * 32 + 8 * fq;
            f32x4 g[2][2];
#pragma unroll
            for (int bj = 0; bj < 2; ++bj)
#pragma unroll
                for (int n = 0; n < 2; ++n) g[bj][n] = *(const f32x4*)(gv + (size_t)grp * gstride + col0 + bj * HALF + n * 4);
#pragma unroll
            for (int ai = 0; ai < 2; ++ai)
#pragma unroll
                for (int m = 0; m < 4; ++m) { bf16_t* tp = (bf16_t*)Tw + (size_t)(row0 + ai * HALF + m * 16) * ldc + col0;
#pragma unroll
                    for (int bj = 0; bj < 2; ++bj) store8_bf16(tp + bj * HALF, g[bj][0] * acc[ai][bj][m][0], g[bj][1] * acc[ai][bj][m][1]); }
        }
    }
};

struct EpiSwiglu {
    static constexpr bool PERM = true, AFTER_DRAIN = false; static constexpr int KSEG = 0;
    bf16_t* H; int ldc;
    __device__ __forceinline__ void kseg(f32x4 (&)[2][2][4][2], const Unit&, int, int, int, int, int) const {}
    __device__ __forceinline__ void operator()(const f32x4 (&acc)[2][2][4][2], const Unit& u, int wr, int wc, int fr, int fq) const {
        const int row0 = u.pm * BM + wr * 64 + fr, col0 = u.pn * HALF + wc * 32 + 8 * fq;
#pragma unroll
        for (int ai = 0; ai < 2; ++ai)
#pragma unroll
            for (int m = 0; m < 4; ++m) { bf16_t* rowp = H + (size_t)(row0 + ai * HALF + m * 16) * ldc + col0; f32x4 o[2];
#pragma unroll
                for (int n = 0; n < 2; ++n) { const f32x4 gt = acc[ai][0][m][n], up = acc[ai][1][m][n];
#pragma unroll
                    for (int i = 0; i < 4; ++i) o[n][i] = gt[i] * sigmoid_f(gt[i]) * up[i]; }
                store8_bf16(rowp, o[0], o[1]); }
    }
};
template <class Epi, class Sched, bool ALIGN_EPI = false, bool SP2 = false>
__device__ __forceinline__ void gemm_phase(PG8_LAS unsigned char* lds, const Gemm g, const Sched& S, const Epi& E) {
    int tid_ = threadIdx.x; asm volatile("" : "+v"(tid_));
    const int tid = tid_, wid = __builtin_amdgcn_readfirstlane(tid >> 6), lane = tid & 63, wr = wid >> 2, wc = wid & 3, fr = lane & 15, fq = lane >> 4;
    const int K = g.K, nt = K / BK;
    unsigned voffA[2], voffB[2];
#pragma unroll
    for (int i = 0; i < 2; ++i) { int R, C; stage_rc(tid * 16 + i * 8192, R, C); const int Rb = Epi::PERM ? ((R & ~31) + perm32(R & 31)) : R;
        voffA[i] = (unsigned)(R * g.lda + C) * 2u; voffB[i] = (unsigned)(Rb * g.ldb + C) * 2u; }
    const size_t kstep = (size_t)(BK * 2);
    const size_t hstepA = (size_t)HALF * g.lda * 2, hstepB = (size_t)HALF * g.ldb * 2;
    const size_t tstepA = 2 * hstepA, tstepB = 2 * hstepB;
    const unsigned ldsw = (unsigned)wid * 1024u;
    const int aoff = lds_byte(wr * 64 + fr, fq * 8), boff = lds_byte(wc * 32 + fr, fq * 8);
#define PG8_SA(b, h) (((b) * 2 + (h)) * HTB)
#define PG8_SB(b, h) ((4 + (b) * 2 + (h)) * HTB)
#define PG8_STAGE(bufoff, gbase, voff) do { _Pragma("unroll") for (int _i = 0; _i < 2; ++_i) \
        __builtin_amdgcn_global_load_lds((const unsigned*)((const char*)(gbase) + (voff)[_i]), (PG8_LAS unsigned*)(lds + (bufoff) + ldsw + _i * 8192), 16, 0, 0); } while (0)
#define PG8_LDA(dst, b, h) do { _Pragma("unroll") for (int m = 0; m < 4; ++m) _Pragma("unroll") for (int k = 0; k < 2; ++k) dst[m][k] = *(const PG8_LAS bf16x8*)(lds + PG8_SA(b, h) + aoff + m * 2048 + k * 1024); } while (0)
#define PG8_LDB(dst, b, h) do { _Pragma("unroll") for (int n = 0; n < 2; ++n) _Pragma("unroll") for (int k = 0; k < 2; ++k) dst[n][k] = *(const PG8_LAS bf16x8*)(lds + PG8_SB(b, h) + boff + n * 2048 + k * 1024); } while (0)
#define PG8_MMA(ai, bj, At, Bt) do { __builtin_amdgcn_s_setprio(1); _Pragma("unroll") for (int m = 0; m < 4; ++m) _Pragma("unroll") for (int n = 0; n < 2; ++n) _Pragma("unroll") for (int k = 0; k < 2; ++k) \
        acc[ai][bj][m][n] = __builtin_amdgcn_mfma_f32_16x16x32_bf16(Bt[n][k], At[m][k], acc[ai][bj][m][n], 0, 0, 0); __builtin_amdgcn_s_setprio(0); } while (0)
#define PG8_WAIT_V(n) asm volatile("s_waitcnt vmcnt(" #n ")" ::: "memory")
#define PG8_WAIT_L(n) asm volatile("s_waitcnt lgkmcnt(" #n ")" ::: "memory")
#define PG8_BAR __builtin_amdgcn_s_barrier()
#define PG8_SCHED __builtin_amdgcn_sched_barrier(0)
    Unit cur, nxt; int ui = 0;
    if (!S.next(0, cur)) return;
    f32x4 acc[2][2][4][2];
#pragma unroll
    for (int a = 0; a < 2; ++a)
#pragma unroll
        for (int b = 0; b < 2; ++b)
#pragma unroll
            for (int m = 0; m < 4; ++m)
#pragma unroll
                for (int n = 0; n < 2; ++n) acc[a][b][m][n] = (f32x4){0.f, 0.f, 0.f, 0.f};
    bf16x8 At[4][2], B0[2][2], B1[2][2];
    const char* cA = (const char*)g.A + (size_t)cur.pm * tstepA + (size_t)cur.ka * 2; const char* cB = (const char*)g.Bt + (size_t)cur.pn * tstepB + (size_t)cur.ka * 2;
    S.a_ready(cur);
    if constexpr (SP2) {
        PG8_STAGE(PG8_SB(0, 0), cB, voffB); PG8_STAGE(PG8_SB(0, 1), cB + hstepB, voffB); PG8_STAGE(PG8_SA(0, 0), cA, voffA); PG8_STAGE(PG8_SA(0, 1), cA + hstepA, voffA);
        if (wr == 1) PG8_BAR;
        PG8_WAIT_V(2); PG8_BAR;
        PG8_STAGE(PG8_SB(1, 0), cB + kstep, voffB); PG8_STAGE(PG8_SA(1, 0), cA + kstep, voffA); PG8_STAGE(PG8_SB(1, 1), cB + hstepB + kstep, voffB);
        PG8_WAIT_V(6); PG8_BAR;
    } else {
        PG8_STAGE(PG8_SB(0, 0), cB, voffB); PG8_STAGE(PG8_SA(0, 0), cA, voffA); PG8_STAGE(PG8_SB(0, 1), cB + hstepB, voffB); PG8_STAGE(PG8_SA(0, 1), cA + hstepA, voffA);
        if (wr == 1) PG8_BAR;
        PG8_WAIT_V(4); PG8_BAR;
        PG8_STAGE(PG8_SB(1, 0), cB + kstep, voffB); PG8_STAGE(PG8_SA(1, 0), cA + kstep, voffA); PG8_STAGE(PG8_SB(1, 1), cB + hstepB + kstep, voffB);
        PG8_WAIT_V(6); PG8_BAR;
    }
    for (;;) {
        const bool has_next = S.next(ui + 1, nxt);
        const char* nA = has_next ? (const char*)g.A + (size_t)nxt.pm * tstepA + (size_t)nxt.ka * 2 : cA; const char* nB = has_next ? (const char*)g.Bt + (size_t)nxt.pn * tstepB + (size_t)nxt.ka * 2 : cB;
        for (int t = 0; t < nt; t += 2) {
            const bool last = (t == nt - 2);
            if constexpr (Epi::KSEG > 0) { if (t > 0 && (t % Epi::KSEG) == 0) E.kseg(acc, cur, t / Epi::KSEG, wr, wc, fr, fq); }
            const char* a1 = cA + (size_t)(t + 1) * kstep;
            const char* a2 = last ? nA : cA + (size_t)(t + 2) * kstep; const char* b2 = last ? nB : cB + (size_t)(t + 2) * kstep;
            const char* a3 = a2 + kstep; const char* b3 = b2 + kstep;
            if (last && has_next) S.a_ready(nxt);
            if constexpr (SP2) {
            PG8_LDB(B0, 0, 0); PG8_LDB(B1, 0, 1); PG8_SCHED; PG8_LDA(At, 0, 0); PG8_STAGE(PG8_SA(1, 1), a1 + hstepA, voffA);
            PG8_WAIT_V(8); PG8_WAIT_L(0); PG8_BAR; PG8_MMA(0, 0, At, B0); PG8_MMA(0, 1, At, B1); PG8_BAR; PG8_SCHED;
            PG8_LDA(At, 0, 1); PG8_STAGE(PG8_SB(0, 0), b2, voffB); PG8_STAGE(PG8_SB(0, 1), b2 + hstepB, voffB); PG8_STAGE(PG8_SA(0, 0), a2, voffA);
            PG8_WAIT_V(8); PG8_WAIT_L(0); PG8_BAR; PG8_MMA(1, 0, At, B0); PG8_MMA(1, 1, At, B1); PG8_BAR; PG8_SCHED;
            PG8_LDB(B0, 1, 0); PG8_LDB(B1, 1, 1); PG8_SCHED; PG8_LDA(At, 1, 0); PG8_STAGE(PG8_SA(0, 1), a2 + hstepA, voffA);
            PG8_WAIT_V(8); PG8_WAIT_L(0); PG8_BAR; PG8_MMA(0, 0, At, B0); PG8_MMA(0, 1, At, B1); PG8_BAR; PG8_SCHED;
            PG8_LDA(At, 1, 1); PG8_STAGE(PG8_SB(1, 0), b3, voffB); PG8_STAGE(PG8_SB(1, 1), b3 + hstepB, voffB); PG8_STAGE(PG8_SA(1, 0), a3, voffA);
            PG8_WAIT_V(8); PG8_WAIT_L(0); PG8_BAR; PG8_MMA(1, 0, At, B0); PG8_MMA(1, 1, At, B1); PG8_BAR; PG8_SCHED;
            } else {
            PG8_LDB(B0, 0, 0); PG8_SCHED; PG8_LDA(At, 0, 0); PG8_STAGE(PG8_SA(1, 1), a1 + hstepA, voffA);
            PG8_WAIT_L(8); PG8_BAR; PG8_WAIT_L(0); PG8_MMA(0, 0, At, B0); PG8_BAR; PG8_SCHED;
            PG8_LDB(B1, 0, 1); PG8_STAGE(PG8_SB(0, 0), b2, voffB);
            PG8_BAR; PG8_WAIT_L(0); PG8_MMA(0, 1, At, B1); PG8_BAR;
            PG8_LDA(At, 0, 1); PG8_STAGE(PG8_SA(0, 0), a2, voffA);
            PG8_BAR; PG8_WAIT_L(0); PG8_MMA(1, 0, At, B0); PG8_BAR; PG8_SCHED;
            PG8_STAGE(PG8_SB(0, 1), b2 + hstepB, voffB);
            PG8_WAIT_V(6); PG8_BAR; PG8_MMA(1, 1, At, B1); PG8_BAR;
            PG8_LDB(B0, 1, 0); PG8_SCHED; PG8_LDA(At, 1, 0); PG8_STAGE(PG8_SA(0, 1), a2 + hstepA, voffA);
            PG8_WAIT_L(8); PG8_BAR; PG8_WAIT_L(0); PG8_MMA(0, 0, At, B0); PG8_BAR; PG8_SCHED;
            PG8_LDB(B1, 1, 1); PG8_STAGE(PG8_SB(1, 0), b3, voffB);
            PG8_BAR; PG8_WAIT_L(0); PG8_MMA(0, 1, At, B1); PG8_BAR;
            PG8_LDA(At, 1, 1); PG8_STAGE(PG8_SA(1, 0), a3, voffA);
            PG8_BAR; PG8_WAIT_L(0); PG8_MMA(1, 0, At, B0); PG8_BAR; PG8_SCHED;
            PG8_STAGE(PG8_SB(1, 1), b3 + hstepB, voffB);
            PG8_WAIT_V(6); PG8_BAR; PG8_MMA(1, 1, At, B1); PG8_BAR;
            }
        }
        if constexpr (ALIGN_EPI) { if (wr == 0) PG8_BAR; }
        if constexpr (!Epi::AFTER_DRAIN) { E(acc, cur, wr, wc, fr, fq); S.done(cur); }
        if (!has_next) break;
#pragma unroll
        for (int a = 0; a < 2; ++a)
#pragma unroll
            for (int b = 0; b < 2; ++b)
#pragma unroll
                for (int m = 0; m < 4; ++m)
#pragma unroll
                    for (int n = 0; n < 2; ++n) acc[a][b][m][n] = (f32x4){0.f, 0.f, 0.f, 0.f};
        cur = nxt; cA = nA; cB = nB; ++ui;
        if constexpr (ALIGN_EPI) { if (wr == 1) PG8_BAR; }
    }
    PG8_WAIT_V(0);
    if constexpr (!ALIGN_EPI) { if (wr == 0) PG8_BAR; }
    PG8_BAR;
    if constexpr (Epi::AFTER_DRAIN) { E.fused(acc, cur, wr, wc, fr, fq, lds, wid, lane); S.done(cur); }
#undef PG8_SA
#undef PG8_SB
#undef PG8_STAGE
#undef PG8_LDA
#undef PG8_LDB
#undef PG8_MMA
#undef PG8_WAIT_V
#undef PG8_WAIT_L
#undef PG8_BAR
#undef PG8_SCHED
}
}

constexpr int NWAVES = 8;
constexpr int D = 2048, NBATCH = 4, SEQ = 4096, DEPTH = 4, CTXL = 256;
constexpr int MLAT = NBATCH * SEQ, MCTX = NBATCH * CTXL, MTOT = MLAT + MCTX;
constexpr int INW = 12288, BW = 1024, FFH = 5632, NHEAD = 8;
constexpr int Q_OFF = 0, K_OFF = 1024, V_OFF = 2048, BU_OFF = 3072, C_OFF = 5120, G_OFF = 6144;
constexpr int YW = 3 * BW;
constexpr float LN_EPS = 1e-6f;
constexpr float ALPHA = 1.681792830507429f;
constexpr float QSCALE = 0.125f * 1.4426950408889634f;

constexpr size_t MiB = 1u << 20;
constexpr size_t WS_CTL = 0, CTL_ZERO_BYTES = 1 * MiB;
constexpr size_t WS_ROPE = 1 * MiB;
constexpr size_t WS_MODS = 2 * MiB;
constexpr size_t WS_MODP = 4 * MiB;
constexpr size_t WS_WSP = 20 * MiB;
constexpr size_t WS_WPOOL = 21 * MiB;
constexpr size_t WS_WIN = 24 * MiB;
constexpr size_t WS_WBR = 216 * MiB;
constexpr size_t WS_WOUT = 264 * MiB;
constexpr size_t WS_WGU = 296 * MiB;
constexpr size_t WS_WDN = 472 * MiB;
constexpr size_t WS_X = 560 * MiB;
constexpr size_t WS_HA = 696 * MiB;
constexpr size_t WS_Y = 764 * MiB;
constexpr size_t WS_MG = 866 * MiB;
constexpr size_t WS_Z = 934 * MiB;
constexpr size_t WS_KB = 1342 * MiB, WS_VB = 1378 * MiB;
constexpr size_t WS_END = 1414 * MiB;
static_assert(WS_MODP + 16ull * 4 * 5 * 12288 * 4 <= WS_WSP && WS_WIN + 4ull * 12288 * 2048 * 2 <= WS_WBR && WS_WBR + 4ull * 2048 * 3072 * 2 <= WS_WOUT && WS_WOUT + 4ull * 2048 * 2048 * 2 <= WS_WGU, "ws map 1");
static_assert(WS_WGU + 4ull * 11264 * 2048 * 2 <= WS_WDN && WS_WDN + 4ull * 2048 * 5632 * 2 <= WS_X && WS_X + (size_t)MTOT * D * 4 <= WS_HA && WS_HA + (size_t)MTOT * D * 2 <= WS_Y, "ws map 2");
static_assert(WS_Y + (size_t)MTOT * YW * 2 <= WS_MG && WS_MG + (size_t)MTOT * D * 2 <= WS_Z && WS_Z + (size_t)MTOT * INW * 2 <= WS_KB && WS_KB + 32ull * 4352 * 256 <= WS_VB && WS_VB + 32ull * 4352 * 256 <= WS_END, "ws map 3");
constexpr int CW_BAR = 4096;

constexpr int RING_OFF = 0, RING_BYTES = 131072;
constexpr int LDSCTL_OFF = RING_BYTES, MISC_OFF = LDSCTL_OFF + 320;
constexpr int LDS_BYTES = 147456;

#define GAS __attribute__((address_space(1)))
#define LAS __attribute__((address_space(3)))
typedef unsigned short bf16;
typedef unsigned v4u __attribute__((ext_vector_type(4)));
typedef unsigned v2u __attribute__((ext_vector_type(2)));
typedef float f32x4 __attribute__((ext_vector_type(4)));
typedef float f32x16 __attribute__((ext_vector_type(16)));
typedef short bf16x8 __attribute__((ext_vector_type(8)));
typedef short s16x4 __attribute__((ext_vector_type(4)));
typedef GAS unsigned gu32;
#define RLX_AGENT __ATOMIC_RELAXED, __HIP_MEMORY_SCOPE_AGENT
#define LDS_WAIT() asm volatile("s_waitcnt lgkmcnt(0)" ::: "memory")
#define VM_WAIT() asm volatile("s_waitcnt vmcnt(0)" ::: "memory")
__device__ __forceinline__ unsigned f2bf(float f) { unsigned u = __builtin_bit_cast(unsigned, f); return (u + 0x7fffu + ((u >> 16) & 1u)) >> 16; }
__device__ __forceinline__ unsigned pk2(float lo, float hi) { return f2bf(lo) | (f2bf(hi) << 16); }
__device__ __forceinline__ unsigned cvtpk(float lo, float hi) { unsigned r; asm volatile("v_cvt_pk_bf16_f32 %0, %1, %2" : "=v"(r) : "v"(lo), "v"(hi)); return r; }
__device__ __forceinline__ float bflo(unsigned w) { return __uint_as_float(w << 16); }
__device__ __forceinline__ float bfhi(unsigned w) { return __uint_as_float(w & 0xffff0000u); }

#define XB_TMO      128
#define XB_XCNT(j)  (256  + 64 * (j))
#define XB_XSUB(j)  (1280 + 64 * (j))
#define XB_XGEN(j)  (2304 + 64 * (j))
#define XB_TOP      3328
#define XB_TOPGEN   3392
#define XCD_BAR_WORDS 3456
#define XB_SPIN_CAP (1u << 18)

__device__ __forceinline__ unsigned xb_ld(unsigned* p)              { return __hip_atomic_load(p, __ATOMIC_RELAXED, __HIP_MEMORY_SCOPE_AGENT); }
__device__ __forceinline__ unsigned xb_add(unsigned* p, unsigned v) { return __hip_atomic_fetch_add(p, v, __ATOMIC_RELAXED, __HIP_MEMORY_SCOPE_AGENT); }
__device__ __forceinline__ unsigned xb_xcc_id() { return (unsigned)__builtin_amdgcn_s_getreg((3 << 11) | 20) & 0xFu; }
#define XB_SPIN(cond, bar) do { unsigned _sp = 0; while (cond) { __builtin_amdgcn_s_sleep(1); \
    if ((++_sp & 255u) == 0u) { if (xb_ld(&(bar)[XB_TMO])) break; if (_sp > XB_SPIN_CAP) { atomicAdd(&(bar)[XB_TMO], 1u); break; } } } } while (0)

struct XcdBarrier {
    unsigned* bar; unsigned x;
    volatile LAS unsigned* st;
};

__device__ __forceinline__ XcdBarrier xcd_barrier_post(unsigned* bar, volatile LAS unsigned* st) {
    XcdBarrier b; b.bar = bar; b.x = xb_xcc_id(); b.st = st;
    if (threadIdx.x == 0) (void)xb_add(&bar[XB_XCNT(b.x)], 1u);
    return b;
}
__device__ __forceinline__ void xcd_barrier_complete(unsigned* bar, unsigned x, unsigned& nloc, unsigned& nx) {
    const unsigned G = gridDim.x * gridDim.y * gridDim.z;
    unsigned sum, cnt, mine, sp = 0u;
    for (;;) {
        sum = 0u; cnt = 0u; mine = 0u;
#pragma unroll
        for (unsigned j = 0; j < 16; ++j) { const unsigned c = xb_ld(&bar[XB_XCNT(j)]); sum += c; cnt += (c > 0u) ? 1u : 0u; mine = (j == x) ? c : mine; }
        if (sum == G) break;
        __builtin_amdgcn_s_sleep(1);
        if ((++sp & 255u) == 0u) { if (xb_ld(&bar[XB_TMO])) break; if (sp > XB_SPIN_CAP) { atomicAdd(&bar[XB_TMO], 1u); break; } }
    }
    nloc = mine > 0u ? mine : 1u; nx = cnt > 0u ? cnt : 1u;
}

__device__ __forceinline__ void xcd_barrier(const XcdBarrier& b) {
    asm volatile("s_waitcnt vmcnt(0)" ::: "memory");
    __syncthreads();
    if (threadIdx.x == 0) {
        unsigned* bar = b.bar;
        __builtin_amdgcn_s_waitcnt(0);
        unsigned nloc = b.st[0], nx = b.st[1];
        if (nloc == 0u) { xcd_barrier_complete(bar, b.x, nloc, nx); b.st[0] = nloc; b.st[1] = nx; }
        const unsigned old = xb_add(&bar[XB_XSUB(b.x)], 1u);
        const unsigned gen = old / nloc;
        if (old + 1u == (gen + 1u) * nloc) {
            __builtin_amdgcn_fence(__ATOMIC_RELEASE, "agent");
            asm volatile("s_waitcnt vmcnt(0)" ::: "memory");
            const unsigned og = xb_add(&bar[XB_TOP], 1u);
            const unsigned tg = og / nx;
            if (og + 1u == (tg + 1u) * nx) xb_add(&bar[XB_TOPGEN], 1u);
            else XB_SPIN(xb_ld(&bar[XB_TOPGEN]) == tg, bar);
            __builtin_amdgcn_fence(__ATOMIC_ACQUIRE, "agent");
            xb_add(&bar[XB_XGEN(b.x)], 1u);
            asm volatile("s_waitcnt vmcnt(0)" ::: "memory");
        } else {
            XB_SPIN(xb_ld(&bar[XB_XGEN(b.x)]) == gen, bar);
            __builtin_amdgcn_fence(__ATOMIC_ACQUIRE, "agent");
            asm volatile("s_waitcnt vmcnt(0)" ::: "memory");
        }
    }
    __syncthreads();
}


struct Frame {
    LAS unsigned char* lds;
    volatile LAS unsigned* MISC;
    gu32* ctl;
    int vcu, G, bx;
    __device__ __forceinline__ int ltid() const { int t = threadIdx.x; asm volatile("" : "+v"(t)); return t; }
    const float *x, *c, *ctx, *cctx, *w_ada, *b_ada, *w_in, *lam_qk, *subln_g, *gln_g, *gln_b, *w_sp, *b_sp, *w_pool, *pool_scale, *w_branch, *w_out, *ln1_g, *ln1_b, *w_gu, *w_down, *ln2_g, *ln2_b;
    float* out;
    float *rope, *mods, *modp, *X;
    bf16 *Wsp, *Wpool, *Win, *Wbr, *Wout, *Wgu, *Wdn, *HA, *Y, *MG, *Z, *KB, *VB;
};

typedef __attribute__((address_space(4))) const unsigned char* kptr_t;
__device__ __forceinline__ void frame_ptrs(Frame& F) {
    kptr_t kp = (kptr_t)__builtin_amdgcn_kernarg_segment_ptr(); asm volatile("" : "+s"(kp));
#define KIN(i) (*(const float* const __attribute__((address_space(4)))*)(kp + 8 * (i)))
    F.x = KIN(0); F.c = KIN(1); F.ctx = KIN(2); F.cctx = KIN(3); F.w_ada = KIN(4); F.b_ada = KIN(5); F.w_in = KIN(6); F.lam_qk = KIN(7); F.subln_g = KIN(8);
    F.gln_g = KIN(9); F.gln_b = KIN(10); F.w_sp = KIN(11); F.b_sp = KIN(12); F.w_pool = KIN(13); F.pool_scale = KIN(14); F.w_branch = KIN(15); F.w_out = KIN(16);
    F.ln1_g = KIN(17); F.ln1_b = KIN(18); F.w_gu = KIN(19); F.w_down = KIN(20); F.ln2_g = KIN(21); F.ln2_b = KIN(22);
#undef KIN
    F.out = *(float* const __attribute__((address_space(4)))*)(kp + 184);
    unsigned char* ws = *(unsigned char* const __attribute__((address_space(4)))*)(kp + 192);
    F.rope = (float*)(ws + WS_ROPE); F.mods = (float*)(ws + WS_MODS); F.modp = (float*)(ws + WS_MODP); F.X = (float*)(ws + WS_X);
    F.Wsp = (bf16*)(ws + WS_WSP); F.Wpool = (bf16*)(ws + WS_WPOOL); F.Win = (bf16*)(ws + WS_WIN); F.Wbr = (bf16*)(ws + WS_WBR); F.Wout = (bf16*)(ws + WS_WOUT); F.Wgu = (bf16*)(ws + WS_WGU); F.Wdn = (bf16*)(ws + WS_WDN);
    F.HA = (bf16*)(ws + WS_HA); F.Y = (bf16*)(ws + WS_Y); F.MG = (bf16*)(ws + WS_MG); F.Z = (bf16*)(ws + WS_Z); F.KB = (bf16*)(ws + WS_KB); F.VB = (bf16*)(ws + WS_VB);
}
__device__ __forceinline__ float wave_sum(float v) {
    v += __builtin_bit_cast(float, __builtin_amdgcn_update_dpp(0, __builtin_bit_cast(int, v), 0xB1, 0xF, 0xF, true));
    v += __builtin_bit_cast(float, __builtin_amdgcn_update_dpp(0, __builtin_bit_cast(int, v), 0x4E, 0xF, 0xF, true));
    v += __builtin_bit_cast(float, __builtin_amdgcn_update_dpp(0, __builtin_bit_cast(int, v), 0x141, 0xF, 0xF, true));
    v += __builtin_bit_cast(float, __builtin_amdgcn_update_dpp(0, __builtin_bit_cast(int, v), 0x140, 0xF, 0xF, true));
    v += __shfl_xor(v, 16);
    { auto rr = __builtin_amdgcn_permlane32_swap(__float_as_uint(v), __float_as_uint(v), false, false); v = __uint_as_float(rr[0]) + __uint_as_float(rr[1]); }
    return v;
}

__device__ __forceinline__ void cvt_item(const float* W, int N, int k0, int ncol0, bool perm, bf16* WT, size_t drow0, int ldk, int dk0, LAS float* scr, int lane) {
#pragma unroll 8
    for (int i = 0; i < 32; ++i) { const int kk = 2 * i + (lane >> 5); scr[kk * 33 + (lane & 31)] = __builtin_nontemporal_load(W + (size_t)(k0 + kk) * N + ncol0 + (lane & 31)); }
    LDS_WAIT(); asm volatile("" ::: "memory");
    const int c = lane & 7;
#pragma unroll
    for (int j = 0; j < 4; ++j) { const int n = (lane >> 3) + 8 * j; const int ns = perm ? ((n & 1) * 16 + (n >> 1)) : n; const LAS float* s = scr + (8 * c) * 33 + ns;
        v4u o; o.x = pk2(s[0 * 33], s[1 * 33]); o.y = pk2(s[2 * 33], s[3 * 33]); o.z = pk2(s[4 * 33], s[5 * 33]); o.w = pk2(s[6 * 33], s[7 * 33]);
        *(GAS v4u*)(WT + (drow0 + n) * (size_t)ldk + dk0 + k0 + 8 * c) = o; }
    LDS_WAIT(); asm volatile("" ::: "memory");
}
constexpr int CV_IN = 32 * 384, CV_GU = 32 * 352, CV_DN = 88 * 64, CV_BR = 3 * 16 * 64, CV_OUT = 32 * 64, CV_POOL = 4 * 4 * 8, CV_LAYER = CV_IN + CV_GU + CV_DN + CV_BR + CV_OUT + CV_POOL;
__device__ __forceinline__ void cvt_dispatch(Frame& F, int it, LAS float* scr) {
    const int l = it / CV_LAYER; int r = it - l * CV_LAYER;
    if (r < CV_IN) { const int kb = r / 384, nb = r - kb * 384;
        cvt_item(F.w_in + (size_t)l * D * INW, INW, 64 * kb, 32 * nb, nb < 64, F.Win + (size_t)l * INW * D, (size_t)32 * nb, D, 0, scr, (F.ltid() & 63)); return; }
    r -= CV_IN;
    if (r < CV_GU) { const int kb = r / 352, nb = r - kb * 352; const int tpn = nb >> 3, half = (nb >> 2) & 1, jj0 = (nb & 3) * 32;
        cvt_item(F.w_gu + (size_t)l * D * 2 * FFH, 2 * FFH, 64 * kb, half * FFH + 128 * tpn + jj0, false, F.Wgu + (size_t)l * 2 * FFH * D, (size_t)32 * nb, D, 0, scr, (F.ltid() & 63)); return; }
    r -= CV_GU;
    if (r < CV_DN) { const int kb = r >> 6, nb = r & 63;
        cvt_item(F.w_down + (size_t)l * FFH * D, D, 64 * kb, 32 * nb, false, F.Wdn + (size_t)l * D * FFH, (size_t)32 * nb, FFH, 0, scr, (F.ltid() & 63)); return; }
    r -= CV_DN;
    if (r < CV_BR) { const int n = r >> 10, rr = r & 1023, kb = rr >> 6, nb = rr & 63;
        cvt_item(F.w_branch + ((size_t)l * 3 + n) * BW * D, D, 64 * kb, 32 * nb, false, F.Wbr + (size_t)l * D * YW, (size_t)32 * nb, YW, BW * n, scr, (F.ltid() & 63)); return; }
    r -= CV_BR;
    if (r < CV_OUT) { const int kb = r >> 6, nb = r & 63;
        cvt_item(F.w_out + (size_t)l * D * D, D, 64 * kb, 32 * nb, false, F.Wout + (size_t)l * D * D, (size_t)32 * nb, D, 0, scr, (F.ltid() & 63)); return; }
    r -= CV_OUT;
    { const int g = r >> 5, rr = r & 31, kb = rr >> 3, nb = rr & 7;
        cvt_item(F.w_pool + ((size_t)l * 4 + g) * 65536, 256, 64 * kb, 32 * nb, false, F.Wpool + ((size_t)l * 4 + g) * 65536, (size_t)32 * nb, 256, 0, scr, (F.ltid() & 63)); }
}

__device__ __forceinline__ double rope_inv(int p) {
    const double t[16] = {1.0, 0.5623413251903491, 0.31622776601683794, 0.1778279410038923, 0.1, 0.05623413251903491, 0.03162277660168379, 0.01778279410038923,
                          0.01, 0.005623413251903491, 0.003162277660168379, 0.001778279410038923, 0.001, 0.0005623413251903491, 0.00031622776601683794, 0.0001778279410038923};
    double r = t[0];
#pragma unroll
    for (int i = 1; i < 16; ++i) r = (p == i) ? t[i] : r;
    return r;
}
#ifndef TAILWORK
#define TAILWORK 0
#endif
__device__ __forceinline__ void ada_partial_layer(Frame& F, int l, int gw, int NGW) {
    LAS float* scs = (LAS float*)(F.lds);
    __syncthreads();
    for (int i = F.ltid(); i < 5 * D; i += NWAVES * 64) { const int g = i >> 11, k = i & 2047; const float v = g < 4 ? F.c[g * D + k] : F.cctx[k]; scs[i] = v / (1.0f + __expf(-v)); }
    __syncthreads();
    for (int it = gw; it < 16 * 48; it += NGW) {
        const int ks = it / 48, cgw = it - ks * 48; const int col = cgw * 256 + (F.ltid() & 63) * 4;
        const float* wp = F.w_ada + ((size_t)l * D + ks * 128) * INW + col;
        f32x4 a0 = {0.f, 0.f, 0.f, 0.f}, a1 = a0, a2 = a0, a3 = a0, a4 = a0;
#pragma unroll 8
        for (int k = 0; k < 128; ++k) { const f32x4 w = __builtin_nontemporal_load((const GAS f32x4*)(wp + (size_t)k * INW)); const int kk = ks * 128 + k;
            a0 += w * scs[kk]; a1 += w * scs[D + kk]; a2 += w * scs[2 * D + kk]; a3 += w * scs[3 * D + kk]; a4 += w * scs[4 * D + kk]; }
        float* pp = F.modp + (((size_t)ks * 4 + l) * 5) * INW + col;
        *(f32x4*)(pp) = a0; *(f32x4*)(pp + INW) = a1; *(f32x4*)(pp + 2 * INW) = a2; *(f32x4*)(pp + 3 * INW) = a3; *(f32x4*)(pp + 4 * INW) = a4;
    }
    __syncthreads();
}
__device__ __forceinline__ void cvt_layer(Frame& F, int l, int gw, int NGW) {
    LAS float* scr = (LAS float*)(F.lds + __builtin_amdgcn_readfirstlane(F.ltid() >> 6) * 16384);
    for (int it = gw; it < CV_LAYER; it += NGW) cvt_dispatch(F, l * CV_LAYER + it, scr);
}
__device__ __forceinline__ void mods_reduce_layer(Frame& F, int l) {
    const int gt = F.vcu * NWAVES * 64 + F.ltid(), NGT = F.G * NWAVES * 64;
    for (int i = gt; i < 5 * (INW / 4); i += NGT) { const int g = i / (INW / 4), j = (i - g * (INW / 4)) * 4;
        f32x4 sm = *(const f32x4*)(F.b_ada + (size_t)l * INW + j);
#pragma unroll
        for (int ks = 0; ks < 16; ++ks) sm += *(const f32x4*)(F.modp + (((size_t)ks * 4 + l) * 5 + g) * INW + j);
        *(f32x4*)(F.mods + ((size_t)l * 5 + g) * INW + j) = sm; }
}
__device__ __forceinline__ void phase_a1(Frame& F) {
    const int gw = F.vcu * NWAVES + __builtin_amdgcn_readfirstlane(F.ltid() >> 6), NGW = F.G * NWAVES;
#pragma nounroll
    for (int l = 0; l < (TAILWORK ? 1 : DEPTH); ++l) ada_partial_layer(F, l, gw, NGW);
#pragma nounroll
    for (int l = 0; l < (TAILWORK ? 1 : DEPTH); ++l) cvt_layer(F, l, gw, NGW);
    for (int it = gw; it < (DEPTH * 8 * 128 * 128) / 512; it += NGW) { const size_t e = (size_t)it * 512 + (F.ltid() & 63) * 8;
        const f32x4 a = *(const f32x4*)(F.w_sp + e), b = *(const f32x4*)(F.w_sp + e + 4);
        v4u o; o.x = pk2(a[0], a[1]); o.y = pk2(a[2], a[3]); o.z = pk2(b[0], b[1]); o.w = pk2(b[2], b[3]); *(v4u*)(F.Wsp + e) = o; }
    if (gw == 0) {
        for (int e = (F.ltid() & 63); e < 1024; e += 64) { const int pos = e >> 4, pr = e & 15;
            const double ang = (double)pos * rope_inv(pr); const double twopi = 6.283185307179586476925286766559;
            const double kq = __builtin_rint(ang / twopi); const double rr = ang - kq * twopi; const double r2 = rr * rr;
            double sn = 1.0, cs = 1.0;
#pragma unroll
            for (int n = 14; n >= 1; --n) { sn = 1.0 - sn * r2 / (double)((2 * n) * (2 * n + 1)); cs = 1.0 - cs * r2 / (double)((2 * n - 1) * (2 * n)); }
            sn *= rr;
            F.rope[2 * e] = (float)cs; F.rope[2 * e + 1] = (float)sn; }
    }
}
__device__ __forceinline__ void phase_a2(Frame& F) {
#pragma nounroll
    for (int l = 0; l < (TAILWORK ? 1 : DEPTH); ++l) mods_reduce_layer(F, l); }
__device__ __forceinline__ void ln_row(const float* src, const bf16* tadd, const float* part, int npart, const float* gam, const float* bet, float* xo, float xs, bf16* ho, const float* sc, const float* sh, int lane) {
    f32x4 v[8]; float s = 0.f;
#pragma unroll
    for (int j = 0; j < 8; ++j) v[j] = __builtin_nontemporal_load((const GAS f32x4*)(src + 4 * lane + 256 * j));
    if (tadd) {
#pragma unroll
        for (int j = 0; j < 8; ++j) { const v2u t2 = *(const GAS v2u*)(tadd + 4 * lane + 256 * j); v[j] += (f32x4){bflo(t2.x), bfhi(t2.x), bflo(t2.y), bfhi(t2.y)}; } }
    for (int p = 0; p < npart; ++p) {
#pragma unroll
        for (int j = 0; j < 8; ++j) v[j] += __builtin_nontemporal_load((const GAS f32x4*)(part + (size_t)p * 1024 * D + 4 * lane + 256 * j)); }
#pragma unroll
    for (int j = 0; j < 8; ++j) s += (v[j][0] + v[j][1]) + (v[j][2] + v[j][3]);
    const float mean = wave_sum(s) * (1.f / D); float s2 = 0.f;
#pragma unroll
    for (int j = 0; j < 8; ++j) { v[j] = v[j] - mean; s2 += (v[j][0] * v[j][0] + v[j][1] * v[j][1]) + (v[j][2] * v[j][2] + v[j][3] * v[j][3]); }
    const float rstd = 1.0f / sqrtf(wave_sum(s2) * (1.f / D) + LN_EPS);
#pragma unroll
    for (int j = 0; j < 8; ++j) { const int col = 4 * lane + 256 * j; f32x4 xn = v[j] * rstd;
        if (gam) xn = xn * *(const f32x4*)(gam + col) + *(const f32x4*)(bet + col);
        if (xo) __builtin_nontemporal_store(xn * xs, (GAS f32x4*)(xo + col));
        if (ho) { const f32x4 hv = xn * (1.0f + *(const f32x4*)(sc + col)) + *(const f32x4*)(sh + col); v2u o; o.x = pk2(hv[0], hv[1]); o.y = pk2(hv[2], hv[3]); __builtin_nontemporal_store(o, (GAS v2u*)(ho + col)); } }
}
__device__ __forceinline__ int row_group(int row) { return row < MLAT ? (row >> 12) : 4; }
__device__ __forceinline__ void phase_a3(Frame& F) {
    const int gw = F.vcu * NWAVES + __builtin_amdgcn_readfirstlane(F.ltid() >> 6), NGW = F.G * NWAVES;
    for (int row = gw; row < MTOT; row += NGW) { const float* src = row < MLAT ? F.x + (size_t)row * D : F.ctx + (size_t)(row - MLAT) * D; const float* md = F.mods + (size_t)row_group(row) * INW;
        ln_row(src, nullptr, nullptr, 0, nullptr, nullptr, F.X + (size_t)row * D, ALPHA, F.HA + (size_t)row * D, md + D, md, (F.ltid() & 63)); }
}
#ifndef LN_NT
#define LN_NT 1
#endif
#if LN_NT
#define LN_LD(p) __builtin_nontemporal_load(p)
#define LN_ST(p, v) __builtin_nontemporal_store((v), (p))
#else
#define LN_LD(p) (*(p))
#define LN_ST(p, v) (*(p) = (v))
#endif
__device__ __forceinline__ void ln_finish(f32x4 (&v)[8], const float* gam, const float* bet, float* xo, float xs, bf16* ho, const float* sc, const float* sh, int lane) {
    float s = 0.f;
#pragma unroll
    for (int j = 0; j < 8; ++j) s += (v[j][0] + v[j][1]) + (v[j][2] + v[j][3]);
    const float mean = wave_sum(s) * (1.f / D); float s2 = 0.f;
#pragma unroll
    for (int j = 0; j < 8; ++j) { v[j] = v[j] - mean; s2 += (v[j][0] * v[j][0] + v[j][1] * v[j][1]) + (v[j][2] * v[j][2] + v[j][3] * v[j][3]); }
    const float rstd = 1.0f / sqrtf(wave_sum(s2) * (1.f / D) + LN_EPS);
#pragma unroll
    for (int j = 0; j < 8; ++j) { const int col = 4 * lane + 256 * j; f32x4 xn = v[j] * rstd;
        xn = xn * *(const f32x4*)(gam + col) + *(const f32x4*)(bet + col);
        if (xo) LN_ST((GAS f32x4*)(xo + col), xn * xs);
        if (ho) { const f32x4 hv = xn * (1.0f + *(const f32x4*)(sc + col)) + *(const f32x4*)(sh + col); v2u o; o.x = pk2(hv[0], hv[1]); o.y = pk2(hv[2], hv[3]); LN_ST((GAS v2u*)(ho + col), o); } }
}
__device__ __forceinline__ void phase_ln(Frame& F, const float* gam, const float* bet, int nrows, bool to_out, bool want_h, int lm, int moff, int nsplit, bool dry = false) {
    const int gw = F.vcu * NWAVES + __builtin_amdgcn_readfirstlane(F.ltid() >> 6), NGW = F.G * NWAVES; const int lane = F.ltid() & 63;
    f32x4 xa[8]; v2u ta[8];
    int row = gw;
    if (row < MLAT) {
#pragma unroll
        for (int j = 0; j < 8; ++j) { xa[j] = LN_LD((const GAS f32x4*)(F.X + (size_t)row * D + 4 * lane + 256 * j)); ta[j] = LN_LD((const GAS v2u*)(F.Y + (size_t)row * D + 4 * lane + 256 * j)); } }
    for (; row < MLAT; row += NGW) {
        f32x4 v[8];
#pragma unroll
        for (int j = 0; j < 8; ++j) v[j] = xa[j] + (f32x4){bflo(ta[j].x), bfhi(ta[j].x), bflo(ta[j].y), bfhi(ta[j].y)};
        const int nx = row + NGW;
        if (nx < MLAT) {
#pragma unroll
            for (int j = 0; j < 8; ++j) { xa[j] = LN_LD((const GAS f32x4*)(F.X + (size_t)nx * D + 4 * lane + 256 * j)); ta[j] = LN_LD((const GAS v2u*)(F.Y + (size_t)nx * D + 4 * lane + 256 * j)); } }
        const float* md = F.mods + ((size_t)lm * 5 + (row >> 12)) * INW + moff;
        ln_finish(v, gam, bet, dry ? (float*)(F.Z + (size_t)134 * MiB) + (size_t)row * D : (to_out ? F.out + (size_t)row * D : F.X + (size_t)row * D), to_out ? 1.0f : ALPHA, want_h ? (dry ? F.MG : F.HA) + (size_t)row * D : nullptr, md + D, md, lane);
    }
    for (; row < nrows; row += NGW) { const float* md = F.mods + ((size_t)lm * 5 + 4) * INW + moff;
        ln_row(F.X + (size_t)row * D, nullptr, (const float*)(F.Z + (size_t)100 * MiB) + (size_t)(row - MLAT) * D, nsplit, gam, bet, dry ? (float*)(F.Z + (size_t)134 * MiB) + (size_t)row * D : (to_out ? F.out + (size_t)row * D : F.X + (size_t)row * D), to_out ? 1.0f : ALPHA, want_h ? (dry ? F.MG : F.HA) + (size_t)row * D : nullptr, md + D, md, lane); }
}

constexpr int AT_KB = 0, AT_VB = 32768, AT_TILE = 16384, AT_XB = 65536;
__device__ __forceinline__ s16x4 vtr(const LAS unsigned char* p) { typedef short v4i16_t __attribute__((ext_vector_type(4))); return __builtin_bit_cast(s16x4, __builtin_amdgcn_ds_read_tr16_b64_v4i16((LAS v4i16_t*)p)); }
__device__ __forceinline__ float max3f(float a, float b, float c) { float r; asm("v_max3_f32 %0, %1, %2, %3" : "=v"(r) : "v"(a), "v"(b), "v"(c)); return r; }
__device__ __forceinline__ float max2f(float a, float b) { float r; asm("v_max_f32_e32 %0, %1, %2" : "=v"(r) : "v"(a), "v"(b)); return r; }
__device__ __forceinline__ void glds16(const void* gsrc, unsigned lds_dst) { unsigned keep;
    asm volatile("s_mov_b32 %0, m0\n\ts_mov_b32 m0, %2\n\ts_nop 0\n\tglobal_load_lds_dwordx4 %1, off\n\ts_mov_b32 m0, %0" : "=&s"(keep) : "v"(gsrc), "s"(lds_dst) : "memory"); }
#ifndef XTRA_EXP
#define XTRA_EXP 0
#endif
#define AT_WAITV(n) asm volatile("s_waitcnt vmcnt(" #n ")" ::: "memory")
#define AT_BAR() asm volatile("s_waitcnt lgkmcnt(0)\n\ts_barrier" ::: "memory")
__device__ __forceinline__ void attn_unit(Frame& F, int b, int h, int qb, bool ctxq, float lam, float oscale, const float* subg) {
    int lane_ = (F.ltid() & 63); asm volatile("" : "+v"(lane_));
    const int lane = lane_, wid = __builtin_amdgcn_readfirstlane(F.ltid() >> 6), r32 = lane & 31, hi = lane >> 5, m = wid >> 2, qg = wid & 3; const bool lead = wid < 4;
    const bf16* Z = F.Z;
    const int qrow = (ctxq ? MLAT + b * CTXL : b * SEQ) + qb * 128 + qg * 32 + r32;
    bf16x8 qf[4];
#pragma unroll
    for (int d0 = 0; d0 < 4; ++d0) qf[d0] = *(const GAS bf16x8*)(Z + (size_t)qrow * INW + Q_OFF + h * 128 + m * 64 + d0 * 16 + hi * 8);
    const int NT = ctxq ? 4 : 68;
    const bf16* Kbh = F.KB + (size_t)(b * 8 + h) * 4352 * 128; const bf16* Vbh = F.VB + (size_t)(b * 8 + h) * 4352 * 128;
    const unsigned lds0 = (unsigned)(size_t)F.lds;
    const int prow = 8 * wid + (lane >> 4), ppos = lane & 15;
    const unsigned koff0 = (unsigned)(prow * 128 + ((ppos ^ (prow & 15)) * 8)), koff1 = (unsigned)((prow + 4) * 128 + ((ppos ^ ((prow + 4) & 15)) * 8));
    const unsigned voff0 = (unsigned)(prow * 128 + ((ppos ^ (4 * (prow & 3))) * 8)), voff1 = voff0 + 4 * 128;
    const unsigned kdst = (unsigned)__builtin_amdgcn_readfirstlane((int)(lds0 + AT_KB + wid * 2048)), vdst = (unsigned)__builtin_amdgcn_readfirstlane((int)(lds0 + AT_VB + wid * 2048));
#define AT_DMAK(t, bufo) do { const bf16* tb_ = Kbh + (size_t)(t) * 8192; glds16(tb_ + koff0, kdst + (bufo)); glds16(tb_ + koff1, kdst + (bufo) + 1024); } while (0)
#define AT_DMAV(t, bufo) do { const bf16* tb_ = Vbh + (size_t)(t) * 8192; glds16(tb_ + voff0, vdst + (bufo)); glds16(tb_ + voff1, vdst + (bufo) + 1024); } while (0)
    f32x16 o[4];
#pragma unroll
    for (int db = 0; db < 4; ++db)
#pragma unroll
        for (int r = 0; r < 16; ++r) o[db][r] = 0.f;
    float mref = 0.f, lsum = 0.f;
    f32x16 negm;
#pragma unroll
    for (int r = 0; r < 16; ++r) negm[r] = 0.f;
    const unsigned kaddr0 = AT_KB + r32 * 256 + (((8 * m + hi) ^ (r32 & 15)) << 4);
    const int a4 = (lane & 15) >> 2, cc = 2 * ((lane >> 4) & 1) + ((lane & 3) >> 1);
    const unsigned vaddr0 = AT_VB + (4 * hi + a4) * 256 + ((4 * a4 + cc) << 4) + 8 * (lane & 1);
    __syncthreads();
#define AT_SB() __builtin_amdgcn_sched_barrier(0)
#define AT_PIN(x) asm volatile("" : "+v"(x))
#define AT_KFRAG(i) (*(const LAS bf16x8*)(F.lds + (kb_ ^ (unsigned)((2 * ((i) >> 1)) << 4)) + ((i) & 1) * 8192))
#define AT_VFRAG(lo, hh, ks, db) do { const unsigned va_ = (vb_ ^ (unsigned)((db) << 6)) + (16 * (ks)) * 256; lo = vtr(F.lds + va_); hh = vtr(F.lds + va_ + 8 * 256); } while (0)
#define AT_VF(lo, hh) ((bf16x8){lo[0], lo[1], lo[2], lo[3], hh[0], hh[1], hh[2], hh[3]})
#define AT_MAXDEC(C0, C1, FIRST) do { \
        float tmax = max3f(C0[0], C1[0], C0[1]); \
        _Pragma("unroll") for (int r = 1; r < 15; ++r) tmax = max3f(tmax, C1[r], C0[r + 1]); \
        tmax = max2f(tmax, C1[15]); { auto rr_ = __builtin_amdgcn_permlane32_swap(__float_as_uint(tmax), __float_as_uint(tmax), false, false); tmax = max2f(__uint_as_float(rr_[0]), __uint_as_float(rr_[1])); } \
        resc = false; \
        if (FIRST) { mref = tmax; \
            _Pragma("unroll") for (int r = 0; r < 16; ++r) { C0[r] -= tmax; C1[r] -= tmax; negm[r] = -mref; } \
        } else if (__any(tmax > 8.0f)) { \
            const float dl = __builtin_fmaxf(tmax, 0.f); mref += dl; alr = __builtin_amdgcn_exp2f(-dl); lsum *= alr; resc = true; \
            _Pragma("unroll") for (int r = 0; r < 16; ++r) { C0[r] -= dl; C1[r] -= dl; negm[r] = -mref; } \
        } } while (0)
#define AT_GAPA(i, CD, CS, PP, PB, PW, PWI) do { \
        AT_VFRAG(vlo[i], vhi[i], (i) >> 2, (i) & 3); \
        CD = __builtin_amdgcn_mfma_f32_32x32x16_bf16(((i) & 1) ? kfb : kfa, qf[(i) >> 1], CS, 0, 0, 0); \
        if ((i) + 2 < 8) { if ((i) & 1) kfb = AT_KFRAG((i) + 2); else kfa = AT_KFRAG((i) + 2); } \
        sacc += PP[PB]; sacc += PP[PB + 1]; sacc += PP[PB + 2]; sacc += PP[PB + 3]; AT_PIN(sacc); \
        PW[PWI] = cvtpk(PP[PB], PP[PB + 1]); PW[PWI + 1] = cvtpk(PP[PB + 2], PP[PB + 3]); AT_PIN(PW); AT_SB(); } while (0)
#define AT_GAPB(j, VL, VH, PW, CC, CB) do { \
        if ((j) < 8) AT_VFRAG(wlo[j], whi[j], 2 + ((j) >> 2), (j) & 3); \
        o[(j) & 3] = __builtin_amdgcn_mfma_f32_32x32x16_bf16(AT_VF(VL, VH), __builtin_bit_cast(bf16x8, PW), o[(j) & 3], 0, 0, 0); \
        CC[CB] = __builtin_amdgcn_exp2f(CC[CB]); CC[CB + 1] = __builtin_amdgcn_exp2f(CC[CB + 1]); AT_PIN(CC); AT_SB(); } while (0)
#define AT_STEP(C0, C1, P0, P1, T) do { \
        const unsigned kbo_ = ((T) & 1) ? AT_TILE : 0, vbo_ = ((T) & 1) ? 0 : AT_TILE; \
        if ((T) + 1 < NT) AT_DMAK((T) + 1, kbo_ ^ AT_TILE); \
        AT_DMAV((T), vbo_ ^ AT_TILE); \
        unsigned kb_ = kaddr0 + kbo_, vb_ = vaddr0 + vbo_; asm volatile("" : "+v"(kb_), "+v"(vb_)); \
        bf16x8 kfa = AT_KFRAG(0), kfb = AT_KFRAG(1); float sacc = 0.f; AT_SB(); \
        AT_GAPA(0, C0, negm, P0, 0, pw0, 0); AT_GAPA(1, C1, negm, P0, 4, pw0, 2); AT_GAPA(2, C0, C0, P0, 8, pw1, 0); AT_GAPA(3, C1, C1, P0, 12, pw1, 2); \
        AT_GAPA(4, C0, C0, P1, 0, pw2, 0); AT_GAPA(5, C1, C1, P1, 4, pw2, 2); AT_GAPA(6, C0, C0, P1, 8, pw3, 0); AT_GAPA(7, C1, C1, P1, 12, pw3, 2); \
        lsum += sacc; \
        AT_MAXDEC(C0, C1, false); AT_SB(); \
        AT_GAPB(0, vlo[0], vhi[0], pw0, C0, 0); AT_GAPB(1, vlo[1], vhi[1], pw0, C0, 2); AT_GAPB(2, vlo[2], vhi[2], pw0, C0, 4); AT_GAPB(3, vlo[3], vhi[3], pw0, C0, 6); \
        AT_GAPB(4, vlo[4], vhi[4], pw1, C0, 8); AT_GAPB(5, vlo[5], vhi[5], pw1, C0, 10); AT_GAPB(6, vlo[6], vhi[6], pw1, C0, 12); AT_GAPB(7, vlo[7], vhi[7], pw1, C0, 14); \
        AT_GAPB(8, wlo[0], whi[0], pw2, C1, 0); AT_GAPB(9, wlo[1], whi[1], pw2, C1, 2); AT_GAPB(10, wlo[2], whi[2], pw2, C1, 4); AT_GAPB(11, wlo[3], whi[3], pw2, C1, 6); \
        AT_GAPB(12, wlo[4], whi[4], pw3, C1, 8); AT_GAPB(13, wlo[5], whi[5], pw3, C1, 10); AT_GAPB(14, wlo[6], whi[6], pw3, C1, 12); AT_GAPB(15, wlo[7], whi[7], pw3, C1, 14); \
        if (resc) { _Pragma("unroll") for (int db = 0; db < 4; ++db) _Pragma("unroll") for (int r = 0; r < 16; ++r) o[db][r] *= alr; } \
        asm volatile("s_waitcnt vmcnt(0) lgkmcnt(0)\n\ts_barrier" ::: "memory"); } while (0)
    f32x16 pA0, pA1, pB0, pB1; v4u pw0, pw1, pw2, pw3; s16x4 vlo[8], vhi[8], wlo[8], whi[8]; bool resc = false; float alr = 1.f;
#pragma unroll
    for (int r = 0; r < 16; ++r) { pB0[r] = 0.f; pB1[r] = 0.f; }
    pw0 = pw1 = pw2 = pw3 = (v4u){0u, 0u, 0u, 0u};
    AT_DMAK(0, 0);
    asm volatile("s_waitcnt vmcnt(0) lgkmcnt(0)\n\ts_barrier" ::: "memory");
    { if (NT > 1) AT_DMAK(1, AT_TILE);
      AT_DMAV(0, 0);
      unsigned kb_ = kaddr0; asm volatile("" : "+v"(kb_));
      pA0 = __builtin_amdgcn_mfma_f32_32x32x16_bf16(AT_KFRAG(0), qf[0], negm, 0, 0, 0); pA1 = __builtin_amdgcn_mfma_f32_32x32x16_bf16(AT_KFRAG(1), qf[0], negm, 0, 0, 0);
#pragma unroll
      for (int d0 = 1; d0 < 4; ++d0) { pA0 = __builtin_amdgcn_mfma_f32_32x32x16_bf16(AT_KFRAG(2 * d0), qf[d0], pA0, 0, 0, 0); pA1 = __builtin_amdgcn_mfma_f32_32x32x16_bf16(AT_KFRAG(2 * d0 + 1), qf[d0], pA1, 0, 0, 0); }
      AT_MAXDEC(pA0, pA1, true);
#pragma unroll
      for (int r = 0; r < 16; ++r) { pA0[r] = __builtin_amdgcn_exp2f(pA0[r]); pA1[r] = __builtin_amdgcn_exp2f(pA1[r]); }
      asm volatile("s_waitcnt vmcnt(0) lgkmcnt(0)\n\ts_barrier" ::: "memory"); }
    for (int t = 1; t < NT - 1; t += 2) { AT_STEP(pB0, pB1, pA0, pA1, t); AT_STEP(pA0, pA1, pB0, pB1, t + 1); }
    AT_STEP(pB0, pB1, pA0, pA1, NT - 1);
    { float sacc = 0.f;
#pragma unroll
      for (int r = 0; r < 16; ++r) sacc += pB0[r] + pB1[r];
      lsum += sacc;
      pw0 = (v4u){cvtpk(pB0[0], pB0[1]), cvtpk(pB0[2], pB0[3]), cvtpk(pB0[4], pB0[5]), cvtpk(pB0[6], pB0[7])}; pw1 = (v4u){cvtpk(pB0[8], pB0[9]), cvtpk(pB0[10], pB0[11]), cvtpk(pB0[12], pB0[13]), cvtpk(pB0[14], pB0[15])};
      pw2 = (v4u){cvtpk(pB1[0], pB1[1]), cvtpk(pB1[2], pB1[3]), cvtpk(pB1[4], pB1[5]), cvtpk(pB1[6], pB1[7])}; pw3 = (v4u){cvtpk(pB1[8], pB1[9]), cvtpk(pB1[10], pB1[11]), cvtpk(pB1[12], pB1[13]), cvtpk(pB1[14], pB1[15])};
      unsigned vb_ = vaddr0 + (((NT - 1) & 1) ? AT_TILE : 0); asm volatile("" : "+v"(vb_));
#pragma unroll
      for (int j = 0; j < 8; ++j) { AT_VFRAG(vlo[j], vhi[j], j >> 2, j & 3); AT_VFRAG(wlo[j], whi[j], 2 + (j >> 2), j & 3); }
      AT_SB();
#pragma unroll
      for (int j = 0; j < 8; ++j) o[j & 3] = __builtin_amdgcn_mfma_f32_32x32x16_bf16(AT_VF(vlo[j], vhi[j]), __builtin_bit_cast(bf16x8, (j < 4) ? pw0 : pw1), o[j & 3], 0, 0, 0);
#pragma unroll
      for (int j = 0; j < 8; ++j) o[j & 3] = __builtin_amdgcn_mfma_f32_32x32x16_bf16(AT_VF(wlo[j], whi[j]), __builtin_bit_cast(bf16x8, (j < 4) ? pw2 : pw3), o[j & 3], 0, 0, 0);
      asm volatile("s_waitcnt lgkmcnt(0)\n\ts_barrier" ::: "memory"); }
#undef AT_SB
#undef AT_PIN
#undef AT_KFRAG
#undef AT_VFRAG
#undef AT_VF
#undef AT_MAXDEC
#undef AT_GAPA
#undef AT_GAPB
#undef AT_STEP
    const float lt = lsum + __shfl_xor(lsum, 32);
    LAS float* xs = (LAS float*)(F.lds + AT_XB) + qg * 4096 + lane;
    if (!lead) { const float sc1 = lam / lt;
#pragma unroll
        for (int db = 0; db < 4; ++db)
#pragma unroll
            for (int r = 0; r < 16; ++r) xs[(db * 16 + r) * 64] = o[db][r] * sc1; }
    __syncthreads();
    if (lead) {
        const float i0 = 1.0f / lt; float ss = 0.f;
#pragma unroll
        for (int db = 0; db < 4; ++db)
#pragma unroll
            for (int r = 0; r < 16; ++r) { const float v = o[db][r] * i0 - xs[(db * 16 + r) * 64]; o[db][r] = v; ss += v * v; }
        ss += __shfl_xor(ss, 32);
        const float rs = oscale / sqrtf(ss * (1.0f / 128.0f) + LN_EPS);
        bf16* yp = F.Y + (size_t)qrow * YW + h * 128 + 4 * hi;
#pragma unroll
        for (int db = 0; db < 4; ++db)
#pragma unroll
            for (int g4 = 0; g4 < 4; ++g4) { const int d = 32 * db + 8 * g4; const f32x4 gv = *(const f32x4*)(subg + d + 4 * hi);
                v2u w; w.x = cvtpk(o[db][4 * g4 + 0] * rs * gv[0], o[db][4 * g4 + 1] * rs * gv[1]); w.y = cvtpk(o[db][4 * g4 + 2] * rs * gv[2], o[db][4 * g4 + 3] * rs * gv[3]);
                *(GAS v2u*)(yp + d) = w; }
    }
#undef AT_DMAK
#undef AT_DMAV
}

constexpr int GM_ST = 0, GM_VT = 1024, GM_VP = 272;
__device__ __forceinline__ void gmlp_unit(Frame& F, int row0, int l) {
    int tid_ = F.ltid(); asm volatile("" : "+v"(tid_)); const int tid = tid_, lane = tid & 63, wid = __builtin_amdgcn_readfirstlane(F.ltid() >> 6);
    typedef float f32x2v __attribute__((ext_vector_type(2)));
    LAS f32x2v* st = (LAS f32x2v*)(F.lds + GM_ST); LAS unsigned char* vt = F.lds + GM_VT;
    const bf16* Z = F.Z;
    __syncthreads();
#pragma unroll
    for (int hb = 0; hb < 2; ++hb) {
        v4u va[8], vb[8];
#pragma unroll
        for (int i = 0; i < 8; ++i) { const bf16* vp = Z + (size_t)(row0 + wid * 16 + hb * 8 + i) * INW + BU_OFF + BW + lane * 16; va[i] = *(const GAS v4u*)(vp); vb[i] = *(const GAS v4u*)(vp + 8); }
#pragma unroll
        for (int i = 0; i < 8; ++i) { const v4u a = va[i], b2 = vb[i];
            const float x[16] = {bflo(a.x), bfhi(a.x), bflo(a.y), bfhi(a.y), bflo(a.z), bfhi(a.z), bflo(a.w), bfhi(a.w), bflo(b2.x), bfhi(b2.x), bflo(b2.y), bfhi(b2.y), bflo(b2.z), bfhi(b2.z), bflo(b2.w), bfhi(b2.w)};
            float s = 0.f;
#pragma unroll
            for (int e = 0; e < 16; ++e) s += x[e];
            const float mean = wave_sum(s) * (1.0f / 1024.0f); float q = 0.f;
#pragma unroll
            for (int e = 0; e < 16; ++e) { const float dd = x[e] - mean; q += dd * dd; }
            const float rstd = 1.0f / sqrtf(wave_sum(q) * (1.0f / 1024.0f) + LN_EPS);
            if (lane == 0) st[wid * 16 + hb * 8 + i] = (f32x2v){mean, rstd}; }
    }
    const float* lng = F.gln_g + (size_t)l * BW; const float* lnb = F.gln_b + (size_t)l * BW;
    const int j = tid & 127, cc = tid >> 7;
    const int fr = lane & 15, fq = lane >> 4, tok = wid * 16 + fr;
    const bf16* vsrc = Z + (size_t)(row0 + j) * INW + BU_OFF + BW + cc * 32;
    v4u vr[4];
#pragma unroll
    for (int q4 = 0; q4 < 4; ++q4) vr[q4] = *(const GAS v4u*)(vsrc + q4 * 8);
    __syncthreads();
    const f32x2v sj = st[j];
#pragma unroll 1
    for (int g = 0; g < 8; ++g) {
        bf16x8 wf[4]; v2u uu[8];
        const bf16* wg = F.Wsp + ((size_t)l * 8 + g) * 16384 + (size_t)tok * 128 + fq * 8;
#pragma unroll
        for (int ks = 0; ks < 4; ++ks) wf[ks] = *(const GAS bf16x8*)(wg + ks * 32);
        const bf16* up = Z + (size_t)(row0 + tok) * INW + BU_OFF + g * 128 + 4 * fq;
#pragma unroll
        for (int ct = 0; ct < 8; ++ct) uu[ct] = *(const GAS v2u*)(up + ct * 16);
        const float bias = F.b_sp[((size_t)l * 8 + g) * 128 + tok];
#pragma unroll
        for (int q4 = 0; q4 < 4; ++q4) { const v4u a = vr[q4]; const int c0 = cc * 32 + q4 * 8;
            const f32x4 g0 = *(const f32x4*)(lng + g * 128 + c0), g1 = *(const f32x4*)(lng + g * 128 + c0 + 4), b0 = *(const f32x4*)(lnb + g * 128 + c0), b1 = *(const f32x4*)(lnb + g * 128 + c0 + 4);
            const float xv[8] = {bflo(a.x), bfhi(a.x), bflo(a.y), bfhi(a.y), bflo(a.z), bfhi(a.z), bflo(a.w), bfhi(a.w)};
#pragma unroll
            for (int e = 0; e < 8; ++e) { const float gg = e < 4 ? g0[e & 3] : g1[e & 3], bb = e < 4 ? b0[e & 3] : b1[e & 3]; const float y = (xv[e] - sj.x) * sj.y * gg + bb;
                *(LAS bf16*)(vt + (c0 + e) * GM_VP + j * 2) = (bf16)f2bf(y); } }
        if (g < 7) {
#pragma unroll
            for (int q4 = 0; q4 < 4; ++q4) vr[q4] = *(const GAS v4u*)(vsrc + (g + 1) * 128 + q4 * 8);
        }
        __syncthreads();
#pragma unroll
        for (int ct = 0; ct < 8; ++ct) { f32x4 acc = {0.f, 0.f, 0.f, 0.f};
#pragma unroll
            for (int ks = 0; ks < 4; ++ks) { const bf16x8 af = *(const LAS bf16x8*)(vt + (ct * 16 + fr) * GM_VP + (ks * 32 + fq * 8) * 2); acc = __builtin_amdgcn_mfma_f32_16x16x32_bf16(af, wf[ks], acc, 0, 0, 0); }
            const v2u u2 = uu[ct];
            v2u w; w.x = cvtpk(bflo(u2.x) * (acc[0] + bias), bfhi(u2.x) * (acc[1] + bias)); w.y = cvtpk(bflo(u2.y) * (acc[2] + bias), bfhi(u2.y) * (acc[3] + bias));
            *(GAS v2u*)(F.Y + (size_t)(row0 + tok) * YW + BW + g * 128 + ct * 16 + 4 * fq) = w; }
        __syncthreads();
    }
}

constexpr int PL_DP = 528;
template <int GI> __device__ __forceinline__ void pool_unit(Frame& F, int row0, int l) {
    int tid_ = F.ltid(); asm volatile("" : "+v"(tid_)); const int tid = tid_, lane = tid & 63, wid = __builtin_amdgcn_readfirstlane(F.ltid() >> 6);
    LAS unsigned char* dt = F.lds;
    const bf16* Z = F.Z;
    constexpr int W = 2 << GI, HW = W / 2, NR = 8 + W - 1;
    const int seqlen = row0 < MLAT ? SEQ : CTXL; const int s0 = row0 < MLAT ? (row0 & ~(SEQ - 1)) : MLAT + ((row0 - MLAT) & ~(CTXL - 1));
    const int fr = lane & 15, fq = lane >> 4;
    bf16x8 wa[8][2];
    { const bf16* wp = F.Wpool + ((size_t)l * 4 + GI) * 65536 + (size_t)(wid * 32 + fr) * 256 + fq * 8;
#pragma unroll
      for (int ks = 0; ks < 8; ++ks) { wa[ks][0] = *(const GAS bf16x8*)(wp + ks * 32); wa[ks][1] = *(const GAS bf16x8*)(wp + 16 * 256 + ks * 32); } }
    __syncthreads();
    { const int ch = tid & 31, tg = tid >> 5;
      const bf16* zc = Z + C_OFF + GI * 256 + ch * 8; const int p0 = row0 - s0 + tg * 8;
      v4u rw[NR];
#pragma unroll
      for (int k = 0; k < NR; ++k) { const int q = p0 - HW + k; const bool ok = (q >= 0) && (q < seqlen); const int qq = ok ? q : p0; const v4u a = *(const GAS v4u*)(zc + (size_t)(s0 + qq) * INW); rw[k] = ok ? a : (v4u){0u, 0u, 0u, 0u}; }
      float sum[8] = {0.f, 0.f, 0.f, 0.f, 0.f, 0.f, 0.f, 0.f};
#pragma unroll
      for (int k = 0; k < W; ++k) { const v4u a = rw[k]; sum[0] += bflo(a.x); sum[1] += bfhi(a.x); sum[2] += bflo(a.y); sum[3] += bfhi(a.y); sum[4] += bflo(a.z); sum[5] += bfhi(a.z); sum[6] += bflo(a.w); sum[7] += bfhi(a.w); }
#pragma unroll
      for (int i = 0; i < 8; ++i) { const int p = p0 + i; const int lo = p - HW < 0 ? 0 : p - HW; const int hi = p - HW + W > seqlen ? seqlen : p - HW + W; const float inv = 1.0f / (float)(hi - lo);
          const v4u zz = rw[i + HW];
          v4u o; o.x = pk2(sum[0] * inv - bflo(zz.x), sum[1] * inv - bfhi(zz.x)); o.y = pk2(sum[2] * inv - bflo(zz.y), sum[3] * inv - bfhi(zz.y));
          o.z = pk2(sum[4] * inv - bflo(zz.z), sum[5] * inv - bfhi(zz.z)); o.w = pk2(sum[6] * inv - bflo(zz.w), sum[7] * inv - bfhi(zz.w));
          *(LAS v4u*)(dt + (tg * 8 + i) * PL_DP + ch * 16) = o;
          if (i < 7) { const v4u a = rw[i + W], b = rw[i];
              sum[0] += bflo(a.x) - bflo(b.x); sum[1] += bfhi(a.x) - bfhi(b.x); sum[2] += bflo(a.y) - bflo(b.y); sum[3] += bfhi(a.y) - bfhi(b.y);
              sum[4] += bflo(a.z) - bflo(b.z); sum[5] += bfhi(a.z) - bfhi(b.z); sum[6] += bflo(a.w) - bflo(b.w); sum[7] += bfhi(a.w) - bfhi(b.w); } } }
    __syncthreads();
    { f32x4 acc[2][8];
#pragma unroll
      for (int a = 0; a < 2; ++a)
#pragma unroll
          for (int tt = 0; tt < 8; ++tt) acc[a][tt] = (f32x4){0.f, 0.f, 0.f, 0.f};
#pragma unroll
      for (int ks = 0; ks < 8; ++ks) {
#pragma unroll
          for (int tt = 0; tt < 8; ++tt) { const bf16x8 bfr = *(const LAS bf16x8*)(dt + (tt * 16 + fr) * PL_DP + (ks * 32 + fq * 8) * 2);
              acc[0][tt] = __builtin_amdgcn_mfma_f32_16x16x32_bf16(wa[ks][0], bfr, acc[0][tt], 0, 0, 0); acc[1][tt] = __builtin_amdgcn_mfma_f32_16x16x32_bf16(wa[ks][1], bfr, acc[1][tt], 0, 0, 0); } }
      const float* ps = F.pool_scale + (size_t)l * BW + GI * 256;
#pragma unroll
      for (int a = 0; a < 2; ++a) { const int dd = wid * 32 + a * 16 + 4 * fq; const f32x4 sc = *(const f32x4*)(ps + dd);
#pragma unroll
          for (int tt = 0; tt < 8; ++tt) { const f32x4 v = acc[a][tt] * sc; v2u wv; wv.x = cvtpk(v[0], v[1]); wv.y = cvtpk(v[2], v[3]);
              *(GAS v2u*)(F.Y + (size_t)(row0 + tt * 16 + fr) * YW + 2 * BW + GI * 256 + dd) = wv; } } }
}
__device__ __forceinline__ void pool_dispatch(Frame& F, int row0, int g, int l) {
    if (g == 0) pool_unit<0>(F, row0, l); else if (g == 1) pool_unit<1>(F, row0, l); else if (g == 2) pool_unit<2>(F, row0, l); else pool_unit<3>(F, row0, l);
}

#ifndef MIXM
#define MIXM 7
#endif
__device__ __forceinline__ void phase_mixers(Frame& F, int l, float lam_init) {
    const bool last = (l == DEPTH - 1);
    float d01 = 0.f, d23 = 0.f; const float* lq = F.lam_qk + (size_t)l * 256;
    for (int i = 0; i < 64; ++i) { d01 += lq[i] * lq[64 + i]; d23 += lq[128 + i] * lq[192 + i]; }
    const float lam = __expf(d01) - __expf(d23) + lam_init; const float oscale = 1.0f - lam_init;
    const float* subg = F.subln_g + (size_t)l * 128;
#ifndef REP_ATT
#define REP_ATT 1
#endif
#ifndef REP_GP
#define REP_GP 1
#endif
#pragma nounroll
    for (int i = 0; i < 5 * REP_ATT; ++i) { const int uid = F.vcu + F.G * (i % 5);
        if (!(MIXM & 1)) continue;
        if (uid < 1024) attn_unit(F, uid >> 8, (uid >> 5) & 7, uid & 31, false, lam, oscale, subg);
        else if (!last && uid < 1088) attn_unit(F, (uid - 1024) >> 4, ((uid - 1024) >> 1) & 7, uid & 1, true, lam, oscale, subg);
        if (TAILWORK == 2 && !last && i == (F.vcu & 3)) { __syncthreads(); const int gw_ = F.vcu * NWAVES + __builtin_amdgcn_readfirstlane(F.ltid() >> 6); ada_partial_layer(F, l + 1, gw_, F.G * NWAVES); cvt_layer(F, l + 1, gw_, F.G * NWAVES); } }
    const int nchunk = last ? MLAT / 128 : MTOT / 128;
#pragma nounroll
    for (int rgp = 0; rgp < REP_GP; ++rgp) {
    if (MIXM & 2) for (int cidx = F.G - 1 - F.vcu; cidx < nchunk; cidx += F.G) gmlp_unit(F, cidx * 128, l);
    if (MIXM & 4) { const int nfree = F.G - nchunk, npool = nchunk * 4;
        if (nfree > 0 && F.G == 256) {
            if (F.vcu < nfree) { for (int k = 0; k < 4; ++k) { const int u = F.vcu * 4 + k; if (u < npool) pool_dispatch(F, (u >> 2) * 128, u & 3, l); } }
            else { for (int u = nfree * 4 + (F.vcu - nfree); u < npool; u += nchunk) pool_dispatch(F, (u >> 2) * 128, u & 3, l); }
        } else { for (int u = F.vcu; u < npool; u += F.G) pool_dispatch(F, (u >> 2) * 128, u & 3, l); } }
    }
    __syncthreads();
}

#ifndef ALIGN_P3
#define ALIGN_P3 true
#endif
#ifndef WGM_P1
#define WGM_P1 4
#endif
#ifndef WGM_P5
#define WGM_P5 4
#endif
#ifndef WGM_N8
#define WGM_N8 4
#endif
#ifndef SP2_BIG
#define SP2_BIG true
#endif
#ifndef ALIGN_BIG
#define ALIGN_BIG true
#endif
#ifndef STAGGER
#define STAGGER 0
#endif
__device__ __forceinline__ void phase_stagger(int slot) { if (STAGGER) for (int i = 0; i < slot * 3; ++i) __builtin_amdgcn_s_sleep(8); }
#ifndef MK_ONE_LAUNCH
#define MK_ONE_LAUNCH 1
#endif
constexpr int NPHASE = 3 + 8 * DEPTH;
struct Args { const float* in[23]; float* out; unsigned char* ws; int ph_lo, ph_hi; float lam_init[4]; };
__global__ void __launch_bounds__(NWAVES * 64, 2) fwd(Args args) {
    extern __shared__ __attribute__((aligned(16))) unsigned char lds[];
    Frame F;
    F.lds = (LAS unsigned char*)lds;
    F.MISC = (volatile LAS unsigned*)(F.lds + MISC_OFF);
    F.G = gridDim.x; { const int bx = blockIdx.x; F.bx = bx; F.vcu = (F.G % 8 == 0) ? (bx % 8) * (F.G / 8) + bx / 8 : bx; }
    unsigned char* ws = args.ws;
    F.ctl = (gu32*)(ws + WS_CTL);
    frame_ptrs(F);
    for (int u = F.ltid(); u < (LDS_BYTES - LDSCTL_OFF) / 4; u += NWAVES * 64) ((LAS unsigned*)(F.lds + LDSCTL_OFF))[u] = 0u;
    __syncthreads();
#if MK_ONE_LAUNCH
    constexpr int lo = 0, hi = NPHASE; constexpr bool use_bar = true;
#else
    const int lo = args.ph_lo, hi = args.ph_hi;
    const bool use_bar = (hi - lo) > 1;
#endif
    XcdBarrier bar; bar.bar = (unsigned*)(F.ctl + CW_BAR); bar.x = 0; bar.st = nullptr;
    if (use_bar) bar = xcd_barrier_post((unsigned*)(F.ctl + CW_BAR), F.MISC + 8);
#ifndef PHM
#define PHM 0xFFFF
#endif
#define IN(k) (lo <= (k) && (k) < hi)
#define KIND(b) ((PHM >> (b)) & 1)
#ifndef REP_MASK
#define REP_MASK 0
#endif
#define NREP(b) (((REP_MASK >> (b)) & 1) ? 2 : 1)
#define BARRIER() do { XcdBarrier b_ = bar; asm volatile("" : "+s"(b_.x)); xcd_barrier(b_); } while (0)
#ifndef DRY_EPI
#define DRY_EPI 0
#endif
#ifndef BAR_REP
#define BAR_REP 1
#endif
#define SEAM(k) do { if (IN(k) && IN((k) + 1)) { for (int br_ = 0; br_ < BAR_REP; ++br_) BARRIER(); } } while (0)

    if (KIND(0) && IN(0)) { for (int rep = 0; rep < NREP(0); ++rep) { frame_ptrs(F); phase_a1(F); if (rep + 1 < NREP(0)) BARRIER(); } } SEAM(0);
    if (KIND(1) && IN(1)) { frame_ptrs(F); phase_a2(F); } SEAM(1);
    if (KIND(2) && IN(2)) { frame_ptrs(F); phase_a3(F); } SEAM(2);

#pragma nounroll
    for (int l = 0; l < DEPTH; ++l) {
        const int pb = 3 + 8 * l; const bool last = (l == DEPTH - 1);
        { int g_ = F.G, v_ = F.vcu, b_ = F.bx; asm volatile("" : "+s"(g_), "+s"(v_), "+s"(b_)); F.G = g_; F.vcu = v_; F.bx = b_; }
        const int Mrows = last ? MLAT : MTOT;
        if (KIND(3) && IN(pb + 0)) for (int rep = 0; rep < NREP(3); ++rep) { if (rep) BARRIER(); frame_ptrs(F);
            pg8::Gemm g{F.HA, F.Win + (size_t)l * INW * D, MTOT, INW, D, D, D}; pg8::StaticOrder S; S.init(MTOT, INW, F.G, F.bx, WGM_P1);
            pg8::EpiInProj E{F.Z, F.rope, QSCALE, INW, MLAT, F.KB, F.VB, (rep && DRY_EPI) ? 1 : 0};
            phase_stagger((F.bx >> 3) & 7);
            pg8::gemm_phase<pg8::EpiInProj, pg8::StaticOrder, ALIGN_BIG, SP2_BIG>(F.lds + RING_OFF, g, S, E);
        }
        SEAM(pb + 0);
        if (KIND(4) && IN(pb + 1)) for (int rep = 0; rep < NREP(4); ++rep) { if (rep) BARRIER(); frame_ptrs(F); phase_mixers(F, l, args.lam_init[l]); }
        SEAM(pb + 1);
        if (KIND(5) && IN(pb + 2)) for (int rep = 0; rep < NREP(5); ++rep) { if (rep) BARRIER(); frame_ptrs(F);
            pg8::Gemm g{F.Y, F.Wbr + (size_t)l * D * YW, Mrows, D, YW, YW, YW}; pg8::StaticOrder S; S.init(Mrows, D, F.G, F.bx, WGM_N8);
            pg8::EpiGate E{F.Z + G_OFF, INW, F.MG, D};
            pg8::gemm_phase<pg8::EpiGate, pg8::StaticOrder, ALIGN_P3, true>(F.lds + RING_OFF, g, S, E);
        }
        SEAM(pb + 2);
        if (KIND(6) && IN(pb + 3)) for (int rep = 0; rep < NREP(6); ++rep) { if (rep) BARRIER(); frame_ptrs(F);
            void* tw = rep ? (void*)(F.Z + (size_t)134 * MiB) : (void*)F.Y;
            { pg8::Gemm g{F.MG, F.Wout + (size_t)l * D * D, MLAT, D, D, D, D}; pg8::StaticOrder S; S.init(MLAT, D, F.G, F.bx, WGM_N8);
              pg8::EpiResidT<false> E{F.mods + (size_t)l * 5 * INW + 2 * D, INW, tw, D, 1, MLAT};
              pg8::gemm_phase<pg8::EpiResidT<false>, pg8::StaticOrder, true, true>(F.lds + RING_OFF, g, S, E); }
            if (!last) { pg8::Gemm g{F.MG, F.Wout + (size_t)l * D * D, MTOT, D, 256, D, D}; pg8::SplitOrder S; S.init(MLAT / 256, 32, 8, 256, F.G, F.bx);
              pg8::EpiResidT<true> E{F.mods + (size_t)l * 5 * INW + 2 * D, INW, rep ? (void*)(F.Z + (size_t)170 * MiB) : (void*)(F.Z + (size_t)100 * MiB), D, 256, MLAT};
              pg8::gemm_phase<pg8::EpiResidT<true>, pg8::SplitOrder, true, true>(F.lds + RING_OFF, g, S, E); }
            if (TAILWORK == 1 && !last && F.bx >= 32 && rep == 0) ada_partial_layer(F, l + 1, (F.bx - 32) * NWAVES + __builtin_amdgcn_readfirstlane(F.ltid() >> 6), (F.G - 32) * NWAVES);
        }
        SEAM(pb + 3);
        if (KIND(7) && IN(pb + 4)) { frame_ptrs(F); if (NREP(7) > 1) { phase_ln(F, F.ln1_g + (size_t)l * D, F.ln1_b + (size_t)l * D, Mrows, false, true, l, 3 * D, last ? 0 : 8, true); BARRIER(); frame_ptrs(F); }
            phase_ln(F, F.ln1_g + (size_t)l * D, F.ln1_b + (size_t)l * D, Mrows, false, true, l, 3 * D, last ? 0 : 8); if (TAILWORK && !last) mods_reduce_layer(F, l + 1); }
        SEAM(pb + 4);
        if (KIND(8) && IN(pb + 5)) for (int rep = 0; rep < NREP(8); ++rep) { if (rep) BARRIER(); frame_ptrs(F);
            pg8::Gemm g{F.HA, F.Wgu + (size_t)l * 2 * FFH * D, Mrows, 2 * FFH, D, D, D}; pg8::StaticOrder S; S.init(Mrows, 2 * FFH, F.G, F.bx, WGM_P5);
            pg8::EpiSwiglu E{F.Z, FFH};
            phase_stagger((F.bx >> 3) & 7);
            pg8::gemm_phase<pg8::EpiSwiglu, pg8::StaticOrder, ALIGN_BIG, SP2_BIG>(F.lds + RING_OFF, g, S, E);
        }
        SEAM(pb + 5);
        if (KIND(9) && IN(pb + 6)) for (int rep = 0; rep < NREP(9); ++rep) { if (rep) BARRIER(); frame_ptrs(F);
            void* tw = rep ? (void*)(F.Z + (size_t)134 * MiB) : (void*)F.Y;
            { pg8::Gemm g{F.Z, F.Wdn + (size_t)l * D * FFH, MLAT, D, FFH, FFH, FFH}; pg8::StaticOrder S; S.init(MLAT, D, F.G, F.bx, WGM_N8);
              pg8::EpiResidT<false> E{F.mods + (size_t)l * 5 * INW + 5 * D, INW, tw, D, 1, MLAT};
              pg8::gemm_phase<pg8::EpiResidT<false>, pg8::StaticOrder, true, true>(F.lds + RING_OFF, g, S, E); }
            if (!last) { pg8::Gemm g{F.Z, F.Wdn + (size_t)l * D * FFH, MTOT, D, FFH / 4, FFH, FFH}; pg8::SplitOrder S; S.init(MLAT / 256, 32, 4, FFH / 4, F.G, F.bx);
              pg8::EpiResidT<true> E{F.mods + (size_t)l * 5 * INW + 5 * D, INW, rep ? (void*)(F.Z + (size_t)170 * MiB) : (void*)(F.Z + (size_t)100 * MiB), D, FFH / 4, MLAT};
              pg8::gemm_phase<pg8::EpiResidT<true>, pg8::SplitOrder, true, true>(F.lds + RING_OFF, g, S, E); }
            if (TAILWORK == 1 && !last && F.bx >= 32 && rep == 0) { __syncthreads(); cvt_layer(F, l + 1, (F.bx - 32) * NWAVES + __builtin_amdgcn_readfirstlane(F.ltid() >> 6), (F.G - 32) * NWAVES); }
        }
        SEAM(pb + 6);
        if (KIND(7) && IN(pb + 7)) { frame_ptrs(F); phase_ln(F, F.ln2_g + (size_t)l * D, F.ln2_b + (size_t)l * D, Mrows, last, !last, last ? l : l + 1, 0, last ? 0 : 4); }
        if (!last) SEAM(pb + 7);
    }
#undef IN
#undef SEAM
}

extern "C" void kernel_launch(void* const* d_in, const int* in_sizes, int n_in, void* d_out, int out_size, void* d_ws, size_t ws_size, hipStream_t stream) {
    static int grid = 0;
    if (grid == 0) {
        if (n_in != 23 || in_sizes[0] != MLAT * D || out_size != MLAT * D || ws_size < WS_END) {
            fprintf(stderr, "kernel_launch: unexpected shapes / workspace (n_in %d, in0 %d, out %d, ws %zu, need %zu); nothing launched\n", n_in, n_in > 0 ? in_sizes[0] : -1, out_size, ws_size, (size_t)WS_END); grid = -1; return; }
        int dev = 0, cus = 0, per_cu = 0;
        if (hipGetDevice(&dev) != hipSuccess || hipDeviceGetAttribute(&cus, hipDeviceAttributeMultiprocessorCount, dev) != hipSuccess) { grid = -1; return; }
        if (hipFuncSetAttribute((const void*)fwd, hipFuncAttributeMaxDynamicSharedMemorySize, LDS_BYTES) != hipSuccess) { fprintf(stderr, "kernel_launch: hipFuncSetAttribute failed\n"); grid = -1; return; }
        if (hipOccupancyMaxActiveBlocksPerMultiprocessor(&per_cu, (const void*)fwd, NWAVES * 64, LDS_BYTES) != hipSuccess || per_cu < 1) fprintf(stderr, "kernel_launch: occupancy query reports %d\n", per_cu);
        (void)hipGetLastError();
        grid = cus;
    }
    if (grid < 0) return;
    if (hipMemsetAsync((char*)d_ws + WS_CTL, 0, CTL_ZERO_BYTES, stream) != hipSuccess) return;
    Args a{};
    for (int i = 0; i < 23; ++i) a.in[i] = (const float*)d_in[i];
    a.out = (float*)d_out; a.ws = (unsigned char*)d_ws;
    for (int l = 0; l < DEPTH; ++l) a.lam_init[l] = (float)(0.8 - 0.6 * exp(-0.3 * (double)l));
#if MK_ONE_LAUNCH
    a.ph_lo = 0; a.ph_hi = NPHASE;
    hipLaunchKernelGGL(fwd, dim3(grid), dim3(NWAVES * 64), LDS_BYTES, stream, a);
#else
    for (int p = 0; p < NPHASE; ++p) { a.ph_lo = p; a.ph_hi = p + 1; hipLaunchKernelGGL(fwd, dim3(grid), dim3(NWAVES * 64), LDS_BYTES, stream, a); }
#endif
}
```

```cpp
#include <hip/hip_runtime.h>
#include <cstdio>
#include <cstdint>
#include <cmath>
namespace pg8 {
#define PG8_LAS __attribute__((address_space(3)))
typedef unsigned short bf16_t;
typedef short bf16x8 __attribute__((ext_vector_type(8)));
typedef float f32x4 __attribute__((ext_vector_type(4)));
typedef unsigned u32x4 __attribute__((ext_vector_type(4)));
constexpr int BM = 256, BK = 64, HALF = 128, HTB = HALF * BK * 2  , STAGE_BYTES = 8 * HTB, NXCD = 8, WGM = 4;

__host__ __device__ __forceinline__ int lds_byte(int r, int c) { const int st = (r >> 4) * 2 + (c >> 5), rr = r & 15, cc = c & 31, ob = rr * 64 + cc * 2; return st * 1024 + (ob ^ (((ob >> 9) & 1) << 5)); }
__host__ __device__ __forceinline__ void stage_rc(int b, int& R, int& C) { const int st = b / 1024, sb = b % 1024, swz = sb ^ (((sb >> 9) & 1) << 5); R = (st >> 1) * 16 + swz / 64; C = (st & 1) * 32 + (swz % 64) / 2; }
__host__ __device__ __forceinline__ int perm32(int rho) { const int n = rho >> 4, i = rho & 15; return 8 * (i >> 2) + 4 * n + (i & 3); }

struct Unit { int pm, pn, ka; };
struct Gemm { const bf16_t* A; const bf16_t* Bt; int M, N, K, lda, ldb; };

struct StaticOrder {
    int nM, nN, nwg, G, c, wgm;
    __host__ __device__ void init(int M, int N, int G_, int c_, int wgm_ = WGM) { nM = M / BM; nN = N / BM; nwg = nM * nN; G = G_; c = c_; wgm = wgm_; }
    __host__ __device__ bool next(int i, Unit& u) const {
        const long L = (long)i * G + c; if (L >= nwg) return false;
        int wgid = (int)L; { const int q = nwg / NXCD, r = nwg % NXCD, xcd = wgid % NXCD, off = wgid / NXCD; wgid = (xcd < r ? xcd * (q + 1) : r * (q + 1) + (xcd - r) * q) + off; }
        const int nig = wgm * nN, gid = wgid / nig, fm = gid * wgm, gsz = (nM - fm) < wgm ? (nM - fm) : wgm;
        u.pm = fm + ((wgid % nig) % gsz); u.pn = (wgid % nig) / gsz; u.ka = 0; return true;
    }
    __device__ __forceinline__ void a_ready(const Unit&) const {}
    __device__ __forceinline__ void done(const Unit&) const {}
};

struct SplitOrder {
    int nsplit, klen, G, c, pm0, ntile;
    __host__ __device__ void init(int pm0_, int ntile_, int nsplit_, int klen_, int G_, int c_) { pm0 = pm0_; ntile = ntile_; nsplit = nsplit_; klen = klen_; G = G_; c = c_; }
    __host__ __device__ bool next(int i, Unit& u) const { const int L = i * G + c; if (L >= ntile * nsplit) return false; const int tt = L / nsplit; u.pm = pm0 + (tt & 3); u.pn = tt >> 2; u.ka = (L - tt * nsplit) * klen; return true; }
    __device__ __forceinline__ void a_ready(const Unit&) const {}
    __device__ __forceinline__ void done(const Unit&) const {}
};
__device__ __forceinline__ unsigned cvt_pk_bf16(float lo, float hi) { unsigned r; asm volatile("v_cvt_pk_bf16_f32 %0, %1, %2" : "=v"(r) : "v"(lo), "v"(hi)); return r; }
typedef float f32x2 __attribute__((ext_vector_type(2)));
__device__ __forceinline__ f32x2 gelu_pk(f32x2 v) {
    const f32x2 av = __builtin_elementwise_abs(v), d = av * 0.2316418882f + 1.0f;
    f32x2 t; t.x = __builtin_amdgcn_rcpf(d.x); t.y = __builtin_amdgcn_rcpf(d.y);
    f32x2 q = t * 0.5307027145f + (-0.7265760135f); q = q * t + 0.7107068705f; q = q * t + (-0.142248368f); q = q * t + 0.127414796f; q = q * t;
    const f32x2 s = (v * v) * (-0.72134752044f);
    f32x2 e; e.x = __builtin_amdgcn_exp2f(s.x); e.y = __builtin_amdgcn_exp2f(s.y);
    const f32x2 m = v * (q * e), r = v - m;
    f32x2 o; o.x = v.x < 0.f ? m.x : r.x; o.y = v.y < 0.f ? m.y : r.y; return o;
}

#ifndef GATE_NT
#define GATE_NT 0
#endif
#if GATE_NT
#define GATE_LD(p) __builtin_nontemporal_load(p)
#else
#define GATE_LD(p) (*(p))
#endif
#ifndef GATE_ST_NT
#define GATE_ST_NT 0
#endif
#ifndef EPI_NT
#define EPI_NT 0
#endif
typedef unsigned u32x2 __attribute__((ext_vector_type(2)));
__device__ __forceinline__ float bf_lo(unsigned w) { return __uint_as_float(w << 16); }
__device__ __forceinline__ float bf_hi(unsigned w) { return __uint_as_float(w & 0xffff0000u); }
__device__ __forceinline__ void store8_bf16(bf16_t* p, const f32x4 v0, const f32x4 v1) {
    u32x4 w; w.x = cvt_pk_bf16(v0[0], v0[1]); w.y = cvt_pk_bf16(v0[2], v0[3]); w.z = cvt_pk_bf16(v1[0], v1[1]); w.w = cvt_pk_bf16(v1[2], v1[3]);
#if EPI_NT
    __builtin_nontemporal_store(w, (u32x4*)p);
#else
    *(u32x4*)p = w;
#endif
}
__device__ __forceinline__ float sigmoid_f(float x) { return __builtin_amdgcn_rcpf(1.0f + __builtin_amdgcn_exp2f(x * -1.4426950408889634f)); }

struct EpiInProj {
    static constexpr bool PERM = true, AFTER_DRAIN = false; static constexpr int KSEG = 0;
    bf16_t* Z; const float* rope; float qscale; int ldc; int nlat; bf16_t* Kb; bf16_t* Vb; int dry;
    __device__ __forceinline__ void kseg(f32x4 (&)[2][2][4][2], const Unit&, int, int, int, int, int) const {}
    __device__ __forceinline__ void operator()(const f32x4 (&acc)[2][2][4][2], const Unit& u, int wr, int wc, int fr, int fq) const {
        const int pn = u.pn; const int row0 = u.pm * BM + wr * 64 + fr; const int col0 = pn * BM + wc * 32 + 8 * fq;
        if (dry) { float s_ = 0.f;
#pragma unroll
            for (int a_ = 0; a_ < 2; ++a_)
#pragma unroll
                for (int b_ = 0; b_ < 2; ++b_)
#pragma unroll
                    for (int m_ = 0; m_ < 4; ++m_)
#pragma unroll
                        for (int n_ = 0; n_ < 2; ++n_) s_ += acc[a_][b_][m_][n_][0];
            if (s_ != s_) Z[0] = 0; return; }
        if (pn < 8) {
            const float sc = pn < 4 ? qscale : 1.0f;
#pragma unroll
            for (int ai = 0; ai < 2; ++ai)
#pragma unroll
                for (int m = 0; m < 4; ++m) {
                    const int row = row0 + ai * HALF + m * 16; const int t = row & 4095; const int pos = (wc & 1) ? (t & 63) : (t >> 6);
                    f32x4 cs0 = *(const f32x4*)(rope + (pos * 16 + 4 * fq) * 2), cs1 = *(const f32x4*)(rope + (pos * 16 + 4 * fq) * 2 + 4);
                    if (row >= nlat) { cs0 = (f32x4){1.f, 0.f, 1.f, 0.f}; cs1 = cs0; }
                    bf16_t* rowp = Z + (size_t)row * ldc + col0;
                    if (pn >= 4) { const int bb = row < nlat ? (row >> 12) : ((row - nlat) >> 8), key = row < nlat ? 256 + (row & 4095) : ((row - nlat) & 255);
                        rowp = Kb + ((size_t)(bb * 8 + 2 * (pn - 4)) * 4352 + key) * 128 + wc * 32 + 8 * fq; }
#pragma unroll
                    for (int bj = 0; bj < 2; ++bj) {
                        const f32x4 a = acc[ai][bj][m][0], b = acc[ai][bj][m][1];
                        f32x4 o0, o1;
                        o0[0] = (a[0] * cs0[0] - a[1] * cs0[1]) * sc; o0[1] = (a[0] * cs0[1] + a[1] * cs0[0]) * sc;
                        o0[2] = (a[2] * cs0[2] - a[3] * cs0[3]) * sc; o0[3] = (a[2] * cs0[3] + a[3] * cs0[2]) * sc;
                        o1[0] = (b[0] * cs1[0] - b[1] * cs1[1]) * sc; o1[1] = (b[0] * cs1[1] + b[1] * cs1[0]) * sc;
                        o1[2] = (b[2] * cs1[2] - b[3] * cs1[3]) * sc; o1[3] = (b[2] * cs1[3] + b[3] * cs1[2]) * sc;
                        store8_bf16(rowp + (pn >= 4 ? (size_t)bj * 4352 * 128 : (size_t)bj * HALF), o0, o1);
                    }
                }
        } else if (pn < 12) {
#pragma unroll
            for (int ai = 0; ai < 2; ++ai)
#pragma unroll
                for (int m = 0; m < 4; ++m) { const int row = row0 + ai * HALF + m * 16; const int bb = row < nlat ? (row >> 12) : ((row - nlat) >> 8), key = row < nlat ? 256 + (row & 4095) : ((row - nlat) & 255);
                    bf16_t* rowp = Vb + ((size_t)(bb * 8 + 2 * (pn - 8)) * 4352 + key) * 128 + wc * 32 + 8 * fq;
#pragma unroll
                    for (int bj = 0; bj < 2; ++bj) store8_bf16(rowp + (size_t)bj * 4352 * 128, acc[ai][bj][m][0], acc[ai][bj][m][1]); }
        } else if (pn >= 20 && pn < 24) {
#pragma unroll
            for (int ai = 0; ai < 2; ++ai)
#pragma unroll
                for (int m = 0; m < 4; ++m) { bf16_t* rowp = Z + (size_t)(row0 + ai * HALF + m * 16) * ldc + col0;
#pragma unroll
                    for (int bj = 0; bj < 2; ++bj) store8_bf16(rowp + bj * HALF, acc[ai][bj][m][0], acc[ai][bj][m][1]); }
        } else if (pn < 20) {
#pragma unroll
            for (int ai = 0; ai < 2; ++ai)
#pragma unroll
                for (int m = 0; m < 4; ++m) { bf16_t* rowp = Z + (size_t)(row0 + ai * HALF + m * 16) * ldc + col0;
#pragma unroll
                    for (int bj = 0; bj < 2; ++bj) { const f32x4 v0 = acc[ai][bj][m][0], v1 = acc[ai][bj][m][1];
                        const f32x2 a = gelu_pk((f32x2){v0[0], v0[1]}), b = gelu_pk((f32x2){v0[2], v0[3]}), c = gelu_pk((f32x2){v1[0], v1[1]}), d = gelu_pk((f32x2){v1[2], v1[3]});
                        store8_bf16(rowp + bj * HALF, (f32x4){a.x, a.y, b.x, b.y}, (f32x4){c.x, c.y, d.x, d.y}); } }
        } else {
#pragma unroll
            for (int ai = 0; ai < 2; ++ai)
#pragma unroll
                for (int m = 0; m < 4; ++m) { bf16_t* rowp = Z + (size_t)(row0 + ai * HALF + m * 16) * ldc + col0;
#pragma unroll
                    for (int bj = 0; bj < 2; ++bj) { const f32x4 v0 = acc[ai][bj][m][0], v1 = acc[ai][bj][m][1]; f32x4 o0, o1;
#pragma unroll
                        for (int i = 0; i < 4; ++i) { o0[i] = __builtin_fmaxf(sigmoid_f(v0[i]), 1e-12f); o1[i] = __builtin_fmaxf(sigmoid_f(v1[i]), 1e-12f); }
#if GATE_ST_NT
                        { u32x4 w; w.x = cvt_pk_bf16(o0[0], o0[1]); w.y = cvt_pk_bf16(o0[2], o0[3]); w.z = cvt_pk_bf16(o1[0], o1[1]); w.w = cvt_pk_bf16(o1[2], o1[3]); __builtin_nontemporal_store(w, (u32x4*)(rowp + bj * HALF)); } } }
#else
                        store8_bf16(rowp + bj * HALF, o0, o1); } }
#endif
        }
    }
};

struct EpiGate {
    static constexpr bool PERM = true, AFTER_DRAIN = false; static constexpr int KSEG = 16;
    const bf16_t* G; int ldg; bf16_t* O; int ldo;
    __device__ __forceinline__ void kseg(f32x4 (&acc)[2][2][4][2], const Unit& u, int seg, int wr, int wc, int fr, int fq) const {
        const int row0 = u.pm * BM + wr * 64 + fr; const int col0 = u.pn * BM + wc * 32 + 8 * fq;
#pragma unroll
        for (int ai = 0; ai < 2; ++ai) {
            u32x4 ga[4][2], gb[4][2];
#pragma unroll
            for (int m = 0; m < 4; ++m) { const bf16_t* gp = G + (size_t)(row0 + ai * HALF + m * 16) * ldg + (seg - 1) * 2048 + col0;
#pragma unroll
                for (int bj = 0; bj < 2; ++bj) { ga[m][bj] = GATE_LD((const u32x4*)(gp + bj * HALF)); gb[m][bj] = GATE_LD((const u32x4*)(gp + 2048 + bj * HALF)); } }
#pragma unroll
            for (int m = 0; m < 4; ++m)
#pragma unroll
                for (int bj = 0; bj < 2; ++bj) { const u32x4 a = ga[m][bj], b = gb[m][bj];
                    f32x4 r0, r1;
                    r0[0] = bf_lo(a.x) * __builtin_amdgcn_rcpf(bf_lo(b.x)); r0[1] = bf_hi(a.x) * __builtin_amdgcn_rcpf(bf_hi(b.x));
                    r0[2] = bf_lo(a.y) * __builtin_amdgcn_rcpf(bf_lo(b.y)); r0[3] = bf_hi(a.y) * __builtin_amdgcn_rcpf(bf_hi(b.y));
                    r1[0] = bf_lo(a.z) * __builtin_amdgcn_rcpf(bf_lo(b.z)); r1[1] = bf_hi(a.z) * __builtin_amdgcn_rcpf(bf_hi(b.z));
                    r1[2] = bf_lo(a.w) * __builtin_amdgcn_rcpf(bf_lo(b.w)); r1[3] = bf_hi(a.w) * __builtin_amdgcn_rcpf(bf_hi(b.w));
                    acc[ai][bj][m][0] *= r0; acc[ai][bj][m][1] *= r1; }
            asm volatile("" ::: "memory"); }
    }
    __device__ __forceinline__ void operator()(const f32x4 (&acc)[2][2][4][2], const Unit& u, int wr, int wc, int fr, int fq) const {
        const int row0 = u.pm * BM + wr * 64 + fr; const int col0 = u.pn * BM + wc * 32 + 8 * fq;
        u32x4 gg[2][4][2];
#pragma unroll
        for (int ai = 0; ai < 2; ++ai)
#pragma unroll
            for (int m = 0; m < 4; ++m) { const bf16_t* gp = G + (size_t)(row0 + ai * HALF + m * 16) * ldg + 2 * 2048 + col0;
#pragma unroll
                for (int bj = 0; bj < 2; ++bj) gg[ai][m][bj] = GATE_LD((const u32x4*)(gp + bj * HALF)); }
#pragma unroll
        for (int ai = 0; ai < 2; ++ai)
#pragma unroll
            for (int m = 0; m < 4; ++m) { bf16_t* op = O + (size_t)(row0 + ai * HALF + m * 16) * ldo + col0;
#pragma unroll
                for (int bj = 0; bj < 2; ++bj) { const u32x4 g = gg[ai][m][bj];
                    const f32x4 g0 = (f32x4){bf_lo(g.x), bf_hi(g.x), bf_lo(g.y), bf_hi(g.y)}, g1 = (f32x4){bf_lo(g.z), bf_hi(g.z), bf_lo(g.w), bf_hi(g.w)};
                    store8_bf16(op + bj * HALF, acc[ai][bj][m][0] * g0, acc[ai][bj][m][1] * g1); } }
    }
};

template <bool SLAB> struct EpiResidT {
    static constexpr bool PERM = !SLAB, AFTER_DRAIN = false; static constexpr int KSEG = 0;
    const float* gv; int gstride; void* Tw; int ldc; int klen, nlat;
    __device__ __forceinline__ void kseg(f32x4 (&)[2][2][4][2], const Unit&, int, int, int, int, int) const {}
    __device__ __forceinline__ void operator()(const f32x4 (&acc)[2][2][4][2], const Unit& u, int wr, int wc, int fr, int fq) const {
        const int row0 = u.pm * BM + wr * 64 + fr; const int grp = u.pm < 64 ? (u.pm >> 4) : 4;
        if constexpr (SLAB) {
            const int col0 = u.pn * BM + wc * 32 + 4 * fq;
            f32x4 g[2][2];
#pragma unroll
            for (int bj = 0; bj < 2; ++bj)
#pragma unroll
                for (int n = 0; n < 2; ++n) g[bj][n] = *(const f32x4*)(gv + (size_t)grp * gstride + col0 + bj * HALF + n * 16);
#pragma unroll
            for (int ai = 0; ai < 2; ++ai)
#pragma unroll
                for (int m = 0; m < 4; ++m) { float* pp = (float*)Tw + ((size_t)(u.ka / klen) * 1024 + (size_t)(row0 + ai * HALF + m * 16 - nlat)) * ldc + col0;
#pragma unroll
                    for (int bj = 0; bj < 2; ++bj)
#pragma unroll
                        for (int n = 0; n < 2; ++n) *(f32x4*)(pp + bj * HALF + n * 16) = g[bj][n] * acc[ai][bj][m][n]; }
        } else {
            const int col0 = u.pn * BM + wc * 32 + 8 * fq;
            f32x4 g[2][2];
#pragma unroll
            for (int bj = 0; bj < 2; ++bj)
#pragma unroll
                for (int n = 0; n < 2; ++n) g[bj][n] = *(const f32x4*)(gv + (size_t)grp * gstride + col0 + bj * HALF + n * 4);
#pragma unroll
            for (int ai = 0; ai < 2; ++ai)
#pragma unroll
                for (int m = 0; m < 4; ++m) { bf16_t* tp = (bf16_t*)Tw + (size_t)(row0 + ai * HALF + m * 16) * ldc + col0;
#pragma unroll
                    for (int bj = 0; bj < 2; ++bj) store8_bf16(tp + bj * HALF, g[bj][0] * acc[ai][bj][m][0], g[bj][1] * acc[ai][bj][m][1]); }
        }
    }
};

struct EpiSwiglu {
    static constexpr bool PERM = true, AFTER_DRAIN = false; static constexpr int KSEG = 0;
    bf16_t* H; int ldc;
    __device__ __forceinline__ void kseg(f32x4 (&)[2][2][4][2], const Unit&, int, int, int, int, int) const {}
    __device__ __forceinline__ void operator()(const f32x4 (&acc)[2][2][4][2], const Unit& u, int wr, int wc, int fr, int fq) const {
        const int row0 = u.pm * BM + wr * 64 + fr, col0 = u.pn * HALF + wc * 32 + 8 * fq;
#pragma unroll
        for (int ai = 0; ai < 2; ++ai)
#pragma unroll
            for (int m = 0; m < 4; ++m) { bf16_t* rowp = H + (size_t)(row0 + ai * HALF + m * 16) * ldc + col0; f32x4 o[2];
#pragma unroll
                for (int n = 0; n < 2; ++n) { const f32x4 gt = acc[ai][0][m][n], up = acc[ai][1][m][n];
#pragma unroll
                    for (int i = 0; i < 4; ++i) o[n][i] = gt[i] * sigmoid_f(gt[i]) * up[i]; }
                store8_bf16(rowp, o[0], o[1]); }
    }
};
template <class Epi, class Sched, bool ALIGN_EPI = false, bool SP2 = false>
__device__ __forceinline__ void gemm_phase(PG8_LAS unsigned char* lds, const Gemm g, const Sched& S, const Epi& E) {
    int tid_ = threadIdx.x; asm volatile("" : "+v"(tid_));
    const int tid = tid_, wid = __builtin_amdgcn_readfirstlane(tid >> 6), lane = tid & 63, wr = wid >> 2, wc = wid & 3, fr = lane & 15, fq = lane >> 4;
    const int K = g.K, nt = K / BK;
    unsigned voffA[2], voffB[2];
#pragma unroll
    for (int i = 0; i < 2; ++i) { int R, C; stage_rc(tid * 16 + i * 8192, R, C); const int Rb = Epi::PERM ? ((R & ~31) + perm32(R & 31)) : R;
        voffA[i] = (unsigned)(R * g.lda + C) * 2u; voffB[i] = (unsigned)(Rb * g.ldb + C) * 2u; }
    const size_t kstep = (size_t)(BK * 2);
    const size_t hstepA = (size_t)HALF * g.lda * 2, hstepB = (size_t)HALF * g.ldb * 2;
    const size_t tstepA = 2 * hstepA, tstepB = 2 * hstepB;
    const unsigned ldsw = (unsigned)wid * 1024u;
    const int aoff = lds_byte(wr * 64 + fr, fq * 8), boff = lds_byte(wc * 32 + fr, fq * 8);
#define PG8_SA(b, h) (((b) * 2 + (h)) * HTB)
#define PG8_SB(b, h) ((4 + (b) * 2 + (h)) * HTB)
#define PG8_STAGE(bufoff, gbase, voff) do { _Pragma("unroll") for (int _i = 0; _i < 2; ++_i) \
        __builtin_amdgcn_global_load_lds((const unsigned*)((const char*)(gbase) + (voff)[_i]), (PG8_LAS unsigned*)(lds + (bufoff) + ldsw + _i * 8192), 16, 0, 0); } while (0)
#define PG8_LDA(dst, b, h) do { _Pragma("unroll") for (int m = 0; m < 4; ++m) _Pragma("unroll") for (int k = 0; k < 2; ++k) dst[m][k] = *(const PG8_LAS bf16x8*)(lds + PG8_SA(b, h) + aoff + m * 2048 + k * 1024); } while (0)
#define PG8_LDB(dst, b, h) do { _Pragma("unroll") for (int n = 0; n < 2; ++n) _Pragma("unroll") for (int k = 0; k < 2; ++k) dst[n][k] = *(const PG8_LAS bf16x8*)(lds + PG8_SB(b, h) + boff + n * 2048 + k * 1024); } while (0)
#define PG8_MMA(ai, bj, At, Bt) do { __builtin_amdgcn_s_setprio(1); _Pragma("unroll") for (int m = 0; m < 4; ++m) _Pragma("unroll") for (int n = 0; n < 2; ++n) _Pragma("unroll") for (int k = 0; k < 2; ++k) \
        acc[ai][bj][m][n] = __builtin_amdgcn_mfma_f32_16x16x32_bf16(Bt[n][k], At[m][k], acc[ai][bj][m][n], 0, 0, 0); __builtin_amdgcn_s_setprio(0); } while (0)
#define PG8_WAIT_V(n) asm volatile("s_waitcnt vmcnt(" #n ")" ::: "memory")
#define PG8_WAIT_L(n) asm volatile("s_waitcnt lgkmcnt(" #n ")" ::: "memory")
#define PG8_BAR __builtin_amdgcn_s_barrier()
#define PG8_SCHED __builtin_amdgcn_sched_barrier(0)
    Unit cur, nxt; int ui = 0;
    if (!S.next(0, cur)) return;
    f32x4 acc[2][2][4][2];
#pragma unroll
    for (int a = 0; a < 2; ++a)
#pragma unroll
        for (int b = 0; b < 2; ++b)
#pragma unroll
            for (int m = 0; m < 4; ++m)
#pragma unroll
                for (int n = 0; n < 2; ++n) acc[a][b][m][n] = (f32x4){0.f, 0.f, 0.f, 0.f};
    bf16x8 At[4][2], B0[2][2], B1[2][2];
    const char* cA = (const char*)g.A + (size_t)cur.pm * tstepA + (size_t)cur.ka * 2; const char* cB = (const char*)g.Bt + (size_t)cur.pn * tstepB + (size_t)cur.ka * 2;
    S.a_ready(cur);
    if constexpr (SP2) {
        PG8_STAGE(PG8_SB(0, 0), cB, voffB); PG8_STAGE(PG8_SB(0, 1), cB + hstepB, voffB); PG8_STAGE(PG8_SA(0, 0), cA, voffA); PG8_STAGE(PG8_SA(0, 1), cA + hstepA, voffA);
        if (wr == 1) PG8_BAR;
        PG8_WAIT_V(2); PG8_BAR;
        PG8_STAGE(PG8_SB(1, 0), cB + kstep, voffB); PG8_STAGE(PG8_SA(1, 0), cA + kstep, voffA); PG8_STAGE(PG8_SB(1, 1), cB + hstepB + kstep, voffB);
        PG8_WAIT_V(6); PG8_BAR;
    } else {
        PG8_STAGE(PG8_SB(0, 0), cB, voffB); PG8_STAGE(PG8_SA(0, 0), cA, voffA); PG8_STAGE(PG8_SB(0, 1), cB + hstepB, voffB); PG8_STAGE(PG8_SA(0, 1), cA + hstepA, voffA);
        if (wr == 1) PG8_BAR;
        PG8_WAIT_V(4); PG8_BAR;
        PG8_STAGE(PG8_SB(1, 0), cB + kstep, voffB); PG8_STAGE(PG8_SA(1, 0), cA + kstep, voffA); PG8_STAGE(PG8_SB(1, 1), cB + hstepB + kstep, voffB);
        PG8_WAIT_V(6); PG8_BAR;
    }
    for (;;) {
        const bool has_next = S.next(ui + 1, nxt);
        const char* nA = has_next ? (const char*)g.A + (size_t)nxt.pm * tstepA + (size_t)nxt.ka * 2 : cA; const char* nB = has_next ? (const char*)g.Bt + (size_t)nxt.pn * tstepB + (size_t)nxt.ka * 2 : cB;
        for (int t = 0; t < nt; t += 2) {
            const bool last = (t == nt - 2);
            if constexpr (Epi::KSEG > 0) { if (t > 0 && (t % Epi::KSEG) == 0) E.kseg(acc, cur, t / Epi::KSEG, wr, wc, fr, fq); }
            const char* a1 = cA + (size_t)(t + 1) * kstep;
            const char* a2 = last ? nA : cA + (size_t)(t + 2) * kstep; const char* b2 = last ? nB : cB + (size_t)(t + 2) * kstep;
            const char* a3 = a2 + kstep; const char* b3 = b2 + kstep;
            if (last && has_next) S.a_ready(nxt);
            if constexpr (SP2) {
            PG8_LDB(B0, 0, 0); PG8_LDB(B1, 0, 1); PG8_SCHED; PG8_LDA(At, 0, 0); PG8_STAGE(PG8_SA(1, 1), a1 + hstepA, voffA);
            PG8_WAIT_V(8); PG8_WAIT_L(0); PG8_BAR; PG8_MMA(0, 0, At, B0); PG8_MMA(0, 1, At, B1); PG8_BAR; PG8_SCHED;
            PG8_LDA(At, 0, 1); PG8_STAGE(PG8_SB(0, 0), b2, voffB); PG8_STAGE(PG8_SB(0, 1), b2 + hstepB, voffB); PG8_STAGE(PG8_SA(0, 0), a2, voffA);
            PG8_WAIT_V(8); PG8_WAIT_L(0); PG8_BAR; PG8_MMA(1, 0, At, B0); PG8_MMA(1, 1, At, B1); PG8_BAR; PG8_SCHED;
            PG8_LDB(B0, 1, 0); PG8_LDB(B1, 1, 1); PG8_SCHED; PG8_LDA(At, 1, 0); PG8_STAGE(PG8_SA(0, 1), a2 + hstepA, voffA);
            PG8_WAIT_V(8); PG8_WAIT_L(0); PG8_BAR; PG8_MMA(0, 0, At, B0); PG8_MMA(0, 1, At, B1); PG8_BAR; PG8_SCHED;
            PG8_LDA(At, 1, 1); PG8_STAGE(PG8_SB(1, 0), b3, voffB); PG8_STAGE(PG8_SB(1, 1), b3 + hstepB, voffB); PG8_STAGE(PG8_SA(1, 0), a3, voffA);
            PG8_WAIT_V(8); PG8_WAIT_L(0); PG8_BAR; PG8_MMA(1, 0, At, B0); PG8_MMA(1, 1, At, B1); PG8_BAR; PG8_SCHED;
            } else {
            PG8_LDB(B0, 0, 0); PG8_SCHED; PG8_LDA(At, 0, 0); PG8_STAGE(PG8_SA(1, 1), a1 + hstepA, voffA);
            PG8_WAIT_L(8); PG8_BAR; PG8_WAIT_L(0); PG8_MMA(0, 0, At, B0); PG8_BAR; PG8_SCHED;
            PG8_LDB(B1, 0, 1); PG8_STAGE(PG8_SB(0, 0), b2, voffB);
            PG8_BAR; PG8_WAIT_L(0); PG8_MMA(0, 1, At, B1); PG8_BAR;
            PG8_LDA(At, 0, 1); PG8_STAGE(PG8_SA(0, 0), a2, voffA);
            PG8_BAR; PG8_WAIT_L(0); PG8_MMA(1, 0, At, B0); PG8_BAR; PG8_SCHED;
            PG8_STAGE(PG8_SB(0, 1), b2 + hstepB, voffB);
            PG8_WAIT_V(6); PG8_BAR; PG8_MMA(1, 1, At, B1); PG8_BAR;
            PG8_LDB(B0, 1, 0); PG8_SCHED; PG8_LDA(At, 1, 0); PG8_STAGE(PG8_SA(0, 1), a2 + hstepA, voffA);
            PG8_WAIT_L(8); PG8_BAR; PG8_WAIT_L(0); PG8_MMA(0, 0, At, B0); PG8_BAR; PG8_SCHED;
            PG8_LDB(B1, 1, 1); PG8_STAGE(PG8_SB(1, 0), b3, voffB);
            PG8_BAR; PG8_WAIT_L(0); PG8_MMA(0, 1, At, B1); PG8_BAR;
            PG8_LDA(At, 1, 1); PG8_STAGE(PG8_SA(1, 0), a3, voffA);
            PG8_BAR; PG8_WAIT_L(0); PG8_MMA(1, 0, At, B0); PG8_BAR; PG8_SCHED;
            PG8_STAGE(PG8_SB(1, 1), b3 + hstepB, voffB);
            PG8_WAIT_V(6); PG8_BAR; PG8_MMA(1, 1, At, B1); PG8_BAR;
            }
        }
        if constexpr (ALIGN_EPI) { if (wr == 0) PG8_BAR; }
        if constexpr (!Epi::AFTER_DRAIN) { E(acc, cur, wr, wc, fr, fq); S.done(cur); }
        if (!has_next) break;
#pragma unroll
        for (int a = 0; a < 2; ++a)
#pragma unroll
            for (int b = 0; b < 2; ++b)
#pragma unroll
                for (int m = 0; m < 4; ++m)
#pragma unroll
                    for (int n = 0; n < 2; ++n) acc[a][b][m][n] = (f32x4){0.f, 0.f, 0.f, 0.f};
        cur = nxt; cA = nA; cB = nB; ++ui;
        if constexpr (ALIGN_EPI) { if (wr == 1) PG8_BAR; }
    }
    PG8_WAIT_V(0);
    if constexpr (!ALIGN_EPI) { if (wr == 0) PG8_BAR; }
    PG8_BAR;
    if constexpr (Epi::AFTER_DRAIN) { E.fused(acc, cur, wr, wc, fr, fq, lds, wid, lane); S.done(cur); }
#undef PG8_SA
#undef PG8_SB
#undef PG8_STAGE
#undef PG8_LDA
#undef PG8_LDB
#undef PG8_MMA
#undef PG8_WAIT_V
#undef PG8_WAIT_L
#undef PG8_BAR
#undef PG8_SCHED
}
}

constexpr int NWAVES = 8;
constexpr int D = 2048, NBATCH = 4, SEQ = 4096, DEPTH = 4, CTXL = 256;
constexpr int MLAT = NBATCH * SEQ, MCTX = NBATCH * CTXL, MTOT = MLAT + MCTX;
constexpr int INW = 12288, BW = 1024, FFH = 5632, NHEAD = 8;
constexpr int Q_OFF = 0, K_OFF = 1024, V_OFF = 2048, BU_OFF = 3072, C_OFF = 5120, G_OFF = 6144;
constexpr int YW = 3 * BW;
constexpr float LN_EPS = 1e-6f;
constexpr float ALPHA = 1.681792830507429f;
constexpr float QSCALE = 0.125f * 1.4426950408889634f;

constexpr size_t MiB = 1u << 20;
constexpr size_t WS_CTL = 0, CTL_ZERO_BYTES = 1 * MiB;
constexpr size_t WS_ROPE = 1 * MiB;
constexpr size_t WS_MODS = 2 * MiB;
constexpr size_t WS_MODP = 4 * MiB;
constexpr size_t WS_WSP = 20 * MiB;
constexpr size_t WS_WPOOL = 21 * MiB;
constexpr size_t WS_WIN = 24 * MiB;
constexpr size_t WS_WBR = 216 * MiB;
constexpr size_t WS_WOUT = 264 * MiB;
constexpr size_t WS_WGU = 296 * MiB;
constexpr size_t WS_WDN = 472 * MiB;
constexpr size_t WS_X = 560 * MiB;
constexpr size_t WS_HA = 696 * MiB;
constexpr size_t WS_Y = 764 * MiB;
constexpr size_t WS_MG = 866 * MiB;
constexpr size_t WS_Z = 934 * MiB;
constexpr size_t WS_KB = 1342 * MiB, WS_VB = 1378 * MiB;
constexpr size_t WS_END = 1414 * MiB;
static_assert(WS_MODP + 16ull * 4 * 5 * 12288 * 4 <= WS_WSP && WS_WIN + 4ull * 12288 * 2048 * 2 <= WS_WBR && WS_WBR + 4ull * 2048 * 3072 * 2 <= WS_WOUT && WS_WOUT + 4ull * 2048 * 2048 * 2 <= WS_WGU, "ws map 1");
static_assert(WS_WGU + 4ull * 11264 * 2048 * 2 <= WS_WDN && WS_WDN + 4ull * 2048 * 5632 * 2 <= WS_X && WS_X + (size_t)MTOT * D * 4 <= WS_HA && WS_HA + (size_t)MTOT * D * 2 <= WS_Y, "ws map 2");
static_assert(WS_Y + (size_t)MTOT * YW * 2 <= WS_MG && WS_MG + (size_t)MTOT * D * 2 <= WS_Z && WS_Z + (size_t)MTOT * INW * 2 <= WS_KB && WS_KB + 32ull * 4352 * 256 <= WS_VB && WS_VB + 32ull * 4352 * 256 <= WS_END, "ws map 3");
constexpr int CW_BAR = 4096;

constexpr int RING_OFF = 0, RING_BYTES = 131072;
constexpr int LDSCTL_OFF = RING_BYTES, MISC_OFF = LDSCTL_OFF + 320;
constexpr int LDS_BYTES = 147456;

#define GAS __attribute__((address_space(1)))
#define LAS __attribute__((address_space(3)))
typedef unsigned short bf16;
typedef unsigned v4u __attribute__((ext_vector_type(4)));
typedef unsigned v2u __attribute__((ext_vector_type(2)));
typedef float f32x4 __attribute__((ext_vector_type(4)));
typedef float f32x16 __attribute__((ext_vector_type(16)));
typedef short bf16x8 __attribute__((ext_vector_type(8)));
typedef short s16x4 __attribute__((ext_vector_type(4)));
typedef GAS unsigned gu32;
#define RLX_AGENT __ATOMIC_RELAXED, __HIP_MEMORY_SCOPE_AGENT
#define LDS_WAIT() asm volatile("s_waitcnt lgkmcnt(0)" ::: "memory")
#define VM_WAIT() asm volatile("s_waitcnt vmcnt(0)" ::: "memory")
__device__ __forceinline__ unsigned f2bf(float f) { unsigned u = __builtin_bit_cast(unsigned, f); return (u + 0x7fffu + ((u >> 16) & 1u)) >> 16; }
__device__ __forceinline__ unsigned pk2(float lo, float hi) { return f2bf(lo) | (f2bf(hi) << 16); }
__device__ __forceinline__ unsigned cvtpk(float lo, float hi) { unsigned r; asm volatile("v_cvt_pk_bf16_f32 %0, %1, %2" : "=v"(r) : "v"(lo), "v"(hi)); return r; }
__device__ __forceinline__ float bflo(unsigned w) { return __uint_as_float(w << 16); }
__device__ __forceinline__ float bfhi(unsigned w) { return __uint_as_float(w & 0xffff0000u); }

#define XB_TMO      128
#define XB_XCNT(j)  (256  + 64 * (j))
#define XB_XSUB(j)  (1280 + 64 * (j))
#define XB_XGEN(j)  (2304 + 64 * (j))
#define XB_TOP      3328
#define XB_TOPGEN   3392
#define XCD_BAR_WORDS 3456
#define XB_SPIN_CAP (1u << 18)

__device__ __forceinline__ unsigned xb_ld(unsigned* p)              { return __hip_atomic_load(p, __ATOMIC_RELAXED, __HIP_MEMORY_SCOPE_AGENT); }
__device__ __forceinline__ unsigned xb_add(unsigned* p, unsigned v) { return __hip_atomic_fetch_add(p, v, __ATOMIC_RELAXED, __HIP_MEMORY_SCOPE_AGENT); }
__device__ __forceinline__ unsigned xb_xcc_id() { return (unsigned)__builtin_amdgcn_s_getreg((3 << 11) | 20) & 0xFu; }
#define XB_SPIN(cond, bar) do { unsigned _sp = 0; while (cond) { __builtin_amdgcn_s_sleep(1); \
    if ((++_sp & 255u) == 0u) { if (xb_ld(&(bar)[XB_TMO])) break; if (_sp > XB_SPIN_CAP) { atomicAdd(&(bar)[XB_TMO], 1u); break; } } } } while (0)

struct XcdBarrier {
    unsigned* bar; unsigned x;
    volatile LAS unsigned* st;
};

__device__ __forceinline__ XcdBarrier xcd_barrier_post(unsigned* bar, volatile LAS unsigned* st) {
    XcdBarrier b; b.bar = bar; b.x = xb_xcc_id(); b.st = st;
    if (threadIdx.x == 0) (void)xb_add(&bar[XB_XCNT(b.x)], 1u);
    return b;
}
__device__ __forceinline__ void xcd_barrier_complete(unsigned* bar, unsigned x, unsigned& nloc, unsigned& nx) {
    const unsigned G = gridDim.x * gridDim.y * gridDim.z;
    unsigned sum, cnt, mine, sp = 0u;
    for (;;) {
        sum = 0u; cnt = 0u; mine = 0u;
#pragma unroll
        for (unsigned j = 0; j < 16; ++j) { const unsigned c = xb_ld(&bar[XB_XCNT(j)]); sum += c; cnt += (c > 0u) ? 1u : 0u; mine = (j == x) ? c : mine; }
        if (sum == G) break;
        __builtin_amdgcn_s_sleep(1);
        if ((++sp & 255u) == 0u) { if (xb_ld(&bar[XB_TMO])) break; if (sp > XB_SPIN_CAP) { atomicAdd(&bar[XB_TMO], 1u); break; } }
    }
    nloc = mine > 0u ? mine : 1u; nx = cnt > 0u ? cnt : 1u;
}

__device__ __forceinline__ void xcd_barrier(const XcdBarrier& b) {
    asm volatile("s_waitcnt vmcnt(0)" ::: "memory");
    __syncthreads();
    if (threadIdx.x == 0) {
        unsigned* bar = b.bar;
        __builtin_amdgcn_s_waitcnt(0);
        unsigned nloc = b.st[0], nx = b.st[1];
        if (nloc == 0u) { xcd_barrier_complete(bar, b.x, nloc, nx); b.st[0] = nloc; b.st[1] = nx; }
        const unsigned old = xb_add(&bar[XB_XSUB(b.x)], 1u);
        const unsigned gen = old / nloc;
        if (old + 1u == (gen + 1u) * nloc) {
            __builtin_amdgcn_fence(__ATOMIC_RELEASE, "agent");
            asm volatile("s_waitcnt vmcnt(0)" ::: "memory");
            const unsigned og = xb_add(&bar[XB_TOP], 1u);
            const unsigned tg = og / nx;
            if (og + 1u == (tg + 1u) * nx) xb_add(&bar[XB_TOPGEN], 1u);
            else XB_SPIN(xb_ld(&bar[XB_TOPGEN]) == tg, bar);
            __builtin_amdgcn_fence(__ATOMIC_ACQUIRE, "agent");
            xb_add(&bar[XB_XGEN(b.x)], 1u);
            asm volatile("s_waitcnt vmcnt(0)" ::: "memory");
        } else {
            XB_SPIN(xb_ld(&bar[XB_XGEN(b.x)]) == gen, bar);
            __builtin_amdgcn_fence(__ATOMIC_ACQUIRE, "agent");
            asm volatile("s_waitcnt vmcnt(0)" ::: "memory");
        }
    }
    __syncthreads();
}


struct Frame {
    LAS unsigned char* lds;
    volatile LAS unsigned* MISC;
    gu32* ctl;
    int vcu, G, bx;
    __device__ __forceinline__ int ltid() const { int t = threadIdx.x; asm volatile("" : "+v"(t)); return t; }
    const float *x, *c, *ctx, *cctx, *w_ada, *b_ada, *w_in, *lam_qk, *subln_g, *gln_g, *gln_b, *w_sp, *b_sp, *w_pool, *pool_scale, *w_branch, *w_out, *ln1_g, *ln1_b, *w_gu, *w_down, *ln2_g, *ln2_b;
    float* out;
    float *rope, *mods, *modp, *X;
    bf16 *Wsp, *Wpool, *Win, *Wbr, *Wout, *Wgu, *Wdn, *HA, *Y, *MG, *Z, *KB, *VB;
};

typedef __attribute__((address_space(4))) const unsigned char* kptr_t;
__device__ __forceinline__ void frame_ptrs(Frame& F) {
    kptr_t kp = (kptr_t)__builtin_amdgcn_kernarg_segment_ptr(); asm volatile("" : "+s"(kp));
#define KIN(i) (*(const float* const __attribute__((address_space(4)))*)(kp + 8 * (i)))
    F.x = KIN(0); F.c = KIN(1); F.ctx = KIN(2); F.cctx = KIN(3); F.w_ada = KIN(4); F.b_ada = KIN(5); F.w_in = KIN(6); F.lam_qk = KIN(7); F.subln_g = KIN(8);
    F.gln_g = KIN(9); F.gln_b = KIN(10); F.w_sp = KIN(11); F.b_sp = KIN(12); F.w_pool = KIN(13); F.pool_scale = KIN(14); F.w_branch = KIN(15); F.w_out = KIN(16);
    F.ln1_g = KIN(17); F.ln1_b = KIN(18); F.w_gu = KIN(19); F.w_down = KIN(20); F.ln2_g = KIN(21); F.ln2_b = KIN(22);
#undef KIN
    F.out = *(float* const __attribute__((address_space(4)))*)(kp + 184);
    unsigned char* ws = *(unsigned char* const __attribute__((address_space(4)))*)(kp + 192);
    F.rope = (float*)(ws + WS_ROPE); F.mods = (float*)(ws + WS_MODS); F.modp = (float*)(ws + WS_MODP); F.X = (float*)(ws + WS_X);
    F.Wsp = (bf16*)(ws + WS_WSP); F.Wpool = (bf16*)(ws + WS_WPOOL); F.Win = (bf16*)(ws + WS_WIN); F.Wbr = (bf16*)(ws + WS_WBR); F.Wout = (bf16*)(ws + WS_WOUT); F.Wgu = (bf16*)(ws + WS_WGU); F.Wdn = (bf16*)(ws + WS_WDN);
    F.HA = (bf16*)(ws + WS_HA); F.Y = (bf16*)(ws + WS_Y); F.MG = (bf16*)(ws + WS_MG); F.Z = (bf16*)(ws + WS_Z); F.KB = (bf16*)(ws + WS_KB); F.VB = (bf16*)(ws + WS_VB);
}
__device__ __forceinline__ float wave_sum(float v) {
    v += __builtin_bit_cast(float, __builtin_amdgcn_update_dpp(0, __builtin_bit_cast(int, v), 0xB1, 0xF, 0xF, true));
    v += __builtin_bit_cast(float, __builtin_amdgcn_update_dpp(0, __builtin_bit_cast(int, v), 0x4E, 0xF, 0xF, true));
    v += __builtin_bit_cast(float, __builtin_amdgcn_update_dpp(0, __builtin_bit_cast(int, v), 0x141, 0xF, 0xF, true));
    v += __builtin_bit_cast(float, __builtin_amdgcn_update_dpp(0, __builtin_bit_cast(int, v), 0x140, 0xF, 0xF, true));
    v += __shfl_xor(v, 16);
    { auto rr = __builtin_amdgcn_permlane32_swap(__float_as_uint(v), __float_as_uint(v), false, false); v = __uint_as_float(rr[0]) + __uint_as_float(rr[1]); }
    return v;
}

__device__ __forceinline__ void cvt_item(const float* W, int N, int k0, int ncol0, bool perm, bf16* WT, size_t drow0, int ldk, int dk0, LAS float* scr, int lane) {
#pragma unroll 8
    for (int i = 0; i < 32; ++i) { const int kk = 2 * i + (lane >> 5); scr[kk * 33 + (lane & 31)] = __builtin_nontemporal_load(W + (size_t)(k0 + kk) * N + ncol0 + (lane & 31)); }
    LDS_WAIT(); asm volatile("" ::: "memory");
    const int c = lane & 7;
#pragma unroll
    for (int j = 0; j < 4; ++j) { const int n = (lane >> 3) + 8 * j; const int ns = perm ? ((n & 1) * 16 + (n >> 1)) : n; const LAS float* s = scr + (8 * c) * 33 + ns;
        v4u o; o.x = pk2(s[0 * 33], s[1 * 33]); o.y = pk2(s[2 * 33], s[3 * 33]); o.z = pk2(s[4 * 33], s[5 * 33]); o.w = pk2(s[6 * 33], s[7 * 33]);
        *(GAS v4u*)(WT + (drow0 + n) * (size_t)ldk + dk0 + k0 + 8 * c) = o; }
    LDS_WAIT(); asm volatile("" ::: "memory");
}
constexpr int CV_IN = 32 * 384, CV_GU = 32 * 352, CV_DN = 88 * 64, CV_BR = 3 * 16 * 64, CV_OUT = 32 * 64, CV_POOL = 4 * 4 * 8, CV_LAYER = CV_IN + CV_GU + CV_DN + CV_BR + CV_OUT + CV_POOL;
__device__ __forceinline__ void cvt_dispatch(Frame& F, int it, LAS float* scr) {
    const int l = it / CV_LAYER; int r = it - l * CV_LAYER;
    if (r < CV_IN) { const int kb = r / 384, nb = r - kb * 384;
        cvt_item(F.w_in + (size_t)l * D * INW, INW, 64 * kb, 32 * nb, nb < 64, F.Win + (size_t)l * INW * D, (size_t)32 * nb, D, 0, scr, (F.ltid() & 63)); return; }
    r -= CV_IN;
    if (r < CV_GU) { const int kb = r / 352, nb = r - kb * 352; const int tpn = nb >> 3, half = (nb >> 2) & 1, jj0 = (nb & 3) * 32;
        cvt_item(F.w_gu + (size_t)l * D * 2 * FFH, 2 * FFH, 64 * kb, half * FFH + 128 * tpn + jj0, false, F.Wgu + (size_t)l * 2 * FFH * D, (size_t)32 * nb, D, 0, scr, (F.ltid() & 63)); return; }
    r -= CV_GU;
    if (r < CV_DN) { const int kb = r >> 6, nb = r & 63;
        cvt_item(F.w_down + (size_t)l * FFH * D, D, 64 * kb, 32 * nb, false, F.Wdn + (size_t)l * D * FFH, (size_t)32 * nb, FFH, 0, scr, (F.ltid() & 63)); return; }
    r -= CV_DN;
    if (r < CV_BR) { const int n = r >> 10, rr = r & 1023, kb = rr >> 6, nb = rr & 63;
        cvt_item(F.w_branch + ((size_t)l * 3 + n) * BW * D, D, 64 * kb, 32 * nb, false, F.Wbr + (size_t)l * D * YW, (size_t)32 * nb, YW, BW * n, scr, (F.ltid() & 63)); return; }
    r -= CV_BR;
    if (r < CV_OUT) { const int kb = r >> 6, nb = r & 63;
        cvt_item(F.w_out + (size_t)l * D * D, D, 64 * kb, 32 * nb, false, F.Wout + (size_t)l * D * D, (size_t)32 * nb, D, 0, scr, (F.ltid() & 63)); return; }
    r -= CV_OUT;
    { const int g = r >> 5, rr = r & 31, kb = rr >> 3, nb = rr & 7;
        cvt_item(F.w_pool + ((size_t)l * 4 + g) * 65536, 256, 64 * kb, 32 * nb, false, F.Wpool + ((size_t)l * 4 + g) * 65536, (size_t)32 * nb, 256, 0, scr, (F.ltid() & 63)); }
}

__device__ __forceinline__ double rope_inv(int p) {
    const double t[16] = {1.0, 0.5623413251903491, 0.31622776601683794, 0.1778279410038923, 0.1, 0.05623413251903491, 0.03162277660168379, 0.01778279410038923,
                          0.01, 0.005623413251903491, 0.003162277660168379, 0.001778279410038923, 0.001, 0.0005623413251903491, 0.00031622776601683794, 0.0001778279410038923};
    double r = t[0];
#pragma unroll
    for (int i = 1; i < 16; ++i) r = (p == i) ? t[i] : r;
    return r;
}
#ifndef TAILWORK
#define TAILWORK 0
#endif
__device__ __forceinline__ void ada_partial_layer(Frame& F, int l, int gw, int NGW) {
    LAS float* scs = (LAS float*)(F.lds);
    __syncthreads();
    for (int i = F.ltid(); i < 5 * D; i += NWAVES * 64) { const int g = i >> 11, k = i & 2047; const float v = g < 4 ? F.c[g * D + k] : F.cctx[k]; scs[i] = v / (1.0f + __expf(-v)); }
    __syncthreads();
    for (int it = gw; it < 16 * 48; it += NGW) {
        const int ks = it / 48, cgw = it - ks * 48; const int col = cgw * 256 + (F.ltid() & 63) * 4;
        const float* wp = F.w_ada + ((size_t)l * D + ks * 128) * INW + col;
        f32x4 a0 = {0.f, 0.f, 0.f, 0.f}, a1 = a0, a2 = a0, a3 = a0, a4 = a0;
#pragma unroll 8
        for (int k = 0; k < 128; ++k) { const f32x4 w = __builtin_nontemporal_load((const GAS f32x4*)(wp + (size_t)k * INW)); const int kk = ks * 128 + k;
            a0 += w * scs[kk]; a1 += w * scs[D + kk]; a2 += w * scs[2 * D + kk]; a3 += w * scs[3 * D + kk]; a4 += w * scs[4 * D + kk]; }
        float* pp = F.modp + (((size_t)ks * 4 + l) * 5) * INW + col;
        *(f32x4*)(pp) = a0; *(f32x4*)(pp + INW) = a1; *(f32x4*)(pp + 2 * INW) = a2; *(f32x4*)(pp + 3 * INW) = a3; *(f32x4*)(pp + 4 * INW) = a4;
    }
    __syncthreads();
}
__device__ __forceinline__ void cvt_layer(Frame& F, int l, int gw, int NGW) {
    LAS float* scr = (LAS float*)(F.lds + __builtin_amdgcn_readfirstlane(F.ltid() >> 6) * 16384);
    for (int it = gw; it < CV_LAYER; it += NGW) cvt_dispatch(F, l * CV_LAYER + it, scr);
}
__device__ __forceinline__ void mods_reduce_layer(Frame& F, int l) {
    const int gt = F.vcu * NWAVES * 64 + F.ltid(), NGT = F.G * NWAVES * 64;
    for (int i = gt; i < 5 * (INW / 4); i += NGT) { const int g = i / (INW / 4), j = (i - g * (INW / 4)) * 4;
        f32x4 sm = *(const f32x4*)(F.b_ada + (size_t)l * INW + j);
#pragma unroll
        for (int ks = 0; ks < 16; ++ks) sm += *(const f32x4*)(F.modp + (((size_t)ks * 4 + l) * 5 + g) * INW + j);
        *(f32x4*)(F.mods + ((size_t)l * 5 + g) * INW + j) = sm; }
}
__device__ __forceinline__ void phase_a1(Frame& F) {
    const int gw = F.vcu * NWAVES + __builtin_amdgcn_readfirstlane(F.ltid() >> 6), NGW = F.G * NWAVES;
#pragma nounroll
    for (int l = 0; l < (TAILWORK ? 1 : DEPTH); ++l) ada_partial_layer(F, l, gw, NGW);
#pragma nounroll
    for (int l = 0; l < (TAILWORK ? 1 : DEPTH); ++l) cvt_layer(F, l, gw, NGW);
    for (int it = gw; it < (DEPTH * 8 * 128 * 128) / 512; it += NGW) { const size_t e = (size_t)it * 512 + (F.ltid() & 63) * 8;
        const f32x4 a = *(const f32x4*)(F.w_sp + e), b = *(const f32x4*)(F.w_sp + e + 4);
        v4u o; o.x = pk2(a[0], a[1]); o.y = pk2(a[2], a[3]); o.z = pk2(b[0], b[1]); o.w = pk2(b[2], b[3]); *(v4u*)(F.Wsp + e) = o; }
    if (gw == 0) {
        for (int e = (F.ltid() & 63); e < 1024; e += 64) { const int pos = e >> 4, pr = e & 15;
            const double ang = (double)pos * rope_inv(pr); const double twopi = 6.283185307179586476925286766559;
            const double kq = __builtin_rint(ang / twopi); const double rr = ang - kq * twopi; const double r2 = rr * rr;
            double sn = 1.0, cs = 1.0;
#pragma unroll
            for (int n = 14; n >= 1; --n) { sn = 1.0 - sn * r2 / (double)((2 * n) * (2 * n + 1)); cs = 1.0 - cs * r2 / (double)((2 * n - 1) * (2 * n)); }
            sn *= rr;
            F.rope[2 * e] = (float)cs; F.rope[2 * e + 1] = (float)sn; }
    }
}
__device__ __forceinline__ void phase_a2(Frame& F) {
#pragma nounroll
    for (int l = 0; l < (TAILWORK ? 1 : DEPTH); ++l) mods_reduce_layer(F, l); }
__device__ __forceinline__ void ln_row(const float* src, const bf16* tadd, const float* part, int npart, const float* gam, const float* bet, float* xo, float xs, bf16* ho, const float* sc, const float* sh, int lane) {
    f32x4 v[8]; float s = 0.f;
#pragma unroll
    for (int j = 0; j < 8; ++j) v[j] = __builtin_nontemporal_load((const GAS f32x4*)(src + 4 * lane + 256 * j));
    if (tadd) {
#pragma unroll
        for (int j = 0; j < 8; ++j) { const v2u t2 = *(const GAS v2u*)(tadd + 4 * lane + 256 * j); v[j] += (f32x4){bflo(t2.x), bfhi(t2.x), bflo(t2.y), bfhi(t2.y)}; } }
    for (int p = 0; p < npart; ++p) {
#pragma unroll
        for (int j = 0; j < 8; ++j) v[j] += __builtin_nontemporal_load((const GAS f32x4*)(part + (size_t)p * 1024 * D + 4 * lane + 256 * j)); }
#pragma unroll
    for (int j = 0; j < 8; ++j) s += (v[j][0] + v[j][1]) + (v[j][2] + v[j][3]);
    const float mean = wave_sum(s) * (1.f / D); float s2 = 0.f;
#pragma unroll
    for (int j = 0; j < 8; ++j) { v[j] = v[j] - mean; s2 += (v[j][0] * v[j][0] + v[j][1] * v[j][1]) + (v[j][2] * v[j][2] + v[j][3] * v[j][3]); }
    const float rstd = 1.0f / sqrtf(wave_sum(s2) * (1.f / D) + LN_EPS);
#pragma unroll
    for (int j = 0; j < 8; ++j) { const int col = 4 * lane + 256 * j; f32x4 xn = v[j] * rstd;
        if (gam) xn = xn * *(const f32x4*)(gam + col) + *(const f32x4*)(bet + col);
        if (xo) __builtin_nontemporal_store(xn * xs, (GAS f32x4*)(xo + col));
        if (ho) { const f32x4 hv = xn * (1.0f + *(const f32x4*)(sc + col)) + *(const f32x4*)(sh + col); v2u o; o.x = pk2(hv[0], hv[1]); o.y = pk2(hv[2], hv[3]); __builtin_nontemporal_store(o, (GAS v2u*)(ho + col)); } }
}
__device__ __forceinline__ int row_group(int row) { return row < MLAT ? (row >> 12) : 4; }
__device__ __forceinline__ void phase_a3(Frame& F) {
    const int gw = F.vcu * NWAVES + __builtin_amdgcn_readfirstlane(F.ltid() >> 6), NGW = F.G * NWAVES;
    for (int row = gw; row < MTOT; row += NGW) { const float* src = row < MLAT ? F.x + (size_t)row * D : F.ctx + (size_t)(row - MLAT) * D; const float* md = F.mods + (size_t)row_group(row) * INW;
        ln_row(src, nullptr, nullptr, 0, nullptr, nullptr, F.X + (size_t)row * D, ALPHA, F.HA + (size_t)row * D, md + D, md, (F.ltid() & 63)); }
}
#ifndef LN_NT
#define LN_NT 1
#endif
#if LN_NT
#define LN_LD(p) __builtin_nontemporal_load(p)
#define LN_ST(p, v) __builtin_nontemporal_store((v), (p))
#else
#define LN_LD(p) (*(p))
#define LN_ST(p, v) (*(p) = (v))
#endif
__device__ __forceinline__ void ln_finish(f32x4 (&v)[8], const float* gam, const float* bet, float* xo, float xs, bf16* ho, const float* sc, const float* sh, int lane) {
    float s = 0.f;
#pragma unroll
    for (int j = 0; j < 8; ++j) s += (v[j][0] + v[j][1]) + (v[j][2] + v[j][3]);
    const float mean = wave_sum(s) * (1.f / D); float s2 = 0.f;
#pragma unroll
    for (int j = 0; j < 8; ++j) { v[j] = v[j] - mean; s2 += (v[j][0] * v[j][0] + v[j][1] * v[j][1]) + (v[j][2] * v[j][2] + v[j][3] * v[j][3]); }
    const float rstd = 1.0f / sqrtf(wave_sum(s2) * (1.f / D) + LN_EPS);
#pragma unroll
    for (int j = 0; j < 8; ++j) { const int col = 4 * lane + 256 * j; f32x4 xn = v[j] * rstd;
        xn = xn * *(const f32x4*)(gam + col) + *(const f32x4*)(bet + col);
        if (xo) LN_ST((GAS f32x4*)(xo + col), xn * xs);
        if (ho) { const f32x4 hv = xn * (1.0f + *(const f32x4*)(sc + col)) + *(const f32x4*)(sh + col); v2u o; o.x = pk2(hv[0], hv[1]); o.y = pk2(hv[2], hv[3]); LN_ST((GAS v2u*)(ho + col), o); } }
}
__device__ __forceinline__ void phase_ln(Frame& F, const float* gam, const float* bet, int nrows, bool to_out, bool want_h, int lm, int moff, int nsplit, bool dry = false) {
    const int gw = F.vcu * NWAVES + __builtin_amdgcn_readfirstlane(F.ltid() >> 6), NGW = F.G * NWAVES; const int lane = F.ltid() & 63;
    f32x4 xa[8]; v2u ta[8];
    int row = gw;
    if (row < MLAT) {
#pragma unroll
        for (int j = 0; j < 8; ++j) { xa[j] = LN_LD((const GAS f32x4*)(F.X + (size_t)row * D + 4 * lane + 256 * j)); ta[j] = LN_LD((const GAS v2u*)(F.Y + (size_t)row * D + 4 * lane + 256 * j)); } }
    for (; row < MLAT; row += NGW) {
        f32x4 v[8];
#pragma unroll
        for (int j = 0; j < 8; ++j) v[j] = xa[j] + (f32x4){bflo(ta[j].x), bfhi(ta[j].x), bflo(ta[j].y), bfhi(ta[j].y)};
        const int nx = row + NGW;
        if (nx < MLAT) {
#pragma unroll
            for (int j = 0; j < 8; ++j) { xa[j] = LN_LD((const GAS f32x4*)(F.X + (size_t)nx * D + 4 * lane + 256 * j)); ta[j] = LN_LD((const GAS v2u*)(F.Y + (size_t)nx * D + 4 * lane + 256 * j)); } }
        const float* md = F.mods + ((size_t)lm * 5 + (row >> 12)) * INW + moff;
        ln_finish(v, gam, bet, dry ? (float*)(F.Z + (size_t)134 * MiB) + (size_t)row * D : (to_out ? F.out + (size_t)row * D : F.X + (size_t)row * D), to_out ? 1.0f : ALPHA, want_h ? (dry ? F.MG : F.HA) + (size_t)row * D : nullptr, md + D, md, lane);
    }
    for (; row < nrows; row += NGW) { const float* md = F.mods + ((size_t)lm * 5 + 4) * INW + moff;
        ln_row(F.X + (size_t)row * D, nullptr, (const float*)(F.Z + (size_t)100 * MiB) + (size_t)(row - MLAT) * D, nsplit, gam, bet, dry ? (float*)(F.Z + (size_t)134 * MiB) + (size_t)row * D : (to_out ? F.out + (size_t)row * D : F.X + (size_t)row * D), to_out ? 1.0f : ALPHA, want_h ? (dry ? F.MG : F.HA) + (size_t)row * D : nullptr, md + D, md, lane); }
}

constexpr int AT_KB = 0, AT_VB = 32768, AT_TILE = 16384, AT_XB = 65536;
__device__ __forceinline__ s16x4 vtr(const LAS unsigned char* p) { typedef short v4i16_t __attribute__((ext_vector_type(4))); return __builtin_bit_cast(s16x4, __builtin_amdgcn_ds_read_tr16_b64_v4i16((LAS v4i16_t*)p)); }
__device__ __forceinline__ float max3f(float a, float b, float c) { float r; asm("v_max3_f32 %0, %1, %2, %3" : "=v"(r) : "v"(a), "v"(b), "v"(c)); return r; }
__device__ __forceinline__ float max2f(float a, float b) { float r; asm("v_max_f32_e32 %0, %1, %2" : "=v"(r) : "v"(a), "v"(b)); return r; }
__device__ __forceinline__ void glds16(const void* gsrc, unsigned lds_dst) { unsigned keep;
    asm volatile("s_mov_b32 %0, m0\n\ts_mov_b32 m0, %2\n\ts_nop 0\n\tglobal_load_lds_dwordx4 %1, off\n\ts_mov_b32 m0, %0" : "=&s"(keep) : "v"(gsrc), "s"(lds_dst) : "memory"); }
#ifndef XTRA_EXP
#define XTRA_EXP 0
#endif
#define AT_WAITV(n) asm volatile("s_waitcnt vmcnt(" #n ")" ::: "memory")
#define AT_BAR() asm volatile("s_waitcnt lgkmcnt(0)\n\ts_barrier" ::: "memory")
__device__ __forceinline__ void attn_unit(Frame& F, int b, int h, int qb, bool ctxq, float lam, float oscale, const float* subg) {
    int lane_ = (F.ltid() & 63); asm volatile("" : "+v"(lane_));
    const int lane = lane_, wid = __builtin_amdgcn_readfirstlane(F.ltid() >> 6), r32 = lane & 31, hi = lane >> 5, m = wid >> 2, qg = wid & 3; const bool lead = wid < 4;
    const bf16* Z = F.Z;
    const int qrow = (ctxq ? MLAT + b * CTXL : b * SEQ) + qb * 128 + qg * 32 + r32;
    bf16x8 qf[4];
#pragma unroll
    for (int d0 = 0; d0 < 4; ++d0) qf[d0] = *(const GAS bf16x8*)(Z + (size_t)qrow * INW + Q_OFF + h * 128 + m * 64 + d0 * 16 + hi * 8);
    const int NT = ctxq ? 4 : 68;
    const bf16* Kbh = F.KB + (size_t)(b * 8 + h) * 4352 * 128; const bf16* Vbh = F.VB + (size_t)(b * 8 + h) * 4352 * 128;
    const unsigned lds0 = (unsigned)(size_t)F.lds;
    const int prow = 8 * wid + (lane >> 4), ppos = lane & 15;
    const unsigned koff0 = (unsigned)(prow * 128 + ((ppos ^ (prow & 15)) * 8)), koff1 = (unsigned)((prow + 4) * 128 + ((ppos ^ ((prow + 4) & 15)) * 8));
    const unsigned voff0 = (unsigned)(prow * 128 + ((ppos ^ (4 * (prow & 3))) * 8)), voff1 = voff0 + 4 * 128;
    const unsigned kdst = (unsigned)__builtin_amdgcn_readfirstlane((int)(lds0 + AT_KB + wid * 2048)), vdst = (unsigned)__builtin_amdgcn_readfirstlane((int)(lds0 + AT_VB + wid * 2048));
#define AT_DMAK(t, bufo) do { const bf16* tb_ = Kbh + (size_t)(t) * 8192; glds16(tb_ + koff0, kdst + (bufo)); glds16(tb_ + koff1, kdst + (bufo) + 1024); } while (0)
#define AT_DMAV(t, bufo) do { const bf16* tb_ = Vbh + (size_t)(t) * 8192; glds16(tb_ + voff0, vdst + (bufo)); glds16(tb_ + voff1, vdst + (bufo) + 1024); } while (0)
    f32x16 o[4];
#pragma unroll
    for (int db = 0; db < 4; ++db)
#pragma unroll
        for (int r = 0; r < 16; ++r) o[db][r] = 0.f;
    float mref = 0.f, lsum = 0.f;
    f32x16 negm;
#pragma unroll
    for (int r = 0; r < 16; ++r) negm[r] = 0.f;
    const unsigned kaddr0 = AT_KB + r32 * 256 + (((8 * m + hi) ^ (r32 & 15)) << 4);
    const int a4 = (lane & 15) >> 2, cc = 2 * ((lane >> 4) & 1) + ((lane & 3) >> 1);
    const unsigned vaddr0 = AT_VB + (4 * hi + a4) * 256 + ((4 * a4 + cc) << 4) + 8 * (lane & 1);
    __syncthreads();
#define AT_SB() __builtin_amdgcn_sched_barrier(0)
#define AT_PIN(x) asm volatile("" : "+v"(x))
#define AT_KFRAG(i) (*(const LAS bf16x8*)(F.lds + (kb_ ^ (unsigned)((2 * ((i) >> 1)) << 4)) + ((i) & 1) * 8192))
#define AT_VFRAG(lo, hh, ks, db) do { const unsigned va_ = (vb_ ^ (unsigned)((db) << 6)) + (16 * (ks)) * 256; lo = vtr(F.lds + va_); hh = vtr(F.lds + va_ + 8 * 256); } while (0)
#define AT_VF(lo, hh) ((bf16x8){lo[0], lo[1], lo[2], lo[3], hh[0], hh[1], hh[2], hh[3]})
#define AT_MAXDEC(C0, C1, FIRST) do { \
        float tmax = max3f(C0[0], C0[1], C0[2]), tmb_ = max3f(C1[0], C1[1], C1[2]); \
        _Pragma("unroll") for (int r = 3; r < 15; r += 2) tmax = max3f(tmax, C0[r], C0[r + 1]); \
        _Pragma("unroll") for (int r = 3; r < 15; r += 2) tmb_ = max3f(tmb_, C1[r], C1[r + 1]); \
        tmax = max3f(tmax, C0[15], C1[15]); tmax = max2f(tmax, tmb_); { auto rr_ = __builtin_amdgcn_permlane32_swap(__float_as_uint(tmax), __float_as_uint(tmax), false, false); tmax = max2f(__uint_as_float(rr_[0]), __uint_as_float(rr_[1])); } \
        resc = false; \
        if (FIRST) { mref = tmax; \
            _Pragma("unroll") for (int r = 0; r < 16; ++r) { C0[r] -= tmax; C1[r] -= tmax; negm[r] = -mref; } \
        } else if (__any(tmax > 8.0f)) { \
            const float dl = __builtin_fmaxf(tmax, 0.f); mref += dl; alr = __builtin_amdgcn_exp2f(-dl); lsum *= alr; resc = true; \
            _Pragma("unroll") for (int r = 0; r < 16; ++r) { C0[r] -= dl; C1[r] -= dl; negm[r] = -mref; } \
        } } while (0)
#define AT_GAPA(i, CD, CS, PP, PB, PW, PWI) do { \
        AT_VFRAG(vlo[i], vhi[i], (i) >> 2, (i) & 3); \
        CD = __builtin_amdgcn_mfma_f32_32x32x16_bf16(((i) & 1) ? kfb : kfa, qf[(i) >> 1], CS, 0, 0, 0); \
        if ((i) + 2 < 8) { if ((i) & 1) kfb = AT_KFRAG((i) + 2); else kfa = AT_KFRAG((i) + 2); } \
        sacc += PP[PB]; sacc += PP[PB + 1]; sacc += PP[PB + 2]; sacc += PP[PB + 3]; AT_PIN(sacc); \
        PW[PWI] = cvtpk(PP[PB], PP[PB + 1]); PW[PWI + 1] = cvtpk(PP[PB + 2], PP[PB + 3]); AT_PIN(PW); AT_SB(); } while (0)
#define AT_GAPB(j, VL, VH, PW, CC, CB) do { \
        if ((j) < 8) AT_VFRAG(wlo[j], whi[j], 2 + ((j) >> 2), (j) & 3); \
        o[(j) & 3] = __builtin_amdgcn_mfma_f32_32x32x16_bf16(AT_VF(VL, VH), __builtin_bit_cast(bf16x8, PW), o[(j) & 3], 0, 0, 0); \
        CC[CB] = __builtin_amdgcn_exp2f(CC[CB]); CC[CB + 1] = __builtin_amdgcn_exp2f(CC[CB + 1]); AT_PIN(CC); AT_SB(); } while (0)
#define AT_STEP(C0, C1, P0, P1, T) do { \
        const unsigned kbo_ = ((T) & 1) ? AT_TILE : 0, vbo_ = ((T) & 1) ? 0 : AT_TILE; \
        const bf16* tk_ = Kbh + (size_t)((T) + 1) * 8192; const bf16* tv_ = Vbh + (size_t)(T) * 8192; const bool morek_ = (T) + 1 < NT; \
        unsigned kb_ = kaddr0 + kbo_, vb_ = vaddr0 + vbo_; asm volatile("" : "+v"(kb_), "+v"(vb_)); \
        bf16x8 kfa = AT_KFRAG(0), kfb = AT_KFRAG(1); float sacc = 0.f; AT_SB(); \
        AT_GAPA(0, C0, negm, P0, 0, pw0, 0); glds16(tv_ + voff0, vdst + (vbo_ ^ AT_TILE)); AT_SB(); AT_GAPA(1, C1, negm, P0, 4, pw0, 2); glds16(tv_ + voff1, vdst + (vbo_ ^ AT_TILE) + 1024); AT_SB(); \
        AT_GAPA(2, C0, C0, P0, 8, pw1, 0); if (morek_) glds16(tk_ + koff0, kdst + (kbo_ ^ AT_TILE)); AT_SB(); AT_GAPA(3, C1, C1, P0, 12, pw1, 2); if (morek_) glds16(tk_ + koff1, kdst + (kbo_ ^ AT_TILE) + 1024); AT_SB(); \
        AT_GAPA(4, C0, C0, P1, 0, pw2, 0); AT_GAPA(5, C1, C1, P1, 4, pw2, 2); AT_GAPA(6, C0, C0, P1, 8, pw3, 0); AT_GAPA(7, C1, C1, P1, 12, pw3, 2); \
        lsum += sacc; \
        AT_MAXDEC(C0, C1, false); AT_SB(); \
        AT_GAPB(0, vlo[0], vhi[0], pw0, C0, 0); AT_GAPB(1, vlo[1], vhi[1], pw0, C0, 2); AT_GAPB(2, vlo[2], vhi[2], pw0, C0, 4); AT_GAPB(3, vlo[3], vhi[3], pw0, C0, 6); \
        AT_GAPB(4, vlo[4], vhi[4], pw1, C0, 8); AT_GAPB(5, vlo[5], vhi[5], pw1, C0, 10); AT_GAPB(6, vlo[6], vhi[6], pw1, C0, 12); AT_GAPB(7, vlo[7], vhi[7], pw1, C0, 14); \
        AT_GAPB(8, wlo[0], whi[0], pw2, C1, 0); AT_GAPB(9, wlo[1], whi[1], pw2, C1, 2); AT_GAPB(10, wlo[2], whi[2], pw2, C1, 4); AT_GAPB(11, wlo[3], whi[3], pw2, C1, 6); \
        AT_GAPB(12, wlo[4], whi[4], pw3, C1, 8); AT_GAPB(13, wlo[5], whi[5], pw3, C1, 10); AT_GAPB(14, wlo[6], whi[6], pw3, C1, 12); AT_GAPB(15, wlo[7], whi[7], pw3, C1, 14); \
        if (resc) { _Pragma("unroll") for (int db = 0; db < 4; ++db) _Pragma("unroll") for (int r = 0; r < 16; ++r) o[db][r] *= alr; } \
        asm volatile("s_waitcnt vmcnt(0) lgkmcnt(0)\n\ts_barrier" ::: "memory"); } while (0)
    f32x16 pA0, pA1, pB0, pB1; v4u pw0, pw1, pw2, pw3; s16x4 vlo[8], vhi[8], wlo[8], whi[8]; bool resc = false; float alr = 1.f;
#pragma unroll
    for (int r = 0; r < 16; ++r) { pB0[r] = 0.f; pB1[r] = 0.f; }
    pw0 = pw1 = pw2 = pw3 = (v4u){0u, 0u, 0u, 0u};
    AT_DMAK(0, 0);
    asm volatile("s_waitcnt vmcnt(0) lgkmcnt(0)\n\ts_barrier" ::: "memory");
    { if (NT > 1) AT_DMAK(1, AT_TILE);
      AT_DMAV(0, 0);
      unsigned kb_ = kaddr0; asm volatile("" : "+v"(kb_));
      pA0 = __builtin_amdgcn_mfma_f32_32x32x16_bf16(AT_KFRAG(0), qf[0], negm, 0, 0, 0); pA1 = __builtin_amdgcn_mfma_f32_32x32x16_bf16(AT_KFRAG(1), qf[0], negm, 0, 0, 0);
#pragma unroll
      for (int d0 = 1; d0 < 4; ++d0) { pA0 = __builtin_amdgcn_mfma_f32_32x32x16_bf16(AT_KFRAG(2 * d0), qf[d0], pA0, 0, 0, 0); pA1 = __builtin_amdgcn_mfma_f32_32x32x16_bf16(AT_KFRAG(2 * d0 + 1), qf[d0], pA1, 0, 0, 0); }
      AT_MAXDEC(pA0, pA1, true);
#pragma unroll
      for (int r = 0; r < 16; ++r) { pA0[r] = __builtin_amdgcn_exp2f(pA0[r]); pA1[r] = __builtin_amdgcn_exp2f(pA1[r]); }
      asm volatile("s_waitcnt vmcnt(0) lgkmcnt(0)\n\ts_barrier" ::: "memory"); }
    for (int t = 1; t < NT - 1; t += 2) { AT_STEP(pB0, pB1, pA0, pA1, t); AT_STEP(pA0, pA1, pB0, pB1, t + 1); }
    AT_STEP(pB0, pB1, pA0, pA1, NT - 1);
    { float sacc = 0.f;
#pragma unroll
      for (int r = 0; r < 16; ++r) sacc += pB0[r] + pB1[r];
      lsum += sacc;
      pw0 = (v4u){cvtpk(pB0[0], pB0[1]), cvtpk(pB0[2], pB0[3]), cvtpk(pB0[4], pB0[5]), cvtpk(pB0[6], pB0[7])}; pw1 = (v4u){cvtpk(pB0[8], pB0[9]), cvtpk(pB0[10], pB0[11]), cvtpk(pB0[12], pB0[13]), cvtpk(pB0[14], pB0[15])};
      pw2 = (v4u){cvtpk(pB1[0], pB1[1]), cvtpk(pB1[2], pB1[3]), cvtpk(pB1[4], pB1[5]), cvtpk(pB1[6], pB1[7])}; pw3 = (v4u){cvtpk(pB1[8], pB1[9]), cvtpk(pB1[10], pB1[11]), cvtpk(pB1[12], pB1[13]), cvtpk(pB1[14], pB1[15])};
      unsigned vb_ = vaddr0 + (((NT - 1) & 1) ? AT_TILE : 0); asm volatile("" : "+v"(vb_));
#pragma unroll
      for (int j = 0; j < 8; ++j) { AT_VFRAG(vlo[j], vhi[j], j >> 2, j & 3); AT_VFRAG(wlo[j], whi[j], 2 + (j >> 2), j & 3); }
      AT_SB();
#pragma unroll
      for (int j = 0; j < 8; ++j) o[j & 3] = __builtin_amdgcn_mfma_f32_32x32x16_bf16(AT_VF(vlo[j], vhi[j]), __builtin_bit_cast(bf16x8, (j < 4) ? pw0 : pw1), o[j & 3], 0, 0, 0);
#pragma unroll
      for (int j = 0; j < 8; ++j) o[j & 3] = __builtin_amdgcn_mfma_f32_32x32x16_bf16(AT_VF(wlo[j], whi[j]), __builtin_bit_cast(bf16x8, (j < 4) ? pw2 : pw3), o[j & 3], 0, 0, 0);
      asm volatile("s_waitcnt lgkmcnt(0)\n\ts_barrier" ::: "memory"); }
#undef AT_SB
#undef AT_PIN
#undef AT_KFRAG
#undef AT_VFRAG
#undef AT_VF
#undef AT_MAXDEC
#undef AT_GAPA
#undef AT_GAPB
#undef AT_STEP
    const float lt = lsum + __shfl_xor(lsum, 32);
    LAS float* xs = (LAS float*)(F.lds + AT_XB) + qg * 4096 + lane;
    if (!lead) { const float sc1 = lam / lt;
#pragma unroll
        for (int db = 0; db < 4; ++db)
#pragma unroll
            for (int r = 0; r < 16; ++r) xs[(db * 16 + r) * 64] = o[db][r] * sc1; }
    __syncthreads();
    if (lead) {
        const float i0 = 1.0f / lt; float ss = 0.f;
#pragma unroll
        for (int db = 0; db < 4; ++db)
#pragma unroll
            for (int r = 0; r < 16; ++r) { const float v = o[db][r] * i0 - xs[(db * 16 + r) * 64]; o[db][r] = v; ss += v * v; }
        ss += __shfl_xor(ss, 32);
        const float rs = oscale / sqrtf(ss * (1.0f / 128.0f) + LN_EPS);
        bf16* yp = F.Y + (size_t)qrow * YW + h * 128 + 4 * hi;
#pragma unroll
        for (int db = 0; db < 4; ++db)
#pragma unroll
            for (int g4 = 0; g4 < 4; ++g4) { const int d = 32 * db + 8 * g4; const f32x4 gv = *(const f32x4*)(subg + d + 4 * hi);
                v2u w; w.x = cvtpk(o[db][4 * g4 + 0] * rs * gv[0], o[db][4 * g4 + 1] * rs * gv[1]); w.y = cvtpk(o[db][4 * g4 + 2] * rs * gv[2], o[db][4 * g4 + 3] * rs * gv[3]);
                *(GAS v2u*)(yp + d) = w; }
    }
#undef AT_DMAK
#undef AT_DMAV
}

constexpr int GM_ST = 0, GM_VT = 1024, GM_VP = 272;
__device__ __forceinline__ void gmlp_unit(Frame& F, int row0, int l) {
    int tid_ = F.ltid(); asm volatile("" : "+v"(tid_)); const int tid = tid_, lane = tid & 63, wid = __builtin_amdgcn_readfirstlane(F.ltid() >> 6);
    typedef float f32x2v __attribute__((ext_vector_type(2)));
    LAS f32x2v* st = (LAS f32x2v*)(F.lds + GM_ST); LAS unsigned char* vt = F.lds + GM_VT;
    const bf16* Z = F.Z;
    __syncthreads();
#pragma unroll
    for (int hb = 0; hb < 2; ++hb) {
        v4u va[8], vb[8];
#pragma unroll
        for (int i = 0; i < 8; ++i) { const bf16* vp = Z + (size_t)(row0 + wid * 16 + hb * 8 + i) * INW + BU_OFF + BW + lane * 16; va[i] = *(const GAS v4u*)(vp); vb[i] = *(const GAS v4u*)(vp + 8); }
#pragma unroll
        for (int i = 0; i < 8; ++i) { const v4u a = va[i], b2 = vb[i];
            const float x[16] = {bflo(a.x), bfhi(a.x), bflo(a.y), bfhi(a.y), bflo(a.z), bfhi(a.z), bflo(a.w), bfhi(a.w), bflo(b2.x), bfhi(b2.x), bflo(b2.y), bfhi(b2.y), bflo(b2.z), bfhi(b2.z), bflo(b2.w), bfhi(b2.w)};
            float s = 0.f;
#pragma unroll
            for (int e = 0; e < 16; ++e) s += x[e];
            const float mean = wave_sum(s) * (1.0f / 1024.0f); float q = 0.f;
#pragma unroll
            for (int e = 0; e < 16; ++e) { const float dd = x[e] - mean; q += dd * dd; }
            const float rstd = 1.0f / sqrtf(wave_sum(q) * (1.0f / 1024.0f) + LN_EPS);
            if (lane == 0) st[wid * 16 + hb * 8 + i] = (f32x2v){mean, rstd}; }
    }
    const float* lng = F.gln_g + (size_t)l * BW; const float* lnb = F.gln_b + (size_t)l * BW;
    const int j = tid & 127, cc = tid >> 7;
    const int fr = lane & 15, fq = lane >> 4, tok = wid * 16 + fr;
    const bf16* vsrc = Z + (size_t)(row0 + j) * INW + BU_OFF + BW + cc * 32;
    v4u vr[4];
#pragma unroll
    for (int q4 = 0; q4 < 4; ++q4) vr[q4] = *(const GAS v4u*)(vsrc + q4 * 8);
    __syncthreads();
    const f32x2v sj = st[j];
#pragma unroll 1
    for (int g = 0; g < 8; ++g) {
        bf16x8 wf[4]; v2u uu[8];
        const bf16* wg = F.Wsp + ((size_t)l * 8 + g) * 16384 + (size_t)tok * 128 + fq * 8;
#pragma unroll
        for (int ks = 0; ks < 4; ++ks) wf[ks] = *(const GAS bf16x8*)(wg + ks * 32);
        const bf16* up = Z + (size_t)(row0 + tok) * INW + BU_OFF + g * 128 + 4 * fq;
#pragma unroll
        for (int ct = 0; ct < 8; ++ct) uu[ct] = *(const GAS v2u*)(up + ct * 16);
        const float bias = F.b_sp[((size_t)l * 8 + g) * 128 + tok];
#pragma unroll
        for (int q4 = 0; q4 < 4; ++q4) { const v4u a = vr[q4]; const int c0 = cc * 32 + q4 * 8;
            const f32x4 g0 = *(const f32x4*)(lng + g * 128 + c0), g1 = *(const f32x4*)(lng + g * 128 + c0 + 4), b0 = *(const f32x4*)(lnb + g * 128 + c0), b1 = *(const f32x4*)(lnb + g * 128 + c0 + 4);
            const float xv[8] = {bflo(a.x), bfhi(a.x), bflo(a.y), bfhi(a.y), bflo(a.z), bfhi(a.z), bflo(a.w), bfhi(a.w)};
#pragma unroll
            for (int e = 0; e < 8; ++e) { const float gg = e < 4 ? g0[e & 3] : g1[e & 3], bb = e < 4 ? b0[e & 3] : b1[e & 3]; const float y = (xv[e] - sj.x) * sj.y * gg + bb;
                *(LAS bf16*)(vt + (c0 + e) * GM_VP + j * 2) = (bf16)f2bf(y); } }
        if (g < 7) {
#pragma unroll
            for (int q4 = 0; q4 < 4; ++q4) vr[q4] = *(const GAS v4u*)(vsrc + (g + 1) * 128 + q4 * 8);
        }
        __syncthreads();
#pragma unroll
        for (int ct = 0; ct < 8; ++ct) { f32x4 acc = {0.f, 0.f, 0.f, 0.f};
#pragma unroll
            for (int ks = 0; ks < 4; ++ks) { const bf16x8 af = *(const LAS bf16x8*)(vt + (ct * 16 + fr) * GM_VP + (ks * 32 + fq * 8) * 2); acc = __builtin_amdgcn_mfma_f32_16x16x32_bf16(af, wf[ks], acc, 0, 0, 0); }
            const v2u u2 = uu[ct];
            v2u w; w.x = cvtpk(bflo(u2.x) * (acc[0] + bias), bfhi(u2.x) * (acc[1] + bias)); w.y = cvtpk(bflo(u2.y) * (acc[2] + bias), bfhi(u2.y) * (acc[3] + bias));
            *(GAS v2u*)(F.Y + (size_t)(row0 + tok) * YW + BW + g * 128 + ct * 16 + 4 * fq) = w; }
        __syncthreads();
    }
}

constexpr int PL_DP = 528;
template <int GI> __device__ __forceinline__ void pool_unit(Frame& F, int row0, int l) {
    int tid_ = F.ltid(); asm volatile("" : "+v"(tid_)); const int tid = tid_, lane = tid & 63, wid = __builtin_amdgcn_readfirstlane(F.ltid() >> 6);
    LAS unsigned char* dt = F.lds;
    const bf16* Z = F.Z;
    constexpr int W = 2 << GI, HW = W / 2, NR = 8 + W - 1;
    const int seqlen = row0 < MLAT ? SEQ : CTXL; const int s0 = row0 < MLAT ? (row0 & ~(SEQ - 1)) : MLAT + ((row0 - MLAT) & ~(CTXL - 1));
    const int fr = lane & 15, fq = lane >> 4;
    bf16x8 wa[8][2];
    { const bf16* wp = F.Wpool + ((size_t)l * 4 + GI) * 65536 + (size_t)(wid * 32 + fr) * 256 + fq * 8;
#pragma unroll
      for (int ks = 0; ks < 8; ++ks) { wa[ks][0] = *(const GAS bf16x8*)(wp + ks * 32); wa[ks][1] = *(const GAS bf16x8*)(wp + 16 * 256 + ks * 32); } }
    __syncthreads();
    { const int ch = tid & 31, tg = tid >> 5;
      const bf16* zc = Z + C_OFF + GI * 256 + ch * 8; const int p0 = row0 - s0 + tg * 8;
      v4u rw[NR];
#pragma unroll
      for (int k = 0; k < NR; ++k) { const int q = p0 - HW + k; const bool ok = (q >= 0) && (q < seqlen); const int qq = ok ? q : p0; const v4u a = *(const GAS v4u*)(zc + (size_t)(s0 + qq) * INW); rw[k] = ok ? a : (v4u){0u, 0u, 0u, 0u}; }
      float sum[8] = {0.f, 0.f, 0.f, 0.f, 0.f, 0.f, 0.f, 0.f};
#pragma unroll
      for (int k = 0; k < W; ++k) { const v4u a = rw[k]; sum[0] += bflo(a.x); sum[1] += bfhi(a.x); sum[2] += bflo(a.y); sum[3] += bfhi(a.y); sum[4] += bflo(a.z); sum[5] += bfhi(a.z); sum[6] += bflo(a.w); sum[7] += bfhi(a.w); }
#pragma unroll
      for (int i = 0; i < 8; ++i) { const int p = p0 + i; const int lo = p - HW < 0 ? 0 : p - HW; const int hi = p - HW + W > seqlen ? seqlen : p - HW + W; const float inv = 1.0f / (float)(hi - lo);
          const v4u zz = rw[i + HW];
          v4u o; o.x = pk2(sum[0] * inv - bflo(zz.x), sum[1] * inv - bfhi(zz.x)); o.y = pk2(sum[2] * inv - bflo(zz.y), sum[3] * inv - bfhi(zz.y));
          o.z = pk2(sum[4] * inv - bflo(zz.z), sum[5] * inv - bfhi(zz.z)); o.w = pk2(sum[6] * inv - bflo(zz.w), sum[7] * inv - bfhi(zz.w));
          *(LAS v4u*)(dt + (tg * 8 + i) * PL_DP + ch * 16) = o;
          if (i < 7) { const v4u a = rw[i + W], b = rw[i];
              sum[0] += bflo(a.x) - bflo(b.x); sum[1] += bfhi(a.x) - bfhi(b.x); sum[2] += bflo(a.y) - bflo(b.y); sum[3] += bfhi(a.y) - bfhi(b.y);
              sum[4] += bflo(a.z) - bflo(b.z); sum[5] += bfhi(a.z) - bfhi(b.z); sum[6] += bflo(a.w) - bflo(b.w); sum[7] += bfhi(a.w) - bfhi(b.w); } } }
    __syncthreads();
    { f32x4 acc[2][8];
#pragma unroll
      for (int a = 0; a < 2; ++a)
#pragma unroll
          for (int tt = 0; tt < 8; ++tt) acc[a][tt] = (f32x4){0.f, 0.f, 0.f, 0.f};
#pragma unroll
      for (int ks = 0; ks < 8; ++ks) {
#pragma unroll
          for (int tt = 0; tt < 8; ++tt) { const bf16x8 bfr = *(const LAS bf16x8*)(dt + (tt * 16 + fr) * PL_DP + (ks * 32 + fq * 8) * 2);
              acc[0][tt] = __builtin_amdgcn_mfma_f32_16x16x32_bf16(wa[ks][0], bfr, acc[0][tt], 0, 0, 0); acc[1][tt] = __builtin_amdgcn_mfma_f32_16x16x32_bf16(wa[ks][1], bfr, acc[1][tt], 0, 0, 0); } }
      const float* ps = F.pool_scale + (size_t)l * BW + GI * 256;
#pragma unroll
      for (int a = 0; a < 2; ++a) { const int dd = wid * 32 + a * 16 + 4 * fq; const f32x4 sc = *(const f32x4*)(ps + dd);
#pragma unroll
          for (int tt = 0; tt < 8; ++tt) { const f32x4 v = acc[a][tt] * sc; v2u wv; wv.x = cvtpk(v[0], v[1]); wv.y = cvtpk(v[2], v[3]);
              *(GAS v2u*)(F.Y + (size_t)(row0 + tt * 16 + fr) * YW + 2 * BW + GI * 256 + dd) = wv; } } }
}
__device__ __forceinline__ void pool_dispatch(Frame& F, int row0, int g, int l) {
    if (g == 0) pool_unit<0>(F, row0, l); else if (g == 1) pool_unit<1>(F, row0, l); else if (g == 2) pool_unit<2>(F, row0, l); else pool_unit<3>(F, row0, l);
}

#ifndef MIXM
#define MIXM 7
#endif
__device__ __forceinline__ void phase_mixers(Frame& F, int l, float lam_init) {
    const bool last = (l == DEPTH - 1);
    float d01 = 0.f, d23 = 0.f; const float* lq = F.lam_qk + (size_t)l * 256;
    for (int i = 0; i < 64; ++i) { d01 += lq[i] * lq[64 + i]; d23 += lq[128 + i] * lq[192 + i]; }
    const float lam = __expf(d01) - __expf(d23) + lam_init; const float oscale = 1.0f - lam_init;
    const float* subg = F.subln_g + (size_t)l * 128;
#ifndef REP_ATT
#define REP_ATT 1
#endif
#ifndef REP_GP
#define REP_GP 1
#endif
#pragma nounroll
    for (int i = 0; i < 5 * REP_ATT; ++i) { const int uid = F.vcu + F.G * (i % 5);
        if (!(MIXM & 1)) continue;
        if (uid < 1024) attn_unit(F, uid >> 8, (uid >> 5) & 7, uid & 31, false, lam, oscale, subg);
        else if (!last && uid < 1088) attn_unit(F, (uid - 1024) >> 4, ((uid - 1024) >> 1) & 7, uid & 1, true, lam, oscale, subg);
        if (TAILWORK == 2 && !last && i == (F.vcu & 3)) { __syncthreads(); const int gw_ = F.vcu * NWAVES + __builtin_amdgcn_readfirstlane(F.ltid() >> 6); ada_partial_layer(F, l + 1, gw_, F.G * NWAVES); cvt_layer(F, l + 1, gw_, F.G * NWAVES); } }
    const int nchunk = last ? MLAT / 128 : MTOT / 128;
#pragma nounroll
    for (int rgp = 0; rgp < REP_GP; ++rgp) {
    if (MIXM & 2) for (int cidx = F.G - 1 - F.vcu; cidx < nchunk; cidx += F.G) gmlp_unit(F, cidx * 128, l);
    if (MIXM & 4) { const int nfree = F.G - nchunk, npool = nchunk * 4;
        if (nfree > 0 && F.G == 256) {
            if (F.vcu < nfree) { for (int k = 0; k < 4; ++k) { const int u = F.vcu * 4 + k; if (u < npool) pool_dispatch(F, (u >> 2) * 128, u & 3, l); } }
            else { for (int u = nfree * 4 + (F.vcu - nfree); u < npool; u += nchunk) pool_dispatch(F, (u >> 2) * 128, u & 3, l); }
        } else { for (int u = F.vcu; u < npool; u += F.G) pool_dispatch(F, (u >> 2) * 128, u & 3, l); } }
    }
    __syncthreads();
}

#ifndef ALIGN_P3
#define ALIGN_P3 true
#endif
#ifndef WGM_P1
#define WGM_P1 4
#endif
#ifndef WGM_P5
#define WGM_P5 4
#endif
#ifndef WGM_N8
#define WGM_N8 4
#endif
#ifndef SP2_BIG
#define SP2_BIG true
#endif
#ifndef ALIGN_BIG
#define ALIGN_BIG true
#endif
#ifndef STAGGER
#define STAGGER 0
#endif
__device__ __forceinline__ void phase_stagger(int slot) { if (STAGGER) for (int i = 0; i < slot * 3; ++i) __builtin_amdgcn_s_sleep(8); }
#ifndef MK_ONE_LAUNCH
#define MK_ONE_LAUNCH 1
#endif
constexpr int NPHASE = 3 + 8 * DEPTH;
struct Args { const float* in[23]; float* out; unsigned char* ws; int ph_lo, ph_hi; float lam_init[4]; };
__global__ void __launch_bounds__(NWAVES * 64, 2) fwd(Args args) {
    extern __shared__ __attribute__((aligned(16))) unsigned char lds[];
    Frame F;
    F.lds = (LAS unsigned char*)lds;
    F.MISC = (volatile LAS unsigned*)(F.lds + MISC_OFF);
    F.G = gridDim.x; { const int bx = blockIdx.x; F.bx = bx; F.vcu = (F.G % 8 == 0) ? (bx % 8) * (F.G / 8) + bx / 8 : bx; }
    unsigned char* ws = args.ws;
    F.ctl = (gu32*)(ws + WS_CTL);
    frame_ptrs(F);
    for (int u = F.ltid(); u < (LDS_BYTES - LDSCTL_OFF) / 4; u += NWAVES * 64) ((LAS unsigned*)(F.lds + LDSCTL_OFF))[u] = 0u;
    __syncthreads();
#if MK_ONE_LAUNCH
    constexpr int lo = 0, hi = NPHASE; constexpr bool use_bar = true;
#else
    const int lo = args.ph_lo, hi = args.ph_hi;
    const bool use_bar = (hi - lo) > 1;
#endif
    XcdBarrier bar; bar.bar = (unsigned*)(F.ctl + CW_BAR); bar.x = 0; bar.st = nullptr;
    if (use_bar) bar = xcd_barrier_post((unsigned*)(F.ctl + CW_BAR), F.MISC + 8);
#ifndef PHM
#define PHM 0xFFFF
#endif
#define IN(k) (lo <= (k) && (k) < hi)
#define KIND(b) ((PHM >> (b)) & 1)
#ifndef REP_MASK
#define REP_MASK 0
#endif
#define NREP(b) (((REP_MASK >> (b)) & 1) ? 2 : 1)
#define BARRIER() do { XcdBarrier b_ = bar; asm volatile("" : "+s"(b_.x)); xcd_barrier(b_); } while (0)
#ifndef DRY_EPI
#define DRY_EPI 0
#endif
#ifndef BAR_REP
#define BAR_REP 1
#endif
#define SEAM(k) do { if (IN(k) && IN((k) + 1)) { for (int br_ = 0; br_ < BAR_REP; ++br_) BARRIER(); } } while (0)

    if (KIND(0) && IN(0)) { for (int rep = 0; rep < NREP(0); ++rep) { frame_ptrs(F); phase_a1(F); if (rep + 1 < NREP(0)) BARRIER(); } } SEAM(0);
    if (KIND(1) && IN(1)) { frame_ptrs(F); phase_a2(F); } SEAM(1);
    if (KIND(2) && IN(2)) { frame_ptrs(F); phase_a3(F); } SEAM(2);

#pragma nounroll
    for (int l = 0; l < DEPTH; ++l) {
        const int pb = 3 + 8 * l; const bool last = (l == DEPTH - 1);
        { int g_ = F.G, v_ = F.vcu, b_ = F.bx; asm volatile("" : "+s"(g_), "+s"(v_), "+s"(b_)); F.G = g_; F.vcu = v_; F.bx = b_; }
        const int Mrows = last ? MLAT : MTOT;
        if (KIND(3) && IN(pb + 0)) for (int rep = 0; rep < NREP(3); ++rep) { if (rep) BARRIER(); frame_ptrs(F);
            pg8::Gemm g{F.HA, F.Win + (size_t)l * INW * D, MTOT, INW, D, D, D}; pg8::StaticOrder S; S.init(MTOT, INW, F.G, F.bx, WGM_P1);
            pg8::EpiInProj E{F.Z, F.rope, QSCALE, INW, MLAT, F.KB, F.VB, (rep && DRY_EPI) ? 1 : 0};
            phase_stagger((F.bx >> 3) & 7);
            pg8::gemm_phase<pg8::EpiInProj, pg8::StaticOrder, ALIGN_BIG, SP2_BIG>(F.lds + RING_OFF, g, S, E);
        }
        SEAM(pb + 0);
        if (KIND(4) && IN(pb + 1)) for (int rep = 0; rep < NREP(4); ++rep) { if (rep) BARRIER(); frame_ptrs(F); phase_mixers(F, l, args.lam_init[l]); }
        SEAM(pb + 1);
        if (KIND(5) && IN(pb + 2)) for (int rep = 0; rep < NREP(5); ++rep) { if (rep) BARRIER(); frame_ptrs(F);
            pg8::Gemm g{F.Y, F.Wbr + (size_t)l * D * YW, Mrows, D, YW, YW, YW}; pg8::StaticOrder S; S.init(Mrows, D, F.G, F.bx, WGM_N8);
            pg8::EpiGate E{F.Z + G_OFF, INW, F.MG, D};
            pg8::gemm_phase<pg8::EpiGate, pg8::StaticOrder, ALIGN_P3, true>(F.lds + RING_OFF, g, S, E);
        }
        SEAM(pb + 2);
        if (KIND(6) && IN(pb + 3)) for (int rep = 0; rep < NREP(6); ++rep) { if (rep) BARRIER(); frame_ptrs(F);
            void* tw = rep ? (void*)(F.Z + (size_t)134 * MiB) : (void*)F.Y;
            { pg8::Gemm g{F.MG, F.Wout + (size_t)l * D * D, MLAT, D, D, D, D}; pg8::StaticOrder S; S.init(MLAT, D, F.G, F.bx, WGM_N8);
              pg8::EpiResidT<false> E{F.mods + (size_t)l * 5 * INW + 2 * D, INW, tw, D, 1, MLAT};
              pg8::gemm_phase<pg8::EpiResidT<false>, pg8::StaticOrder, true, true>(F.lds + RING_OFF, g, S, E); }
            if (!last) { pg8::Gemm g{F.MG, F.Wout + (size_t)l * D * D, MTOT, D, 256, D, D}; pg8::SplitOrder S; S.init(MLAT / 256, 32, 8, 256, F.G, F.bx);
              pg8::EpiResidT<true> E{F.mods + (size_t)l * 5 * INW + 2 * D, INW, rep ? (void*)(F.Z + (size_t)170 * MiB) : (void*)(F.Z + (size_t)100 * MiB), D, 256, MLAT};
              pg8::gemm_phase<pg8::EpiResidT<true>, pg8::SplitOrder, true, true>(F.lds + RING_OFF, g, S, E); }
            if (TAILWORK == 1 && !last && F.bx >= 32 && rep == 0) ada_partial_layer(F, l + 1, (F.bx - 32) * NWAVES + __builtin_amdgcn_readfirstlane(F.ltid() >> 6), (F.G - 32) * NWAVES);
        }
        SEAM(pb + 3);
        if (KIND(7) && IN(pb + 4)) { frame_ptrs(F); if (NREP(7) > 1) { phase_ln(F, F.ln1_g + (size_t)l * D, F.ln1_b + (size_t)l * D, Mrows, false, true, l, 3 * D, last ? 0 : 8, true); BARRIER(); frame_ptrs(F); }
            phase_ln(F, F.ln1_g + (size_t)l * D, F.ln1_b + (size_t)l * D, Mrows, false, true, l, 3 * D, last ? 0 : 8); if (TAILWORK && !last) mods_reduce_layer(F, l + 1); }
        SEAM(pb + 4);
        if (KIND(8) && IN(pb + 5)) for (int rep = 0; rep < NREP(8); ++rep) { if (rep) BARRIER(); frame_ptrs(F);
            pg8::Gemm g{F.HA, F.Wgu + (size_t)l * 2 * FFH * D, Mrows, 2 * FFH, D, D, D}; pg8::StaticOrder S; S.init(Mrows, 2 * FFH, F.G, F.bx, WGM_P5);
            pg8::EpiSwiglu E{F.Z, FFH};
            phase_stagger((F.bx >> 3) & 7);
            pg8::gemm_phase<pg8::EpiSwiglu, pg8::StaticOrder, ALIGN_BIG, SP2_BIG>(F.lds + RING_OFF, g, S, E);
        }
        SEAM(pb + 5);
        if (KIND(9) && IN(pb + 6)) for (int rep = 0; rep < NREP(9); ++rep) { if (rep) BARRIER(); frame_ptrs(F);
            void* tw = rep ? (void*)(F.Z + (size_t)134 * MiB) : (void*)F.Y;
            { pg8::Gemm g{F.Z, F.Wdn + (size_t)l * D * FFH, MLAT, D, FFH, FFH, FFH}; pg8::StaticOrder S; S.init(MLAT, D, F.G, F.bx, WGM_N8);
              pg8::EpiResidT<false> E{F.mods + (size_t)l * 5 * INW + 5 * D, INW, tw, D, 1, MLAT};
              pg8::gemm_phase<pg8::EpiResidT<false>, pg8::StaticOrder, true, true>(F.lds + RING_OFF, g, S, E); }
            if (!last) { pg8::Gemm g{F.Z, F.Wdn + (size_t)l * D * FFH, MTOT, D, FFH / 4, FFH, FFH}; pg8::SplitOrder S; S.init(MLAT / 256, 32, 4, FFH / 4, F.G, F.bx);
              pg8::EpiResidT<true> E{F.mods + (size_t)l * 5 * INW + 5 * D, INW, rep ? (void*)(F.Z + (size_t)170 * MiB) : (void*)(F.Z + (size_t)100 * MiB), D, FFH / 4, MLAT};
              pg8::gemm_phase<pg8::EpiResidT<true>, pg8::SplitOrder, true, true>(F.lds + RING_OFF, g, S, E); }
            if (TAILWORK == 1 && !last && F.bx >= 32 && rep == 0) { __syncthreads(); cvt_layer(F, l + 1, (F.bx - 32) * NWAVES + __builtin_amdgcn_readfirstlane(F.ltid() >> 6), (F.G - 32) * NWAVES); }
        }
        SEAM(pb + 6);
        if (KIND(7) && IN(pb + 7)) { frame_ptrs(F); phase_ln(F, F.ln2_g + (size_t)l * D, F.ln2_b + (size_t)l * D, Mrows, last, !last, last ? l : l + 1, 0, last ? 0 : 4); }
        if (!last) SEAM(pb + 7);
    }
#undef IN
#undef SEAM
}

extern "C" void kernel_launch(void* const* d_in, const int* in_sizes, int n_in, void* d_out, int out_size, void* d_ws, size_t ws_size, hipStream_t stream) {
    static int grid = 0;
    if (grid == 0) {
        if (n_in != 23 || in_sizes[0] != MLAT * D || out_size != MLAT * D || ws_size < WS_END) {
            fprintf(stderr, "kernel_launch: unexpected shapes / workspace (n_in %d, in0 %d, out %d, ws %zu, need %zu); nothing launched\n", n_in, n_in > 0 ? in_sizes[0] : -1, out_size, ws_size, (size_t)WS_END); grid = -1; return; }
        int dev = 0, cus = 0, per_cu = 0;
        if (hipGetDevice(&dev) != hipSuccess || hipDeviceGetAttribute(&cus, hipDeviceAttributeMultiprocessorCount, dev) != hipSuccess) { grid = -1; return; }
        if (hipFuncSetAttribute((const void*)fwd, hipFuncAttributeMaxDynamicSharedMemorySize, LDS_BYTES) != hipSuccess) { fprintf(stderr, "kernel_launch: hipFuncSetAttribute failed\n"); grid = -1; return; }
        if (hipOccupancyMaxActiveBlocksPerMultiprocessor(&per_cu, (const void*)fwd, NWAVES * 64, LDS_BYTES) != hipSuccess || per_cu < 1) fprintf(stderr, "kernel_launch: occupancy query reports %d\n", per_cu);
        (void)hipGetLastError();
        grid = cus;
    }
    if (grid < 0) return;
    if (hipMemsetAsync((char*)d_ws + WS_CTL, 0, CTL_ZERO_BYTES, stream) != hipSuccess) return;
    Args a{};
    for (int i = 0; i < 23; ++i) a.in[i] = (const float*)d_in[i];
    a.out = (float*)d_out; a.ws = (unsigned char*)d_ws;
    for (int l = 0; l < DEPTH; ++l) a.lam_init[l] = (float)(0.8 - 0.6 * exp(-0.3 * (double)l));
#if MK_ONE_LAUNCH
    a.ph_lo = 0; a.ph_hi = NPHASE;
    hipLaunchKernelGGL(fwd, dim3(grid), dim3(NWAVES * 64), LDS_BYTES, stream, a);
#else
    for (int p = 0; p < NPHASE; ++p) { a.ph_lo = p; a.ph_hi = p + 1; hipLaunchKernelGGL(fwd, dim3(grid), dim3(NWAVES * 64), LDS_BYTES, stream, a); }
#endif
}
```

```cpp
#include <hip/hip_runtime.h>
#include <cstdio>
#include <cstdint>
#include <cmath>
namespace pg8 {
#define PG8_LAS __attribute__((address_space(3)))
typedef unsigned short bf16_t;
typedef short bf16x8 __attribute__((ext_vector_type(8)));
typedef float f32x4 __attribute__((ext_vector_type(4)));
typedef unsigned u32x4 __attribute__((ext_vector_type(4)));
constexpr int BM = 256, BK = 64, HALF = 128, HTB = HALF * BK * 2  , STAGE_BYTES = 8 * HTB, NXCD = 8, WGM = 4;

__host__ __device__ __forceinline__ int lds_byte(int r, int c) { const int st = (r >> 4) * 2 + (c >> 5), rr = r & 15, cc = c & 31, ob = rr * 64 + cc * 2; return st * 1024 + (ob ^ (((ob >> 9) & 1) << 5)); }
__host__ __device__ __forceinline__ void stage_rc(int b, int& R, int& C) { const int st = b / 1024, sb = b % 1024, swz = sb ^ (((sb >> 9) & 1) << 5); R = (st >> 1) * 16 + swz / 64; C = (st & 1) * 32 + (swz % 64) / 2; }
__host__ __device__ __forceinline__ int perm32(int rho) { const int n = rho >> 4, i = rho & 15; return 8 * (i >> 2) + 4 * n + (i & 3); }

struct Unit { int pm, pn, ka; };
struct Gemm { const bf16_t* A; const bf16_t* Bt; int M, N, K, lda, ldb; };

struct StaticOrder {
    int nM, nN, nwg, G, c, wgm;
    __host__ __device__ void init(int M, int N, int G_, int c_, int wgm_ = WGM) { nM = M / BM; nN = N / BM; nwg = nM * nN; G = G_; c = c_; wgm = wgm_; }
    __host__ __device__ bool next(int i, Unit& u) const {
        const long L = (long)i * G + c; if (L >= nwg) return false;
        int wgid = (int)L; { const int q = nwg / NXCD, r = nwg % NXCD, xcd = wgid % NXCD, off = wgid / NXCD; wgid = (xcd < r ? xcd * (q + 1) : r * (q + 1) + (xcd - r) * q) + off; }
        const int nig = wgm * nN, gid = wgid / nig, fm = gid * wgm, gsz = (nM - fm) < wgm ? (nM - fm) : wgm;
        u.pm = fm + ((wgid % nig) % gsz); u.pn = (wgid % nig) / gsz; u.ka = 0; return true;
    }
    __device__ __forceinline__ void a_ready(const Unit&) const {}
    __device__ __forceinline__ void done(const Unit&) const {}
};

struct SplitOrder {
    int nsplit, klen, G, c, pm0, ntile;
    __host__ __device__ void init(int pm0_, int ntile_, int nsplit_, int klen_, int G_, int c_) { pm0 = pm0_; ntile = ntile_; nsplit = nsplit_; klen = klen_; G = G_; c = c_; }
    __host__ __device__ bool next(int i, Unit& u) const { const int L = i * G + c; if (L >= ntile * nsplit) return false; const int tt = L / nsplit; u.pm = pm0 + (tt & 3); u.pn = tt >> 2; u.ka = (L - tt * nsplit) * klen; return true; }
    __device__ __forceinline__ void a_ready(const Unit&) const {}
    __device__ __forceinline__ void done(const Unit&) const {}
};
__device__ __forceinline__ unsigned cvt_pk_bf16(float lo, float hi) { unsigned r; asm volatile("v_cvt_pk_bf16_f32 %0, %1, %2" : "=v"(r) : "v"(lo), "v"(hi)); return r; }
typedef float f32x2 __attribute__((ext_vector_type(2)));
__device__ __forceinline__ f32x2 gelu_pk(f32x2 v) {
    const f32x2 av = __builtin_elementwise_abs(v), d = av * 0.2316418882f + 1.0f;
    f32x2 t; t.x = __builtin_amdgcn_rcpf(d.x); t.y = __builtin_amdgcn_rcpf(d.y);
    f32x2 q = t * 0.5307027145f + (-0.7265760135f); q = q * t + 0.7107068705f; q = q * t + (-0.142248368f); q = q * t + 0.127414796f; q = q * t;
    const f32x2 s = (v * v) * (-0.72134752044f);
    f32x2 e; e.x = __builtin_amdgcn_exp2f(s.x); e.y = __builtin_amdgcn_exp2f(s.y);
    const f32x2 m = v * (q * e), r = v - m;
    f32x2 o; o.x = v.x < 0.f ? m.x : r.x; o.y = v.y < 0.f ? m.y : r.y; return o;
}

#ifndef GATE_NT
#define GATE_NT 0
#endif
#if GATE_NT
#define GATE_LD(p) __builtin_nontemporal_load(p)
#else
#define GATE_LD(p) (*(p))
#endif
#ifndef GATE_ST_NT
#define GATE_ST_NT 0
#endif
#ifndef EPI_NT
#define EPI_NT 0
#endif
typedef unsigned u32x2 __attribute__((ext_vector_type(2)));
__device__ __forceinline__ float bf_lo(unsigned w) { return __uint_as_float(w << 16); }
__device__ __forceinline__ float bf_hi(unsigned w) { return __uint_as_float(w & 0xffff0000u); }
__device__ __forceinline__ void store8_bf16(bf16_t* p, const f32x4 v0, const f32x4 v1) {
    u32x4 w; w.x = cvt_pk_bf16(v0[0], v0[1]); w.y = cvt_pk_bf16(v0[2], v0[3]); w.z = cvt_pk_bf16(v1[0], v1[1]); w.w = cvt_pk_bf16(v1[2], v1[3]);
#if EPI_NT
    __builtin_nontemporal_store(w, (u32x4*)p);
#else
    *(u32x4*)p = w;
#endif
}
__device__ __forceinline__ float sigmoid_f(float x) { return __builtin_amdgcn_rcpf(1.0f + __builtin_amdgcn_exp2f(x * -1.4426950408889634f)); }

struct EpiInProj {
    static constexpr bool PERM = true, AFTER_DRAIN = false; static constexpr int KSEG = 0;
    bf16_t* Z; const float* rope; float qscale; int ldc; int nlat; bf16_t* Kb; bf16_t* Vb; int dry;
    __device__ __forceinline__ void kseg(f32x4 (&)[2][2][4][2], const Unit&, int, int, int, int, int) const {}
    __device__ __forceinline__ void operator()(const f32x4 (&acc)[2][2][4][2], const Unit& u, int wr, int wc, int fr, int fq) const {
        const int pn = u.pn; const int row0 = u.pm * BM + wr * 64 + fr; const int col0 = pn * BM + wc * 32 + 8 * fq;
        if (dry) { float s_ = 0.f;
#pragma unroll
            for (int a_ = 0; a_ < 2; ++a_)
#pragma unroll
                for (int b_ = 0; b_ < 2; ++b_)
#pragma unroll
                    for (int m_ = 0; m_ < 4; ++m_)
#pragma unroll
                        for (int n_ = 0; n_ < 2; ++n_) s_ += acc[a_][b_][m_][n_][0];
            if (s_ != s_) Z[0] = 0; return; }
        if (pn < 8) {
            const float sc = pn < 4 ? qscale : 1.0f;
#pragma unroll
            for (int ai = 0; ai < 2; ++ai)
#pragma unroll
                for (int m = 0; m < 4; ++m) {
                    const int row = row0 + ai * HALF + m * 16; const int t = row & 4095; const int pos = (wc & 1) ? (t & 63) : (t >> 6);
                    f32x4 cs0 = *(const f32x4*)(rope + (pos * 16 + 4 * fq) * 2), cs1 = *(const f32x4*)(rope + (pos * 16 + 4 * fq) * 2 + 4);
                    if (row >= nlat) { cs0 = (f32x4){1.f, 0.f, 1.f, 0.f}; cs1 = cs0; }
                    bf16_t* rowp = Z + (size_t)row * ldc + col0;
                    if (pn >= 4) { const int bb = row < nlat ? (row >> 12) : ((row - nlat) >> 8), key = row < nlat ? 256 + (row & 4095) : ((row - nlat) & 255);
                        rowp = Kb + ((size_t)(bb * 8 + 2 * (pn - 4)) * 4352 + key) * 128 + wc * 32 + 8 * fq; }
#pragma unroll
                    for (int bj = 0; bj < 2; ++bj) {
                        const f32x4 a = acc[ai][bj][m][0], b = acc[ai][bj][m][1];
                        f32x4 o0, o1;
                        o0[0] = (a[0] * cs0[0] - a[1] * cs0[1]) * sc; o0[1] = (a[0] * cs0[1] + a[1] * cs0[0]) * sc;
                        o0[2] = (a[2] * cs0[2] - a[3] * cs0[3]) * sc; o0[3] = (a[2] * cs0[3] + a[3] * cs0[2]) * sc;
                        o1[0] = (b[0] * cs1[0] - b[1] * cs1[1]) * sc; o1[1] = (b[0] * cs1[1] + b[1] * cs1[0]) * sc;
                        o1[2] = (b[2] * cs1[2] - b[3] * cs1[3]) * sc; o1[3] = (b[2] * cs1[3] + b[3] * cs1[2]) * sc;
                        store8_bf16(rowp + (pn >= 4 ? (size_t)bj * 4352 * 128 : (size_t)bj * HALF), o0, o1);
                    }
                }
        } else if (pn < 12) {
#pragma unroll
            for (int ai = 0; ai < 2; ++ai)
#pragma unroll
                for (int m = 0; m < 4; ++m) { const int row = row0 + ai * HALF + m * 16; const int bb = row < nlat ? (row >> 12) : ((row - nlat) >> 8), key = row < nlat ? 256 + (row & 4095) : ((row - nlat) & 255);
                    bf16_t* rowp = Vb + ((size_t)(bb * 8 + 2 * (pn - 8)) * 4352 + key) * 128 + wc * 32 + 8 * fq;
#pragma unroll
                    for (int bj = 0; bj < 2; ++bj) store8_bf16(rowp + (size_t)bj * 4352 * 128, acc[ai][bj][m][0], acc[ai][bj][m][1]); }
        } else if (pn >= 20 && pn < 24) {
#pragma unroll
            for (int ai = 0; ai < 2; ++ai)
#pragma unroll
                for (int m = 0; m < 4; ++m) { bf16_t* rowp = Z + (size_t)(row0 + ai * HALF + m * 16) * ldc + col0;
#pragma unroll
                    for (int bj = 0; bj < 2; ++bj) store8_bf16(rowp + bj * HALF, acc[ai][bj][m][0], acc[ai][bj][m][1]); }
        } else if (pn < 20) {
#pragma unroll
            for (int ai = 0; ai < 2; ++ai)
#pragma unroll
                for (int m = 0; m < 4; ++m) { bf16_t* rowp = Z + (size_t)(row0 + ai * HALF + m * 16) * ldc + col0;
#pragma unroll
                    for (int bj = 0; bj < 2; ++bj) { const f32x4 v0 = acc[ai][bj][m][0], v1 = acc[ai][bj][m][1];
                        const f32x2 a = gelu_pk((f32x2){v0[0], v0[1]}), b = gelu_pk((f32x2){v0[2], v0[3]}), c = gelu_pk((f32x2){v1[0], v1[1]}), d = gelu_pk((f32x2){v1[2], v1[3]});
                        store8_bf16(rowp + bj * HALF, (f32x4){a.x, a.y, b.x, b.y}, (f32x4){c.x, c.y, d.x, d.y}); } }
        } else {
#pragma unroll
            for (int ai = 0; ai < 2; ++ai)
#pragma unroll
                for (int m = 0; m < 4; ++m) { bf16_t* rowp = Z + (size_t)(row0 + ai * HALF + m * 16) * ldc + col0;
#pragma unroll
                    for (int bj = 0; bj < 2; ++bj) { const f32x4 v0 = acc[ai][bj][m][0], v1 = acc[ai][bj][m][1]; f32x4 o0, o1;
#pragma unroll
                        for (int i = 0; i < 4; ++i) { o0[i] = __builtin_fmaxf(sigmoid_f(v0[i]), 1e-12f); o1[i] = __builtin_fmaxf(sigmoid_f(v1[i]), 1e-12f); }
#if GATE_ST_NT
                        { u32x4 w; w.x = cvt_pk_bf16(o0[0], o0[1]); w.y = cvt_pk_bf16(o0[2], o0[3]); w.z = cvt_pk_bf16(o1[0], o1[1]); w.w = cvt_pk_bf16(o1[2], o1[3]); __builtin_nontemporal_store(w, (u32x4*)(rowp + bj * HALF)); } } }
#else
                        store8_bf16(rowp + bj * HALF, o0, o1); } }
#endif
        }
    }
};

struct EpiGate {
    static constexpr bool PERM = true, AFTER_DRAIN = false; static constexpr int KSEG = 16;
    const bf16_t* G; int ldg; bf16_t* O; int ldo;
    __device__ __forceinline__ void kseg(f32x4 (&acc)[2][2][4][2], const Unit& u, int seg, int wr, int wc, int fr, int fq) const {
        const int row0 = u.pm * BM + wr * 64 + fr; const int col0 = u.pn * BM + wc * 32 + 8 * fq;
#pragma unroll
        for (int ai = 0; ai < 2; ++ai) {
            u32x4 ga[4][2], gb[4][2];
#pragma unroll
            for (int m = 0; m < 4; ++m) { const bf16_t* gp = G + (size_t)(row0 + ai * HALF + m * 16) * ldg + (seg - 1) * 2048 + col0;
#pragma unroll
                for (int bj = 0; bj < 2; ++bj) { ga[m][bj] = GATE_LD((const u32x4*)(gp + bj * HALF)); gb[m][bj] = GATE_LD((const u32x4*)(gp + 2048 + bj * HALF)); } }
#pragma unroll
            for (int m = 0; m < 4; ++m)
#pragma unroll
                for (int bj = 0; bj < 2; ++bj) { const u32x4 a = ga[m][bj], b = gb[m][bj];
                    f32x4 r0, r1;
                    r0[0] = bf_lo(a.x) * __builtin_amdgcn_rcpf(bf_lo(b.x)); r0[1] = bf_hi(a.x) * __builtin_amdgcn_rcpf(bf_hi(b.x));
                    r0[2] = bf_lo(a.y) * __builtin_amdgcn_rcpf(bf_lo(b.y)); r0[3] = bf_hi(a.y) * __builtin_amdgcn_rcpf(bf_hi(b.y));
                    r1[0] = bf_lo(a.z) * __builtin_amdgcn_rcpf(bf_lo(b.z)); r1[1] = bf_hi(a.z) * __builtin_amdgcn_rcpf(bf_hi(b.z));
                    r1[2] = bf_lo(a.w) * __builtin_amdgcn_rcpf(bf_lo(b.w)); r1[3] = bf_hi(a.w) * __builtin_amdgcn_rcpf(bf_hi(b.w));
                    acc[ai][bj][m][0] *= r0; acc[ai][bj][m][1] *= r1; }
            asm volatile("" ::: "memory"); }
    }
    __device__ __forceinline__ void operator()(const f32x4 (&acc)[2][2][4][2], const Unit& u, int wr, int wc, int fr, int fq) const {
        const int row0 = u.pm * BM + wr * 64 + fr; const int col0 = u.pn * BM + wc * 32 + 8 * fq;
        u32x4 gg[2][4][2];
#pragma unroll
        for (int ai = 0; ai < 2; ++ai)
#pragma unroll
            for (int m = 0; m < 4; ++m) { const bf16_t* gp = G + (size_t)(row0 + ai * HALF + m * 16) * ldg + 2 * 2048 + col0;
#pragma unroll
                for (int bj = 0; bj < 2; ++bj) gg[ai][m][bj] = GATE_LD((const u32x4*)(gp + bj * HALF)); }
#pragma unroll
        for (int ai = 0; ai < 2; ++ai)
#pragma unroll
            for (int m = 0; m < 4; ++m) { bf16_t* op = O + (size_t)(row0 + ai * HALF + m * 16) * ldo + col0;
#pragma unroll
                for (int bj = 0; bj < 2; ++bj) { const u32x4 g = gg[ai][m][bj];
                    const f32x4 g0 = (f32x4){bf_lo(g.x), bf_hi(g.x), bf_lo(g.y), bf_hi(g.y)}, g1 = (f32x4){bf_lo(g.z), bf_hi(g.z), bf_lo(g.w), bf_hi(g.w)};
                    store8_bf16(op + bj * HALF, acc[ai][bj][m][0] * g0, acc[ai][bj][m][1] * g1); } }
    }
};

template <bool SLAB> struct EpiResidT {
    static constexpr bool PERM = !SLAB, AFTER_DRAIN = false; static constexpr int KSEG = 0;
    const float* gv; int gstride; void* Tw; int ldc; int klen, nlat;
    __device__ __forceinline__ void kseg(f32x4 (&)[2][2][4][2], const Unit&, int, int, int, int, int) const {}
    __device__ __forceinline__ void operator()(const f32x4 (&acc)[2][2][4][2], const Unit& u, int wr, int wc, int fr, int fq) const {
        const int row0 = u.pm * BM + wr * 64 + fr; const int grp = u.pm < 64 ? (u.pm >> 4) : 4;
        if constexpr (SLAB) {
            const int col0 = u.pn * BM + wc * 32 + 4 * fq;
            f32x4 g[2][2];
#pragma unroll
            for (int bj = 0; bj < 2; ++bj)
#pragma unroll
                for (int n = 0; n < 2; ++n) g[bj][n] = *(const f32x4*)(gv + (size_t)grp * gstride + col0 + bj * HALF + n * 16);
#pragma unroll
            for (int ai = 0; ai < 2; ++ai)
#pragma unroll
                for (int m = 0; m < 4; ++m) { float* pp = (float*)Tw + ((size_t)(u.ka / klen) * 1024 + (size_t)(row0 + ai * HALF + m * 16 - nlat)) * ldc + col0;
#pragma unroll
                    for (int bj = 0; bj < 2; ++bj)
#pragma unroll
                        for (int n = 0; n < 2; ++n) *(f32x4*)(pp + bj * HALF + n * 16) = g[bj][n] * acc[ai][bj][m][n]; }
        } else {
            const int col0 = u.pn * BM + wc * 32 + 8 * fq;
            f32x4 g[2][2];
#pragma unroll
            for (int bj = 0; bj < 2; ++bj)
#pragma unroll
                for (int n = 0; n < 2; ++n) g[bj][n] = *(const f32x4*)(gv + (size_t)grp * gstride + col0 + bj * HALF + n * 4);
#pragma unroll
            for (int ai = 0; ai < 2; ++ai)
#pragma unroll
                for (int m = 0; m < 4; ++m) { bf16_t* tp = (bf16_t*)Tw + (size_t)(row0 + ai * HALF + m * 16) * ldc + col0;
#pragma unroll
                    for (int bj = 0; bj < 2; ++bj) store8_bf16(tp + bj * HALF, g[bj][0] * acc[ai][bj][m][0], g[bj][1] * acc[ai][bj][m][1]); }
        }
    }
};

struct EpiSwiglu {
    static constexpr bool PERM = true, AFTER_DRAIN = false; static constexpr int KSEG = 0;
    bf16_t* H; int ldc;
    __device__ __forceinline__ void kseg(f32x4 (&)[2][2][4][2], const Unit&, int, int, int, int, int) const {}
    __device__ __forceinline__ void operator()(const f32x4 (&acc)[2][2][4][2], const Unit& u, int wr, int wc, int fr, int fq) const {
        const int row0 = u.pm * BM + wr * 64 + fr, col0 = u.pn * HALF + wc * 32 + 8 * fq;
#pragma unroll
        for (int ai = 0; ai < 2; ++ai)
#pragma unroll
            for (int m = 0; m < 4; ++m) { bf16_t* rowp = H + (size_t)(row0 + ai * HALF + m * 16) * ldc + col0; f32x4 o[2];
#pragma unroll
                for (int n = 0; n < 2; ++n) { const f32x4 gt = acc[ai][0][m][n], up = acc[ai][1][m][n];
#pragma unroll
                    for (int i = 0; i < 4; ++i) o[n][i] = gt[i] * sigmoid_f(gt[i]) * up[i]; }
                store8_bf16(rowp, o[0], o[1]); }
    }
};
template <class Epi, class Sched, bool ALIGN_EPI = false, bool SP2 = false>
__device__ __forceinline__ void gemm_phase(PG8_LAS unsigned char* lds, const Gemm g, const Sched& S, const Epi& E) {
    int tid_ = threadIdx.x; asm volatile("" : "+v"(tid_));
    const int tid = tid_, wid = __builtin_amdgcn_readfirstlane(tid >> 6), lane = tid & 63, wr = wid >> 2, wc = wid & 3, fr = lane & 15, fq = lane >> 4;
    const int K = g.K, nt = K / BK;
    unsigned voffA[2], voffB[2];
#pragma unroll
    for (int i = 0; i < 2; ++i) { int R, C; stage_rc(tid * 16 + i * 8192, R, C); const int Rb = Epi::PERM ? ((R & ~31) + perm32(R & 31)) : R;
        voffA[i] = (unsigned)(R * g.lda + C) * 2u; voffB[i] = (unsigned)(Rb * g.ldb + C) * 2u; }
    const size_t kstep = (size_t)(BK * 2);
    const size_t hstepA = (size_t)HALF * g.lda * 2, hstepB = (size_t)HALF * g.ldb * 2;
    const size_t tstepA = 2 * hstepA, tstepB = 2 * hstepB;
    const unsigned ldsw = (unsigned)wid * 1024u;
    const int aoff = lds_byte(wr * 64 + fr, fq * 8), boff = lds_byte(wc * 32 + fr, fq * 8);
#define PG8_SA(b, h) (((b) * 2 + (h)) * HTB)
#define PG8_SB(b, h) ((4 + (b) * 2 + (h)) * HTB)
#define PG8_STAGE(bufoff, gbase, voff) do { _Pragma("unroll") for (int _i = 0; _i < 2; ++_i) \
        __builtin_amdgcn_global_load_lds((const unsigned*)((const char*)(gbase) + (voff)[_i]), (PG8_LAS unsigned*)(lds + (bufoff) + ldsw + _i * 8192), 16, 0, 0); } while (0)
#define PG8_LDA(dst, b, h) do { _Pragma("unroll") for (int m = 0; m < 4; ++m) _Pragma("unroll") for (int k = 0; k < 2; ++k) dst[m][k] = *(const PG8_LAS bf16x8*)(lds + PG8_SA(b, h) + aoff + m * 2048 + k * 1024); } while (0)
#define PG8_LDB(dst, b, h) do { _Pragma("unroll") for (int n = 0; n < 2; ++n) _Pragma("unroll") for (int k = 0; k < 2; ++k) dst[n][k] = *(const PG8_LAS bf16x8*)(lds + PG8_SB(b, h) + boff + n * 2048 + k * 1024); } while (0)
#define PG8_MMA(ai, bj, At, Bt) do { __builtin_amdgcn_s_setprio(1); _Pragma("unroll") for (int m = 0; m < 4; ++m) _Pragma("unroll") for (int n = 0; n < 2; ++n) _Pragma("unroll") for (int k = 0; k < 2; ++k) \
        acc[ai][bj][m][n] = __builtin_amdgcn_mfma_f32_16x16x32_bf16(Bt[n][k], At[m][k], acc[ai][bj][m][n], 0, 0, 0); __builtin_amdgcn_s_setprio(0); } while (0)
#define PG8_WAIT_V(n) asm volatile("s_waitcnt vmcnt(" #n ")" ::: "memory")
#define PG8_WAIT_L(n) asm volatile("s_waitcnt lgkmcnt(" #n ")" ::: "memory")
#define PG8_BAR __builtin_amdgcn_s_barrier()
#define PG8_SCHED __builtin_amdgcn_sched_barrier(0)
    Unit cur, nxt; int ui = 0;
    if (!S.next(0, cur)) return;
    f32x4 acc[2][2][4][2];
#pragma unroll
    for (int a = 0; a < 2; ++a)
#pragma unroll
        for (int b = 0; b < 2; ++b)
#pragma unroll
            for (int m = 0; m < 4; ++m)
#pragma unroll
                for (int n = 0; n < 2; ++n) acc[a][b][m][n] = (f32x4){0.f, 0.f, 0.f, 0.f};
    bf16x8 At[4][2], B0[2][2], B1[2][2];
    const char* cA = (const char*)g.A + (size_t)cur.pm * tstepA + (size_t)cur.ka * 2; const char* cB = (const char*)g.Bt + (size_t)cur.pn * tstepB + (size_t)cur.ka * 2;
    S.a_ready(cur);
    if constexpr (SP2) {
        PG8_STAGE(PG8_SB(0, 0), cB, voffB); PG8_STAGE(PG8_SB(0, 1), cB + hstepB, voffB); PG8_STAGE(PG8_SA(0, 0), cA, voffA); PG8_STAGE(PG8_SA(0, 1), cA + hstepA, voffA);
        if (wr == 1) PG8_BAR;
        PG8_WAIT_V(2); PG8_BAR;
        PG8_STAGE(PG8_SB(1, 0), cB + kstep, voffB); PG8_STAGE(PG8_SA(1, 0), cA + kstep, voffA); PG8_STAGE(PG8_SB(1, 1), cB + hstepB + kstep, voffB);
        PG8_WAIT_V(6); PG8_BAR;
    } else {
        PG8_STAGE(PG8_SB(0, 0), cB, voffB); PG8_STAGE(PG8_SA(0, 0), cA, voffA); PG8_STAGE(PG8_SB(0, 1), cB + hstepB, voffB); PG8_STAGE(PG8_SA(0, 1), cA + hstepA, voffA);
        if (wr == 1) PG8_BAR;
        PG8_WAIT_V(4); PG8_BAR;
        PG8_STAGE(PG8_SB(1, 0), cB + kstep, voffB); PG8_STAGE(PG8_SA(1, 0), cA + kstep, voffA); PG8_STAGE(PG8_SB(1, 1), cB + hstepB + kstep, voffB);
        PG8_WAIT_V(6); PG8_BAR;
    }
    for (;;) {
        const bool has_next = S.next(ui + 1, nxt);
        const char* nA = has_next ? (const char*)g.A + (size_t)nxt.pm * tstepA + (size_t)nxt.ka * 2 : cA; const char* nB = has_next ? (const char*)g.Bt + (size_t)nxt.pn * tstepB + (size_t)nxt.ka * 2 : cB;
        for (int t = 0; t < nt; t += 2) {
            const bool last = (t == nt - 2);
            if constexpr (Epi::KSEG > 0) { if (t > 0 && (t % Epi::KSEG) == 0) E.kseg(acc, cur, t / Epi::KSEG, wr, wc, fr, fq); }
            const char* a1 = cA + (size_t)(t + 1) * kstep;
            const char* a2 = last ? nA : cA + (size_t)(t + 2) * kstep; const char* b2 = last ? nB : cB + (size_t)(t + 2) * kstep;
            const char* a3 = a2 + kstep; const char* b3 = b2 + kstep;
            if (last && has_next) S.a_ready(nxt);
            if constexpr (SP2) {
            PG8_LDB(B0, 0, 0); PG8_LDB(B1, 0, 1); PG8_SCHED; PG8_LDA(At, 0, 0); PG8_STAGE(PG8_SA(1, 1), a1 + hstepA, voffA);
            PG8_WAIT_V(8); PG8_WAIT_L(0); PG8_BAR; PG8_MMA(0, 0, At, B0); PG8_MMA(0, 1, At, B1); PG8_BAR; PG8_SCHED;
            PG8_LDA(At, 0, 1); PG8_STAGE(PG8_SB(0, 0), b2, voffB); PG8_STAGE(PG8_SB(0, 1), b2 + hstepB, voffB); PG8_STAGE(PG8_SA(0, 0), a2, voffA);
            PG8_WAIT_V(8); PG8_WAIT_L(0); PG8_BAR; PG8_MMA(1, 0, At, B0); PG8_MMA(1, 1, At, B1); PG8_BAR; PG8_SCHED;
            PG8_LDB(B0, 1, 0); PG8_LDB(B1, 1, 1); PG8_SCHED; PG8_LDA(At, 1, 0); PG8_STAGE(PG8_SA(0, 1), a2 + hstepA, voffA);
            PG8_WAIT_V(8); PG8_WAIT_L(0); PG8_BAR; PG8_MMA(0, 0, At, B0); PG8_MMA(0, 1, At, B1); PG8_BAR; PG8_SCHED;
            PG8_LDA(At, 1, 1); PG8_STAGE(PG8_SB(1, 0), b3, voffB); PG8_STAGE(PG8_SB(1, 1), b3 + hstepB, voffB); PG8_STAGE(PG8_SA(1, 0), a3, voffA);
            PG8_WAIT_V(8); PG8_WAIT_L(0); PG8_BAR; PG8_MMA(1, 0, At, B0); PG8_MMA(1, 1, At, B1); PG8_BAR; PG8_SCHED;
            } else {
            PG8_LDB(B0, 0, 0); PG8_SCHED; PG8_LDA(At, 0, 0); PG8_STAGE(PG8_SA(1, 1), a1 + hstepA, voffA);
            PG8_WAIT_L(8); PG8_BAR; PG8_WAIT_L(0); PG8_MMA(0, 0, At, B0); PG8_BAR; PG8_SCHED;
            PG8_LDB(B1, 0, 1); PG8_STAGE(PG8_SB(0, 0), b2, voffB);
            PG8_BAR; PG8_WAIT_L(0); PG8_MMA(0, 1, At, B1); PG8_BAR;
            PG8_LDA(At, 0, 1); PG8_STAGE(PG8_SA(0, 0), a2, voffA);
            PG8_BAR; PG8_WAIT_L(0); PG8_MMA(1, 0, At, B0); PG8_BAR; PG8_SCHED;
            PG8_STAGE(PG8_SB(0, 1), b2 + hstepB, voffB);
            PG8_WAIT_V(6); PG8_BAR; PG8_MMA(1, 1, At, B1); PG8_BAR;
            PG8_LDB(B0, 1, 0); PG8_SCHED; PG8_LDA(At, 1, 0); PG8_STAGE(PG8_SA(0, 1), a2 + hstepA, voffA);
            PG8_WAIT_L(8); PG8_BAR; PG8_WAIT_L(0); PG8_MMA(0, 0, At, B0); PG8_BAR; PG8_SCHED;
            PG8_LDB(B1, 1, 1); PG8_STAGE(PG8_SB(1, 0), b3, voffB);
            PG8_BAR; PG8_WAIT_L(0); PG8_MMA(0, 1, At, B1); PG8_BAR;
            PG8_LDA(At, 1, 1); PG8_STAGE(PG8_SA(1, 0), a3, voffA);
            PG8_BAR; PG8_WAIT_L(0); PG8_MMA(1, 0, At, B0); PG8_BAR; PG8_SCHED;
            PG8_STAGE(PG8_SB(1, 1), b3 + hstepB, voffB);
            PG8_WAIT_V(6); PG8_BAR; PG8_MMA(1, 1, At, B1); PG8_BAR;
            }
        }
        if constexpr (ALIGN_EPI) { if (wr == 0) PG8_BAR; }
        if constexpr (!Epi::AFTER_DRAIN) { E(acc, cur, wr, wc, fr, fq); S.done(cur); }
        if (!has_next) break;
#pragma unroll
        for (int a = 0; a < 2; ++a)
#pragma unroll
            for (int b = 0; b < 2; ++b)
#pragma unroll
                for (int m = 0; m < 4; ++m)
#pragma unroll
                    for (int n = 0; n < 2; ++n) acc[a][b][m][n] = (f32x4){0.f, 0.f, 0.f, 0.f};
        cur = nxt; cA = nA; cB = nB; ++ui;
        if constexpr (ALIGN_EPI) { if (wr == 1) PG8_BAR; }
    }
    PG8_WAIT_V(0);
    if constexpr (!ALIGN_EPI) { if (wr == 0) PG8_BAR; }
    PG8_BAR;
    if constexpr (Epi::AFTER_DRAIN) { E.fused(acc, cur, wr, wc, fr, fq, lds, wid, lane); S.done(cur); }
#undef PG8_SA
#undef PG8_SB
#undef PG8_STAGE
#undef PG8_LDA
#undef PG8_LDB
#undef PG8_MMA
#undef PG8_WAIT_V
#undef PG8_WAIT_L
#undef PG8_BAR
#undef PG8_SCHED
}
}

constexpr int NWAVES = 8;
constexpr int D = 2048, NBATCH = 4, SEQ = 4096, DEPTH = 4, CTXL = 256;
constexpr int MLAT = NBATCH * SEQ, MCTX = NBATCH * CTXL, MTOT = MLAT + MCTX;
constexpr int INW = 12288, BW = 1024, FFH = 5632, NHEAD = 8;
constexpr int Q_OFF = 0, K_OFF = 1024, V_OFF = 2048, BU_OFF = 3072, C_OFF = 5120, G_OFF = 6144;
constexpr int YW = 3 * BW;
constexpr float LN_EPS = 1e-6f;
constexpr float ALPHA = 1.681792830507429f;
constexpr float QSCALE = 0.125f * 1.4426950408889634f;

constexpr size_t MiB = 1u << 20;
constexpr size_t WS_CTL = 0, CTL_ZERO_BYTES = 1 * MiB;
constexpr size_t WS_ROPE = 1 * MiB;
constexpr size_t WS_MODS = 2 * MiB;
constexpr size_t WS_MODP = 4 * MiB;
constexpr size_t WS_WSP = 20 * MiB;
constexpr size_t WS_WPOOL = 21 * MiB;
constexpr size_t WS_WIN = 24 * MiB;
constexpr size_t WS_WBR = 216 * MiB;
constexpr size_t WS_WOUT = 264 * MiB;
constexpr size_t WS_WGU = 296 * MiB;
constexpr size_t WS_WDN = 472 * MiB;
constexpr size_t WS_X = 560 * MiB;
constexpr size_t WS_HA = 696 * MiB;
constexpr size_t WS_Y = 764 * MiB;
constexpr size_t WS_MG = 866 * MiB;
constexpr size_t WS_Z = 934 * MiB;
constexpr size_t WS_KB = 1342 * MiB, WS_VB = 1378 * MiB;
constexpr size_t WS_END = 1414 * MiB;
static_assert(WS_MODP + 16ull * 4 * 5 * 12288 * 4 <= WS_WSP && WS_WIN + 4ull * 12288 * 2048 * 2 <= WS_WBR && WS_WBR + 4ull * 2048 * 3072 * 2 <= WS_WOUT && WS_WOUT + 4ull * 2048 * 2048 * 2 <= WS_WGU, "ws map 1");
static_assert(WS_WGU + 4ull * 11264 * 2048 * 2 <= WS_WDN && WS_WDN + 4ull * 2048 * 5632 * 2 <= WS_X && WS_X + (size_t)MTOT * D * 4 <= WS_HA && WS_HA + (size_t)MTOT * D * 2 <= WS_Y, "ws map 2");
static_assert(WS_Y + (size_t)MTOT * YW * 2 <= WS_MG && WS_MG + (size_t)MTOT * D * 2 <= WS_Z && WS_Z + (size_t)MTOT * INW * 2 <= WS_KB && WS_KB + 32ull * 4352 * 256 <= WS_VB && WS_VB + 32ull * 4352 * 256 <= WS_END, "ws map 3");
constexpr int CW_BAR = 4096;

constexpr int RING_OFF = 0, RING_BYTES = 131072;
constexpr int LDSCTL_OFF = RING_BYTES, MISC_OFF = LDSCTL_OFF + 320;
constexpr int LDS_BYTES = 147456;

#define GAS __attribute__((address_space(1)))
#define LAS __attribute__((address_space(3)))
typedef unsigned short bf16;
typedef unsigned v4u __attribute__((ext_vector_type(4)));
typedef unsigned v2u __attribute__((ext_vector_type(2)));
typedef float f32x4 __attribute__((ext_vector_type(4)));
typedef float f32x16 __attribute__((ext_vector_type(16)));
typedef short bf16x8 __attribute__((ext_vector_type(8)));
typedef short s16x4 __attribute__((ext_vector_type(4)));
typedef GAS unsigned gu32;
#define RLX_AGENT __ATOMIC_RELAXED, __HIP_MEMORY_SCOPE_AGENT
#define LDS_WAIT() asm volatile("s_waitcnt lgkmcnt(0)" ::: "memory")
#define VM_WAIT() asm volatile("s_waitcnt vmcnt(0)" ::: "memory")
__device__ __forceinline__ unsigned f2bf(float f) { unsigned u = __builtin_bit_cast(unsigned, f); return (u + 0x7fffu + ((u >> 16) & 1u)) >> 16; }
__device__ __forceinline__ unsigned pk2(float lo, float hi) { return f2bf(lo) | (f2bf(hi) << 16); }
__device__ __forceinline__ unsigned cvtpk(float lo, float hi) { unsigned r; asm volatile("v_cvt_pk_bf16_f32 %0, %1, %2" : "=v"(r) : "v"(lo), "v"(hi)); return r; }
__device__ __forceinline__ float bflo(unsigned w) { return __uint_as_float(w << 16); }
__device__ __forceinline__ float bfhi(unsigned w) { return __uint_as_float(w & 0xffff0000u); }

#define XB_TMO      128
#define XB_XCNT(j)  (256  + 64 * (j))
#define XB_XSUB(j)  (1280 + 64 * (j))
#define XB_XGEN(j)  (2304 + 64 * (j))
#define XB_TOP      3328
#define XB_TOPGEN   3392
#define XCD_BAR_WORDS 3456
#define XB_SPIN_CAP (1u << 18)

__device__ __forceinline__ unsigned xb_ld(unsigned* p)              { return __hip_atomic_load(p, __ATOMIC_RELAXED, __HIP_MEMORY_SCOPE_AGENT); }
__device__ __forceinline__ unsigned xb_add(unsigned* p, unsigned v) { return __hip_atomic_fetch_add(p, v, __ATOMIC_RELAXED, __HIP_MEMORY_SCOPE_AGENT); }
__device__ __forceinline__ unsigned xb_xcc_id() { return (unsigned)__builtin_amdgcn_s_getreg((3 << 11) | 20) & 0xFu; }
#define XB_SPIN(cond, bar) do { unsigned _sp = 0; while (cond) { __builtin_amdgcn_s_sleep(1); \
    if ((++_sp & 255u) == 0u) { if (xb_ld(&(bar)[XB_TMO])) break; if (_sp > XB_SPIN_CAP) { atomicAdd(&(bar)[XB_TMO], 1u); break; } } } } while (0)

struct XcdBarrier {
    unsigned* bar; unsigned x;
    volatile LAS unsigned* st;
};

__device__ __forceinline__ XcdBarrier xcd_barrier_post(unsigned* bar, volatile LAS unsigned* st) {
    XcdBarrier b; b.bar = bar; b.x = xb_xcc_id(); b.st = st;
    if (threadIdx.x == 0) (void)xb_add(&bar[XB_XCNT(b.x)], 1u);
    return b;
}
__device__ __forceinline__ void xcd_barrier_complete(unsigned* bar, unsigned x, unsigned& nloc, unsigned& nx) {
    const unsigned G = gridDim.x * gridDim.y * gridDim.z;
    unsigned sum, cnt, mine, sp = 0u;
    for (;;) {
        sum = 0u; cnt = 0u; mine = 0u;
#pragma unroll
        for (unsigned j = 0; j < 16; ++j) { const unsigned c = xb_ld(&bar[XB_XCNT(j)]); sum += c; cnt += (c > 0u) ? 1u : 0u; mine = (j == x) ? c : mine; }
        if (sum == G) break;
        __builtin_amdgcn_s_sleep(1);
        if ((++sp & 255u) == 0u) { if (xb_ld(&bar[XB_TMO])) break; if (sp > XB_SPIN_CAP) { atomicAdd(&bar[XB_TMO], 1u); break; } }
    }
    nloc = mine > 0u ? mine : 1u; nx = cnt > 0u ? cnt : 1u;
}

__device__ __forceinline__ void xcd_barrier(const XcdBarrier& b) {
    asm volatile("s_waitcnt vmcnt(0)" ::: "memory");
    __syncthreads();
    if (threadIdx.x == 0) {
        unsigned* bar = b.bar;
        __builtin_amdgcn_s_waitcnt(0);
        unsigned nloc = b.st[0], nx = b.st[1];
        if (nloc == 0u) { xcd_barrier_complete(bar, b.x, nloc, nx); b.st[0] = nloc; b.st[1] = nx; }
        const unsigned old = xb_add(&bar[XB_XSUB(b.x)], 1u);
        const unsigned gen = old / nloc;
        if (old + 1u == (gen + 1u) * nloc) {
            __builtin_amdgcn_fence(__ATOMIC_RELEASE, "agent");
            asm volatile("s_waitcnt vmcnt(0)" ::: "memory");
            const unsigned og = xb_add(&bar[XB_TOP], 1u);
            const unsigned tg = og / nx;
            if (og + 1u == (tg + 1u) * nx) xb_add(&bar[XB_TOPGEN], 1u);
            else XB_SPIN(xb_ld(&bar[XB_TOPGEN]) == tg, bar);
            __builtin_amdgcn_fence(__ATOMIC_ACQUIRE, "agent");
            xb_add(&bar[XB_XGEN(b.x)], 1u);
            asm volatile("s_waitcnt vmcnt(0)" ::: "memory");
        } else {
            XB_SPIN(xb_ld(&bar[XB_XGEN(b.x)]) == gen, bar);
            __builtin_amdgcn_fence(__ATOMIC_ACQUIRE, "agent");
            asm volatile("s_waitcnt vmcnt(0)" ::: "memory");
        }
    }
    __syncthreads();
}


struct Frame {
    LAS unsigned char* lds;
    volatile LAS unsigned* MISC;
    gu32* ctl;
    int vcu, G, bx;
    __device__ __forceinline__ int ltid() const { int t = threadIdx.x; asm volatile("" : "+v"(t)); return t; }
    const float *x, *c, *ctx, *cctx, *w_ada, *b_ada, *w_in, *lam_qk, *subln_g, *gln_g, *gln_b, *w_sp, *b_sp, *w_pool, *pool_scale, *w_branch, *w_out, *ln1_g, *ln1_b, *w_gu, *w_down, *ln2_g, *ln2_b;
    float* out;
    float *rope, *mods, *modp, *X;
    bf16 *Wsp, *Wpool, *Win, *Wbr, *Wout, *Wgu, *Wdn, *HA, *Y, *MG, *Z, *KB, *VB;
};

typedef __attribute__((address_space(4))) const unsigned char* kptr_t;
__device__ __forceinline__ void frame_ptrs(Frame& F) {
    kptr_t kp = (kptr_t)__builtin_amdgcn_kernarg_segment_ptr(); asm volatile("" : "+s"(kp));
#define KIN(i) (*(const float* const __attribute__((address_space(4)))*)(kp + 8 * (i)))
    F.x = KIN(0); F.c = KIN(1); F.ctx = KIN(2); F.cctx = KIN(3); F.w_ada = KIN(4); F.b_ada = KIN(5); F.w_in = KIN(6); F.lam_qk = KIN(7); F.subln_g = KIN(8);
    F.gln_g = KIN(9); F.gln_b = KIN(10); F.w_sp = KIN(11); F.b_sp = KIN(12); F.w_pool = KIN(13); F.pool_scale = KIN(14); F.w_branch = KIN(15); F.w_out = KIN(16);
    F.ln1_g = KIN(17); F.ln1_b = KIN(18); F.w_gu = KIN(19); F.w_down = KIN(20); F.ln2_g = KIN(21); F.ln2_b = KIN(22);
#undef KIN
    F.out = *(float* const __attribute__((address_space(4)))*)(kp + 184);
    unsigned char* ws = *(unsigned char* const __attribute__((address_space(4)))*)(kp + 192);
    F.rope = (float*)(ws + WS_ROPE); F.mods = (float*)(ws + WS_MODS); F.modp = (float*)(ws + WS_MODP); F.X = (float*)(ws + WS_X);
    F.Wsp = (bf16*)(ws + WS_WSP); F.Wpool = (bf16*)(ws + WS_WPOOL); F.Win = (bf16*)(ws + WS_WIN); F.Wbr = (bf16*)(ws + WS_WBR); F.Wout = (bf16*)(ws + WS_WOUT); F.Wgu = (bf16*)(ws + WS_WGU); F.Wdn = (bf16*)(ws + WS_WDN);
    F.HA = (bf16*)(ws + WS_HA); F.Y = (bf16*)(ws + WS_Y); F.MG = (bf16*)(ws + WS_MG); F.Z = (bf16*)(ws + WS_Z); F.KB = (bf16*)(ws + WS_KB); F.VB = (bf16*)(ws + WS_VB);
}
__device__ __forceinline__ float wave_sum(float v) {
    v += __builtin_bit_cast(float, __builtin_amdgcn_update_dpp(0, __builtin_bit_cast(int, v), 0xB1, 0xF, 0xF, true));
    v += __builtin_bit_cast(float, __builtin_amdgcn_update_dpp(0, __builtin_bit_cast(int, v), 0x4E, 0xF, 0xF, true));
    v += __builtin_bit_cast(float, __builtin_amdgcn_update_dpp(0, __builtin_bit_cast(int, v), 0x141, 0xF, 0xF, true));
    v += __builtin_bit_cast(float, __builtin_amdgcn_update_dpp(0, __builtin_bit_cast(int, v), 0x140, 0xF, 0xF, true));
    v += __shfl_xor(v, 16);
    { auto rr = __builtin_amdgcn_permlane32_swap(__float_as_uint(v), __float_as_uint(v), false, false); v = __uint_as_float(rr[0]) + __uint_as_float(rr[1]); }
    return v;
}

__device__ __forceinline__ void cvt_item(const float* W, int N, int k0, int ncol0, bool perm, bf16* WT, size_t drow0, int ldk, int dk0, LAS float* scr, int lane) {
#pragma unroll 8
    for (int i = 0; i < 32; ++i) { const int kk = 2 * i + (lane >> 5); scr[kk * 33 + (lane & 31)] = __builtin_nontemporal_load(W + (size_t)(k0 + kk) * N + ncol0 + (lane & 31)); }
    LDS_WAIT(); asm volatile("" ::: "memory");
    const int c = lane & 7;
#pragma unroll
    for (int j = 0; j < 4; ++j) { const int n = (lane >> 3) + 8 * j; const int ns = perm ? ((n & 1) * 16 + (n >> 1)) : n; const LAS float* s = scr + (8 * c) * 33 + ns;
        v4u o; o.x = pk2(s[0 * 33], s[1 * 33]); o.y = pk2(s[2 * 33], s[3 * 33]); o.z = pk2(s[4 * 33], s[5 * 33]); o.w = pk2(s[6 * 33], s[7 * 33]);
        *(GAS v4u*)(WT + (drow0 + n) * (size_t)ldk + dk0 + k0 + 8 * c) = o; }
    LDS_WAIT(); asm volatile("" ::: "memory");
}
constexpr int CV_IN = 32 * 384, CV_GU = 32 * 352, CV_DN = 88 * 64, CV_BR = 3 * 16 * 64, CV_OUT = 32 * 64, CV_POOL = 4 * 4 * 8, CV_LAYER = CV_IN + CV_GU + CV_DN + CV_BR + CV_OUT + CV_POOL;
__device__ __forceinline__ void cvt_dispatch(Frame& F, int it, LAS float* scr) {
    const int l = it / CV_LAYER; int r = it - l * CV_LAYER;
    if (r < CV_IN) { const int kb = r / 384, nb = r - kb * 384;
        cvt_item(F.w_in + (size_t)l * D * INW, INW, 64 * kb, 32 * nb, nb < 64, F.Win + (size_t)l * INW * D, (size_t)32 * nb, D, 0, scr, (F.ltid() & 63)); return; }
    r -= CV_IN;
    if (r < CV_GU) { const int kb = r / 352, nb = r - kb * 352; const int tpn = nb >> 3, half = (nb >> 2) & 1, jj0 = (nb & 3) * 32;
        cvt_item(F.w_gu + (size_t)l * D * 2 * FFH, 2 * FFH, 64 * kb, half * FFH + 128 * tpn + jj0, false, F.Wgu + (size_t)l * 2 * FFH * D, (size_t)32 * nb, D, 0, scr, (F.ltid() & 63)); return; }
    r -= CV_GU;
    if (r < CV_DN) { const int kb = r >> 6, nb = r & 63;
        cvt_item(F.w_down + (size_t)l * FFH * D, D, 64 * kb, 32 * nb, false, F.Wdn + (size_t)l * D * FFH, (size_t)32 * nb, FFH, 0, scr, (F.ltid() & 63)); return; }
    r -= CV_DN;
    if (r < CV_BR) { const int n = r >> 10, rr = r & 1023, kb = rr >> 6, nb = rr & 63;
        cvt_item(F.w_branch + ((size_t)l * 3 + n) * BW * D, D, 64 * kb, 32 * nb, false, F.Wbr + (size_t)l * D * YW, (size_t)32 * nb, YW, BW * n, scr, (F.ltid() & 63)); return; }
    r -= CV_BR;
    if (r < CV_OUT) { const int kb = r >> 6, nb = r & 63;
        cvt_item(F.w_out + (size_t)l * D * D, D, 64 * kb, 32 * nb, false, F.Wout + (size_t)l * D * D, (size_t)32 * nb, D, 0, scr, (F.ltid() & 63)); return; }
    r -= CV_OUT;
    { const int g = r >> 5, rr = r & 31, kb = rr >> 3, nb = rr & 7;
        cvt_item(F.w_pool + ((size_t)l * 4 + g) * 65536, 256, 64 * kb, 32 * nb, false, F.Wpool + ((size_t)l * 4 + g) * 65536, (size_t)32 * nb, 256, 0, scr, (F.ltid() & 63)); }
}

__device__ __forceinline__ double rope_inv(int p) {
    const double t[16] = {1.0, 0.5623413251903491, 0.31622776601683794, 0.1778279410038923, 0.1, 0.05623413251903491, 0.03162277660168379, 0.01778279410038923,
                          0.01, 0.005623413251903491, 0.003162277660168379, 0.001778279410038923, 0.001, 0.0005623413251903491, 0.00031622776601683794, 0.0001778279410038923};
    double r = t[0];
#pragma unroll
    for (int i = 1; i < 16; ++i) r = (p == i) ? t[i] : r;
    return r;
}
#ifndef TAILWORK
#define TAILWORK 0
#endif
__device__ __forceinline__ void ada_partial_layer(Frame& F, int l, int gw, int NGW) {
    LAS float* scs = (LAS float*)(F.lds);
    __syncthreads();
    for (int i = F.ltid(); i < 5 * D; i += NWAVES * 64) { const int g = i >> 11, k = i & 2047; const float v = g < 4 ? F.c[g * D + k] : F.cctx[k]; scs[i] = v / (1.0f + __expf(-v)); }
    __syncthreads();
    for (int it = gw; it < 16 * 48; it += NGW) {
        const int ks = it / 48, cgw = it - ks * 48; const int col = cgw * 256 + (F.ltid() & 63) * 4;
        const float* wp = F.w_ada + ((size_t)l * D + ks * 128) * INW + col;
        f32x4 a0 = {0.f, 0.f, 0.f, 0.f}, a1 = a0, a2 = a0, a3 = a0, a4 = a0;
#pragma unroll 8
        for (int k = 0; k < 128; ++k) { const f32x4 w = __builtin_nontemporal_load((const GAS f32x4*)(wp + (size_t)k * INW)); const int kk = ks * 128 + k;
            a0 += w * scs[kk]; a1 += w * scs[D + kk]; a2 += w * scs[2 * D + kk]; a3 += w * scs[3 * D + kk]; a4 += w * scs[4 * D + kk]; }
        float* pp = F.modp + (((size_t)ks * 4 + l) * 5) * INW + col;
        *(f32x4*)(pp) = a0; *(f32x4*)(pp + INW) = a1; *(f32x4*)(pp + 2 * INW) = a2; *(f32x4*)(pp + 3 * INW) = a3; *(f32x4*)(pp + 4 * INW) = a4;
    }
    __syncthreads();
}
__device__ __forceinline__ void cvt_layer(Frame& F, int l, int gw, int NGW) {
    LAS float* scr = (LAS float*)(F.lds + __builtin_amdgcn_readfirstlane(F.ltid() >> 6) * 16384);
    for (int it = gw; it < CV_LAYER; it += NGW) cvt_dispatch(F, l * CV_LAYER + it, scr);
}
__device__ __forceinline__ void mods_reduce_layer(Frame& F, int l) {
    const int gt = F.vcu * NWAVES * 64 + F.ltid(), NGT = F.G * NWAVES * 64;
    for (int i = gt; i < 5 * (INW / 4); i += NGT) { const int g = i / (INW / 4), j = (i - g * (INW / 4)) * 4;
        f32x4 sm = *(const f32x4*)(F.b_ada + (size_t)l * INW + j);
#pragma unroll
        for (int ks = 0; ks < 16; ++ks) sm += *(const f32x4*)(F.modp + (((size_t)ks * 4 + l) * 5 + g) * INW + j);
        *(f32x4*)(F.mods + ((size_t)l * 5 + g) * INW + j) = sm; }
}
__device__ __forceinline__ void phase_a1(Frame& F) {
    const int gw = F.vcu * NWAVES + __builtin_amdgcn_readfirstlane(F.ltid() >> 6), NGW = F.G * NWAVES;
#pragma nounroll
    for (int l = 0; l < (TAILWORK ? 1 : DEPTH); ++l) ada_partial_layer(F, l, gw, NGW);
#pragma nounroll
    for (int l = 0; l < (TAILWORK ? 1 : DEPTH); ++l) cvt_layer(F, l, gw, NGW);
    for (int it = gw; it < (DEPTH * 8 * 128 * 128) / 512; it += NGW) { const size_t e = (size_t)it * 512 + (F.ltid() & 63) * 8;
        const f32x4 a = *(const f32x4*)(F.w_sp + e), b = *(const f32x4*)(F.w_sp + e + 4);
        v4u o; o.x = pk2(a[0], a[1]); o.y = pk2(a[2], a[3]); o.z = pk2(b[0], b[1]); o.w = pk2(b[2], b[3]); *(v4u*)(F.Wsp + e) = o; }
    if (gw == 0) {
        for (int e = (F.ltid() & 63); e < 1024; e += 64) { const int pos = e >> 4, pr = e & 15;
            const double ang = (double)pos * rope_inv(pr); const double twopi = 6.283185307179586476925286766559;
            const double kq = __builtin_rint(ang / twopi); const double rr = ang - kq * twopi; const double r2 = rr * rr;
            double sn = 1.0, cs = 1.0;
#pragma unroll
            for (int n = 14; n >= 1; --n) { sn = 1.0 - sn * r2 / (double)((2 * n) * (2 * n + 1)); cs = 1.0 - cs * r2 / (double)((2 * n - 1) * (2 * n)); }
            sn *= rr;
            F.rope[2 * e] = (float)cs; F.rope[2 * e + 1] = (float)sn; }
    }
}
__device__ __forceinline__ void phase_a2(Frame& F) {
#pragma nounroll
    for (int l = 0; l < (TAILWORK ? 1 : DEPTH); ++l) mods_reduce_layer(F, l); }
__device__ __forceinline__ void ln_row(const float* src, const bf16* tadd, const float* part, int npart, const float* gam, const float* bet, float* xo, float xs, bf16* ho, const float* sc, const float* sh, int lane) {
    f32x4 v[8]; float s = 0.f;
#pragma unroll
    for (int j = 0; j < 8; ++j) v[j] = __builtin_nontemporal_load((const GAS f32x4*)(src + 4 * lane + 256 * j));
    if (tadd) {
#pragma unroll
        for (int j = 0; j < 8; ++j) { const v2u t2 = *(const GAS v2u*)(tadd + 4 * lane + 256 * j); v[j] += (f32x4){bflo(t2.x), bfhi(t2.x), bflo(t2.y), bfhi(t2.y)}; } }
    for (int p = 0; p < npart; ++p) {
#pragma unroll
        for (int j = 0; j < 8; ++j) v[j] += __builtin_nontemporal_load((const GAS f32x4*)(part + (size_t)p * 1024 * D + 4 * lane + 256 * j)); }
#pragma unroll
    for (int j = 0; j < 8; ++j) s += (v[j][0] + v[j][1]) + (v[j][2] + v[j][3]);
    const float mean = wave_sum(s) * (1.f / D); float s2 = 0.f;
#pragma unroll
    for (int j = 0; j < 8; ++j) { v[j] = v[j] - mean; s2 += (v[j][0] * v[j][0] + v[j][1] * v[j][1]) + (v[j][2] * v[j][2] + v[j][3] * v[j][3]); }
    const float rstd = 1.0f / sqrtf(wave_sum(s2) * (1.f / D) + LN_EPS);
#pragma unroll
    for (int j = 0; j < 8; ++j) { const int col = 4 * lane + 256 * j; f32x4 xn = v[j] * rstd;
        if (gam) xn = xn * *(const f32x4*)(gam + col) + *(const f32x4*)(bet + col);
        if (xo) __builtin_nontemporal_store(xn * xs, (GAS f32x4*)(xo + col));
        if (ho) { const f32x4 hv = xn * (1.0f + *(const f32x4*)(sc + col)) + *(const f32x4*)(sh + col); v2u o; o.x = pk2(hv[0], hv[1]); o.y = pk2(hv[2], hv[3]); __builtin_nontemporal_store(o, (GAS v2u*)(ho + col)); } }
}
__device__ __forceinline__ int row_group(int row) { return row < MLAT ? (row >> 12) : 4; }
__device__ __forceinline__ void phase_a3(Frame& F) {
    const int gw = F.vcu * NWAVES + __builtin_amdgcn_readfirstlane(F.ltid() >> 6), NGW = F.G * NWAVES;
    for (int row = gw; row < MTOT; row += NGW) { const float* src = row < MLAT ? F.x + (size_t)row * D : F.ctx + (size_t)(row - MLAT) * D; const float* md = F.mods + (size_t)row_group(row) * INW;
        ln_row(src, nullptr, nullptr, 0, nullptr, nullptr, F.X + (size_t)row * D, ALPHA, F.HA + (size_t)row * D, md + D, md, (F.ltid() & 63)); }
}
#ifndef LN_NT
#define LN_NT 1
#endif
#if LN_NT
#define LN_LD(p) __builtin_nontemporal_load(p)
#define LN_ST(p, v) __builtin_nontemporal_store((v), (p))
#else
#define LN_LD(p) (*(p))
#define LN_ST(p, v) (*(p) = (v))
#endif
__device__ __forceinline__ void ln_finish(f32x4 (&v)[8], const float* gam, const float* bet, float* xo, float xs, bf16* ho, const float* sc, const float* sh, int lane) {
    float s = 0.f;
#pragma unroll
    for (int j = 0; j < 8; ++j) s += (v[j][0] + v[j][1]) + (v[j][2] + v[j][3]);
    const float mean = wave_sum(s) * (1.f / D); float s2 = 0.f;
#pragma unroll
    for (int j = 0; j < 8; ++j) { v[j] = v[j] - mean; s2 += (v[j][0] * v[j][0] + v[j][1] * v[j][1]) + (v[j][2] * v[j][2] + v[j][3] * v[j][3]); }
    const float rstd = 1.0f / sqrtf(wave_sum(s2) * (1.f / D) + LN_EPS);
#pragma unroll
    for (int j = 0; j < 8; ++j) { const int col = 4 * lane + 256 * j; f32x4 xn = v[j] * rstd;
        xn = xn * *(const f32x4*)(gam + col) + *(const f32x4*)(bet + col);
        if (xo) LN_ST((GAS f32x4*)(xo + col), xn * xs);
        if (ho) { const f32x4 hv = xn * (1.0f + *(const f32x4*)(sc + col)) + *(const f32x4*)(sh + col); v2u o; o.x = pk2(hv[0], hv[1]); o.y = pk2(hv[2], hv[3]); LN_ST((GAS v2u*)(ho + col), o); } }
}
__device__ __forceinline__ void phase_ln(Frame& F, const float* gam, const float* bet, int nrows, bool to_out, bool want_h, int lm, int moff, int nsplit, bool dry = false) {
    const int gw = F.vcu * NWAVES + __builtin_amdgcn_readfirstlane(F.ltid() >> 6), NGW = F.G * NWAVES; const int lane = F.ltid() & 63;
    f32x4 xa[8]; v2u ta[8];
    int row = gw;
    if (row < MLAT) {
#pragma unroll
        for (int j = 0; j < 8; ++j) { xa[j] = LN_LD((const GAS f32x4*)(F.X + (size_t)row * D + 4 * lane + 256 * j)); ta[j] = LN_LD((const GAS v2u*)(F.Y + (size_t)row * D + 4 * lane + 256 * j)); } }
    for (; row < MLAT; row += NGW) {
        f32x4 v[8];
#pragma unroll
        for (int j = 0; j < 8; ++j) v[j] = xa[j] + (f32x4){bflo(ta[j].x), bfhi(ta[j].x), bflo(ta[j].y), bfhi(ta[j].y)};
        const int nx = row + NGW;
        if (nx < MLAT) {
#pragma unroll
            for (int j = 0; j < 8; ++j) { xa[j] = LN_LD((const GAS f32x4*)(F.X + (size_t)nx * D + 4 * lane + 256 * j)); ta[j] = LN_LD((const GAS v2u*)(F.Y + (size_t)nx * D + 4 * lane + 256 * j)); } }
        const float* md = F.mods + ((size_t)lm * 5 + (row >> 12)) * INW + moff;
        ln_finish(v, gam, bet, dry ? (float*)(F.Z + (size_t)134 * MiB) + (size_t)row * D : (to_out ? F.out + (size_t)row * D : F.X + (size_t)row * D), to_out ? 1.0f : ALPHA, want_h ? (dry ? F.MG : F.HA) + (size_t)row * D : nullptr, md + D, md, lane);
    }
    for (; row < nrows; row += NGW) { const float* md = F.mods + ((size_t)lm * 5 + 4) * INW + moff;
        ln_row(F.X + (size_t)row * D, nullptr, (const float*)(F.Z + (size_t)100 * MiB) + (size_t)(row - MLAT) * D, nsplit, gam, bet, dry ? (float*)(F.Z + (size_t)134 * MiB) + (size_t)row * D : (to_out ? F.out + (size_t)row * D : F.X + (size_t)row * D), to_out ? 1.0f : ALPHA, want_h ? (dry ? F.MG : F.HA) + (size_t)row * D : nullptr, md + D, md, lane); }
}

constexpr int AT_KB = 0, AT_VB = 32768, AT_TILE = 16384, AT_XB = 65536;
__device__ __forceinline__ s16x4 vtr(const LAS unsigned char* p) { typedef short v4i16_t __attribute__((ext_vector_type(4))); return __builtin_bit_cast(s16x4, __builtin_amdgcn_ds_read_tr16_b64_v4i16((LAS v4i16_t*)p)); }
__device__ __forceinline__ float max3f(float a, float b, float c) { float r; asm("v_max3_f32 %0, %1, %2, %3" : "=v"(r) : "v"(a), "v"(b), "v"(c)); return r; }
__device__ __forceinline__ float max2f(float a, float b) { float r; asm("v_max_f32_e32 %0, %1, %2" : "=v"(r) : "v"(a), "v"(b)); return r; }
__device__ __forceinline__ void glds16(const void* gsrc, unsigned lds_dst) { unsigned keep;
    asm volatile("s_mov_b32 %0, m0\n\ts_mov_b32 m0, %2\n\ts_nop 0\n\tglobal_load_lds_dwordx4 %1, off\n\ts_mov_b32 m0, %0" : "=&s"(keep) : "v"(gsrc), "s"(lds_dst) : "memory"); }
#ifndef XTRA_EXP
#define XTRA_EXP 0
#endif
#define AT_WAITV(n) asm volatile("s_waitcnt vmcnt(" #n ")" ::: "memory")
#define AT_BAR() asm volatile("s_waitcnt lgkmcnt(0)\n\ts_barrier" ::: "memory")
__device__ __forceinline__ void attn_unit(Frame& F, int b, int h, int qb, bool ctxq, float lam, float oscale, const float* subg) {
    int lane_ = (F.ltid() & 63); asm volatile("" : "+v"(lane_));
    const int lane = lane_, wid = __builtin_amdgcn_readfirstlane(F.ltid() >> 6), r32 = lane & 31, hi = lane >> 5, m = wid >> 2, qg = wid & 3; const bool lead = wid < 4;
    const bf16* Z = F.Z;
    const int qrow = (ctxq ? MLAT + b * CTXL : b * SEQ) + qb * 128 + qg * 32 + r32;
    bf16x8 qf[4];
#pragma unroll
    for (int d0 = 0; d0 < 4; ++d0) qf[d0] = *(const GAS bf16x8*)(Z + (size_t)qrow * INW + Q_OFF + h * 128 + m * 64 + d0 * 16 + hi * 8);
    const int NT = ctxq ? 4 : 68;
    const bf16* Kbh = F.KB + (size_t)(b * 8 + h) * 4352 * 128; const bf16* Vbh = F.VB + (size_t)(b * 8 + h) * 4352 * 128;
    const unsigned lds0 = (unsigned)(size_t)F.lds;
    const int prow = 8 * wid + (lane >> 4), ppos = lane & 15;
    const unsigned koff0 = (unsigned)(prow * 128 + ((ppos ^ (prow & 15)) * 8)), koff1 = (unsigned)((prow + 4) * 128 + ((ppos ^ ((prow + 4) & 15)) * 8));
    const unsigned voff0 = (unsigned)(prow * 128 + ((ppos ^ (4 * (prow & 3))) * 8)), voff1 = voff0 + 4 * 128;
    const unsigned kdst = (unsigned)__builtin_amdgcn_readfirstlane((int)(lds0 + AT_KB + wid * 2048)), vdst = (unsigned)__builtin_amdgcn_readfirstlane((int)(lds0 + AT_VB + wid * 2048));
#define AT_DMAK(t, bufo) do { const bf16* tb_ = Kbh + (size_t)(t) * 8192; glds16(tb_ + koff0, kdst + (bufo)); glds16(tb_ + koff1, kdst + (bufo) + 1024); } while (0)
#define AT_DMAV(t, bufo) do { const bf16* tb_ = Vbh + (size_t)(t) * 8192; glds16(tb_ + voff0, vdst + (bufo)); glds16(tb_ + voff1, vdst + (bufo) + 1024); } while (0)
    f32x16 o[4];
#pragma unroll
    for (int db = 0; db < 4; ++db)
#pragma unroll
        for (int r = 0; r < 16; ++r) o[db][r] = 0.f;
    float mref = 0.f, lsum = 0.f;
    f32x16 negm;
#pragma unroll
    for (int r = 0; r < 16; ++r) negm[r] = 0.f;
    const unsigned kaddr0 = AT_KB + r32 * 256 + (((8 * m + hi) ^ (r32 & 15)) << 4);
    const int a4 = (lane & 15) >> 2, cc = 2 * ((lane >> 4) & 1) + ((lane & 3) >> 1);
    const unsigned vaddr0 = AT_VB + (4 * hi + a4) * 256 + ((4 * a4 + cc) << 4) + 8 * (lane & 1);
    __syncthreads();
#ifndef AT_THR
#define AT_THR 8.0f
#endif
#define AT_SB() __builtin_amdgcn_sched_barrier(0)
#define AT_PIN(x) asm volatile("" : "+v"(x))
#define AT_KFRAG(i) (*(const LAS bf16x8*)(F.lds + (kb_ ^ (unsigned)((2 * ((i) >> 1)) << 4)) + ((i) & 1) * 8192))
#define AT_VFRAG(lo, hh, ks, db) do { const unsigned va_ = (vb_ ^ (unsigned)((db) << 6)) + (16 * (ks)) * 256; lo = vtr(F.lds + va_); hh = vtr(F.lds + va_ + 8 * 256); } while (0)
#define AT_VF(lo, hh) ((bf16x8){lo[0], lo[1], lo[2], lo[3], hh[0], hh[1], hh[2], hh[3]})
#define AT_MAXDEC(C0, C1, FIRST) do { \
        float tmax = max3f(C0[0], C0[1], C0[2]), tmb_ = max3f(C1[0], C1[1], C1[2]); \
        _Pragma("unroll") for (int r = 3; r < 15; r += 2) tmax = max3f(tmax, C0[r], C0[r + 1]); \
        _Pragma("unroll") for (int r = 3; r < 15; r += 2) tmb_ = max3f(tmb_, C1[r], C1[r + 1]); \
        tmax = max3f(tmax, C0[15], C1[15]); tmax = max2f(tmax, tmb_); { auto rr_ = __builtin_amdgcn_permlane32_swap(__float_as_uint(tmax), __float_as_uint(tmax), false, false); tmax = max2f(__uint_as_float(rr_[0]), __uint_as_float(rr_[1])); } \
        resc = false; \
        if (FIRST) { mref = tmax; \
            _Pragma("unroll") for (int r = 0; r < 16; ++r) { C0[r] -= tmax; C1[r] -= tmax; negm[r] = -mref; } \
        } else if (__any(tmax > AT_THR)) { \
            const float dl = __builtin_fmaxf(tmax, 0.f); mref += dl; alr = __builtin_amdgcn_exp2f(-dl); lsum *= alr; resc = true; \
            _Pragma("unroll") for (int r = 0; r < 16; ++r) { C0[r] -= dl; C1[r] -= dl; negm[r] = -mref; } \
        } } while (0)
#define AT_GAPA(i, CD, CS, PP, PB, PW, PWI) do { \
        AT_VFRAG(vlo[i], vhi[i], (i) >> 2, (i) & 3); \
        CD = __builtin_amdgcn_mfma_f32_32x32x16_bf16(((i) & 1) ? kfb : kfa, qf[(i) >> 1], CS, 0, 0, 0); \
        if ((i) + 2 < 8) { if ((i) & 1) kfb = AT_KFRAG((i) + 2); else kfa = AT_KFRAG((i) + 2); } \
        sacc += PP[PB]; sacc += PP[PB + 1]; sacc += PP[PB + 2]; sacc += PP[PB + 3]; AT_PIN(sacc); \
        PW[PWI] = cvtpk(PP[PB], PP[PB + 1]); PW[PWI + 1] = cvtpk(PP[PB + 2], PP[PB + 3]); AT_PIN(PW); AT_SB(); } while (0)
#define AT_GAPB(j, VL, VH, PW, CC, CB) do { \
        if ((j) < 8) AT_VFRAG(wlo[j], whi[j], 2 + ((j) >> 2), (j) & 3); \
        o[(j) & 3] = __builtin_amdgcn_mfma_f32_32x32x16_bf16(AT_VF(VL, VH), __builtin_bit_cast(bf16x8, PW), o[(j) & 3], 0, 0, 0); \
        CC[CB] = __builtin_amdgcn_exp2f(CC[CB]); CC[CB + 1] = __builtin_amdgcn_exp2f(CC[CB + 1]); AT_PIN(CC); AT_SB(); } while (0)
#define AT_STEP(C0, C1, P0, P1, T) do { \
        const unsigned kbo_ = ((T) & 1) ? AT_TILE : 0, vbo_ = ((T) & 1) ? 0 : AT_TILE; \
        const bf16* tk_ = Kbh + (size_t)((T) + 1) * 8192; const bf16* tv_ = Vbh + (size_t)(T) * 8192; const bool morek_ = (T) + 1 < NT; \
        unsigned kb_ = kaddr0 + kbo_, vb_ = vaddr0 + vbo_; asm volatile("" : "+v"(kb_), "+v"(vb_)); \
        bf16x8 kfa = AT_KFRAG(0), kfb = AT_KFRAG(1); float sacc = 0.f; AT_SB(); \
        AT_GAPA(0, C0, negm, P0, 0, pw0, 0); glds16(tv_ + voff0, vdst + (vbo_ ^ AT_TILE)); AT_SB(); AT_GAPA(1, C1, negm, P0, 4, pw0, 2); glds16(tv_ + voff1, vdst + (vbo_ ^ AT_TILE) + 1024); AT_SB(); \
        AT_GAPA(2, C0, C0, P0, 8, pw1, 0); if (morek_) glds16(tk_ + koff0, kdst + (kbo_ ^ AT_TILE)); AT_SB(); AT_GAPA(3, C1, C1, P0, 12, pw1, 2); if (morek_) glds16(tk_ + koff1, kdst + (kbo_ ^ AT_TILE) + 1024); AT_SB(); \
        AT_GAPA(4, C0, C0, P1, 0, pw2, 0); AT_GAPA(5, C1, C1, P1, 4, pw2, 2); AT_GAPA(6, C0, C0, P1, 8, pw3, 0); AT_GAPA(7, C1, C1, P1, 12, pw3, 2); \
        lsum += sacc; \
        AT_MAXDEC(C0, C1, false); AT_SB(); \
        AT_GAPB(0, vlo[0], vhi[0], pw0, C0, 0); AT_GAPB(1, vlo[1], vhi[1], pw0, C0, 2); AT_GAPB(2, vlo[2], vhi[2], pw0, C0, 4); AT_GAPB(3, vlo[3], vhi[3], pw0, C0, 6); \
        AT_GAPB(4, vlo[4], vhi[4], pw1, C0, 8); AT_GAPB(5, vlo[5], vhi[5], pw1, C0, 10); AT_GAPB(6, vlo[6], vhi[6], pw1, C0, 12); AT_GAPB(7, vlo[7], vhi[7], pw1, C0, 14); \
        AT_GAPB(8, wlo[0], whi[0], pw2, C1, 0); AT_GAPB(9, wlo[1], whi[1], pw2, C1, 2); AT_GAPB(10, wlo[2], whi[2], pw2, C1, 4); AT_GAPB(11, wlo[3], whi[3], pw2, C1, 6); \
        AT_GAPB(12, wlo[4], whi[4], pw3, C1, 8); AT_GAPB(13, wlo[5], whi[5], pw3, C1, 10); AT_GAPB(14, wlo[6], whi[6], pw3, C1, 12); AT_GAPB(15, wlo[7], whi[7], pw3, C1, 14); \
        if (resc) { _Pragma("unroll") for (int db = 0; db < 4; ++db) _Pragma("unroll") for (int r = 0; r < 16; ++r) o[db][r] *= alr; } \
        asm volatile("s_waitcnt vmcnt(0) lgkmcnt(0)\n\ts_barrier" ::: "memory"); } while (0)
    f32x16 pA0, pA1, pB0, pB1; v4u pw0, pw1, pw2, pw3; s16x4 vlo[8], vhi[8], wlo[8], whi[8]; bool resc = false; float alr = 1.f;
#pragma unroll
    for (int r = 0; r < 16; ++r) { pB0[r] = 0.f; pB1[r] = 0.f; }
    pw0 = pw1 = pw2 = pw3 = (v4u){0u, 0u, 0u, 0u};
    AT_DMAK(0, 0);
    asm volatile("s_waitcnt vmcnt(0) lgkmcnt(0)\n\ts_barrier" ::: "memory");
    { if (NT > 1) AT_DMAK(1, AT_TILE);
      AT_DMAV(0, 0);
      unsigned kb_ = kaddr0; asm volatile("" : "+v"(kb_));
      pA0 = __builtin_amdgcn_mfma_f32_32x32x16_bf16(AT_KFRAG(0), qf[0], negm, 0, 0, 0); pA1 = __builtin_amdgcn_mfma_f32_32x32x16_bf16(AT_KFRAG(1), qf[0], negm, 0, 0, 0);
#pragma unroll
      for (int d0 = 1; d0 < 4; ++d0) { pA0 = __builtin_amdgcn_mfma_f32_32x32x16_bf16(AT_KFRAG(2 * d0), qf[d0], pA0, 0, 0, 0); pA1 = __builtin_amdgcn_mfma_f32_32x32x16_bf16(AT_KFRAG(2 * d0 + 1), qf[d0], pA1, 0, 0, 0); }
      AT_MAXDEC(pA0, pA1, true);
#pragma unroll
      for (int r = 0; r < 16; ++r) { pA0[r] = __builtin_amdgcn_exp2f(pA0[r]); pA1[r] = __builtin_amdgcn_exp2f(pA1[r]); }
      asm volatile("s_waitcnt vmcnt(0) lgkmcnt(0)\n\ts_barrier" ::: "memory"); }
    for (int t = 1; t < NT - 1; t += 2) { AT_STEP(pB0, pB1, pA0, pA1, t); AT_STEP(pA0, pA1, pB0, pB1, t + 1); }
    AT_STEP(pB0, pB1, pA0, pA1, NT - 1);
    { float sacc = 0.f;
#pragma unroll
      for (int r = 0; r < 16; ++r) sacc += pB0[r] + pB1[r];
      lsum += sacc;
      pw0 = (v4u){cvtpk(pB0[0], pB0[1]), cvtpk(pB0[2], pB0[3]), cvtpk(pB0[4], pB0[5]), cvtpk(pB0[6], pB0[7])}; pw1 = (v4u){cvtpk(pB0[8], pB0[9]), cvtpk(pB0[10], pB0[11]), cvtpk(pB0[12], pB0[13]), cvtpk(pB0[14], pB0[15])};
      pw2 = (v4u){cvtpk(pB1[0], pB1[1]), cvtpk(pB1[2], pB1[3]), cvtpk(pB1[4], pB1[5]), cvtpk(pB1[6], pB1[7])}; pw3 = (v4u){cvtpk(pB1[8], pB1[9]), cvtpk(pB1[10], pB1[11]), cvtpk(pB1[12], pB1[13]), cvtpk(pB1[14], pB1[15])};
      unsigned vb_ = vaddr0 + (((NT - 1) & 1) ? AT_TILE : 0); asm volatile("" : "+v"(vb_));
#pragma unroll
      for (int j = 0; j < 8; ++j) { AT_VFRAG(vlo[j], vhi[j], j >> 2, j & 3); AT_VFRAG(wlo[j], whi[j], 2 + (j >> 2), j & 3); }
      AT_SB();
#pragma unroll
      for (int j = 0; j < 8; ++j) o[j & 3] = __builtin_amdgcn_mfma_f32_32x32x16_bf16(AT_VF(vlo[j], vhi[j]), __builtin_bit_cast(bf16x8, (j < 4) ? pw0 : pw1), o[j & 3], 0, 0, 0);
#pragma unroll
      for (int j = 0; j < 8; ++j) o[j & 3] = __builtin_amdgcn_mfma_f32_32x32x16_bf16(AT_VF(wlo[j], whi[j]), __builtin_bit_cast(bf16x8, (j < 4) ? pw2 : pw3), o[j & 3], 0, 0, 0);
      asm volatile("s_waitcnt lgkmcnt(0)\n\ts_barrier" ::: "memory"); }
#undef AT_SB
#undef AT_PIN
#undef AT_KFRAG
#undef AT_VFRAG
#undef AT_VF
#undef AT_MAXDEC
#undef AT_GAPA
#undef AT_GAPB
#undef AT_STEP
    const float lt = lsum + __shfl_xor(lsum, 32);
    LAS float* xs = (LAS float*)(F.lds + AT_XB) + qg * 4096 + lane;
    if (!lead) { const float sc1 = lam / lt;
#pragma unroll
        for (int db = 0; db < 4; ++db)
#pragma unroll
            for (int r = 0; r < 16; ++r) xs[(db * 16 + r) * 64] = o[db][r] * sc1; }
    __syncthreads();
    if (lead) {
        const float i0 = 1.0f / lt; float ss = 0.f;
#pragma unroll
        for (int db = 0; db < 4; ++db)
#pragma unroll
            for (int r = 0; r < 16; ++r) { const float v = o[db][r] * i0 - xs[(db * 16 + r) * 64]; o[db][r] = v; ss += v * v; }
        ss += __shfl_xor(ss, 32);
        const float rs = oscale / sqrtf(ss * (1.0f / 128.0f) + LN_EPS);
        bf16* yp = F.Y + (size_t)qrow * YW + h * 128 + 4 * hi;
#pragma unroll
        for (int db = 0; db < 4; ++db)
#pragma unroll
            for (int g4 = 0; g4 < 4; ++g4) { const int d = 32 * db + 8 * g4; const f32x4 gv = *(const f32x4*)(subg + d + 4 * hi);
                v2u w; w.x = cvtpk(o[db][4 * g4 + 0] * rs * gv[0], o[db][4 * g4 + 1] * rs * gv[1]); w.y = cvtpk(o[db][4 * g4 + 2] * rs * gv[2], o[db][4 * g4 + 3] * rs * gv[3]);
                *(GAS v2u*)(yp + d) = w; }
    }
#undef AT_DMAK
#undef AT_DMAV
}

constexpr int GM_ST = 0, GM_VT = 1024, GM_VP = 272;
__device__ __forceinline__ void gmlp_unit(Frame& F, int row0, int l) {
    int tid_ = F.ltid(); asm volatile("" : "+v"(tid_)); const int tid = tid_, lane = tid & 63, wid = __builtin_amdgcn_readfirstlane(F.ltid() >> 6);
    typedef float f32x2v __attribute__((ext_vector_type(2)));
    LAS f32x2v* st = (LAS f32x2v*)(F.lds + GM_ST); LAS unsigned char* vt = F.lds + GM_VT;
    const bf16* Z = F.Z;
    __syncthreads();
#pragma unroll
    for (int hb = 0; hb < 2; ++hb) {
        v4u va[8], vb[8];
#pragma unroll
        for (int i = 0; i < 8; ++i) { const bf16* vp = Z + (size_t)(row0 + wid * 16 + hb * 8 + i) * INW + BU_OFF + BW + lane * 16; va[i] = *(const GAS v4u*)(vp); vb[i] = *(const GAS v4u*)(vp + 8); }
#pragma unroll
        for (int i = 0; i < 8; ++i) { const v4u a = va[i], b2 = vb[i];
            const float x[16] = {bflo(a.x), bfhi(a.x), bflo(a.y), bfhi(a.y), bflo(a.z), bfhi(a.z), bflo(a.w), bfhi(a.w), bflo(b2.x), bfhi(b2.x), bflo(b2.y), bfhi(b2.y), bflo(b2.z), bfhi(b2.z), bflo(b2.w), bfhi(b2.w)};
            float s = 0.f;
#pragma unroll
            for (int e = 0; e < 16; ++e) s += x[e];
            const float mean = wave_sum(s) * (1.0f / 1024.0f); float q = 0.f;
#pragma unroll
            for (int e = 0; e < 16; ++e) { const float dd = x[e] - mean; q += dd * dd; }
            const float rstd = 1.0f / sqrtf(wave_sum(q) * (1.0f / 1024.0f) + LN_EPS);
            if (lane == 0) st[wid * 16 + hb * 8 + i] = (f32x2v){mean, rstd}; }
    }
    const float* lng = F.gln_g + (size_t)l * BW; const float* lnb = F.gln_b + (size_t)l * BW;
    const int j = tid & 127, cc = tid >> 7;
    const int fr = lane & 15, fq = lane >> 4, tok = wid * 16 + fr;
    const bf16* vsrc = Z + (size_t)(row0 + j) * INW + BU_OFF + BW + cc * 32;
    v4u vr[4];
#pragma unroll
    for (int q4 = 0; q4 < 4; ++q4) vr[q4] = *(const GAS v4u*)(vsrc + q4 * 8);
    __syncthreads();
    const f32x2v sj = st[j];
#pragma unroll 1
    for (int g = 0; g < 8; ++g) {
        bf16x8 wf[4]; v2u uu[8];
        const bf16* wg = F.Wsp + ((size_t)l * 8 + g) * 16384 + (size_t)tok * 128 + fq * 8;
#pragma unroll
        for (int ks = 0; ks < 4; ++ks) wf[ks] = *(const GAS bf16x8*)(wg + ks * 32);
        const bf16* up = Z + (size_t)(row0 + tok) * INW + BU_OFF + g * 128 + 4 * fq;
#pragma unroll
        for (int ct = 0; ct < 8; ++ct) uu[ct] = *(const GAS v2u*)(up + ct * 16);
        const float bias = F.b_sp[((size_t)l * 8 + g) * 128 + tok];
#pragma unroll
        for (int q4 = 0; q4 < 4; ++q4) { const v4u a = vr[q4]; const int c0 = cc * 32 + q4 * 8;
            const f32x4 g0 = *(const f32x4*)(lng + g * 128 + c0), g1 = *(const f32x4*)(lng + g * 128 + c0 + 4), b0 = *(const f32x4*)(lnb + g * 128 + c0), b1 = *(const f32x4*)(lnb + g * 128 + c0 + 4);
            const float xv[8] = {bflo(a.x), bfhi(a.x), bflo(a.y), bfhi(a.y), bflo(a.z), bfhi(a.z), bflo(a.w), bfhi(a.w)};
#pragma unroll
            for (int e = 0; e < 8; ++e) { const float gg = e < 4 ? g0[e & 3] : g1[e & 3], bb = e < 4 ? b0[e & 3] : b1[e & 3]; const float y = (xv[e] - sj.x) * sj.y * gg + bb;
                *(LAS bf16*)(vt + (c0 + e) * GM_VP + j * 2) = (bf16)f2bf(y); } }
        if (g < 7) {
#pragma unroll
            for (int q4 = 0; q4 < 4; ++q4) vr[q4] = *(const GAS v4u*)(vsrc + (g + 1) * 128 + q4 * 8);
        }
        __syncthreads();
#pragma unroll
        for (int ct = 0; ct < 8; ++ct) { f32x4 acc = {0.f, 0.f, 0.f, 0.f};
#pragma unroll
            for (int ks = 0; ks < 4; ++ks) { const bf16x8 af = *(const LAS bf16x8*)(vt + (ct * 16 + fr) * GM_VP + (ks * 32 + fq * 8) * 2); acc = __builtin_amdgcn_mfma_f32_16x16x32_bf16(af, wf[ks], acc, 0, 0, 0); }
            const v2u u2 = uu[ct];
            v2u w; w.x = cvtpk(bflo(u2.x) * (acc[0] + bias), bfhi(u2.x) * (acc[1] + bias)); w.y = cvtpk(bflo(u2.y) * (acc[2] + bias), bfhi(u2.y) * (acc[3] + bias));
            *(GAS v2u*)(F.Y + (size_t)(row0 + tok) * YW + BW + g * 128 + ct * 16 + 4 * fq) = w; }
        __syncthreads();
    }
}

constexpr int PL_DP = 528;
template <int GI> __device__ __forceinline__ void pool_unit(Frame& F, int row0, int l) {
    int tid_ = F.ltid(); asm volatile("" : "+v"(tid_)); const int tid = tid_, lane = tid & 63, wid = __builtin_amdgcn_readfirstlane(F.ltid() >> 6);
    LAS unsigned char* dt = F.lds;
    const bf16* Z = F.Z;
    constexpr int W = 2 << GI, HW = W / 2, NR = 8 + W - 1;
    const int seqlen = row0 < MLAT ? SEQ : CTXL; const int s0 = row0 < MLAT ? (row0 & ~(SEQ - 1)) : MLAT + ((row0 - MLAT) & ~(CTXL - 1));
    const int fr = lane & 15, fq = lane >> 4;
    bf16x8 wa[8][2];
    { const bf16* wp = F.Wpool + ((size_t)l * 4 + GI) * 65536 + (size_t)(wid * 32 + fr) * 256 + fq * 8;
#pragma unroll
      for (int ks = 0; ks < 8; ++ks) { wa[ks][0] = *(const GAS bf16x8*)(wp + ks * 32); wa[ks][1] = *(const GAS bf16x8*)(wp + 16 * 256 + ks * 32); } }
    __syncthreads();
    { const int ch = tid & 31, tg = tid >> 5;
      const bf16* zc = Z + C_OFF + GI * 256 + ch * 8; const int p0 = row0 - s0 + tg * 8;
      v4u rw[NR];
#pragma unroll
      for (int k = 0; k < NR; ++k) { const int q = p0 - HW + k; const bool ok = (q >= 0) && (q < seqlen); const int qq = ok ? q : p0; const v4u a = *(const GAS v4u*)(zc + (size_t)(s0 + qq) * INW); rw[k] = ok ? a : (v4u){0u, 0u, 0u, 0u}; }
      float sum[8] = {0.f, 0.f, 0.f, 0.f, 0.f, 0.f, 0.f, 0.f};
#pragma unroll
      for (int k = 0; k < W; ++k) { const v4u a = rw[k]; sum[0] += bflo(a.x); sum[1] += bfhi(a.x); sum[2] += bflo(a.y); sum[3] += bfhi(a.y); sum[4] += bflo(a.z); sum[5] += bfhi(a.z); sum[6] += bflo(a.w); sum[7] += bfhi(a.w); }
#pragma unroll
      for (int i = 0; i < 8; ++i) { const int p = p0 + i; const int lo = p - HW < 0 ? 0 : p - HW; const int hi = p - HW + W > seqlen ? seqlen : p - HW + W; const float inv = 1.0f / (float)(hi - lo);
          const v4u zz = rw[i + HW];
          v4u o; o.x = pk2(sum[0] * inv - bflo(zz.x), sum[1] * inv - bfhi(zz.x)); o.y = pk2(sum[2] * inv - bflo(zz.y), sum[3] * inv - bfhi(zz.y));
          o.z = pk2(sum[4] * inv - bflo(zz.z), sum[5] * inv - bfhi(zz.z)); o.w = pk2(sum[6] * inv - bflo(zz.w), sum[7] * inv - bfhi(zz.w));
          *(LAS v4u*)(dt + (tg * 8 + i) * PL_DP + ch * 16) = o;
          if (i < 7) { const v4u a = rw[i + W], b = rw[i];
              sum[0] += bflo(a.x) - bflo(b.x); sum[1] += bfhi(a.x) - bfhi(b.x); sum[2] += bflo(a.y) - bflo(b.y); sum[3] += bfhi(a.y) - bfhi(b.y);
              sum[4] += bflo(a.z) - bflo(b.z); sum[5] += bfhi(a.z) - bfhi(b.z); sum[6] += bflo(a.w) - bflo(b.w); sum[7] += bfhi(a.w) - bfhi(b.w); } } }
    __syncthreads();
    { f32x4 acc[2][8];
#pragma unroll
      for (int a = 0; a < 2; ++a)
#pragma unroll
          for (int tt = 0; tt < 8; ++tt) acc[a][tt] = (f32x4){0.f, 0.f, 0.f, 0.f};
#pragma unroll
      for (int ks = 0; ks < 8; ++ks) {
#pragma unroll
          for (int tt = 0; tt < 8; ++tt) { const bf16x8 bfr = *(const LAS bf16x8*)(dt + (tt * 16 + fr) * PL_DP + (ks * 32 + fq * 8) * 2);
              acc[0][tt] = __builtin_amdgcn_mfma_f32_16x16x32_bf16(wa[ks][0], bfr, acc[0][tt], 0, 0, 0); acc[1][tt] = __builtin_amdgcn_mfma_f32_16x16x32_bf16(wa[ks][1], bfr, acc[1][tt], 0, 0, 0); } }
      const float* ps = F.pool_scale + (size_t)l * BW + GI * 256;
#pragma unroll
      for (int a = 0; a < 2; ++a) { const int dd = wid * 32 + a * 16 + 4 * fq; const f32x4 sc = *(const f32x4*)(ps + dd);
#pragma unroll
          for (int tt = 0; tt < 8; ++tt) { const f32x4 v = acc[a][tt] * sc; v2u wv; wv.x = cvtpk(v[0], v[1]); wv.y = cvtpk(v[2], v[3]);
              *(GAS v2u*)(F.Y + (size_t)(row0 + tt * 16 + fr) * YW + 2 * BW + GI * 256 + dd) = wv; } } }
}
__device__ __forceinline__ void pool_dispatch(Frame& F, int row0, int g, int l) {
    if (g == 0) pool_unit<0>(F, row0, l); else if (g == 1) pool_unit<1>(F, row0, l); else if (g == 2) pool_unit<2>(F, row0, l); else pool_unit<3>(F, row0, l);
}

#ifndef MIXM
#define MIXM 7
#endif
__device__ __forceinline__ void phase_mixers(Frame& F, int l, float lam_init) {
    const bool last = (l == DEPTH - 1);
    float d01 = 0.f, d23 = 0.f; const float* lq = F.lam_qk + (size_t)l * 256;
    for (int i = 0; i < 64; ++i) { d01 += lq[i] * lq[64 + i]; d23 += lq[128 + i] * lq[192 + i]; }
    const float lam = __expf(d01) - __expf(d23) + lam_init; const float oscale = 1.0f - lam_init;
    const float* subg = F.subln_g + (size_t)l * 128;
#ifndef REP_ATT
#define REP_ATT 1
#endif
#ifndef REP_GP
#define REP_GP 1
#endif
#pragma nounroll
    for (int i = 0; i < 5 * REP_ATT; ++i) { const int uid = F.vcu + F.G * (i % 5);
        if (!(MIXM & 1)) continue;
        if (uid < 1024) attn_unit(F, uid >> 8, (uid >> 5) & 7, uid & 31, false, lam, oscale, subg);
        else if (!last && uid < 1088) attn_unit(F, (uid - 1024) >> 4, ((uid - 1024) >> 1) & 7, uid & 1, true, lam, oscale, subg);
        if (TAILWORK == 2 && !last && i == (F.vcu & 3)) { __syncthreads(); const int gw_ = F.vcu * NWAVES + __builtin_amdgcn_readfirstlane(F.ltid() >> 6); ada_partial_layer(F, l + 1, gw_, F.G * NWAVES); cvt_layer(F, l + 1, gw_, F.G * NWAVES); } }
    const int nchunk = last ? MLAT / 128 : MTOT / 128;
#pragma nounroll
    for (int rgp = 0; rgp < REP_GP; ++rgp) {
    if (MIXM & 2) for (int cidx = F.G - 1 - F.vcu; cidx < nchunk; cidx += F.G) gmlp_unit(F, cidx * 128, l);
    if (MIXM & 4) { const int nfree = F.G - nchunk, npool = nchunk * 4;
        if (nfree > 0 && F.G == 256) {
            if (F.vcu < nfree) { for (int k = 0; k < 4; ++k) { const int u = F.vcu * 4 + k; if (u < npool) pool_dispatch(F, (u >> 2) * 128, u & 3, l); } }
            else { for (int u = nfree * 4 + (F.vcu - nfree); u < npool; u += nchunk) pool_dispatch(F, (u >> 2) * 128, u & 3, l); }
        } else { for (int u = F.vcu; u < npool; u += F.G) pool_dispatch(F, (u >> 2) * 128, u & 3, l); } }
    }
    __syncthreads();
}

#ifndef ALIGN_P3
#define ALIGN_P3 true
#endif
#ifndef WGM_P1
#define WGM_P1 4
#endif
#ifndef WGM_P5
#define WGM_P5 4
#endif
#ifndef WGM_N8
#define WGM_N8 4
#endif
#ifndef SP2_BIG
#define SP2_BIG true
#endif
#ifndef ALIGN_BIG
#define ALIGN_BIG true
#endif
#ifndef STAGGER
#define STAGGER 0
#endif
__device__ __forceinline__ void phase_stagger(int slot) { if (STAGGER) for (int i = 0; i < slot * 3; ++i) __builtin_amdgcn_s_sleep(8); }
#ifndef MK_ONE_LAUNCH
#define MK_ONE_LAUNCH 1
#endif
constexpr int NPHASE = 3 + 8 * DEPTH;
struct Args { const float* in[23]; float* out; unsigned char* ws; int ph_lo, ph_hi; float lam_init[4]; };
__global__ void __launch_bounds__(NWAVES * 64, 2) fwd(Args args) {
    extern __shared__ __attribute__((aligned(16))) unsigned char lds[];
    Frame F;
    F.lds = (LAS unsigned char*)lds;
    F.MISC = (volatile LAS unsigned*)(F.lds + MISC_OFF);
    F.G = gridDim.x; { const int bx = blockIdx.x; F.bx = bx; F.vcu = (F.G % 8 == 0) ? (bx % 8) * (F.G / 8) + bx / 8 : bx; }
    unsigned char* ws = args.ws;
    F.ctl = (gu32*)(ws + WS_CTL);
    frame_ptrs(F);
    for (int u = F.ltid(); u < (LDS_BYTES - LDSCTL_OFF) / 4; u += NWAVES * 64) ((LAS unsigned*)(F.lds + LDSCTL_OFF))[u] = 0u;
    __syncthreads();
#if MK_ONE_LAUNCH
    constexpr int lo = 0, hi = NPHASE; constexpr bool use_bar = true;
#else
    const int lo = args.ph_lo, hi = args.ph_hi;
    const bool use_bar = (hi - lo) > 1;
#endif
    XcdBarrier bar; bar.bar = (unsigned*)(F.ctl + CW_BAR); bar.x = 0; bar.st = nullptr;
    if (use_bar) bar = xcd_barrier_post((unsigned*)(F.ctl + CW_BAR), F.MISC + 8);
#ifndef PHM
#define PHM 0xFFFF
#endif
#define IN(k) (lo <= (k) && (k) < hi)
#define KIND(b) ((PHM >> (b)) & 1)
#ifndef REP_MASK
#define REP_MASK 0
#endif
#define NREP(b) (((REP_MASK >> (b)) & 1) ? 2 : 1)
#define BARRIER() do { XcdBarrier b_ = bar; asm volatile("" : "+s"(b_.x)); xcd_barrier(b_); } while (0)
#ifndef DRY_EPI
#define DRY_EPI 0
#endif
#ifndef BAR_REP
#define BAR_REP 1
#endif
#define SEAM(k) do { if (IN(k) && IN((k) + 1)) { for (int br_ = 0; br_ < BAR_REP; ++br_) BARRIER(); } } while (0)

    if (KIND(0) && IN(0)) { for (int rep = 0; rep < NREP(0); ++rep) { frame_ptrs(F); phase_a1(F); if (rep + 1 < NREP(0)) BARRIER(); } } SEAM(0);
    if (KIND(1) && IN(1)) { frame_ptrs(F); phase_a2(F); } SEAM(1);
    if (KIND(2) && IN(2)) { frame_ptrs(F); phase_a3(F); } SEAM(2);

#pragma nounroll
    for (int l = 0; l < DEPTH; ++l) {
        const int pb = 3 + 8 * l; const bool last = (l == DEPTH - 1);
        { int g_ = F.G, v_ = F.vcu, b_ = F.bx; asm volatile("" : "+s"(g_), "+s"(v_), "+s"(b_)); F.G = g_; F.vcu = v_; F.bx = b_; }
        const int Mrows = last ? MLAT : MTOT;
        if (KIND(3) && IN(pb + 0)) for (int rep = 0; rep < NREP(3); ++rep) { if (rep) BARRIER(); frame_ptrs(F);
            pg8::Gemm g{F.HA, F.Win + (size_t)l * INW * D, MTOT, INW, D, D, D}; pg8::StaticOrder S; S.init(MTOT, INW, F.G, F.bx, WGM_P1);
            pg8::EpiInProj E{F.Z, F.rope, QSCALE, INW, MLAT, F.KB, F.VB, (rep && DRY_EPI) ? 1 : 0};
            phase_stagger((F.bx >> 3) & 7);
            pg8::gemm_phase<pg8::EpiInProj, pg8::StaticOrder, ALIGN_BIG, SP2_BIG>(F.lds + RING_OFF, g, S, E);
        }
        SEAM(pb + 0);
        if (KIND(4) && IN(pb + 1)) for (int rep = 0; rep < NREP(4); ++rep) { if (rep) BARRIER(); frame_ptrs(F); phase_mixers(F, l, args.lam_init[l]); }
        SEAM(pb + 1);
        if (KIND(5) && IN(pb + 2)) for (int rep = 0; rep < NREP(5); ++rep) { if (rep) BARRIER(); frame_ptrs(F);
            pg8::Gemm g{F.Y, F.Wbr + (size_t)l * D * YW, Mrows, D, YW, YW, YW}; pg8::StaticOrder S; S.init(Mrows, D, F.G, F.bx, WGM_N8);
            pg8::EpiGate E{F.Z + G_OFF, INW, F.MG, D};
            pg8::gemm_phase<pg8::EpiGate, pg8::StaticOrder, ALIGN_P3, true>(F.lds + RING_OFF, g, S, E);
        }
        SEAM(pb + 2);
        if (KIND(6) && IN(pb + 3)) for (int rep = 0; rep < NREP(6); ++rep) { if (rep) BARRIER(); frame_ptrs(F);
            void* tw = rep ? (void*)(F.Z + (size_t)134 * MiB) : (void*)F.Y;
            { pg8::Gemm g{F.MG, F.Wout + (size_t)l * D * D, MLAT, D, D, D, D}; pg8::StaticOrder S; S.init(MLAT, D, F.G, F.bx, WGM_N8);
              pg8::EpiResidT<false> E{F.mods + (size_t)l * 5 * INW + 2 * D, INW, tw, D, 1, MLAT};
              pg8::gemm_phase<pg8::EpiResidT<false>, pg8::StaticOrder, true, true>(F.lds + RING_OFF, g, S, E); }
            if (!last) { pg8::Gemm g{F.MG, F.Wout + (size_t)l * D * D, MTOT, D, 256, D, D}; pg8::SplitOrder S; S.init(MLAT / 256, 32, 8, 256, F.G, F.bx);
              pg8::EpiResidT<true> E{F.mods + (size_t)l * 5 * INW + 2 * D, INW, rep ? (void*)(F.Z + (size_t)170 * MiB) : (void*)(F.Z + (size_t)100 * MiB), D, 256, MLAT};
              pg8::gemm_phase<pg8::EpiResidT<true>, pg8::SplitOrder, true, true>(F.lds + RING_OFF, g, S, E); }
            if (TAILWORK == 1 && !last && F.bx >= 32 && rep == 0) ada_partial_layer(F, l + 1, (F.bx - 32) * NWAVES + __builtin_amdgcn_readfirstlane(F.ltid() >> 6), (F.G - 32) * NWAVES);
        }
        SEAM(pb + 3);
        if (KIND(7) && IN(pb + 4)) { frame_ptrs(F); if (NREP(7) > 1) { phase_ln(F, F.ln1_g + (size_t)l * D, F.ln1_b + (size_t)l * D, Mrows, false, true, l, 3 * D, last ? 0 : 8, true); BARRIER(); frame_ptrs(F); }
            phase_ln(F, F.ln1_g + (size_t)l * D, F.ln1_b + (size_t)l * D, Mrows, false, true, l, 3 * D, last ? 0 : 8); if (TAILWORK && !last) mods_reduce_layer(F, l + 1); }
        SEAM(pb + 4);
        if (KIND(8) && IN(pb + 5)) for (int rep = 0; rep < NREP(8); ++rep) { if (rep) BARRIER(); frame_ptrs(F);
            pg8::Gemm g{F.HA, F.Wgu + (size_t)l * 2 * FFH * D, Mrows, 2 * FFH, D, D, D}; pg8::StaticOrder S; S.init(Mrows, 2 * FFH, F.G, F.bx, WGM_P5);
            pg8::EpiSwiglu E{F.Z, FFH};
            phase_stagger((F.bx >> 3) & 7);
            pg8::gemm_phase<pg8::EpiSwiglu, pg8::StaticOrder, ALIGN_BIG, SP2_BIG>(F.lds + RING_OFF, g, S, E);
        }
        SEAM(pb + 5);
        if (KIND(9) && IN(pb + 6)) for (int rep = 0; rep < NREP(9); ++rep) { if (rep) BARRIER(); frame_ptrs(F);
            void* tw = rep ? (void*)(F.Z + (size_t)134 * MiB) : (void*)F.Y;
            { pg8::Gemm g{F.Z, F.Wdn + (size_t)l * D * FFH, MLAT, D, FFH, FFH, FFH}; pg8::StaticOrder S; S.init(MLAT, D, F.G, F.bx, WGM_N8);
              pg8::EpiResidT<false> E{F.mods + (size_t)l * 5 * INW + 5 * D, INW, tw, D, 1, MLAT};
              pg8::gemm_phase<pg8::EpiResidT<false>, pg8::StaticOrder, true, true>(F.lds + RING_OFF, g, S, E); }
            if (!last) { pg8::Gemm g{F.Z, F.Wdn + (size_t)l * D * FFH, MTOT, D, FFH / 4, FFH, FFH}; pg8::SplitOrder S; S.init(MLAT / 256, 32, 4, FFH / 4, F.G, F.bx);
              pg8::EpiResidT<true> E{F.mods + (size_t)l * 5 * INW + 5 * D, INW, rep ? (void*)(F.Z + (size_t)170 * MiB) : (void*)(F.Z + (size_t)100 * MiB), D, FFH / 4, MLAT};
              pg8::gemm_phase<pg8::EpiResidT<true>, pg8::SplitOrder, true, true>(F.lds + RING_OFF, g, S, E); }
            if (TAILWORK == 1 && !last && F.bx >= 32 && rep == 0) { __syncthreads(); cvt_layer(F, l + 1, (F.bx - 32) * NWAVES + __builtin_amdgcn_readfirstlane(F.ltid() >> 6), (F.G - 32) * NWAVES); }
        }
        SEAM(pb + 6);
        if (KIND(7) && IN(pb + 7)) { frame_ptrs(F); phase_ln(F, F.ln2_g + (size_t)l * D, F.ln2_b + (size_t)l * D, Mrows, last, !last, last ? l : l + 1, 0, last ? 0 : 4); }
        if (!last) SEAM(pb + 7);
    }
#undef IN
#undef SEAM
}

extern "C" void kernel_launch(void* const* d_in, const int* in_sizes, int n_in, void* d_out, int out_size, void* d_ws, size_t ws_size, hipStream_t stream) {
    static int grid = 0;
    if (grid == 0) {
        if (n_in != 23 || in_sizes[0] != MLAT * D || out_size != MLAT * D || ws_size < WS_END) {
            fprintf(stderr, "kernel_launch: unexpected shapes / workspace (n_in %d, in0 %d, out %d, ws %zu, need %zu); nothing launched\n", n_in, n_in > 0 ? in_sizes[0] : -1, out_size, ws_size, (size_t)WS_END); grid = -1; return; }
        int dev = 0, cus = 0, per_cu = 0;
        if (hipGetDevice(&dev) != hipSuccess || hipDeviceGetAttribute(&cus, hipDeviceAttributeMultiprocessorCount, dev) != hipSuccess) { grid = -1; return; }
        if (hipFuncSetAttribute((const void*)fwd, hipFuncAttributeMaxDynamicSharedMemorySize, LDS_BYTES) != hipSuccess) { fprintf(stderr, "kernel_launch: hipFuncSetAttribute failed\n"); grid = -1; return; }
        if (hipOccupancyMaxActiveBlocksPerMultiprocessor(&per_cu, (const void*)fwd, NWAVES * 64, LDS_BYTES) != hipSuccess || per_cu < 1) fprintf(stderr, "kernel_launch: occupancy query reports %d\n", per_cu);
        (void)hipGetLastError();
        grid = cus;
    }
    if (grid < 0) return;
    if (hipMemsetAsync((char*)d_ws + WS_CTL, 0, CTL_ZERO_BYTES, stream) != hipSuccess) return;
    Args a{};
    for (int i = 0; i < 23; ++i) a.in[i] = (const float*)d_in[i];
    a.out = (float*)d_out; a.ws = (unsigned char*)d_ws;
    for (int l = 0; l < DEPTH; ++l) a.lam_init[l] = (float)(0.8 - 0.6 * exp(-0.3 * (double)l));
#if MK_ONE_LAUNCH
    a.ph_lo = 0; a.ph_hi = NPHASE;
    hipLaunchKernelGGL(fwd, dim3(grid), dim3(NWAVES * 64), LDS_BYTES, stream, a);
#else
    for (int p = 0; p < NPHASE; ++p) { a.ph_lo = p; a.ph_hi = p + 1; hipLaunchKernelGGL(fwd, dim3(grid), dim3(NWAVES * 64), LDS_BYTES, stream, a); }
#endif
}
```

```cpp
#include <hip/hip_runtime.h>
#include <cstdio>
#include <cstdint>
#include <cmath>
namespace pg8 {
#define PG8_LAS __attribute__((address_space(3)))
typedef unsigned short bf16_t;
typedef short bf16x8 __attribute__((ext_vector_type(8)));
typedef float f32x4 __attribute__((ext_vector_type(4)));
typedef unsigned u32x4 __attribute__((ext_vector_type(4)));
constexpr int BM = 256, BK = 64, HALF = 128, HTB = HALF * BK * 2  , STAGE_BYTES = 8 * HTB, NXCD = 8, WGM = 4;

__host__ __device__ __forceinline__ int lds_byte(int r, int c) { const int st = (r >> 4) * 2 + (c >> 5), rr = r & 15, cc = c & 31, ob = rr * 64 + cc * 2; return st * 1024 + (ob ^ (((ob >> 9) & 1) << 5)); }
__host__ __device__ __forceinline__ void stage_rc(int b, int& R, int& C) { const int st = b / 1024, sb = b % 1024, swz = sb ^ (((sb >> 9) & 1) << 5); R = (st >> 1) * 16 + swz / 64; C = (st & 1) * 32 + (swz % 64) / 2; }
__host__ __device__ __forceinline__ int perm32(int rho) { const int n = rho >> 4, i = rho & 15; return 8 * (i >> 2) + 4 * n + (i & 3); }

struct Unit { int pm, pn, ka; };
struct Gemm { const bf16_t* A; const bf16_t* Bt; int M, N, K, lda, ldb; };

struct StaticOrder {
    int nM, nN, nwg, G, c, wgm;
    __host__ __device__ void init(int M, int N, int G_, int c_, int wgm_ = WGM) { nM = M / BM; nN = N / BM; nwg = nM * nN; G = G_; c = c_; wgm = wgm_; }
    __host__ __device__ bool next(int i, Unit& u) const {
        const long L = (long)i * G + c; if (L >= nwg) return false;
        int wgid = (int)L; { const int q = nwg / NXCD, r = nwg % NXCD, xcd = wgid % NXCD, off = wgid / NXCD; wgid = (xcd < r ? xcd * (q + 1) : r * (q + 1) + (xcd - r) * q) + off; }
        const int nig = wgm * nN, gid = wgid / nig, fm = gid * wgm, gsz = (nM - fm) < wgm ? (nM - fm) : wgm;
        u.pm = fm + ((wgid % nig) % gsz); u.pn = (wgid % nig) / gsz; u.ka = 0; return true;
    }
    __device__ __forceinline__ void a_ready(const Unit&) const {}
    __device__ __forceinline__ void done(const Unit&) const {}
};

struct SplitOrder {
    int nsplit, klen, G, c, pm0, ntile;
    __host__ __device__ void init(int pm0_, int ntile_, int nsplit_, int klen_, int G_, int c_) { pm0 = pm0_; ntile = ntile_; nsplit = nsplit_; klen = klen_; G = G_; c = c_; }
    __host__ __device__ bool next(int i, Unit& u) const { const int L = i * G + c; if (L >= ntile * nsplit) return false; const int tt = L / nsplit; u.pm = pm0 + (tt & 3); u.pn = tt >> 2; u.ka = (L - tt * nsplit) * klen; return true; }
    __device__ __forceinline__ void a_ready(const Unit&) const {}
    __device__ __forceinline__ void done(const Unit&) const {}
};
__device__ __forceinline__ unsigned cvt_pk_bf16(float lo, float hi) { unsigned r; asm volatile("v_cvt_pk_bf16_f32 %0, %1, %2" : "=v"(r) : "v"(lo), "v"(hi)); return r; }
typedef float f32x2 __attribute__((ext_vector_type(2)));
__device__ __forceinline__ f32x2 gelu_pk(f32x2 v) {
    const f32x2 av = __builtin_elementwise_abs(v), d = av * 0.2316418882f + 1.0f;
    f32x2 t; t.x = __builtin_amdgcn_rcpf(d.x); t.y = __builtin_amdgcn_rcpf(d.y);
    f32x2 q = t * 0.5307027145f + (-0.7265760135f); q = q * t + 0.7107068705f; q = q * t + (-0.142248368f); q = q * t + 0.127414796f; q = q * t;
    const f32x2 s = (v * v) * (-0.72134752044f);
    f32x2 e; e.x = __builtin_amdgcn_exp2f(s.x); e.y = __builtin_amdgcn_exp2f(s.y);
    const f32x2 m = v * (q * e), r = v - m;
    f32x2 o; o.x = v.x < 0.f ? m.x : r.x; o.y = v.y < 0.f ? m.y : r.y; return o;
}

#ifndef GATE_NT
#define GATE_NT 0
#endif
#if GATE_NT
#define GATE_LD(p) __builtin_nontemporal_load(p)
#else
#define GATE_LD(p) (*(p))
#endif
#ifndef GATE_ST_NT
#define GATE_ST_NT 0
#endif
#ifndef EPI_NT
#define EPI_NT 0
#endif
typedef unsigned u32x2 __attribute__((ext_vector_type(2)));
__device__ __forceinline__ float bf_lo(unsigned w) { return __uint_as_float(w << 16); }
__device__ __forceinline__ float bf_hi(unsigned w) { return __uint_as_float(w & 0xffff0000u); }
__device__ __forceinline__ void store8_bf16(bf16_t* p, const f32x4 v0, const f32x4 v1) {
    u32x4 w; w.x = cvt_pk_bf16(v0[0], v0[1]); w.y = cvt_pk_bf16(v0[2], v0[3]); w.z = cvt_pk_bf16(v1[0], v1[1]); w.w = cvt_pk_bf16(v1[2], v1[3]);
#if EPI_NT
    __builtin_nontemporal_store(w, (u32x4*)p);
#else
    *(u32x4*)p = w;
#endif
}
__device__ __forceinline__ float sigmoid_f(float x) { return __builtin_amdgcn_rcpf(1.0f + __builtin_amdgcn_exp2f(x * -1.4426950408889634f)); }

struct EpiInProj {
    static constexpr bool PERM = true, AFTER_DRAIN = false; static constexpr int KSEG = 0;
    bf16_t* Z; const float* rope; float qscale; int ldc; int nlat; bf16_t* Kb; bf16_t* Vb; int dry;
    __device__ __forceinline__ void kseg(f32x4 (&)[2][2][4][2], const Unit&, int, int, int, int, int) const {}
    __device__ __forceinline__ void operator()(const f32x4 (&acc)[2][2][4][2], const Unit& u, int wr, int wc, int fr, int fq) const {
        const int pn = u.pn; const int row0 = u.pm * BM + wr * 64 + fr; const int col0 = pn * BM + wc * 32 + 8 * fq;
        if (dry) { float s_ = 0.f;
#pragma unroll
            for (int a_ = 0; a_ < 2; ++a_)
#pragma unroll
                for (int b_ = 0; b_ < 2; ++b_)
#pragma unroll
                    for (int m_ = 0; m_ < 4; ++m_)
#pragma unroll
                        for (int n_ = 0; n_ < 2; ++n_) s_ += acc[a_][b_][m_][n_][0];
            if (s_ != s_) Z[0] = 0; return; }
        if (pn < 8) {
            const float sc = pn < 4 ? qscale : 1.0f;
#pragma unroll
            for (int ai = 0; ai < 2; ++ai)
#pragma unroll
                for (int m = 0; m < 4; ++m) {
                    const int row = row0 + ai * HALF + m * 16; const int t = row & 4095; const int pos = (wc & 1) ? (t & 63) : (t >> 6);
                    f32x4 cs0 = *(const f32x4*)(rope + (pos * 16 + 4 * fq) * 2), cs1 = *(const f32x4*)(rope + (pos * 16 + 4 * fq) * 2 + 4);
                    if (row >= nlat) { cs0 = (f32x4){1.f, 0.f, 1.f, 0.f}; cs1 = cs0; }
                    bf16_t* rowp = Z + (size_t)row * ldc + col0;
                    if (pn >= 4) { const int bb = row < nlat ? (row >> 12) : ((row - nlat) >> 8), key = row < nlat ? 256 + (row & 4095) : ((row - nlat) & 255);
                        rowp = Kb + ((size_t)(bb * 8 + 2 * (pn - 4)) * 4352 + key) * 128 + wc * 32 + 8 * fq; }
#pragma unroll
                    for (int bj = 0; bj < 2; ++bj) {
                        const f32x4 a = acc[ai][bj][m][0], b = acc[ai][bj][m][1];
                        f32x4 o0, o1;
                        o0[0] = (a[0] * cs0[0] - a[1] * cs0[1]) * sc; o0[1] = (a[0] * cs0[1] + a[1] * cs0[0]) * sc;
                        o0[2] = (a[2] * cs0[2] - a[3] * cs0[3]) * sc; o0[3] = (a[2] * cs0[3] + a[3] * cs0[2]) * sc;
                        o1[0] = (b[0] * cs1[0] - b[1] * cs1[1]) * sc; o1[1] = (b[0] * cs1[1] + b[1] * cs1[0]) * sc;
                        o1[2] = (b[2] * cs1[2] - b[3] * cs1[3]) * sc; o1[3] = (b[2] * cs1[3] + b[3] * cs1[2]) * sc;
                        store8_bf16(rowp + (pn >= 4 ? (size_t)bj * 4352 * 128 : (size_t)bj * HALF), o0, o1);
                    }
                }
        } else if (pn < 12) {
#pragma unroll
            for (int ai = 0; ai < 2; ++ai)
#pragma unroll
                for (int m = 0; m < 4; ++m) { const int row = row0 + ai * HALF + m * 16; const int bb = row < nlat ? (row >> 12) : ((row - nlat) >> 8), key = row < nlat ? 256 + (row & 4095) : ((row - nlat) & 255);
                    bf16_t* rowp = Vb + ((size_t)(bb * 8 + 2 * (pn - 8)) * 4352 + key) * 128 + wc * 32 + 8 * fq;
#pragma unroll
                    for (int bj = 0; bj < 2; ++bj) store8_bf16(rowp + (size_t)bj * 4352 * 128, acc[ai][bj][m][0], acc[ai][bj][m][1]); }
        } else if (pn >= 20 && pn < 24) {
#pragma unroll
            for (int ai = 0; ai < 2; ++ai)
#pragma unroll
                for (int m = 0; m < 4; ++m) { bf16_t* rowp = Z + (size_t)(row0 + ai * HALF + m * 16) * ldc + col0;
#pragma unroll
                    for (int bj = 0; bj < 2; ++bj) store8_bf16(rowp + bj * HALF, acc[ai][bj][m][0], acc[ai][bj][m][1]); }
        } else if (pn < 20) {
#pragma unroll
            for (int ai = 0; ai < 2; ++ai)
#pragma unroll
                for (int m = 0; m < 4; ++m) { bf16_t* rowp = Z + (size_t)(row0 + ai * HALF + m * 16) * ldc + col0;
#pragma unroll
                    for (int bj = 0; bj < 2; ++bj) { const f32x4 v0 = acc[ai][bj][m][0], v1 = acc[ai][bj][m][1];
                        const f32x2 a = gelu_pk((f32x2){v0[0], v0[1]}), b = gelu_pk((f32x2){v0[2], v0[3]}), c = gelu_pk((f32x2){v1[0], v1[1]}), d = gelu_pk((f32x2){v1[2], v1[3]});
                        store8_bf16(rowp + bj * HALF, (f32x4){a.x, a.y, b.x, b.y}, (f32x4){c.x, c.y, d.x, d.y}); } }
        } else {
#pragma unroll
            for (int ai = 0; ai < 2; ++ai)
#pragma unroll
                for (int m = 0; m < 4; ++m) { bf16_t* rowp = Z + (size_t)(row0 + ai * HALF + m * 16) * ldc + col0;
#pragma unroll
                    for (int bj = 0; bj < 2; ++bj) { const f32x4 v0 = acc[ai][bj][m][0], v1 = acc[ai][bj][m][1]; f32x4 o0, o1;
#pragma unroll
                        for (int i = 0; i < 4; ++i) { o0[i] = __builtin_fmaxf(sigmoid_f(v0[i]), 1e-12f); o1[i] = __builtin_fmaxf(sigmoid_f(v1[i]), 1e-12f); }
#if GATE_ST_NT
                        { u32x4 w; w.x = cvt_pk_bf16(o0[0], o0[1]); w.y = cvt_pk_bf16(o0[2], o0[3]); w.z = cvt_pk_bf16(o1[0], o1[1]); w.w = cvt_pk_bf16(o1[2], o1[3]); __builtin_nontemporal_store(w, (u32x4*)(rowp + bj * HALF)); } } }
#else
                        store8_bf16(rowp + bj * HALF, o0, o1); } }
#endif
        }
    }
};

struct EpiGate {
    static constexpr bool PERM = true, AFTER_DRAIN = false; static constexpr int KSEG = 16;
    const bf16_t* G; int ldg; bf16_t* O; int ldo;
    __device__ __forceinline__ void kseg(f32x4 (&acc)[2][2][4][2], const Unit& u, int seg, int wr, int wc, int fr, int fq) const {
        const int row0 = u.pm * BM + wr * 64 + fr; const int col0 = u.pn * BM + wc * 32 + 8 * fq;
#pragma unroll
        for (int ai = 0; ai < 2; ++ai) {
            u32x4 ga[4][2], gb[4][2];
#pragma unroll
            for (int m = 0; m < 4; ++m) { const bf16_t* gp = G + (size_t)(row0 + ai * HALF + m * 16) * ldg + (seg - 1) * 2048 + col0;
#pragma unroll
                for (int bj = 0; bj < 2; ++bj) { ga[m][bj] = GATE_LD((const u32x4*)(gp + bj * HALF)); gb[m][bj] = GATE_LD((const u32x4*)(gp + 2048 + bj * HALF)); } }
#pragma unroll
            for (int m = 0; m < 4; ++m)
#pragma unroll
                for (int bj = 0; bj < 2; ++bj) { const u32x4 a = ga[m][bj], b = gb[m][bj];
                    f32x4 r0, r1;
                    r0[0] = bf_lo(a.x) * __builtin_amdgcn_rcpf(bf_lo(b.x)); r0[1] = bf_hi(a.x) * __builtin_amdgcn_rcpf(bf_hi(b.x));
                    r0[2] = bf_lo(a.y) * __builtin_amdgcn_rcpf(bf_lo(b.y)); r0[3] = bf_hi(a.y) * __builtin_amdgcn_rcpf(bf_hi(b.y));
                    r1[0] = bf_lo(a.z) * __builtin_amdgcn_rcpf(bf_lo(b.z)); r1[1] = bf_hi(a.z) * __builtin_amdgcn_rcpf(bf_hi(b.z));
                    r1[2] = bf_lo(a.w) * __builtin_amdgcn_rcpf(bf_lo(b.w)); r1[3] = bf_hi(a.w) * __builtin_amdgcn_rcpf(bf_hi(b.w));
                    acc[ai][bj][m][0] *= r0; acc[ai][bj][m][1] *= r1; }
            asm volatile("" ::: "memory"); }
    }
    __device__ __forceinline__ void operator()(const f32x4 (&acc)[2][2][4][2], const Unit& u, int wr, int wc, int fr, int fq) const {
        const int row0 = u.pm * BM + wr * 64 + fr; const int col0 = u.pn * BM + wc * 32 + 8 * fq;
        u32x4 gg[2][4][2];
#pragma unroll
        for (int ai = 0; ai < 2; ++ai)
#pragma unroll
            for (int m = 0; m < 4; ++m) { const bf16_t* gp = G + (size_t)(row0 + ai * HALF + m * 16) * ldg + 2 * 2048 + col0;
#pragma unroll
                for (int bj = 0; bj < 2; ++bj) gg[ai][m][bj] = GATE_LD((const u32x4*)(gp + bj * HALF)); }
#pragma unroll
        for (int ai = 0; ai < 2; ++ai)
#pragma unroll
            for (int m = 0; m < 4; ++m) { bf16_t* op = O + (size_t)(row0 + ai * HALF + m * 16) * ldo + col0;
#pragma unroll
                for (int bj = 0; bj < 2; ++bj) { const u32x4 g = gg[ai][m][bj];
                    const f32x4 g0 = (f32x4){bf_lo(g.x), bf_hi(g.x), bf_lo(g.y), bf_hi(g.y)}, g1 = (f32x4){bf_lo(g.z), bf_hi(g.z), bf_lo(g.w), bf_hi(g.w)};
                    store8_bf16(op + bj * HALF, acc[ai][bj][m][0] * g0, acc[ai][bj][m][1] * g1); } }
    }
};

template <bool SLAB> struct EpiResidT {
    static constexpr bool PERM = !SLAB, AFTER_DRAIN = false; static constexpr int KSEG = 0;
    const float* gv; int gstride; void* Tw; int ldc; int klen, nlat;
    __device__ __forceinline__ void kseg(f32x4 (&)[2][2][4][2], const Unit&, int, int, int, int, int) const {}
    __device__ __forceinline__ void operator()(const f32x4 (&acc)[2][2][4][2], const Unit& u, int wr, int wc, int fr, int fq) const {
        const int row0 = u.pm * BM + wr * 64 + fr; const int grp = u.pm < 64 ? (u.pm >> 4) : 4;
        if constexpr (SLAB) {
            const int col0 = u.pn * BM + wc * 32 + 4 * fq;
            f32x4 g[2][2];
#pragma unroll
            for (int bj = 0; bj < 2; ++bj)
#pragma unroll
                for (int n = 0; n < 2; ++n) g[bj][n] = *(const f32x4*)(gv + (size_t)grp * gstride + col0 + bj * HALF + n * 16);
#pragma unroll
            for (int ai = 0; ai < 2; ++ai)
#pragma unroll
                for (int m = 0; m < 4; ++m) { float* pp = (float*)Tw + ((size_t)(u.ka / klen) * 1024 + (size_t)(row0 + ai * HALF + m * 16 - nlat)) * ldc + col0;
#pragma unroll
                    for (int bj = 0; bj < 2; ++bj)
#pragma unroll
                        for (int n = 0; n < 2; ++n) *(f32x4*)(pp + bj * HALF + n * 16) = g[bj][n] * acc[ai][bj][m][n]; }
        } else {
            const int col0 = u.pn * BM + wc * 32 + 8 * fq;
            f32x4 g[2][2];
#pragma unroll
            for (int bj = 0; bj < 2; ++bj)
#pragma unroll
                for (int n = 0; n < 2; ++n) g[bj][n] = *(const f32x4*)(gv + (size_t)grp * gstride + col0 + bj * HALF + n * 4);
#pragma unroll
            for (int ai = 0; ai < 2; ++ai)
#pragma unroll
                for (int m = 0; m < 4; ++m) { bf16_t* tp = (bf16_t*)Tw + (size_t)(row0 + ai * HALF + m * 16) * ldc + col0;
#pragma unroll
                    for (int bj = 0; bj < 2; ++bj) store8_bf16(tp + bj * HALF, g[bj][0] * acc[ai][bj][m][0], g[bj][1] * acc[ai][bj][m][1]); }
        }
    }
};

struct EpiSwiglu {
    static constexpr bool PERM = true, AFTER_DRAIN = false; static constexpr int KSEG = 0;
    bf16_t* H; int ldc;
    __device__ __forceinline__ void kseg(f32x4 (&)[2][2][4][2], const Unit&, int, int, int, int, int) const {}
    __device__ __forceinline__ void operator()(const f32x4 (&acc)[2][2][4][2], const Unit& u, int wr, int wc, int fr, int fq) const {
        const int row0 = u.pm * BM + wr * 64 + fr, col0 = u.pn * HALF + wc * 32 + 8 * fq;
#pragma unroll
        for (int ai = 0; ai < 2; ++ai)
#pragma unroll
            for (int m = 0; m < 4; ++m) { bf16_t* rowp = H + (size_t)(row0 + ai * HALF + m * 16) * ldc + col0; f32x4 o[2];
#pragma unroll
                for (int n = 0; n < 2; ++n) { const f32x4 gt = acc[ai][0][m][n], up = acc[ai][1][m][n];
#pragma unroll
                    for (int i = 0; i < 4; ++i) o[n][i] = gt[i] * sigmoid_f(gt[i]) * up[i]; }
                store8_bf16(rowp, o[0], o[1]); }
    }
};
template <class Epi, class Sched, bool ALIGN_EPI = false, bool SP2 = false>
__device__ __forceinline__ void gemm_phase(PG8_LAS unsigned char* lds, const Gemm g, const Sched& S, const Epi& E) {
    int tid_ = threadIdx.x; asm volatile("" : "+v"(tid_));
    const int tid = tid_, wid = __builtin_amdgcn_readfirstlane(tid >> 6), lane = tid & 63, wr = wid >> 2, wc = wid & 3, fr = lane & 15, fq = lane >> 4;
    const int K = g.K, nt = K / BK;
    unsigned voffA[2], voffB[2];
#pragma unroll
    for (int i = 0; i < 2; ++i) { int R, C; stage_rc(tid * 16 + i * 8192, R, C); const int Rb = Epi::PERM ? ((R & ~31) + perm32(R & 31)) : R;
        voffA[i] = (unsigned)(R * g.lda + C) * 2u; voffB[i] = (unsigned)(Rb * g.ldb + C) * 2u; }
    const size_t kstep = (size_t)(BK * 2);
    const size_t hstepA = (size_t)HALF * g.lda * 2, hstepB = (size_t)HALF * g.ldb * 2;
    const size_t tstepA = 2 * hstepA, tstepB = 2 * hstepB;
    const unsigned ldsw = (unsigned)wid * 1024u;
    const int aoff = lds_byte(wr * 64 + fr, fq * 8), boff = lds_byte(wc * 32 + fr, fq * 8);
#define PG8_SA(b, h) (((b) * 2 + (h)) * HTB)
#define PG8_SB(b, h) ((4 + (b) * 2 + (h)) * HTB)
#define PG8_STAGE(bufoff, gbase, voff) do { _Pragma("unroll") for (int _i = 0; _i < 2; ++_i) \
        __builtin_amdgcn_global_load_lds((const unsigned*)((const char*)(gbase) + (voff)[_i]), (PG8_LAS unsigned*)(lds + (bufoff) + ldsw + _i * 8192), 16, 0, 0); } while (0)
#define PG8_LDA(dst, b, h) do { _Pragma("unroll") for (int m = 0; m < 4; ++m) _Pragma("unroll") for (int k = 0; k < 2; ++k) dst[m][k] = *(const PG8_LAS bf16x8*)(lds + PG8_SA(b, h) + aoff + m * 2048 + k * 1024); } while (0)
#define PG8_LDB(dst, b, h) do { _Pragma("unroll") for (int n = 0; n < 2; ++n) _Pragma("unroll") for (int k = 0; k < 2; ++k) dst[n][k] = *(const PG8_LAS bf16x8*)(lds + PG8_SB(b, h) + boff + n * 2048 + k * 1024); } while (0)
#define PG8_MMA(ai, bj, At, Bt) do { __builtin_amdgcn_s_setprio(1); _Pragma("unroll") for (int m = 0; m < 4; ++m) _Pragma("unroll") for (int n = 0; n < 2; ++n) _Pragma("unroll") for (int k = 0; k < 2; ++k) \
        acc[ai][bj][m][n] = __builtin_amdgcn_mfma_f32_16x16x32_bf16(Bt[n][k], At[m][k], acc[ai][bj][m][n], 0, 0, 0); __builtin_amdgcn_s_setprio(0); } while (0)
#define PG8_WAIT_V(n) asm volatile("s_waitcnt vmcnt(" #n ")" ::: "memory")
#define PG8_WAIT_L(n) asm volatile("s_waitcnt lgkmcnt(" #n ")" ::: "memory")
#define PG8_BAR __builtin_amdgcn_s_barrier()
#define PG8_SCHED __builtin_amdgcn_sched_barrier(0)
    Unit cur, nxt; int ui = 0;
    if (!S.next(0, cur)) return;
    f32x4 acc[2][2][4][2];
#pragma unroll
    for (int a = 0; a < 2; ++a)
#pragma unroll
        for (int b = 0; b < 2; ++b)
#pragma unroll
            for (int m = 0; m < 4; ++m)
#pragma unroll
                for (int n = 0; n < 2; ++n) acc[a][b][m][n] = (f32x4){0.f, 0.f, 0.f, 0.f};
    bf16x8 At[4][2], B0[2][2], B1[2][2];
    const char* cA = (const char*)g.A + (size_t)cur.pm * tstepA + (size_t)cur.ka * 2; const char* cB = (const char*)g.Bt + (size_t)cur.pn * tstepB + (size_t)cur.ka * 2;
    S.a_ready(cur);
    if constexpr (SP2) {
        PG8_STAGE(PG8_SB(0, 0), cB, voffB); PG8_STAGE(PG8_SB(0, 1), cB + hstepB, voffB); PG8_STAGE(PG8_SA(0, 0), cA, voffA); PG8_STAGE(PG8_SA(0, 1), cA + hstepA, voffA);
        if (wr == 1) PG8_BAR;
        PG8_WAIT_V(2); PG8_BAR;
        PG8_STAGE(PG8_SB(1, 0), cB + kstep, voffB); PG8_STAGE(PG8_SA(1, 0), cA + kstep, voffA); PG8_STAGE(PG8_SB(1, 1), cB + hstepB + kstep, voffB);
        PG8_WAIT_V(6); PG8_BAR;
    } else {
        PG8_STAGE(PG8_SB(0, 0), cB, voffB); PG8_STAGE(PG8_SA(0, 0), cA, voffA); PG8_STAGE(PG8_SB(0, 1), cB + hstepB, voffB); PG8_STAGE(PG8_SA(0, 1), cA + hstepA, voffA);
        if (wr == 1) PG8_BAR;
        PG8_WAIT_V(4); PG8_BAR;
        PG8_STAGE(PG8_SB(1, 0), cB + kstep, voffB); PG8_STAGE(PG8_SA(1, 0), cA + kstep, voffA); PG8_STAGE(PG8_SB(1, 1), cB + hstepB + kstep, voffB);
        PG8_WAIT_V(6); PG8_BAR;
    }
    for (;;) {
        const bool has_next = S.next(ui + 1, nxt);
        const char* nA = has_next ? (const char*)g.A + (size_t)nxt.pm * tstepA + (size_t)nxt.ka * 2 : cA; const char* nB = has_next ? (const char*)g.Bt + (size_t)nxt.pn * tstepB + (size_t)nxt.ka * 2 : cB;
        for (int t = 0; t < nt; t += 2) {
            const bool last = (t == nt - 2);
            if constexpr (Epi::KSEG > 0) { if (t > 0 && (t % Epi::KSEG) == 0) E.kseg(acc, cur, t / Epi::KSEG, wr, wc, fr, fq); }
            const char* a1 = cA + (size_t)(t + 1) * kstep;
            const char* a2 = last ? nA : cA + (size_t)(t + 2) * kstep; const char* b2 = last ? nB : cB + (size_t)(t + 2) * kstep;
            const char* a3 = a2 + kstep; const char* b3 = b2 + kstep;
            if (last && has_next) S.a_ready(nxt);
            if constexpr (SP2) {
            PG8_LDB(B0, 0, 0); PG8_LDB(B1, 0, 1); PG8_SCHED; PG8_LDA(At, 0, 0); PG8_STAGE(PG8_SA(1, 1), a1 + hstepA, voffA);
            PG8_WAIT_V(8); PG8_WAIT_L(0); PG8_BAR; PG8_MMA(0, 0, At, B0); PG8_MMA(0, 1, At, B1); PG8_BAR; PG8_SCHED;
            PG8_LDA(At, 0, 1); PG8_STAGE(PG8_SB(0, 0), b2, voffB); PG8_STAGE(PG8_SB(0, 1), b2 + hstepB, voffB); PG8_STAGE(PG8_SA(0, 0), a2, voffA);
            PG8_WAIT_V(8); PG8_WAIT_L(0); PG8_BAR; PG8_MMA(1, 0, At, B0); PG8_MMA(1, 1, At, B1); PG8_BAR; PG8_SCHED;
            PG8_LDB(B0, 1, 0); PG8_LDB(B1, 1, 1); PG8_SCHED; PG8_LDA(At, 1, 0); PG8_STAGE(PG8_SA(0, 1), a2 + hstepA, voffA);
            PG8_WAIT_V(8); PG8_WAIT_L(0); PG8_BAR; PG8_MMA(0, 0, At, B0); PG8_MMA(0, 1, At, B1); PG8_BAR; PG8_SCHED;
            PG8_LDA(At, 1, 1); PG8_STAGE(PG8_SB(1, 0), b3, voffB); PG8_STAGE(PG8_SB(1, 1), b3 + hstepB, voffB); PG8_STAGE(PG8_SA(1, 0), a3, voffA);
            PG8_WAIT_V(8); PG8_WAIT_L(0); PG8_BAR; PG8_MMA(1, 0, At, B0); PG8_MMA(1, 1, At, B1); PG8_BAR; PG8_SCHED;
            } else {
            PG8_LDB(B0, 0, 0); PG8_SCHED; PG8_LDA(At, 0, 0); PG8_STAGE(PG8_SA(1, 1), a1 + hstepA, voffA);
            PG8_WAIT_L(8); PG8_BAR; PG8_WAIT_L(0); PG8_MMA(0, 0, At, B0); PG8_BAR; PG8_SCHED;
            PG8_LDB(B1, 0, 1); PG8_STAGE(PG8_SB(0, 0), b2, voffB);
            PG8_BAR; PG8_WAIT_L(0); PG8_MMA(0, 1, At, B1); PG8_BAR;
            PG8_LDA(At, 0, 1); PG8_STAGE(PG8_SA(0, 0), a2, voffA);
            PG8_BAR; PG8_WAIT_L(0); PG8_MMA(1, 0, At, B0); PG8_BAR; PG8_SCHED;
            PG8_STAGE(PG8_SB(0, 1), b2 + hstepB, voffB);
            PG8_WAIT_V(6); PG8_BAR; PG8_MMA(1, 1, At, B1); PG8_BAR;
            PG8_LDB(B0, 1, 0); PG8_SCHED; PG8_LDA(At, 1, 0); PG8_STAGE(PG8_SA(0, 1), a2 + hstepA, voffA);
            PG8_WAIT_L(8); PG8_BAR; PG8_WAIT_L(0); PG8_MMA(0, 0, At, B0); PG8_BAR; PG8_SCHED;
            PG8_LDB(B1, 1, 1); PG8_STAGE(PG8_SB(1, 0), b3, voffB);
            PG8_BAR; PG8_WAIT_L(0); PG8_MMA(0, 1, At, B1); PG8_BAR;
            PG8_LDA(At, 1, 1); PG8_STAGE(PG8_SA(1, 0), a3, voffA);
            PG8_BAR; PG8_WAIT_L(0); PG8_MMA(1, 0, At, B0); PG8_BAR; PG8_SCHED;
            PG8_STAGE(PG8_SB(1, 1), b3 + hstepB, voffB);
            PG8_WAIT_V(6); PG8_BAR; PG8_MMA(1, 1, At, B1); PG8_BAR;
            }
        }
        if constexpr (ALIGN_EPI) { if (wr == 0) PG8_BAR; }
        if constexpr (!Epi::AFTER_DRAIN) { E(acc, cur, wr, wc, fr, fq); S.done(cur); }
        if (!has_next) break;
#pragma unroll
        for (int a = 0; a < 2; ++a)
#pragma unroll
            for (int b = 0; b < 2; ++b)
#pragma unroll
                for (int m = 0; m < 4; ++m)
#pragma unroll
                    for (int n = 0; n < 2; ++n) acc[a][b][m][n] = (f32x4){0.f, 0.f, 0.f, 0.f};
        cur = nxt; cA = nA; cB = nB; ++ui;
        if constexpr (ALIGN_EPI) { if (wr == 1) PG8_BAR; }
    }
    PG8_WAIT_V(0);
    if constexpr (!ALIGN_EPI) { if (wr == 0) PG8_BAR; }
    PG8_BAR;
    if constexpr (Epi::AFTER_DRAIN) { E.fused(acc, cur, wr, wc, fr, fq, lds, wid, lane); S.done(cur); }
#undef PG8_SA
#undef PG8_SB
#undef PG8_STAGE
#undef PG8_LDA
#undef PG8_LDB
#undef PG8_MMA
#undef PG8_WAIT_V
#undef PG8_WAIT_L
#undef PG8_BAR
#undef PG8_SCHED
}
}

constexpr int NWAVES = 8;
constexpr int D = 2048, NBATCH = 4, SEQ = 4096, DEPTH = 4, CTXL = 256;
constexpr int MLAT = NBATCH * SEQ, MCTX = NBATCH * CTXL, MTOT = MLAT + MCTX;
constexpr int INW = 12288, BW = 1024, FFH = 5632, NHEAD = 8;
constexpr int Q_OFF = 0, K_OFF = 1024, V_OFF = 2048, BU_OFF = 3072, C_OFF = 5120, G_OFF = 6144;
constexpr int YW = 3 * BW;
constexpr float LN_EPS = 1e-6f;
constexpr float ALPHA = 1.681792830507429f;
constexpr float QSCALE = 0.125f * 1.4426950408889634f;

constexpr size_t MiB = 1u << 20;
constexpr size_t WS_CTL = 0, CTL_ZERO_BYTES = 1 * MiB;
constexpr size_t WS_ROPE = 1 * MiB;
constexpr size_t WS_MODS = 2 * MiB;
constexpr size_t WS_MODP = 4 * MiB;
constexpr size_t WS_WSP = 20 * MiB;
constexpr size_t WS_WPOOL = 21 * MiB;
constexpr size_t WS_WIN = 24 * MiB;
constexpr size_t WS_WBR = 216 * MiB;
constexpr size_t WS_WOUT = 264 * MiB;
constexpr size_t WS_WGU = 296 * MiB;
constexpr size_t WS_WDN = 472 * MiB;
constexpr size_t WS_X = 560 * MiB;
constexpr size_t WS_HA = 696 * MiB;
constexpr size_t WS_Y = 764 * MiB;
constexpr size_t WS_MG = 866 * MiB;
constexpr size_t WS_Z = 934 * MiB;
constexpr size_t WS_KB = 1342 * MiB, WS_VB = 1378 * MiB;
constexpr size_t WS_END = 1414 * MiB;
static_assert(WS_MODP + 16ull * 4 * 5 * 12288 * 4 <= WS_WSP && WS_WIN + 4ull * 12288 * 2048 * 2 <= WS_WBR && WS_WBR + 4ull * 2048 * 3072 * 2 <= WS_WOUT && WS_WOUT + 4ull * 2048 * 2048 * 2 <= WS_WGU, "ws map 1");
static_assert(WS_WGU + 4ull * 11264 * 2048 * 2 <= WS_WDN && WS_WDN + 4ull * 2048 * 5632 * 2 <= WS_X && WS_X + (size_t)MTOT * D * 4 <= WS_HA && WS_HA + (size_t)MTOT * D * 2 <= WS_Y, "ws map 2");
static_assert(WS_Y + (size_t)MTOT * YW * 2 <= WS_MG && WS_MG + (size_t)MTOT * D * 2 <= WS_Z && WS_Z + (size_t)MTOT * INW * 2 <= WS_KB && WS_KB + 32ull * 4352 * 256 <= WS_VB && WS_VB + 32ull * 4352 * 256 <= WS_END, "ws map 3");
constexpr int CW_BAR = 4096;

constexpr int RING_OFF = 0, RING_BYTES = 131072;
constexpr int LDSCTL_OFF = RING_BYTES, MISC_OFF = LDSCTL_OFF + 320;
constexpr int LDS_BYTES = 147456;

#define GAS __attribute__((address_space(1)))
#define LAS __attribute__((address_space(3)))
typedef unsigned short bf16;
typedef unsigned v4u __attribute__((ext_vector_type(4)));
typedef unsigned v2u __attribute__((ext_vector_type(2)));
typedef float f32x4 __attribute__((ext_vector_type(4)));
typedef float f32x16 __attribute__((ext_vector_type(16)));
typedef short bf16x8 __attribute__((ext_vector_type(8)));
typedef short s16x4 __attribute__((ext_vector_type(4)));
typedef GAS unsigned gu32;
#define RLX_AGENT __ATOMIC_RELAXED, __HIP_MEMORY_SCOPE_AGENT
#define LDS_WAIT() asm volatile("s_waitcnt lgkmcnt(0)" ::: "memory")
#define VM_WAIT() asm volatile("s_waitcnt vmcnt(0)" ::: "memory")
__device__ __forceinline__ unsigned f2bf(float f) { unsigned u = __builtin_bit_cast(unsigned, f); return (u + 0x7fffu + ((u >> 16) & 1u)) >> 16; }
__device__ __forceinline__ unsigned pk2(float lo, float hi) { return f2bf(lo) | (f2bf(hi) << 16); }
__device__ __forceinline__ unsigned cvtpk(float lo, float hi) { unsigned r; asm volatile("v_cvt_pk_bf16_f32 %0, %1, %2" : "=v"(r) : "v"(lo), "v"(hi)); return r; }
__device__ __forceinline__ float bflo(unsigned w) { return __uint_as_float(w << 16); }
__device__ __forceinline__ float bfhi(unsigned w) { return __uint_as_float(w & 0xffff0000u); }

#define XB_TMO      128
#define XB_XCNT(j)  (256  + 64 * (j))
#define XB_XSUB(j)  (1280 + 64 * (j))
#define XB_XGEN(j)  (2304 + 64 * (j))
#define XB_TOP      3328
#define XB_TOPGEN   3392
#define XCD_BAR_WORDS 3456
#define XB_SPIN_CAP (1u << 18)

__device__ __forceinline__ unsigned xb_ld(unsigned* p)              { return __hip_atomic_load(p, __ATOMIC_RELAXED, __HIP_MEMORY_SCOPE_AGENT); }
__device__ __forceinline__ unsigned xb_add(unsigned* p, unsigned v) { return __hip_atomic_fetch_add(p, v, __ATOMIC_RELAXED, __HIP_MEMORY_SCOPE_AGENT); }
__device__ __forceinline__ unsigned xb_xcc_id() { return (unsigned)__builtin_amdgcn_s_getreg((3 << 11) | 20) & 0xFu; }
#define XB_SPIN(cond, bar) do { unsigned _sp = 0; while (cond) { __builtin_amdgcn_s_sleep(1); \
    if ((++_sp & 255u) == 0u) { if (xb_ld(&(bar)[XB_TMO])) break; if (_sp > XB_SPIN_CAP) { atomicAdd(&(bar)[XB_TMO], 1u); break; } } } } while (0)

struct XcdBarrier {
    unsigned* bar; unsigned x;
    volatile LAS unsigned* st;
};

__device__ __forceinline__ XcdBarrier xcd_barrier_post(unsigned* bar, volatile LAS unsigned* st) {
    XcdBarrier b; b.bar = bar; b.x = xb_xcc_id(); b.st = st;
    if (threadIdx.x == 0) (void)xb_add(&bar[XB_XCNT(b.x)], 1u);
    return b;
}
__device__ __forceinline__ void xcd_barrier_complete(unsigned* bar, unsigned x, unsigned& nloc, unsigned& nx) {
    const unsigned G = gridDim.x * gridDim.y * gridDim.z;
    unsigned sum, cnt, mine, sp = 0u;
    for (;;) {
        sum = 0u; cnt = 0u; mine = 0u;
#pragma unroll
        for (unsigned j = 0; j < 16; ++j) { const unsigned c = xb_ld(&bar[XB_XCNT(j)]); sum += c; cnt += (c > 0u) ? 1u : 0u; mine = (j == x) ? c : mine; }
        if (sum == G) break;
        __builtin_amdgcn_s_sleep(1);
        if ((++sp & 255u) == 0u) { if (xb_ld(&bar[XB_TMO])) break; if (sp > XB_SPIN_CAP) { atomicAdd(&bar[XB_TMO], 1u); break; } }
    }
    nloc = mine > 0u ? mine : 1u; nx = cnt > 0u ? cnt : 1u;
}

__device__ __forceinline__ void xcd_barrier(const XcdBarrier& b) {
    asm volatile("s_waitcnt vmcnt(0)" ::: "memory");
    __syncthreads();
    if (threadIdx.x == 0) {
        unsigned* bar = b.bar;
        __builtin_amdgcn_s_waitcnt(0);
        unsigned nloc = b.st[0], nx = b.st[1];
        if (nloc == 0u) { xcd_barrier_complete(bar, b.x, nloc, nx); b.st[0] = nloc; b.st[1] = nx; }
        const unsigned old = xb_add(&bar[XB_XSUB(b.x)], 1u);
        const unsigned gen = old / nloc;
        if (old + 1u == (gen + 1u) * nloc) {
            __builtin_amdgcn_fence(__ATOMIC_RELEASE, "agent");
            asm volatile("s_waitcnt vmcnt(0)" ::: "memory");
            const unsigned og = xb_add(&bar[XB_TOP], 1u);
            const unsigned tg = og / nx;
            if (og + 1u == (tg + 1u) * nx) xb_add(&bar[XB_TOPGEN], 1u);
            else XB_SPIN(xb_ld(&bar[XB_TOPGEN]) == tg, bar);
            __builtin_amdgcn_fence(__ATOMIC_ACQUIRE, "agent");
            xb_add(&bar[XB_XGEN(b.x)], 1u);
            asm volatile("s_waitcnt vmcnt(0)" ::: "memory");
        } else {
            XB_SPIN(xb_ld(&bar[XB_XGEN(b.x)]) == gen, bar);
            __builtin_amdgcn_fence(__ATOMIC_ACQUIRE, "agent");
            asm volatile("s_waitcnt vmcnt(0)" ::: "memory");
        }
    }
    __syncthreads();
}


struct Frame {
    LAS unsigned char* lds;
    volatile LAS unsigned* MISC;
    gu32* ctl;
    int vcu, G, bx;
    __device__ __forceinline__ int ltid() const { int t = threadIdx.x; asm volatile("" : "+v"(t)); return t; }
    const float *x, *c, *ctx, *cctx, *w_ada, *b_ada, *w_in, *lam_qk, *subln_g, *gln_g, *gln_b, *w_sp, *b_sp, *w_pool, *pool_scale, *w_branch, *w_out, *ln1_g, *ln1_b, *w_gu, *w_down, *ln2_g, *ln2_b;
    float* out;
    float *rope, *mods, *modp, *X;
    bf16 *Wsp, *Wpool, *Win, *Wbr, *Wout, *Wgu, *Wdn, *HA, *Y, *MG, *Z, *KB, *VB;
};

typedef __attribute__((address_space(4))) const unsigned char* kptr_t;
__device__ __forceinline__ void frame_ptrs(Frame& F) {
    kptr_t kp = (kptr_t)__builtin_amdgcn_kernarg_segment_ptr(); asm volatile("" : "+s"(kp));
#define KIN(i) (*(const float* const __attribute__((address_space(4)))*)(kp + 8 * (i)))
    F.x = KIN(0); F.c = KIN(1); F.ctx = KIN(2); F.cctx = KIN(3); F.w_ada = KIN(4); F.b_ada = KIN(5); F.w_in = KIN(6); F.lam_qk = KIN(7); F.subln_g = KIN(8);
    F.gln_g = KIN(9); F.gln_b = KIN(10); F.w_sp = KIN(11); F.b_sp = KIN(12); F.w_pool = KIN(13); F.pool_scale = KIN(14); F.w_branch = KIN(15); F.w_out = KIN(16);
    F.ln1_g = KIN(17); F.ln1_b = KIN(18); F.w_gu = KIN(19); F.w_down = KIN(20); F.ln2_g = KIN(21); F.ln2_b = KIN(22);
#undef KIN
    F.out = *(float* const __attribute__((address_space(4)))*)(kp + 184);
    unsigned char* ws = *(unsigned char* const __attribute__((address_space(4)))*)(kp + 192);
    F.rope = (float*)(ws + WS_ROPE); F.mods = (float*)(ws + WS_MODS); F.modp = (float*)(ws + WS_MODP); F.X = (float*)(ws + WS_X);
    F.Wsp = (bf16*)(ws + WS_WSP); F.Wpool = (bf16*)(ws + WS_WPOOL); F.Win = (bf16*)(ws + WS_WIN); F.Wbr = (bf16*)(ws + WS_WBR); F.Wout = (bf16*)(ws + WS_WOUT); F.Wgu = (bf16*)(ws + WS_WGU); F.Wdn = (bf16*)(ws + WS_WDN);
    F.HA = (bf16*)(ws + WS_HA); F.Y = (bf16*)(ws + WS_Y); F.MG = (bf16*)(ws + WS_MG); F.Z = (bf16*)(ws + WS_Z); F.KB = (bf16*)(ws + WS_KB); F.VB = (bf16*)(ws + WS_VB);
}
__device__ __forceinline__ float wave_sum(float v) {
    v += __builtin_bit_cast(float, __builtin_amdgcn_update_dpp(0, __builtin_bit_cast(int, v), 0xB1, 0xF, 0xF, true));
    v += __builtin_bit_cast(float, __builtin_amdgcn_update_dpp(0, __builtin_bit_cast(int, v), 0x4E, 0xF, 0xF, true));
    v += __builtin_bit_cast(float, __builtin_amdgcn_update_dpp(0, __builtin_bit_cast(int, v), 0x141, 0xF, 0xF, true));
    v += __builtin_bit_cast(float, __builtin_amdgcn_update_dpp(0, __builtin_bit_cast(int, v), 0x140, 0xF, 0xF, true));
    v += __shfl_xor(v, 16);
    { auto rr = __builtin_amdgcn_permlane32_swap(__float_as_uint(v), __float_as_uint(v), false, false); v = __uint_as_float(rr[0]) + __uint_as_float(rr[1]); }
    return v;
}

__device__ __forceinline__ void cvt_item(const float* W, int N, int k0, int ncol0, bool perm, bf16* WT, size_t drow0, int ldk, int dk0, LAS float* scr, int lane) {
#pragma unroll 8
    for (int i = 0; i < 32; ++i) { const int kk = 2 * i + (lane >> 5); scr[kk * 33 + (lane & 31)] = __builtin_nontemporal_load(W + (size_t)(k0 + kk) * N + ncol0 + (lane & 31)); }
    LDS_WAIT(); asm volatile("" ::: "memory");
    const int c = lane & 7;
#pragma unroll
    for (int j = 0; j < 4; ++j) { const int n = (lane >> 3) + 8 * j; const int ns = perm ? ((n & 1) * 16 + (n >> 1)) : n; const LAS float* s = scr + (8 * c) * 33 + ns;
        v4u o; o.x = pk2(s[0 * 33], s[1 * 33]); o.y = pk2(s[2 * 33], s[3 * 33]); o.z = pk2(s[4 * 33], s[5 * 33]); o.w = pk2(s[6 * 33], s[7 * 33]);
        *(GAS v4u*)(WT + (drow0 + n) * (size_t)ldk + dk0 + k0 + 8 * c) = o; }
    LDS_WAIT(); asm volatile("" ::: "memory");
}
constexpr int CV_IN = 32 * 384, CV_GU = 32 * 352, CV_DN = 88 * 64, CV_BR = 3 * 16 * 64, CV_OUT = 32 * 64, CV_POOL = 4 * 4 * 8, CV_LAYER = CV_IN + CV_GU + CV_DN + CV_BR + CV_OUT + CV_POOL;
__device__ __forceinline__ void cvt_dispatch(Frame& F, int it, LAS float* scr) {
    const int l = it / CV_LAYER; int r = it - l * CV_LAYER;
    if (r < CV_IN) { const int kb = r / 384, nb = r - kb * 384;
        cvt_item(F.w_in + (size_t)l * D * INW, INW, 64 * kb, 32 * nb, nb < 64, F.Win + (size_t)l * INW * D, (size_t)32 * nb, D, 0, scr, (F.ltid() & 63)); return; }
    r -= CV_IN;
    if (r < CV_GU) { const int kb = r / 352, nb = r - kb * 352; const int tpn = nb >> 3, half = (nb >> 2) & 1, jj0 = (nb & 3) * 32;
        cvt_item(F.w_gu + (size_t)l * D * 2 * FFH, 2 * FFH, 64 * kb, half * FFH + 128 * tpn + jj0, false, F.Wgu + (size_t)l * 2 * FFH * D, (size_t)32 * nb, D, 0, scr, (F.ltid() & 63)); return; }
    r -= CV_GU;
    if (r < CV_DN) { const int kb = r >> 6, nb = r & 63;
        cvt_item(F.w_down + (size_t)l * FFH * D, D, 64 * kb, 32 * nb, false, F.Wdn + (size_t)l * D * FFH, (size_t)32 * nb, FFH, 0, scr, (F.ltid() & 63)); return; }
    r -= CV_DN;
    if (r < CV_BR) { const int n = r >> 10, rr = r & 1023, kb = rr >> 6, nb = rr & 63;
        cvt_item(F.w_branch + ((size_t)l * 3 + n) * BW * D, D, 64 * kb, 32 * nb, false, F.Wbr + (size_t)l * D * YW, (size_t)32 * nb, YW, BW * n, scr, (F.ltid() & 63)); return; }
    r -= CV_BR;
    if (r < CV_OUT) { const int kb = r >> 6, nb = r & 63;
        cvt_item(F.w_out + (size_t)l * D * D, D, 64 * kb, 32 * nb, false, F.Wout + (size_t)l * D * D, (size_t)32 * nb, D, 0, scr, (F.ltid() & 63)); return; }
    r -= CV_OUT;
    { const int g = r >> 5, rr = r & 31, kb = rr >> 3, nb = rr & 7;
        cvt_item(F.w_pool + ((size_t)l * 4 + g) * 65536, 256, 64 * kb, 32 * nb, false, F.Wpool + ((size_t)l * 4 + g) * 65536, (size_t)32 * nb, 256, 0, scr, (F.ltid() & 63)); }
}

__device__ __forceinline__ double rope_inv(int p) {
    const double t[16] = {1.0, 0.5623413251903491, 0.31622776601683794, 0.1778279410038923, 0.1, 0.05623413251903491, 0.03162277660168379, 0.01778279410038923,
                          0.01, 0.005623413251903491, 0.003162277660168379, 0.001778279410038923, 0.001, 0.0005623413251903491, 0.00031622776601683794, 0.0001778279410038923};
    double r = t[0];
#pragma unroll
    for (int i = 1; i < 16; ++i) r = (p == i) ? t[i] : r;
    return r;
}
#ifndef TAILWORK
#define TAILWORK 0
#endif
__device__ __forceinline__ void ada_partial_layer(Frame& F, int l, int gw, int NGW) {
    LAS float* scs = (LAS float*)(F.lds);
    __syncthreads();
    for (int i = F.ltid(); i < 5 * D; i += NWAVES * 64) { const int g = i >> 11, k = i & 2047; const float v = g < 4 ? F.c[g * D + k] : F.cctx[k]; scs[i] = v / (1.0f + __expf(-v)); }
    __syncthreads();
    for (int it = gw; it < 16 * 48; it += NGW) {
        const int ks = it / 48, cgw = it - ks * 48; const int col = cgw * 256 + (F.ltid() & 63) * 4;
        const float* wp = F.w_ada + ((size_t)l * D + ks * 128) * INW + col;
        f32x4 a0 = {0.f, 0.f, 0.f, 0.f}, a1 = a0, a2 = a0, a3 = a0, a4 = a0;
#pragma unroll 8
        for (int k = 0; k < 128; ++k) { const f32x4 w = __builtin_nontemporal_load((const GAS f32x4*)(wp + (size_t)k * INW)); const int kk = ks * 128 + k;
            a0 += w * scs[kk]; a1 += w * scs[D + kk]; a2 += w * scs[2 * D + kk]; a3 += w * scs[3 * D + kk]; a4 += w * scs[4 * D + kk]; }
        float* pp = F.modp + (((size_t)ks * 4 + l) * 5) * INW + col;
        *(f32x4*)(pp) = a0; *(f32x4*)(pp + INW) = a1; *(f32x4*)(pp + 2 * INW) = a2; *(f32x4*)(pp + 3 * INW) = a3; *(f32x4*)(pp + 4 * INW) = a4;
    }
    __syncthreads();
}
__device__ __forceinline__ void cvt_layer(Frame& F, int l, int gw, int NGW) {
    LAS float* scr = (LAS float*)(F.lds + __builtin_amdgcn_readfirstlane(F.ltid() >> 6) * 16384);
    for (int it = gw; it < CV_LAYER; it += NGW) cvt_dispatch(F, l * CV_LAYER + it, scr);
}
__device__ __forceinline__ void mods_reduce_layer(Frame& F, int l) {
    const int gt = F.vcu * NWAVES * 64 + F.ltid(), NGT = F.G * NWAVES * 64;
    for (int i = gt; i < 5 * (INW / 4); i += NGT) { const int g = i / (INW / 4), j = (i - g * (INW / 4)) * 4;
        f32x4 sm = *(const f32x4*)(F.b_ada + (size_t)l * INW + j);
#pragma unroll
        for (int ks = 0; ks < 16; ++ks) sm += *(const f32x4*)(F.modp + (((size_t)ks * 4 + l) * 5 + g) * INW + j);
        *(f32x4*)(F.mods + ((size_t)l * 5 + g) * INW + j) = sm; }
}
__device__ __forceinline__ void phase_a1(Frame& F) {
    const int gw = F.vcu * NWAVES + __builtin_amdgcn_readfirstlane(F.ltid() >> 6), NGW = F.G * NWAVES;
#pragma nounroll
    for (int l = 0; l < (TAILWORK ? 1 : DEPTH); ++l) ada_partial_layer(F, l, gw, NGW);
#pragma nounroll
    for (int l = 0; l < (TAILWORK ? 1 : DEPTH); ++l) cvt_layer(F, l, gw, NGW);
    for (int it = gw; it < (DEPTH * 8 * 128 * 128) / 512; it += NGW) { const size_t e = (size_t)it * 512 + (F.ltid() & 63) * 8;
        const f32x4 a = *(const f32x4*)(F.w_sp + e), b = *(const f32x4*)(F.w_sp + e + 4);
        v4u o; o.x = pk2(a[0], a[1]); o.y = pk2(a[2], a[3]); o.z = pk2(b[0], b[1]); o.w = pk2(b[2], b[3]); *(v4u*)(F.Wsp + e) = o; }
    if (gw == 0) {
        for (int e = (F.ltid() & 63); e < 1024; e += 64) { const int pos = e >> 4, pr = e & 15;
            const double ang = (double)pos * rope_inv(pr); const double twopi = 6.283185307179586476925286766559;
            const double kq = __builtin_rint(ang / twopi); const double rr = ang - kq * twopi; const double r2 = rr * rr;
            double sn = 1.0, cs = 1.0;
#pragma unroll
            for (int n = 14; n >= 1; --n) { sn = 1.0 - sn * r2 / (double)((2 * n) * (2 * n + 1)); cs = 1.0 - cs * r2 / (double)((2 * n - 1) * (2 * n)); }
            sn *= rr;
            F.rope[2 * e] = (float)cs; F.rope[2 * e + 1] = (float)sn; }
    }
}
__device__ __forceinline__ void phase_a2(Frame& F) {
#pragma nounroll
    for (int l = 0; l < (TAILWORK ? 1 : DEPTH); ++l) mods_reduce_layer(F, l); }
__device__ __forceinline__ void ln_row(const float* src, const bf16* tadd, const float* part, int npart, const float* gam, const float* bet, float* xo, float xs, bf16* ho, const float* sc, const float* sh, int lane) {
    f32x4 v[8]; float s = 0.f;
#pragma unroll
    for (int j = 0; j < 8; ++j) v[j] = __builtin_nontemporal_load((const GAS f32x4*)(src + 4 * lane + 256 * j));
    if (tadd) {
#pragma unroll
        for (int j = 0; j < 8; ++j) { const v2u t2 = *(const GAS v2u*)(tadd + 4 * lane + 256 * j); v[j] += (f32x4){bflo(t2.x), bfhi(t2.x), bflo(t2.y), bfhi(t2.y)}; } }
    for (int p = 0; p < npart; ++p) {
#pragma unroll
        for (int j = 0; j < 8; ++j) v[j] += __builtin_nontemporal_load((const GAS f32x4*)(part + (size_t)p * 1024 * D + 4 * lane + 256 * j)); }
#pragma unroll
    for (int j = 0; j < 8; ++j) s += (v[j][0] + v[j][1]) + (v[j][2] + v[j][3]);
    const float mean = wave_sum(s) * (1.f / D); float s2 = 0.f;
#pragma unroll
    for (int j = 0; j < 8; ++j) { v[j] = v[j] - mean; s2 += (v[j][0] * v[j][0] + v[j][1] * v[j][1]) + (v[j][2] * v[j][2] + v[j][3] * v[j][3]); }
    const float rstd = 1.0f / sqrtf(wave_sum(s2) * (1.f / D) + LN_EPS);
#pragma unroll
    for (int j = 0; j < 8; ++j) { const int col = 4 * lane + 256 * j; f32x4 xn = v[j] * rstd;
        if (gam) xn = xn * *(const f32x4*)(gam + col) + *(const f32x4*)(bet + col);
        if (xo) __builtin_nontemporal_store(xn * xs, (GAS f32x4*)(xo + col));
        if (ho) { const f32x4 hv = xn * (1.0f + *(const f32x4*)(sc + col)) + *(const f32x4*)(sh + col); v2u o; o.x = pk2(hv[0], hv[1]); o.y = pk2(hv[2], hv[3]); __builtin_nontemporal_store(o, (GAS v2u*)(ho + col)); } }
}
__device__ __forceinline__ int row_group(int row) { return row < MLAT ? (row >> 12) : 4; }
__device__ __forceinline__ void phase_a3(Frame& F) {
    const int gw = F.vcu * NWAVES + __builtin_amdgcn_readfirstlane(F.ltid() >> 6), NGW = F.G * NWAVES;
    for (int row = gw; row < MTOT; row += NGW) { const float* src = row < MLAT ? F.x + (size_t)row * D : F.ctx + (size_t)(row - MLAT) * D; const float* md = F.mods + (size_t)row_group(row) * INW;
        ln_row(src, nullptr, nullptr, 0, nullptr, nullptr, F.X + (size_t)row * D, ALPHA, F.HA + (size_t)row * D, md + D, md, (F.ltid() & 63)); }
}
#ifndef LN_NT
#define LN_NT 1
#endif
#if LN_NT
#define LN_LD(p) __builtin_nontemporal_load(p)
#define LN_ST(p, v) __builtin_nontemporal_store((v), (p))
#else
#define LN_LD(p) (*(p))
#define LN_ST(p, v) (*(p) = (v))
#endif
__device__ __forceinline__ void ln_finish(f32x4 (&v)[8], const float* gam, const float* bet, float* xo, float xs, bf16* ho, const float* sc, const float* sh, int lane) {
    float s = 0.f;
#pragma unroll
    for (int j = 0; j < 8; ++j) s += (v[j][0] + v[j][1]) + (v[j][2] + v[j][3]);
    const float mean = wave_sum(s) * (1.f / D); float s2 = 0.f;
#pragma unroll
    for (int j = 0; j < 8; ++j) { v[j] = v[j] - mean; s2 += (v[j][0] * v[j][0] + v[j][1] * v[j][1]) + (v[j][2] * v[j][2] + v[j][3] * v[j][3]); }
    const float rstd = 1.0f / sqrtf(wave_sum(s2) * (1.f / D) + LN_EPS);
#pragma unroll
    for (int j = 0; j < 8; ++j) { const int col = 4 * lane + 256 * j; f32x4 xn = v[j] * rstd;
        xn = xn * *(const f32x4*)(gam + col) + *(const f32x4*)(bet + col);
        if (xo) LN_ST((GAS f32x4*)(xo + col), xn * xs);
        if (ho) { const f32x4 hv = xn * (1.0f + *(const f32x4*)(sc + col)) + *(const f32x4*)(sh + col); v2u o; o.x = pk2(hv[0], hv[1]); o.y = pk2(hv[2], hv[3]); LN_ST((GAS v2u*)(ho + col), o); } }
}
__device__ __forceinline__ void phase_ln(Frame& F, const float* gam, const float* bet, int nrows, bool to_out, bool want_h, int lm, int moff, int nsplit, bool dry = false) {
    const int gw = F.vcu * NWAVES + __builtin_amdgcn_readfirstlane(F.ltid() >> 6), NGW = F.G * NWAVES; const int lane = F.ltid() & 63;
    f32x4 xa[8]; v2u ta[8];
    int row = gw;
    if (row < MLAT) {
#pragma unroll
        for (int j = 0; j < 8; ++j) { xa[j] = LN_LD((const GAS f32x4*)(F.X + (size_t)row * D + 4 * lane + 256 * j)); ta[j] = LN_LD((const GAS v2u*)(F.Y + (size_t)row * D + 4 * lane + 256 * j)); } }
    for (; row < MLAT; row += NGW) {
        f32x4 v[8];
#pragma unroll
        for (int j = 0; j < 8; ++j) v[j] = xa[j] + (f32x4){bflo(ta[j].x), bfhi(ta[j].x), bflo(ta[j].y), bfhi(ta[j].y)};
        const int nx = row + NGW;
        if (nx < MLAT) {
#pragma unroll
            for (int j = 0; j < 8; ++j) { xa[j] = LN_LD((const GAS f32x4*)(F.X + (size_t)nx * D + 4 * lane + 256 * j)); ta[j] = LN_LD((const GAS v2u*)(F.Y + (size_t)nx * D + 4 * lane + 256 * j)); } }
        const float* md = F.mods + ((size_t)lm * 5 + (row >> 12)) * INW + moff;
        ln_finish(v, gam, bet, dry ? (float*)(F.Z + (size_t)134 * MiB) + (size_t)row * D : (to_out ? F.out + (size_t)row * D : F.X + (size_t)row * D), to_out ? 1.0f : ALPHA, want_h ? (dry ? F.MG : F.HA) + (size_t)row * D : nullptr, md + D, md, lane);
    }
    for (; row < nrows; row += NGW) { const float* md = F.mods + ((size_t)lm * 5 + 4) * INW + moff;
        ln_row(F.X + (size_t)row * D, nullptr, (const float*)(F.Z + (size_t)100 * MiB) + (size_t)(row - MLAT) * D, nsplit, gam, bet, dry ? (float*)(F.Z + (size_t)134 * MiB) + (size_t)row * D : (to_out ? F.out + (size_t)row * D : F.X + (size_t)row * D), to_out ? 1.0f : ALPHA, want_h ? (dry ? F.MG : F.HA) + (size_t)row * D : nullptr, md + D, md, lane); }
}

constexpr int AT_KB = 0, AT_VB = 32768, AT_TILE = 16384, AT_XB = 65536;
__device__ __forceinline__ s16x4 vtr(const LAS unsigned char* p) { typedef short v4i16_t __attribute__((ext_vector_type(4))); return __builtin_bit_cast(s16x4, __builtin_amdgcn_ds_read_tr16_b64_v4i16((LAS v4i16_t*)p)); }
__device__ __forceinline__ float max3f(float a, float b, float c) { float r; asm("v_max3_f32 %0, %1, %2, %3" : "=v"(r) : "v"(a), "v"(b), "v"(c)); return r; }
__device__ __forceinline__ float max2f(float a, float b) { float r; asm("v_max_f32_e32 %0, %1, %2" : "=v"(r) : "v"(a), "v"(b)); return r; }
__device__ __forceinline__ void glds16(const void* gsrc, unsigned lds_dst) { unsigned keep;
    asm volatile("s_mov_b32 %0, m0\n\ts_mov_b32 m0, %2\n\ts_nop 0\n\tglobal_load_lds_dwordx4 %1, off\n\ts_mov_b32 m0, %0" : "=&s"(keep) : "v"(gsrc), "s"(lds_dst) : "memory"); }
#ifndef XTRA_EXP
#define XTRA_EXP 0
#endif
#define AT_WAITV(n) asm volatile("s_waitcnt vmcnt(" #n ")" ::: "memory")
#define AT_BAR() asm volatile("s_waitcnt lgkmcnt(0)\n\ts_barrier" ::: "memory")
__device__ __forceinline__ void attn_unit(Frame& F, int b, int h, int qb, bool ctxq, float lam, float oscale, const float* subg) {
    int lane_ = (F.ltid() & 63); asm volatile("" : "+v"(lane_));
    const int lane = lane_, wid = __builtin_amdgcn_readfirstlane(F.ltid() >> 6), r32 = lane & 31, hi = lane >> 5, m = wid >> 2, qg = wid & 3; const bool lead = wid < 4;
    const bf16* Z = F.Z;
    const int qrow = (ctxq ? MLAT + b * CTXL : b * SEQ) + qb * 128 + qg * 32 + r32;
    bf16x8 qf[4];
#pragma unroll
    for (int d0 = 0; d0 < 4; ++d0) qf[d0] = *(const GAS bf16x8*)(Z + (size_t)qrow * INW + Q_OFF + h * 128 + m * 64 + d0 * 16 + hi * 8);
    const int NT = ctxq ? 4 : 68;
    const bf16* Kbh = F.KB + (size_t)(b * 8 + h) * 4352 * 128; const bf16* Vbh = F.VB + (size_t)(b * 8 + h) * 4352 * 128;
    const unsigned lds0 = (unsigned)(size_t)F.lds;
    const int prow = 8 * wid + (lane >> 4), ppos = lane & 15;
    const unsigned koff0 = (unsigned)(prow * 128 + ((ppos ^ (prow & 15)) * 8)), koff1 = (unsigned)((prow + 4) * 128 + ((ppos ^ ((prow + 4) & 15)) * 8));
    const unsigned voff0 = (unsigned)(prow * 128 + ((ppos ^ (4 * (prow & 3))) * 8)), voff1 = voff0 + 4 * 128;
    const unsigned kdst = (unsigned)__builtin_amdgcn_readfirstlane((int)(lds0 + AT_KB + wid * 2048)), vdst = (unsigned)__builtin_amdgcn_readfirstlane((int)(lds0 + AT_VB + wid * 2048));
#define AT_DMAK(t, bufo) do { const bf16* tb_ = Kbh + (size_t)(t) * 8192; glds16(tb_ + koff0, kdst + (bufo)); glds16(tb_ + koff1, kdst + (bufo) + 1024); } while (0)
#define AT_DMAV(t, bufo) do { const bf16* tb_ = Vbh + (size_t)(t) * 8192; glds16(tb_ + voff0, vdst + (bufo)); glds16(tb_ + voff1, vdst + (bufo) + 1024); } while (0)
    f32x16 o[4];
#pragma unroll
    for (int db = 0; db < 4; ++db)
#pragma unroll
        for (int r = 0; r < 16; ++r) o[db][r] = 0.f;
    float mref = 0.f, lsum = 0.f;
    f32x16 negm;
#pragma unroll
    for (int r = 0; r < 16; ++r) negm[r] = 0.f;
    const unsigned kaddr0 = AT_KB + r32 * 256 + (((8 * m + hi) ^ (r32 & 15)) << 4);
    const int a4 = (lane & 15) >> 2, cc = 2 * ((lane >> 4) & 1) + ((lane & 3) >> 1);
    const unsigned vaddr0 = AT_VB + (4 * hi + a4) * 256 + ((4 * a4 + cc) << 4) + 8 * (lane & 1);
    __syncthreads();
#ifndef AT_THR
#define AT_THR 8.0f
#endif
#define AT_SB() __builtin_amdgcn_sched_barrier(0)
#define AT_PIN(x) asm volatile("" : "+v"(x))
#define AT_KFRAG(i) (*(const LAS bf16x8*)(F.lds + (kb_ ^ (unsigned)((2 * ((i) >> 1)) << 4)) + ((i) & 1) * 8192))
#define AT_VFRAG(lo, hh, ks, db) do { const unsigned va_ = (vb_ ^ (unsigned)((db) << 6)) + (16 * (ks)) * 256; lo = vtr(F.lds + va_); hh = vtr(F.lds + va_ + 8 * 256); } while (0)
#define AT_VF(lo, hh) ((bf16x8){lo[0], lo[1], lo[2], lo[3], hh[0], hh[1], hh[2], hh[3]})
#define AT_MAXDEC(C0, C1, FIRST) do { \
        float tmax = max3f(C0[0], C0[1], C0[2]), tmb_ = max3f(C1[0], C1[1], C1[2]); \
        _Pragma("unroll") for (int r = 3; r < 15; r += 2) tmax = max3f(tmax, C0[r], C0[r + 1]); \
        _Pragma("unroll") for (int r = 3; r < 15; r += 2) tmb_ = max3f(tmb_, C1[r], C1[r + 1]); \
        tmax = max3f(tmax, C0[15], C1[15]); tmax = max2f(tmax, tmb_); { auto rr_ = __builtin_amdgcn_permlane32_swap(__float_as_uint(tmax), __float_as_uint(tmax), false, false); tmax = max2f(__uint_as_float(rr_[0]), __uint_as_float(rr_[1])); } \
        resc = false; \
        if (FIRST) { mref = tmax; \
            _Pragma("unroll") for (int r = 0; r < 16; ++r) { C0[r] -= tmax; C1[r] -= tmax; negm[r] = -mref; } \
        } else if (__any(tmax > AT_THR)) { \
            const float dl = __builtin_fmaxf(tmax, 0.f); mref += dl; alr = __builtin_amdgcn_exp2f(-dl); lsum *= alr; resc = true; \
            _Pragma("unroll") for (int r = 0; r < 16; ++r) { C0[r] -= dl; C1[r] -= dl; negm[r] = -mref; } \
        } } while (0)
#define AT_GAPA(i, CD, CS, PP, PB, PW, PWI) do { \
        AT_VFRAG(vlo[i], vhi[i], (i) >> 2, (i) & 3); \
        CD = __builtin_amdgcn_mfma_f32_32x32x16_bf16(((i) & 1) ? kfb : kfa, qf[(i) >> 1], CS, 0, 0, 0); \
        if ((i) + 2 < 8) { if ((i) & 1) kfb = AT_KFRAG((i) + 2); else kfa = AT_KFRAG((i) + 2); } \
        sacc += PP[PB]; sacc += PP[PB + 1]; sacc += PP[PB + 2]; sacc += PP[PB + 3]; AT_PIN(sacc); \
        PW[PWI] = cvtpk(PP[PB], PP[PB + 1]); PW[PWI + 1] = cvtpk(PP[PB + 2], PP[PB + 3]); AT_PIN(PW); AT_SB(); } while (0)
#define AT_GAPB(j, VL, VH, PW, CC, CB) do { \
        if ((j) < 8) AT_VFRAG(wlo[j], whi[j], 2 + ((j) >> 2), (j) & 3); \
        o[(j) & 3] = __builtin_amdgcn_mfma_f32_32x32x16_bf16(AT_VF(VL, VH), __builtin_bit_cast(bf16x8, PW), o[(j) & 3], 0, 0, 0); \
        CC[CB] = __builtin_amdgcn_exp2f(CC[CB]); CC[CB + 1] = __builtin_amdgcn_exp2f(CC[CB + 1]); AT_PIN(CC); AT_SB(); } while (0)
#define AT_STEP(C0, C1, P0, P1, T) do { \
        const unsigned kbo_ = ((T) & 1) ? AT_TILE : 0, vbo_ = ((T) & 1) ? 0 : AT_TILE; \
        const bf16* tk_ = Kbh + (size_t)((T) + 1) * 8192; const bf16* tv_ = Vbh + (size_t)(T) * 8192; const bool morek_ = (T) + 1 < NT; \
        unsigned kb_ = kaddr0 + kbo_, vb_ = vaddr0 + vbo_; asm volatile("" : "+v"(kb_), "+v"(vb_)); \
        bf16x8 kfa = AT_KFRAG(0), kfb = AT_KFRAG(1); float sacc = 0.f; AT_SB(); \
        AT_GAPA(0, C0, negm, P0, 0, pw0, 0); glds16(tv_ + voff0, vdst + (vbo_ ^ AT_TILE)); AT_SB(); AT_GAPA(1, C1, negm, P0, 4, pw0, 2); glds16(tv_ + voff1, vdst + (vbo_ ^ AT_TILE) + 1024); AT_SB(); \
        AT_GAPA(2, C0, C0, P0, 8, pw1, 0); if (morek_) glds16(tk_ + koff0, kdst + (kbo_ ^ AT_TILE)); AT_SB(); AT_GAPA(3, C1, C1, P0, 12, pw1, 2); if (morek_) glds16(tk_ + koff1, kdst + (kbo_ ^ AT_TILE) + 1024); AT_SB(); \
        AT_GAPA(4, C0, C0, P1, 0, pw2, 0); AT_GAPA(5, C1, C1, P1, 4, pw2, 2); AT_GAPA(6, C0, C0, P1, 8, pw3, 0); AT_GAPA(7, C1, C1, P1, 12, pw3, 2); \
        lsum += sacc; \
        AT_MAXDEC(C0, C1, false); AT_SB(); \
        AT_GAPB(0, vlo[0], vhi[0], pw0, C0, 0); AT_GAPB(1, vlo[1], vhi[1], pw0, C0, 2); AT_GAPB(2, vlo[2], vhi[2], pw0, C0, 4); AT_GAPB(3, vlo[3], vhi[3], pw0, C0, 6); \
        AT_GAPB(4, vlo[4], vhi[4], pw1, C0, 8); AT_GAPB(5, vlo[5], vhi[5], pw1, C0, 10); AT_GAPB(6, vlo[6], vhi[6], pw1, C0, 12); AT_GAPB(7, vlo[7], vhi[7], pw1, C0, 14); \
        AT_GAPB(8, wlo[0], whi[0], pw2, C1, 0); AT_GAPB(9, wlo[1], whi[1], pw2, C1, 2); AT_GAPB(10, wlo[2], whi[2], pw2, C1, 4); AT_GAPB(11, wlo[3], whi[3], pw2, C1, 6); \
        AT_GAPB(12, wlo[4], whi[4], pw3, C1, 8); AT_GAPB(13, wlo[5], whi[5], pw3, C1, 10); AT_GAPB(14, wlo[6], whi[6], pw3, C1, 12); AT_GAPB(15, wlo[7], whi[7], pw3, C1, 14); \
        if (resc) { _Pragma("unroll") for (int db = 0; db < 4; ++db) _Pragma("unroll") for (int r = 0; r < 16; ++r) o[db][r] *= alr; } \
        asm volatile("s_waitcnt vmcnt(0) lgkmcnt(0)\n\ts_barrier" ::: "memory"); } while (0)
    f32x16 pA0, pA1, pB0, pB1; v4u pw0, pw1, pw2, pw3; s16x4 vlo[8], vhi[8], wlo[8], whi[8]; bool resc = false; float alr = 1.f;
#pragma unroll
    for (int r = 0; r < 16; ++r) { pB0[r] = 0.f; pB1[r] = 0.f; }
    pw0 = pw1 = pw2 = pw3 = (v4u){0u, 0u, 0u, 0u};
    AT_DMAK(0, 0);
    asm volatile("s_waitcnt vmcnt(0) lgkmcnt(0)\n\ts_barrier" ::: "memory");
    { if (NT > 1) AT_DMAK(1, AT_TILE);
      AT_DMAV(0, 0);
      unsigned kb_ = kaddr0; asm volatile("" : "+v"(kb_));
      pA0 = __builtin_amdgcn_mfma_f32_32x32x16_bf16(AT_KFRAG(0), qf[0], negm, 0, 0, 0); pA1 = __builtin_amdgcn_mfma_f32_32x32x16_bf16(AT_KFRAG(1), qf[0], negm, 0, 0, 0);
#pragma unroll
      for (int d0 = 1; d0 < 4; ++d0) { pA0 = __builtin_amdgcn_mfma_f32_32x32x16_bf16(AT_KFRAG(2 * d0), qf[d0], pA0, 0, 0, 0); pA1 = __builtin_amdgcn_mfma_f32_32x32x16_bf16(AT_KFRAG(2 * d0 + 1), qf[d0], pA1, 0, 0, 0); }
      AT_MAXDEC(pA0, pA1, true);
#pragma unroll
      for (int r = 0; r < 16; ++r) { pA0[r] = __builtin_amdgcn_exp2f(pA0[r]); pA1[r] = __builtin_amdgcn_exp2f(pA1[r]); }
      asm volatile("s_waitcnt vmcnt(0) lgkmcnt(0)\n\ts_barrier" ::: "memory"); }
    for (int t = 1; t < NT - 1; t += 2) { AT_STEP(pB0, pB1, pA0, pA1, t); AT_STEP(pA0, pA1, pB0, pB1, t + 1); }
    AT_STEP(pB0, pB1, pA0, pA1, NT - 1);
    { float sacc = 0.f;
#pragma unroll
      for (int r = 0; r < 16; ++r) sacc += pB0[r] + pB1[r];
      lsum += sacc;
      pw0 = (v4u){cvtpk(pB0[0], pB0[1]), cvtpk(pB0[2], pB0[3]), cvtpk(pB0[4], pB0[5]), cvtpk(pB0[6], pB0[7])}; pw1 = (v4u){cvtpk(pB0[8], pB0[9]), cvtpk(pB0[10], pB0[11]), cvtpk(pB0[12], pB0[13]), cvtpk(pB0[14], pB0[15])};
      pw2 = (v4u){cvtpk(pB1[0], pB1[1]), cvtpk(pB1[2], pB1[3]), cvtpk(pB1[4], pB1[5]), cvtpk(pB1[6], pB1[7])}; pw3 = (v4u){cvtpk(pB1[8], pB1[9]), cvtpk(pB1[10], pB1[11]), cvtpk(pB1[12], pB1[13]), cvtpk(pB1[14], pB1[15])};
      unsigned vb_ = vaddr0 + (((NT - 1) & 1) ? AT_TILE : 0); asm volatile("" : "+v"(vb_));
#pragma unroll
      for (int j = 0; j < 8; ++j) { AT_VFRAG(vlo[j], vhi[j], j >> 2, j & 3); AT_VFRAG(wlo[j], whi[j], 2 + (j >> 2), j & 3); }
      AT_SB();
#pragma unroll
      for (int j = 0; j < 8; ++j) o[j & 3] = __builtin_amdgcn_mfma_f32_32x32x16_bf16(AT_VF(vlo[j], vhi[j]), __builtin_bit_cast(bf16x8, (j < 4) ? pw0 : pw1), o[j & 3], 0, 0, 0);
#pragma unroll
      for (int j = 0; j < 8; ++j) o[j & 3] = __builtin_amdgcn_mfma_f32_32x32x16_bf16(AT_VF(wlo[j], whi[j]), __builtin_bit_cast(bf16x8, (j < 4) ? pw2 : pw3), o[j & 3], 0, 0, 0);
      asm volatile("s_waitcnt lgkmcnt(0)\n\ts_barrier" ::: "memory"); }
#undef AT_SB
#undef AT_PIN
#undef AT_KFRAG
#undef AT_VFRAG
#undef AT_VF
#undef AT_MAXDEC
#undef AT_GAPA
#undef AT_GAPB
#undef AT_STEP
    const float lt = lsum + __shfl_xor(lsum, 32);
    LAS float* xs = (LAS float*)(F.lds + AT_XB) + qg * 4096 + lane;
    if (!lead) { const float sc1 = lam / lt;
#pragma unroll
        for (int db = 0; db < 4; ++db)
#pragma unroll
            for (int r = 0; r < 16; ++r) xs[(db * 16 + r) * 64] = o[db][r] * sc1; }
    __syncthreads();
    if (lead) {
        const float i0 = 1.0f / lt; float ss = 0.f;
#pragma unroll
        for (int db = 0; db < 4; ++db)
#pragma unroll
            for (int r = 0; r < 16; ++r) { const float v = o[db][r] * i0 - xs[(db * 16 + r) * 64]; o[db][r] = v; ss += v * v; }
        ss += __shfl_xor(ss, 32);
        const float rs = oscale / sqrtf(ss * (1.0f / 128.0f) + LN_EPS);
        bf16* yp = F.Y + (size_t)qrow * YW + h * 128 + 8 * hi;
#pragma unroll
        for (int db = 0; db < 4; ++db)
#pragma unroll
            for (int k2 = 0; k2 < 2; ++k2) { v2u w[2];
#pragma unroll
                for (int e = 0; e < 2; ++e) { const int g4 = 2 * k2 + e; const int d = 32 * db + 8 * g4; const f32x4 gv = *(const f32x4*)(subg + d + 4 * hi);
                    w[e].x = cvtpk(o[db][4 * g4 + 0] * rs * gv[0], o[db][4 * g4 + 1] * rs * gv[1]); w[e].y = cvtpk(o[db][4 * g4 + 2] * rs * gv[2], o[db][4 * g4 + 3] * rs * gv[3]); }
                const auto sx = __builtin_amdgcn_permlane32_swap(w[0].x, w[1].x, false, false), sy = __builtin_amdgcn_permlane32_swap(w[0].y, w[1].y, false, false);
                v4u q4; q4.x = sx[0]; q4.y = sy[0]; q4.z = sx[1]; q4.w = sy[1];
                *(GAS v4u*)(yp + 32 * db + 16 * k2) = q4; }
    }
#undef AT_DMAK
#undef AT_DMAV
}

constexpr int GM_ST = 0, GM_VT = 1024, GM_VP = 272;
__device__ __forceinline__ void gmlp_unit(Frame& F, int row0, int l) {
    int tid_ = F.ltid(); asm volatile("" : "+v"(tid_)); const int tid = tid_, lane = tid & 63, wid = __builtin_amdgcn_readfirstlane(F.ltid() >> 6);
    typedef float f32x2v __attribute__((ext_vector_type(2)));
    LAS f32x2v* st = (LAS f32x2v*)(F.lds + GM_ST); LAS unsigned char* vt = F.lds + GM_VT;
    const bf16* Z = F.Z;
    __syncthreads();
#pragma unroll
    for (int hb = 0; hb < 2; ++hb) {
        v4u va[8], vb[8];
#pragma unroll
        for (int i = 0; i < 8; ++i) { const bf16* vp = Z + (size_t)(row0 + wid * 16 + hb * 8 + i) * INW + BU_OFF + BW + lane * 16; va[i] = *(const GAS v4u*)(vp); vb[i] = *(const GAS v4u*)(vp + 8); }
#pragma unroll
        for (int i = 0; i < 8; ++i) { const v4u a = va[i], b2 = vb[i];
            const float x[16] = {bflo(a.x), bfhi(a.x), bflo(a.y), bfhi(a.y), bflo(a.z), bfhi(a.z), bflo(a.w), bfhi(a.w), bflo(b2.x), bfhi(b2.x), bflo(b2.y), bfhi(b2.y), bflo(b2.z), bfhi(b2.z), bflo(b2.w), bfhi(b2.w)};
            float s = 0.f;
#pragma unroll
            for (int e = 0; e < 16; ++e) s += x[e];
            const float mean = wave_sum(s) * (1.0f / 1024.0f); float q = 0.f;
#pragma unroll
            for (int e = 0; e < 16; ++e) { const float dd = x[e] - mean; q += dd * dd; }
            const float rstd = 1.0f / sqrtf(wave_sum(q) * (1.0f / 1024.0f) + LN_EPS);
            if (lane == 0) st[wid * 16 + hb * 8 + i] = (f32x2v){mean, rstd}; }
    }
    const float* lng = F.gln_g + (size_t)l * BW; const float* lnb = F.gln_b + (size_t)l * BW;
    const int j = tid & 127, cc = tid >> 7;
    const int fr = lane & 15, fq = lane >> 4, tok = wid * 16 + fr;
    const bf16* vsrc = Z + (size_t)(row0 + j) * INW + BU_OFF + BW + cc * 32;
    v4u vr[4];
#pragma unroll
    for (int q4 = 0; q4 < 4; ++q4) vr[q4] = *(const GAS v4u*)(vsrc + q4 * 8);
    __syncthreads();
    const f32x2v sj = st[j];
#pragma unroll 1
    for (int g = 0; g < 8; ++g) {
        bf16x8 wf[4]; v2u uu[8];
        const bf16* wg = F.Wsp + ((size_t)l * 8 + g) * 16384 + (size_t)tok * 128 + fq * 8;
#pragma unroll
        for (int ks = 0; ks < 4; ++ks) wf[ks] = *(const GAS bf16x8*)(wg + ks * 32);
        const bf16* up = Z + (size_t)(row0 + tok) * INW + BU_OFF + g * 128 + 4 * fq;
#pragma unroll
        for (int ct = 0; ct < 8; ++ct) uu[ct] = *(const GAS v2u*)(up + ct * 16);
        const float bias = F.b_sp[((size_t)l * 8 + g) * 128 + tok];
#pragma unroll
        for (int q4 = 0; q4 < 4; ++q4) { const v4u a = vr[q4]; const int c0 = cc * 32 + q4 * 8;
            const f32x4 g0 = *(const f32x4*)(lng + g * 128 + c0), g1 = *(const f32x4*)(lng + g * 128 + c0 + 4), b0 = *(const f32x4*)(lnb + g * 128 + c0), b1 = *(const f32x4*)(lnb + g * 128 + c0 + 4);
            const float xv[8] = {bflo(a.x), bfhi(a.x), bflo(a.y), bfhi(a.y), bflo(a.z), bfhi(a.z), bflo(a.w), bfhi(a.w)};
#pragma unroll
            for (int e = 0; e < 8; ++e) { const float gg = e < 4 ? g0[e & 3] : g1[e & 3], bb = e < 4 ? b0[e & 3] : b1[e & 3]; const float y = (xv[e] - sj.x) * sj.y * gg + bb;
                *(LAS bf16*)(vt + (c0 + e) * GM_VP + j * 2) = (bf16)f2bf(y); } }
        if (g < 7) {
#pragma unroll
            for (int q4 = 0; q4 < 4; ++q4) vr[q4] = *(const GAS v4u*)(vsrc + (g + 1) * 128 + q4 * 8);
        }
        __syncthreads();
#pragma unroll
        for (int ct = 0; ct < 8; ++ct) { f32x4 acc = {0.f, 0.f, 0.f, 0.f};
#pragma unroll
            for (int ks = 0; ks < 4; ++ks) { const bf16x8 af = *(const LAS bf16x8*)(vt + (ct * 16 + fr) * GM_VP + (ks * 32 + fq * 8) * 2); acc = __builtin_amdgcn_mfma_f32_16x16x32_bf16(af, wf[ks], acc, 0, 0, 0); }
            const v2u u2 = uu[ct];
            v2u w; w.x = cvtpk(bflo(u2.x) * (acc[0] + bias), bfhi(u2.x) * (acc[1] + bias)); w.y = cvtpk(bflo(u2.y) * (acc[2] + bias), bfhi(u2.y) * (acc[3] + bias));
            *(GAS v2u*)(F.Y + (size_t)(row0 + tok) * YW + BW + g * 128 + ct * 16 + 4 * fq) = w; }
        __syncthreads();
    }
}

constexpr int PL_DP = 528;
template <int GI> __device__ __forceinline__ void pool_unit(Frame& F, int row0, int l) {
    int tid_ = F.ltid(); asm volatile("" : "+v"(tid_)); const int tid = tid_, lane = tid & 63, wid = __builtin_amdgcn_readfirstlane(F.ltid() >> 6);
    LAS unsigned char* dt = F.lds;
    const bf16* Z = F.Z;
    constexpr int W = 2 << GI, HW = W / 2, NR = 8 + W - 1;
    const int seqlen = row0 < MLAT ? SEQ : CTXL; const int s0 = row0 < MLAT ? (row0 & ~(SEQ - 1)) : MLAT + ((row0 - MLAT) & ~(CTXL - 1));
    const int fr = lane & 15, fq = lane >> 4;
    bf16x8 wa[8][2];
    { const bf16* wp = F.Wpool + ((size_t)l * 4 + GI) * 65536 + (size_t)(wid * 32 + fr) * 256 + fq * 8;
#pragma unroll
      for (int ks = 0; ks < 8; ++ks) { wa[ks][0] = *(const GAS bf16x8*)(wp + ks * 32); wa[ks][1] = *(const GAS bf16x8*)(wp + 16 * 256 + ks * 32); } }
    __syncthreads();
    { const int ch = tid & 31, tg = tid >> 5;
      const bf16* zc = Z + C_OFF + GI * 256 + ch * 8; const int p0 = row0 - s0 + tg * 8;
      v4u rw[NR];
#pragma unroll
      for (int k = 0; k < NR; ++k) { const int q = p0 - HW + k; const bool ok = (q >= 0) && (q < seqlen); const int qq = ok ? q : p0; const v4u a = *(const GAS v4u*)(zc + (size_t)(s0 + qq) * INW); rw[k] = ok ? a : (v4u){0u, 0u, 0u, 0u}; }
      float sum[8] = {0.f, 0.f, 0.f, 0.f, 0.f, 0.f, 0.f, 0.f};
#pragma unroll
      for (int k = 0; k < W; ++k) { const v4u a = rw[k]; sum[0] += bflo(a.x); sum[1] += bfhi(a.x); sum[2] += bflo(a.y); sum[3] += bfhi(a.y); sum[4] += bflo(a.z); sum[5] += bfhi(a.z); sum[6] += bflo(a.w); sum[7] += bfhi(a.w); }
#pragma unroll
      for (int i = 0; i < 8; ++i) { const int p = p0 + i; const int lo = p - HW < 0 ? 0 : p - HW; const int hi = p - HW + W > seqlen ? seqlen : p - HW + W; const float inv = 1.0f / (float)(hi - lo);
          const v4u zz = rw[i + HW];
          v4u o; o.x = pk2(sum[0] * inv - bflo(zz.x), sum[1] * inv - bfhi(zz.x)); o.y = pk2(sum[2] * inv - bflo(zz.y), sum[3] * inv - bfhi(zz.y));
          o.z = pk2(sum[4] * inv - bflo(zz.z), sum[5] * inv - bfhi(zz.z)); o.w = pk2(sum[6] * inv - bflo(zz.w), sum[7] * inv - bfhi(zz.w));
          *(LAS v4u*)(dt + (tg * 8 + i) * PL_DP + ch * 16) = o;
          if (i < 7) { const v4u a = rw[i + W], b = rw[i];
              sum[0] += bflo(a.x) - bflo(b.x); sum[1] += bfhi(a.x) - bfhi(b.x); sum[2] += bflo(a.y) - bflo(b.y); sum[3] += bfhi(a.y) - bfhi(b.y);
              sum[4] += bflo(a.z) - bflo(b.z); sum[5] += bfhi(a.z) - bfhi(b.z); sum[6] += bflo(a.w) - bflo(b.w); sum[7] += bfhi(a.w) - bfhi(b.w); } } }
    __syncthreads();
    { f32x4 acc[2][8];
#pragma unroll
      for (int a = 0; a < 2; ++a)
#pragma unroll
          for (int tt = 0; tt < 8; ++tt) acc[a][tt] = (f32x4){0.f, 0.f, 0.f, 0.f};
#pragma unroll
      for (int ks = 0; ks < 8; ++ks) {
#pragma unroll
          for (int tt = 0; tt < 8; ++tt) { const bf16x8 bfr = *(const LAS bf16x8*)(dt + (tt * 16 + fr) * PL_DP + (ks * 32 + fq * 8) * 2);
              acc[0][tt] = __builtin_amdgcn_mfma_f32_16x16x32_bf16(wa[ks][0], bfr, acc[0][tt], 0, 0, 0); acc[1][tt] = __builtin_amdgcn_mfma_f32_16x16x32_bf16(wa[ks][1], bfr, acc[1][tt], 0, 0, 0); } }
      const float* ps = F.pool_scale + (size_t)l * BW + GI * 256;
#pragma unroll
      for (int a = 0; a < 2; ++a) { const int dd = wid * 32 + a * 16 + 4 * fq; const f32x4 sc = *(const f32x4*)(ps + dd);
#pragma unroll
          for (int tt = 0; tt < 8; ++tt) { const f32x4 v = acc[a][tt] * sc; v2u wv; wv.x = cvtpk(v[0], v[1]); wv.y = cvtpk(v[2], v[3]);
              *(GAS v2u*)(F.Y + (size_t)(row0 + tt * 16 + fr) * YW + 2 * BW + GI * 256 + dd) = wv; } } }
}
__device__ __forceinline__ void pool_dispatch(Frame& F, int row0, int g, int l) {
    if (g == 0) pool_unit<0>(F, row0, l); else if (g == 1) pool_unit<1>(F, row0, l); else if (g == 2) pool_unit<2>(F, row0, l); else pool_unit<3>(F, row0, l);
}

#ifndef MIXM
#define MIXM 7
#endif
__device__ __forceinline__ void phase_mixers(Frame& F, int l, float lam_init) {
    const bool last = (l == DEPTH - 1);
    float d01 = 0.f, d23 = 0.f; const float* lq = F.lam_qk + (size_t)l * 256;
    for (int i = 0; i < 64; ++i) { d01 += lq[i] * lq[64 + i]; d23 += lq[128 + i] * lq[192 + i]; }
    const float lam = __expf(d01) - __expf(d23) + lam_init; const float oscale = 1.0f - lam_init;
    const float* subg = F.subln_g + (size_t)l * 128;
#ifndef REP_ATT
#define REP_ATT 1
#endif
#ifndef REP_GP
#define REP_GP 1
#endif
#pragma nounroll
    for (int i = 0; i < 5 * REP_ATT; ++i) { const int uid = F.vcu + F.G * (i % 5);
        if (!(MIXM & 1)) continue;
        if (uid < 1024) attn_unit(F, uid >> 8, (uid >> 5) & 7, uid & 31, false, lam, oscale, subg);
        else if (!last && uid < 1088) attn_unit(F, (uid - 1024) >> 4, ((uid - 1024) >> 1) & 7, uid & 1, true, lam, oscale, subg);
        if (TAILWORK == 2 && !last && i == (F.vcu & 3)) { __syncthreads(); const int gw_ = F.vcu * NWAVES + __builtin_amdgcn_readfirstlane(F.ltid() >> 6); ada_partial_layer(F, l + 1, gw_, F.G * NWAVES); cvt_layer(F, l + 1, gw_, F.G * NWAVES); } }
    const int nchunk = last ? MLAT / 128 : MTOT / 128;
#pragma nounroll
    for (int rgp = 0; rgp < REP_GP; ++rgp) {
    if (MIXM & 2) for (int cidx = F.G - 1 - F.vcu; cidx < nchunk; cidx += F.G) gmlp_unit(F, cidx * 128, l);
    if (MIXM & 4) { const int nfree = F.G - nchunk, npool = nchunk * 4;
        if (nfree > 0 && F.G == 256) {
            if (F.vcu < nfree) { for (int k = 0; k < 4; ++k) { const int u = F.vcu * 4 + k; if (u < npool) pool_dispatch(F, (u >> 2) * 128, u & 3, l); } }
            else { for (int u = nfree * 4 + (F.vcu - nfree); u < npool; u += nchunk) pool_dispatch(F, (u >> 2) * 128, u & 3, l); }
        } else { for (int u = F.vcu; u < npool; u += F.G) pool_dispatch(F, (u >> 2) * 128, u & 3, l); } }
    }
    __syncthreads();
}

#ifndef ALIGN_P3
#define ALIGN_P3 true
#endif
#ifndef WGM_P1
#define WGM_P1 4
#endif
#ifndef WGM_P5
#define WGM_P5 4
#endif
#ifndef WGM_N8
#define WGM_N8 4
#endif
#ifndef SP2_BIG
#define SP2_BIG true
#endif
#ifndef ALIGN_BIG
#define ALIGN_BIG true
#endif
#ifndef STAGGER
#define STAGGER 0
#endif
__device__ __forceinline__ void phase_stagger(int slot) { if (STAGGER) for (int i = 0; i < slot * 3; ++i) __builtin_amdgcn_s_sleep(8); }
#ifndef MK_ONE_LAUNCH
#define MK_ONE_LAUNCH 1
#endif
constexpr int NPHASE = 3 + 8 * DEPTH;
struct Args { const float* in[23]; float* out; unsigned char* ws; int ph_lo, ph_hi; float lam_init[4]; };
__global__ void __launch_bounds__(NWAVES * 64, 2) fwd(Args args) {
    extern __shared__ __attribute__((aligned(16))) unsigned char lds[];
    Frame F;
    F.lds = (LAS unsigned char*)lds;
    F.MISC = (volatile LAS unsigned*)(F.lds + MISC_OFF);
    F.G = gridDim.x; { const int bx = blockIdx.x; F.bx = bx; F.vcu = (F.G % 8 == 0) ? (bx % 8) * (F.G / 8) + bx / 8 : bx; }
    unsigned char* ws = args.ws;
    F.ctl = (gu32*)(ws + WS_CTL);
    frame_ptrs(F);
    for (int u = F.ltid(); u < (LDS_BYTES - LDSCTL_OFF) / 4; u += NWAVES * 64) ((LAS unsigned*)(F.lds + LDSCTL_OFF))[u] = 0u;
    __syncthreads();
#if MK_ONE_LAUNCH
    constexpr int lo = 0, hi = NPHASE; constexpr bool use_bar = true;
#else
    const int lo = args.ph_lo, hi = args.ph_hi;
    const bool use_bar = (hi - lo) > 1;
#endif
    XcdBarrier bar; bar.bar = (unsigned*)(F.ctl + CW_BAR); bar.x = 0; bar.st = nullptr;
    if (use_bar) bar = xcd_barrier_post((unsigned*)(F.ctl + CW_BAR), F.MISC + 8);
#ifndef PHM
#define PHM 0xFFFF
#endif
#define IN(k) (lo <= (k) && (k) < hi)
#define KIND(b) ((PHM >> (b)) & 1)
#ifndef REP_MASK
#define REP_MASK 0
#endif
#define NREP(b) (((REP_MASK >> (b)) & 1) ? 2 : 1)
#define BARRIER() do { XcdBarrier b_ = bar; asm volatile("" : "+s"(b_.x)); xcd_barrier(b_); } while (0)
#ifndef DRY_EPI
#define DRY_EPI 0
#endif
#ifndef BAR_REP
#define BAR_REP 1
#endif
#define SEAM(k) do { if (IN(k) && IN((k) + 1)) { for (int br_ = 0; br_ < BAR_REP; ++br_) BARRIER(); } } while (0)

    if (KIND(0) && IN(0)) { for (int rep = 0; rep < NREP(0); ++rep) { frame_ptrs(F); phase_a1(F); if (rep + 1 < NREP(0)) BARRIER(); } } SEAM(0);
    if (KIND(1) && IN(1)) { frame_ptrs(F); phase_a2(F); } SEAM(1);
    if (KIND(2) && IN(2)) { frame_ptrs(F); phase_a3(F); } SEAM(2);

#pragma nounroll
    for (int l = 0; l < DEPTH; ++l) {
        const int pb = 3 + 8 * l; const bool last = (l == DEPTH - 1);
        { int g_ = F.G, v_ = F.vcu, b_ = F.bx; asm volatile("" : "+s"(g_), "+s"(v_), "+s"(b_)); F.G = g_; F.vcu = v_; F.bx = b_; }
        const int Mrows = last ? MLAT : MTOT;
        if (KIND(3) && IN(pb + 0)) for (int rep = 0; rep < NREP(3); ++rep) { if (rep) BARRIER(); frame_ptrs(F);
            pg8::Gemm g{F.HA, F.Win + (size_t)l * INW * D, MTOT, INW, D, D, D}; pg8::StaticOrder S; S.init(MTOT, INW, F.G, F.bx, WGM_P1);
            pg8::EpiInProj E{F.Z, F.rope, QSCALE, INW, MLAT, F.KB, F.VB, (rep && DRY_EPI) ? 1 : 0};
            phase_stagger((F.bx >> 3) & 7);
            pg8::gemm_phase<pg8::EpiInProj, pg8::StaticOrder, ALIGN_BIG, SP2_BIG>(F.lds + RING_OFF, g, S, E);
        }
        SEAM(pb + 0);
        if (KIND(4) && IN(pb + 1)) for (int rep = 0; rep < NREP(4); ++rep) { if (rep) BARRIER(); frame_ptrs(F); phase_mixers(F, l, args.lam_init[l]); }
        SEAM(pb + 1);
        if (KIND(5) && IN(pb + 2)) for (int rep = 0; rep < NREP(5); ++rep) { if (rep) BARRIER(); frame_ptrs(F);
            pg8::Gemm g{F.Y, F.Wbr + (size_t)l * D * YW, Mrows, D, YW, YW, YW}; pg8::StaticOrder S; S.init(Mrows, D, F.G, F.bx, WGM_N8);
            pg8::EpiGate E{F.Z + G_OFF, INW, F.MG, D};
            pg8::gemm_phase<pg8::EpiGate, pg8::StaticOrder, ALIGN_P3, true>(F.lds + RING_OFF, g, S, E);
        }
        SEAM(pb + 2);
        if (KIND(6) && IN(pb + 3)) for (int rep = 0; rep < NREP(6); ++rep) { if (rep) BARRIER(); frame_ptrs(F);
            void* tw = rep ? (void*)(F.Z + (size_t)134 * MiB) : (void*)F.Y;
            { pg8::Gemm g{F.MG, F.Wout + (size_t)l * D * D, MLAT, D, D, D, D}; pg8::StaticOrder S; S.init(MLAT, D, F.G, F.bx, WGM_N8);
              pg8::EpiResidT<false> E{F.mods + (size_t)l * 5 * INW + 2 * D, INW, tw, D, 1, MLAT};
              pg8::gemm_phase<pg8::EpiResidT<false>, pg8::StaticOrder, true, true>(F.lds + RING_OFF, g, S, E); }
            if (!last) { pg8::Gemm g{F.MG, F.Wout + (size_t)l * D * D, MTOT, D, 256, D, D}; pg8::SplitOrder S; S.init(MLAT / 256, 32, 8, 256, F.G, F.bx);
              pg8::EpiResidT<true> E{F.mods + (size_t)l * 5 * INW + 2 * D, INW, rep ? (void*)(F.Z + (size_t)170 * MiB) : (void*)(F.Z + (size_t)100 * MiB), D, 256, MLAT};
              pg8::gemm_phase<pg8::EpiResidT<true>, pg8::SplitOrder, true, true>(F.lds + RING_OFF, g, S, E); }
            if (TAILWORK == 1 && !last && F.bx >= 32 && rep == 0) ada_partial_layer(F, l + 1, (F.bx - 32) * NWAVES + __builtin_amdgcn_readfirstlane(F.ltid() >> 6), (F.G - 32) * NWAVES);
        }
        SEAM(pb + 3);
        if (KIND(7) && IN(pb + 4)) { frame_ptrs(F); if (NREP(7) > 1) { phase_ln(F, F.ln1_g + (size_t)l * D, F.ln1_b + (size_t)l * D, Mrows, false, true, l, 3 * D, last ? 0 : 8, true); BARRIER(); frame_ptrs(F); }
            phase_ln(F, F.ln1_g + (size_t)l * D, F.ln1_b + (size_t)l * D, Mrows, false, true, l, 3 * D, last ? 0 : 8); if (TAILWORK && !last) mods_reduce_layer(F, l + 1); }
        SEAM(pb + 4);
        if (KIND(8) && IN(pb + 5)) for (int rep = 0; rep < NREP(8); ++rep) { if (rep) BARRIER(); frame_ptrs(F);
            pg8::Gemm g{F.HA, F.Wgu + (size_t)l * 2 * FFH * D, Mrows, 2 * FFH, D, D, D}; pg8::StaticOrder S; S.init(Mrows, 2 * FFH, F.G, F.bx, WGM_P5);
            pg8::EpiSwiglu E{F.Z, FFH};
            phase_stagger((F.bx >> 3) & 7);
            pg8::gemm_phase<pg8::EpiSwiglu, pg8::StaticOrder, ALIGN_BIG, SP2_BIG>(F.lds + RING_OFF, g, S, E);
        }
        SEAM(pb + 5);
        if (KIND(9) && IN(pb + 6)) for (int rep = 0; rep < NREP(9); ++rep) { if (rep) BARRIER(); frame_ptrs(F);
            void* tw = rep ? (void*)(F.Z + (size_t)134 * MiB) : (void*)F.Y;
            { pg8::Gemm g{F.Z, F.Wdn + (size_t)l * D * FFH, MLAT, D, FFH, FFH, FFH}; pg8::StaticOrder S; S.init(MLAT, D, F.G, F.bx, WGM_N8);
              pg8::EpiResidT<false> E{F.mods + (size_t)l * 5 * INW + 5 * D, INW, tw, D, 1, MLAT};
              pg8::gemm_phase<pg8::EpiResidT<false>, pg8::StaticOrder, true, true>(F.lds + RING_OFF, g, S, E); }
            if (!last) { pg8::Gemm g{F.Z, F.Wdn + (size_t)l * D * FFH, MTOT, D, FFH / 4, FFH, FFH}; pg8::SplitOrder S; S.init(MLAT / 256, 32, 4, FFH / 4, F.G, F.bx);
              pg8::EpiResidT<true> E{F.mods + (size_t)l * 5 * INW + 5 * D, INW, rep ? (void*)(F.Z + (size_t)170 * MiB) : (void*)(F.Z + (size_t)100 * MiB), D, FFH / 4, MLAT};
              pg8::gemm_phase<pg8::EpiResidT<true>, pg8::SplitOrder, true, true>(F.lds + RING_OFF, g, S, E); }
            if (TAILWORK == 1 && !last && F.bx >= 32 && rep == 0) { __syncthreads(); cvt_layer(F, l + 1, (F.bx - 32) * NWAVES + __builtin_amdgcn_readfirstlane(F.ltid() >> 6), (F.G - 32) * NWAVES); }
        }
        SEAM(pb + 6);
        if (KIND(7) && IN(pb + 7)) { frame_ptrs(F); phase_ln(F, F.ln2_g + (size_t)l * D, F.ln2_b + (size_t)l * D, Mrows, last, !last, last ? l : l + 1, 0, last ? 0 : 4); }
        if (!last) SEAM(pb + 7);
    }
#undef IN
#undef SEAM
}

extern "C" void kernel_launch(void* const* d_in, const int* in_sizes, int n_in, void* d_out, int out_size, void* d_ws, size_t ws_size, hipStream_t stream) {
    static int grid = 0;
    if (grid == 0) {
        if (n_in != 23 || in_sizes[0] != MLAT * D || out_size != MLAT * D || ws_size < WS_END) {
            fprintf(stderr, "kernel_launch: unexpected shapes / workspace (n_in %d, in0 %d, out %d, ws %zu, need %zu); nothing launched\n", n_in, n_in > 0 ? in_sizes[0] : -1, out_size, ws_size, (size_t)WS_END); grid = -1; return; }
        int dev = 0, cus = 0, per_cu = 0;
        if (hipGetDevice(&dev) != hipSuccess || hipDeviceGetAttribute(&cus, hipDeviceAttributeMultiprocessorCount, dev) != hipSuccess) { grid = -1; return; }
        if (hipFuncSetAttribute((const void*)fwd, hipFuncAttributeMaxDynamicSharedMemorySize, LDS_BYTES) != hipSuccess) { fprintf(stderr, "kernel_launch: hipFuncSetAttribute failed\n"); grid = -1; return; }
        if (hipOccupancyMaxActiveBlocksPerMultiprocessor(&per_cu, (const void*)fwd, NWAVES * 64, LDS_BYTES) != hipSuccess || per_cu < 1) fprintf(stderr, "kernel_launch: occupancy query reports %d\n", per_cu);
        (void)hipGetLastError();
        grid = cus;
    }
    if (grid < 0) return;
    if (hipMemsetAsync((char*)d_ws + WS_CTL, 0, CTL_ZERO_BYTES, stream) != hipSuccess) return;
    Args a{};
    for (int i = 0; i < 23; ++i) a.in[i] = (const float*)d_in[i];
    a.out = (float*)d_out; a.ws = (unsigned char*)d_ws;
    for (int l = 0; l < DEPTH; ++l) a.lam_init[l] = (float)(0.8 - 0.6 * exp(-0.3 * (double)l));
#if MK_ONE_LAUNCH
    a.ph_lo = 0; a.ph_hi = NPHASE;
    hipLaunchKernelGGL(fwd, dim3(grid), dim3(NWAVES * 64), LDS_BYTES, stream, a);
#else
    for (int p = 0; p < NPHASE; ++p) { a.ph_lo = p; a.ph_hi = p + 1; hipLaunchKernelGGL(fwd, dim3(grid), dim3(NWAVES * 64), LDS_BYTES, stream, a); }
#endif
}
```
